# Optimizing an MI355X kernel written in HIP

```python
import math
import jax, jax.numpy as jnp
from jax import lax
import numpy as np

D_MODEL = 2048
BATCH = 2
SEQ = 8192
DEPTH = 1

DIFF_HEADS = 8
DIFF_HEAD_DIM = 64
MOBA_HEADS = 8
MOBA_HEAD_DIM = 128
MOBA_BLOCK = 256
MOBA_TOPK = 3
MOBA_Q_CHUNK = 64
ATTN_Q_BLOCK = 128
REL_BUCKETS = 32
REL_MAX_DIST = 128
N_EXPERTS = 64
N_GROUPS = 8
TOPK_GROUPS = 4
TOPK_EXPERTS = 8
EXPERT_DIM = 512
SHARED_DIM = 512
ROUTED_SCALE = 2.5
MOE_ROW_BLOCK = 128
RMS_EPS = 1e-6

DIFF_QK_W = DIFF_HEADS * 2 * DIFF_HEAD_DIM
DIFF_V_W = DIFF_HEADS * 2 * DIFF_HEAD_DIM
MOBA_W = MOBA_HEADS * MOBA_HEAD_DIM
IN_COLS = 2 * DIFF_QK_W + DIFF_V_W + 3 * MOBA_W + 2 * D_MODEL

kernel_name = 'hybrid_diffattn_moba_moe_adaln'


def _rmsnorm(x, gain):
    xf = x.astype(jnp.float32)
    y = xf * lax.rsqrt(jnp.mean(xf * xf, axis=-1, keepdims=True) + RMS_EPS)
    return (y * gain.astype(jnp.float32)).astype(x.dtype)


def _t5_bucket(rel):
    n = jnp.maximum(rel, 0)
    max_exact = REL_BUCKETS // 2
    nf = jnp.maximum(n, 1).astype(jnp.float32)
    large = max_exact + (jnp.log(nf / max_exact) / math.log(REL_MAX_DIST / max_exact)
                         * (REL_BUCKETS - max_exact)).astype(jnp.int32)
    large = jnp.minimum(large, REL_BUCKETS - 1)
    return jnp.where(n < max_exact, n, large)


def _diff_attention(q, k, v, lam_vecs, subln_g, table, layer_idx):
    B, S = q.shape[0], q.shape[1]
    H, dh, QB = DIFF_HEADS, DIFF_HEAD_DIM, ATTN_Q_BLOCK
    lam_init = 0.8 - 0.6 * math.exp(-0.3 * layer_idx)
    lv = lam_vecs.astype(jnp.float32)
    lam = jnp.exp(jnp.sum(lv[0] * lv[1])) - jnp.exp(jnp.sum(lv[2] * lv[3])) + lam_init
    qh = q.transpose(0, 2, 3, 1, 4)
    kh = k.transpose(0, 2, 3, 1, 4)
    vh = v.transpose(0, 2, 1, 3)
    nqb = S // QB
    q_blocks = qh.reshape(B, H, 2, nqb, QB, dh).transpose(3, 0, 1, 2, 4, 5)
    k_pos = jnp.arange(S)
    scale = dh ** -0.5

    def one_block(args):
        qb, start = args
        q_pos = start + jnp.arange(QB)
        rel = q_pos[:, None] - k_pos[None, :]
        bias = table[_t5_bucket(rel)].astype(jnp.float32).transpose(2, 0, 1)
        logits = jnp.einsum('bhmqd,bhmkd->bhmqk', qb, kh).astype(jnp.float32) * scale + bias[None, :, None]
        logits = jnp.where(rel >= 0, logits, -jnp.inf)
        p = jax.nn.softmax(logits, axis=-1)
        a = p[:, :, 0] - lam * p[:, :, 1]
        return jnp.einsum('bhqk,bhkd->bhqd', a.astype(vh.dtype), vh)

    o = lax.map(one_block, (q_blocks, jnp.arange(nqb, dtype=jnp.int32) * QB))
    o = _rmsnorm(o, subln_g) * (1.0 - lam_init)
    return o.transpose(1, 0, 3, 2, 4).reshape(B, S, H * 2 * dh)


def _moba_attention(q, k, v, table):
    B, S = q.shape[0], q.shape[1]
    H, dh, BLK, QC = MOBA_HEADS, MOBA_HEAD_DIM, MOBA_BLOCK, MOBA_Q_CHUNK
    qh = q.transpose(0, 2, 1, 3)
    kh = k.transpose(0, 2, 1, 3)
    vh = v.transpose(0, 2, 1, 3)
    nb = -(-S // BLK)
    pad = nb * BLK - S
    kblk = jnp.pad(kh, ((0, 0), (0, 0), (0, pad), (0, 0))).reshape(B, H, nb, BLK, dh)
    vblk = jnp.pad(vh, ((0, 0), (0, 0), (0, pad), (0, 0))).reshape(B, H, nb, BLK, dh)
    kmean = jnp.mean(kblk.astype(jnp.float32), axis=3)
    topk = min(MOBA_TOPK, nb)
    nqc = S // QC
    q_chunks = qh.reshape(B, H, nqc, QC, dh).transpose(2, 0, 1, 3, 4)
    blk_pos = jnp.arange(BLK)
    head_ids = jnp.arange(H)
    scale = dh ** -0.5
    gather = jax.vmap(jax.vmap(lambda t, i: t[i]))

    def one_chunk(args):
        qc, start = args
        cur = start // BLK
        q_pos = start + jnp.arange(QC)
        gate = jnp.einsum('bhqd,bhnd->bhqn', qc.astype(jnp.float32), kmean)
        gate = jnp.where(jnp.arange(nb) < cur, gate, -jnp.inf)
        _, idx = lax.top_k(gate, topk)
        valid = idx < cur
        ksel = gather(kblk, idx)
        vsel = gather(vblk, idx)
        kown = lax.dynamic_index_in_dim(kblk, cur, axis=2, keepdims=False)
        vown = lax.dynamic_index_in_dim(vblk, cur, axis=2, keepdims=False)
        s_sel = jnp.einsum('bhqd,bhqtkd->bhqtk', qc, ksel).astype(jnp.float32) * scale
        rel_sel = q_pos[None, None, :, None, None] - (idx[..., None] * BLK + blk_pos)
        s_sel = s_sel + table[head_ids[None, :, None, None, None], _t5_bucket(rel_sel)].astype(jnp.float32)
        s_sel = jnp.where(valid[..., None], s_sel, -jnp.inf)
        s_own = jnp.einsum('bhqd,bhkd->bhqk', qc, kown).astype(jnp.float32) * scale
        rel_own = q_pos[:, None] - (cur * BLK + blk_pos)[None, :]
        s_own = s_own + table[:, _t5_bucket(rel_own)].astype(jnp.float32)[None]
        s_own = jnp.where(rel_own >= 0, s_own, -jnp.inf)
        logits = jnp.concatenate([s_own, s_sel.reshape(B, H, QC, topk * BLK)], axis=-1)
        p = jax.nn.softmax(logits, axis=-1).astype(vh.dtype)
        p_sel = p[..., BLK:].reshape(B, H, QC, topk, BLK)
        return (jnp.einsum('bhqk,bhkd->bhqd', p[..., :BLK], vown)
                + jnp.einsum('bhqtk,bhqtkd->bhqd', p_sel, vsel))

    o = lax.map(one_chunk, (q_chunks, jnp.arange(nqc, dtype=jnp.int32) * QC))
    return o.transpose(1, 0, 3, 2, 4).reshape(B, S, H * dh)


def _moe(h, w_router, router_bias, w_gate, w_up, w_down, w_sh_gate, w_sh_up, w_sh_down):
    B, S, D = h.shape
    T = B * S
    E, K, M = N_EXPERTS, TOPK_EXPERTS, MOE_ROW_BLOCK
    ht = h.reshape(T, D)
    scores = jax.nn.sigmoid(jnp.matmul(ht, w_router).astype(jnp.float32))
    sel = scores + router_bias.astype(jnp.float32)
    grp = sel.reshape(T, N_GROUPS, E // N_GROUPS)
    grp_score = jnp.sum(lax.top_k(grp, 2)[0], axis=-1)
    _, gidx = lax.top_k(grp_score, TOPK_GROUPS)
    gmask = jnp.sum(jax.nn.one_hot(gidx, N_GROUPS, dtype=jnp.int32), axis=-2) > 0
    sel = jnp.where(jnp.repeat(gmask, E // N_GROUPS, axis=-1), sel, -jnp.inf)
    _, eidx = lax.top_k(sel, K)
    w = jnp.take_along_axis(scores, eidx, axis=-1)
    w = w / jnp.sum(w, axis=-1, keepdims=True) * ROUTED_SCALE
    A = T * K
    flat_e = eidx.reshape(A)
    flat_tok = jnp.repeat(jnp.arange(T, dtype=jnp.int32), K)
    order = jnp.argsort(flat_e)
    e_sorted = flat_e[order]
    tok_sorted = flat_tok[order]
    w_sorted = w.reshape(A)[order]
    counts = jnp.bincount(flat_e, length=E)
    starts = jnp.cumsum(counts) - counts
    padded = ((counts + M - 1) // M) * M
    pad_ends = jnp.cumsum(padded)
    dest = (pad_ends - padded)[e_sorted] + jnp.arange(A) - starts[e_sorted]
    n_blocks = -(-A // M) + E
    P = n_blocks * M
    row_tok = jnp.zeros((P,), jnp.int32).at[dest].set(tok_sorted)
    row_w = jnp.zeros((P,), jnp.float32).at[dest].set(w_sorted)
    block_expert = jnp.minimum(jnp.searchsorted(pad_ends // M, jnp.arange(n_blocks), side='right'), E - 1)
    x_pad = ht[row_tok].reshape(n_blocks, M, D)

    def expert_block(args):
        xb, e = args
        g = jnp.matmul(xb, w_gate[e])
        u = jnp.matmul(xb, w_up[e])
        return jnp.matmul(jax.nn.silu(g) * u, w_down[e])

    y_pad = lax.map(expert_block, (x_pad, block_expert)).reshape(P, D)
    routed = jax.ops.segment_sum(y_pad.astype(jnp.float32) * row_w[:, None], row_tok, num_segments=T)
    shared = jnp.matmul(jax.nn.silu(jnp.matmul(ht, w_sh_gate)) * jnp.matmul(ht, w_sh_up), w_sh_down)
    return (routed.astype(h.dtype) + shared).reshape(B, S, D)


def setup_inputs(seed: int = 0) -> dict:
    key = jax.random.key(seed)
    ks = jax.random.split(key, 24)
    f32 = jnp.float32
    D, L = D_MODEL, DEPTH
    nrm = lambda k, shape, s: jax.random.normal(k, shape, f32) * s
    return {
        'x': nrm(ks[0], (BATCH, SEQ, D), 1.0),
        'c': nrm(ks[1], (BATCH, D), 1.0),
        'w_ada': nrm(ks[2], (L, D, 6 * D), 0.5 * D ** -0.5),
        'b_ada': nrm(ks[3], (L, 6 * D), 0.02),
        'g_mix': 1.0 + nrm(ks[4], (L, D), 0.05),
        'g_ffn': 1.0 + nrm(ks[5], (L, D), 0.05),
        'w_in': nrm(ks[6], (L, D, IN_COLS), D ** -0.5),
        'diff_lambda': nrm(ks[7], (L, 4, DIFF_HEAD_DIM), 0.1),
        'diff_subln_g': 1.0 + nrm(ks[8], (L, 2 * DIFF_HEAD_DIM), 0.05),
        'rel_bias': nrm(ks[9], (REL_BUCKETS, DIFF_HEADS + MOBA_HEADS), 0.5),
        'w_o_diff': nrm(ks[10], (L, DIFF_V_W, D), DIFF_V_W ** -0.5),
        'w_o_moba': nrm(ks[11], (L, MOBA_W, D), MOBA_W ** -0.5),
        'w_out': nrm(ks[12], (L, D, D), D ** -0.5),
        'w_router': nrm(ks[13], (L, D, N_EXPERTS), D ** -0.5),
        'router_bias': nrm(ks[14], (L, N_EXPERTS), 0.01),
        'w_exp_gate': nrm(ks[15], (L, N_EXPERTS, D, EXPERT_DIM), D ** -0.5),
        'w_exp_up': nrm(ks[16], (L, N_EXPERTS, D, EXPERT_DIM), D ** -0.5),
        'w_exp_down': nrm(ks[17], (L, N_EXPERTS, EXPERT_DIM, D), EXPERT_DIM ** -0.5),
        'w_sh_gate': nrm(ks[18], (L, D, SHARED_DIM), D ** -0.5),
        'w_sh_up': nrm(ks[19], (L, D, SHARED_DIM), D ** -0.5),
        'w_sh_down': nrm(ks[20], (L, SHARED_DIM, D), SHARED_DIM ** -0.5),
        'g_final': 1.0 + nrm(ks[21], (D,), 0.05),
    }


def reference(x, c, w_ada, b_ada, g_mix, g_ffn, w_in, diff_lambda, diff_subln_g, rel_bias,
              w_o_diff, w_o_moba, w_out, w_router, router_bias, w_exp_gate, w_exp_up, w_exp_down,
              w_sh_gate, w_sh_up, w_sh_down, g_final):
    B, S, D = x.shape
    table_diff = rel_bias[:, :DIFF_HEADS]
    table_moba = rel_bias[:, DIFF_HEADS:].T
    c_act = jax.nn.silu(c)
    o_qd = 0
    o_kd = o_qd + DIFF_QK_W
    o_vd = o_kd + DIFF_QK_W
    o_qm = o_vd + DIFF_V_W
    o_km = o_qm + MOBA_W
    o_vm = o_km + MOBA_W
    o_gd = o_vm + MOBA_W
    o_gm = o_gd + D
    for l in range(DEPTH):
        mod = jnp.matmul(c_act, w_ada[l]) + b_ada[l]
        shift1, scale1, gate1, shift2, scale2, gate2 = jnp.split(mod[:, None, :], 6, axis=-1)
        h = _rmsnorm(x, g_mix[l]) * (1.0 + scale1) + shift1
        proj = jnp.matmul(h, w_in[l])
        qd = proj[..., o_qd:o_kd].reshape(B, S, DIFF_HEADS, 2, DIFF_HEAD_DIM)
        kd = proj[..., o_kd:o_vd].reshape(B, S, DIFF_HEADS, 2, DIFF_HEAD_DIM)
        vd = proj[..., o_vd:o_qm].reshape(B, S, DIFF_HEADS, 2 * DIFF_HEAD_DIM)
        qm = proj[..., o_qm:o_km].reshape(B, S, MOBA_HEADS, MOBA_HEAD_DIM)
        km = proj[..., o_km:o_vm].reshape(B, S, MOBA_HEADS, MOBA_HEAD_DIM)
        vm = proj[..., o_vm:o_gd].reshape(B, S, MOBA_HEADS, MOBA_HEAD_DIM)
        gd = jax.nn.sigmoid(proj[..., o_gd:o_gm])
        gm = jax.nn.sigmoid(proj[..., o_gm:])
        y_d = jnp.matmul(_diff_attention(qd, kd, vd, diff_lambda[l], diff_subln_g[l], table_diff, l), w_o_diff[l])
        y_m = jnp.matmul(_moba_attention(qm, km, vm, table_moba), w_o_moba[l])
        mixed = jnp.matmul(gd * y_d + gm * y_m, w_out[l])
        x = x + gate1 * mixed
        h2 = _rmsnorm(x, g_ffn[l]) * (1.0 + scale2) + shift2
        x = x + gate2 * _moe(h2, w_router[l], router_bias[l], w_exp_gate[l], w_exp_up[l], w_exp_down[l],
                             w_sh_gate[l], w_sh_up[l], w_sh_down[l])
    return _rmsnorm(x, g_final)
```

```cpp
#include <hip/hip_runtime.h>
#include <cstdio>
#include <cstdint>

#define LAS __attribute__((address_space(3)))
#define GAS __attribute__((address_space(1)))
typedef unsigned short bf16_t;
typedef short bf16x8 __attribute__((ext_vector_type(8)));
typedef short s16x4 __attribute__((ext_vector_type(4)));
typedef int i32x4 __attribute__((ext_vector_type(4)));
typedef int i32x8 __attribute__((ext_vector_type(8)));
typedef float f32x4 __attribute__((ext_vector_type(4)));
typedef float f32x2 __attribute__((ext_vector_type(2)));
typedef float f32x16 __attribute__((ext_vector_type(16)));
typedef unsigned u32x4 __attribute__((ext_vector_type(4)));
typedef unsigned u32x2 __attribute__((ext_vector_type(2)));
typedef __bf16 bf16x2_t __attribute__((ext_vector_type(2)));

#ifndef MK_N_LAUNCHES
#define MK_N_LAUNCHES 1
#endif
#ifndef REP_MASK
#define REP_MASK 0u
#endif
#ifndef PHASE_MASK
#define PHASE_MASK 0xFFFFFFFFu
#endif

constexpr int NB = 2, SEQ = 8192, T = NB * SEQ, D = 2048, NH = 8, INC = 10240, NE = 64, EDIM = 512, TOPK = 8;
constexpr int NPHASE = 13;
constexpr float RMS_EPS = 1e-6f;
constexpr float LOG2E = 1.4426950408889634f;

constexpr size_t MiB = 1u << 20;
constexpr size_t WS_CTL = 0, CTL_ZERO_BYTES = 1 * MiB;
constexpr size_t WS_MODP = 1 * MiB;
constexpr size_t WS_MOD = 4 * MiB;
constexpr size_t WS_KMEAN = 4 * MiB + 256 * 1024;
constexpr size_t WS_WR = 4 * MiB + 512 * 1024;
constexpr size_t WS_TOKE = 5 * MiB;
constexpr size_t WS_TOKW = 5 * MiB + 512 * 1024;
constexpr size_t WS_W_IN_T = 8 * MiB;
constexpr size_t WS_W_OD_T = 48 * MiB;
constexpr size_t WS_W_OM_T = 52 * MiB;
constexpr size_t WS_W_OUT_T = 56 * MiB;
constexpr size_t WS_W_SHGU_T = 64 * MiB;
constexpr size_t WS_W_SHD_T = 68 * MiB;
constexpr size_t WS_ELIST = 70 * MiB;
constexpr size_t WS_W_ED_T = 76 * MiB;
constexpr size_t WS_W_EGU_T = 204 * MiB;
constexpr size_t WS_H = 460 * MiB;
constexpr size_t WS_QD = 524 * MiB;
constexpr size_t WS_KDT = 556 * MiB;
constexpr size_t WS_VDT = 588 * MiB;
constexpr size_t WS_QM = 620 * MiB;
constexpr size_t WS_KMT = 652 * MiB;
constexpr size_t WS_VMT = 684 * MiB;
constexpr size_t WS_GATES = 716 * MiB;
constexpr size_t WS_AD = 844 * MiB;
constexpr size_t WS_AM = 876 * MiB;
constexpr size_t WS_ML = 908 * MiB;
constexpr size_t WS_MLIST = 912 * MiB;
constexpr size_t WS_PARTS = 460 * MiB;
constexpr size_t WS_G = 460 * MiB;
constexpr size_t WS_T1 = 524 * MiB;
constexpr size_t WS_X1 = 524 * MiB;
constexpr size_t WS_H2 = 588 * MiB;
constexpr size_t WS_ACT = 716 * MiB;
constexpr size_t WS_H2F8 = 800 * MiB;
constexpr float F8_SH = 8.0f, F8_SW = 64.0f, F8_SA = 8.0f, F8_SD = 32.0f;
namespace att { constexpr float D8_QS = 0.125f * LOG2E * 16.0f, D8_KS = 4.0f, D8_VS = 8.0f; }
constexpr size_t WS_QM8 = 604 * MiB, WS_VMT8 = 684 * MiB, WS_KMT8 = 700 * MiB;
namespace att { constexpr float MB8_QS = 0.08838834764831845f * LOG2E * 16.0f; }
constexpr bool O78F8 = true;
constexpr float F8_SAD = 16.0f, F8_SAM = 64.0f, F8_SWO = 32.0f, F8_SG = 16.0f, F8_SWOUT = 64.0f;
constexpr bool P2F8 = true;
constexpr float DS2 = 1.0f;
constexpr int P2_EXP = 9;
constexpr size_t WS_SHACT = 860 * MiB;
constexpr size_t WS_SHOUT = 588 * MiB;
constexpr size_t WS_Y = 204 * MiB;
constexpr size_t WS_END = 928 * MiB;
static_assert(WS_Y + (size_t)131072 * 2048 * 2 <= WS_ACT, "Y must not reach ACT");
static_assert(WS_ACT + (size_t)147456 * 512 * 2 <= WS_SHACT && WS_SHACT + (size_t)T * 512 * 2 <= WS_END, "act map");
static_assert(WS_PARTS + (size_t)T * 8 * 4 * 128 * 2 <= WS_VDT, "parts overlay");

constexpr int CW_BAR = 4096;
constexpr int CW_ECNT = 8192;
constexpr int CW_MCNT = 8448;
constexpr int CW_AQ = 9216;
constexpr int CW_CQ = 9216 + 64 * 8;

constexpr int RING_BYTES = 131072;
constexpr int LDSX_OFF = RING_BYTES;
constexpr int MISC_OFF = RING_BYTES + 16384;
constexpr int LDS_BYTES = MISC_OFF + 128;

#define LDS_WAIT() asm volatile("s_waitcnt lgkmcnt(0)" ::: "memory")
#define VM_WAIT() asm volatile("s_waitcnt vmcnt(0)" ::: "memory")
#define RLX_AGENT __ATOMIC_RELAXED, __HIP_MEMORY_SCOPE_AGENT

__device__ __forceinline__ unsigned cvtpk(float lo, float hi) { f32x2 v = {lo, hi}; bf16x2_t b = __builtin_convertvector(v, bf16x2_t); return __builtin_bit_cast(unsigned, b); }
__device__ __forceinline__ float bf_lo(unsigned u) { return __uint_as_float(u << 16); }
__device__ __forceinline__ float bf_hi(unsigned u) { return __uint_as_float(u & 0xffff0000u); }
__device__ __forceinline__ float wave_sum(float v) {
#pragma unroll
    for (int o = 1; o < 64; o <<= 1) v += __shfl_xor(v, o);
    return v;
}
__device__ __forceinline__ float fast_exp2(float x) { return __builtin_amdgcn_exp2f(x); }
__device__ __forceinline__ float fast_rcp(float x) { return __builtin_amdgcn_rcpf(x); }
__device__ __forceinline__ float sigmoidf_(float x) { return fast_rcp(1.0f + fast_exp2(-x * LOG2E)); }
__device__ __forceinline__ float siluf_(float x) { return x * sigmoidf_(x); }

#define XB_TMO      128
#define XB_XCNT(j)  (256  + 64 * (j))
#define XB_XSUB(j)  (1280 + 64 * (j))
#define XB_XGEN(j)  (2304 + 64 * (j))
#define XB_TOP      3328
#define XB_TOPGEN   3392
#define XCD_BAR_WORDS 3456
#define XB_SPIN_CAP (1u << 22)

__device__ __forceinline__ unsigned xb_ld(unsigned* p)              { return __hip_atomic_load(p, __ATOMIC_RELAXED, __HIP_MEMORY_SCOPE_AGENT); }
__device__ __forceinline__ unsigned xb_add(unsigned* p, unsigned v) { return __hip_atomic_fetch_add(p, v, __ATOMIC_RELAXED, __HIP_MEMORY_SCOPE_AGENT); }
__device__ __forceinline__ unsigned xb_xcc_id() { return (unsigned)__builtin_amdgcn_s_getreg((3 << 11) | 20) & 0xFu; }
#define XB_SPIN(cond, bar) do { unsigned _sp = 0; while (cond) { __builtin_amdgcn_s_sleep(1); \
    if ((++_sp & 255u) == 0u) { if (xb_ld(&(bar)[XB_TMO])) break; if (_sp > XB_SPIN_CAP) { atomicAdd(&(bar)[XB_TMO], 1u); break; } } } } while (0)

struct XcdBarrier { unsigned* bar; unsigned x; volatile LAS unsigned* st; };

__device__ __forceinline__ XcdBarrier xcd_barrier_post(unsigned* bar, volatile LAS unsigned* st) {
    XcdBarrier b; b.bar = bar; b.x = xb_xcc_id(); b.st = st;
    if (threadIdx.x == 0) (void)xb_add(&bar[XB_XCNT(b.x)], 1u);
    return b;
}
__device__ __forceinline__ void xcd_barrier_complete(unsigned* bar, unsigned x, unsigned& nloc, unsigned& nx) {
    const unsigned G = gridDim.x * gridDim.y * gridDim.z;
    unsigned sum, cnt, mine, sp = 0u;
    for (;;) {
        sum = 0u; cnt = 0u; mine = 0u;
#pragma unroll
        for (unsigned j = 0; j < 16; ++j) { const unsigned c = xb_ld(&bar[XB_XCNT(j)]); sum += c; cnt += (c > 0u) ? 1u : 0u; mine = (j == x) ? c : mine; }
        if (sum == G) break;
        __builtin_amdgcn_s_sleep(1);
        if ((++sp & 255u) == 0u) { if (xb_ld(&bar[XB_TMO])) break; if (sp > XB_SPIN_CAP) { atomicAdd(&bar[XB_TMO], 1u); break; } }
    }
    nloc = mine > 0u ? mine : 1u; nx = cnt > 0u ? cnt : 1u;
}
__device__ __forceinline__ void xcd_barrier(const XcdBarrier& b) {
    asm volatile("s_waitcnt vmcnt(0)" ::: "memory");
    __syncthreads();
    if (threadIdx.x == 0) {
        unsigned* bar = b.bar;
        __builtin_amdgcn_s_waitcnt(0);
        unsigned nloc = b.st[0], nx = b.st[1];
        if (nloc == 0u) { xcd_barrier_complete(bar, b.x, nloc, nx); b.st[0] = nloc; b.st[1] = nx; }
        const unsigned old = xb_add(&bar[XB_XSUB(b.x)], 1u);
        const unsigned gen = old / nloc;
        if (old + 1u == (gen + 1u) * nloc) {
            __builtin_amdgcn_fence(__ATOMIC_RELEASE, "agent");
            asm volatile("s_waitcnt vmcnt(0)" ::: "memory");
            const unsigned og = xb_add(&bar[XB_TOP], 1u);
            const unsigned tg = og / nx;
            if (og + 1u == (tg + 1u) * nx) xb_add(&bar[XB_TOPGEN], 1u);
            else XB_SPIN(xb_ld(&bar[XB_TOPGEN]) == tg, bar);
            __builtin_amdgcn_fence(__ATOMIC_ACQUIRE, "agent");
            xb_add(&bar[XB_XGEN(b.x)], 1u);
            asm volatile("s_waitcnt vmcnt(0)" ::: "memory");
        } else {
            XB_SPIN(xb_ld(&bar[XB_XGEN(b.x)]) == gen, bar);
            __builtin_amdgcn_fence(__ATOMIC_ACQUIRE, "agent");
            asm volatile("s_waitcnt vmcnt(0)" ::: "memory");
        }
    }
    __syncthreads();
}

namespace pg8 {
constexpr int BM = 256, BK = 64, HALF = 128, HTB = HALF * BK * 2, STAGE_BYTES = 8 * HTB, NXCD = 8, WGM = 8;
static_assert(STAGE_BYTES == RING_BYTES, "ring");
__host__ __device__ __forceinline__ int lds_byte(int r, int c) { const int st = (r >> 4) * 2 + (c >> 5), rr = r & 15, cc = c & 31, ob = rr * 64 + cc * 2; return st * 1024 + (ob ^ (((ob >> 9) & 1) << 5)); }
__host__ __device__ __forceinline__ void stage_rc(int b, int& R, int& C) { const int st = b / 1024, sb = b % 1024, swz = sb ^ (((sb >> 9) & 1) << 5); R = (st >> 1) * 16 + swz / 64; C = (st & 1) * 32 + (swz % 64) / 2; }
__host__ __device__ __forceinline__ int perm32(int rho) { const int n = rho >> 4, i = rho & 15; return 8 * (i >> 2) + 4 * n + (i & 3); }

struct Unit { int pm, pn; const char* A; const char* B; int rowbase, valid, aux; };

struct StaticOrder {
    int nM, nN, nwg, G, c; const char* A; const char* B; size_t tstep;
    __device__ void init(const void* A_, const void* B_, int M, int N, int K, int G_, int c_) { A = (const char*)A_; B = (const char*)B_; nM = M / BM; nN = N / BM; nwg = nM * nN; G = G_; c = c_; tstep = (size_t)BM * K * 2; }
    __device__ bool next(int i, Unit& u) const {
        const long L = (long)i * G + c; if (L >= nwg) return false;
        int wgid = (int)L; { const int q = nwg / NXCD, r = nwg % NXCD, xcd = wgid % NXCD, off = wgid / NXCD; wgid = (xcd < r ? xcd * (q + 1) : r * (q + 1) + (xcd - r) * q) + off; }
        const int nig = WGM * nN, gid = wgid / nig, fm = gid * WGM, gsz = (nM - fm) < WGM ? (nM - fm) : WGM;
        u.pm = fm + ((wgid % nig) % gsz); u.pn = (wgid % nig) / gsz;
        u.A = A + (size_t)u.pm * tstep; u.B = B + (size_t)u.pn * tstep; u.rowbase = u.pm * BM; u.valid = BM; u.aux = 0; return true;
    }
};

struct PairOrder {
    StaticOrder base; const char* A1; const char* B1;
    __device__ void init(const void* A0_, const void* B0_, const void* A1_, const void* B1_, int M, int N, int K, int G_, int c_) { base.init(A0_, B0_, M, N, K, G_, c_); A1 = (const char*)A1_; B1 = (const char*)B1_; }
    __device__ bool next(int i, Unit& u) const {
        if (!base.next(i >> 1, u)) return false;
        if (i & 1) { u.A = A1 + (size_t)u.pm * base.tstep; u.B = B1 + (size_t)u.pn * base.tstep; u.aux = 1; }
        return true;
    }
};

template <class Epi, class Sched, bool ALIGN_EPI, bool SP2, bool GATHER, bool F8 = false>
__device__ __forceinline__ void gemm_phase(LAS unsigned char* lds, const int K, const Sched& S, const Epi& E, const LAS unsigned short* gtab) {
    int tid_ = threadIdx.x; asm volatile("" : "+v"(tid_));
    const int tid = tid_, wid = __builtin_amdgcn_readfirstlane(tid >> 6), lane = tid & 63, wr = wid >> 2, wc = wid & 3, fr = lane & 15, fq = lane >> 4;
    const int nt = K / BK;
    unsigned voffA[2], voffB[2]; int RA[2], CA[2];
#pragma unroll
    for (int i = 0; i < 2; ++i) { int R, C; stage_rc(tid * 16 + i * 8192, R, C); const int Rb = (int)Epi::PERM == 2 ? (64 * (R >> 5) + 16 * ((R >> 2) & 3) + 4 * ((R >> 4) & 1) + (R & 3)) : (Epi::PERM ? ((R & ~31) + perm32(R & 31)) : R);
        RA[i] = R; CA[i] = C; voffA[i] = (unsigned)(R * K + C) * 2u; voffB[i] = (unsigned)(Rb * K + C) * 2u; }
    const size_t kstep = (size_t)(BK * 2);
    const size_t hstep = (size_t)HALF * K * 2;
    const size_t hstepB = (int)Epi::PERM == 2 ? (size_t)8 * K * 2 : hstep;
    const unsigned ldsw = (unsigned)wid * 1024u;
    const int aoff = lds_byte(wr * 64 + fr, fq * 8), boff = lds_byte(wc * 32 + fr, fq * 8);
    unsigned vA[2][2], nvA[2][2];
#define PG8_SA(b, h) (((b) * 2 + (h)) * HTB)
#define PG8_SB(b, h) ((4 + (b) * 2 + (h)) * HTB)
#define PG8_GL(gp, ldsoff) __builtin_amdgcn_global_load_lds((const unsigned*)(gp), (LAS unsigned*)(lds + (ldsoff)), 16, 0, 0)
#define PG8_STAGE(bufoff, gbase, voff) do { _Pragma("unroll") for (int _i = 0; _i < 2; ++_i) PG8_GL((const char*)(gbase) + (voff)[_i], (bufoff) + ldsw + _i * 8192); } while (0)
#define PG8_STA(bufoff, gbase, h, nx) do { if constexpr (GATHER) { \
        const unsigned _o0 = (nx) ? nvA[h][0] : vA[h][0], _o1 = (nx) ? nvA[h][1] : vA[h][1]; \
        PG8_GL((const char*)(gbase) + _o0, (bufoff) + ldsw); PG8_GL((const char*)(gbase) + _o1, (bufoff) + ldsw + 8192); \
    } else { PG8_STAGE(bufoff, (const char*)(gbase) + (h) * hstep, voffA); } } while (0)
#define PG8_GVA(dst, ul) do { _Pragma("unroll") for (int _h = 0; _h < 2; ++_h) _Pragma("unroll") for (int _i = 0; _i < 2; ++_i) \
        dst[_h][_i] = (unsigned)gtab[(ul) * 256 + _h * 128 + RA[_i]] * (unsigned)(K * 2) + (unsigned)(CA[_i] * 2); } while (0)
#define PG8_LDA(dst, b, h) do { _Pragma("unroll") for (int m = 0; m < 4; ++m) _Pragma("unroll") for (int k = 0; k < 2; ++k) dst[m][k] = *(const LAS bf16x8*)(lds + PG8_SA(b, h) + aoff + m * 2048 + k * 1024); } while (0)
#define PG8_LDB(dst, b, h) do { _Pragma("unroll") for (int n = 0; n < 2; ++n) _Pragma("unroll") for (int k = 0; k < 2; ++k) dst[n][k] = *(const LAS bf16x8*)(lds + PG8_SB(b, h) + boff + n * 2048 + k * 1024); } while (0)
#define PG8_MMA(ai, bj, At, Bt) do { __builtin_amdgcn_s_setprio(1); _Pragma("unroll") for (int m = 0; m < 4; ++m) _Pragma("unroll") for (int n = 0; n < 2; ++n) { \
        if constexpr (F8) { const i32x4 _b0 = __builtin_bit_cast(i32x4, Bt[n][0]), _b1 = __builtin_bit_cast(i32x4, Bt[n][1]), _a0 = __builtin_bit_cast(i32x4, At[m][0]), _a1 = __builtin_bit_cast(i32x4, At[m][1]); \
            const i32x8 _b8 = __builtin_shufflevector(_b0, _b1, 0, 1, 2, 3, 4, 5, 6, 7), _a8 = __builtin_shufflevector(_a0, _a1, 0, 1, 2, 3, 4, 5, 6, 7); \
            asm volatile("v_mfma_scale_f32_16x16x128_f8f6f4 %0, %1, %2, %0, %3, %4 op_sel_hi:[0,0,0]" : "+v"(acc[ai][bj][m][n]) : "v"(_b8), "v"(_a8), "v"(f8sc), "v"(f8one)); } \
        else { _Pragma("unroll") for (int k = 0; k < 2; ++k) acc[ai][bj][m][n] = __builtin_amdgcn_mfma_f32_16x16x32_bf16(Bt[n][k], At[m][k], acc[ai][bj][m][n], 0, 0, 0); } } __builtin_amdgcn_s_setprio(0); } while (0)
#define PG8_WAIT_V(n) asm volatile("s_waitcnt vmcnt(" #n ")" ::: "memory")
#define PG8_WAIT_L(n) asm volatile("s_waitcnt lgkmcnt(" #n ")" ::: "memory")
#define PG8_BAR __builtin_amdgcn_s_barrier()
#define PG8_SCHED __builtin_amdgcn_sched_barrier(0)
    Unit cur, nxt; int ui = 0;
    if (!S.next(0, cur)) return;
    if constexpr (GATHER) { PG8_GVA(vA, 0); }
    int f8sc = 0x7F7F7F7F;
    const int f8one = 0x7F7F7F7F;
    f32x4 acc[2][2][4][2];
#pragma unroll
    for (int a = 0; a < 2; ++a)
#pragma unroll
        for (int b = 0; b < 2; ++b)
#pragma unroll
            for (int m = 0; m < 4; ++m)
#pragma unroll
                for (int n = 0; n < 2; ++n) acc[a][b][m][n] = (f32x4){0.f, 0.f, 0.f, 0.f};
    bf16x8 At[4][2], B0[2][2], B1[2][2];
    const char* cA = cur.A; const char* cB = cur.B;
    if constexpr (SP2) {
        PG8_STAGE(PG8_SB(0, 0), cB, voffB); PG8_STAGE(PG8_SB(0, 1), cB + hstepB, voffB); PG8_STA(PG8_SA(0, 0), cA, 0, false); PG8_STA(PG8_SA(0, 1), cA, 1, false);
        if (wr == 1) PG8_BAR;
        PG8_WAIT_V(2); PG8_BAR;
        PG8_STAGE(PG8_SB(1, 0), cB + kstep, voffB); PG8_STA(PG8_SA(1, 0), cA + kstep, 0, false); PG8_STAGE(PG8_SB(1, 1), cB + hstepB + kstep, voffB);
        PG8_WAIT_V(6); PG8_BAR;
    } else {
        PG8_STAGE(PG8_SB(0, 0), cB, voffB); PG8_STA(PG8_SA(0, 0), cA, 0, false); PG8_STAGE(PG8_SB(0, 1), cB + hstepB, voffB); PG8_STA(PG8_SA(0, 1), cA, 1, false);
        if (wr == 1) PG8_BAR;
        PG8_WAIT_V(4); PG8_BAR;
        PG8_STAGE(PG8_SB(1, 0), cB + kstep, voffB); PG8_STA(PG8_SA(1, 0), cA + kstep, 0, false); PG8_STAGE(PG8_SB(1, 1), cB + hstepB + kstep, voffB);
        PG8_WAIT_V(6); PG8_BAR;
    }
    for (;;) {
        if constexpr (F8) f8sc = 0x01010101 * (127 - E.f8exp(cur));
        bool has_next = false; const char* nA = cA; const char* nB = cB;
#define PG8_NEXT_UNIT() do { has_next = S.next(ui + 1, nxt); nA = has_next ? nxt.A : cA; nB = has_next ? nxt.B : cB; \
        if constexpr (GATHER) { if (has_next) { PG8_GVA(nvA, ui + 1); } else { _Pragma("unroll") for (int _h = 0; _h < 2; ++_h) _Pragma("unroll") for (int _i = 0; _i < 2; ++_i) nvA[_h][_i] = vA[_h][_i]; } } } while (0)
        if (nt < 4 || !SP2) PG8_NEXT_UNIT();
        for (int t = 0; t < nt; t += 2) {
            const bool last = (t == nt - 2);
            const char* a1 = cA + (size_t)(t + 1) * kstep;
            const char* a2 = last ? nA : cA + (size_t)(t + 2) * kstep; const char* b2 = last ? nB : cB + (size_t)(t + 2) * kstep;
            const char* a3 = a2 + kstep; const char* b3 = b2 + kstep;
            if constexpr (SP2) {
            PG8_LDB(B0, 0, 0); PG8_LDB(B1, 0, 1); PG8_SCHED; PG8_LDA(At, 0, 0); PG8_STA(PG8_SA(1, 1), a1, 1, false);
            PG8_WAIT_V(8); PG8_WAIT_L(0); PG8_BAR; PG8_MMA(0, 0, At, B0); PG8_MMA(0, 1, At, B1); if (t == 0 && nt >= 4) { PG8_SCHED; PG8_NEXT_UNIT(); PG8_SCHED; } PG8_BAR; PG8_SCHED;
            PG8_LDA(At, 0, 1); PG8_STAGE(PG8_SB(0, 0), b2, voffB); PG8_STAGE(PG8_SB(0, 1), b2 + hstepB, voffB); PG8_STA(PG8_SA(0, 0), a2, 0, last);
            PG8_WAIT_V(8); PG8_WAIT_L(0); PG8_BAR; PG8_MMA(1, 0, At, B0); PG8_MMA(1, 1, At, B1); PG8_BAR; PG8_SCHED;
            PG8_LDB(B0, 1, 0); PG8_LDB(B1, 1, 1); PG8_SCHED; PG8_LDA(At, 1, 0); PG8_STA(PG8_SA(0, 1), a2, 1, last);
            PG8_WAIT_V(8); PG8_WAIT_L(0); PG8_BAR; PG8_MMA(0, 0, At, B0); PG8_MMA(0, 1, At, B1); PG8_BAR; PG8_SCHED;
            PG8_LDA(At, 1, 1); PG8_STAGE(PG8_SB(1, 0), b3, voffB); PG8_STAGE(PG8_SB(1, 1), b3 + hstepB, voffB); PG8_STA(PG8_SA(1, 0), a3, 0, last);
            PG8_WAIT_V(8); PG8_WAIT_L(0); PG8_BAR; PG8_MMA(1, 0, At, B0); PG8_MMA(1, 1, At, B1); PG8_BAR; PG8_SCHED;
            } else {
            PG8_LDB(B0, 0, 0); PG8_SCHED; PG8_LDA(At, 0, 0); PG8_STA(PG8_SA(1, 1), a1, 1, false);
            PG8_WAIT_L(8); PG8_BAR; PG8_WAIT_L(0); PG8_MMA(0, 0, At, B0); PG8_BAR; PG8_SCHED;
            PG8_LDB(B1, 0, 1); PG8_STAGE(PG8_SB(0, 0), b2, voffB);
            PG8_BAR; PG8_WAIT_L(0); PG8_MMA(0, 1, At, B1); PG8_BAR;
            PG8_LDA(At, 0, 1); PG8_STA(PG8_SA(0, 0), a2, 0, last);
            PG8_BAR; PG8_WAIT_L(0); PG8_MMA(1, 0, At, B0); PG8_BAR; PG8_SCHED;
            PG8_STAGE(PG8_SB(0, 1), b2 + hstepB, voffB);
            PG8_WAIT_V(6); PG8_BAR; PG8_MMA(1, 1, At, B1); PG8_BAR;
            PG8_LDB(B0, 1, 0); PG8_SCHED; PG8_LDA(At, 1, 0); PG8_STA(PG8_SA(0, 1), a2, 1, last);
            PG8_WAIT_L(8); PG8_BAR; PG8_WAIT_L(0); PG8_MMA(0, 0, At, B0); PG8_BAR; PG8_SCHED;
            PG8_LDB(B1, 1, 1); PG8_STAGE(PG8_SB(1, 0), b3, voffB);
            PG8_BAR; PG8_WAIT_L(0); PG8_MMA(0, 1, At, B1); PG8_BAR;
            PG8_LDA(At, 1, 1); PG8_STA(PG8_SA(1, 0), a3, 0, last);
            PG8_BAR; PG8_WAIT_L(0); PG8_MMA(1, 0, At, B0); PG8_BAR; PG8_SCHED;
            PG8_STAGE(PG8_SB(1, 1), b3 + hstepB, voffB);
            PG8_WAIT_V(6); PG8_BAR; PG8_MMA(1, 1, At, B1); PG8_BAR;
            }
        }
        if constexpr (F8) asm volatile("s_nop 15\n\ts_nop 15" ::: "memory");
        if constexpr (ALIGN_EPI) { if (wr == 0) PG8_BAR; }
        { int l2 = lane; asm volatile("" : "+v"(l2)); E(acc, cur, wr, wc, l2 & 15, l2 >> 4); }
        if (!has_next) break;
#pragma unroll
        for (int a = 0; a < 2; ++a)
#pragma unroll
            for (int b = 0; b < 2; ++b)
#pragma unroll
                for (int m = 0; m < 4; ++m)
#pragma unroll
                    for (int n = 0; n < 2; ++n) acc[a][b][m][n] = (f32x4){0.f, 0.f, 0.f, 0.f};
        cur = nxt; cA = nA; cB = nB; ++ui;
        if constexpr (GATHER) {
#pragma unroll
            for (int _h = 0; _h < 2; ++_h)
#pragma unroll
                for (int _i = 0; _i < 2; ++_i) vA[_h][_i] = nvA[_h][_i];
        }
        if constexpr (ALIGN_EPI) { if (wr == 1) PG8_BAR; }
    }
    PG8_WAIT_V(0);
    if constexpr (!ALIGN_EPI) { if (wr == 0) PG8_BAR; }
    PG8_BAR;
#undef PG8_SA
#undef PG8_SB
#undef PG8_GL
#undef PG8_STAGE
#undef PG8_STA
#undef PG8_GVA
#undef PG8_LDA
#undef PG8_LDB
#undef PG8_MMA
#undef PG8_WAIT_V
#undef PG8_WAIT_L
#undef PG8_BAR
#undef PG8_SCHED
}
}
namespace epi {
__device__ __forceinline__ float clamp_f8(float v) { return __builtin_fminf(__builtin_fmaxf(v, -448.0f), 448.0f); }
__device__ __forceinline__ unsigned pack4_f8(float a, float b, float c, float d) { int w = __builtin_amdgcn_cvt_pk_fp8_f32(clamp_f8(a), clamp_f8(b), 0, false); return (unsigned)__builtin_amdgcn_cvt_pk_fp8_f32(clamp_f8(c), clamp_f8(d), w, true); }
using pg8::Unit;
template <int ACT> struct StoreBf16 {
    static constexpr bool PERM = true;
    bf16_t* O; int ldc;
    __device__ __forceinline__ int f8exp(const Unit&) const { return 8; }
    __device__ __forceinline__ void operator()(const f32x4 (&acc)[2][2][4][2], const Unit& u, int wr, int wc, int fr, int fq) const {
        const int row0 = u.pm * 256 + wr * 64 + fr, col0 = u.pn * 256 + wc * 32 + 8 * fq;
#pragma unroll
        for (int ai = 0; ai < 2; ++ai)
#pragma unroll
            for (int m = 0; m < 4; ++m) { bf16_t* rowp = O + (size_t)(row0 + ai * 128 + m * 16) * ldc + col0;
#pragma unroll
                for (int bj = 0; bj < 2; ++bj) { f32x4 v0 = acc[ai][bj][m][0], v1 = acc[ai][bj][m][1];
                    if (ACT == 1) {
#pragma unroll
                        for (int j = 0; j < 4; ++j) { v0[j] = sigmoidf_(v0[j] * DS2); v1[j] = sigmoidf_(v1[j] * DS2); } }
                    u32x4 w; w.x = cvtpk(v0[0], v0[1]); w.y = cvtpk(v0[2], v0[3]); w.z = cvtpk(v1[0], v1[1]); w.w = cvtpk(v1[2], v1[3]);
                    *(u32x4*)(rowp + bj * 128) = w; } }
    }
};
template <int MODE> struct GateMul {
    static constexpr bool PERM = true;
    const bf16_t* gate; int goff; const bf16_t* prev; bf16_t* O;
    __device__ __forceinline__ void operator()(const f32x4 (&acc)[2][2][4][2], const Unit& u, int wr, int wc, int fr, int fq) const {
        const int row0 = u.pm * 256 + wr * 64 + fr, col0 = u.pn * 256 + wc * 32 + 8 * fq;
#pragma unroll
        for (int ai = 0; ai < 2; ++ai)
#pragma unroll
            for (int m = 0; m < 4; ++m) { const size_t row = (size_t)(row0 + ai * 128 + m * 16);
#pragma unroll
                for (int bj = 0; bj < 2; ++bj) { const int col = col0 + bj * 128;
                    const u32x4 g = *(const u32x4*)(gate + row * 4096 + goff + col);
                    f32x4 v0 = acc[ai][bj][m][0], v1 = acc[ai][bj][m][1];
                    v0[0] *= bf_lo(g.x); v0[1] *= bf_hi(g.x); v0[2] *= bf_lo(g.y); v0[3] *= bf_hi(g.y);
                    v1[0] *= bf_lo(g.z); v1[1] *= bf_hi(g.z); v1[2] *= bf_lo(g.w); v1[3] *= bf_hi(g.w);
                    if (MODE == 1) { const u32x4 p = *(const u32x4*)(prev + row * 2048 + col);
                        v0[0] += bf_lo(p.x); v0[1] += bf_hi(p.x); v0[2] += bf_lo(p.y); v0[3] += bf_hi(p.y);
                        v1[0] += bf_lo(p.z); v1[1] += bf_hi(p.z); v1[2] += bf_lo(p.w); v1[3] += bf_hi(p.w); }
                    if (O78F8 && MODE == 1) { *(u32x2*)((unsigned char*)O + row * 2048 + col) = (u32x2){pack4_f8(v0[0] * F8_SG, v0[1] * F8_SG, v0[2] * F8_SG, v0[3] * F8_SG), pack4_f8(v1[0] * F8_SG, v1[1] * F8_SG, v1[2] * F8_SG, v1[3] * F8_SG)}; }
                    else { u32x4 w; w.x = cvtpk(v0[0], v0[1]); w.y = cvtpk(v0[2], v0[3]); w.z = cvtpk(v1[0], v1[1]); w.w = cvtpk(v1[2], v1[3]);
                    *(u32x4*)(O + row * 2048 + col) = w; } } }
    }
};
struct Resid {
    static constexpr bool PERM = false;
    const float* base; float* out; const float* gate; int goff;
    __device__ __forceinline__ void operator()(const f32x4 (&acc)[2][2][4][2], const Unit& u, int wr, int wc, int fr, int fq) const {
        const int row0 = u.pm * 256 + wr * 64 + fr, col0 = u.pn * 256 + wc * 32 + 4 * fq;
        const int b = (u.pm * 256) / SEQ;
        f32x4 gv[2][2];
#pragma unroll
        for (int bj = 0; bj < 2; ++bj)
#pragma unroll
            for (int n = 0; n < 2; ++n) gv[bj][n] = *(const f32x4*)(gate + (size_t)b * 12288 + goff + col0 + bj * 128 + n * 16);
#pragma unroll
        for (int ai = 0; ai < 2; ++ai)
#pragma unroll
            for (int m = 0; m < 4; ++m) { const size_t off = (size_t)(row0 + ai * 128 + m * 16) * 2048 + col0;
#pragma unroll
                for (int bj = 0; bj < 2; ++bj)
#pragma unroll
                    for (int n = 0; n < 2; ++n) { const f32x4 bs = *(const f32x4*)(base + off + bj * 128 + n * 16);
                        *(f32x4*)(out + off + bj * 128 + n * 16) = bs + gv[bj][n] * acc[ai][bj][m][n]; } }
    }
};
struct SwiGLU {
    static constexpr bool PERM = true;
    bf16_t* O;
    __device__ __forceinline__ void operator()(const f32x4 (&acc)[2][2][4][2], const Unit& u, int wr, int wc, int fr, int fq) const {
        const int r0 = wr * 64 + fr, col0 = u.pn * 128 + wc * 32 + 8 * fq;
#pragma unroll
        for (int ai = 0; ai < 2; ++ai)
#pragma unroll
            for (int m = 0; m < 4; ++m) { const int r = r0 + ai * 128 + m * 16;
                f32x4 v0, v1;
#pragma unroll
                for (int j = 0; j < 4; ++j) { v0[j] = siluf_(acc[ai][0][m][0][j]) * acc[ai][1][m][0][j]; v1[j] = siluf_(acc[ai][0][m][1][j]) * acc[ai][1][m][1][j]; }
                u32x4 w; w.x = cvtpk(v0[0], v0[1]); w.y = cvtpk(v0[2], v0[3]); w.z = cvtpk(v1[0], v1[1]); w.w = cvtpk(v1[2], v1[3]);
                if (r < u.valid) *(u32x4*)(O + (size_t)(u.rowbase + r) * 512 + col0) = w; }
    }
};
struct SwiGLU8 {
    static constexpr bool PERM = true;
    unsigned char* O;
    __device__ __forceinline__ int f8exp(const Unit&) const { return 9; }
    __device__ __forceinline__ void operator()(const f32x4 (&acc)[2][2][4][2], const Unit& u, int wr, int wc, int fr, int fq) const {
        const int r0 = wr * 64 + fr, col0 = u.pn * 128 + wc * 32 + 8 * fq;
        constexpr float ds = 1.0f, us = F8_SA;
#pragma unroll
        for (int ai = 0; ai < 2; ++ai)
#pragma unroll
            for (int m = 0; m < 4; ++m) { const int r = r0 + ai * 128 + m * 16;
                f32x4 v0, v1;
#pragma unroll
                for (int j = 0; j < 4; ++j) { v0[j] = siluf_(acc[ai][0][m][0][j] * ds) * (acc[ai][1][m][0][j] * us); v1[j] = siluf_(acc[ai][0][m][1][j] * ds) * (acc[ai][1][m][1][j] * us); }
                if (r < u.valid) *(u32x2*)(O + (size_t)(u.rowbase + r) * 512 + col0) = (u32x2){pack4_f8(v0[0], v0[1], v0[2], v0[3]), pack4_f8(v1[0], v1[1], v1[2], v1[3])}; }
    }
};
struct DownY {
    static constexpr int PERM = 2;
    unsigned char* O;
    __device__ __forceinline__ int f8exp(const Unit&) const { return 8; }
    __device__ __forceinline__ void operator()(const f32x4 (&acc)[2][2][4][2], const Unit& u, int wr, int wc, int fr, int fq) const {
        const int r0 = wr * 64 + fr, col0 = u.pn * 256 + wc * 64 + 16 * fq;
#pragma unroll
        for (int ai = 0; ai < 2; ++ai)
#pragma unroll
            for (int m = 0; m < 4; ++m) { const int r = r0 + ai * 128 + m * 16;
                if (r < u.valid) {
                    const f32x4 v0 = acc[ai][0][m][0], v1 = acc[ai][0][m][1], v2 = acc[ai][1][m][0], v3 = acc[ai][1][m][1];
                    int w0 = __builtin_amdgcn_cvt_pk_fp8_f32(v0[0], v0[1], 0, false); w0 = __builtin_amdgcn_cvt_pk_fp8_f32(v0[2], v0[3], w0, true);
                    int w1 = __builtin_amdgcn_cvt_pk_fp8_f32(v1[0], v1[1], 0, false); w1 = __builtin_amdgcn_cvt_pk_fp8_f32(v1[2], v1[3], w1, true);
                    int w2 = __builtin_amdgcn_cvt_pk_fp8_f32(v2[0], v2[1], 0, false); w2 = __builtin_amdgcn_cvt_pk_fp8_f32(v2[2], v2[3], w2, true);
                    int w3 = __builtin_amdgcn_cvt_pk_fp8_f32(v3[0], v3[1], 0, false); w3 = __builtin_amdgcn_cvt_pk_fp8_f32(v3[2], v3[3], w3, true);
                    *(u32x4*)(O + (size_t)(u.rowbase + r) * 2048 + col0) = (u32x4){(unsigned)w0, (unsigned)w1, (unsigned)w2, (unsigned)w3}; } }
    }
};
struct StoreQK {
    static constexpr bool PERM = true;
    bf16_t* Q; bf16_t* KT; float qscale;
    __device__ __forceinline__ void operator()(const f32x4 (&acc)[2][2][4][2], const Unit& u, int wr, int wc, int fr, int fq) const {
        const int row0 = u.pm * 256 + wr * 64 + fr, col0 = u.pn * 256 + wc * 32 + 8 * fq;
        const bool isk = (u.pn >= 4);
#pragma unroll
        for (int ai = 0; ai < 2; ++ai)
#pragma unroll
            for (int m = 0; m < 4; ++m) { const int row = row0 + ai * 128 + m * 16;
#pragma unroll
                for (int bj = 0; bj < 2; ++bj) { const float sc = (isk ? 1.0f : qscale) * DS2; const f32x4 v0 = acc[ai][bj][m][0] * sc, v1 = acc[ai][bj][m][1] * sc; const int col = col0 + bj * 128;
                    u32x4 w; w.x = cvtpk(v0[0], v0[1]); w.y = cvtpk(v0[2], v0[3]); w.z = cvtpk(v1[0], v1[1]); w.w = cvtpk(v1[2], v1[3]);
                    bf16_t* p = isk ? KT + ((((size_t)((col - 1024) >> 7) * 256 + (row >> 6)) * 64 + (row & 63)) * 128 + (col & 127)) : Q + (size_t)row * 1024 + col;
                    *(u32x4*)p = w; } }
    }
};
struct StoreQK8 {
    static constexpr bool PERM = true;
    unsigned char* Q; unsigned char* KT; float qs, ks;
    __device__ __forceinline__ void operator()(const f32x4 (&acc)[2][2][4][2], const Unit& u, int wr, int wc, int fr, int fq) const {
        const int row0 = u.pm * 256 + wr * 64 + fr, col0 = u.pn * 256 + wc * 32 + 8 * fq;
        const bool isk = (u.pn >= 4);
#pragma unroll
        for (int ai = 0; ai < 2; ++ai)
#pragma unroll
            for (int m = 0; m < 4; ++m) { const int row = row0 + ai * 128 + m * 16;
#pragma unroll
                for (int bj = 0; bj < 2; ++bj) { const float sc = isk ? 1.0f : qs;        const f32x4 v0 = acc[ai][bj][m][0] * sc, v1 = acc[ai][bj][m][1] * sc; const int col = col0 + bj * 128;
                    unsigned char* p = isk ? KT + ((((size_t)((col - 1024) >> 7) * 256 + (row >> 6)) * 64 + (row & 63)) * 128 + (col & 127)) : Q + (size_t)row * 1024 + col;
                    *(u32x2*)p = (u32x2){pack4_f8(v0[0], v0[1], v0[2], v0[3]), pack4_f8(v1[0], v1[1], v1[2], v1[3])}; }
                __builtin_amdgcn_sched_barrier(0); }
    }
};
struct StoreQKboth {
    static constexpr bool PERM = true;
    StoreQK b16; unsigned char* Q8; unsigned char* KT8;
    __device__ __forceinline__ void operator()(const f32x4 (&acc)[2][2][4][2], const Unit& u, int wr, int wc, int fr, int fq) const {
        b16(acc, u, wr, wc, fr, fq);
        const int row0 = u.pm * 256 + wr * 64 + fr, col0 = u.pn * 256 + wc * 32 + 8 * fq;
        const bool isk = (u.pn >= 4);
        const float sc = isk ? att::D8_KS : att::MB8_QS;
#pragma unroll
        for (int ai = 0; ai < 2; ++ai)
#pragma unroll
            for (int m = 0; m < 4; ++m) { const int row = row0 + ai * 128 + m * 16;
#pragma unroll
                for (int bj = 0; bj < 2; ++bj) { const f32x4 v0 = acc[ai][bj][m][0] * sc, v1 = acc[ai][bj][m][1] * sc; const int col = col0 + bj * 128;
                    unsigned char* p = isk ? KT8 + ((((size_t)((col - 1024) >> 7) * 256 + (row >> 6)) * 64 + (row & 63)) * 128 + (col & 127)) : Q8 + (size_t)row * 1024 + col;
                    *(u32x2*)p = (u32x2){pack4_f8(v0[0], v0[1], v0[2], v0[3]), pack4_f8(v1[0], v1[1], v1[2], v1[3])}; }
                __builtin_amdgcn_sched_barrier(0); }
    }
};
struct StoreVT8 {
    static constexpr bool PERM = true;
    unsigned char* VT; float vs;
    __device__ __forceinline__ void operator()(const f32x4 (&acc)[2][2][4][2], const Unit& u, int wr, int wc, int fr, int fq) const {
        const int row0 = u.pm * 256 + wr * 64 + fr, col0 = u.pn * 256 + wc * 32 + 8 * fq;
#pragma unroll
        for (int ai = 0; ai < 2; ++ai)
#pragma unroll
            for (int m = 0; m < 4; ++m) { const int f = row0 + ai * 128 + m * 16;
#pragma unroll
                for (int bj = 0; bj < 2; ++bj) { const f32x4 v0 = acc[ai][bj][m][0], v1 = acc[ai][bj][m][1]; const int tok = col0 + bj * 128, k = tok & 63;
                    unsigned char* p = VT + ((((size_t)(f >> 7) * 256 + (tok >> 6)) * 128 + (f & 127)) * 64 + (k >> 5) * 16 + ((k & 31) >> 3) * 4);
                    *(unsigned*)p = pack4_f8(v0[0], v0[1], v0[2], v0[3]); *(unsigned*)(p + 32) = pack4_f8(v1[0], v1[1], v1[2], v1[3]); }
                __builtin_amdgcn_sched_barrier(0); }
    }
};
struct StoreVT {
    static constexpr bool PERM = true;
    bf16_t* VT;
    __device__ __forceinline__ void operator()(const f32x4 (&acc)[2][2][4][2], const Unit& u, int wr, int wc, int fr, int fq) const {
        const int row0 = u.pm * 256 + wr * 64 + fr, col0 = u.pn * 256 + wc * 32 + 8 * fq;
#pragma unroll
        for (int ai = 0; ai < 2; ++ai)
#pragma unroll
            for (int m = 0; m < 4; ++m) { const int f = row0 + ai * 128 + m * 16;
#pragma unroll
                for (int bj = 0; bj < 2; ++bj) { const f32x4 v0 = acc[ai][bj][m][0] * DS2, v1 = acc[ai][bj][m][1] * DS2; const int tok = col0 + bj * 128;
                    u32x4 w; w.x = cvtpk(v0[0], v0[1]); w.y = cvtpk(v0[2], v0[3]); w.z = cvtpk(v1[0], v1[1]); w.w = cvtpk(v1[2], v1[3]);
                    *(u32x4*)(VT + ((((size_t)(f >> 7) * 256 + (tok >> 6)) * 128 + (f & 127)) * 64 + (tok & 63))) = w; } }
    }
};
struct ProjEpi {
    static constexpr bool PERM = true, HAS_MID = false;
    StoreQK8 qkd; StoreQKboth qkm; StoreBf16<1> gates;
    __device__ __forceinline__ int f8exp(const Unit& u) const { return (u.pn >= 4 && u.pn < 8) ? P2_EXP - 2 : P2_EXP; }
    __device__ __forceinline__ void operator()(const f32x4 (&acc)[2][2][4][2], const Unit& u, int wr, int wc, int fr, int fq) const {
        Unit v = u;
        if (u.pn < 8) qkd(acc, v, wr, wc, fr, fq);
        else if (u.pn < 16) { v.pn = u.pn - 8; qkm(acc, v, wr, wc, fr, fq); }
        else { v.pn = u.pn - 16; gates(acc, v, wr, wc, fr, fq); }
    }
};
struct ProjVT {
    static constexpr bool PERM = true, HAS_MID = false;
    StoreVT8 vd; StoreVT8 vm;
    __device__ __forceinline__ int f8exp(const Unit& u) const { return P2_EXP - 3; }
    __device__ __forceinline__ void operator()(const f32x4 (&acc)[2][2][4][2], const Unit& u, int wr, int wc, int fr, int fq) const {
        Unit v = u;
        if (u.pm < 4) vd(acc, v, wr, wc, fr, fq); else { v.pm = u.pm - 4; vm(acc, v, wr, wc, fr, fq); }
    }
};
struct GatePair {
    static constexpr bool PERM = true, HAS_MID = false;
    GateMul<0> e0; GateMul<1> e1;
    __device__ __forceinline__ int f8exp(const Unit& u) const { return u.aux == 0 ? 9 : 11; }
    __device__ __forceinline__ void operator()(const f32x4 (&acc)[2][2][4][2], const Unit& u, int wr, int wc, int fr, int fq) const {
        if (u.aux == 0) e0(acc, u, wr, wc, fr, fq); else e1(acc, u, wr, wc, fr, fq);
    }
};
struct ResidBf16 {
    static constexpr bool PERM = true, HAS_MID = false;
    const float* base; bf16_t* out; const float* gate; int goff;
    __device__ __forceinline__ int f8exp(const Unit&) const { return 10; }
    __device__ __forceinline__ void operator()(const f32x4 (&acc)[2][2][4][2], const Unit& u, int wr, int wc, int fr, int fq) const {
        const int row0 = u.pm * 256 + wr * 64 + fr, col0 = u.pn * 256 + wc * 32 + 8 * fq;
        const int b = (u.pm * 256) / SEQ;
        f32x4 gv[2][2];
#pragma unroll
        for (int bj = 0; bj < 2; ++bj)
#pragma unroll
            for (int n = 0; n < 2; ++n) gv[bj][n] = *(const f32x4*)(gate + (size_t)b * 12288 + goff + col0 + bj * 128 + n * 4);
#pragma unroll
        for (int ai = 0; ai < 2; ++ai)
#pragma unroll
            for (int m = 0; m < 4; ++m) { const size_t off = (size_t)(row0 + ai * 128 + m * 16) * 2048 + col0;
#pragma unroll
                for (int bj = 0; bj < 2; ++bj) {
                    const f32x4 b0 = *(const f32x4*)(base + off + bj * 128), b1 = *(const f32x4*)(base + off + bj * 128 + 4);
                    const f32x4 v0 = b0 + gv[bj][0] * acc[ai][bj][m][0], v1 = b1 + gv[bj][1] * acc[ai][bj][m][1];
                    u32x4 w; w.x = cvtpk(v0[0], v0[1]); w.y = cvtpk(v0[2], v0[3]); w.z = cvtpk(v1[0], v1[1]); w.w = cvtpk(v1[2], v1[3]);
                    *(u32x4*)(out + off + bj * 128) = w; } }
    }
};
}
namespace att {
constexpr int KROW = 272;
constexpr int VROW = 144;
constexpr int KBUF = 64 * KROW;
constexpr int VBUF = 128 * VROW;
constexpr int OFF_K = 0, OFF_V = 2 * KBUF, OFF_TAB = OFF_V + 2 * VBUF, OFF_G = OFF_TAB + 512, OFF_END = OFF_G + 512;
static_assert(OFF_END <= RING_BYTES, "attention LDS");
__device__ __forceinline__ int crow(int i, int hh) { return (i & 3) + 8 * (i >> 2) + 4 * hh; }

__device__ __forceinline__ int t5_bucket(int n) {
    if (n < 16) return n;
    int b = 16;
    b += (n >= 19); b += (n >= 21); b += (n >= 24); b += (n >= 27); b += (n >= 31); b += (n >= 35); b += (n >= 40); b += (n >= 46);
    b += (n >= 52); b += (n >= 59); b += (n >= 67); b += (n >= 77); b += (n >= 87); b += (n >= 99); b += (n >= 113);
    return b;
}
__device__ __forceinline__ void fill_bias_tab(LAS float* tab, const float* rel_bias, int col) {
    if (threadIdx.x < 128) { const int n = threadIdx.x; tab[n] = (rel_bias[t5_bucket(n) * 16 + col] - rel_bias[31 * 16 + col]) * LOG2E; }
}

struct TileRegs { u32x4 k[2]; u32x4 v[2]; };
__device__ __forceinline__ void tile_load(TileRegs& R, const bf16_t* kt, const bf16_t* vt, int tid) {
#pragma unroll
    for (int i = 0; i < 2; ++i) { const int c = tid + 512 * i; R.k[i] = *(const u32x4*)(kt + c * 8); }
#pragma unroll
    for (int i = 0; i < 2; ++i) { const int c = tid + 512 * i; R.v[i] = *(const u32x4*)(vt + c * 8); }
}
__device__ __forceinline__ void tile_store(const TileRegs& R, LAS unsigned char* kb, LAS unsigned char* vb, int tid) {
#pragma unroll
    for (int i = 0; i < 2; ++i) { const int c = tid + 512 * i; *(LAS u32x4*)(kb + (c >> 4) * KROW + (c & 15) * 16) = R.k[i]; }
#pragma unroll
    for (int i = 0; i < 2; ++i) { const int c = tid + 512 * i;
        LAS unsigned char* p = vb + (c >> 3) * VROW + ((c & 7) >> 1) * 32 + (c & 1) * 8;
        *(LAS u32x2*)p = (u32x2){R.v[i].x, R.v[i].y}; *(LAS u32x2*)(p + 16) = (u32x2){R.v[i].z, R.v[i].w}; }
}

template <int NMAP, int KS>
__device__ __forceinline__ void attn_half(const LAS unsigned char* kb, const LAS unsigned char* vb, int kh, const bf16x8 (&qf)[NMAP][KS], f32x16 (&O)[NMAP][4],
                                          float (&mrun)[NMAP], float (&lrun)[NMAP], int qpos, int kvpos0, bool need_mask, bool need_bias, const LAS float* btab, float sc, int r, int hh, int kcolbase) {
    bf16x8 P[NMAP][2];
#pragma unroll
    for (int m = 0; m < NMAP; ++m) {
        f32x16 s;
#pragma unroll
        for (int i = 0; i < 16; ++i) s[i] = 0.f;
#pragma unroll
        for (int ks = 0; ks < KS; ++ks) {
            const bf16x8 kf = *(const LAS bf16x8*)(kb + (32 * kh + r) * KROW + (kcolbase + m * 16 * KS + 16 * ks + 8 * hh) * 2);
            s = __builtin_amdgcn_mfma_f32_32x32x16_bf16(kf, qf[m][ks], s, 0, 0, 0);
        }
#pragma unroll
        for (int i = 0; i < 16; ++i) s[i] *= sc;
        if (need_bias) {
#pragma unroll
            for (int i = 0; i < 16; ++i) { int rel = qpos - (kvpos0 + crow(i, hh)); rel = rel < 0 ? 0 : (rel > 127 ? 127 : rel); s[i] += btab[rel]; }
        }
        if (need_mask) {
#pragma unroll
            for (int i = 0; i < 16; ++i) { if (kvpos0 + crow(i, hh) > qpos) s[i] = -INFINITY; }
        }
        float mx = s[0];
#pragma unroll
        for (int i = 1; i < 16; ++i) mx = fmaxf(mx, s[i]);
        mx = fmaxf(mx, __shfl_xor(mx, 32));
        const float mnew = fmaxf(mrun[m], mx);
        const float alpha = fast_exp2(mrun[m] - mnew);
        float sum = 0.f;
#pragma unroll
        for (int i = 0; i < 16; ++i) { const float p = fast_exp2(s[i] - mnew); sum += p; s[i] = p; }
        lrun[m] = lrun[m] * alpha + sum; mrun[m] = mnew;
#pragma unroll
        for (int dt = 0; dt < 4; ++dt)
#pragma unroll
            for (int i = 0; i < 16; ++i) O[m][dt][i] *= alpha;
#pragma unroll
        for (int st = 0; st < 2; ++st) { u32x4 w; w.x = cvtpk(s[8 * st + 0], s[8 * st + 1]); w.y = cvtpk(s[8 * st + 2], s[8 * st + 3]); w.z = cvtpk(s[8 * st + 4], s[8 * st + 5]); w.w = cvtpk(s[8 * st + 6], s[8 * st + 7]);
            P[m][st] = __builtin_bit_cast(bf16x8, w); }
    }
#pragma unroll
    for (int dt = 0; dt < 4; ++dt)
#pragma unroll
        for (int st = 0; st < 2; ++st) {
            const bf16x8 vf = *(const LAS bf16x8*)(vb + (32 * dt + r) * VROW + (2 * kh + st) * 32 + hh * 16);
#pragma unroll
            for (int m = 0; m < NMAP; ++m) O[m][dt] = __builtin_amdgcn_mfma_f32_32x32x16_bf16(vf, P[m][st], O[m][dt], 0, 0, 0);
        }
}

#define SBAR() __builtin_amdgcn_sched_barrier(0)
constexpr int TBUF = KBUF + VBUF;
constexpr int D_OFF_TAB = 3 * TBUF, D_OFF_G = D_OFF_TAB + 512;
static_assert(D_OFF_G + 512 <= RING_BYTES, "diff attention LDS");
constexpr float D_C = 0.125f * LOG2E;
__device__ __forceinline__ void d_load_kf(bf16x8 (&kf)[4], const LAS unsigned char* kb, int kh, int r, int hh, int kcol) {
#pragma unroll
    for (int ks = 0; ks < 4; ++ks) kf[ks] = *(const LAS bf16x8*)(kb + (32 * kh + r) * KROW + (kcol + 16 * ks + 8 * hh) * 2);
}
constexpr float D_THR = 8.0f;
__device__ __forceinline__ float max3_(float a, float b, float c) { float r; asm("v_max3_f32 %0, %1, %2, %3" : "=v"(r) : "v"(a), "v"(b), "v"(c)); return r; }
template <int MODE, bool LOADV, bool PREFK>
__device__ __forceinline__ void d_half_a(const bf16x8 (&kf)[4], bf16x8 (&kfn)[4], const LAS unsigned char* knext, int khn, const LAS unsigned char* vb, int kh,
                                         const bf16x8 (&qf)[4], f32x16 (&o)[4], float& mref, float& lrun, int qpos, int kvpos0, bool need_mask, bool need_bias, bool first,
                                         const LAS float* btab, int r, int hh, int kcol, bf16x8 (&vf)[4], bf16x8 (&P)[2]) {
    if (LOADV) {
#pragma unroll
        for (int dt = 0; dt < 2; ++dt)
#pragma unroll
            for (int st = 0; st < 2; ++st) vf[2 * dt + st] = *(const LAS bf16x8*)(vb + (32 * dt + r) * VROW + (2 * kh + st) * 32 + hh * 16);
    }
    SBAR();
    f32x16 s;
#pragma unroll
    for (int i = 0; i < 16; ++i) s[i] = 0.f;
    __builtin_amdgcn_s_setprio(1);
#pragma unroll
    for (int ks = 0; ks < 4; ++ks) { if (MODE != 3) s = __builtin_amdgcn_mfma_f32_32x32x16_bf16(kf[ks], qf[ks], s, 0, 0, 0); else { s[ks] += __builtin_bit_cast(float, (int)kf[ks][0]); s[4 + ks] += __builtin_bit_cast(float, (int)qf[ks][1]); } }
    __builtin_amdgcn_s_setprio(0);
    if (PREFK) d_load_kf(kfn, knext, khn, r, hh, kcol);
    SBAR();
    if (MODE == 4) { P[0] = qf[0]; P[1] = qf[1]; mref = fmaxf(mref, s[0]); } else {
    if (need_bias) {
#pragma unroll
        for (int i = 0; i < 16; ++i) { int rel = qpos - (kvpos0 + crow(i, hh)); rel = rel < 0 ? 0 : (rel > 127 ? 127 : rel); s[i] += btab[rel]; }
    }
    if (need_mask) {
#pragma unroll
        for (int i = 0; i < 16; ++i) { if (kvpos0 + crow(i, hh) > qpos) s[i] = -INFINITY; }
    }
    float mx = max3_(s[0], s[1], s[2]);
    mx = max3_(mx, s[3], s[4]); mx = max3_(mx, s[5], s[6]); mx = max3_(mx, s[7], s[8]); mx = max3_(mx, s[9], s[10]); mx = max3_(mx, s[11], s[12]); mx = max3_(mx, s[13], s[14]);
    { auto rr = __builtin_amdgcn_permlane32_swap(__float_as_uint(mx), __float_as_uint(mx), false, false); mx = max3_(s[15], __uint_as_float(rr[0]), __uint_as_float(rr[1])); }
    if (first || __any(mx - mref > D_THR)) {
        const float mn = first ? mx : fmaxf(mref, mx);
        const float alpha = first ? 0.f : fast_exp2(mref - mn);
        mref = mn; lrun *= alpha;
#pragma unroll
        for (int dt = 0; dt < 4; ++dt)
#pragma unroll
            for (int i = 0; i < 16; ++i) o[dt][i] *= alpha;
    }
    float sum = 0.f;
#pragma unroll
    for (int i = 0; i < 16; ++i) { const float p = fast_exp2(s[i] - mref); sum += p; s[i] = p; }
    lrun += sum;
#pragma unroll
    for (int st = 0; st < 2; ++st) { u32x4 w; w.x = cvtpk(s[8 * st + 0], s[8 * st + 1]); w.y = cvtpk(s[8 * st + 2], s[8 * st + 3]); w.z = cvtpk(s[8 * st + 4], s[8 * st + 5]); w.w = cvtpk(s[8 * st + 6], s[8 * st + 7]);
        P[st] = __builtin_bit_cast(bf16x8, w); }
    }
}
template <int MODE, bool LOADV>
__device__ __forceinline__ void d_half_b(f32x16 (&o)[4], bf16x8 (&vf)[4], const bf16x8 (&P)[2], const LAS unsigned char* vb, int kh, int r, int hh) {
    if (LOADV) {
#pragma unroll
        for (int dt = 0; dt < 2; ++dt)
#pragma unroll
            for (int st = 0; st < 2; ++st) vf[2 * dt + st] = *(const LAS bf16x8*)(vb + (32 * dt + r) * VROW + (2 * kh + st) * 32 + hh * 16);
    }
    bf16x8 vg[4];
#pragma unroll
    for (int dt = 2; dt < 4; ++dt)
#pragma unroll
        for (int st = 0; st < 2; ++st) vg[2 * (dt - 2) + st] = *(const LAS bf16x8*)(vb + (32 * dt + r) * VROW + (2 * kh + st) * 32 + hh * 16);
    asm volatile("s_waitcnt lgkmcnt(4)" ::: "memory"); SBAR();
    __builtin_amdgcn_s_setprio(1);
#pragma unroll
    for (int dt = 0; dt < 2; ++dt)
#pragma unroll
        for (int st = 0; st < 2; ++st) {
            if (MODE != 3) o[dt] = __builtin_amdgcn_mfma_f32_32x32x16_bf16(vf[2 * dt + st], P[st], o[dt], 0, 0, 0);
            else o[dt][st] += __builtin_bit_cast(float, (int)vf[2 * dt + st][0]) * __builtin_bit_cast(float, (int)P[st][0]);
        }
    asm volatile("s_waitcnt lgkmcnt(0)" ::: "memory"); SBAR();
#pragma unroll
    for (int dt = 2; dt < 4; ++dt)
#pragma unroll
        for (int st = 0; st < 2; ++st) {
            if (MODE != 3) o[dt] = __builtin_amdgcn_mfma_f32_32x32x16_bf16(vg[2 * (dt - 2) + st], P[st], o[dt], 0, 0, 0);
            else o[dt][st] += __builtin_bit_cast(float, (int)vg[2 * (dt - 2) + st][0]) * __builtin_bit_cast(float, (int)P[st][0]);
        }
    __builtin_amdgcn_s_setprio(0);
}
template <int MODE>
__device__ __forceinline__ void diff_unit(LAS unsigned char* lds, int b, int h, int qt, const bf16_t* QD, const bf16_t* KDT, const bf16_t* VDT, bf16_t* AD, const float* subln, const float* rel_bias) {
    int tid_ = threadIdx.x; asm volatile("" : "+v"(tid_));
    const int tid = tid_, lane = tid & 63, r = lane & 31, hh = lane >> 5; const int wid = __builtin_amdgcn_readfirstlane(tid >> 6);
    const int map = wid >> 2, qsub = wid & 3;
    const int q0 = qt * 128, qw0 = q0 + 32 * qsub, qpos = qw0 + r;
    const size_t tok0 = (size_t)b * SEQ;
    const LAS float* btab = (const LAS float*)(lds + D_OFF_TAB);
    const LAS float* gtab = (const LAS float*)(lds + D_OFF_G);
    const int kcol = map * 64;
    bf16x8 qf[4];
#pragma unroll
    for (int ks = 0; ks < 4; ++ks) qf[ks] = *(const bf16x8*)(QD + (tok0 + qpos) * 1024 + h * 128 + map * 64 + 16 * ks + 8 * hh);
    f32x16 o[4];
#pragma unroll
    for (int dt = 0; dt < 4; ++dt)
#pragma unroll
        for (int i = 0; i < 16; ++i) o[dt][i] = 0.f;
    float mrun = 0.f, lrun = 0.f;
    const bf16_t* kbase = KDT + ((size_t)h * 256 + b * 128) * 8192;
    const bf16_t* vbase = VDT + ((size_t)h * 256 + b * 128) * 8192;
    const int NT = 2 * (qt + 1);
    TileRegs R;
    bf16x8 kfa[4], kfb[4];
    __syncthreads();
    fill_bias_tab((LAS float*)(lds + D_OFF_TAB), rel_bias, h);
    if (tid < 128) ((LAS float*)(lds + D_OFF_G))[tid] = subln[tid];
    tile_load(R, kbase, vbase, tid);
    tile_store(R, lds, lds + KBUF, tid);
    tile_load(R, kbase + 8192, vbase + 8192, tid);
    __syncthreads();
    if (MODE != 2) d_load_kf(kfa, lds, 0, r, hh, kcol);
    int bc = 0;
    bf16x8 vf[4], P[2];
#define D_STAGE() do { if (t + 1 < NT) tile_store(R, lds + bn * TBUF, lds + bn * TBUF + KBUF, tid); \
        if (t + 2 < NT) tile_load(R, kbase + (size_t)(MODE == 1 ? 0 : t + 2) * 8192, vbase + (size_t)(MODE == 1 ? 0 : t + 2) * 8192, tid); \
        __syncthreads(); } while (0)
    if (wid < 4) {
#pragma unroll 1
        for (int t = 0; t < NT; ++t) {
            const int bn = (bc == 2) ? 0 : bc + 1;
            const LAS unsigned char* kb = lds + bc * TBUF; const LAS unsigned char* vb = kb + KBUF;
            const int k0 = 64 * t;
            { const bool nm = (k0 + 31 > qw0), nb = (qw0 - (k0 + 31) < 113);
              if (MODE != 2) { d_half_a<MODE, true, true>(kfa, kfb, kb, 1, vb, 0, qf, o, mrun, lrun, qpos, k0, nm, nb, t == 0, btab, r, hh, kcol, vf, P); d_half_b<MODE, false>(o, vf, P, vb, 0, r, hh); } }
            D_STAGE();
            { const bool nm = (k0 + 63 > qw0), nb = (qw0 - (k0 + 63) < 113);
              if (MODE != 2) { d_half_a<MODE, true, true>(kfb, kfa, lds + bn * TBUF, 0, vb, 1, qf, o, mrun, lrun, qpos, k0 + 32, nm, nb, false, btab, r, hh, kcol, vf, P); d_half_b<MODE, false>(o, vf, P, vb, 1, r, hh); } }
            bc = bn;
        }
    } else {
#pragma unroll 1
        for (int t = 0; t < NT; ++t) {
            const int bn = (bc == 2) ? 0 : bc + 1;
            const LAS unsigned char* kb = lds + bc * TBUF; const LAS unsigned char* vb = kb + KBUF;
            const int k0 = 64 * t;
            { const bool nm = (k0 + 31 > qw0), nb = (qw0 - (k0 + 31) < 113);
              if (MODE != 2) d_half_a<MODE, false, false>(kfa, kfb, kb, 1, vb, 0, qf, o, mrun, lrun, qpos, k0, nm, nb, t == 0, btab, r, hh, kcol, vf, P); }
            D_STAGE();
            if (MODE != 2) { d_half_b<MODE, true>(o, vf, P, vb, 0, r, hh); d_load_kf(kfb, kb, 1, r, hh, kcol); }
            { const bool nm = (k0 + 63 > qw0), nb = (qw0 - (k0 + 63) < 113);
              if (MODE != 2) { d_half_a<MODE, true, true>(kfb, kfa, lds + bn * TBUF, 0, vb, 1, qf, o, mrun, lrun, qpos, k0 + 32, nm, nb, false, btab, r, hh, kcol, vf, P); d_half_b<MODE, false>(o, vf, P, vb, 1, r, hh); } }
            bc = bn;
        }
    }
#undef D_STAGE
    __syncthreads();
    const float l = lrun + __shfl_xor(lrun, 32);
    LAS float* xch = (LAS float*)lds + qsub * 4096 + lane;
    if (map == 1) {
        const float lam = *(const LAS float*)(lds + MISC_OFF + 68);
        const float f = lam / l;
#pragma unroll
        for (int dt = 0; dt < 4; ++dt)
#pragma unroll
            for (int i = 0; i < 16; ++i) xch[(dt * 16 + i) * 64] = o[dt][i] * f;
    }
    __syncthreads();
    if (map == 0) {
        const float i0 = 1.0f / l;
        float ss = 0.f;
#pragma unroll
        for (int dt = 0; dt < 4; ++dt)
#pragma unroll
            for (int i = 0; i < 16; ++i) { const float v = o[dt][i] * i0 - xch[(dt * 16 + i) * 64]; o[dt][i] = v; ss += v * v; }
        ss += __shfl_xor(ss, 32);
        const float rs = 0.8f / sqrtf(ss * (1.0f / 128.0f) + RMS_EPS);
        bf16_t* orow = AD + (tok0 + qpos) * 1024 + h * 128;
#pragma unroll
        for (int dt = 0; dt < 4; ++dt)
#pragma unroll
            for (int g = 0; g < 4; ++g) { const int d = 32 * dt + 8 * g + 4 * hh;
                const f32x4 gg = *(const LAS f32x4*)(gtab + d);
                u32x2 w; w.x = cvtpk(o[dt][4 * g + 0] * rs * gg[0], o[dt][4 * g + 1] * rs * gg[1]); w.y = cvtpk(o[dt][4 * g + 2] * rs * gg[2], o[dt][4 * g + 3] * rs * gg[3]);
                *(u32x2*)(orow + d) = w; }
    }
}

constexpr int KROW8 = 144, VROW8 = 80, KBUF8 = 64 * KROW8, VBUF8 = 128 * VROW8, TBUF8 = KBUF8 + VBUF8;
static_assert(4 * TBUF8 <= D_OFF_TAB, "fp8 diff attention LDS");
constexpr float D8_C = 1.0f / 64.0f, D8_THR = 3.0f * 64.0f, D8_SH = 5.0f;
struct TileRegs8 { u32x4 k, v; };
__device__ __forceinline__ void tile_load8(TileRegs8& R, const unsigned char* kt, const unsigned char* vt, int tid) { R.k = *(const u32x4*)(kt + tid * 16); R.v = *(const u32x4*)(vt + tid * 16); }
__device__ __forceinline__ void tile_store8(const TileRegs8& R, LAS unsigned char* kb, LAS unsigned char* vb, int tid) {
    *(LAS u32x4*)(kb + (tid >> 3) * KROW8 + (tid & 7) * 16) = R.k; *(LAS u32x4*)(vb + (tid >> 2) * VROW8 + (tid & 3) * 16) = R.v; }
__device__ __forceinline__ i32x8 cat8(const i32x4 a, const i32x4 b) { return __builtin_shufflevector(a, b, 0, 1, 2, 3, 4, 5, 6, 7); }
__device__ __forceinline__ void d8_load_kf(i32x8 (&kf)[2], const LAS unsigned char* kb, int r, int hh, int kcolb) {
#pragma unroll
    for (int kh = 0; kh < 2; ++kh) { const LAS unsigned char* q = kb + (32 * kh + r) * KROW8 + kcolb + 32 * hh; kf[kh] = cat8(*(const LAS i32x4*)q, *(const LAS i32x4*)(q + 16)); }
}
template <int DT0>
__device__ __forceinline__ void d8_load_vf2(i32x8 (&vf)[2], const LAS unsigned char* vb, int r, int hh) {
#pragma unroll
    for (int dt = 0; dt < 2; ++dt) { const LAS unsigned char* q = vb + (32 * (DT0 + dt) + r) * VROW8 + 32 * hh; vf[dt] = cat8(*(const LAS i32x4*)q, *(const LAS i32x4*)(q + 16)); }
}
__device__ __forceinline__ void d8_scores(f32x16& s0, f32x16& s1, const i32x8 (&kf)[2], const i32x8& qf) {
    f32x16 z;
#pragma unroll
    for (int i = 0; i < 16; ++i) z[i] = 0.f;
    __builtin_amdgcn_s_setprio(1);
    s0 = __builtin_amdgcn_mfma_scale_f32_32x32x64_f8f6f4(kf[0], qf, z, 0, 0, 0, 0x7F7F7F7F, 0, 0x7F7F7F7F);
    s1 = __builtin_amdgcn_mfma_scale_f32_32x32x64_f8f6f4(kf[1], qf, z, 0, 0, 0, 0x7F7F7F7F, 0, 0x7F7F7F7F);
    __builtin_amdgcn_s_setprio(0);
}
template <bool ROW = false>
__device__ __forceinline__ i32x8 d8_softmax(f32x16& s0, f32x16& s1, f32x16 (&o)[4], float& mref, float& lrun, int qpos, int k0, bool need_mask, bool need_bias, bool first, const LAS float* btab, int hh) {
    if (need_bias) {
#pragma unroll
        for (int i = 0; i < 16; ++i) { int rel = qpos - (k0 + crow(i, hh)); rel = rel < 0 ? 0 : (rel > 127 ? 127 : rel); s0[i] += btab[rel]; }
        SBAR();
#pragma unroll
        for (int i = 0; i < 16; ++i) { int rel = qpos - (k0 + 32 + crow(i, hh)); rel = rel < 0 ? 0 : (rel > 127 ? 127 : rel); s1[i] += btab[rel]; }
        SBAR();
    }
    if (need_mask) {
#pragma unroll
        for (int i = 0; i < 16; ++i) { if (k0 + crow(i, hh) > qpos) s0[i] = -INFINITY; if (k0 + 32 + crow(i, hh) > qpos) s1[i] = -INFINITY; }
    }
    float mx = max3_(s0[0], s0[1], s0[2]);
#pragma unroll
    for (int i = 3; i < 15; i += 2) mx = max3_(mx, s0[i], s0[i + 1]);
    mx = max3_(mx, s0[15], s1[0]);
#pragma unroll
    for (int i = 1; i < 15; i += 2) mx = max3_(mx, s1[i], s1[i + 1]);
    { auto rr = __builtin_amdgcn_permlane32_swap(__float_as_uint(mx), __float_as_uint(mx), false, false); mx = max3_(s1[15], __uint_as_float(rr[0]), __uint_as_float(rr[1])); }
    if constexpr (ROW) {
        const bool up = (mx - mref > D8_THR);
        if (__any(up)) {
            const float alpha = up ? fast_exp2((mref - mx) * D8_C) : 1.0f;
            if (up) mref = mx;
            lrun *= alpha;
            asm volatile("s_nop 15\n\ts_nop 15" ::: "memory");
#pragma unroll
            for (int dt = 0; dt < 4; ++dt)
#pragma unroll
                for (int i = 0; i < 16; ++i) o[dt][i] *= alpha;
        }
    } else
    if (first || __any(mx - mref > D8_THR)) {
        const float mn = first ? mx : fmaxf(mref, mx);
        const float alpha = first ? 0.f : fast_exp2((mref - mn) * D8_C);
        mref = mn; lrun *= alpha;
        asm volatile("s_nop 15\n\ts_nop 15" ::: "memory");
#pragma unroll
        for (int dt = 0; dt < 4; ++dt)
#pragma unroll
            for (int i = 0; i < 16; ++i) o[dt][i] *= alpha;
    }
    const float off = D8_SH - mref * D8_C;
    float sum0 = 0.f, sum1 = 0.f;
    i32x8 P;
    const f32x2 c2 = {D8_C, D8_C}, off2 = {off, off};
    f32x2 sum2 = {0.f, 0.f};
#pragma unroll
    for (int g = 0; g < 4; ++g) {
        const f32x2 a0 = __builtin_elementwise_fma((f32x2){s0[4 * g], s0[4 * g + 1]}, c2, off2), a1 = __builtin_elementwise_fma((f32x2){s0[4 * g + 2], s0[4 * g + 3]}, c2, off2);
        const f32x2 b0 = __builtin_elementwise_fma((f32x2){s1[4 * g], s1[4 * g + 1]}, c2, off2), b1 = __builtin_elementwise_fma((f32x2){s1[4 * g + 2], s1[4 * g + 3]}, c2, off2);
        const f32x2 e0 = {fast_exp2(a0[0]), fast_exp2(a0[1])}, e1 = {fast_exp2(a1[0]), fast_exp2(a1[1])}, f0 = {fast_exp2(b0[0]), fast_exp2(b0[1])}, f1 = {fast_exp2(b1[0]), fast_exp2(b1[1])};
        sum2 += (e0 + e1) + (f0 + f1);
        int w0 = __builtin_amdgcn_cvt_pk_fp8_f32(e0[0], e0[1], 0, false); w0 = __builtin_amdgcn_cvt_pk_fp8_f32(e1[0], e1[1], w0, true);
        int w1 = __builtin_amdgcn_cvt_pk_fp8_f32(f0[0], f0[1], 0, false); w1 = __builtin_amdgcn_cvt_pk_fp8_f32(f1[0], f1[1], w1, true);
        P[g] = w0; P[4 + g] = w1; }
    sum0 = sum2[0]; sum1 = sum2[1];
    lrun += sum0 + sum1;
    return P;
}
__device__ __forceinline__ void d8_pv(f32x16 (&o)[4], const i32x8 (&va)[2], const i32x8& P, const LAS unsigned char* vb, int r, int hh) {
    i32x8 vg[2];
    d8_load_vf2<2>(vg, vb, r, hh);
    asm volatile("s_waitcnt lgkmcnt(4)" ::: "memory"); SBAR();
    __builtin_amdgcn_s_setprio(1);
#pragma unroll
    for (int dt = 0; dt < 2; ++dt) asm volatile("v_mfma_scale_f32_32x32x64_f8f6f4 %0, %1, %2, %0, %3, %3 op_sel_hi:[0,0,0]" : "+v"(o[dt]) : "v"(va[dt]), "v"(P), "v"(0x7F7F7F7F));
    asm volatile("s_waitcnt lgkmcnt(0)" ::: "memory"); SBAR();
#pragma unroll
    for (int dt = 0; dt < 2; ++dt) asm volatile("v_mfma_scale_f32_32x32x64_f8f6f4 %0, %1, %2, %0, %3, %3 op_sel_hi:[0,0,0]" : "+v"(o[2 + dt]) : "v"(vg[dt]), "v"(P), "v"(0x7F7F7F7F));
    __builtin_amdgcn_s_setprio(0);
}
__device__ __forceinline__ void diff_unit8(LAS unsigned char* lds, int b, int h, int qt, const unsigned char* QD, const unsigned char* KDT, const unsigned char* VDT, bf16_t* AD, const float* subln, const float* rel_bias) {
    int tid_ = threadIdx.x; asm volatile("" : "+v"(tid_));
    const int tid = tid_, lane = tid & 63, r = lane & 31, hh = lane >> 5; const int wid = __builtin_amdgcn_readfirstlane(tid >> 6);
    const int map = wid >> 2, qsub = wid & 3;
    const int q0 = qt * 128, qw0 = q0 + 32 * qsub, qpos = qw0 + r;
    const size_t tok0 = (size_t)b * SEQ;
    const LAS float* btab = (const LAS float*)(lds + D_OFF_TAB);
    const LAS float* gtab = (const LAS float*)(lds + D_OFF_G);
    const int kcolb = map * 64;
    i32x8 qf;
    { const unsigned char* qp = QD + (tok0 + qpos) * 1024 + h * 128 + map * 64 + 32 * hh; qf = cat8(*(const i32x4*)qp, *(const i32x4*)(qp + 16)); }
    f32x16 o[4];
#pragma unroll
    for (int dt = 0; dt < 4; ++dt)
#pragma unroll
        for (int i = 0; i < 16; ++i) o[dt][i] = 0.f;
    float mrun = 0.f, lrun = 0.f;
    const unsigned char* kbase = KDT + ((size_t)h * 256 + b * 128) * 8192;
    const unsigned char* vbase = VDT + ((size_t)h * 256 + b * 128) * 8192;
    const int NT = 2 * (qt + 1);
    TileRegs8 R;
    __syncthreads();
    { TileRegs8 Rb;
      tile_load8(R, kbase, vbase, tid); tile_load8(Rb, kbase + 8192, vbase + 8192, tid);
      SBAR();
      if (tid < 128) { const int n = tid; ((LAS float*)(lds + D_OFF_TAB))[n] = (rel_bias[t5_bucket(n) * 16 + h] - rel_bias[31 * 16 + h]) * (LOG2E * 64.0f); ((LAS float*)(lds + D_OFF_G))[n] = subln[n]; }
      tile_store8(R, lds, lds + KBUF8, tid); tile_store8(Rb, lds + TBUF8, lds + TBUF8 + KBUF8, tid); }
    if (NT > 2) tile_load8(R, kbase + 2 * 8192, vbase + 2 * 8192, tid);
    __syncthreads();
    i32x8 kf[2], vf[2];
    d8_load_kf(kf, lds, r, hh, kcolb);
#define D8_STAGE(t) do { if ((t) + 2 < NT) tile_store8(R, lds + (((t) + 2) & 3) * TBUF8, lds + (((t) + 2) & 3) * TBUF8 + KBUF8, tid); \
        if ((t) + 3 < NT) tile_load8(R, kbase + (size_t)((t) + 3) * 8192, vbase + (size_t)((t) + 3) * 8192, tid); \
        __syncthreads(); } while (0)
#pragma unroll 1
    for (int t = 0; t < NT; ++t) {
        const int k0 = 64 * t; const LAS unsigned char* tb = lds + (t & 3) * TBUF8;
        f32x16 s0, s1; d8_scores(s0, s1, kf, qf);
        d8_load_vf2<0>(vf, tb + KBUF8, r, hh); d8_load_kf(kf, lds + ((t + 1) & 3) * TBUF8, r, hh, kcolb); SBAR();
        const i32x8 P = d8_softmax(s0, s1, o, mrun, lrun, qpos, k0, (k0 + 63 > qw0), (qw0 - (k0 + 63) < 113), t == 0, btab, hh);
        if (wid >= 4) D8_STAGE(t);
        d8_pv(o, vf, P, tb + KBUF8, r, hh);
        if (wid < 4) D8_STAGE(t);
    }
#undef D8_STAGE
    __syncthreads();
    asm volatile("s_nop 15\n\ts_nop 15\n\ts_nop 15\n\ts_nop 15" ::: "memory");
    const float l = (lrun + __shfl_xor(lrun, 32)) * D8_VS;
    LAS float* xch = (LAS float*)lds + qsub * 4096 + lane;
    if (map == 1) {
        const float lam = *(const LAS float*)(lds + MISC_OFF + 68);
        const float f = lam / l;
#pragma unroll
        for (int dt = 0; dt < 4; ++dt)
#pragma unroll
            for (int i = 0; i < 16; ++i) xch[(dt * 16 + i) * 64] = o[dt][i] * f;
    }
    __syncthreads();
    if (map == 0) {
        const float i0 = 1.0f / l;
        float ss = 0.f;
#pragma unroll
        for (int dt = 0; dt < 4; ++dt)
#pragma unroll
            for (int i = 0; i < 16; ++i) { const float v = o[dt][i] * i0 - xch[(dt * 16 + i) * 64]; o[dt][i] = v; ss += v * v; }
        ss += __shfl_xor(ss, 32);
        const float rs = 0.8f / sqrtf(ss * (1.0f / 128.0f) + RMS_EPS);
        bf16_t* orow = AD + (tok0 + qpos) * 1024 + h * 128;
#pragma unroll
        for (int dt = 0; dt < 4; ++dt)
#pragma unroll
            for (int g = 0; g < 4; ++g) { const int d = 32 * dt + 8 * g + 4 * hh;
                const f32x4 gg = *(const LAS f32x4*)(gtab + d);
                if constexpr (O78F8) { const float r8 = rs * F8_SAD;
                    *(unsigned*)((unsigned char*)AD + (tok0 + qpos) * 1024 + h * 128 + d) = epi::pack4_f8(o[dt][4 * g + 0] * r8 * gg[0], o[dt][4 * g + 1] * r8 * gg[1], o[dt][4 * g + 2] * r8 * gg[2], o[dt][4 * g + 3] * r8 * gg[3]); }
                else { u32x2 w; w.x = cvtpk(o[dt][4 * g + 0] * rs * gg[0], o[dt][4 * g + 1] * rs * gg[1]); w.y = cvtpk(o[dt][4 * g + 2] * rs * gg[2], o[dt][4 * g + 3] * rs * gg[3]);
                *(u32x2*)(orow + d) = w; } }
    }
}

__device__ __forceinline__ void moba_unit(LAS unsigned char* lds, int b, int h, int n, const int* list, int cnt, const bf16_t* QM, const bf16_t* KMT, const bf16_t* VMT, bf16_t* PARTS, float* ML, const float* rel_bias) {
    int tid_ = threadIdx.x; asm volatile("" : "+v"(tid_));
    const int tid = tid_, lane = tid & 63, r = lane & 31, hh = lane >> 5; const int wid = __builtin_amdgcn_readfirstlane(tid >> 6);
    const size_t tok0 = (size_t)b * SEQ;
    const LAS float* btab = (const LAS float*)(lds + OFF_TAB);
    const float sc = 0.08838834764831845f * LOG2E;
    const bool own = (list == nullptr);
    const int li = 32 * wid + r;
    const bool lane_valid = li < cnt;
    int qpos, slot;
    if (own) { qpos = 256 * n + li; slot = 3; }
    else { const int e = list[lane_valid ? li : 0]; qpos = e >> 2; slot = e & 3; }
    const bool wave_active = (32 * wid < cnt);
    bf16x8 qf[1][8];
#pragma unroll
    for (int ks = 0; ks < 8; ++ks) qf[0][ks] = *(const bf16x8*)(QM + (tok0 + qpos) * 1024 + h * 128 + 16 * ks + 8 * hh);
    f32x16 O[1][4];
#pragma unroll
    for (int dt = 0; dt < 4; ++dt)
#pragma unroll
        for (int i = 0; i < 16; ++i) O[0][dt][i] = 0.f;
    float mrun[1] = {-INFINITY}, lrun[1] = {0.f};
    const bf16_t* kbase = KMT + ((size_t)h * 256 + b * 128 + 4 * n) * 8192;
    const bf16_t* vbase = VMT + ((size_t)h * 256 + b * 128 + 4 * n) * 8192;
    const int qw0 = 256 * n + 32 * wid;
    TileRegs R;
    __syncthreads();
    fill_bias_tab((LAS float*)(lds + OFF_TAB), rel_bias, 8 + h);
    tile_load(R, kbase, vbase, tid);
    tile_store(R, lds + OFF_K, lds + OFF_V, tid);
    __syncthreads();
#pragma unroll 1
    for (int t = 0; t < 4; ++t) {
        const int cur = t & 1;
        if (t + 1 < 4) tile_load(R, kbase + (size_t)(t + 1) * 8192, vbase + (size_t)(t + 1) * 8192, tid);
        if (wave_active) {
#pragma unroll 1
            for (int kh = 0; kh < 2; ++kh) {
                const int kp = 256 * n + 64 * t + 32 * kh;
                bool run = true, need_mask = false, need_bias;
                if (own) { run = (kp <= qw0 + 31); need_mask = (kp + 31 > qw0); need_bias = true; }
                else { need_bias = __any(qpos - (kp + 31) < 113); }
                if (run) attn_half<1, 8>(lds + OFF_K + cur * KBUF, lds + OFF_V + cur * VBUF, kh, qf, O, mrun, lrun, qpos, kp, need_mask, need_bias, btab, sc, r, hh, 0);
            }
        }
        if (t + 1 < 4) tile_store(R, lds + OFF_K + (cur ^ 1) * KBUF, lds + OFF_V + (cur ^ 1) * VBUF, tid);
        __syncthreads();
    }
    const float l = lrun[0] + __shfl_xor(lrun[0], 32);
    const float il = 1.0f / l;
    if (lane_valid) {
        const size_t pidx = ((tok0 + qpos) * 8 + h) * 4 + slot;
        bf16_t* orow = PARTS + pidx * 128;
#pragma unroll
        for (int dt = 0; dt < 4; ++dt)
#pragma unroll
            for (int g = 0; g < 4; ++g) { const int d = 32 * dt + 8 * g + 4 * hh;
                u32x2 w; w.x = cvtpk(O[0][dt][4 * g + 0] * il, O[0][dt][4 * g + 1] * il); w.y = cvtpk(O[0][dt][4 * g + 2] * il, O[0][dt][4 * g + 3] * il);
                *(u32x2*)(orow + d) = w; }
        if (hh == 0) *(f32x2*)(ML + pidx * 2) = (f32x2){mrun[0], l};
    }
}
constexpr int MB_K = 0, MB_V = 4 * KBUF, MB_INC = MB_V + 4 * VBUF, MB_TAB = MB_INC + 2048, MB_END = MB_TAB + 512;
static_assert(MB_END <= MISC_OFF, "MoBA block LDS");
__device__ __forceinline__ void moba_block(LAS unsigned char* lds, int b, int h, int n, const int* list, int cntl, int c0, int c1, const bf16_t* QM, const bf16_t* KMT, const bf16_t* VMT, bf16_t* PARTS, float* ML, const float* rel_bias) {
    int tid_ = threadIdx.x; asm volatile("" : "+v"(tid_));
    const int tid = tid_, lane = tid & 63, r = lane & 31, hh = lane >> 5; const int wid = __builtin_amdgcn_readfirstlane(tid >> 6);
    const size_t tok0 = (size_t)b * SEQ;
    const LAS float* btab = (const LAS float*)(lds + MB_TAB);
    const float sc = 0.08838834764831845f * LOG2E;
    const bf16_t* kbase = KMT + ((size_t)h * 256 + b * 128 + 4 * n) * 8192;
    const bf16_t* vbase = VMT + ((size_t)h * 256 + b * 128 + 4 * n) * 8192;
    __syncthreads();
    fill_bias_tab((LAS float*)(lds + MB_TAB), rel_bias, 8 + h);
    const int li = 32 * wid + r;
    const int cA = c0, cB = c0 + 1;
    const bool ownA = (cA == 0);
    const int cntA = ownA ? 256 : ((cntl - 256 * (cA - 1)) < 256 ? (cntl - 256 * (cA - 1)) : 256);
    const int cntB = (cB < c1) ? ((cntl - 256 * (cB - 1)) < 256 ? (cntl - 256 * (cB - 1)) : 256) : 0;
    const bool hasA = (32 * wid < cntA), hasB = (32 * wid < cntB);
    const bool lvA = li < cntA, lvB = li < cntB;
    int eA = 0, eB = 0;
    if (hasA && !ownA) eA = list[256 * (cA - 1) + (lvA ? li : 0)];
    if (hasB) eB = list[256 * (cB - 1) + (lvB ? li : 0)];
    TileRegs R, R2;
    tile_load(R, kbase, vbase, tid); tile_load(R2, kbase + 8192, vbase + 8192, tid);
    tile_store(R, lds + MB_K, lds + MB_V, tid); tile_load(R, kbase + 2 * 8192, vbase + 2 * 8192, tid);
    const int qposA = ownA ? 256 * n + li : (eA >> 2), slotA = ownA ? 3 : (eA & 3);
    const int qposB = eB >> 2, slotB = eB & 3;
    bf16x8 qfA[1][8], qfB[1][8];
    if (hasA) {
#pragma unroll
        for (int ks = 0; ks < 8; ++ks) qfA[0][ks] = *(const bf16x8*)(QM + (tok0 + qposA) * 1024 + h * 128 + 16 * ks + 8 * hh);
    }
    if (hasB) {
#pragma unroll
        for (int ks = 0; ks < 8; ++ks) qfB[0][ks] = *(const bf16x8*)(QM + (tok0 + qposB) * 1024 + h * 128 + 16 * ks + 8 * hh);
    }
    tile_store(R2, lds + MB_K + KBUF, lds + MB_V + VBUF, tid); tile_load(R2, kbase + 3 * 8192, vbase + 3 * 8192, tid);
    tile_store(R, lds + MB_K + 2 * KBUF, lds + MB_V + 2 * VBUF, tid);
    tile_store(R2, lds + MB_K + 3 * KBUF, lds + MB_V + 3 * VBUF, tid);
    __syncthreads();
#define MB_CHUNK(HAS, OWN, QF, QPOS, SLOT, LV) do { if (HAS) { \
        f32x16 O[1][4]; \
        _Pragma("unroll") for (int dt = 0; dt < 4; ++dt) _Pragma("unroll") for (int i = 0; i < 16; ++i) O[0][dt][i] = 0.f; \
        float mrun[1] = {-INFINITY}, lrun[1] = {0.f}; \
        const int qw0 = 256 * n + 32 * wid; \
        _Pragma("unroll 1") for (int t8 = 0; t8 < 8; ++t8) { \
            const int t = t8 >> 1, kh = t8 & 1; const int kp = 256 * n + 32 * t8; \
            bool run = true, need_mask = false, need_bias; \
            if (OWN) { run = (kp <= qw0 + 31); need_mask = (kp + 31 > qw0); need_bias = true; } \
            else { need_bias = __any((QPOS) - (kp + 31) < 113); } \
            if (run) attn_half<1, 8>(lds + MB_K + t * KBUF, lds + MB_V + t * VBUF, kh, QF, O, mrun, lrun, QPOS, kp, need_mask, need_bias, btab, sc, r, hh, 0); \
        } \
        const float l = lrun[0] + __shfl_xor(lrun[0], 32); const float il = 1.0f / l; \
        if (LV) { const size_t pidx = ((tok0 + (QPOS)) * 8 + h) * 4 + (SLOT); bf16_t* orow = PARTS + pidx * 128; \
            _Pragma("unroll") for (int dt = 0; dt < 4; ++dt) _Pragma("unroll") for (int g = 0; g < 4; ++g) { const int d = 32 * dt + 8 * g + 4 * hh; \
                u32x2 w; w.x = cvtpk(O[0][dt][4 * g + 0] * il, O[0][dt][4 * g + 1] * il); w.y = cvtpk(O[0][dt][4 * g + 2] * il, O[0][dt][4 * g + 3] * il); \
                *(u32x2*)(orow + d) = w; } \
            if (hh == 0) *(f32x2*)(ML + pidx * 2) = (f32x2){mrun[0], l}; } } } while (0)
    MB_CHUNK(hasA, ownA, qfA, qposA, slotA, lvA);
    MB_CHUNK(hasB, false, qfB, qposB, slotB, lvB);
#undef MB_CHUNK
}
constexpr int MB8_TAB = 4 * TBUF8;
static_assert(MB8_TAB + 512 <= MB_INC, "fp8 MoBA block LDS");
__device__ __forceinline__ void moba_block8(LAS unsigned char* lds, int b, int h, int n, const int* list, int cntl, int c0, int c1, const unsigned char* QM8, const unsigned char* KMT8, const unsigned char* VMT8, bf16_t* PARTS, float* ML, const float* rel_bias) {
    int tid_ = threadIdx.x; asm volatile("" : "+v"(tid_));
    const int tid = tid_, lane = tid & 63, r = lane & 31, hh = lane >> 5; const int wid = __builtin_amdgcn_readfirstlane(tid >> 6);
    const size_t tok0 = (size_t)b * SEQ;
    const LAS float* btab = (const LAS float*)(lds + MB8_TAB);
    const unsigned char* kbase = KMT8 + ((size_t)h * 256 + b * 128 + 4 * n) * 8192;
    const unsigned char* vbase = VMT8 + ((size_t)h * 256 + b * 128 + 4 * n) * 8192;
    __syncthreads();
    if (tid < 128) { const int q = tid; ((LAS float*)(lds + MB8_TAB))[q] = (rel_bias[t5_bucket(q) * 16 + 8 + h] - rel_bias[31 * 16 + 8 + h]) * (LOG2E * 64.0f); }
    const int li = 32 * wid + r;
    const int cA = c0, cB = c0 + 1;
    const bool ownA = (cA == 0);
    const int cntA = ownA ? 256 : ((cntl - 256 * (cA - 1)) < 256 ? (cntl - 256 * (cA - 1)) : 256);
    const int cntB = (cB < c1) ? ((cntl - 256 * (cB - 1)) < 256 ? (cntl - 256 * (cB - 1)) : 256) : 0;
    const bool hasA = (32 * wid < cntA), hasB = (32 * wid < cntB);
    const bool lvA = li < cntA, lvB = li < cntB;
    int eA = 0, eB = 0;
    if (hasA && !ownA) eA = list[256 * (cA - 1) + (lvA ? li : 0)];
    if (hasB) eB = list[256 * (cB - 1) + (lvB ? li : 0)];
    TileRegs8 R0, R1, R2, R3;
    tile_load8(R0, kbase, vbase, tid); tile_load8(R1, kbase + 8192, vbase + 8192, tid); tile_load8(R2, kbase + 2 * 8192, vbase + 2 * 8192, tid); tile_load8(R3, kbase + 3 * 8192, vbase + 3 * 8192, tid);
    SBAR();
    tile_store8(R0, lds, lds + KBUF8, tid);
    const int qposA = ownA ? 256 * n + li : (eA >> 2), slotA = ownA ? 3 : (eA & 3);
    const int qposB = eB >> 2, slotB = eB & 3;
    i32x8 qf[2];
    if (hasA) { const unsigned char* qp = QM8 + (tok0 + qposA) * 1024 + h * 128 + 32 * hh; qf[0] = cat8(*(const i32x4*)qp, *(const i32x4*)(qp + 16)); qf[1] = cat8(*(const i32x4*)(qp + 64), *(const i32x4*)(qp + 80)); }
    tile_store8(R1, lds + TBUF8, lds + TBUF8 + KBUF8, tid);
    tile_store8(R2, lds + 2 * TBUF8, lds + 2 * TBUF8 + KBUF8, tid);
    tile_store8(R3, lds + 3 * TBUF8, lds + 3 * TBUF8 + KBUF8, tid);
    __syncthreads();
#define MB8_LOADQB() do { if (hasB) { const unsigned char* qp = QM8 + (tok0 + qposB) * 1024 + h * 128 + 32 * hh; qf[0] = cat8(*(const i32x4*)qp, *(const i32x4*)(qp + 16)); qf[1] = cat8(*(const i32x4*)(qp + 64), *(const i32x4*)(qp + 80)); } } while (0)
#define MB8_CHUNK(HAS, OWN, QPOS, SLOT, LV, NEXTQ) do { if (HAS) { \
        f32x16 o[4]; \
        _Pragma("unroll") for (int dt = 0; dt < 4; ++dt) _Pragma("unroll") for (int i = 0; i < 16; ++i) o[dt][i] = 0.f; \
        float mref = -INFINITY, lrun = 0.f; \
        const int qw0 = 256 * n + 32 * wid; \
        _Pragma("unroll 1") for (int t = 0; t < 4; ++t) { \
            const int kp = 256 * n + 64 * t; const LAS unsigned char* tb = lds + t * TBUF8; \
            bool run = true, need_mask = false, need_bias; \
            if (OWN) { run = (kp <= qw0 + 31); need_mask = (kp + 63 > qw0); need_bias = (qw0 - (kp + 63) < 113); } \
            else { need_bias = __any((QPOS) - (kp + 63) < 113); } \
            if (run) { \
                i32x8 ka[2], kc[2], vf[2]; \
                d8_load_kf(ka, tb, r, hh, 0); d8_load_kf(kc, tb, r, hh, 64); \
                f32x16 s0, s1; d8_scores(s0, s1, ka, qf[0]); \
                __builtin_amdgcn_s_setprio(1); \
                s0 = __builtin_amdgcn_mfma_scale_f32_32x32x64_f8f6f4(kc[0], qf[1], s0, 0, 0, 0, 0x7F7F7F7F, 0, 0x7F7F7F7F); \
                s1 = __builtin_amdgcn_mfma_scale_f32_32x32x64_f8f6f4(kc[1], qf[1], s1, 0, 0, 0, 0x7F7F7F7F, 0, 0x7F7F7F7F); \
                __builtin_amdgcn_s_setprio(0); \
                d8_load_vf2<0>(vf, tb + KBUF8, r, hh); SBAR(); \
                const i32x8 P = d8_softmax<true>(s0, s1, o, mref, lrun, QPOS, kp, need_mask, need_bias, false, btab, hh); \
                d8_pv(o, vf, P, tb + KBUF8, r, hh); \
            } \
        } \
        NEXTQ; \
        asm volatile("s_nop 15\n\ts_nop 15\n\ts_nop 15\n\ts_nop 15" ::: "memory");        \
        const float l = lrun + __shfl_xor(lrun, 32); const float il = 1.0f / (l * D8_VS); \
        if (LV) { const size_t pidx = ((tok0 + (QPOS)) * 8 + h) * 4 + (SLOT); bf16_t* orow = PARTS + pidx * 128; \
            _Pragma("unroll") for (int dt = 0; dt < 4; ++dt) _Pragma("unroll") for (int g = 0; g < 4; ++g) { const int d = 32 * dt + 8 * g + 4 * hh; \
                u32x2 w; w.x = cvtpk(o[dt][4 * g + 0] * il, o[dt][4 * g + 1] * il); w.y = cvtpk(o[dt][4 * g + 2] * il, o[dt][4 * g + 3] * il); \
                *(u32x2*)(orow + d) = w; } \
            if (hh == 0) *(f32x2*)(ML + pidx * 2) = (f32x2){mref * D8_C - D8_SH, l}; } } else { NEXTQ; } } while (0)
    MB8_CHUNK(hasA, ownA, qposA, slotA, lvA, MB8_LOADQB());
    MB8_CHUNK(hasB, false, qposB, slotB, lvB, (void)0);
#undef MB8_CHUNK
#undef MB8_LOADQB
}
}

struct Ctx {
    LAS unsigned char* lds;
    unsigned char* ws; unsigned* ctl;
    const float* const* in; float* out;
    int tid, lane, wave, G, blk;
};
enum { I_X = 0, I_C, I_WADA, I_BADA, I_GMIX, I_GFFN, I_WIN, I_LAMBDA, I_SUBLN, I_RELB, I_WOD, I_WOM, I_WOUT, I_WROUTER, I_RBIAS, I_WEG, I_WEU, I_WED, I_WSG, I_WSU, I_WSD, I_GFINAL };

constexpr int TR_SCR = 64 * 65 * 4 + 128;
static_assert(8 * TR_SCR <= RING_BYTES + 16384, "transpose scratch");
template <bool NT>
__device__ __forceinline__ void transpose_item(const float* __restrict__ W, int K, int N, bf16_t* __restrict__ WT, int drow0, int k0, int n0, LAS float* scr, int lane) {
    const int nq = lane & 15, kr = lane >> 4;
    f32x4 v[16];
#pragma unroll
    for (int i = 0; i < 16; ++i) { const f32x4* p = (const f32x4*)(W + (size_t)(k0 + 4 * i + kr) * N + n0 + 4 * nq); v[i] = NT ? __builtin_nontemporal_load(p) : *p; }
#pragma unroll
    for (int i = 0; i < 16; ++i) { LAS float* d = scr + (4 * i + kr) * 65 + 4 * nq; d[0] = v[i][0]; d[1] = v[i][1]; d[2] = v[i][2]; d[3] = v[i][3]; }
    LDS_WAIT(); asm volatile("" ::: "memory");
    const int c = lane & 7;
#pragma unroll
    for (int j = 0; j < 8; ++j) { const int n = (lane >> 3) + 8 * j; const LAS float* s = scr + (8 * c) * 65 + n;
        u32x4 o; o.x = cvtpk(s[0 * 65], s[1 * 65]); o.y = cvtpk(s[2 * 65], s[3 * 65]); o.z = cvtpk(s[4 * 65], s[5 * 65]); o.w = cvtpk(s[6 * 65], s[7 * 65]);
        u32x4* q = (u32x4*)(WT + (size_t)(drow0 + n) * K + k0 + 8 * c); if (NT) __builtin_nontemporal_store(o, q); else *q = o; }
    LDS_WAIT(); asm volatile("" ::: "memory");
}
template <bool NT>
__device__ __forceinline__ void transpose_item_f8(const float* __restrict__ W, int K, int N, unsigned char* __restrict__ WT, int drow0, int k0, int n0, LAS float* scr, int lane, float scale) {
    const int nq = lane & 15, kr = lane >> 4;
    f32x4 v[16];
#pragma unroll
    for (int i = 0; i < 16; ++i) { const f32x4* p = (const f32x4*)(W + (size_t)(k0 + 4 * i + kr) * N + n0 + 4 * nq); v[i] = NT ? __builtin_nontemporal_load(p) : *p; }
#pragma unroll
    for (int i = 0; i < 16; ++i) { LAS float* d = scr + (4 * i + kr) * 65 + 4 * nq; d[0] = v[i][0] * scale; d[1] = v[i][1] * scale; d[2] = v[i][2] * scale; d[3] = v[i][3] * scale; }
    LDS_WAIT(); asm volatile("" ::: "memory");
    const int c = lane & 7;
#pragma unroll
    for (int j = 0; j < 8; ++j) { const int n = (lane >> 3) + 8 * j; const LAS float* s = scr + (8 * c) * 65 + n;
        const u32x2 o = {epi::pack4_f8(s[0 * 65], s[1 * 65], s[2 * 65], s[3 * 65]), epi::pack4_f8(s[4 * 65], s[5 * 65], s[6 * 65], s[7 * 65])};
        u32x2* q = (u32x2*)(WT + (size_t)(drow0 + n) * K + k0 + 8 * c); if (NT) __builtin_nontemporal_store(o, q); else *q = o; }
    LDS_WAIT(); asm volatile("" ::: "memory");
}
struct CvItemF8 { const float* W; unsigned char* WT; int K, N, drow0, k0, n0; float scale; };
__device__ __forceinline__ void transpose_pair_f8(const CvItemF8& A, const CvItemF8& B, LAS float* scr, int lane) {
    const int nq = lane & 15, kr = lane >> 4, c = lane & 7;
    f32x4 va[16], vb[16];
#pragma unroll
    for (int i = 0; i < 16; ++i) va[i] = __builtin_nontemporal_load((const f32x4*)(A.W + (size_t)(A.k0 + 4 * i + kr) * A.N + A.n0 + 4 * nq));
#pragma unroll
    for (int i = 0; i < 16; ++i) vb[i] = __builtin_nontemporal_load((const f32x4*)(B.W + (size_t)(B.k0 + 4 * i + kr) * B.N + B.n0 + 4 * nq));
    __builtin_amdgcn_sched_barrier(0);
#pragma unroll
    for (int i = 0; i < 16; ++i) { LAS float* d = scr + (4 * i + kr) * 65 + 4 * nq; d[0] = va[i][0] * A.scale; d[1] = va[i][1] * A.scale; d[2] = va[i][2] * A.scale; d[3] = va[i][3] * A.scale; }
    LDS_WAIT(); asm volatile("" ::: "memory");
#pragma unroll
    for (int j = 0; j < 8; ++j) { const int n = (lane >> 3) + 8 * j; const LAS float* s = scr + (8 * c) * 65 + n;
        const u32x2 o = {epi::pack4_f8(s[0 * 65], s[1 * 65], s[2 * 65], s[3 * 65]), epi::pack4_f8(s[4 * 65], s[5 * 65], s[6 * 65], s[7 * 65])};
        __builtin_nontemporal_store(o, (u32x2*)(A.WT + (size_t)(A.drow0 + n) * A.K + A.k0 + 8 * c)); }
    LDS_WAIT(); asm volatile("" ::: "memory");
#pragma unroll
    for (int i = 0; i < 16; ++i) { LAS float* d = scr + (4 * i + kr) * 65 + 4 * nq; d[0] = vb[i][0] * B.scale; d[1] = vb[i][1] * B.scale; d[2] = vb[i][2] * B.scale; d[3] = vb[i][3] * B.scale; }
    LDS_WAIT(); asm volatile("" ::: "memory");
#pragma unroll
    for (int j = 0; j < 8; ++j) { const int n = (lane >> 3) + 8 * j; const LAS float* s = scr + (8 * c) * 65 + n;
        const u32x2 o = {epi::pack4_f8(s[0 * 65], s[1 * 65], s[2 * 65], s[3 * 65]), epi::pack4_f8(s[4 * 65], s[5 * 65], s[6 * 65], s[7 * 65])};
        __builtin_nontemporal_store(o, (u32x2*)(B.WT + (size_t)(B.drow0 + n) * B.K + B.k0 + 8 * c)); }
    LDS_WAIT(); asm volatile("" ::: "memory");
}
__device__ __forceinline__ int gu_row(int n0, int up) { return 256 * (n0 >> 7) + 128 * up + (n0 & 127); }

__device__ __forceinline__ int win_row(int n) { return n < 2048 ? n : (n < 3072 ? 8192 + (n - 2048) : (n < 5120 ? 2048 + (n - 3072) : (n < 6144 ? 9216 + (n - 5120) : 4096 + (n - 6144)))); }
__device__ __forceinline__ void p0_prologue(Ctx& F) {
    const int gw = F.blk * 8 + F.wave, NGW = F.G * 8;
    unsigned char* ws = F.ws;
    {
        const float* wada = F.in[I_WADA]; const float* c = F.in[I_C]; float* modp = (float*)(ws + WS_MODP);
        for (int it = gw; it < 48 * 32; it += NGW) {
            const int cc = it % 48, ks = it / 48, col = 256 * cc + 4 * F.lane;
            f32x4 a0 = {0.f, 0.f, 0.f, 0.f}, a1 = {0.f, 0.f, 0.f, 0.f};
#pragma unroll 8
            for (int k = 64 * ks; k < 64 * ks + 64; ++k) {
                const f32x4 w = *(const f32x4*)(wada + (size_t)k * 12288 + col);
                const float c0 = c[k], c1 = c[2048 + k];
                a0 += w * siluf_(c0); a1 += w * siluf_(c1);
            }
            *(f32x4*)(modp + ((size_t)ks * 2 + 0) * 12288 + col) = a0;
            *(f32x4*)(modp + ((size_t)ks * 2 + 1) * 12288 + col) = a1;
        }
    }
    {
        LAS float* scr = (LAS float*)(F.lds + F.wave * TR_SCR);
        constexpr int I0 = 5120, I1 = I0 + 512, I2 = I1 + 512, I3 = I2 + 1024, I4 = I3 + 256, I5 = I4 + 256, I6 = I5 + 256;
        for (int it = gw; it < I6; it += NGW) {
            if (it < I0) { const int r = it, kb = r / 160, nb = r % 160; if constexpr (P2F8) transpose_item_f8<false>(F.in[I_WIN], 2048, 10240, ws + WS_W_IN_T, win_row(64 * nb), 64 * kb, 64 * nb, scr, F.lane, F8_SW); else transpose_item<false>(F.in[I_WIN], 2048, 10240, (bf16_t*)(ws + WS_W_IN_T), win_row(64 * nb), 64 * kb, 64 * nb, scr, F.lane); }
            else if (it < I1) { const int r = it - I0, kb = r / 32, nb = r % 32; if constexpr (O78F8) transpose_item_f8<false>(F.in[I_WOD], 1024, 2048, ws + WS_W_OD_T, 64 * nb, 64 * kb, 64 * nb, scr, F.lane, F8_SWO); else transpose_item<false>(F.in[I_WOD], 1024, 2048, (bf16_t*)(ws + WS_W_OD_T), 64 * nb, 64 * kb, 64 * nb, scr, F.lane); }
            else if (it < I2) { const int r = it - I1, kb = r / 32, nb = r % 32; if constexpr (O78F8) transpose_item_f8<false>(F.in[I_WOM], 1024, 2048, ws + WS_W_OM_T, 64 * nb, 64 * kb, 64 * nb, scr, F.lane, F8_SWO); else transpose_item<false>(F.in[I_WOM], 1024, 2048, (bf16_t*)(ws + WS_W_OM_T), 64 * nb, 64 * kb, 64 * nb, scr, F.lane); }
            else if (it < I3) { const int r = it - I2, kb = r / 32, nb = r % 32; if constexpr (O78F8) transpose_item_f8<false>(F.in[I_WOUT], 2048, 2048, ws + WS_W_OUT_T, 64 * nb, 64 * kb, 64 * nb, scr, F.lane, F8_SWOUT); else transpose_item<false>(F.in[I_WOUT], 2048, 2048, (bf16_t*)(ws + WS_W_OUT_T), 64 * nb, 64 * kb, 64 * nb, scr, F.lane); }
            else if (it < I4) { const int r = it - I3, kb = r / 8, nb = r % 8; transpose_item_f8<false>(F.in[I_WSG], 2048, 512, ws + WS_W_SHGU_T, gu_row(64 * nb, 0), 64 * kb, 64 * nb, scr, F.lane, F8_SW); }
            else if (it < I5) { const int r = it - I4, kb = r / 8, nb = r % 8; transpose_item_f8<false>(F.in[I_WSU], 2048, 512, ws + WS_W_SHGU_T, gu_row(64 * nb, 1), 64 * kb, 64 * nb, scr, F.lane, F8_SW); }
            else { const int r = it - I5, kb = r / 32, nb = r % 32; transpose_item_f8<false>(F.in[I_WSD], 512, 2048, ws + WS_W_SHD_T, 64 * nb, 64 * kb, 64 * nb, scr, F.lane, F8_SD); }
        }
    }
    {
        const float* wr = F.in[I_WROUTER]; bf16_t* hi = (bf16_t*)(ws + WS_WR); bf16_t* lo = hi + 64 * 2048;
        for (int idx = F.blk * 512 + F.tid; idx < 2048 * 64; idx += F.G * 512) {
            const int k = idx >> 6, e = idx & 63; const float w = wr[idx];
            const unsigned h16 = cvtpk(w, 0.f) & 0xffffu; const float res = w - __uint_as_float(h16 << 16);
            hi[e * 2048 + k] = (bf16_t)h16; lo[e * 2048 + k] = (bf16_t)(cvtpk(res, 0.f) & 0xffffu);
        }
    }
}

constexpr int CV_NCHUNK = 1536;
struct CvItem { const float* W; unsigned char* WT; int K, N, drow0, k0, n0; float scale; };
__device__ __forceinline__ CvItem cv_decode(Ctx& F, int it) {
    unsigned char* ws = F.ws; CvItem c;
    if (it < 16384) { const int r = it, e = r >> 8, r2 = r & 255, kb = r2 / 8, nb = r2 % 8;
        c.W = F.in[I_WEG] + (size_t)e * 2048 * 512; c.WT = ws + WS_W_EGU_T + (size_t)e * 1024 * 2048; c.scale = F8_SW; c.K = 2048; c.N = 512; c.drow0 = gu_row(64 * nb, 0); c.k0 = 64 * kb; c.n0 = 64 * nb; }
    else if (it < 32768) { const int r = it - 16384, e = r >> 8, r2 = r & 255, kb = r2 / 8, nb = r2 % 8;
        c.W = F.in[I_WEU] + (size_t)e * 2048 * 512; c.WT = ws + WS_W_EGU_T + (size_t)e * 1024 * 2048; c.scale = F8_SW; c.K = 2048; c.N = 512; c.drow0 = gu_row(64 * nb, 1); c.k0 = 64 * kb; c.n0 = 64 * nb; }
    else { const int r = it - 32768, e = r >> 8, r2 = r & 255, kb = r2 / 32, nb = r2 % 32;
        c.W = F.in[I_WED] + (size_t)e * 512 * 2048; c.WT = ws + WS_W_ED_T + (size_t)e * 2048 * 512; c.scale = F8_SD; c.K = 512; c.N = 2048; c.drow0 = 64 * nb; c.k0 = 64 * kb; c.n0 = 64 * nb; }
    return c;
}
__device__ __forceinline__ void convert_chunk(Ctx& F, int chunk) {
    LAS float* scr = (LAS float*)(F.lds + F.wave * TR_SCR);
    int lane = F.lane; asm volatile("" : "+v"(lane));
    const int it0 = chunk * 32 + F.wave * 4;
#pragma unroll 1
    for (int i = 0; i < 4; i += 2) { const CvItem a = cv_decode(F, it0 + i), b = cv_decode(F, it0 + i + 1);
        transpose_pair_f8(CvItemF8{a.W, a.WT, a.K, a.N, a.drow0, a.k0, a.n0, a.scale}, CvItemF8{b.W, b.WT, b.K, b.N, b.drow0, b.k0, b.n0, b.scale}, scr, lane); }
}
__device__ __forceinline__ int queue_take(Ctx& F, unsigned* head) {
    volatile LAS int* slot = (volatile LAS int*)(F.lds + MISC_OFF + 64);
    __syncthreads();
    if (F.tid == 0) *slot = (int)__hip_atomic_fetch_add(head, 1u, RLX_AGENT);
    __syncthreads();
    return *slot;
}

__device__ __forceinline__ void fill_mod_tables(Ctx& F, const float* gain, int shift_off, int scale_off, bool from_partials, int bsel = -1) {
    LAS float* A = (LAS float*)F.lds; LAS float* Bt = (LAS float*)(F.lds + 16384);
    const float* modp = (const float*)(F.ws + WS_MODP); const float* modf = (const float*)(F.ws + WS_MOD); const float* bada = F.in[I_BADA];
    const int lo = bsel < 0 ? 0 : bsel * 2048, hi = bsel < 0 ? 4096 : lo + 2048;
    for (int idx = lo + F.tid; idx < hi; idx += 512) {
        const int b = idx >> 11, c = idx & 2047;
        float sh, scl;
        if (from_partials) {
            sh = bada[shift_off + c]; scl = bada[scale_off + c];
#pragma unroll 16
            for (int ks = 0; ks < 32; ++ks) { sh += modp[((size_t)ks * 2 + b) * 12288 + shift_off + c]; scl += modp[((size_t)ks * 2 + b) * 12288 + scale_off + c]; }
        } else { sh = modf[b * 12288 + shift_off + c]; scl = modf[b * 12288 + scale_off + c]; }
        A[idx] = gain[c] * (1.0f + scl); Bt[idx] = sh;
    }
    __syncthreads();
}

__device__ __forceinline__ void p1_norm(Ctx& F) {
    { const float* modp = (const float*)(F.ws + WS_MODP); float* modf = (float*)(F.ws + WS_MOD); const float* bada = F.in[I_BADA];
      for (int idx = F.blk * 512 + F.tid; idx < 2 * 12288; idx += F.G * 512) { const int b = idx / 12288, j = idx % 12288; float s = bada[j];
#pragma unroll 8
          for (int ks = 0; ks < 32; ++ks) s += modp[((size_t)ks * 2 + b) * 12288 + j];
          modf[idx] = s; } }
    const int rpb = T / F.G;
    const bool one_batch = (F.G * rpb == T) && (SEQ % rpb == 0);
    const int row_lo = one_batch ? F.blk * rpb : 0, row_hi = one_batch ? row_lo + rpb : T, rstep = one_batch ? 8 : F.G * 8, r0 = one_batch ? row_lo + F.wave : F.blk * 8 + F.wave;
    fill_mod_tables(F, F.in[I_GMIX], 0, 2048, true, one_batch ? row_lo / SEQ : -1);
    const LAS float* A = (const LAS float*)F.lds; const LAS float* Bt = (const LAS float*)(F.lds + 16384);
    const float* x = F.in[I_X]; bf16_t* H = (bf16_t*)(F.ws + WS_H);
    for (int row = r0; row < row_hi; row += 2 * rstep) {
        const int row2 = row + rstep; const bool has2 = row2 < row_hi;
        const int b = row / SEQ, b2 = has2 ? row2 / SEQ : b;
        const f32x4* xr = (const f32x4*)(x + (size_t)row * 2048) + F.lane;
        const f32x4* xr2 = (const f32x4*)(x + (size_t)(has2 ? row2 : row) * 2048) + F.lane;
        f32x4 v[8], v2[8]; float ss = 0.f, ss2 = 0.f;
#pragma unroll
        for (int j = 0; j < 8; ++j) { v[j] = __builtin_nontemporal_load(xr + 64 * j); v2[j] = __builtin_nontemporal_load(xr2 + 64 * j); }
#pragma unroll
        for (int j = 0; j < 8; ++j) { ss += (v[j].x * v[j].x + v[j].y * v[j].y) + (v[j].z * v[j].z + v[j].w * v[j].w); ss2 += (v2[j].x * v2[j].x + v2[j].y * v2[j].y) + (v2[j].z * v2[j].z + v2[j].w * v2[j].w); }
        const float rstd = 1.0f / sqrtf(wave_sum(ss) * (1.0f / 2048.0f) + RMS_EPS), rstd2 = 1.0f / sqrtf(wave_sum(ss2) * (1.0f / 2048.0f) + RMS_EPS);
        unsigned long long* o8 = (unsigned long long*)(H + (size_t)row * 2048) + F.lane;
        unsigned long long* o82 = (unsigned long long*)(H + (size_t)row2 * 2048) + F.lane;
#pragma unroll
        for (int j = 0; j < 8; ++j) { const int c = 4 * F.lane + 256 * j;
            const f32x4 a = *(const LAS f32x4*)(A + b * 2048 + c), sft = *(const LAS f32x4*)(Bt + b * 2048 + c);
            const f32x4 y = v[j] * rstd * a + sft;
            if constexpr (P2F8) ((unsigned*)((unsigned char*)H + (size_t)row * 2048))[F.lane + 64 * j] = epi::pack4_f8(y.x * F8_SH, y.y * F8_SH, y.z * F8_SH, y.w * F8_SH);
            else o8[64 * j] = (unsigned long long)cvtpk(y.x, y.y) | ((unsigned long long)cvtpk(y.z, y.w) << 32);
            if (has2) { const f32x4 a2 = *(const LAS f32x4*)(A + b2 * 2048 + c), sft2 = *(const LAS f32x4*)(Bt + b2 * 2048 + c);
                const f32x4 y2 = v2[j] * rstd2 * a2 + sft2;
                if constexpr (P2F8) ((unsigned*)((unsigned char*)H + (size_t)row2 * 2048))[F.lane + 64 * j] = epi::pack4_f8(y2.x * F8_SH, y2.y * F8_SH, y2.z * F8_SH, y2.w * F8_SH);
                else o82[64 * j] = (unsigned long long)cvtpk(y2.x, y2.y) | ((unsigned long long)cvtpk(y2.z, y2.w) << 32); } }
    }
}

__device__ __forceinline__ void p3_kmean(Ctx& F) {
    const bf16_t* KMT = (const bf16_t*)(F.ws + WS_KMT); float* KM = (float*)(F.ws + WS_KMEAN);
    LAS float* red = (LAS float*)F.lds;
    for (int item = F.blk; item < 512; item += F.G) {
        const int b = item >> 8, h = (item >> 5) & 7, n = item & 31;
        const int cp = F.tid & 63, rg = F.tid >> 6;
        const bf16_t* base = KMT + (((size_t)h * 256 + b * 128 + 4 * n) * 64 + 32 * rg) * 128 + 2 * cp;
        float s0 = 0.f, s1 = 0.f;
#pragma unroll 8
        for (int rr = 0; rr < 32; ++rr) { const unsigned u = *(const unsigned*)(base + (size_t)rr * 128); s0 += bf_lo(u); s1 += bf_hi(u); }
        __syncthreads();
        red[rg * 128 + 2 * cp] = s0; red[rg * 128 + 2 * cp + 1] = s1;
        __syncthreads();
        if (F.tid < 128) { float s = 0.f;
#pragma unroll
            for (int g = 0; g < 8; ++g) s += red[g * 128 + F.tid];
            KM[(size_t)item * 128 + F.tid] = s * (1.0f / 256.0f); }
    }
    __syncthreads();
}

__device__ __forceinline__ void p4_gating(Ctx& F) {
    const bf16_t* QM = (const bf16_t*)(F.ws + WS_QM); const float* KM = (const float*)(F.ws + WS_KMEAN);
    float* ML = (float*)(F.ws + WS_ML); int* MLIST = (int*)(F.ws + WS_MLIST); unsigned* mcnt = F.ctl + CW_MCNT;
    for (int grp = F.blk; grp < T / 64; grp += F.G) {
        const int h = F.wave, tok = grp * 64 + F.lane, b = tok / SEQ, qs = tok % SEQ, cur = qs >> 8;
        const int curu = __builtin_amdgcn_readfirstlane(cur), bu = __builtin_amdgcn_readfirstlane(b);
        float q[128];
        const u32x4* qp = (const u32x4*)(QM + (size_t)tok * 1024 + h * 128);
#pragma unroll
        for (int i = 0; i < 16; ++i) { const u32x4 u = qp[i]; q[8 * i + 0] = bf_lo(u.x); q[8 * i + 1] = bf_hi(u.x); q[8 * i + 2] = bf_lo(u.y); q[8 * i + 3] = bf_hi(u.y);
            q[8 * i + 4] = bf_lo(u.z); q[8 * i + 5] = bf_hi(u.z); q[8 * i + 6] = bf_lo(u.w); q[8 * i + 7] = bf_hi(u.w); }
        float v0 = -INFINITY, v1 = -INFINITY, v2 = -INFINITY; int i0 = -1, i1 = -1, i2 = -1;
        const float* kmb = KM + (size_t)((bu * 8 + h) * 32) * 128;
        for (int n = 0; n < curu; ++n) {
            const float* km = kmb + n * 128;
            float a0 = 0.f, a1 = 0.f, a2 = 0.f, a3 = 0.f;
#pragma unroll
            for (int d = 0; d < 128; d += 4) { a0 += q[d] * km[d]; a1 += q[d + 1] * km[d + 1]; a2 += q[d + 2] * km[d + 2]; a3 += q[d + 3] * km[d + 3]; }
            const float s = (a0 + a1) + (a2 + a3);
            if (s > v0) { v2 = v1; i2 = i1; v1 = v0; i1 = i0; v0 = s; i0 = n; }
            else if (s > v1) { v2 = v1; i2 = i1; v1 = s; i1 = n; }
            else if (s > v2) { v2 = s; i2 = n; }
        }
        float* ml = ML + ((size_t)tok * 8 + h) * 8;
        if (i0 < 0) *(f32x2*)(ml + 0) = (f32x2){-INFINITY, 0.f};
        if (i1 < 0) *(f32x2*)(ml + 2) = (f32x2){-INFINITY, 0.f};
        if (i2 < 0) *(f32x2*)(ml + 4) = (f32x2){-INFINITY, 0.f};
        for (int n = 0; n < curu; ++n) {
            const bool hit = (i0 == n) || (i1 == n) || (i2 == n);
            const unsigned long long mask = __ballot(hit);
            if (mask) {
                const int cntw = __popcll(mask);
                unsigned base = 0;
                if (F.lane == 0) base = __hip_atomic_fetch_add(mcnt + ((bu * 8 + h) * 32 + n), (unsigned)cntw, RLX_AGENT);
                base = __builtin_amdgcn_readfirstlane(base);
                if (hit) { const int pos = base + __popcll(mask & ((1ull << F.lane) - 1ull)); const int slot = (i0 == n) ? 0 : ((i1 == n) ? 1 : 2);
                    MLIST[(size_t)((bu * 8 + h) * 32 + n) * 8192 + pos] = (qs << 2) | slot; }
            }
        }
    }
}

__device__ __forceinline__ void p6_merge(Ctx& F) {
    const bf16_t* PARTS = (const bf16_t*)(F.ws + WS_PARTS); const float* ML = (const float*)(F.ws + WS_ML); bf16_t* AM = (bf16_t*)(F.ws + WS_AM);
    const int gw = F.blk * 8 + F.wave, NGW = F.G * 8;
    for (int tok = gw; tok < T; tok += NGW) {
        f32x4 ml01[2], ml23[2]; u32x4 pu[2][4];
#pragma unroll
        for (int i = 0; i < 2; ++i) {
            const int item = F.lane + 64 * i, h = item >> 4, ch = item & 15;
            const float* ml = ML + ((size_t)tok * 8 + h) * 8;
            ml01[i] = *(const f32x4*)ml; ml23[i] = *(const f32x4*)(ml + 4);
            const bf16_t* pb = PARTS + (((size_t)tok * 8 + h) * 4) * 128 + ch * 8;
#pragma unroll
            for (int s4 = 0; s4 < 4; ++s4) pu[i][s4] = __builtin_nontemporal_load((const u32x4*)(pb + s4 * 128));
        }
#pragma unroll
        for (int i = 0; i < 2; ++i) {
            const int item = F.lane + 64 * i, h = item >> 4, ch = item & 15;
            const float m0 = ml01[i][0], l0 = ml01[i][1], m1 = ml01[i][2], l1 = ml01[i][3], m2 = ml23[i][0], l2 = ml23[i][1], m3 = ml23[i][2], l3 = ml23[i][3];
            const float M = fmaxf(fmaxf(m0, m1), fmaxf(m2, m3));
            const float w0 = l0 * fast_exp2(m0 - M), w1 = l1 * fast_exp2(m1 - M), w2 = l2 * fast_exp2(m2 - M), w3 = l3 * fast_exp2(m3 - M);
            const float inv = 1.0f / (w0 + w1 + w2 + w3);
            float acc[8];
#pragma unroll
            for (int j = 0; j < 8; ++j) acc[j] = 0.f;
            const float ws4[4] = {w0, w1, w2, w3};
#pragma unroll
            for (int s4 = 0; s4 < 4; ++s4) {
                const float w = ws4[s4]; u32x4 u = pu[i][s4];
                if (!(w > 0.f)) u = (u32x4){0u, 0u, 0u, 0u};
                acc[0] += w * bf_lo(u.x); acc[1] += w * bf_hi(u.x); acc[2] += w * bf_lo(u.y); acc[3] += w * bf_hi(u.y);
                acc[4] += w * bf_lo(u.z); acc[5] += w * bf_hi(u.z); acc[6] += w * bf_lo(u.w); acc[7] += w * bf_hi(u.w);
            }
            if constexpr (O78F8) { const float i8 = inv * F8_SAM;
                *(u32x2*)((unsigned char*)AM + (size_t)tok * 1024 + h * 128 + ch * 8) = (u32x2){epi::pack4_f8(acc[0] * i8, acc[1] * i8, acc[2] * i8, acc[3] * i8), epi::pack4_f8(acc[4] * i8, acc[5] * i8, acc[6] * i8, acc[7] * i8)}; }
            else { u32x4 o; o.x = cvtpk(acc[0] * inv, acc[1] * inv); o.y = cvtpk(acc[2] * inv, acc[3] * inv); o.z = cvtpk(acc[4] * inv, acc[5] * inv); o.w = cvtpk(acc[6] * inv, acc[7] * inv);
            *(u32x4*)(AM + (size_t)tok * 1024 + h * 128 + ch * 8) = o; }
        }
    }
}
constexpr int P9_RSTD = 32768, P9_LG = 33792, P9_LGROW = 68, P9_LCNT = P9_LG + 2 * 64 * P9_LGROW * 4, P9_LBASE = P9_LCNT + 256, P9_END = P9_LBASE + 256;
static_assert(P9_END <= RING_BYTES, "P9 LDS");
__device__ __forceinline__ void p9_route(Ctx& F) {
    fill_mod_tables(F, F.in[I_GFFN], 6144, 8192, false);
    const LAS float* A2 = (const LAS float*)F.lds; const LAS float* B2 = (const LAS float*)(F.lds + 16384);
    LAS float* rstd_l = (LAS float*)(F.lds + P9_RSTD); LAS float* LG = (LAS float*)(F.lds + P9_LG);
    LAS int* lcnt = (LAS int*)(F.lds + P9_LCNT); LAS int* lbase = (LAS int*)(F.lds + P9_LBASE);
    const bf16_t* x1 = (const bf16_t*)(F.ws + WS_X1); bf16_t* H2 = (bf16_t*)(F.ws + WS_H2); unsigned char* H2F8 = F.ws + WS_H2F8;
    const bf16_t* WRH = (const bf16_t*)(F.ws + WS_WR); const bf16_t* WRL = WRH + 64 * 2048;
    const float* rbias = F.in[I_RBIAS];
    int* ELIST = (int*)(F.ws + WS_ELIST); int* TOKE = (int*)(F.ws + WS_TOKE); float* TOKW = (float*)(F.ws + WS_TOKW);
    unsigned* ecnt = F.ctl + CW_ECNT;
    for (int grp = F.blk; grp < T / 64; grp += F.G) {
        const int tokb = grp * 64, b = tokb / SEQ;
        if (F.tid < 64) lcnt[F.tid] = 0;
        for (int i = 0; i < 8; i += 4) {
            const int tl = F.wave * 8 + i;
            u32x4 va[4][4];
#pragma unroll
            for (int q = 0; q < 4; ++q) { const u32x4* xr = (const u32x4*)(x1 + (size_t)(tokb + tl + q) * 2048) + F.lane;
#pragma unroll
                for (int j = 0; j < 4; ++j) va[q][j] = xr[64 * j]; }
#pragma unroll
            for (int q = 0; q < 4; ++q) { float ss = 0.f;
#pragma unroll
                for (int j = 0; j < 4; ++j) { const u32x4 u = va[q][j];
                    const float a0 = bf_lo(u.x), a1 = bf_hi(u.x), a2 = bf_lo(u.y), a3 = bf_hi(u.y), a4 = bf_lo(u.z), a5 = bf_hi(u.z), a6 = bf_lo(u.w), a7 = bf_hi(u.w);
                    ss += ((a0 * a0 + a1 * a1) + (a2 * a2 + a3 * a3)) + ((a4 * a4 + a5 * a5) + (a6 * a6 + a7 * a7)); }
                ss = wave_sum(ss);
                if (F.lane == 0) rstd_l[tl + q] = 1.0f / sqrtf(ss * (1.0f / 2048.0f) + RMS_EPS); }
        }
        __syncthreads();
        {
            const int tg = F.wave & 3, kh = F.wave >> 2, tc = F.lane & 15, kg = F.lane >> 4;
            const int tl = 16 * tg + tc; const float rs = rstd_l[tl];
            const bf16_t* xrow = x1 + (size_t)(tokb + tl) * 2048;
            bf16_t* hrow = H2 + (size_t)(tokb + tl) * 2048;
            f32x4 acc[4];
#pragma unroll
            for (int nt = 0; nt < 4; ++nt) acc[nt] = (f32x4){0.f, 0.f, 0.f, 0.f};
#pragma unroll 2
            for (int s = 32 * kh; s < 32 * kh + 32; ++s) {
                const int c0 = 32 * s + 8 * kg;
                const u32x4 xu = *(const u32x4*)(xrow + c0);
                const f32x4 xa = {bf_lo(xu.x), bf_hi(xu.x), bf_lo(xu.y), bf_hi(xu.y)}, xb = {bf_lo(xu.z), bf_hi(xu.z), bf_lo(xu.w), bf_hi(xu.w)};
                const f32x4 aa = *(const LAS f32x4*)(A2 + b * 2048 + c0), ab = *(const LAS f32x4*)(A2 + b * 2048 + c0 + 4);
                const f32x4 ba = *(const LAS f32x4*)(B2 + b * 2048 + c0), bb = *(const LAS f32x4*)(B2 + b * 2048 + c0 + 4);
                const f32x4 ya = xa * rs * aa + ba, yb = xb * rs * ab + bb;
                u32x4 hi; hi.x = cvtpk(ya[0], ya[1]); hi.y = cvtpk(ya[2], ya[3]); hi.z = cvtpk(yb[0], yb[1]); hi.w = cvtpk(yb[2], yb[3]);
                *(u32x2*)(H2F8 + (size_t)(tokb + tl) * 2048 + c0) = (u32x2){epi::pack4_f8(ya[0] * F8_SH, ya[1] * F8_SH, ya[2] * F8_SH, ya[3] * F8_SH), epi::pack4_f8(yb[0] * F8_SH, yb[1] * F8_SH, yb[2] * F8_SH, yb[3] * F8_SH)};
                u32x4 lo; lo.x = cvtpk(ya[0] - bf_lo(hi.x), ya[1] - bf_hi(hi.x)); lo.y = cvtpk(ya[2] - bf_lo(hi.y), ya[3] - bf_hi(hi.y));
                lo.z = cvtpk(yb[0] - bf_lo(hi.z), yb[1] - bf_hi(hi.z)); lo.w = cvtpk(yb[2] - bf_lo(hi.w), yb[3] - bf_hi(hi.w));
                const bf16x8 hf = __builtin_bit_cast(bf16x8, hi), lf = __builtin_bit_cast(bf16x8, lo);
#pragma unroll
                for (int nt = 0; nt < 4; ++nt) {
                    const bf16x8 wh = *(const bf16x8*)(WRH + (size_t)(16 * nt + tc) * 2048 + c0), wl = *(const bf16x8*)(WRL + (size_t)(16 * nt + tc) * 2048 + c0);
                    acc[nt] = __builtin_amdgcn_mfma_f32_16x16x32_bf16(wh, hf, acc[nt], 0, 0, 0);
                    acc[nt] = __builtin_amdgcn_mfma_f32_16x16x32_bf16(wh, lf, acc[nt], 0, 0, 0);
                    acc[nt] = __builtin_amdgcn_mfma_f32_16x16x32_bf16(wl, hf, acc[nt], 0, 0, 0);
                }
            }
#pragma unroll
            for (int nt = 0; nt < 4; ++nt) *(LAS f32x4*)(LG + (kh * 64 + tl) * P9_LGROW + 16 * nt + 4 * kg) = acc[nt];
        }
        __syncthreads();
        int se[8], sslot[8]; float sw[8];
        if (F.tid < 64) {
            LAS float* row0 = LG + F.tid * P9_LGROW; const LAS float* row1 = LG + (64 + F.tid) * P9_LGROW;
            float sl[64];
#pragma unroll
            for (int e = 0; e < 64; ++e) { const float s = sigmoidf_(row0[e] + row1[e]); row0[e] = s; sl[e] = s + rbias[e]; }
            float gs[8];
#pragma unroll
            for (int g = 0; g < 8; ++g) { float m1 = -INFINITY, m2 = -INFINITY;
#pragma unroll
                for (int j = 0; j < 8; ++j) { const float v = sl[8 * g + j]; if (v > m1) { m2 = m1; m1 = v; } else if (v > m2) m2 = v; }
                gs[g] = m1 + m2; }
            unsigned gmask = 0u;
#pragma unroll
            for (int it = 0; it < 4; ++it) { float best = -INFINITY; int bi = 0;
#pragma unroll
                for (int g = 0; g < 8; ++g) { const bool free_ = !((gmask >> g) & 1u); if (free_ && gs[g] > best) { best = gs[g]; bi = g; } }
                gmask |= 1u << bi; }
            unsigned long long picked = 0ull; float wsum = 0.f;
#pragma unroll
            for (int it = 0; it < 8; ++it) { float best = -INFINITY; int bi = 0;
#pragma unroll
                for (int e = 0; e < 64; ++e) { const bool ok = ((gmask >> (e >> 3)) & 1u) && !((picked >> e) & 1ull); if (ok && sl[e] > best) { best = sl[e]; bi = e; } }
                picked |= 1ull << bi; se[it] = bi; const float s = row0[bi]; sw[it] = s; wsum += s; }
            const float inv = 2.5f / wsum;
#pragma unroll
            for (int k = 0; k < 8; ++k) { sw[k] *= inv; sslot[k] = __hip_atomic_fetch_add(lcnt + se[k], 1, __ATOMIC_RELAXED, __HIP_MEMORY_SCOPE_WORKGROUP); }
        }
        __syncthreads();
        if (F.tid < 64) { const int c = lcnt[F.tid]; lbase[F.tid] = c > 0 ? (int)__hip_atomic_fetch_add(ecnt + F.tid, (unsigned)c, RLX_AGENT) : 0; }
        __syncthreads();
        if (F.tid < 64) { const int tok = tokb + F.tid;
#pragma unroll
            for (int k = 0; k < 8; ++k) { const int slot = lbase[se[k]] + sslot[k];
                ELIST[(size_t)se[k] * 16384 + slot] = tok; TOKE[tok * 8 + k] = (se[k] << 16) | slot; TOKW[tok * 8 + k] = sw[k]; } }
        __syncthreads();
    }
}

constexpr int MT_CNT = 0, MT_TST = 256, MT_COFF = 768, MT_GTAB = 2048;
__device__ __forceinline__ void moe_tables(Ctx& F) {
    LAS int* cnt = (LAS int*)(F.lds + LDSX_OFF + MT_CNT); LAS int* tst = (LAS int*)(F.lds + LDSX_OFF + MT_TST); LAS int* coff = (LAS int*)(F.lds + LDSX_OFF + MT_COFF);
    if (F.tid < 64) cnt[F.tid] = (int)__hip_atomic_load(F.ctl + CW_ECNT + F.tid, RLX_AGENT);
    __syncthreads();
    if (F.tid == 0) { int t = 0, c = 0; for (int e = 0; e < 64; ++e) { tst[e] = t; coff[e] = c; const int n = cnt[e]; t += (n + 255) >> 8; c += n; } tst[64] = t; coff[64] = c; }
    __syncthreads();
}
struct MoeSched {
    const LAS int* cnt; const LAS int* tst; const LAS int* coff; int G, c, npn_log2; const char* A; const char* B; size_t a_tile_bytes, b_exp_bytes, b_tile_bytes; bool compact;
    __device__ __forceinline__ bool next(int i, pg8::Unit& u) const {
        const int ntile = tst[64];
        const long L = (long)i * G + c; if (L >= ((long)ntile << npn_log2)) return false;
        const int rt = (int)(L >> npn_log2), pn = (int)(L & ((1 << npn_log2) - 1));
        int lo = 0, hi = 64;
#pragma unroll
        for (int s = 0; s < 6; ++s) { const int mid = (lo + hi) >> 1; if (tst[mid] <= rt) lo = mid; else hi = mid; }
        int e = lo;
        e = __builtin_amdgcn_readfirstlane(e);
        const int j = rt - __builtin_amdgcn_readfirstlane(tst[e]);
        const int n = __builtin_amdgcn_readfirstlane(cnt[e]);
        u.pm = rt; u.pn = pn; u.aux = e;
        u.valid = (n - 256 * j) < 256 ? (n - 256 * j) : 256;
        u.rowbase = compact ? (__builtin_amdgcn_readfirstlane(coff[e]) + 256 * j) : rt * 256;
        u.A = A + (size_t)rt * a_tile_bytes; u.B = B + (size_t)e * b_exp_bytes + (size_t)pn * b_tile_bytes;
        return true;
    }
};

__device__ __forceinline__ void p12_combine(Ctx& F) {
    moe_tables(F);
    const LAS int* coff = (const LAS int*)(F.lds + LDSX_OFF + MT_COFF);
    const unsigned char* Y = (const unsigned char*)(F.ws + WS_Y); const int* TOKE = (const int*)(F.ws + WS_TOKE); const float* TOKW = (const float*)(F.ws + WS_TOKW);
    const float* modf = (const float*)(F.ws + WS_MOD); const float* gfin = F.in[I_GFINAL]; const bf16_t* SHOUT = (const bf16_t*)(F.ws + WS_SHOUT);
    float* out = F.out;
    const int gw = F.blk * 8 + F.wave, NGW = F.G * 8;
    for (int tok = gw; tok < T; tok += NGW) {
        const int b = tok / SEQ;
        f32x4 acc[8];
        int es8[8]; float w8[8];
#pragma unroll
        for (int k = 0; k < 8; ++k) { es8[k] = TOKE[tok * 8 + k]; w8[k] = TOKW[tok * 8 + k]; }
        f32x4* xr = (f32x4*)(out + (size_t)tok * 2048) + F.lane;
        f32x4 v[8];
        { const unsigned long long* x1r = (const unsigned long long*)((const bf16_t*)(F.ws + WS_X1) + (size_t)tok * 2048) + F.lane;
#pragma unroll
          for (int j = 0; j < 8; ++j) { const unsigned long long u = __builtin_nontemporal_load(x1r + 64 * j); const unsigned lo = (unsigned)u, hi = (unsigned)(u >> 32);
              v[j] = (f32x4){bf_lo(lo), bf_hi(lo), bf_lo(hi), bf_hi(hi)}; } }
        { const unsigned long long* sr = (const unsigned long long*)(SHOUT + (size_t)tok * 2048) + F.lane;
#pragma unroll
          for (int j = 0; j < 8; ++j) { const unsigned long long u = __builtin_nontemporal_load(sr + 64 * j); const unsigned lo = (unsigned)u, hi = (unsigned)(u >> 32);
              acc[j].x = bf_lo(lo); acc[j].y = bf_hi(lo); acc[j].z = bf_lo(hi); acc[j].w = bf_hi(hi); } }
#pragma unroll
        for (int kk = 0; kk < 8; kk += 4) {
            unsigned yu[4][8];
#pragma unroll
            for (int k = 0; k < 4; ++k) { const int e = es8[kk + k] >> 16, slot = es8[kk + k] & 0xffff;
                const unsigned* yr = (const unsigned*)(Y + (size_t)(coff[e] + slot) * 2048) + F.lane;
#pragma unroll
                for (int j = 0; j < 8; ++j) yu[k][j] = __builtin_nontemporal_load(yr + 64 * j); }
#pragma unroll
            for (int k = 0; k < 4; ++k) { const float w = w8[kk + k];
#pragma unroll
                for (int j = 0; j < 8; ++j) { const int u = (int)yu[k][j]; const f32x2 lo = __builtin_amdgcn_cvt_pk_f32_fp8(u, false), hi = __builtin_amdgcn_cvt_pk_f32_fp8(u, true);
                    acc[j].x += w * lo[0]; acc[j].y += w * lo[1]; acc[j].z += w * hi[0]; acc[j].w += w * hi[1]; } }
        }
        float ss = 0.f;
#pragma unroll
        for (int j = 0; j < 8; ++j) { const int c = 4 * F.lane + 256 * j; const f32x4 g2 = *(const f32x4*)(modf + b * 12288 + 10240 + c);
            v[j] = v[j] + g2 * acc[j]; ss += (v[j].x * v[j].x + v[j].y * v[j].y) + (v[j].z * v[j].z + v[j].w * v[j].w); }
        const float rstd = 1.0f / sqrtf(wave_sum(ss) * (1.0f / 2048.0f) + RMS_EPS);
#pragma unroll
        for (int j = 0; j < 8; ++j) { const int c = 4 * F.lane + 256 * j; const f32x4 g = *(const f32x4*)(gfin + c); __builtin_nontemporal_store(v[j] * rstd * g, xr + 64 * j); }
    }
}
struct Args { const float* in[22]; float* out; unsigned char* ws; int ph_lo, ph_hi; };
static_assert(sizeof(Args) == 22 * 8 + 8 + 8 + 8, "Args has no padding");

__global__ void __launch_bounds__(512, 2) fwd_kernel(Args args) {
    extern __shared__ __attribute__((aligned(16))) unsigned char lds_raw[];
    Ctx F;
    F.lds = (LAS unsigned char*)lds_raw;
    F.tid = threadIdx.x; F.lane = F.tid & 63; F.wave = __builtin_amdgcn_readfirstlane(F.tid >> 6);
    F.G = gridDim.x; F.blk = blockIdx.x;
    F.ws = args.ws; F.ctl = (unsigned*)(args.ws + WS_CTL); F.out = args.out;
    F.in = args.in;
    volatile LAS unsigned* MISC = (volatile LAS unsigned*)(F.lds + MISC_OFF);
    if (F.tid < 32) MISC[F.tid] = 0u;
    __syncthreads();
    XcdBarrier bar; bar.bar = F.ctl + CW_BAR; bar.x = 0; bar.st = nullptr;
    if (MK_N_LAUNCHES == 1) bar = xcd_barrier_post(F.ctl + CW_BAR, MISC + 8);
    const int lo = args.ph_lo, hi = args.ph_hi;
    unsigned char* ws = args.ws;
#define IN(k) (lo <= (k) && (k) < hi && ((PHASE_MASK >> (k)) & 1u))
#define SEAM(k) do { if (MK_N_LAUNCHES == 1 && (k) + 1 < hi) xcd_barrier(bar); } while (0)
#define NREP(k) (((REP_MASK >> (k)) & 1u) ? 2 : 1)
    typedef pg8::StaticOrder SO;

    if (lo <= 0 && 0 < hi) { if (IN(0)) { for (int rep_ = 0; rep_ < NREP(0); ++rep_) { if (rep_) xcd_barrier(bar); p0_prologue(F); } } SEAM(0); }
    if (lo <= 1 && 1 < hi) { if (IN(1)) { for (int rep_ = 0; rep_ < NREP(1); ++rep_) { if (rep_) xcd_barrier(bar); p1_norm(F); } } SEAM(1); }
    if (lo <= 2 && 2 < hi) {
        if (IN(2)) {
#pragma unroll 1
        for (int rep_ = 0; rep_ < NREP(2); ++rep_) { if (rep_) xcd_barrier(bar);
            const char* H = (const char*)(ws + WS_H); const char* W = (const char*)(ws + WS_W_IN_T);
            constexpr int KP = P2F8 ? 1024 : 2048;
            { SO S; S.init(H, W, T, 8192, KP, F.G, F.blk);
              epi::ProjEpi E{epi::StoreQK8{ws + WS_QD, ws + WS_KDT, att::D8_QS, att::D8_KS}, epi::StoreQKboth{epi::StoreQK{(bf16_t*)(ws + WS_QM), (bf16_t*)(ws + WS_KMT), 1.0f}, ws + WS_QM8, ws + WS_KMT8}, epi::StoreBf16<1>{(bf16_t*)(ws + WS_GATES), 4096}};
              pg8::gemm_phase<epi::ProjEpi, SO, true, true, false, P2F8>(F.lds, KP, S, E, nullptr); }
            { SO S; S.init(W + (size_t)8192 * KP * 2, H, 2048, T, KP, F.G, F.blk); epi::ProjVT E{epi::StoreVT8{ws + WS_VDT, att::D8_VS}, epi::StoreVT8{ws + WS_VMT8, att::D8_VS}};
              pg8::gemm_phase<epi::ProjVT, SO, true, true, false, P2F8>(F.lds, KP, S, E, nullptr); }
        }
        }
        SEAM(2);
    }
    if (lo <= 3 && 3 < hi) {
        if (IN(3)) {
#pragma unroll 1
        for (int rep_ = 0; rep_ < NREP(3); ++rep_) { if (rep_) xcd_barrier(bar);
            const float* lv = F.in[I_LAMBDA];
            float d1 = 0.f, d2 = 0.f;
            for (int i = 0; i < 64; ++i) { d1 += lv[i] * lv[64 + i]; d2 += lv[128 + i] * lv[192 + i]; }
            if (F.tid == 0) *(LAS float*)(F.lds + MISC_OFF + 68) = expf(d1) - expf(d2) + 0.2f;
            {
                const int x = (int)(xb_xcc_id() & 7u);
                const bool converter = ((F.blk >> 3) & 3) == 3;
                if (converter) { for (int c = queue_take(F, F.ctl + CW_CQ); c < CV_NCHUNK; c = queue_take(F, F.ctl + CW_CQ)) { __syncthreads(); convert_chunk(F, c); } }
#pragma unroll 1
                for (int k = 0; k < 8; ++k) {
                    const int xq = (x + k) & 7;
#pragma unroll 1
                    for (int i = queue_take(F, F.ctl + CW_AQ + 64 * xq); i < 128; ) {
                        unsigned nx = 0u;
                        if (F.tid == 0) nx = __hip_atomic_fetch_add(F.ctl + CW_AQ + 64 * xq, 1u, RLX_AGENT);
                        const int bh = 2 * xq + (i & 1), qt = 63 - (i >> 1);
                        att::diff_unit8(F.lds, bh >> 3, bh & 7, qt, ws + WS_QD, ws + WS_KDT, ws + WS_VDT, (bf16_t*)(ws + WS_AD), F.in[I_SUBLN], F.in[I_RELB]);
                        { volatile LAS int* slot = (volatile LAS int*)(F.lds + MISC_OFF + 64);
                          __syncthreads(); if (F.tid == 0) *slot = (int)nx; __syncthreads(); i = *slot; }
                    }
                }
                for (int c = queue_take(F, F.ctl + CW_CQ); c < CV_NCHUNK; c = queue_take(F, F.ctl + CW_CQ)) { __syncthreads(); convert_chunk(F, c); }
            }
            __syncthreads();
            p3_kmean(F);
        }
        }
        SEAM(3);
    }
    if (lo <= 4 && 4 < hi) { if (IN(4)) p4_gating(F); SEAM(4); }
    if (lo <= 5 && 5 < hi) {
        if (IN(5)) {
#pragma unroll 1
        for (int rep_ = 0; rep_ < NREP(5); ++rep_) { if (rep_) xcd_barrier(bar);
            constexpr int MB_CPU = 2;
            LAS int* pre = (LAS int*)(F.lds + LDSX_OFF);
            const unsigned* mcnt = F.ctl + CW_MCNT;
            const int mycnt = (int)__hip_atomic_load(mcnt + F.tid, RLX_AGENT);
            pre[F.tid] = (1 + ((mycnt + 255) >> 8) + MB_CPU - 1) / MB_CPU;
            __syncthreads();
            int src = 0;
            for (int off = 1; off < 512; off <<= 1) { const int v = pre[src * 512 + F.tid] + (F.tid >= off ? pre[src * 512 + F.tid - off] : 0); pre[(src ^ 1) * 512 + F.tid] = v; src ^= 1; __syncthreads(); }
            LAS int* inc = (LAS int*)(F.lds + att::MB_INC);
            inc[F.tid] = pre[src * 512 + F.tid];
            __syncthreads();
            const int total = inc[511];
            for (int u = F.blk; u < total; u += F.G) {
                int lo_ = -1, hi_ = 511;
#pragma unroll
                for (int st = 0; st < 9; ++st) { const int mid = (lo_ + hi_) >> 1; if (inc[mid] > u) hi_ = mid; else lo_ = mid; }
                const int l = __builtin_amdgcn_readfirstlane(hi_);
                const int before = l > 0 ? __builtin_amdgcn_readfirstlane(inc[l - 1]) : 0;
                const int j = u - before;
                const int cntl = (int)__builtin_amdgcn_readfirstlane(__hip_atomic_load(mcnt + l, RLX_AGENT));
                const int nch = 1 + ((cntl + 255) >> 8);
                const int c0 = j * MB_CPU, c1 = (c0 + MB_CPU) < nch ? (c0 + MB_CPU) : nch;
                att::moba_block8(F.lds, l >> 8, (l >> 5) & 7, l & 31, (const int*)(ws + WS_MLIST) + (size_t)l * 8192, cntl, c0, c1, ws + WS_QM8, ws + WS_KMT8, ws + WS_VMT8, (bf16_t*)(ws + WS_PARTS), (float*)(ws + WS_ML), F.in[I_RELB]);
            }
            __syncthreads();
        }
        }
        SEAM(5);
    }
    if (lo <= 6 && 6 < hi) { if (IN(6)) { for (int rep_ = 0; rep_ < NREP(6); ++rep_) { if (rep_) xcd_barrier(bar); p6_merge(F); } } SEAM(6); }
    if (lo <= 7 && 7 < hi) {
        if (IN(7)) {
#pragma unroll 1
        for (int rep_ = 0; rep_ < NREP(7); ++rep_) { if (rep_) xcd_barrier(bar);
            { pg8::PairOrder S; S.init(ws + WS_AD, ws + WS_W_OD_T, ws + WS_AM, ws + WS_W_OM_T, T, 2048, O78F8 ? 512 : 1024, F.G, F.blk);
              epi::GatePair E{epi::GateMul<0>{(const bf16_t*)(ws + WS_GATES), 0, nullptr, (bf16_t*)(ws + WS_T1)}, epi::GateMul<1>{(const bf16_t*)(ws + WS_GATES), 2048, (const bf16_t*)(ws + WS_T1), (bf16_t*)(ws + WS_G)}};
              pg8::gemm_phase<epi::GatePair, pg8::PairOrder, true, true, false, O78F8>(F.lds, O78F8 ? 512 : 1024, S, E, nullptr); }
        }
        }
        SEAM(7);
    }
    if (lo <= 8 && 8 < hi) {
        if (IN(8)) {
#pragma unroll 1
        for (int rep_ = 0; rep_ < NREP(8); ++rep_) { if (rep_) xcd_barrier(bar);
            SO S; S.init(ws + WS_G, ws + WS_W_OUT_T, T, 2048, O78F8 ? 1024 : 2048, F.G, F.blk); epi::ResidBf16 E{F.in[I_X], (bf16_t*)(ws + WS_X1), (const float*)(ws + WS_MOD), 4096};
            pg8::gemm_phase<epi::ResidBf16, SO, true, true, false, O78F8>(F.lds, O78F8 ? 1024 : 2048, S, E, nullptr);
        }
        }
        SEAM(8);
    }
    if (lo <= 9 && 9 < hi) { if (IN(9)) p9_route(F); SEAM(9); }
    if (lo <= 10 && 10 < hi) {
        if (IN(10)) {
#pragma unroll 1
        for (int rep_ = 0; rep_ < NREP(10); ++rep_) { if (rep_) xcd_barrier(bar);
            moe_tables(F);
            MoeSched S{(const LAS int*)(F.lds + LDSX_OFF + MT_CNT), (const LAS int*)(F.lds + LDSX_OFF + MT_TST), (const LAS int*)(F.lds + LDSX_OFF + MT_COFF), F.G, F.blk, 2,
                       (const char*)(ws + WS_H2F8), (const char*)(ws + WS_W_EGU_T), 0, (size_t)1024 * 2048, (size_t)256 * 2048, false};
            LAS unsigned short* gtab = (LAS unsigned short*)(F.lds + LDSX_OFF + MT_GTAB);
            { const int* ELIST = (const int*)(ws + WS_ELIST); pg8::Unit u;
              for (int i = 0; i < 24 && S.next(i, u); ++i) { if (F.tid < 256) { const int j = u.pm - S.tst[u.aux]; gtab[i * 256 + F.tid] = (unsigned short)(F.tid < u.valid ? ELIST[(size_t)u.aux * 16384 + 256 * j + F.tid] : 0); } } }
            __syncthreads();
            { epi::SwiGLU8 E{ws + WS_ACT}; pg8::gemm_phase<epi::SwiGLU8, MoeSched, true, true, true, true>(F.lds, 1024, S, E, gtab); }
            { SO S2; S2.init(ws + WS_H2F8, ws + WS_W_SHGU_T, T, 1024, 1024, F.G, F.blk); epi::SwiGLU8 E{ws + WS_SHACT};
              pg8::gemm_phase<epi::SwiGLU8, SO, true, true, false, true>(F.lds, 1024, S2, E, nullptr); }
        }
        }
        SEAM(10);
    }
    if (lo <= 11 && 11 < hi) {
        if (IN(11)) {
            moe_tables(F);
            MoeSched S{(const LAS int*)(F.lds + LDSX_OFF + MT_CNT), (const LAS int*)(F.lds + LDSX_OFF + MT_TST), (const LAS int*)(F.lds + LDSX_OFF + MT_COFF), F.G, F.blk, 3,
                       (const char*)(ws + WS_ACT), (const char*)(ws + WS_W_ED_T), (size_t)256 * 512, (size_t)2048 * 512, (size_t)256 * 512, true};
#pragma unroll 1
            for (int rep_ = 0; rep_ < NREP(11); ++rep_) { if (rep_) xcd_barrier(bar);
            { epi::DownY E{(unsigned char*)(ws + WS_Y)}; pg8::gemm_phase<epi::DownY, MoeSched, true, true, false, true>(F.lds, 256, S, E, nullptr); } }
            { SO S2; S2.init(ws + WS_SHACT, ws + WS_W_SHD_T, T, 2048, 256, F.G, F.blk); epi::StoreBf16<2> E{(bf16_t*)(ws + WS_SHOUT), 2048};
              pg8::gemm_phase<epi::StoreBf16<2>, SO, true, true, false, true>(F.lds, 256, S2, E, nullptr); }
        }
        SEAM(11);
    }
    if (lo <= 12 && 12 < hi) { if (IN(12)) p12_combine(F); }
#undef IN
#undef SEAM
}

extern "C" void kernel_launch(void* const* d_in, const int* in_sizes, int n_in, void* d_out, int out_size, void* d_ws, size_t ws_size, hipStream_t stream) {
    static int grid = 0;
    if (grid == 0) {
        if (n_in != 22 || in_sizes[0] != T * D || out_size != T * D || ws_size < WS_END) { fprintf(stderr, "kernel_launch: unexpected shapes (n_in %d, in0 %d, out %d, ws %zu < %zu); nothing launched\n", n_in, n_in > 0 ? in_sizes[0] : -1, out_size, ws_size, (size_t)WS_END); grid = -1; return; }
        int dev = 0, cus = 0, per_cu = 0;
        if (hipGetDevice(&dev) != hipSuccess || hipDeviceGetAttribute(&cus, hipDeviceAttributeMultiprocessorCount, dev) != hipSuccess) { grid = -1; return; }
        if (hipFuncSetAttribute((const void*)fwd_kernel, hipFuncAttributeMaxDynamicSharedMemorySize, LDS_BYTES) != hipSuccess) { fprintf(stderr, "kernel_launch: hipFuncSetAttribute failed\n"); grid = -1; return; }
        if (hipOccupancyMaxActiveBlocksPerMultiprocessor(&per_cu, (const void*)fwd_kernel, 512, LDS_BYTES) != hipSuccess || per_cu < 1) fprintf(stderr, "kernel_launch: occupancy query says %d\n", per_cu);
        (void)hipGetLastError();
        grid = cus;
    }
    if (grid < 0) return;
    if (hipMemsetAsync((char*)d_ws + WS_CTL, 0, CTL_ZERO_BYTES, stream) != hipSuccess) { fprintf(stderr, "kernel_launch: memset failed\n"); return; }
    Args a{};
    for (int i = 0; i < 22; ++i) a.in[i] = (const float*)d_in[i];
    a.out = (float*)d_out; a.ws = (unsigned char*)d_ws;
    for (int li = 0; li < MK_N_LAUNCHES; ++li) {
        a.ph_lo = (MK_N_LAUNCHES == 1) ? 0 : li; a.ph_hi = (MK_N_LAUNCHES == 1) ? NPHASE : li + 1;
        hipLaunchKernelGGL(fwd_kernel, dim3(grid), dim3(512), LDS_BYTES, stream, a);
        const hipError_t le = hipPeekAtLastError();
        if (le != hipSuccess) { fprintf(stderr, "kernel_launch: launch %d failed: %s\n", li, hipGetErrorName(le)); break; }
    }
}
```

```cpp
#include <hip/hip_runtime.h>
#include <cstdio>
#include <cstdint>

#define LAS __attribute__((address_space(3)))
#define GAS __attribute__((address_space(1)))
typedef unsigned short bf16_t;
typedef short bf16x8 __attribute__((ext_vector_type(8)));
typedef short s16x4 __attribute__((ext_vector_type(4)));
typedef int i32x4 __attribute__((ext_vector_type(4)));
typedef int i32x8 __attribute__((ext_vector_type(8)));
typedef float f32x4 __attribute__((ext_vector_type(4)));
typedef float f32x2 __attribute__((ext_vector_type(2)));
typedef float f32x16 __attribute__((ext_vector_type(16)));
typedef unsigned u32x4 __attribute__((ext_vector_type(4)));
typedef unsigned u32x2 __attribute__((ext_vector_type(2)));
typedef __bf16 bf16x2_t __attribute__((ext_vector_type(2)));

#ifndef MK_N_LAUNCHES
#define MK_N_LAUNCHES 1
#endif
#ifndef REP_MASK
#define REP_MASK 0u
#endif
#ifndef PHASE_MASK
#define PHASE_MASK 0xFFFFFFFFu
#endif

constexpr int NB = 2, SEQ = 8192, T = NB * SEQ, D = 2048, NH = 8, INC = 10240, NE = 64, EDIM = 512, TOPK = 8;
constexpr int NPHASE = 13;
constexpr float RMS_EPS = 1e-6f;
constexpr float LOG2E = 1.4426950408889634f;

constexpr size_t MiB = 1u << 20;
constexpr size_t WS_CTL = 0, CTL_ZERO_BYTES = 1 * MiB;
constexpr size_t WS_MODP = 1 * MiB;
constexpr size_t WS_MOD = 4 * MiB;
constexpr size_t WS_KMEAN = 4 * MiB + 256 * 1024;
constexpr size_t WS_WR = 4 * MiB + 512 * 1024;
constexpr size_t WS_TOKE = 5 * MiB;
constexpr size_t WS_TOKW = 5 * MiB + 512 * 1024;
constexpr size_t WS_W_IN_T = 8 * MiB;
constexpr size_t WS_W_OD_T = 48 * MiB;
constexpr size_t WS_W_OM_T = 52 * MiB;
constexpr size_t WS_W_OUT_T = 56 * MiB;
constexpr size_t WS_W_SHGU_T = 64 * MiB;
constexpr size_t WS_W_SHD_T = 68 * MiB;
constexpr size_t WS_ELIST = 70 * MiB;
constexpr size_t WS_W_ED_T = 76 * MiB;
constexpr size_t WS_W_EGU_T = 204 * MiB;
constexpr size_t WS_H = 460 * MiB;
constexpr size_t WS_QD = 524 * MiB;
constexpr size_t WS_KDT = 556 * MiB;
constexpr size_t WS_VDT = 588 * MiB;
constexpr size_t WS_QM = 620 * MiB;
constexpr size_t WS_KMT = 652 * MiB;
constexpr size_t WS_VMT = 684 * MiB;
constexpr size_t WS_GATES = 716 * MiB;
constexpr size_t WS_AD = 844 * MiB;
constexpr size_t WS_AM = 876 * MiB;
constexpr size_t WS_ML = 908 * MiB;
constexpr size_t WS_MLIST = 912 * MiB;
constexpr size_t WS_PARTS = 460 * MiB;
constexpr size_t WS_G = 460 * MiB;
constexpr size_t WS_T1 = 524 * MiB;
constexpr size_t WS_X1 = 524 * MiB;
constexpr size_t WS_H2 = 588 * MiB;
constexpr size_t WS_ACT = 716 * MiB;
constexpr size_t WS_H2F8 = 800 * MiB;
constexpr float F8_SH = 8.0f, F8_SW = 64.0f, F8_SA = 8.0f, F8_SD = 32.0f;
namespace att { constexpr float D8_QS = 0.125f * LOG2E * 16.0f, D8_KS = 4.0f, D8_VS = 8.0f; }
constexpr size_t WS_QM8 = 604 * MiB, WS_VMT8 = 684 * MiB, WS_KMT8 = 700 * MiB;
namespace att { constexpr float MB8_QS = 0.08838834764831845f * LOG2E * 16.0f; }
constexpr bool O78F8 = true;
constexpr float F8_SAD = 16.0f, F8_SAM = 64.0f, F8_SWO = 32.0f, F8_SG = 16.0f, F8_SWOUT = 64.0f;
constexpr bool P2F8 = true;
constexpr float DS2 = 1.0f;
constexpr int P2_EXP = 9;
constexpr size_t WS_SHACT = 860 * MiB;
constexpr size_t WS_SHOUT = 588 * MiB;
constexpr size_t WS_Y = 204 * MiB;
constexpr size_t WS_END = 928 * MiB;
static_assert(WS_Y + (size_t)131072 * 2048 * 2 <= WS_ACT, "Y must not reach ACT");
static_assert(WS_ACT + (size_t)147456 * 512 * 2 <= WS_SHACT && WS_SHACT + (size_t)T * 512 * 2 <= WS_END, "act map");
static_assert(WS_PARTS + (size_t)T * 8 * 4 * 128 * 2 <= WS_VDT, "parts overlay");

constexpr int CW_BAR = 4096;
constexpr int CW_ECNT = 8192;
constexpr int CW_MCNT = 8448;
constexpr int CW_AQ = 9216;
constexpr int CW_CQ = 9216 + 64 * 8;

constexpr int RING_BYTES = 131072;
constexpr int LDSX_OFF = RING_BYTES;
constexpr int MISC_OFF = RING_BYTES + 16384;
constexpr int LDS_BYTES = MISC_OFF + 128;

#define LDS_WAIT() asm volatile("s_waitcnt lgkmcnt(0)" ::: "memory")
#define VM_WAIT() asm volatile("s_waitcnt vmcnt(0)" ::: "memory")
#define RLX_AGENT __ATOMIC_RELAXED, __HIP_MEMORY_SCOPE_AGENT

__device__ __forceinline__ unsigned cvtpk(float lo, float hi) { f32x2 v = {lo, hi}; bf16x2_t b = __builtin_convertvector(v, bf16x2_t); return __builtin_bit_cast(unsigned, b); }
__device__ __forceinline__ float bf_lo(unsigned u) { return __uint_as_float(u << 16); }
__device__ __forceinline__ float bf_hi(unsigned u) { return __uint_as_float(u & 0xffff0000u); }
__device__ __forceinline__ float wave_sum(float v) {
#pragma unroll
    for (int o = 1; o < 64; o <<= 1) v += __shfl_xor(v, o);
    return v;
}
__device__ __forceinline__ float fast_exp2(float x) { return __builtin_amdgcn_exp2f(x); }
__device__ __forceinline__ float fast_rcp(float x) { return __builtin_amdgcn_rcpf(x); }
__device__ __forceinline__ float sigmoidf_(float x) { return fast_rcp(1.0f + fast_exp2(-x * LOG2E)); }
__device__ __forceinline__ float siluf_(float x) { return x * sigmoidf_(x); }

#define XB_TMO      128
#define XB_XCNT(j)  (256  + 64 * (j))
#define XB_XSUB(j)  (1280 + 64 * (j))
#define XB_XGEN(j)  (2304 + 64 * (j))
#define XB_TOP      3328
#define XB_TOPGEN   3392
#define XCD_BAR_WORDS 3456
#define XB_SPIN_CAP (1u << 22)

__device__ __forceinline__ unsigned xb_ld(unsigned* p)              { return __hip_atomic_load(p, __ATOMIC_RELAXED, __HIP_MEMORY_SCOPE_AGENT); }
__device__ __forceinline__ unsigned xb_add(unsigned* p, unsigned v) { return __hip_atomic_fetch_add(p, v, __ATOMIC_RELAXED, __HIP_MEMORY_SCOPE_AGENT); }
__device__ __forceinline__ unsigned xb_xcc_id() { return (unsigned)__builtin_amdgcn_s_getreg((3 << 11) | 20) & 0xFu; }
#define XB_SPIN(cond, bar) do { unsigned _sp = 0; while (cond) { __builtin_amdgcn_s_sleep(1); \
    if ((++_sp & 255u) == 0u) { if (xb_ld(&(bar)[XB_TMO])) break; if (_sp > XB_SPIN_CAP) { atomicAdd(&(bar)[XB_TMO], 1u); break; } } } } while (0)

struct XcdBarrier { unsigned* bar; unsigned x; volatile LAS unsigned* st; };

__device__ __forceinline__ XcdBarrier xcd_barrier_post(unsigned* bar, volatile LAS unsigned* st) {
    XcdBarrier b; b.bar = bar; b.x = xb_xcc_id(); b.st = st;
    if (threadIdx.x == 0) (void)xb_add(&bar[XB_XCNT(b.x)], 1u);
    return b;
}
__device__ __forceinline__ void xcd_barrier_complete(unsigned* bar, unsigned x, unsigned& nloc, unsigned& nx) {
    const unsigned G = gridDim.x * gridDim.y * gridDim.z;
    unsigned sum, cnt, mine, sp = 0u;
    for (;;) {
        sum = 0u; cnt = 0u; mine = 0u;
#pragma unroll
        for (unsigned j = 0; j < 16; ++j) { const unsigned c = xb_ld(&bar[XB_XCNT(j)]); sum += c; cnt += (c > 0u) ? 1u : 0u; mine = (j == x) ? c : mine; }
        if (sum == G) break;
        __builtin_amdgcn_s_sleep(1);
        if ((++sp & 255u) == 0u) { if (xb_ld(&bar[XB_TMO])) break; if (sp > XB_SPIN_CAP) { atomicAdd(&bar[XB_TMO], 1u); break; } }
    }
    nloc = mine > 0u ? mine : 1u; nx = cnt > 0u ? cnt : 1u;
}
__device__ __forceinline__ void xcd_barrier(const XcdBarrier& b) {
    asm volatile("s_waitcnt vmcnt(0)" ::: "memory");
    __syncthreads();
    if (threadIdx.x == 0) {
        unsigned* bar = b.bar;
        __builtin_amdgcn_s_waitcnt(0);
        unsigned nloc = b.st[0], nx = b.st[1];
        if (nloc == 0u) { xcd_barrier_complete(bar, b.x, nloc, nx); b.st[0] = nloc; b.st[1] = nx; }
        const unsigned old = xb_add(&bar[XB_XSUB(b.x)], 1u);
        const unsigned gen = old / nloc;
        if (old + 1u == (gen + 1u) * nloc) {
            __builtin_amdgcn_fence(__ATOMIC_RELEASE, "agent");
            asm volatile("s_waitcnt vmcnt(0)" ::: "memory");
            const unsigned og = xb_add(&bar[XB_TOP], 1u);
            const unsigned tg = og / nx;
            if (og + 1u == (tg + 1u) * nx) xb_add(&bar[XB_TOPGEN], 1u);
            else XB_SPIN(xb_ld(&bar[XB_TOPGEN]) == tg, bar);
            __builtin_amdgcn_fence(__ATOMIC_ACQUIRE, "agent");
            xb_add(&bar[XB_XGEN(b.x)], 1u);
            asm volatile("s_waitcnt vmcnt(0)" ::: "memory");
        } else {
            XB_SPIN(xb_ld(&bar[XB_XGEN(b.x)]) == gen, bar);
            __builtin_amdgcn_fence(__ATOMIC_ACQUIRE, "agent");
            asm volatile("s_waitcnt vmcnt(0)" ::: "memory");
        }
    }
    __syncthreads();
}

namespace pg8 {
constexpr int BM = 256, BK = 64, HALF = 128, HTB = HALF * BK * 2, STAGE_BYTES = 8 * HTB, NXCD = 8, WGM = 8;
static_assert(STAGE_BYTES == RING_BYTES, "ring");
__host__ __device__ __forceinline__ int lds_byte(int r, int c) { const int st = (r >> 4) * 2 + (c >> 5), rr = r & 15, cc = c & 31, ob = rr * 64 + cc * 2; return st * 1024 + (ob ^ (((ob >> 9) & 1) << 5)); }
__host__ __device__ __forceinline__ void stage_rc(int b, int& R, int& C) { const int st = b / 1024, sb = b % 1024, swz = sb ^ (((sb >> 9) & 1) << 5); R = (st >> 1) * 16 + swz / 64; C = (st & 1) * 32 + (swz % 64) / 2; }
__host__ __device__ __forceinline__ int perm32(int rho) { const int n = rho >> 4, i = rho & 15; return 8 * (i >> 2) + 4 * n + (i & 3); }

struct Unit { int pm, pn; const char* A; const char* B; int rowbase, valid, aux; };

struct StaticOrder {
    int nM, nN, nwg, G, c; const char* A; const char* B; size_t tstep;
    __device__ void init(const void* A_, const void* B_, int M, int N, int K, int G_, int c_) { A = (const char*)A_; B = (const char*)B_; nM = M / BM; nN = N / BM; nwg = nM * nN; G = G_; c = c_; tstep = (size_t)BM * K * 2; }
    __device__ bool next(int i, Unit& u) const {
        const long L = (long)i * G + c; if (L >= nwg) return false;
        int wgid = (int)L; { const int q = nwg / NXCD, r = nwg % NXCD, xcd = wgid % NXCD, off = wgid / NXCD; wgid = (xcd < r ? xcd * (q + 1) : r * (q + 1) + (xcd - r) * q) + off; }
        const int nig = WGM * nN, gid = wgid / nig, fm = gid * WGM, gsz = (nM - fm) < WGM ? (nM - fm) : WGM;
        u.pm = fm + ((wgid % nig) % gsz); u.pn = (wgid % nig) / gsz;
        u.A = A + (size_t)u.pm * tstep; u.B = B + (size_t)u.pn * tstep; u.rowbase = u.pm * BM; u.valid = BM; u.aux = 0; return true;
    }
};

struct PairOrder {
    StaticOrder base; const char* A1; const char* B1;
    __device__ void init(const void* A0_, const void* B0_, const void* A1_, const void* B1_, int M, int N, int K, int G_, int c_) { base.init(A0_, B0_, M, N, K, G_, c_); A1 = (const char*)A1_; B1 = (const char*)B1_; }
    __device__ bool next(int i, Unit& u) const {
        if (!base.next(i >> 1, u)) return false;
        if (i & 1) { u.A = A1 + (size_t)u.pm * base.tstep; u.B = B1 + (size_t)u.pn * base.tstep; u.aux = 1; }
        return true;
    }
};

template <class Epi, class Sched, bool ALIGN_EPI, bool SP2, bool GATHER, bool F8 = false>
__device__ __forceinline__ void gemm_phase(LAS unsigned char* lds, const int K, const Sched& S, const Epi& E, const LAS unsigned short* gtab) {
    int tid_ = threadIdx.x; asm volatile("" : "+v"(tid_));
    const int tid = tid_, wid = __builtin_amdgcn_readfirstlane(tid >> 6), lane = tid & 63, wr = wid >> 2, wc = wid & 3, fr = lane & 15, fq = lane >> 4;
    const int nt = K / BK;
    unsigned voffA[2], voffB[2]; int RA[2], CA[2];
#pragma unroll
    for (int i = 0; i < 2; ++i) { int R, C; stage_rc(tid * 16 + i * 8192, R, C); const int Rb = (int)Epi::PERM == 2 ? (64 * (R >> 5) + 16 * ((R >> 2) & 3) + 4 * ((R >> 4) & 1) + (R & 3)) : (Epi::PERM ? ((R & ~31) + perm32(R & 31)) : R);
        RA[i] = R; CA[i] = C; voffA[i] = (unsigned)(R * K + C) * 2u; voffB[i] = (unsigned)(Rb * K + C) * 2u; }
    const size_t kstep = (size_t)(BK * 2);
    const size_t hstep = (size_t)HALF * K * 2;
    const size_t hstepB = (int)Epi::PERM == 2 ? (size_t)8 * K * 2 : hstep;
    const unsigned ldsw = (unsigned)wid * 1024u;
    const int aoff = lds_byte(wr * 64 + fr, fq * 8), boff = lds_byte(wc * 32 + fr, fq * 8);
    unsigned vA[2][2], nvA[2][2];
#define PG8_SA(b, h) (((b) * 2 + (h)) * HTB)
#define PG8_SB(b, h) ((4 + (b) * 2 + (h)) * HTB)
#define PG8_GL(gp, ldsoff) __builtin_amdgcn_global_load_lds((const unsigned*)(gp), (LAS unsigned*)(lds + (ldsoff)), 16, 0, 0)
#define PG8_STAGE(bufoff, gbase, voff) do { _Pragma("unroll") for (int _i = 0; _i < 2; ++_i) PG8_GL((const char*)(gbase) + (voff)[_i], (bufoff) + ldsw + _i * 8192); } while (0)
#define PG8_STA(bufoff, gbase, h, nx) do { if constexpr (GATHER) { \
        const unsigned _o0 = (nx) ? nvA[h][0] : vA[h][0], _o1 = (nx) ? nvA[h][1] : vA[h][1]; \
        PG8_GL((const char*)(gbase) + _o0, (bufoff) + ldsw); PG8_GL((const char*)(gbase) + _o1, (bufoff) + ldsw + 8192); \
    } else { PG8_STAGE(bufoff, (const char*)(gbase) + (h) * hstep, voffA); } } while (0)
#define PG8_GVA(dst, ul) do { _Pragma("unroll") for (int _h = 0; _h < 2; ++_h) _Pragma("unroll") for (int _i = 0; _i < 2; ++_i) \
        dst[_h][_i] = (unsigned)gtab[(ul) * 256 + _h * 128 + RA[_i]] * (unsigned)(K * 2) + (unsigned)(CA[_i] * 2); } while (0)
#define PG8_LDA(dst, b, h) do { _Pragma("unroll") for (int m = 0; m < 4; ++m) _Pragma("unroll") for (int k = 0; k < 2; ++k) dst[m][k] = *(const LAS bf16x8*)(lds + PG8_SA(b, h) + aoff + m * 2048 + k * 1024); } while (0)
#define PG8_LDB(dst, b, h) do { _Pragma("unroll") for (int n = 0; n < 2; ++n) _Pragma("unroll") for (int k = 0; k < 2; ++k) dst[n][k] = *(const LAS bf16x8*)(lds + PG8_SB(b, h) + boff + n * 2048 + k * 1024); } while (0)
#define PG8_MMA(ai, bj, At, Bt) do { __builtin_amdgcn_s_setprio(1); _Pragma("unroll") for (int m = 0; m < 4; ++m) _Pragma("unroll") for (int n = 0; n < 2; ++n) { \
        if constexpr (F8) { const i32x4 _b0 = __builtin_bit_cast(i32x4, Bt[n][0]), _b1 = __builtin_bit_cast(i32x4, Bt[n][1]), _a0 = __builtin_bit_cast(i32x4, At[m][0]), _a1 = __builtin_bit_cast(i32x4, At[m][1]); \
            const i32x8 _b8 = __builtin_shufflevector(_b0, _b1, 0, 1, 2, 3, 4, 5, 6, 7), _a8 = __builtin_shufflevector(_a0, _a1, 0, 1, 2, 3, 4, 5, 6, 7); \
            asm volatile("v_mfma_scale_f32_16x16x128_f8f6f4 %0, %1, %2, %0, %3, %4 op_sel_hi:[0,0,0]" : "+v"(acc[ai][bj][m][n]) : "v"(_b8), "v"(_a8), "v"(f8sc), "v"(f8one)); } \
        else { _Pragma("unroll") for (int k = 0; k < 2; ++k) acc[ai][bj][m][n] = __builtin_amdgcn_mfma_f32_16x16x32_bf16(Bt[n][k], At[m][k], acc[ai][bj][m][n], 0, 0, 0); } } __builtin_amdgcn_s_setprio(0); } while (0)
#define PG8_WAIT_V(n) asm volatile("s_waitcnt vmcnt(" #n ")" ::: "memory")
#define PG8_WAIT_L(n) asm volatile("s_waitcnt lgkmcnt(" #n ")" ::: "memory")
#define PG8_BAR __builtin_amdgcn_s_barrier()
#define PG8_SCHED __builtin_amdgcn_sched_barrier(0)
    Unit cur, nxt; int ui = 0;
    if (!S.next(0, cur)) return;
    if constexpr (GATHER) { PG8_GVA(vA, 0); }
    int f8sc = 0x7F7F7F7F;
    const int f8one = 0x7F7F7F7F;
    f32x4 acc[2][2][4][2];
#pragma unroll
    for (int a = 0; a < 2; ++a)
#pragma unroll
        for (int b = 0; b < 2; ++b)
#pragma unroll
            for (int m = 0; m < 4; ++m)
#pragma unroll
                for (int n = 0; n < 2; ++n) acc[a][b][m][n] = (f32x4){0.f, 0.f, 0.f, 0.f};
    bf16x8 At[4][2], B0[2][2], B1[2][2];
    const char* cA = cur.A; const char* cB = cur.B;
    if constexpr (SP2) {
        PG8_STAGE(PG8_SB(0, 0), cB, voffB); PG8_STAGE(PG8_SB(0, 1), cB + hstepB, voffB); PG8_STA(PG8_SA(0, 0), cA, 0, false); PG8_STA(PG8_SA(0, 1), cA, 1, false);
        if (wr == 1) PG8_BAR;
        PG8_WAIT_V(2); PG8_BAR;
        PG8_STAGE(PG8_SB(1, 0), cB + kstep, voffB); PG8_STA(PG8_SA(1, 0), cA + kstep, 0, false); PG8_STAGE(PG8_SB(1, 1), cB + hstepB + kstep, voffB);
        PG8_WAIT_V(6); PG8_BAR;
    } else {
        PG8_STAGE(PG8_SB(0, 0), cB, voffB); PG8_STA(PG8_SA(0, 0), cA, 0, false); PG8_STAGE(PG8_SB(0, 1), cB + hstepB, voffB); PG8_STA(PG8_SA(0, 1), cA, 1, false);
        if (wr == 1) PG8_BAR;
        PG8_WAIT_V(4); PG8_BAR;
        PG8_STAGE(PG8_SB(1, 0), cB + kstep, voffB); PG8_STA(PG8_SA(1, 0), cA + kstep, 0, false); PG8_STAGE(PG8_SB(1, 1), cB + hstepB + kstep, voffB);
        PG8_WAIT_V(6); PG8_BAR;
    }
    for (;;) {
        if constexpr (F8) f8sc = 0x01010101 * (127 - E.f8exp(cur));
        bool has_next = false; const char* nA = cA; const char* nB = cB;
#define PG8_NEXT_UNIT() do { has_next = S.next(ui + 1, nxt); nA = has_next ? nxt.A : cA; nB = has_next ? nxt.B : cB; \
        if constexpr (GATHER) { if (has_next) { PG8_GVA(nvA, ui + 1); } else { _Pragma("unroll") for (int _h = 0; _h < 2; ++_h) _Pragma("unroll") for (int _i = 0; _i < 2; ++_i) nvA[_h][_i] = vA[_h][_i]; } } } while (0)
        if (nt < 4 || !SP2) PG8_NEXT_UNIT();
        for (int t = 0; t < nt; t += 2) {
            const bool last = (t == nt - 2);
            const char* a1 = cA + (size_t)(t + 1) * kstep;
            const char* a2 = last ? nA : cA + (size_t)(t + 2) * kstep; const char* b2 = last ? nB : cB + (size_t)(t + 2) * kstep;
            const char* a3 = a2 + kstep; const char* b3 = b2 + kstep;
            if constexpr (SP2) {
            PG8_LDB(B0, 0, 0); PG8_LDB(B1, 0, 1); PG8_SCHED; PG8_LDA(At, 0, 0); PG8_STA(PG8_SA(1, 1), a1, 1, false);
            PG8_WAIT_V(8); PG8_WAIT_L(0); PG8_BAR; PG8_MMA(0, 0, At, B0); PG8_MMA(0, 1, At, B1); if (t == 0 && nt >= 4) { PG8_SCHED; PG8_NEXT_UNIT(); PG8_SCHED; } PG8_BAR; PG8_SCHED;
            PG8_LDA(At, 0, 1); PG8_STAGE(PG8_SB(0, 0), b2, voffB); PG8_STAGE(PG8_SB(0, 1), b2 + hstepB, voffB); PG8_STA(PG8_SA(0, 0), a2, 0, last);
            PG8_WAIT_V(8); PG8_WAIT_L(0); PG8_BAR; PG8_MMA(1, 0, At, B0); PG8_MMA(1, 1, At, B1); PG8_BAR; PG8_SCHED;
            PG8_LDB(B0, 1, 0); PG8_LDB(B1, 1, 1); PG8_SCHED; PG8_LDA(At, 1, 0); PG8_STA(PG8_SA(0, 1), a2, 1, last);
            PG8_WAIT_V(8); PG8_WAIT_L(0); PG8_BAR; PG8_MMA(0, 0, At, B0); PG8_MMA(0, 1, At, B1); PG8_BAR; PG8_SCHED;
            PG8_LDA(At, 1, 1); PG8_STAGE(PG8_SB(1, 0), b3, voffB); PG8_STAGE(PG8_SB(1, 1), b3 + hstepB, voffB); PG8_STA(PG8_SA(1, 0), a3, 0, last);
            PG8_WAIT_V(8); PG8_WAIT_L(0); PG8_BAR; PG8_MMA(1, 0, At, B0); PG8_MMA(1, 1, At, B1); PG8_BAR; PG8_SCHED;
            } else {
            PG8_LDB(B0, 0, 0); PG8_SCHED; PG8_LDA(At, 0, 0); PG8_STA(PG8_SA(1, 1), a1, 1, false);
            PG8_WAIT_L(8); PG8_BAR; PG8_WAIT_L(0); PG8_MMA(0, 0, At, B0); PG8_BAR; PG8_SCHED;
            PG8_LDB(B1, 0, 1); PG8_STAGE(PG8_SB(0, 0), b2, voffB);
            PG8_BAR; PG8_WAIT_L(0); PG8_MMA(0, 1, At, B1); PG8_BAR;
            PG8_LDA(At, 0, 1); PG8_STA(PG8_SA(0, 0), a2, 0, last);
            PG8_BAR; PG8_WAIT_L(0); PG8_MMA(1, 0, At, B0); PG8_BAR; PG8_SCHED;
            PG8_STAGE(PG8_SB(0, 1), b2 + hstepB, voffB);
            PG8_WAIT_V(6); PG8_BAR; PG8_MMA(1, 1, At, B1); PG8_BAR;
            PG8_LDB(B0, 1, 0); PG8_SCHED; PG8_LDA(At, 1, 0); PG8_STA(PG8_SA(0, 1), a2, 1, last);
            PG8_WAIT_L(8); PG8_BAR; PG8_WAIT_L(0); PG8_MMA(0, 0, At, B0); PG8_BAR; PG8_SCHED;
            PG8_LDB(B1, 1, 1); PG8_STAGE(PG8_SB(1, 0), b3, voffB);
            PG8_BAR; PG8_WAIT_L(0); PG8_MMA(0, 1, At, B1); PG8_BAR;
            PG8_LDA(At, 1, 1); PG8_STA(PG8_SA(1, 0), a3, 0, last);
            PG8_BAR; PG8_WAIT_L(0); PG8_MMA(1, 0, At, B0); PG8_BAR; PG8_SCHED;
            PG8_STAGE(PG8_SB(1, 1), b3 + hstepB, voffB);
            PG8_WAIT_V(6); PG8_BAR; PG8_MMA(1, 1, At, B1); PG8_BAR;
            }
        }
        if constexpr (F8) asm volatile("s_nop 15\n\ts_nop 15" ::: "memory");
        if constexpr (ALIGN_EPI) { if (wr == 0) PG8_BAR; }
        { int l2 = lane; asm volatile("" : "+v"(l2)); E(acc, cur, wr, wc, l2 & 15, l2 >> 4); }
        if (!has_next) break;
#pragma unroll
        for (int a = 0; a < 2; ++a)
#pragma unroll
            for (int b = 0; b < 2; ++b)
#pragma unroll
                for (int m = 0; m < 4; ++m)
#pragma unroll
                    for (int n = 0; n < 2; ++n) acc[a][b][m][n] = (f32x4){0.f, 0.f, 0.f, 0.f};
        cur = nxt; cA = nA; cB = nB; ++ui;
        if constexpr (GATHER) {
#pragma unroll
            for (int _h = 0; _h < 2; ++_h)
#pragma unroll
                for (int _i = 0; _i < 2; ++_i) vA[_h][_i] = nvA[_h][_i];
        }
        if constexpr (ALIGN_EPI) { if (wr == 1) PG8_BAR; }
    }
    PG8_WAIT_V(0);
    if constexpr (!ALIGN_EPI) { if (wr == 0) PG8_BAR; }
    PG8_BAR;
#undef PG8_SA
#undef PG8_SB
#undef PG8_GL
#undef PG8_STAGE
#undef PG8_STA
#undef PG8_GVA
#undef PG8_LDA
#undef PG8_LDB
#undef PG8_MMA
#undef PG8_WAIT_V
#undef PG8_WAIT_L
#undef PG8_BAR
#undef PG8_SCHED
}
}
namespace epi {
__device__ __forceinline__ float clamp_f8(float v) { return __builtin_fminf(__builtin_fmaxf(v, -448.0f), 448.0f); }
__device__ __forceinline__ unsigned pack4_f8(float a, float b, float c, float d) { int w = __builtin_amdgcn_cvt_pk_fp8_f32(clamp_f8(a), clamp_f8(b), 0, false); return (unsigned)__builtin_amdgcn_cvt_pk_fp8_f32(clamp_f8(c), clamp_f8(d), w, true); }
using pg8::Unit;
template <int ACT> struct StoreBf16 {
    static constexpr bool PERM = true;
    bf16_t* O; int ldc;
    __device__ __forceinline__ int f8exp(const Unit&) const { return 8; }
    __device__ __forceinline__ void operator()(const f32x4 (&acc)[2][2][4][2], const Unit& u, int wr, int wc, int fr, int fq) const {
        const int row0 = u.pm * 256 + wr * 64 + fr, col0 = u.pn * 256 + wc * 32 + 8 * fq;
#pragma unroll
        for (int ai = 0; ai < 2; ++ai)
#pragma unroll
            for (int m = 0; m < 4; ++m) { bf16_t* rowp = O + (size_t)(row0 + ai * 128 + m * 16) * ldc + col0;
#pragma unroll
                for (int bj = 0; bj < 2; ++bj) { f32x4 v0 = acc[ai][bj][m][0], v1 = acc[ai][bj][m][1];
                    if (ACT == 1) {
#pragma unroll
                        for (int j = 0; j < 4; ++j) { v0[j] = sigmoidf_(v0[j] * DS2); v1[j] = sigmoidf_(v1[j] * DS2); } }
                    u32x4 w; w.x = cvtpk(v0[0], v0[1]); w.y = cvtpk(v0[2], v0[3]); w.z = cvtpk(v1[0], v1[1]); w.w = cvtpk(v1[2], v1[3]);
                    *(u32x4*)(rowp + bj * 128) = w; } }
    }
};
template <int MODE> struct GateMul {
    static constexpr bool PERM = true;
    const bf16_t* gate; int goff; const bf16_t* prev; bf16_t* O;
    __device__ __forceinline__ void operator()(const f32x4 (&acc)[2][2][4][2], const Unit& u, int wr, int wc, int fr, int fq) const {
        const int row0 = u.pm * 256 + wr * 64 + fr, col0 = u.pn * 256 + wc * 32 + 8 * fq;
#pragma unroll
        for (int ai = 0; ai < 2; ++ai)
#pragma unroll
            for (int m = 0; m < 4; ++m) { const size_t row = (size_t)(row0 + ai * 128 + m * 16);
#pragma unroll
                for (int bj = 0; bj < 2; ++bj) { const int col = col0 + bj * 128;
                    const u32x4 g = *(const u32x4*)(gate + row * 4096 + goff + col);
                    f32x4 v0 = acc[ai][bj][m][0], v1 = acc[ai][bj][m][1];
                    v0[0] *= bf_lo(g.x); v0[1] *= bf_hi(g.x); v0[2] *= bf_lo(g.y); v0[3] *= bf_hi(g.y);
                    v1[0] *= bf_lo(g.z); v1[1] *= bf_hi(g.z); v1[2] *= bf_lo(g.w); v1[3] *= bf_hi(g.w);
                    if (MODE == 1) { const u32x4 p = *(const u32x4*)(prev + row * 2048 + col);
                        v0[0] += bf_lo(p.x); v0[1] += bf_hi(p.x); v0[2] += bf_lo(p.y); v0[3] += bf_hi(p.y);
                        v1[0] += bf_lo(p.z); v1[1] += bf_hi(p.z); v1[2] += bf_lo(p.w); v1[3] += bf_hi(p.w); }
                    if (O78F8 && MODE == 1) { *(u32x2*)((unsigned char*)O + row * 2048 + col) = (u32x2){pack4_f8(v0[0] * F8_SG, v0[1] * F8_SG, v0[2] * F8_SG, v0[3] * F8_SG), pack4_f8(v1[0] * F8_SG, v1[1] * F8_SG, v1[2] * F8_SG, v1[3] * F8_SG)}; }
                    else { u32x4 w; w.x = cvtpk(v0[0], v0[1]); w.y = cvtpk(v0[2], v0[3]); w.z = cvtpk(v1[0], v1[1]); w.w = cvtpk(v1[2], v1[3]);
                    *(u32x4*)(O + row * 2048 + col) = w; } } }
    }
};
struct Resid {
    static constexpr bool PERM = false;
    const float* base; float* out; const float* gate; int goff;
    __device__ __forceinline__ void operator()(const f32x4 (&acc)[2][2][4][2], const Unit& u, int wr, int wc, int fr, int fq) const {
        const int row0 = u.pm * 256 + wr * 64 + fr, col0 = u.pn * 256 + wc * 32 + 4 * fq;
        const int b = (u.pm * 256) / SEQ;
        f32x4 gv[2][2];
#pragma unroll
        for (int bj = 0; bj < 2; ++bj)
#pragma unroll
            for (int n = 0; n < 2; ++n) gv[bj][n] = *(const f32x4*)(gate + (size_t)b * 12288 + goff + col0 + bj * 128 + n * 16);
#pragma unroll
        for (int ai = 0; ai < 2; ++ai)
#pragma unroll
            for (int m = 0; m < 4; ++m) { const size_t off = (size_t)(row0 + ai * 128 + m * 16) * 2048 + col0;
#pragma unroll
                for (int bj = 0; bj < 2; ++bj)
#pragma unroll
                    for (int n = 0; n < 2; ++n) { const f32x4 bs = *(const f32x4*)(base + off + bj * 128 + n * 16);
                        *(f32x4*)(out + off + bj * 128 + n * 16) = bs + gv[bj][n] * acc[ai][bj][m][n]; } }
    }
};
struct SwiGLU {
    static constexpr bool PERM = true;
    bf16_t* O;
    __device__ __forceinline__ void operator()(const f32x4 (&acc)[2][2][4][2], const Unit& u, int wr, int wc, int fr, int fq) const {
        const int r0 = wr * 64 + fr, col0 = u.pn * 128 + wc * 32 + 8 * fq;
#pragma unroll
        for (int ai = 0; ai < 2; ++ai)
#pragma unroll
            for (int m = 0; m < 4; ++m) { const int r = r0 + ai * 128 + m * 16;
                f32x4 v0, v1;
#pragma unroll
                for (int j = 0; j < 4; ++j) { v0[j] = siluf_(acc[ai][0][m][0][j]) * acc[ai][1][m][0][j]; v1[j] = siluf_(acc[ai][0][m][1][j]) * acc[ai][1][m][1][j]; }
                u32x4 w; w.x = cvtpk(v0[0], v0[1]); w.y = cvtpk(v0[2], v0[3]); w.z = cvtpk(v1[0], v1[1]); w.w = cvtpk(v1[2], v1[3]);
                if (r < u.valid) *(u32x4*)(O + (size_t)(u.rowbase + r) * 512 + col0) = w; }
    }
};
struct SwiGLU8 {
    static constexpr bool PERM = true;
    unsigned char* O;
    __device__ __forceinline__ int f8exp(const Unit&) const { return 9; }
    __device__ __forceinline__ void operator()(const f32x4 (&acc)[2][2][4][2], const Unit& u, int wr, int wc, int fr, int fq) const {
        const int r0 = wr * 64 + fr, col0 = u.pn * 128 + wc * 32 + 8 * fq;
        constexpr float ds = 1.0f, us = F8_SA;
#pragma unroll
        for (int ai = 0; ai < 2; ++ai)
#pragma unroll
            for (int m = 0; m < 4; ++m) { const int r = r0 + ai * 128 + m * 16;
                f32x4 v0, v1;
#pragma unroll
                for (int j = 0; j < 4; ++j) { v0[j] = siluf_(acc[ai][0][m][0][j] * ds) * (acc[ai][1][m][0][j] * us); v1[j] = siluf_(acc[ai][0][m][1][j] * ds) * (acc[ai][1][m][1][j] * us); }
                if (r < u.valid) *(u32x2*)(O + (size_t)(u.rowbase + r) * 512 + col0) = (u32x2){pack4_f8(v0[0], v0[1], v0[2], v0[3]), pack4_f8(v1[0], v1[1], v1[2], v1[3])}; }
    }
};
struct DownY {
    static constexpr int PERM = 2;
    unsigned char* O;
    __device__ __forceinline__ int f8exp(const Unit&) const { return 8; }
    __device__ __forceinline__ void operator()(const f32x4 (&acc)[2][2][4][2], const Unit& u, int wr, int wc, int fr, int fq) const {
        const int r0 = wr * 64 + fr, col0 = u.pn * 256 + wc * 64 + 16 * fq;
#pragma unroll
        for (int ai = 0; ai < 2; ++ai)
#pragma unroll
            for (int m = 0; m < 4; ++m) { const int r = r0 + ai * 128 + m * 16;
                if (r < u.valid) {
                    const f32x4 v0 = acc[ai][0][m][0], v1 = acc[ai][0][m][1], v2 = acc[ai][1][m][0], v3 = acc[ai][1][m][1];
                    int w0 = __builtin_amdgcn_cvt_pk_fp8_f32(v0[0], v0[1], 0, false); w0 = __builtin_amdgcn_cvt_pk_fp8_f32(v0[2], v0[3], w0, true);
                    int w1 = __builtin_amdgcn_cvt_pk_fp8_f32(v1[0], v1[1], 0, false); w1 = __builtin_amdgcn_cvt_pk_fp8_f32(v1[2], v1[3], w1, true);
                    int w2 = __builtin_amdgcn_cvt_pk_fp8_f32(v2[0], v2[1], 0, false); w2 = __builtin_amdgcn_cvt_pk_fp8_f32(v2[2], v2[3], w2, true);
                    int w3 = __builtin_amdgcn_cvt_pk_fp8_f32(v3[0], v3[1], 0, false); w3 = __builtin_amdgcn_cvt_pk_fp8_f32(v3[2], v3[3], w3, true);
                    *(u32x4*)(O + (size_t)(u.rowbase + r) * 2048 + col0) = (u32x4){(unsigned)w0, (unsigned)w1, (unsigned)w2, (unsigned)w3}; } }
    }
};
struct StoreQK {
    static constexpr bool PERM = true;
    bf16_t* Q; bf16_t* KT; float qscale;
    __device__ __forceinline__ void operator()(const f32x4 (&acc)[2][2][4][2], const Unit& u, int wr, int wc, int fr, int fq) const {
        const int row0 = u.pm * 256 + wr * 64 + fr, col0 = u.pn * 256 + wc * 32 + 8 * fq;
        const bool isk = (u.pn >= 4);
#pragma unroll
        for (int ai = 0; ai < 2; ++ai)
#pragma unroll
            for (int m = 0; m < 4; ++m) { const int row = row0 + ai * 128 + m * 16;
#pragma unroll
                for (int bj = 0; bj < 2; ++bj) { const float sc = (isk ? 1.0f : qscale) * DS2; const f32x4 v0 = acc[ai][bj][m][0] * sc, v1 = acc[ai][bj][m][1] * sc; const int col = col0 + bj * 128;
                    u32x4 w; w.x = cvtpk(v0[0], v0[1]); w.y = cvtpk(v0[2], v0[3]); w.z = cvtpk(v1[0], v1[1]); w.w = cvtpk(v1[2], v1[3]);
                    bf16_t* p = isk ? KT + ((((size_t)((col - 1024) >> 7) * 256 + (row >> 6)) * 64 + (row & 63)) * 128 + (col & 127)) : Q + (size_t)row * 1024 + col;
                    *(u32x4*)p = w; } }
    }
};
struct StoreQK8 {
    static constexpr bool PERM = true;
    unsigned char* Q; unsigned char* KT; float qs, ks;
    __device__ __forceinline__ void operator()(const f32x4 (&acc)[2][2][4][2], const Unit& u, int wr, int wc, int fr, int fq) const {
        const int row0 = u.pm * 256 + wr * 64 + fr, col0 = u.pn * 256 + wc * 32 + 8 * fq;
        const bool isk = (u.pn >= 4);
#pragma unroll
        for (int ai = 0; ai < 2; ++ai)
#pragma unroll
            for (int m = 0; m < 4; ++m) { const int row = row0 + ai * 128 + m * 16;
#pragma unroll
                for (int bj = 0; bj < 2; ++bj) { const float sc = isk ? 1.0f : qs;        const f32x4 v0 = acc[ai][bj][m][0] * sc, v1 = acc[ai][bj][m][1] * sc; const int col = col0 + bj * 128;
                    unsigned char* p = isk ? KT + ((((size_t)((col - 1024) >> 7) * 256 + (row >> 6)) * 64 + (row & 63)) * 128 + (col & 127)) : Q + (size_t)row * 1024 + col;
                    *(u32x2*)p = (u32x2){pack4_f8(v0[0], v0[1], v0[2], v0[3]), pack4_f8(v1[0], v1[1], v1[2], v1[3])}; }
                __builtin_amdgcn_sched_barrier(0); }
    }
};
struct StoreQKboth {
    static constexpr bool PERM = true;
    StoreQK b16; unsigned char* Q8; unsigned char* KT8;
    __device__ __forceinline__ void operator()(const f32x4 (&acc)[2][2][4][2], const Unit& u, int wr, int wc, int fr, int fq) const {
        b16(acc, u, wr, wc, fr, fq);
        const int row0 = u.pm * 256 + wr * 64 + fr, col0 = u.pn * 256 + wc * 32 + 8 * fq;
        const bool isk = (u.pn >= 4);
        const float sc = isk ? att::D8_KS : att::MB8_QS;
#pragma unroll
        for (int ai = 0; ai < 2; ++ai)
#pragma unroll
            for (int m = 0; m < 4; ++m) { const int row = row0 + ai * 128 + m * 16;
#pragma unroll
                for (int bj = 0; bj < 2; ++bj) { const f32x4 v0 = acc[ai][bj][m][0] * sc, v1 = acc[ai][bj][m][1] * sc; const int col = col0 + bj * 128;
                    unsigned char* p = isk ? KT8 + ((((size_t)((col - 1024) >> 7) * 256 + (row >> 6)) * 64 + (row & 63)) * 128 + (col & 127)) : Q8 + (size_t)row * 1024 + col;
                    *(u32x2*)p = (u32x2){pack4_f8(v0[0], v0[1], v0[2], v0[3]), pack4_f8(v1[0], v1[1], v1[2], v1[3])}; }
                __builtin_amdgcn_sched_barrier(0); }
    }
};
struct StoreVT8 {
    static constexpr bool PERM = true;
    unsigned char* VT; float vs;
    __device__ __forceinline__ void operator()(const f32x4 (&acc)[2][2][4][2], const Unit& u, int wr, int wc, int fr, int fq) const {
        const int row0 = u.pm * 256 + wr * 64 + fr, col0 = u.pn * 256 + wc * 32 + 8 * fq;
#pragma unroll
        for (int ai = 0; ai < 2; ++ai)
#pragma unroll
            for (int m = 0; m < 4; ++m) { const int f = row0 + ai * 128 + m * 16;
#pragma unroll
                for (int bj = 0; bj < 2; ++bj) { const f32x4 v0 = acc[ai][bj][m][0], v1 = acc[ai][bj][m][1]; const int tok = col0 + bj * 128, k = tok & 63;
                    unsigned char* p = VT + ((((size_t)(f >> 7) * 256 + (tok >> 6)) * 128 + (f & 127)) * 64 + (k >> 5) * 16 + ((k & 31) >> 3) * 4);
                    *(unsigned*)p = pack4_f8(v0[0], v0[1], v0[2], v0[3]); *(unsigned*)(p + 32) = pack4_f8(v1[0], v1[1], v1[2], v1[3]); }
                __builtin_amdgcn_sched_barrier(0); }
    }
};
struct StoreVT {
    static constexpr bool PERM = true;
    bf16_t* VT;
    __device__ __forceinline__ void operator()(const f32x4 (&acc)[2][2][4][2], const Unit& u, int wr, int wc, int fr, int fq) const {
        const int row0 = u.pm * 256 + wr * 64 + fr, col0 = u.pn * 256 + wc * 32 + 8 * fq;
#pragma unroll
        for (int ai = 0; ai < 2; ++ai)
#pragma unroll
            for (int m = 0; m < 4; ++m) { const int f = row0 + ai * 128 + m * 16;
#pragma unroll
                for (int bj = 0; bj < 2; ++bj) { const f32x4 v0 = acc[ai][bj][m][0] * DS2, v1 = acc[ai][bj][m][1] * DS2; const int tok = col0 + bj * 128;
                    u32x4 w; w.x = cvtpk(v0[0], v0[1]); w.y = cvtpk(v0[2], v0[3]); w.z = cvtpk(v1[0], v1[1]); w.w = cvtpk(v1[2], v1[3]);
                    *(u32x4*)(VT + ((((size_t)(f >> 7) * 256 + (tok >> 6)) * 128 + (f & 127)) * 64 + (tok & 63))) = w; } }
    }
};
struct ProjEpi {
    static constexpr bool PERM = true, HAS_MID = false;
    StoreQK8 qkd; StoreQKboth qkm; StoreBf16<1> gates;
    __device__ __forceinline__ int f8exp(const Unit& u) const { return (u.pn >= 4 && u.pn < 8) ? P2_EXP - 2 : P2_EXP; }
    __device__ __forceinline__ void operator()(const f32x4 (&acc)[2][2][4][2], const Unit& u, int wr, int wc, int fr, int fq) const {
        Unit v = u;
        if (u.pn < 8) qkd(acc, v, wr, wc, fr, fq);
        else if (u.pn < 16) { v.pn = u.pn - 8; qkm(acc, v, wr, wc, fr, fq); }
        else { v.pn = u.pn - 16; gates(acc, v, wr, wc, fr, fq); }
    }
};
struct ProjVT {
    static constexpr bool PERM = true, HAS_MID = false;
    StoreVT8 vd; StoreVT8 vm;
    __device__ __forceinline__ int f8exp(const Unit& u) const { return P2_EXP - 3; }
    __device__ __forceinline__ void operator()(const f32x4 (&acc)[2][2][4][2], const Unit& u, int wr, int wc, int fr, int fq) const {
        Unit v = u;
        if (u.pm < 4) vd(acc, v, wr, wc, fr, fq); else { v.pm = u.pm - 4; vm(acc, v, wr, wc, fr, fq); }
    }
};
struct GatePair {
    static constexpr bool PERM = true, HAS_MID = false;
    GateMul<0> e0; GateMul<1> e1;
    __device__ __forceinline__ int f8exp(const Unit& u) const { return u.aux == 0 ? 9 : 11; }
    __device__ __forceinline__ void operator()(const f32x4 (&acc)[2][2][4][2], const Unit& u, int wr, int wc, int fr, int fq) const {
        if (u.aux == 0) e0(acc, u, wr, wc, fr, fq); else e1(acc, u, wr, wc, fr, fq);
    }
};
struct ResidBf16 {
    static constexpr bool PERM = true, HAS_MID = false;
    const float* base; bf16_t* out; const float* gate; int goff;
    __device__ __forceinline__ int f8exp(const Unit&) const { return 10; }
    __device__ __forceinline__ void operator()(const f32x4 (&acc)[2][2][4][2], const Unit& u, int wr, int wc, int fr, int fq) const {
        const int row0 = u.pm * 256 + wr * 64 + fr, col0 = u.pn * 256 + wc * 32 + 8 * fq;
        const int b = (u.pm * 256) / SEQ;
        f32x4 gv[2][2];
#pragma unroll
        for (int bj = 0; bj < 2; ++bj)
#pragma unroll
            for (int n = 0; n < 2; ++n) gv[bj][n] = *(const f32x4*)(gate + (size_t)b * 12288 + goff + col0 + bj * 128 + n * 4);
#pragma unroll
        for (int ai = 0; ai < 2; ++ai)
#pragma unroll
            for (int m = 0; m < 4; ++m) { const size_t off = (size_t)(row0 + ai * 128 + m * 16) * 2048 + col0;
#pragma unroll
                for (int bj = 0; bj < 2; ++bj) {
                    const f32x4 b0 = *(const f32x4*)(base + off + bj * 128), b1 = *(const f32x4*)(base + off + bj * 128 + 4);
                    const f32x4 v0 = b0 + gv[bj][0] * acc[ai][bj][m][0], v1 = b1 + gv[bj][1] * acc[ai][bj][m][1];
                    u32x4 w; w.x = cvtpk(v0[0], v0[1]); w.y = cvtpk(v0[2], v0[3]); w.z = cvtpk(v1[0], v1[1]); w.w = cvtpk(v1[2], v1[3]);
                    *(u32x4*)(out + off + bj * 128) = w; } }
    }
};
}
namespace att {
constexpr int KROW = 272;
constexpr int VROW = 144;
constexpr int KBUF = 64 * KROW;
constexpr int VBUF = 128 * VROW;
constexpr int OFF_K = 0, OFF_V = 2 * KBUF, OFF_TAB = OFF_V + 2 * VBUF, OFF_G = OFF_TAB + 512, OFF_END = OFF_G + 512;
static_assert(OFF_END <= RING_BYTES, "attention LDS");
__device__ __forceinline__ int crow(int i, int hh) { return (i & 3) + 8 * (i >> 2) + 4 * hh; }

__device__ __forceinline__ int t5_bucket(int n) {
    if (n < 16) return n;
    int b = 16;
    b += (n >= 19); b += (n >= 21); b += (n >= 24); b += (n >= 27); b += (n >= 31); b += (n >= 35); b += (n >= 40); b += (n >= 46);
    b += (n >= 52); b += (n >= 59); b += (n >= 67); b += (n >= 77); b += (n >= 87); b += (n >= 99); b += (n >= 113);
    return b;
}
__device__ __forceinline__ void fill_bias_tab(LAS float* tab, const float* rel_bias, int col) {
    if (threadIdx.x < 128) { const int n = threadIdx.x; tab[n] = (rel_bias[t5_bucket(n) * 16 + col] - rel_bias[31 * 16 + col]) * LOG2E; }
}

struct TileRegs { u32x4 k[2]; u32x4 v[2]; };
__device__ __forceinline__ void tile_load(TileRegs& R, const bf16_t* kt, const bf16_t* vt, int tid) {
#pragma unroll
    for (int i = 0; i < 2; ++i) { const int c = tid + 512 * i; R.k[i] = *(const u32x4*)(kt + c * 8); }
#pragma unroll
    for (int i = 0; i < 2; ++i) { const int c = tid + 512 * i; R.v[i] = *(const u32x4*)(vt + c * 8); }
}
__device__ __forceinline__ void tile_store(const TileRegs& R, LAS unsigned char* kb, LAS unsigned char* vb, int tid) {
#pragma unroll
    for (int i = 0; i < 2; ++i) { const int c = tid + 512 * i; *(LAS u32x4*)(kb + (c >> 4) * KROW + (c & 15) * 16) = R.k[i]; }
#pragma unroll
    for (int i = 0; i < 2; ++i) { const int c = tid + 512 * i;
        LAS unsigned char* p = vb + (c >> 3) * VROW + ((c & 7) >> 1) * 32 + (c & 1) * 8;
        *(LAS u32x2*)p = (u32x2){R.v[i].x, R.v[i].y}; *(LAS u32x2*)(p + 16) = (u32x2){R.v[i].z, R.v[i].w}; }
}

template <int NMAP, int KS>
__device__ __forceinline__ void attn_half(const LAS unsigned char* kb, const LAS unsigned char* vb, int kh, const bf16x8 (&qf)[NMAP][KS], f32x16 (&O)[NMAP][4],
                                          float (&mrun)[NMAP], float (&lrun)[NMAP], int qpos, int kvpos0, bool need_mask, bool need_bias, const LAS float* btab, float sc, int r, int hh, int kcolbase) {
    bf16x8 P[NMAP][2];
#pragma unroll
    for (int m = 0; m < NMAP; ++m) {
        f32x16 s;
#pragma unroll
        for (int i = 0; i < 16; ++i) s[i] = 0.f;
#pragma unroll
        for (int ks = 0; ks < KS; ++ks) {
            const bf16x8 kf = *(const LAS bf16x8*)(kb + (32 * kh + r) * KROW + (kcolbase + m * 16 * KS + 16 * ks + 8 * hh) * 2);
            s = __builtin_amdgcn_mfma_f32_32x32x16_bf16(kf, qf[m][ks], s, 0, 0, 0);
        }
#pragma unroll
        for (int i = 0; i < 16; ++i) s[i] *= sc;
        if (need_bias) {
#pragma unroll
            for (int i = 0; i < 16; ++i) { int rel = qpos - (kvpos0 + crow(i, hh)); rel = rel < 0 ? 0 : (rel > 127 ? 127 : rel); s[i] += btab[rel]; }
        }
        if (need_mask) {
#pragma unroll
            for (int i = 0; i < 16; ++i) { if (kvpos0 + crow(i, hh) > qpos) s[i] = -INFINITY; }
        }
        float mx = s[0];
#pragma unroll
        for (int i = 1; i < 16; ++i) mx = fmaxf(mx, s[i]);
        mx = fmaxf(mx, __shfl_xor(mx, 32));
        const float mnew = fmaxf(mrun[m], mx);
        const float alpha = fast_exp2(mrun[m] - mnew);
        float sum = 0.f;
#pragma unroll
        for (int i = 0; i < 16; ++i) { const float p = fast_exp2(s[i] - mnew); sum += p; s[i] = p; }
        lrun[m] = lrun[m] * alpha + sum; mrun[m] = mnew;
#pragma unroll
        for (int dt = 0; dt < 4; ++dt)
#pragma unroll
            for (int i = 0; i < 16; ++i) O[m][dt][i] *= alpha;
#pragma unroll
        for (int st = 0; st < 2; ++st) { u32x4 w; w.x = cvtpk(s[8 * st + 0], s[8 * st + 1]); w.y = cvtpk(s[8 * st + 2], s[8 * st + 3]); w.z = cvtpk(s[8 * st + 4], s[8 * st + 5]); w.w = cvtpk(s[8 * st + 6], s[8 * st + 7]);
            P[m][st] = __builtin_bit_cast(bf16x8, w); }
    }
#pragma unroll
    for (int dt = 0; dt < 4; ++dt)
#pragma unroll
        for (int st = 0; st < 2; ++st) {
            const bf16x8 vf = *(const LAS bf16x8*)(vb + (32 * dt + r) * VROW + (2 * kh + st) * 32 + hh * 16);
#pragma unroll
            for (int m = 0; m < NMAP; ++m) O[m][dt] = __builtin_amdgcn_mfma_f32_32x32x16_bf16(vf, P[m][st], O[m][dt], 0, 0, 0);
        }
}

#define SBAR() __builtin_amdgcn_sched_barrier(0)
constexpr int TBUF = KBUF + VBUF;
constexpr int D_OFF_TAB = 3 * TBUF, D_OFF_G = D_OFF_TAB + 512;
static_assert(D_OFF_G + 512 <= RING_BYTES, "diff attention LDS");
constexpr float D_C = 0.125f * LOG2E;
__device__ __forceinline__ void d_load_kf(bf16x8 (&kf)[4], const LAS unsigned char* kb, int kh, int r, int hh, int kcol) {
#pragma unroll
    for (int ks = 0; ks < 4; ++ks) kf[ks] = *(const LAS bf16x8*)(kb + (32 * kh + r) * KROW + (kcol + 16 * ks + 8 * hh) * 2);
}
constexpr float D_THR = 8.0f;
__device__ __forceinline__ float max3_(float a, float b, float c) { float r; asm("v_max3_f32 %0, %1, %2, %3" : "=v"(r) : "v"(a), "v"(b), "v"(c)); return r; }
template <int MODE, bool LOADV, bool PREFK>
__device__ __forceinline__ void d_half_a(const bf16x8 (&kf)[4], bf16x8 (&kfn)[4], const LAS unsigned char* knext, int khn, const LAS unsigned char* vb, int kh,
                                         const bf16x8 (&qf)[4], f32x16 (&o)[4], float& mref, float& lrun, int qpos, int kvpos0, bool need_mask, bool need_bias, bool first,
                                         const LAS float* btab, int r, int hh, int kcol, bf16x8 (&vf)[4], bf16x8 (&P)[2]) {
    if (LOADV) {
#pragma unroll
        for (int dt = 0; dt < 2; ++dt)
#pragma unroll
            for (int st = 0; st < 2; ++st) vf[2 * dt + st] = *(const LAS bf16x8*)(vb + (32 * dt + r) * VROW + (2 * kh + st) * 32 + hh * 16);
    }
    SBAR();
    f32x16 s;
#pragma unroll
    for (int i = 0; i < 16; ++i) s[i] = 0.f;
    __builtin_amdgcn_s_setprio(1);
#pragma unroll
    for (int ks = 0; ks < 4; ++ks) { if (MODE != 3) s = __builtin_amdgcn_mfma_f32_32x32x16_bf16(kf[ks], qf[ks], s, 0, 0, 0); else { s[ks] += __builtin_bit_cast(float, (int)kf[ks][0]); s[4 + ks] += __builtin_bit_cast(float, (int)qf[ks][1]); } }
    __builtin_amdgcn_s_setprio(0);
    if (PREFK) d_load_kf(kfn, knext, khn, r, hh, kcol);
    SBAR();
    if (MODE == 4) { P[0] = qf[0]; P[1] = qf[1]; mref = fmaxf(mref, s[0]); } else {
    if (need_bias) {
#pragma unroll
        for (int i = 0; i < 16; ++i) { int rel = qpos - (kvpos0 + crow(i, hh)); rel = rel < 0 ? 0 : (rel > 127 ? 127 : rel); s[i] += btab[rel]; }
    }
    if (need_mask) {
#pragma unroll
        for (int i = 0; i < 16; ++i) { if (kvpos0 + crow(i, hh) > qpos) s[i] = -INFINITY; }
    }
    float mx = max3_(s[0], s[1], s[2]);
    mx = max3_(mx, s[3], s[4]); mx = max3_(mx, s[5], s[6]); mx = max3_(mx, s[7], s[8]); mx = max3_(mx, s[9], s[10]); mx = max3_(mx, s[11], s[12]); mx = max3_(mx, s[13], s[14]);
    { auto rr = __builtin_amdgcn_permlane32_swap(__float_as_uint(mx), __float_as_uint(mx), false, false); mx = max3_(s[15], __uint_as_float(rr[0]), __uint_as_float(rr[1])); }
    if (first || __any(mx - mref > D_THR)) {
        const float mn = first ? mx : fmaxf(mref, mx);
        const float alpha = first ? 0.f : fast_exp2(mref - mn);
        mref = mn; lrun *= alpha;
#pragma unroll
        for (int dt = 0; dt < 4; ++dt)
#pragma unroll
            for (int i = 0; i < 16; ++i) o[dt][i] *= alpha;
    }
    float sum = 0.f;
#pragma unroll
    for (int i = 0; i < 16; ++i) { const float p = fast_exp2(s[i] - mref); sum += p; s[i] = p; }
    lrun += sum;
#pragma unroll
    for (int st = 0; st < 2; ++st) { u32x4 w; w.x = cvtpk(s[8 * st + 0], s[8 * st + 1]); w.y = cvtpk(s[8 * st + 2], s[8 * st + 3]); w.z = cvtpk(s[8 * st + 4], s[8 * st + 5]); w.w = cvtpk(s[8 * st + 6], s[8 * st + 7]);
        P[st] = __builtin_bit_cast(bf16x8, w); }
    }
}
template <int MODE, bool LOADV>
__device__ __forceinline__ void d_half_b(f32x16 (&o)[4], bf16x8 (&vf)[4], const bf16x8 (&P)[2], const LAS unsigned char* vb, int kh, int r, int hh) {
    if (LOADV) {
#pragma unroll
        for (int dt = 0; dt < 2; ++dt)
#pragma unroll
            for (int st = 0; st < 2; ++st) vf[2 * dt + st] = *(const LAS bf16x8*)(vb + (32 * dt + r) * VROW + (2 * kh + st) * 32 + hh * 16);
    }
    bf16x8 vg[4];
#pragma unroll
    for (int dt = 2; dt < 4; ++dt)
#pragma unroll
        for (int st = 0; st < 2; ++st) vg[2 * (dt - 2) + st] = *(const LAS bf16x8*)(vb + (32 * dt + r) * VROW + (2 * kh + st) * 32 + hh * 16);
    asm volatile("s_waitcnt lgkmcnt(4)" ::: "memory"); SBAR();
    __builtin_amdgcn_s_setprio(1);
#pragma unroll
    for (int dt = 0; dt < 2; ++dt)
#pragma unroll
        for (int st = 0; st < 2; ++st) {
            if (MODE != 3) o[dt] = __builtin_amdgcn_mfma_f32_32x32x16_bf16(vf[2 * dt + st], P[st], o[dt], 0, 0, 0);
            else o[dt][st] += __builtin_bit_cast(float, (int)vf[2 * dt + st][0]) * __builtin_bit_cast(float, (int)P[st][0]);
        }
    asm volatile("s_waitcnt lgkmcnt(0)" ::: "memory"); SBAR();
#pragma unroll
    for (int dt = 2; dt < 4; ++dt)
#pragma unroll
        for (int st = 0; st < 2; ++st) {
            if (MODE != 3) o[dt] = __builtin_amdgcn_mfma_f32_32x32x16_bf16(vg[2 * (dt - 2) + st], P[st], o[dt], 0, 0, 0);
            else o[dt][st] += __builtin_bit_cast(float, (int)vg[2 * (dt - 2) + st][0]) * __builtin_bit_cast(float, (int)P[st][0]);
        }
    __builtin_amdgcn_s_setprio(0);
}
template <int MODE>
__device__ __forceinline__ void diff_unit(LAS unsigned char* lds, int b, int h, int qt, const bf16_t* QD, const bf16_t* KDT, const bf16_t* VDT, bf16_t* AD, const float* subln, const float* rel_bias) {
    int tid_ = threadIdx.x; asm volatile("" : "+v"(tid_));
    const int tid = tid_, lane = tid & 63, r = lane & 31, hh = lane >> 5; const int wid = __builtin_amdgcn_readfirstlane(tid >> 6);
    const int map = wid >> 2, qsub = wid & 3;
    const int q0 = qt * 128, qw0 = q0 + 32 * qsub, qpos = qw0 + r;
    const size_t tok0 = (size_t)b * SEQ;
    const LAS float* btab = (const LAS float*)(lds + D_OFF_TAB);
    const LAS float* gtab = (const LAS float*)(lds + D_OFF_G);
    const int kcol = map * 64;
    bf16x8 qf[4];
#pragma unroll
    for (int ks = 0; ks < 4; ++ks) qf[ks] = *(const bf16x8*)(QD + (tok0 + qpos) * 1024 + h * 128 + map * 64 + 16 * ks + 8 * hh);
    f32x16 o[4];
#pragma unroll
    for (int dt = 0; dt < 4; ++dt)
#pragma unroll
        for (int i = 0; i < 16; ++i) o[dt][i] = 0.f;
    float mrun = 0.f, lrun = 0.f;
    const bf16_t* kbase = KDT + ((size_t)h * 256 + b * 128) * 8192;
    const bf16_t* vbase = VDT + ((size_t)h * 256 + b * 128) * 8192;
    const int NT = 2 * (qt + 1);
    TileRegs R;
    bf16x8 kfa[4], kfb[4];
    __syncthreads();
    fill_bias_tab((LAS float*)(lds + D_OFF_TAB), rel_bias, h);
    if (tid < 128) ((LAS float*)(lds + D_OFF_G))[tid] = subln[tid];
    tile_load(R, kbase, vbase, tid);
    tile_store(R, lds, lds + KBUF, tid);
    tile_load(R, kbase + 8192, vbase + 8192, tid);
    __syncthreads();
    if (MODE != 2) d_load_kf(kfa, lds, 0, r, hh, kcol);
    int bc = 0;
    bf16x8 vf[4], P[2];
#define D_STAGE() do { if (t + 1 < NT) tile_store(R, lds + bn * TBUF, lds + bn * TBUF + KBUF, tid); \
        if (t + 2 < NT) tile_load(R, kbase + (size_t)(MODE == 1 ? 0 : t + 2) * 8192, vbase + (size_t)(MODE == 1 ? 0 : t + 2) * 8192, tid); \
        __syncthreads(); } while (0)
    if (wid < 4) {
#pragma unroll 1
        for (int t = 0; t < NT; ++t) {
            const int bn = (bc == 2) ? 0 : bc + 1;
            const LAS unsigned char* kb = lds + bc * TBUF; const LAS unsigned char* vb = kb + KBUF;
            const int k0 = 64 * t;
            { const bool nm = (k0 + 31 > qw0), nb = (qw0 - (k0 + 31) < 113);
              if (MODE != 2) { d_half_a<MODE, true, true>(kfa, kfb, kb, 1, vb, 0, qf, o, mrun, lrun, qpos, k0, nm, nb, t == 0, btab, r, hh, kcol, vf, P); d_half_b<MODE, false>(o, vf, P, vb, 0, r, hh); } }
            D_STAGE();
            { const bool nm = (k0 + 63 > qw0), nb = (qw0 - (k0 + 63) < 113);
              if (MODE != 2) { d_half_a<MODE, true, true>(kfb, kfa, lds + bn * TBUF, 0, vb, 1, qf, o, mrun, lrun, qpos, k0 + 32, nm, nb, false, btab, r, hh, kcol, vf, P); d_half_b<MODE, false>(o, vf, P, vb, 1, r, hh); } }
            bc = bn;
        }
    } else {
#pragma unroll 1
        for (int t = 0; t < NT; ++t) {
            const int bn = (bc == 2) ? 0 : bc + 1;
            const LAS unsigned char* kb = lds + bc * TBUF; const LAS unsigned char* vb = kb + KBUF;
            const int k0 = 64 * t;
            { const bool nm = (k0 + 31 > qw0), nb = (qw0 - (k0 + 31) < 113);
              if (MODE != 2) d_half_a<MODE, false, false>(kfa, kfb, kb, 1, vb, 0, qf, o, mrun, lrun, qpos, k0, nm, nb, t == 0, btab, r, hh, kcol, vf, P); }
            D_STAGE();
            if (MODE != 2) { d_half_b<MODE, true>(o, vf, P, vb, 0, r, hh); d_load_kf(kfb, kb, 1, r, hh, kcol); }
            { const bool nm = (k0 + 63 > qw0), nb = (qw0 - (k0 + 63) < 113);
              if (MODE != 2) { d_half_a<MODE, true, true>(kfb, kfa, lds + bn * TBUF, 0, vb, 1, qf, o, mrun, lrun, qpos, k0 + 32, nm, nb, false, btab, r, hh, kcol, vf, P); d_half_b<MODE, false>(o, vf, P, vb, 1, r, hh); } }
            bc = bn;
        }
    }
#undef D_STAGE
    __syncthreads();
    const float l = lrun + __shfl_xor(lrun, 32);
    LAS float* xch = (LAS float*)lds + qsub * 4096 + lane;
    if (map == 1) {
        const float lam = *(const LAS float*)(lds + MISC_OFF + 68);
        const float f = lam / l;
#pragma unroll
        for (int dt = 0; dt < 4; ++dt)
#pragma unroll
            for (int i = 0; i < 16; ++i) xch[(dt * 16 + i) * 64] = o[dt][i] * f;
    }
    __syncthreads();
    if (map == 0) {
        const float i0 = 1.0f / l;
        float ss = 0.f;
#pragma unroll
        for (int dt = 0; dt < 4; ++dt)
#pragma unroll
            for (int i = 0; i < 16; ++i) { const float v = o[dt][i] * i0 - xch[(dt * 16 + i) * 64]; o[dt][i] = v; ss += v * v; }
        ss += __shfl_xor(ss, 32);
        const float rs = 0.8f / sqrtf(ss * (1.0f / 128.0f) + RMS_EPS);
        bf16_t* orow = AD + (tok0 + qpos) * 1024 + h * 128;
#pragma unroll
        for (int dt = 0; dt < 4; ++dt)
#pragma unroll
            for (int g = 0; g < 4; ++g) { const int d = 32 * dt + 8 * g + 4 * hh;
                const f32x4 gg = *(const LAS f32x4*)(gtab + d);
                u32x2 w; w.x = cvtpk(o[dt][4 * g + 0] * rs * gg[0], o[dt][4 * g + 1] * rs * gg[1]); w.y = cvtpk(o[dt][4 * g + 2] * rs * gg[2], o[dt][4 * g + 3] * rs * gg[3]);
                *(u32x2*)(orow + d) = w; }
    }
}

constexpr int KROW8 = 144, VROW8 = 80, KBUF8 = 64 * KROW8, VBUF8 = 128 * VROW8, TBUF8 = KBUF8 + VBUF8;
static_assert(4 * TBUF8 <= D_OFF_TAB, "fp8 diff attention LDS");
constexpr float D8_C = 1.0f / 64.0f, D8_THR = 3.0f * 64.0f, D8_SH = 5.0f;
struct TileRegs8 { u32x4 k, v; };
__device__ __forceinline__ void tile_load8(TileRegs8& R, const unsigned char* kt, const unsigned char* vt, int tid) { R.k = *(const u32x4*)(kt + tid * 16); R.v = *(const u32x4*)(vt + tid * 16); }
__device__ __forceinline__ void tile_store8(const TileRegs8& R, LAS unsigned char* kb, LAS unsigned char* vb, int tid) {
    *(LAS u32x4*)(kb + (tid >> 3) * KROW8 + (tid & 7) * 16) = R.k; *(LAS u32x4*)(vb + (tid >> 2) * VROW8 + (tid & 3) * 16) = R.v; }
__device__ __forceinline__ i32x8 cat8(const i32x4 a, const i32x4 b) { return __builtin_shufflevector(a, b, 0, 1, 2, 3, 4, 5, 6, 7); }
__device__ __forceinline__ void d8_load_kf(i32x8 (&kf)[2], const LAS unsigned char* kb, int r, int hh, int kcolb) {
#pragma unroll
    for (int kh = 0; kh < 2; ++kh) { const LAS unsigned char* q = kb + (32 * kh + r) * KROW8 + kcolb + 32 * hh; kf[kh] = cat8(*(const LAS i32x4*)q, *(const LAS i32x4*)(q + 16)); }
}
template <int DT0>
__device__ __forceinline__ void d8_load_vf2(i32x8 (&vf)[2], const LAS unsigned char* vb, int r, int hh) {
#pragma unroll
    for (int dt = 0; dt < 2; ++dt) { const LAS unsigned char* q = vb + (32 * (DT0 + dt) + r) * VROW8 + 32 * hh; vf[dt] = cat8(*(const LAS i32x4*)q, *(const LAS i32x4*)(q + 16)); }
}
__device__ __forceinline__ void d8_scores(f32x16& s0, f32x16& s1, const i32x8 (&kf)[2], const i32x8& qf) {
    f32x16 z;
#pragma unroll
    for (int i = 0; i < 16; ++i) z[i] = 0.f;
    __builtin_amdgcn_s_setprio(1);
    s0 = __builtin_amdgcn_mfma_scale_f32_32x32x64_f8f6f4(kf[0], qf, z, 0, 0, 0, 0x7F7F7F7F, 0, 0x7F7F7F7F);
    s1 = __builtin_amdgcn_mfma_scale_f32_32x32x64_f8f6f4(kf[1], qf, z, 0, 0, 0, 0x7F7F7F7F, 0, 0x7F7F7F7F);
    __builtin_amdgcn_s_setprio(0);
}
template <bool ROW = false>
__device__ __forceinline__ i32x8 d8_softmax(f32x16& s0, f32x16& s1, f32x16 (&o)[4], float& mref, float& lrun, int qpos, int k0, bool need_mask, bool need_bias, bool first, const LAS float* btab, int hh) {
    if (need_bias) {
#pragma unroll
        for (int i = 0; i < 16; ++i) { int rel = qpos - (k0 + crow(i, hh)); rel = rel < 0 ? 0 : (rel > 127 ? 127 : rel); s0[i] += btab[rel]; }
        SBAR();
#pragma unroll
        for (int i = 0; i < 16; ++i) { int rel = qpos - (k0 + 32 + crow(i, hh)); rel = rel < 0 ? 0 : (rel > 127 ? 127 : rel); s1[i] += btab[rel]; }
        SBAR();
    }
    if (need_mask) {
#pragma unroll
        for (int i = 0; i < 16; ++i) { if (k0 + crow(i, hh) > qpos) s0[i] = -INFINITY; if (k0 + 32 + crow(i, hh) > qpos) s1[i] = -INFINITY; }
    }
    float mx = max3_(s0[0], s0[1], s0[2]);
#pragma unroll
    for (int i = 3; i < 15; i += 2) mx = max3_(mx, s0[i], s0[i + 1]);
    mx = max3_(mx, s0[15], s1[0]);
#pragma unroll
    for (int i = 1; i < 15; i += 2) mx = max3_(mx, s1[i], s1[i + 1]);
    { auto rr = __builtin_amdgcn_permlane32_swap(__float_as_uint(mx), __float_as_uint(mx), false, false); mx = max3_(s1[15], __uint_as_float(rr[0]), __uint_as_float(rr[1])); }
    if constexpr (ROW) {
        const bool up = (mx - mref > D8_THR);
        if (__any(up)) {
            const float alpha = up ? fast_exp2((mref - mx) * D8_C) : 1.0f;
            if (up) mref = mx;
            lrun *= alpha;
            asm volatile("s_nop 15\n\ts_nop 15" ::: "memory");
#pragma unroll
            for (int dt = 0; dt < 4; ++dt)
#pragma unroll
                for (int i = 0; i < 16; ++i) o[dt][i] *= alpha;
        }
    } else
    if (first || __any(mx - mref > D8_THR)) {
        const float mn = first ? mx : fmaxf(mref, mx);
        const float alpha = first ? 0.f : fast_exp2((mref - mn) * D8_C);
        mref = mn; lrun *= alpha;
        asm volatile("s_nop 15\n\ts_nop 15" ::: "memory");
#pragma unroll
        for (int dt = 0; dt < 4; ++dt)
#pragma unroll
            for (int i = 0; i < 16; ++i) o[dt][i] *= alpha;
    }
    const float off = D8_SH - mref * D8_C;
    float sum0 = 0.f, sum1 = 0.f;
    i32x8 P;
    const f32x2 c2 = {D8_C, D8_C}, off2 = {off, off};
    f32x2 sum2 = {0.f, 0.f};
#pragma unroll
    for (int g = 0; g < 4; ++g) {
        const f32x2 a0 = __builtin_elementwise_fma((f32x2){s0[4 * g], s0[4 * g + 1]}, c2, off2), a1 = __builtin_elementwise_fma((f32x2){s0[4 * g + 2], s0[4 * g + 3]}, c2, off2);
        const f32x2 b0 = __builtin_elementwise_fma((f32x2){s1[4 * g], s1[4 * g + 1]}, c2, off2), b1 = __builtin_elementwise_fma((f32x2){s1[4 * g + 2], s1[4 * g + 3]}, c2, off2);
        const f32x2 e0 = {fast_exp2(a0[0]), fast_exp2(a0[1])}, e1 = {fast_exp2(a1[0]), fast_exp2(a1[1])}, f0 = {fast_exp2(b0[0]), fast_exp2(b0[1])}, f1 = {fast_exp2(b1[0]), fast_exp2(b1[1])};
        sum2 += (e0 + e1) + (f0 + f1);
        int w0 = __builtin_amdgcn_cvt_pk_fp8_f32(e0[0], e0[1], 0, false); w0 = __builtin_amdgcn_cvt_pk_fp8_f32(e1[0], e1[1], w0, true);
        int w1 = __builtin_amdgcn_cvt_pk_fp8_f32(f0[0], f0[1], 0, false); w1 = __builtin_amdgcn_cvt_pk_fp8_f32(f1[0], f1[1], w1, true);
        P[g] = w0; P[4 + g] = w1; }
    sum0 = sum2[0]; sum1 = sum2[1];
    lrun += sum0 + sum1;
    return P;
}
__device__ __forceinline__ void d8_pv(f32x16 (&o)[4], const i32x8 (&va)[2], const i32x8& P, const LAS unsigned char* vb, int r, int hh) {
    i32x8 vg[2];
    d8_load_vf2<2>(vg, vb, r, hh);
    asm volatile("s_waitcnt lgkmcnt(4)" ::: "memory"); SBAR();
    __builtin_amdgcn_s_setprio(1);
#pragma unroll
    for (int dt = 0; dt < 2; ++dt) asm volatile("v_mfma_scale_f32_32x32x64_f8f6f4 %0, %1, %2, %0, %3, %3 op_sel_hi:[0,0,0]" : "+v"(o[dt]) : "v"(va[dt]), "v"(P), "v"(0x7F7F7F7F));
    asm volatile("s_waitcnt lgkmcnt(0)" ::: "memory"); SBAR();
#pragma unroll
    for (int dt = 0; dt < 2; ++dt) asm volatile("v_mfma_scale_f32_32x32x64_f8f6f4 %0, %1, %2, %0, %3, %3 op_sel_hi:[0,0,0]" : "+v"(o[2 + dt]) : "v"(vg[dt]), "v"(P), "v"(0x7F7F7F7F));
    __builtin_amdgcn_s_setprio(0);
}
__device__ __forceinline__ void diff_unit8(LAS unsigned char* lds, int b, int h, int qt, const unsigned char* QD, const unsigned char* KDT, const unsigned char* VDT, bf16_t* AD, const float* subln, const float* rel_bias) {
    int tid_ = threadIdx.x; asm volatile("" : "+v"(tid_));
    const int tid = tid_, lane = tid & 63, r = lane & 31, hh = lane >> 5; const int wid = __builtin_amdgcn_readfirstlane(tid >> 6);
    const int map = wid >> 2, qsub = wid & 3;
    const int q0 = qt * 128, qw0 = q0 + 32 * qsub, qpos = qw0 + r;
    const size_t tok0 = (size_t)b * SEQ;
    const LAS float* btab = (const LAS float*)(lds + D_OFF_TAB);
    const LAS float* gtab = (const LAS float*)(lds + D_OFF_G);
    const int kcolb = map * 64;
    i32x8 qf;
    { const unsigned char* qp = QD + (tok0 + qpos) * 1024 + h * 128 + map * 64 + 32 * hh; qf = cat8(*(const i32x4*)qp, *(const i32x4*)(qp + 16)); }
    f32x16 o[4];
#pragma unroll
    for (int dt = 0; dt < 4; ++dt)
#pragma unroll
        for (int i = 0; i < 16; ++i) o[dt][i] = 0.f;
    float mrun = 0.f, lrun = 0.f;
    const unsigned char* kbase = KDT + ((size_t)h * 256 + b * 128) * 8192;
    const unsigned char* vbase = VDT + ((size_t)h * 256 + b * 128) * 8192;
    const int NT = 2 * (qt + 1);
    TileRegs8 R;
    __syncthreads();
    if (tid < 128) { const int n = tid; ((LAS float*)(lds + D_OFF_TAB))[n] = (rel_bias[t5_bucket(n) * 16 + h] - rel_bias[31 * 16 + h]) * (LOG2E * 64.0f); ((LAS float*)(lds + D_OFF_G))[n] = subln[n]; }
    tile_load8(R, kbase, vbase, tid); tile_store8(R, lds, lds + KBUF8, tid);
    tile_load8(R, kbase + 8192, vbase + 8192, tid); tile_store8(R, lds + TBUF8, lds + TBUF8 + KBUF8, tid);
    if (NT > 2) tile_load8(R, kbase + 2 * 8192, vbase + 2 * 8192, tid);
    __syncthreads();
    i32x8 kf[2], vf[2];
    d8_load_kf(kf, lds, r, hh, kcolb);
#define D8_STAGE(t) do { if ((t) + 2 < NT) tile_store8(R, lds + (((t) + 2) & 3) * TBUF8, lds + (((t) + 2) & 3) * TBUF8 + KBUF8, tid); \
        if ((t) + 3 < NT) tile_load8(R, kbase + (size_t)((t) + 3) * 8192, vbase + (size_t)((t) + 3) * 8192, tid); \
        __syncthreads(); } while (0)
#pragma unroll 1
    for (int t = 0; t < NT; ++t) {
        const int k0 = 64 * t; const LAS unsigned char* tb = lds + (t & 3) * TBUF8;
        f32x16 s0, s1; d8_scores(s0, s1, kf, qf);
        d8_load_vf2<0>(vf, tb + KBUF8, r, hh); d8_load_kf(kf, lds + ((t + 1) & 3) * TBUF8, r, hh, kcolb); SBAR();
        const i32x8 P = d8_softmax(s0, s1, o, mrun, lrun, qpos, k0, (k0 + 63 > qw0), (qw0 - (k0 + 63) < 113), t == 0, btab, hh);
        if (wid >= 4) D8_STAGE(t);
        d8_pv(o, vf, P, tb + KBUF8, r, hh);
        if (wid < 4) D8_STAGE(t);
    }
#undef D8_STAGE
    __syncthreads();
    asm volatile("s_nop 15\n\ts_nop 15\n\ts_nop 15\n\ts_nop 15" ::: "memory");
    const float l = (lrun + __shfl_xor(lrun, 32)) * D8_VS;
    LAS float* xch = (LAS float*)lds + qsub * 4096 + lane;
    if (map == 1) {
        const float lam = *(const LAS float*)(lds + MISC_OFF + 68);
        const float f = lam / l;
#pragma unroll
        for (int dt = 0; dt < 4; ++dt)
#pragma unroll
            for (int i = 0; i < 16; ++i) xch[(dt * 16 + i) * 64] = o[dt][i] * f;
    }
    __syncthreads();
    if (map == 0) {
        const float i0 = 1.0f / l;
        float ss = 0.f;
#pragma unroll
        for (int dt = 0; dt < 4; ++dt)
#pragma unroll
            for (int i = 0; i < 16; ++i) { const float v = o[dt][i] * i0 - xch[(dt * 16 + i) * 64]; o[dt][i] = v; ss += v * v; }
        ss += __shfl_xor(ss, 32);
        const float rs = 0.8f / sqrtf(ss * (1.0f / 128.0f) + RMS_EPS);
        bf16_t* orow = AD + (tok0 + qpos) * 1024 + h * 128;
#pragma unroll
        for (int dt = 0; dt < 4; ++dt)
#pragma unroll
            for (int g = 0; g < 4; ++g) { const int d = 32 * dt + 8 * g + 4 * hh;
                const f32x4 gg = *(const LAS f32x4*)(gtab + d);
                if constexpr (O78F8) { const float r8 = rs * F8_SAD;
                    *(unsigned*)((unsigned char*)AD + (tok0 + qpos) * 1024 + h * 128 + d) = epi::pack4_f8(o[dt][4 * g + 0] * r8 * gg[0], o[dt][4 * g + 1] * r8 * gg[1], o[dt][4 * g + 2] * r8 * gg[2], o[dt][4 * g + 3] * r8 * gg[3]); }
                else { u32x2 w; w.x = cvtpk(o[dt][4 * g + 0] * rs * gg[0], o[dt][4 * g + 1] * rs * gg[1]); w.y = cvtpk(o[dt][4 * g + 2] * rs * gg[2], o[dt][4 * g + 3] * rs * gg[3]);
                *(u32x2*)(orow + d) = w; } }
    }
}

__device__ __forceinline__ void moba_unit(LAS unsigned char* lds, int b, int h, int n, const int* list, int cnt, const bf16_t* QM, const bf16_t* KMT, const bf16_t* VMT, bf16_t* PARTS, float* ML, const float* rel_bias) {
    int tid_ = threadIdx.x; asm volatile("" : "+v"(tid_));
    const int tid = tid_, lane = tid & 63, r = lane & 31, hh = lane >> 5; const int wid = __builtin_amdgcn_readfirstlane(tid >> 6);
    const size_t tok0 = (size_t)b * SEQ;
    const LAS float* btab = (const LAS float*)(lds + OFF_TAB);
    const float sc = 0.08838834764831845f * LOG2E;
    const bool own = (list == nullptr);
    const int li = 32 * wid + r;
    const bool lane_valid = li < cnt;
    int qpos, slot;
    if (own) { qpos = 256 * n + li; slot = 3; }
    else { const int e = list[lane_valid ? li : 0]; qpos = e >> 2; slot = e & 3; }
    const bool wave_active = (32 * wid < cnt);
    bf16x8 qf[1][8];
#pragma unroll
    for (int ks = 0; ks < 8; ++ks) qf[0][ks] = *(const bf16x8*)(QM + (tok0 + qpos) * 1024 + h * 128 + 16 * ks + 8 * hh);
    f32x16 O[1][4];
#pragma unroll
    for (int dt = 0; dt < 4; ++dt)
#pragma unroll
        for (int i = 0; i < 16; ++i) O[0][dt][i] = 0.f;
    float mrun[1] = {-INFINITY}, lrun[1] = {0.f};
    const bf16_t* kbase = KMT + ((size_t)h * 256 + b * 128 + 4 * n) * 8192;
    const bf16_t* vbase = VMT + ((size_t)h * 256 + b * 128 + 4 * n) * 8192;
    const int qw0 = 256 * n + 32 * wid;
    TileRegs R;
    __syncthreads();
    fill_bias_tab((LAS float*)(lds + OFF_TAB), rel_bias, 8 + h);
    tile_load(R, kbase, vbase, tid);
    tile_store(R, lds + OFF_K, lds + OFF_V, tid);
    __syncthreads();
#pragma unroll 1
    for (int t = 0; t < 4; ++t) {
        const int cur = t & 1;
        if (t + 1 < 4) tile_load(R, kbase + (size_t)(t + 1) * 8192, vbase + (size_t)(t + 1) * 8192, tid);
        if (wave_active) {
#pragma unroll 1
            for (int kh = 0; kh < 2; ++kh) {
                const int kp = 256 * n + 64 * t + 32 * kh;
                bool run = true, need_mask = false, need_bias;
                if (own) { run = (kp <= qw0 + 31); need_mask = (kp + 31 > qw0); need_bias = true; }
                else { need_bias = __any(qpos - (kp + 31) < 113); }
                if (run) attn_half<1, 8>(lds + OFF_K + cur * KBUF, lds + OFF_V + cur * VBUF, kh, qf, O, mrun, lrun, qpos, kp, need_mask, need_bias, btab, sc, r, hh, 0);
            }
        }
        if (t + 1 < 4) tile_store(R, lds + OFF_K + (cur ^ 1) * KBUF, lds + OFF_V + (cur ^ 1) * VBUF, tid);
        __syncthreads();
    }
    const float l = lrun[0] + __shfl_xor(lrun[0], 32);
    const float il = 1.0f / l;
    if (lane_valid) {
        const size_t pidx = ((tok0 + qpos) * 8 + h) * 4 + slot;
        bf16_t* orow = PARTS + pidx * 128;
#pragma unroll
        for (int dt = 0; dt < 4; ++dt)
#pragma unroll
            for (int g = 0; g < 4; ++g) { const int d = 32 * dt + 8 * g + 4 * hh;
                u32x2 w; w.x = cvtpk(O[0][dt][4 * g + 0] * il, O[0][dt][4 * g + 1] * il); w.y = cvtpk(O[0][dt][4 * g + 2] * il, O[0][dt][4 * g + 3] * il);
                *(u32x2*)(orow + d) = w; }
        if (hh == 0) *(f32x2*)(ML + pidx * 2) = (f32x2){mrun[0], l};
    }
}
constexpr int MB_K = 0, MB_V = 4 * KBUF, MB_INC = MB_V + 4 * VBUF, MB_TAB = MB_INC + 2048, MB_END = MB_TAB + 512;
static_assert(MB_END <= MISC_OFF, "MoBA block LDS");
__device__ __forceinline__ void moba_block(LAS unsigned char* lds, int b, int h, int n, const int* list, int cntl, int c0, int c1, const bf16_t* QM, const bf16_t* KMT, const bf16_t* VMT, bf16_t* PARTS, float* ML, const float* rel_bias) {
    int tid_ = threadIdx.x; asm volatile("" : "+v"(tid_));
    const int tid = tid_, lane = tid & 63, r = lane & 31, hh = lane >> 5; const int wid = __builtin_amdgcn_readfirstlane(tid >> 6);
    const size_t tok0 = (size_t)b * SEQ;
    const LAS float* btab = (const LAS float*)(lds + MB_TAB);
    const float sc = 0.08838834764831845f * LOG2E;
    const bf16_t* kbase = KMT + ((size_t)h * 256 + b * 128 + 4 * n) * 8192;
    const bf16_t* vbase = VMT + ((size_t)h * 256 + b * 128 + 4 * n) * 8192;
    __syncthreads();
    fill_bias_tab((LAS float*)(lds + MB_TAB), rel_bias, 8 + h);
    const int li = 32 * wid + r;
    const int cA = c0, cB = c0 + 1;
    const bool ownA = (cA == 0);
    const int cntA = ownA ? 256 : ((cntl - 256 * (cA - 1)) < 256 ? (cntl - 256 * (cA - 1)) : 256);
    const int cntB = (cB < c1) ? ((cntl - 256 * (cB - 1)) < 256 ? (cntl - 256 * (cB - 1)) : 256) : 0;
    const bool hasA = (32 * wid < cntA), hasB = (32 * wid < cntB);
    const bool lvA = li < cntA, lvB = li < cntB;
    int eA = 0, eB = 0;
    if (hasA && !ownA) eA = list[256 * (cA - 1) + (lvA ? li : 0)];
    if (hasB) eB = list[256 * (cB - 1) + (lvB ? li : 0)];
    TileRegs R, R2;
    tile_load(R, kbase, vbase, tid); tile_load(R2, kbase + 8192, vbase + 8192, tid);
    tile_store(R, lds + MB_K, lds + MB_V, tid); tile_load(R, kbase + 2 * 8192, vbase + 2 * 8192, tid);
    const int qposA = ownA ? 256 * n + li : (eA >> 2), slotA = ownA ? 3 : (eA & 3);
    const int qposB = eB >> 2, slotB = eB & 3;
    bf16x8 qfA[1][8], qfB[1][8];
    if (hasA) {
#pragma unroll
        for (int ks = 0; ks < 8; ++ks) qfA[0][ks] = *(const bf16x8*)(QM + (tok0 + qposA) * 1024 + h * 128 + 16 * ks + 8 * hh);
    }
    if (hasB) {
#pragma unroll
        for (int ks = 0; ks < 8; ++ks) qfB[0][ks] = *(const bf16x8*)(QM + (tok0 + qposB) * 1024 + h * 128 + 16 * ks + 8 * hh);
    }
    tile_store(R2, lds + MB_K + KBUF, lds + MB_V + VBUF, tid); tile_load(R2, kbase + 3 * 8192, vbase + 3 * 8192, tid);
    tile_store(R, lds + MB_K + 2 * KBUF, lds + MB_V + 2 * VBUF, tid);
    tile_store(R2, lds + MB_K + 3 * KBUF, lds + MB_V + 3 * VBUF, tid);
    __syncthreads();
#define MB_CHUNK(HAS, OWN, QF, QPOS, SLOT, LV) do { if (HAS) { \
        f32x16 O[1][4]; \
        _Pragma("unroll") for (int dt = 0; dt < 4; ++dt) _Pragma("unroll") for (int i = 0; i < 16; ++i) O[0][dt][i] = 0.f; \
        float mrun[1] = {-INFINITY}, lrun[1] = {0.f}; \
        const int qw0 = 256 * n + 32 * wid; \
        _Pragma("unroll 1") for (int t8 = 0; t8 < 8; ++t8) { \
            const int t = t8 >> 1, kh = t8 & 1; const int kp = 256 * n + 32 * t8; \
            bool run = true, need_mask = false, need_bias; \
            if (OWN) { run = (kp <= qw0 + 31); need_mask = (kp + 31 > qw0); need_bias = true; } \
            else { need_bias = __any((QPOS) - (kp + 31) < 113); } \
            if (run) attn_half<1, 8>(lds + MB_K + t * KBUF, lds + MB_V + t * VBUF, kh, QF, O, mrun, lrun, QPOS, kp, need_mask, need_bias, btab, sc, r, hh, 0); \
        } \
        const float l = lrun[0] + __shfl_xor(lrun[0], 32); const float il = 1.0f / l; \
        if (LV) { const size_t pidx = ((tok0 + (QPOS)) * 8 + h) * 4 + (SLOT); bf16_t* orow = PARTS + pidx * 128; \
            _Pragma("unroll") for (int dt = 0; dt < 4; ++dt) _Pragma("unroll") for (int g = 0; g < 4; ++g) { const int d = 32 * dt + 8 * g + 4 * hh; \
                u32x2 w; w.x = cvtpk(O[0][dt][4 * g + 0] * il, O[0][dt][4 * g + 1] * il); w.y = cvtpk(O[0][dt][4 * g + 2] * il, O[0][dt][4 * g + 3] * il); \
                *(u32x2*)(orow + d) = w; } \
            if (hh == 0) *(f32x2*)(ML + pidx * 2) = (f32x2){mrun[0], l}; } } } while (0)
    MB_CHUNK(hasA, ownA, qfA, qposA, slotA, lvA);
    MB_CHUNK(hasB, false, qfB, qposB, slotB, lvB);
#undef MB_CHUNK
}
constexpr int MB8_TAB = 4 * TBUF8;
static_assert(MB8_TAB + 512 <= MB_INC, "fp8 MoBA block LDS");
__device__ __forceinline__ void moba_block8(LAS unsigned char* lds, int b, int h, int n, const int* list, int cntl, int c0, int c1, const unsigned char* QM8, const unsigned char* KMT8, const unsigned char* VMT8, bf16_t* PARTS, float* ML, const float* rel_bias) {
    int tid_ = threadIdx.x; asm volatile("" : "+v"(tid_));
    const int tid = tid_, lane = tid & 63, r = lane & 31, hh = lane >> 5; const int wid = __builtin_amdgcn_readfirstlane(tid >> 6);
    const size_t tok0 = (size_t)b * SEQ;
    const LAS float* btab = (const LAS float*)(lds + MB8_TAB);
    const unsigned char* kbase = KMT8 + ((size_t)h * 256 + b * 128 + 4 * n) * 8192;
    const unsigned char* vbase = VMT8 + ((size_t)h * 256 + b * 128 + 4 * n) * 8192;
    __syncthreads();
    if (tid < 128) { const int q = tid; ((LAS float*)(lds + MB8_TAB))[q] = (rel_bias[t5_bucket(q) * 16 + 8 + h] - rel_bias[31 * 16 + 8 + h]) * (LOG2E * 64.0f); }
    const int li = 32 * wid + r;
    const int cA = c0, cB = c0 + 1;
    const bool ownA = (cA == 0);
    const int cntA = ownA ? 256 : ((cntl - 256 * (cA - 1)) < 256 ? (cntl - 256 * (cA - 1)) : 256);
    const int cntB = (cB < c1) ? ((cntl - 256 * (cB - 1)) < 256 ? (cntl - 256 * (cB - 1)) : 256) : 0;
    const bool hasA = (32 * wid < cntA), hasB = (32 * wid < cntB);
    const bool lvA = li < cntA, lvB = li < cntB;
    int eA = 0, eB = 0;
    if (hasA && !ownA) eA = list[256 * (cA - 1) + (lvA ? li : 0)];
    if (hasB) eB = list[256 * (cB - 1) + (lvB ? li : 0)];
    TileRegs8 R0, R1, R2, R3;
    tile_load8(R0, kbase, vbase, tid); tile_load8(R1, kbase + 8192, vbase + 8192, tid); tile_load8(R2, kbase + 2 * 8192, vbase + 2 * 8192, tid); tile_load8(R3, kbase + 3 * 8192, vbase + 3 * 8192, tid);
    SBAR();
    tile_store8(R0, lds, lds + KBUF8, tid);
    const int qposA = ownA ? 256 * n + li : (eA >> 2), slotA = ownA ? 3 : (eA & 3);
    const int qposB = eB >> 2, slotB = eB & 3;
    i32x8 qf[2];
    if (hasA) { const unsigned char* qp = QM8 + (tok0 + qposA) * 1024 + h * 128 + 32 * hh; qf[0] = cat8(*(const i32x4*)qp, *(const i32x4*)(qp + 16)); qf[1] = cat8(*(const i32x4*)(qp + 64), *(const i32x4*)(qp + 80)); }
    tile_store8(R1, lds + TBUF8, lds + TBUF8 + KBUF8, tid);
    tile_store8(R2, lds + 2 * TBUF8, lds + 2 * TBUF8 + KBUF8, tid);
    tile_store8(R3, lds + 3 * TBUF8, lds + 3 * TBUF8 + KBUF8, tid);
    __syncthreads();
#define MB8_LOADQB() do { if (hasB) { const unsigned char* qp = QM8 + (tok0 + qposB) * 1024 + h * 128 + 32 * hh; qf[0] = cat8(*(const i32x4*)qp, *(const i32x4*)(qp + 16)); qf[1] = cat8(*(const i32x4*)(qp + 64), *(const i32x4*)(qp + 80)); } } while (0)
#define MB8_CHUNK(HAS, OWN, QPOS, SLOT, LV, NEXTQ) do { if (HAS) { \
        f32x16 o[4]; \
        _Pragma("unroll") for (int dt = 0; dt < 4; ++dt) _Pragma("unroll") for (int i = 0; i < 16; ++i) o[dt][i] = 0.f; \
        float mref = -INFINITY, lrun = 0.f; \
        const int qw0 = 256 * n + 32 * wid; \
        _Pragma("unroll 1") for (int t = 0; t < 4; ++t) { \
            const int kp = 256 * n + 64 * t; const LAS unsigned char* tb = lds + t * TBUF8; \
            bool run = true, need_mask = false, need_bias; \
            if (OWN) { run = (kp <= qw0 + 31); need_mask = (kp + 63 > qw0); need_bias = (qw0 - (kp + 63) < 113); } \
            else { need_bias = __any((QPOS) - (kp + 63) < 113); } \
            if (run) { \
                i32x8 ka[2], kc[2], vf[2]; \
                d8_load_kf(ka, tb, r, hh, 0); d8_load_kf(kc, tb, r, hh, 64); \
                f32x16 s0, s1; d8_scores(s0, s1, ka, qf[0]); \
                __builtin_amdgcn_s_setprio(1); \
                s0 = __builtin_amdgcn_mfma_scale_f32_32x32x64_f8f6f4(kc[0], qf[1], s0, 0, 0, 0, 0x7F7F7F7F, 0, 0x7F7F7F7F); \
                s1 = __builtin_amdgcn_mfma_scale_f32_32x32x64_f8f6f4(kc[1], qf[1], s1, 0, 0, 0, 0x7F7F7F7F, 0, 0x7F7F7F7F); \
                __builtin_amdgcn_s_setprio(0); \
                d8_load_vf2<0>(vf, tb + KBUF8, r, hh); SBAR(); \
                const i32x8 P = d8_softmax<true>(s0, s1, o, mref, lrun, QPOS, kp, need_mask, need_bias, false, btab, hh); \
                d8_pv(o, vf, P, tb + KBUF8, r, hh); \
            } \
        } \
        NEXTQ; \
        asm volatile("s_nop 15\n\ts_nop 15\n\ts_nop 15\n\ts_nop 15" ::: "memory");        \
        const float l = lrun + __shfl_xor(lrun, 32); const float il = 1.0f / (l * D8_VS); \
        if (LV) { const size_t pidx = ((tok0 + (QPOS)) * 8 + h) * 4 + (SLOT); bf16_t* orow = PARTS + pidx * 128; \
            _Pragma("unroll") for (int dt = 0; dt < 4; ++dt) _Pragma("unroll") for (int g = 0; g < 4; ++g) { const int d = 32 * dt + 8 * g + 4 * hh; \
                u32x2 w; w.x = cvtpk(o[dt][4 * g + 0] * il, o[dt][4 * g + 1] * il); w.y = cvtpk(o[dt][4 * g + 2] * il, o[dt][4 * g + 3] * il); \
                *(u32x2*)(orow + d) = w; } \
            if (hh == 0) *(f32x2*)(ML + pidx * 2) = (f32x2){mref * D8_C - D8_SH, l}; } } else { NEXTQ; } } while (0)
    MB8_CHUNK(hasA, ownA, qposA, slotA, lvA, MB8_LOADQB());
    MB8_CHUNK(hasB, false, qposB, slotB, lvB, (void)0);
#undef MB8_CHUNK
#undef MB8_LOADQB
}
}

struct Ctx {
    LAS unsigned char* lds;
    unsigned char* ws; unsigned* ctl;
    const float* const* in; float* out;
    int tid, lane, wave, G, blk;
};
enum { I_X = 0, I_C, I_WADA, I_BADA, I_GMIX, I_GFFN, I_WIN, I_LAMBDA, I_SUBLN, I_RELB, I_WOD, I_WOM, I_WOUT, I_WROUTER, I_RBIAS, I_WEG, I_WEU, I_WED, I_WSG, I_WSU, I_WSD, I_GFINAL };

constexpr int TR_SCR = 64 * 65 * 4 + 128;
static_assert(8 * TR_SCR <= RING_BYTES + 16384, "transpose scratch");
template <bool NT>
__device__ __forceinline__ void transpose_item(const float* __restrict__ W, int K, int N, bf16_t* __restrict__ WT, int drow0, int k0, int n0, LAS float* scr, int lane) {
    const int nq = lane & 15, kr = lane >> 4;
    f32x4 v[16];
#pragma unroll
    for (int i = 0; i < 16; ++i) { const f32x4* p = (const f32x4*)(W + (size_t)(k0 + 4 * i + kr) * N + n0 + 4 * nq); v[i] = NT ? __builtin_nontemporal_load(p) : *p; }
#pragma unroll
    for (int i = 0; i < 16; ++i) { LAS float* d = scr + (4 * i + kr) * 65 + 4 * nq; d[0] = v[i][0]; d[1] = v[i][1]; d[2] = v[i][2]; d[3] = v[i][3]; }
    LDS_WAIT(); asm volatile("" ::: "memory");
    const int c = lane & 7;
#pragma unroll
    for (int j = 0; j < 8; ++j) { const int n = (lane >> 3) + 8 * j; const LAS float* s = scr + (8 * c) * 65 + n;
        u32x4 o; o.x = cvtpk(s[0 * 65], s[1 * 65]); o.y = cvtpk(s[2 * 65], s[3 * 65]); o.z = cvtpk(s[4 * 65], s[5 * 65]); o.w = cvtpk(s[6 * 65], s[7 * 65]);
        u32x4* q = (u32x4*)(WT + (size_t)(drow0 + n) * K + k0 + 8 * c); if (NT) __builtin_nontemporal_store(o, q); else *q = o; }
    LDS_WAIT(); asm volatile("" ::: "memory");
}
template <bool NT>
__device__ __forceinline__ void transpose_item_f8(const float* __restrict__ W, int K, int N, unsigned char* __restrict__ WT, int drow0, int k0, int n0, LAS float* scr, int lane, float scale) {
    const int nq = lane & 15, kr = lane >> 4;
    f32x4 v[16];
#pragma unroll
    for (int i = 0; i < 16; ++i) { const f32x4* p = (const f32x4*)(W + (size_t)(k0 + 4 * i + kr) * N + n0 + 4 * nq); v[i] = NT ? __builtin_nontemporal_load(p) : *p; }
#pragma unroll
    for (int i = 0; i < 16; ++i) { LAS float* d = scr + (4 * i + kr) * 65 + 4 * nq; d[0] = v[i][0] * scale; d[1] = v[i][1] * scale; d[2] = v[i][2] * scale; d[3] = v[i][3] * scale; }
    LDS_WAIT(); asm volatile("" ::: "memory");
    const int c = lane & 7;
#pragma unroll
    for (int j = 0; j < 8; ++j) { const int n = (lane >> 3) + 8 * j; const LAS float* s = scr + (8 * c) * 65 + n;
        const u32x2 o = {epi::pack4_f8(s[0 * 65], s[1 * 65], s[2 * 65], s[3 * 65]), epi::pack4_f8(s[4 * 65], s[5 * 65], s[6 * 65], s[7 * 65])};
        u32x2* q = (u32x2*)(WT + (size_t)(drow0 + n) * K + k0 + 8 * c); if (NT) __builtin_nontemporal_store(o, q); else *q = o; }
    LDS_WAIT(); asm volatile("" ::: "memory");
}
struct CvItemF8 { const float* W; unsigned char* WT; int K, N, drow0, k0, n0; float scale; };
__device__ __forceinline__ void transpose_pair_f8(const CvItemF8& A, const CvItemF8& B, LAS float* scr, int lane) {
    const int nq = lane & 15, kr = lane >> 4, c = lane & 7;
    f32x4 va[16], vb[16];
#pragma unroll
    for (int i = 0; i < 16; ++i) va[i] = __builtin_nontemporal_load((const f32x4*)(A.W + (size_t)(A.k0 + 4 * i + kr) * A.N + A.n0 + 4 * nq));
#pragma unroll
    for (int i = 0; i < 16; ++i) vb[i] = __builtin_nontemporal_load((const f32x4*)(B.W + (size_t)(B.k0 + 4 * i + kr) * B.N + B.n0 + 4 * nq));
    __builtin_amdgcn_sched_barrier(0);
#pragma unroll
    for (int i = 0; i < 16; ++i) { LAS float* d = scr + (4 * i + kr) * 65 + 4 * nq; d[0] = va[i][0] * A.scale; d[1] = va[i][1] * A.scale; d[2] = va[i][2] * A.scale; d[3] = va[i][3] * A.scale; }
    LDS_WAIT(); asm volatile("" ::: "memory");
#pragma unroll
    for (int j = 0; j < 8; ++j) { const int n = (lane >> 3) + 8 * j; const LAS float* s = scr + (8 * c) * 65 + n;
        const u32x2 o = {epi::pack4_f8(s[0 * 65], s[1 * 65], s[2 * 65], s[3 * 65]), epi::pack4_f8(s[4 * 65], s[5 * 65], s[6 * 65], s[7 * 65])};
        __builtin_nontemporal_store(o, (u32x2*)(A.WT + (size_t)(A.drow0 + n) * A.K + A.k0 + 8 * c)); }
    LDS_WAIT(); asm volatile("" ::: "memory");
#pragma unroll
    for (int i = 0; i < 16; ++i) { LAS float* d = scr + (4 * i + kr) * 65 + 4 * nq; d[0] = vb[i][0] * B.scale; d[1] = vb[i][1] * B.scale; d[2] = vb[i][2] * B.scale; d[3] = vb[i][3] * B.scale; }
    LDS_WAIT(); asm volatile("" ::: "memory");
#pragma unroll
    for (int j = 0; j < 8; ++j) { const int n = (lane >> 3) + 8 * j; const LAS float* s = scr + (8 * c) * 65 + n;
        const u32x2 o = {epi::pack4_f8(s[0 * 65], s[1 * 65], s[2 * 65], s[3 * 65]), epi::pack4_f8(s[4 * 65], s[5 * 65], s[6 * 65], s[7 * 65])};
        __builtin_nontemporal_store(o, (u32x2*)(B.WT + (size_t)(B.drow0 + n) * B.K + B.k0 + 8 * c)); }
    LDS_WAIT(); asm volatile("" ::: "memory");
}
__device__ __forceinline__ int gu_row(int n0, int up) { return 256 * (n0 >> 7) + 128 * up + (n0 & 127); }

__device__ __forceinline__ int win_row(int n) { return n < 2048 ? n : (n < 3072 ? 8192 + (n - 2048) : (n < 5120 ? 2048 + (n - 3072) : (n < 6144 ? 9216 + (n - 5120) : 4096 + (n - 6144)))); }
__device__ __forceinline__ void p0_prologue(Ctx& F) {
    const int gw = F.blk * 8 + F.wave, NGW = F.G * 8;
    unsigned char* ws = F.ws;
    {
        const float* wada = F.in[I_WADA]; const float* c = F.in[I_C]; float* modp = (float*)(ws + WS_MODP);
        for (int it = gw; it < 48 * 32; it += NGW) {
            const int cc = it % 48, ks = it / 48, col = 256 * cc + 4 * F.lane;
            f32x4 a0 = {0.f, 0.f, 0.f, 0.f}, a1 = {0.f, 0.f, 0.f, 0.f};
#pragma unroll 8
            for (int k = 64 * ks; k < 64 * ks + 64; ++k) {
                const f32x4 w = *(const f32x4*)(wada + (size_t)k * 12288 + col);
                const float c0 = c[k], c1 = c[2048 + k];
                a0 += w * siluf_(c0); a1 += w * siluf_(c1);
            }
            *(f32x4*)(modp + ((size_t)ks * 2 + 0) * 12288 + col) = a0;
            *(f32x4*)(modp + ((size_t)ks * 2 + 1) * 12288 + col) = a1;
        }
    }
    {
        LAS float* scr = (LAS float*)(F.lds + F.wave * TR_SCR);
        constexpr int I0 = 5120, I1 = I0 + 512, I2 = I1 + 512, I3 = I2 + 1024, I4 = I3 + 256, I5 = I4 + 256, I6 = I5 + 256;
        for (int it = gw; it < I6; it += NGW) {
            if (it < I0) { const int r = it, kb = r / 160, nb = r % 160; if constexpr (P2F8) transpose_item_f8<false>(F.in[I_WIN], 2048, 10240, ws + WS_W_IN_T, win_row(64 * nb), 64 * kb, 64 * nb, scr, F.lane, F8_SW); else transpose_item<false>(F.in[I_WIN], 2048, 10240, (bf16_t*)(ws + WS_W_IN_T), win_row(64 * nb), 64 * kb, 64 * nb, scr, F.lane); }
            else if (it < I1) { const int r = it - I0, kb = r / 32, nb = r % 32; if constexpr (O78F8) transpose_item_f8<false>(F.in[I_WOD], 1024, 2048, ws + WS_W_OD_T, 64 * nb, 64 * kb, 64 * nb, scr, F.lane, F8_SWO); else transpose_item<false>(F.in[I_WOD], 1024, 2048, (bf16_t*)(ws + WS_W_OD_T), 64 * nb, 64 * kb, 64 * nb, scr, F.lane); }
            else if (it < I2) { const int r = it - I1, kb = r / 32, nb = r % 32; if constexpr (O78F8) transpose_item_f8<false>(F.in[I_WOM], 1024, 2048, ws + WS_W_OM_T, 64 * nb, 64 * kb, 64 * nb, scr, F.lane, F8_SWO); else transpose_item<false>(F.in[I_WOM], 1024, 2048, (bf16_t*)(ws + WS_W_OM_T), 64 * nb, 64 * kb, 64 * nb, scr, F.lane); }
            else if (it < I3) { const int r = it - I2, kb = r / 32, nb = r % 32; if constexpr (O78F8) transpose_item_f8<false>(F.in[I_WOUT], 2048, 2048, ws + WS_W_OUT_T, 64 * nb, 64 * kb, 64 * nb, scr, F.lane, F8_SWOUT); else transpose_item<false>(F.in[I_WOUT], 2048, 2048, (bf16_t*)(ws + WS_W_OUT_T), 64 * nb, 64 * kb, 64 * nb, scr, F.lane); }
            else if (it < I4) { const int r = it - I3, kb = r / 8, nb = r % 8; transpose_item_f8<false>(F.in[I_WSG], 2048, 512, ws + WS_W_SHGU_T, gu_row(64 * nb, 0), 64 * kb, 64 * nb, scr, F.lane, F8_SW); }
            else if (it < I5) { const int r = it - I4, kb = r / 8, nb = r % 8; transpose_item_f8<false>(F.in[I_WSU], 2048, 512, ws + WS_W_SHGU_T, gu_row(64 * nb, 1), 64 * kb, 64 * nb, scr, F.lane, F8_SW); }
            else { const int r = it - I5, kb = r / 32, nb = r % 32; transpose_item_f8<false>(F.in[I_WSD], 512, 2048, ws + WS_W_SHD_T, 64 * nb, 64 * kb, 64 * nb, scr, F.lane, F8_SD); }
        }
    }
    {
        const float* wr = F.in[I_WROUTER]; bf16_t* hi = (bf16_t*)(ws + WS_WR); bf16_t* lo = hi + 64 * 2048;
        for (int idx = F.blk * 512 + F.tid; idx < 2048 * 64; idx += F.G * 512) {
            const int k = idx >> 6, e = idx & 63; const float w = wr[idx];
            const unsigned h16 = cvtpk(w, 0.f) & 0xffffu; const float res = w - __uint_as_float(h16 << 16);
            hi[e * 2048 + k] = (bf16_t)h16; lo[e * 2048 + k] = (bf16_t)(cvtpk(res, 0.f) & 0xffffu);
        }
    }
}

constexpr int CV_NCHUNK = 1536;
struct CvItem { const float* W; unsigned char* WT; int K, N, drow0, k0, n0; float scale; };
__device__ __forceinline__ CvItem cv_decode(Ctx& F, int it) {
    unsigned char* ws = F.ws; CvItem c;
    if (it < 16384) { const int r = it, e = r >> 8, r2 = r & 255, kb = r2 / 8, nb = r2 % 8;
        c.W = F.in[I_WEG] + (size_t)e * 2048 * 512; c.WT = ws + WS_W_EGU_T + (size_t)e * 1024 * 2048; c.scale = F8_SW; c.K = 2048; c.N = 512; c.drow0 = gu_row(64 * nb, 0); c.k0 = 64 * kb; c.n0 = 64 * nb; }
    else if (it < 32768) { const int r = it - 16384, e = r >> 8, r2 = r & 255, kb = r2 / 8, nb = r2 % 8;
        c.W = F.in[I_WEU] + (size_t)e * 2048 * 512; c.WT = ws + WS_W_EGU_T + (size_t)e * 1024 * 2048; c.scale = F8_SW; c.K = 2048; c.N = 512; c.drow0 = gu_row(64 * nb, 1); c.k0 = 64 * kb; c.n0 = 64 * nb; }
    else { const int r = it - 32768, e = r >> 8, r2 = r & 255, kb = r2 / 32, nb = r2 % 32;
        c.W = F.in[I_WED] + (size_t)e * 512 * 2048; c.WT = ws + WS_W_ED_T + (size_t)e * 2048 * 512; c.scale = F8_SD; c.K = 512; c.N = 2048; c.drow0 = 64 * nb; c.k0 = 64 * kb; c.n0 = 64 * nb; }
    return c;
}
__device__ __forceinline__ void convert_chunk(Ctx& F, int chunk) {
    LAS float* scr = (LAS float*)(F.lds + F.wave * TR_SCR);
    int lane = F.lane; asm volatile("" : "+v"(lane));
    const int it0 = chunk * 32 + F.wave * 4;
#pragma unroll 1
    for (int i = 0; i < 4; i += 2) { const CvItem a = cv_decode(F, it0 + i), b = cv_decode(F, it0 + i + 1);
        transpose_pair_f8(CvItemF8{a.W, a.WT, a.K, a.N, a.drow0, a.k0, a.n0, a.scale}, CvItemF8{b.W, b.WT, b.K, b.N, b.drow0, b.k0, b.n0, b.scale}, scr, lane); }
}
__device__ __forceinline__ int queue_take(Ctx& F, unsigned* head) {
    volatile LAS int* slot = (volatile LAS int*)(F.lds + MISC_OFF + 64);
    __syncthreads();
    if (F.tid == 0) *slot = (int)__hip_atomic_fetch_add(head, 1u, RLX_AGENT);
    __syncthreads();
    return *slot;
}

__device__ __forceinline__ void fill_mod_tables(Ctx& F, const float* gain, int shift_off, int scale_off, bool from_partials, int bsel = -1) {
    LAS float* A = (LAS float*)F.lds; LAS float* Bt = (LAS float*)(F.lds + 16384);
    const float* modp = (const float*)(F.ws + WS_MODP); const float* modf = (const float*)(F.ws + WS_MOD); const float* bada = F.in[I_BADA];
    const int lo = bsel < 0 ? 0 : bsel * 2048, hi = bsel < 0 ? 4096 : lo + 2048;
    for (int idx = lo + F.tid; idx < hi; idx += 512) {
        const int b = idx >> 11, c = idx & 2047;
        float sh, scl;
        if (from_partials) {
            sh = bada[shift_off + c]; scl = bada[scale_off + c];
#pragma unroll 16
            for (int ks = 0; ks < 32; ++ks) { sh += modp[((size_t)ks * 2 + b) * 12288 + shift_off + c]; scl += modp[((size_t)ks * 2 + b) * 12288 + scale_off + c]; }
        } else { sh = modf[b * 12288 + shift_off + c]; scl = modf[b * 12288 + scale_off + c]; }
        A[idx] = gain[c] * (1.0f + scl); Bt[idx] = sh;
    }
    __syncthreads();
}

__device__ __forceinline__ void p1_norm(Ctx& F) {
    { const float* modp = (const float*)(F.ws + WS_MODP); float* modf = (float*)(F.ws + WS_MOD); const float* bada = F.in[I_BADA];
      for (int idx = F.blk * 512 + F.tid; idx < 2 * 12288; idx += F.G * 512) { const int b = idx / 12288, j = idx % 12288; float s = bada[j];
#pragma unroll 8
          for (int ks = 0; ks < 32; ++ks) s += modp[((size_t)ks * 2 + b) * 12288 + j];
          modf[idx] = s; } }
    const int rpb = T / F.G;
    const bool one_batch = (F.G * rpb == T) && (SEQ % rpb == 0);
    const int row_lo = one_batch ? F.blk * rpb : 0, row_hi = one_batch ? row_lo + rpb : T, rstep = one_batch ? 8 : F.G * 8, r0 = one_batch ? row_lo + F.wave : F.blk * 8 + F.wave;
    fill_mod_tables(F, F.in[I_GMIX], 0, 2048, true, one_batch ? row_lo / SEQ : -1);
    const LAS float* A = (const LAS float*)F.lds; const LAS float* Bt = (const LAS float*)(F.lds + 16384);
    const float* x = F.in[I_X]; bf16_t* H = (bf16_t*)(F.ws + WS_H);
    for (int row = r0; row < row_hi; row += 2 * rstep) {
        const int row2 = row + rstep; const bool has2 = row2 < row_hi;
        const int b = row / SEQ, b2 = has2 ? row2 / SEQ : b;
        const f32x4* xr = (const f32x4*)(x + (size_t)row * 2048) + F.lane;
        const f32x4* xr2 = (const f32x4*)(x + (size_t)(has2 ? row2 : row) * 2048) + F.lane;
        f32x4 v[8], v2[8]; float ss = 0.f, ss2 = 0.f;
#pragma unroll
        for (int j = 0; j < 8; ++j) { v[j] = __builtin_nontemporal_load(xr + 64 * j); v2[j] = __builtin_nontemporal_load(xr2 + 64 * j); }
#pragma unroll
        for (int j = 0; j < 8; ++j) { ss += (v[j].x * v[j].x + v[j].y * v[j].y) + (v[j].z * v[j].z + v[j].w * v[j].w); ss2 += (v2[j].x * v2[j].x + v2[j].y * v2[j].y) + (v2[j].z * v2[j].z + v2[j].w * v2[j].w); }
        const float rstd = 1.0f / sqrtf(wave_sum(ss) * (1.0f / 2048.0f) + RMS_EPS), rstd2 = 1.0f / sqrtf(wave_sum(ss2) * (1.0f / 2048.0f) + RMS_EPS);
        unsigned long long* o8 = (unsigned long long*)(H + (size_t)row * 2048) + F.lane;
        unsigned long long* o82 = (unsigned long long*)(H + (size_t)row2 * 2048) + F.lane;
#pragma unroll
        for (int j = 0; j < 8; ++j) { const int c = 4 * F.lane + 256 * j;
            const f32x4 a = *(const LAS f32x4*)(A + b * 2048 + c), sft = *(const LAS f32x4*)(Bt + b * 2048 + c);
            const f32x4 y = v[j] * rstd * a + sft;
            if constexpr (P2F8) ((unsigned*)((unsigned char*)H + (size_t)row * 2048))[F.lane + 64 * j] = epi::pack4_f8(y.x * F8_SH, y.y * F8_SH, y.z * F8_SH, y.w * F8_SH);
            else o8[64 * j] = (unsigned long long)cvtpk(y.x, y.y) | ((unsigned long long)cvtpk(y.z, y.w) << 32);
            if (has2) { const f32x4 a2 = *(const LAS f32x4*)(A + b2 * 2048 + c), sft2 = *(const LAS f32x4*)(Bt + b2 * 2048 + c);
                const f32x4 y2 = v2[j] * rstd2 * a2 + sft2;
                if constexpr (P2F8) ((unsigned*)((unsigned char*)H + (size_t)row2 * 2048))[F.lane + 64 * j] = epi::pack4_f8(y2.x * F8_SH, y2.y * F8_SH, y2.z * F8_SH, y2.w * F8_SH);
                else o82[64 * j] = (unsigned long long)cvtpk(y2.x, y2.y) | ((unsigned long long)cvtpk(y2.z, y2.w) << 32); } }
    }
}

__device__ __forceinline__ void p3_kmean(Ctx& F) {
    const bf16_t* KMT = (const bf16_t*)(F.ws + WS_KMT); float* KM = (float*)(F.ws + WS_KMEAN);
    LAS float* red = (LAS float*)F.lds;
    for (int item = F.blk; item < 512; item += F.G) {
        const int b = item >> 8, h = (item >> 5) & 7, n = item & 31;
        const int cp = F.tid & 63, rg = F.tid >> 6;
        const bf16_t* base = KMT + (((size_t)h * 256 + b * 128 + 4 * n) * 64 + 32 * rg) * 128 + 2 * cp;
        float s0 = 0.f, s1 = 0.f;
#pragma unroll 8
        for (int rr = 0; rr < 32; ++rr) { const unsigned u = *(const unsigned*)(base + (size_t)rr * 128); s0 += bf_lo(u); s1 += bf_hi(u); }
        __syncthreads();
        red[rg * 128 + 2 * cp] = s0; red[rg * 128 + 2 * cp + 1] = s1;
        __syncthreads();
        if (F.tid < 128) { float s = 0.f;
#pragma unroll
            for (int g = 0; g < 8; ++g) s += red[g * 128 + F.tid];
            KM[(size_t)item * 128 + F.tid] = s * (1.0f / 256.0f); }
    }
    __syncthreads();
}

__device__ __forceinline__ void p4_gating(Ctx& F) {
    const bf16_t* QM = (const bf16_t*)(F.ws + WS_QM); const float* KM = (const float*)(F.ws + WS_KMEAN);
    float* ML = (float*)(F.ws + WS_ML); int* MLIST = (int*)(F.ws + WS_MLIST); unsigned* mcnt = F.ctl + CW_MCNT;
    for (int grp = F.blk; grp < T / 64; grp += F.G) {
        const int h = F.wave, tok = grp * 64 + F.lane, b = tok / SEQ, qs = tok % SEQ, cur = qs >> 8;
        const int curu = __builtin_amdgcn_readfirstlane(cur), bu = __builtin_amdgcn_readfirstlane(b);
        float q[128];
        const u32x4* qp = (const u32x4*)(QM + (size_t)tok * 1024 + h * 128);
#pragma unroll
        for (int i = 0; i < 16; ++i) { const u32x4 u = qp[i]; q[8 * i + 0] = bf_lo(u.x); q[8 * i + 1] = bf_hi(u.x); q[8 * i + 2] = bf_lo(u.y); q[8 * i + 3] = bf_hi(u.y);
            q[8 * i + 4] = bf_lo(u.z); q[8 * i + 5] = bf_hi(u.z); q[8 * i + 6] = bf_lo(u.w); q[8 * i + 7] = bf_hi(u.w); }
        float v0 = -INFINITY, v1 = -INFINITY, v2 = -INFINITY; int i0 = -1, i1 = -1, i2 = -1;
        const float* kmb = KM + (size_t)((bu * 8 + h) * 32) * 128;
        for (int n = 0; n < curu; ++n) {
            const float* km = kmb + n * 128;
            float a0 = 0.f, a1 = 0.f, a2 = 0.f, a3 = 0.f;
#pragma unroll
            for (int d = 0; d < 128; d += 4) { a0 += q[d] * km[d]; a1 += q[d + 1] * km[d + 1]; a2 += q[d + 2] * km[d + 2]; a3 += q[d + 3] * km[d + 3]; }
            const float s = (a0 + a1) + (a2 + a3);
            if (s > v0) { v2 = v1; i2 = i1; v1 = v0; i1 = i0; v0 = s; i0 = n; }
            else if (s > v1) { v2 = v1; i2 = i1; v1 = s; i1 = n; }
            else if (s > v2) { v2 = s; i2 = n; }
        }
        float* ml = ML + ((size_t)tok * 8 + h) * 8;
        if (i0 < 0) *(f32x2*)(ml + 0) = (f32x2){-INFINITY, 0.f};
        if (i1 < 0) *(f32x2*)(ml + 2) = (f32x2){-INFINITY, 0.f};
        if (i2 < 0) *(f32x2*)(ml + 4) = (f32x2){-INFINITY, 0.f};
        for (int n = 0; n < curu; ++n) {
            const bool hit = (i0 == n) || (i1 == n) || (i2 == n);
            const unsigned long long mask = __ballot(hit);
            if (mask) {
                const int cntw = __popcll(mask);
                unsigned base = 0;
                if (F.lane == 0) base = __hip_atomic_fetch_add(mcnt + ((bu * 8 + h) * 32 + n), (unsigned)cntw, RLX_AGENT);
                base = __builtin_amdgcn_readfirstlane(base);
                if (hit) { const int pos = base + __popcll(mask & ((1ull << F.lane) - 1ull)); const int slot = (i0 == n) ? 0 : ((i1 == n) ? 1 : 2);
                    MLIST[(size_t)((bu * 8 + h) * 32 + n) * 8192 + pos] = (qs << 2) | slot; }
            }
        }
    }
}

__device__ __forceinline__ void p6_merge(Ctx& F) {
    const bf16_t* PARTS = (const bf16_t*)(F.ws + WS_PARTS); const float* ML = (const float*)(F.ws + WS_ML); bf16_t* AM = (bf16_t*)(F.ws + WS_AM);
    const int gw = F.blk * 8 + F.wave, NGW = F.G * 8;
    for (int tok = gw; tok < T; tok += NGW) {
        f32x4 ml01[2], ml23[2]; u32x4 pu[2][4];
#pragma unroll
        for (int i = 0; i < 2; ++i) {
            const int item = F.lane + 64 * i, h = item >> 4, ch = item & 15;
            const float* ml = ML + ((size_t)tok * 8 + h) * 8;
            ml01[i] = *(const f32x4*)ml; ml23[i] = *(const f32x4*)(ml + 4);
            const bf16_t* pb = PARTS + (((size_t)tok * 8 + h) * 4) * 128 + ch * 8;
#pragma unroll
            for (int s4 = 0; s4 < 4; ++s4) pu[i][s4] = __builtin_nontemporal_load((const u32x4*)(pb + s4 * 128));
        }
#pragma unroll
        for (int i = 0; i < 2; ++i) {
            const int item = F.lane + 64 * i, h = item >> 4, ch = item & 15;
            const float m0 = ml01[i][0], l0 = ml01[i][1], m1 = ml01[i][2], l1 = ml01[i][3], m2 = ml23[i][0], l2 = ml23[i][1], m3 = ml23[i][2], l3 = ml23[i][3];
            const float M = fmaxf(fmaxf(m0, m1), fmaxf(m2, m3));
            const float w0 = l0 * fast_exp2(m0 - M), w1 = l1 * fast_exp2(m1 - M), w2 = l2 * fast_exp2(m2 - M), w3 = l3 * fast_exp2(m3 - M);
            const float inv = 1.0f / (w0 + w1 + w2 + w3);
            float acc[8];
#pragma unroll
            for (int j = 0; j < 8; ++j) acc[j] = 0.f;
            const float ws4[4] = {w0, w1, w2, w3};
#pragma unroll
            for (int s4 = 0; s4 < 4; ++s4) {
                const float w = ws4[s4]; u32x4 u = pu[i][s4];
                if (!(w > 0.f)) u = (u32x4){0u, 0u, 0u, 0u};
                acc[0] += w * bf_lo(u.x); acc[1] += w * bf_hi(u.x); acc[2] += w * bf_lo(u.y); acc[3] += w * bf_hi(u.y);
                acc[4] += w * bf_lo(u.z); acc[5] += w * bf_hi(u.z); acc[6] += w * bf_lo(u.w); acc[7] += w * bf_hi(u.w);
            }
            if constexpr (O78F8) { const float i8 = inv * F8_SAM;
                *(u32x2*)((unsigned char*)AM + (size_t)tok * 1024 + h * 128 + ch * 8) = (u32x2){epi::pack4_f8(acc[0] * i8, acc[1] * i8, acc[2] * i8, acc[3] * i8), epi::pack4_f8(acc[4] * i8, acc[5] * i8, acc[6] * i8, acc[7] * i8)}; }
            else { u32x4 o; o.x = cvtpk(acc[0] * inv, acc[1] * inv); o.y = cvtpk(acc[2] * inv, acc[3] * inv); o.z = cvtpk(acc[4] * inv, acc[5] * inv); o.w = cvtpk(acc[6] * inv, acc[7] * inv);
            *(u32x4*)(AM + (size_t)tok * 1024 + h * 128 + ch * 8) = o; }
        }
    }
}
constexpr int P9_RSTD = 32768, P9_LG = 33792, P9_LGROW = 68, P9_LCNT = P9_LG + 2 * 64 * P9_LGROW * 4, P9_LBASE = P9_LCNT + 256, P9_END = P9_LBASE + 256;
static_assert(P9_END <= RING_BYTES, "P9 LDS");
__device__ __forceinline__ void p9_route(Ctx& F) {
    fill_mod_tables(F, F.in[I_GFFN], 6144, 8192, false);
    const LAS float* A2 = (const LAS float*)F.lds; const LAS float* B2 = (const LAS float*)(F.lds + 16384);
    LAS float* rstd_l = (LAS float*)(F.lds + P9_RSTD); LAS float* LG = (LAS float*)(F.lds + P9_LG);
    LAS int* lcnt = (LAS int*)(F.lds + P9_LCNT); LAS int* lbase = (LAS int*)(F.lds + P9_LBASE);
    const bf16_t* x1 = (const bf16_t*)(F.ws + WS_X1); bf16_t* H2 = (bf16_t*)(F.ws + WS_H2); unsigned char* H2F8 = F.ws + WS_H2F8;
    const bf16_t* WRH = (const bf16_t*)(F.ws + WS_WR); const bf16_t* WRL = WRH + 64 * 2048;
    const float* rbias = F.in[I_RBIAS];
    int* ELIST = (int*)(F.ws + WS_ELIST); int* TOKE = (int*)(F.ws + WS_TOKE); float* TOKW = (float*)(F.ws + WS_TOKW);
    unsigned* ecnt = F.ctl + CW_ECNT;
    for (int grp = F.blk; grp < T / 64; grp += F.G) {
        const int tokb = grp * 64, b = tokb / SEQ;
        if (F.tid < 64) lcnt[F.tid] = 0;
        for (int i = 0; i < 8; i += 4) {
            const int tl = F.wave * 8 + i;
            u32x4 va[4][4];
#pragma unroll
            for (int q = 0; q < 4; ++q) { const u32x4* xr = (const u32x4*)(x1 + (size_t)(tokb + tl + q) * 2048) + F.lane;
#pragma unroll
                for (int j = 0; j < 4; ++j) va[q][j] = xr[64 * j]; }
#pragma unroll
            for (int q = 0; q < 4; ++q) { float ss = 0.f;
#pragma unroll
                for (int j = 0; j < 4; ++j) { const u32x4 u = va[q][j];
                    const float a0 = bf_lo(u.x), a1 = bf_hi(u.x), a2 = bf_lo(u.y), a3 = bf_hi(u.y), a4 = bf_lo(u.z), a5 = bf_hi(u.z), a6 = bf_lo(u.w), a7 = bf_hi(u.w);
                    ss += ((a0 * a0 + a1 * a1) + (a2 * a2 + a3 * a3)) + ((a4 * a4 + a5 * a5) + (a6 * a6 + a7 * a7)); }
                ss = wave_sum(ss);
                if (F.lane == 0) rstd_l[tl + q] = 1.0f / sqrtf(ss * (1.0f / 2048.0f) + RMS_EPS); }
        }
        __syncthreads();
        {
            const int tg = F.wave & 3, kh = F.wave >> 2, tc = F.lane & 15, kg = F.lane >> 4;
            const int tl = 16 * tg + tc; const float rs = rstd_l[tl];
            const bf16_t* xrow = x1 + (size_t)(tokb + tl) * 2048;
            bf16_t* hrow = H2 + (size_t)(tokb + tl) * 2048;
            f32x4 acc[4];
#pragma unroll
            for (int nt = 0; nt < 4; ++nt) acc[nt] = (f32x4){0.f, 0.f, 0.f, 0.f};
#pragma unroll 2
            for (int s = 32 * kh; s < 32 * kh + 32; ++s) {
                const int c0 = 32 * s + 8 * kg;
                const u32x4 xu = *(const u32x4*)(xrow + c0);
                const f32x4 xa = {bf_lo(xu.x), bf_hi(xu.x), bf_lo(xu.y), bf_hi(xu.y)}, xb = {bf_lo(xu.z), bf_hi(xu.z), bf_lo(xu.w), bf_hi(xu.w)};
                const f32x4 aa = *(const LAS f32x4*)(A2 + b * 2048 + c0), ab = *(const LAS f32x4*)(A2 + b * 2048 + c0 + 4);
                const f32x4 ba = *(const LAS f32x4*)(B2 + b * 2048 + c0), bb = *(const LAS f32x4*)(B2 + b * 2048 + c0 + 4);
                const f32x4 ya = xa * rs * aa + ba, yb = xb * rs * ab + bb;
                u32x4 hi; hi.x = cvtpk(ya[0], ya[1]); hi.y = cvtpk(ya[2], ya[3]); hi.z = cvtpk(yb[0], yb[1]); hi.w = cvtpk(yb[2], yb[3]);
                *(u32x2*)(H2F8 + (size_t)(tokb + tl) * 2048 + c0) = (u32x2){epi::pack4_f8(ya[0] * F8_SH, ya[1] * F8_SH, ya[2] * F8_SH, ya[3] * F8_SH), epi::pack4_f8(yb[0] * F8_SH, yb[1] * F8_SH, yb[2] * F8_SH, yb[3] * F8_SH)};
                u32x4 lo; lo.x = cvtpk(ya[0] - bf_lo(hi.x), ya[1] - bf_hi(hi.x)); lo.y = cvtpk(ya[2] - bf_lo(hi.y), ya[3] - bf_hi(hi.y));
                lo.z = cvtpk(yb[0] - bf_lo(hi.z), yb[1] - bf_hi(hi.z)); lo.w = cvtpk(yb[2] - bf_lo(hi.w), yb[3] - bf_hi(hi.w));
                const bf16x8 hf = __builtin_bit_cast(bf16x8, hi), lf = __builtin_bit_cast(bf16x8, lo);
#pragma unroll
                for (int nt = 0; nt < 4; ++nt) {
                    const bf16x8 wh = *(const bf16x8*)(WRH + (size_t)(16 * nt + tc) * 2048 + c0), wl = *(const bf16x8*)(WRL + (size_t)(16 * nt + tc) * 2048 + c0);
                    acc[nt] = __builtin_amdgcn_mfma_f32_16x16x32_bf16(wh, hf, acc[nt], 0, 0, 0);
                    acc[nt] = __builtin_amdgcn_mfma_f32_16x16x32_bf16(wh, lf, acc[nt], 0, 0, 0);
                    acc[nt] = __builtin_amdgcn_mfma_f32_16x16x32_bf16(wl, hf, acc[nt], 0, 0, 0);
                }
            }
#pragma unroll
            for (int nt = 0; nt < 4; ++nt) *(LAS f32x4*)(LG + (kh * 64 + tl) * P9_LGROW + 16 * nt + 4 * kg) = acc[nt];
        }
        __syncthreads();
        int se[8], sslot[8]; float sw[8];
        if (F.tid < 64) {
            LAS float* row0 = LG + F.tid * P9_LGROW; const LAS float* row1 = LG + (64 + F.tid) * P9_LGROW;
            float sl[64];
#pragma unroll
            for (int e = 0; e < 64; ++e) { const float s = sigmoidf_(row0[e] + row1[e]); row0[e] = s; sl[e] = s + rbias[e]; }
            float gs[8];
#pragma unroll
            for (int g = 0; g < 8; ++g) { float m1 = -INFINITY, m2 = -INFINITY;
#pragma unroll
                for (int j = 0; j < 8; ++j) { const float v = sl[8 * g + j]; if (v > m1) { m2 = m1; m1 = v; } else if (v > m2) m2 = v; }
                gs[g] = m1 + m2; }
            unsigned gmask = 0u;
#pragma unroll
            for (int it = 0; it < 4; ++it) { float best = -INFINITY; int bi = 0;
#pragma unroll
                for (int g = 0; g < 8; ++g) { const bool free_ = !((gmask >> g) & 1u); if (free_ && gs[g] > best) { best = gs[g]; bi = g; } }
                gmask |= 1u << bi; }
            unsigned long long picked = 0ull; float wsum = 0.f;
#pragma unroll
            for (int it = 0; it < 8; ++it) { float best = -INFINITY; int bi = 0;
#pragma unroll
                for (int e = 0; e < 64; ++e) { const bool ok = ((gmask >> (e >> 3)) & 1u) && !((picked >> e) & 1ull); if (ok && sl[e] > best) { best = sl[e]; bi = e; } }
                picked |= 1ull << bi; se[it] = bi; const float s = row0[bi]; sw[it] = s; wsum += s; }
            const float inv = 2.5f / wsum;
#pragma unroll
            for (int k = 0; k < 8; ++k) { sw[k] *= inv; sslot[k] = __hip_atomic_fetch_add(lcnt + se[k], 1, __ATOMIC_RELAXED, __HIP_MEMORY_SCOPE_WORKGROUP); }
        }
        __syncthreads();
        if (F.tid < 64) { const int c = lcnt[F.tid]; lbase[F.tid] = c > 0 ? (int)__hip_atomic_fetch_add(ecnt + F.tid, (unsigned)c, RLX_AGENT) : 0; }
        __syncthreads();
        if (F.tid < 64) { const int tok = tokb + F.tid;
#pragma unroll
            for (int k = 0; k < 8; ++k) { const int slot = lbase[se[k]] + sslot[k];
                ELIST[(size_t)se[k] * 16384 + slot] = tok; TOKE[tok * 8 + k] = (se[k] << 16) | slot; TOKW[tok * 8 + k] = sw[k]; } }
        __syncthreads();
    }
}

constexpr int MT_CNT = 0, MT_TST = 256, MT_COFF = 768, MT_GTAB = 2048;
__device__ __forceinline__ void moe_tables(Ctx& F) {
    LAS int* cnt = (LAS int*)(F.lds + LDSX_OFF + MT_CNT); LAS int* tst = (LAS int*)(F.lds + LDSX_OFF + MT_TST); LAS int* coff = (LAS int*)(F.lds + LDSX_OFF + MT_COFF);
    if (F.tid < 64) cnt[F.tid] = (int)__hip_atomic_load(F.ctl + CW_ECNT + F.tid, RLX_AGENT);
    __syncthreads();
    if (F.tid == 0) { int t = 0, c = 0; for (int e = 0; e < 64; ++e) { tst[e] = t; coff[e] = c; const int n = cnt[e]; t += (n + 255) >> 8; c += n; } tst[64] = t; coff[64] = c; }
    __syncthreads();
}
struct MoeSched {
    const LAS int* cnt; const LAS int* tst; const LAS int* coff; int G, c, npn_log2; const char* A; const char* B; size_t a_tile_bytes, b_exp_bytes, b_tile_bytes; bool compact;
    __device__ __forceinline__ bool next(int i, pg8::Unit& u) const {
        const int ntile = tst[64];
        const long L = (long)i * G + c; if (L >= ((long)ntile << npn_log2)) return false;
        const int rt = (int)(L >> npn_log2), pn = (int)(L & ((1 << npn_log2) - 1));
        int lo = 0, hi = 64;
#pragma unroll
        for (int s = 0; s < 6; ++s) { const int mid = (lo + hi) >> 1; if (tst[mid] <= rt) lo = mid; else hi = mid; }
        int e = lo;
        e = __builtin_amdgcn_readfirstlane(e);
        const int j = rt - __builtin_amdgcn_readfirstlane(tst[e]);
        const int n = __builtin_amdgcn_readfirstlane(cnt[e]);
        u.pm = rt; u.pn = pn; u.aux = e;
        u.valid = (n - 256 * j) < 256 ? (n - 256 * j) : 256;
        u.rowbase = compact ? (__builtin_amdgcn_readfirstlane(coff[e]) + 256 * j) : rt * 256;
        u.A = A + (size_t)rt * a_tile_bytes; u.B = B + (size_t)e * b_exp_bytes + (size_t)pn * b_tile_bytes;
        return true;
    }
};

__device__ __forceinline__ void p12_combine(Ctx& F) {
    moe_tables(F);
    const LAS int* coff = (const LAS int*)(F.lds + LDSX_OFF + MT_COFF);
    const unsigned char* Y = (const unsigned char*)(F.ws + WS_Y); const int* TOKE = (const int*)(F.ws + WS_TOKE); const float* TOKW = (const float*)(F.ws + WS_TOKW);
    const float* modf = (const float*)(F.ws + WS_MOD); const float* gfin = F.in[I_GFINAL]; const bf16_t* SHOUT = (const bf16_t*)(F.ws + WS_SHOUT);
    float* out = F.out;
    const int gw = F.blk * 8 + F.wave, NGW = F.G * 8;
    for (int tok = gw; tok < T; tok += NGW) {
        const int b = tok / SEQ;
        f32x4 acc[8];
        int es8[8]; float w8[8];
#pragma unroll
        for (int k = 0; k < 8; ++k) { es8[k] = TOKE[tok * 8 + k]; w8[k] = TOKW[tok * 8 + k]; }
        f32x4* xr = (f32x4*)(out + (size_t)tok * 2048) + F.lane;
        f32x4 v[8];
        { const unsigned long long* x1r = (const unsigned long long*)((const bf16_t*)(F.ws + WS_X1) + (size_t)tok * 2048) + F.lane;
#pragma unroll
          for (int j = 0; j < 8; ++j) { const unsigned long long u = __builtin_nontemporal_load(x1r + 64 * j); const unsigned lo = (unsigned)u, hi = (unsigned)(u >> 32);
              v[j] = (f32x4){bf_lo(lo), bf_hi(lo), bf_lo(hi), bf_hi(hi)}; } }
        { const unsigned long long* sr = (const unsigned long long*)(SHOUT + (size_t)tok * 2048) + F.lane;
#pragma unroll
          for (int j = 0; j < 8; ++j) { const unsigned long long u = __builtin_nontemporal_load(sr + 64 * j); const unsigned lo = (unsigned)u, hi = (unsigned)(u >> 32);
              acc[j].x = bf_lo(lo); acc[j].y = bf_hi(lo); acc[j].z = bf_lo(hi); acc[j].w = bf_hi(hi); } }
#pragma unroll
        for (int kk = 0; kk < 8; kk += 2) {
            unsigned yu[2][8];
#pragma unroll
            for (int k = 0; k < 2; ++k) { const int e = es8[kk + k] >> 16, slot = es8[kk + k] & 0xffff;
                const unsigned* yr = (const unsigned*)(Y + (size_t)(coff[e] + slot) * 2048) + F.lane;
#pragma unroll
                for (int j = 0; j < 8; ++j) yu[k][j] = __builtin_nontemporal_load(yr + 64 * j); }
#pragma unroll
            for (int k = 0; k < 2; ++k) { const float w = w8[kk + k];
#pragma unroll
                for (int j = 0; j < 8; ++j) { const int u = (int)yu[k][j]; const f32x2 lo = __builtin_amdgcn_cvt_pk_f32_fp8(u, false), hi = __builtin_amdgcn_cvt_pk_f32_fp8(u, true);
                    acc[j].x += w * lo[0]; acc[j].y += w * lo[1]; acc[j].z += w * hi[0]; acc[j].w += w * hi[1]; } }
        }
        float ss = 0.f;
#pragma unroll
        for (int j = 0; j < 8; ++j) { const int c = 4 * F.lane + 256 * j; const f32x4 g2 = *(const f32x4*)(modf + b * 12288 + 10240 + c);
            v[j] = v[j] + g2 * acc[j]; ss += (v[j].x * v[j].x + v[j].y * v[j].y) + (v[j].z * v[j].z + v[j].w * v[j].w); }
        const float rstd = 1.0f / sqrtf(wave_sum(ss) * (1.0f / 2048.0f) + RMS_EPS);
#pragma unroll
        for (int j = 0; j < 8; ++j) { const int c = 4 * F.lane + 256 * j; const f32x4 g = *(const f32x4*)(gfin + c); __builtin_nontemporal_store(v[j] * rstd * g, xr + 64 * j); }
    }
}
struct Args { const float* in[22]; float* out; unsigned char* ws; int ph_lo, ph_hi; };
static_assert(sizeof(Args) == 22 * 8 + 8 + 8 + 8, "Args has no padding");

__global__ void __launch_bounds__(512, 2) fwd_kernel(Args args) {
    extern __shared__ __attribute__((aligned(16))) unsigned char lds_raw[];
    Ctx F;
    F.lds = (LAS unsigned char*)lds_raw;
    F.tid = threadIdx.x; F.lane = F.tid & 63; F.wave = __builtin_amdgcn_readfirstlane(F.tid >> 6);
    F.G = gridDim.x; F.blk = blockIdx.x;
    F.ws = args.ws; F.ctl = (unsigned*)(args.ws + WS_CTL); F.out = args.out;
    F.in = args.in;
    volatile LAS unsigned* MISC = (volatile LAS unsigned*)(F.lds + MISC_OFF);
    if (F.tid < 32) MISC[F.tid] = 0u;
    __syncthreads();
    XcdBarrier bar; bar.bar = F.ctl + CW_BAR; bar.x = 0; bar.st = nullptr;
    if (MK_N_LAUNCHES == 1) bar = xcd_barrier_post(F.ctl + CW_BAR, MISC + 8);
    const int lo = args.ph_lo, hi = args.ph_hi;
    unsigned char* ws = args.ws;
#define IN(k) (lo <= (k) && (k) < hi && ((PHASE_MASK >> (k)) & 1u))
#define SEAM(k) do { if (MK_N_LAUNCHES == 1 && (k) + 1 < hi) xcd_barrier(bar); } while (0)
#define NREP(k) (((REP_MASK >> (k)) & 1u) ? 2 : 1)
    typedef pg8::StaticOrder SO;

    if (lo <= 0 && 0 < hi) { if (IN(0)) { for (int rep_ = 0; rep_ < NREP(0); ++rep_) { if (rep_) xcd_barrier(bar); p0_prologue(F); } } SEAM(0); }
    if (lo <= 1 && 1 < hi) { if (IN(1)) { for (int rep_ = 0; rep_ < NREP(1); ++rep_) { if (rep_) xcd_barrier(bar); p1_norm(F); } } SEAM(1); }
    if (lo <= 2 && 2 < hi) {
        if (IN(2)) {
#pragma unroll 1
        for (int rep_ = 0; rep_ < NREP(2); ++rep_) { if (rep_) xcd_barrier(bar);
            const char* H = (const char*)(ws + WS_H); const char* W = (const char*)(ws + WS_W_IN_T);
            constexpr int KP = P2F8 ? 1024 : 2048;
            { SO S; S.init(H, W, T, 8192, KP, F.G, F.blk);
              epi::ProjEpi E{epi::StoreQK8{ws + WS_QD, ws + WS_KDT, att::D8_QS, att::D8_KS}, epi::StoreQKboth{epi::StoreQK{(bf16_t*)(ws + WS_QM), (bf16_t*)(ws + WS_KMT), 1.0f}, ws + WS_QM8, ws + WS_KMT8}, epi::StoreBf16<1>{(bf16_t*)(ws + WS_GATES), 4096}};
              pg8::gemm_phase<epi::ProjEpi, SO, true, true, false, P2F8>(F.lds, KP, S, E, nullptr); }
            { SO S; S.init(W + (size_t)8192 * KP * 2, H, 2048, T, KP, F.G, F.blk); epi::ProjVT E{epi::StoreVT8{ws + WS_VDT, att::D8_VS}, epi::StoreVT8{ws + WS_VMT8, att::D8_VS}};
              pg8::gemm_phase<epi::ProjVT, SO, true, true, false, P2F8>(F.lds, KP, S, E, nullptr); }
        }
        }
        SEAM(2);
    }
    if (lo <= 3 && 3 < hi) {
        if (IN(3)) {
#pragma unroll 1
        for (int rep_ = 0; rep_ < NREP(3); ++rep_) { if (rep_) xcd_barrier(bar);
            const float* lv = F.in[I_LAMBDA];
            float d1 = 0.f, d2 = 0.f;
            for (int i = 0; i < 64; ++i) { d1 += lv[i] * lv[64 + i]; d2 += lv[128 + i] * lv[192 + i]; }
            if (F.tid == 0) *(LAS float*)(F.lds + MISC_OFF + 68) = expf(d1) - expf(d2) + 0.2f;
            {
                const int x = (int)(xb_xcc_id() & 7u);
                const bool converter = ((F.blk >> 3) & 3) == 3;
                if (converter) { for (int c = queue_take(F, F.ctl + CW_CQ); c < CV_NCHUNK; c = queue_take(F, F.ctl + CW_CQ)) { __syncthreads(); convert_chunk(F, c); } }
#pragma unroll 1
                for (int k = 0; k < 8; ++k) {
                    const int xq = (x + k) & 7;
#pragma unroll 1
                    for (int i = queue_take(F, F.ctl + CW_AQ + 64 * xq); i < 128; i = queue_take(F, F.ctl + CW_AQ + 64 * xq)) {
                        const int bh = 2 * xq + (i & 1), qt = 63 - (i >> 1);
                        att::diff_unit8(F.lds, bh >> 3, bh & 7, qt, ws + WS_QD, ws + WS_KDT, ws + WS_VDT, (bf16_t*)(ws + WS_AD), F.in[I_SUBLN], F.in[I_RELB]);
                    }
                }
                for (int c = queue_take(F, F.ctl + CW_CQ); c < CV_NCHUNK; c = queue_take(F, F.ctl + CW_CQ)) { __syncthreads(); convert_chunk(F, c); }
            }
            __syncthreads();
            p3_kmean(F);
        }
        }
        SEAM(3);
    }
    if (lo <= 4 && 4 < hi) { if (IN(4)) p4_gating(F); SEAM(4); }
    if (lo <= 5 && 5 < hi) {
        if (IN(5)) {
#pragma unroll 1
        for (int rep_ = 0; rep_ < NREP(5); ++rep_) { if (rep_) xcd_barrier(bar);
            constexpr int MB_CPU = 2;
            LAS int* pre = (LAS int*)(F.lds + LDSX_OFF);
            const unsigned* mcnt = F.ctl + CW_MCNT;
            const int mycnt = (int)__hip_atomic_load(mcnt + F.tid, RLX_AGENT);
            pre[F.tid] = (1 + ((mycnt + 255) >> 8) + MB_CPU - 1) / MB_CPU;
            __syncthreads();
            int src = 0;
            for (int off = 1; off < 512; off <<= 1) { const int v = pre[src * 512 + F.tid] + (F.tid >= off ? pre[src * 512 + F.tid - off] : 0); pre[(src ^ 1) * 512 + F.tid] = v; src ^= 1; __syncthreads(); }
            LAS int* inc = (LAS int*)(F.lds + att::MB_INC);
            inc[F.tid] = pre[src * 512 + F.tid];
            __syncthreads();
            const int total = inc[511];
            for (int u = F.blk; u < total; u += F.G) {
                int lo_ = -1, hi_ = 511;
#pragma unroll
                for (int st = 0; st < 9; ++st) { const int mid = (lo_ + hi_) >> 1; if (inc[mid] > u) hi_ = mid; else lo_ = mid; }
                const int l = __builtin_amdgcn_readfirstlane(hi_);
                const int before = l > 0 ? __builtin_amdgcn_readfirstlane(inc[l - 1]) : 0;
                const int j = u - before;
                const int cntl = (int)__builtin_amdgcn_readfirstlane(__hip_atomic_load(mcnt + l, RLX_AGENT));
                const int nch = 1 + ((cntl + 255) >> 8);
                const int c0 = j * MB_CPU, c1 = (c0 + MB_CPU) < nch ? (c0 + MB_CPU) : nch;
                att::moba_block8(F.lds, l >> 8, (l >> 5) & 7, l & 31, (const int*)(ws + WS_MLIST) + (size_t)l * 8192, cntl, c0, c1, ws + WS_QM8, ws + WS_KMT8, ws + WS_VMT8, (bf16_t*)(ws + WS_PARTS), (float*)(ws + WS_ML), F.in[I_RELB]);
            }
            __syncthreads();
        }
        }
        SEAM(5);
    }
    if (lo <= 6 && 6 < hi) { if (IN(6)) { for (int rep_ = 0; rep_ < NREP(6); ++rep_) { if (rep_) xcd_barrier(bar); p6_merge(F); } } SEAM(6); }
    if (lo <= 7 && 7 < hi) {
        if (IN(7)) {
#pragma unroll 1
        for (int rep_ = 0; rep_ < NREP(7); ++rep_) { if (rep_) xcd_barrier(bar);
            { pg8::PairOrder S; S.init(ws + WS_AD, ws + WS_W_OD_T, ws + WS_AM, ws + WS_W_OM_T, T, 2048, O78F8 ? 512 : 1024, F.G, F.blk);
              epi::GatePair E{epi::GateMul<0>{(const bf16_t*)(ws + WS_GATES), 0, nullptr, (bf16_t*)(ws + WS_T1)}, epi::GateMul<1>{(const bf16_t*)(ws + WS_GATES), 2048, (const bf16_t*)(ws + WS_T1), (bf16_t*)(ws + WS_G)}};
              pg8::gemm_phase<epi::GatePair, pg8::PairOrder, true, true, false, O78F8>(F.lds, O78F8 ? 512 : 1024, S, E, nullptr); }
        }
        }
        SEAM(7);
    }
    if (lo <= 8 && 8 < hi) {
        if (IN(8)) {
#pragma unroll 1
        for (int rep_ = 0; rep_ < NREP(8); ++rep_) { if (rep_) xcd_barrier(bar);
            SO S; S.init(ws + WS_G, ws + WS_W_OUT_T, T, 2048, O78F8 ? 1024 : 2048, F.G, F.blk); epi::ResidBf16 E{F.in[I_X], (bf16_t*)(ws + WS_X1), (const float*)(ws + WS_MOD), 4096};
            pg8::gemm_phase<epi::ResidBf16, SO, true, true, false, O78F8>(F.lds, O78F8 ? 1024 : 2048, S, E, nullptr);
        }
        }
        SEAM(8);
    }
    if (lo <= 9 && 9 < hi) { if (IN(9)) p9_route(F); SEAM(9); }
    if (lo <= 10 && 10 < hi) {
        if (IN(10)) {
#pragma unroll 1
        for (int rep_ = 0; rep_ < NREP(10); ++rep_) { if (rep_) xcd_barrier(bar);
            moe_tables(F);
            MoeSched S{(const LAS int*)(F.lds + LDSX_OFF + MT_CNT), (const LAS int*)(F.lds + LDSX_OFF + MT_TST), (const LAS int*)(F.lds + LDSX_OFF + MT_COFF), F.G, F.blk, 2,
                       (const char*)(ws + WS_H2F8), (const char*)(ws + WS_W_EGU_T), 0, (size_t)1024 * 2048, (size_t)256 * 2048, false};
            LAS unsigned short* gtab = (LAS unsigned short*)(F.lds + LDSX_OFF + MT_GTAB);
            { const int* ELIST = (const int*)(ws + WS_ELIST); pg8::Unit u;
              for (int i = 0; i < 24 && S.next(i, u); ++i) { if (F.tid < 256) { const int j = u.pm - S.tst[u.aux]; gtab[i * 256 + F.tid] = (unsigned short)(F.tid < u.valid ? ELIST[(size_t)u.aux * 16384 + 256 * j + F.tid] : 0); } } }
            __syncthreads();
            { epi::SwiGLU8 E{ws + WS_ACT}; pg8::gemm_phase<epi::SwiGLU8, MoeSched, true, true, true, true>(F.lds, 1024, S, E, gtab); }
            { SO S2; S2.init(ws + WS_H2F8, ws + WS_W_SHGU_T, T, 1024, 1024, F.G, F.blk); epi::SwiGLU8 E{ws + WS_SHACT};
              pg8::gemm_phase<epi::SwiGLU8, SO, true, true, false, true>(F.lds, 1024, S2, E, nullptr); }
        }
        }
        SEAM(10);
    }
    if (lo <= 11 && 11 < hi) {
        if (IN(11)) {
            moe_tables(F);
            MoeSched S{(const LAS int*)(F.lds + LDSX_OFF + MT_CNT), (const LAS int*)(F.lds + LDSX_OFF + MT_TST), (const LAS int*)(F.lds + LDSX_OFF + MT_COFF), F.G, F.blk, 3,
                       (const char*)(ws + WS_ACT), (const char*)(ws + WS_W_ED_T), (size_t)256 * 512, (size_t)2048 * 512, (size_t)256 * 512, true};
#pragma unroll 1
            for (int rep_ = 0; rep_ < NREP(11); ++rep_) { if (rep_) xcd_barrier(bar);
            { epi::DownY E{(unsigned char*)(ws + WS_Y)}; pg8::gemm_phase<epi::DownY, MoeSched, true, true, false, true>(F.lds, 256, S, E, nullptr); } }
            { SO S2; S2.init(ws + WS_SHACT, ws + WS_W_SHD_T, T, 2048, 256, F.G, F.blk); epi::StoreBf16<2> E{(bf16_t*)(ws + WS_SHOUT), 2048};
              pg8::gemm_phase<epi::StoreBf16<2>, SO, true, true, false, true>(F.lds, 256, S2, E, nullptr); }
        }
        SEAM(11);
    }
    if (lo <= 12 && 12 < hi) { if (IN(12)) p12_combine(F); }
#undef IN
#undef SEAM
}

extern "C" void kernel_launch(void* const* d_in, const int* in_sizes, int n_in, void* d_out, int out_size, void* d_ws, size_t ws_size, hipStream_t stream) {
    static int grid = 0;
    if (grid == 0) {
        if (n_in != 22 || in_sizes[0] != T * D || out_size != T * D || ws_size < WS_END) { fprintf(stderr, "kernel_launch: unexpected shapes (n_in %d, in0 %d, out %d, ws %zu < %zu); nothing launched\n", n_in, n_in > 0 ? in_sizes[0] : -1, out_size, ws_size, (size_t)WS_END); grid = -1; return; }
        int dev = 0, cus = 0, per_cu = 0;
        if (hipGetDevice(&dev) != hipSuccess || hipDeviceGetAttribute(&cus, hipDeviceAttributeMultiprocessorCount, dev) != hipSuccess) { grid = -1; return; }
        if (hipFuncSetAttribute((const void*)fwd_kernel, hipFuncAttributeMaxDynamicSharedMemorySize, LDS_BYTES) != hipSuccess) { fprintf(stderr, "kernel_launch: hipFuncSetAttribute failed\n"); grid = -1; return; }
        if (hipOccupancyMaxActiveBlocksPerMultiprocessor(&per_cu, (const void*)fwd_kernel, 512, LDS_BYTES) != hipSuccess || per_cu < 1) fprintf(stderr, "kernel_launch: occupancy query says %d\n", per_cu);
        (void)hipGetLastError();
        grid = cus;
    }
    if (grid < 0) return;
    if (hipMemsetAsync((char*)d_ws + WS_CTL, 0, CTL_ZERO_BYTES, stream) != hipSuccess) { fprintf(stderr, "kernel_launch: memset failed\n"); return; }
    Args a{};
    for (int i = 0; i < 22; ++i) a.in[i] = (const float*)d_in[i];
    a.out = (float*)d_out; a.ws = (unsigned char*)d_ws;
    for (int li = 0; li < MK_N_LAUNCHES; ++li) {
        a.ph_lo = (MK_N_LAUNCHES == 1) ? 0 : li; a.ph_hi = (MK_N_LAUNCHES == 1) ? NPHASE : li + 1;
        hipLaunchKernelGGL(fwd_kernel, dim3(grid), dim3(512), LDS_BYTES, stream, a);
        const hipError_t le = hipPeekAtLastError();
        if (le != hipSuccess) { fprintf(stderr, "kernel_launch: launch %d failed: %s\n", li, hipGetErrorName(le)); break; }
    }
}
```

```cpp
#include <hip/hip_runtime.h>
#include <cstdio>
#include <cstdint>

#define LAS __attribute__((address_space(3)))
#define GAS __attribute__((address_space(1)))
typedef unsigned short bf16_t;
typedef short bf16x8 __attribute__((ext_vector_type(8)));
typedef short s16x4 __attribute__((ext_vector_type(4)));
typedef int i32x4 __attribute__((ext_vector_type(4)));
typedef int i32x8 __attribute__((ext_vector_type(8)));
typedef float f32x4 __attribute__((ext_vector_type(4)));
typedef float f32x2 __attribute__((ext_vector_type(2)));
typedef float f32x16 __attribute__((ext_vector_type(16)));
typedef unsigned u32x4 __attribute__((ext_vector_type(4)));
typedef unsigned u32x2 __attribute__((ext_vector_type(2)));
typedef __bf16 bf16x2_t __attribute__((ext_vector_type(2)));

#ifndef MK_N_LAUNCHES
#define MK_N_LAUNCHES 1
#endif
#ifndef REP_MASK
#define REP_MASK 0u
#endif
#ifndef PHASE_MASK
#define PHASE_MASK 0xFFFFFFFFu
#endif

constexpr int NB = 2, SEQ = 8192, T = NB * SEQ, D = 2048, NH = 8, INC = 10240, NE = 64, EDIM = 512, TOPK = 8;
constexpr int NPHASE = 13;
constexpr float RMS_EPS = 1e-6f;
constexpr float LOG2E = 1.4426950408889634f;

constexpr size_t MiB = 1u << 20;
constexpr size_t WS_CTL = 0, CTL_ZERO_BYTES = 1 * MiB;
constexpr size_t WS_MODP = 1 * MiB;
constexpr size_t WS_MOD = 4 * MiB;
constexpr size_t WS_KMEAN = 4 * MiB + 256 * 1024;
constexpr size_t WS_WR = 4 * MiB + 512 * 1024;
constexpr size_t WS_TOKE = 5 * MiB;
constexpr size_t WS_TOKW = 5 * MiB + 512 * 1024;
constexpr size_t WS_W_IN_T = 8 * MiB;
constexpr size_t WS_W_OD_T = 48 * MiB;
constexpr size_t WS_W_OM_T = 52 * MiB;
constexpr size_t WS_W_OUT_T = 56 * MiB;
constexpr size_t WS_W_SHGU_T = 64 * MiB;
constexpr size_t WS_W_SHD_T = 68 * MiB;
constexpr size_t WS_ELIST = 70 * MiB;
constexpr size_t WS_W_ED_T = 76 * MiB;
constexpr size_t WS_W_EGU_T = 204 * MiB;
constexpr size_t WS_H = 460 * MiB;
constexpr size_t WS_QD = 524 * MiB;
constexpr size_t WS_KDT = 556 * MiB;
constexpr size_t WS_VDT = 588 * MiB;
constexpr size_t WS_QM = 620 * MiB;
constexpr size_t WS_KMT = 652 * MiB;
constexpr size_t WS_VMT = 684 * MiB;
constexpr size_t WS_GATES = 716 * MiB;
constexpr size_t WS_AD = 844 * MiB;
constexpr size_t WS_AM = 876 * MiB;
constexpr size_t WS_ML = 908 * MiB;
constexpr size_t WS_MLIST = 912 * MiB;
constexpr size_t WS_PARTS = 460 * MiB;
constexpr size_t WS_G = 460 * MiB;
constexpr size_t WS_T1 = 524 * MiB;
constexpr size_t WS_X1 = 524 * MiB;
constexpr size_t WS_H2 = 588 * MiB;
constexpr size_t WS_ACT = 716 * MiB;
constexpr size_t WS_H2F8 = 800 * MiB;
constexpr float F8_SH = 8.0f, F8_SW = 64.0f, F8_SA = 8.0f, F8_SD = 32.0f;
namespace att { constexpr float D8_QS = 0.125f * LOG2E * 16.0f, D8_KS = 4.0f, D8_VS = 8.0f; }
constexpr size_t WS_QM8 = 604 * MiB, WS_VMT8 = 684 * MiB, WS_KMT8 = 700 * MiB;
namespace att { constexpr float MB8_QS = 0.08838834764831845f * LOG2E * 16.0f; }
constexpr bool O78F8 = true;
constexpr float F8_SAD = 16.0f, F8_SAM = 64.0f, F8_SWO = 32.0f, F8_SG = 16.0f, F8_SWOUT = 64.0f;
constexpr bool P2F8 = true;
constexpr float DS2 = 1.0f;
constexpr int P2_EXP = 9;
constexpr size_t WS_SHACT = 860 * MiB;
constexpr size_t WS_SHOUT = 588 * MiB;
constexpr size_t WS_Y = 204 * MiB;
constexpr size_t WS_END = 928 * MiB;
static_assert(WS_Y + (size_t)131072 * 2048 * 2 <= WS_ACT, "Y must not reach ACT");
static_assert(WS_ACT + (size_t)147456 * 512 * 2 <= WS_SHACT && WS_SHACT + (size_t)T * 512 * 2 <= WS_END, "act map");
static_assert(WS_PARTS + (size_t)T * 8 * 4 * 128 * 2 <= WS_VDT, "parts overlay");

constexpr int CW_BAR = 4096;
constexpr int CW_ECNT = 8192;
constexpr int CW_MCNT = 8448;
constexpr int CW_AQ = 9216;
constexpr int CW_CQ = 9216 + 64 * 8;

constexpr int RING_BYTES = 131072;
constexpr int LDSX_OFF = RING_BYTES;
constexpr int MISC_OFF = RING_BYTES + 16384;
constexpr int LDS_BYTES = MISC_OFF + 128;

#define LDS_WAIT() asm volatile("s_waitcnt lgkmcnt(0)" ::: "memory")
#define VM_WAIT() asm volatile("s_waitcnt vmcnt(0)" ::: "memory")
#define RLX_AGENT __ATOMIC_RELAXED, __HIP_MEMORY_SCOPE_AGENT

__device__ __forceinline__ unsigned cvtpk(float lo, float hi) { f32x2 v = {lo, hi}; bf16x2_t b = __builtin_convertvector(v, bf16x2_t); return __builtin_bit_cast(unsigned, b); }
__device__ __forceinline__ float bf_lo(unsigned u) { return __uint_as_float(u << 16); }
__device__ __forceinline__ float bf_hi(unsigned u) { return __uint_as_float(u & 0xffff0000u); }
__device__ __forceinline__ float wave_sum(float v) {
#pragma unroll
    for (int o = 1; o < 64; o <<= 1) v += __shfl_xor(v, o);
    return v;
}
__device__ __forceinline__ float fast_exp2(float x) { return __builtin_amdgcn_exp2f(x); }
__device__ __forceinline__ float fast_rcp(float x) { return __builtin_amdgcn_rcpf(x); }
__device__ __forceinline__ float sigmoidf_(float x) { return fast_rcp(1.0f + fast_exp2(-x * LOG2E)); }
__device__ __forceinline__ float siluf_(float x) { return x * sigmoidf_(x); }

#define XB_TMO      128
#define XB_XCNT(j)  (256  + 64 * (j))
#define XB_XSUB(j)  (1280 + 64 * (j))
#define XB_XGEN(j)  (2304 + 64 * (j))
#define XB_TOP      3328
#define XB_TOPGEN   3392
#define XCD_BAR_WORDS 3456
#define XB_SPIN_CAP (1u << 22)

__device__ __forceinline__ unsigned xb_ld(unsigned* p)              { return __hip_atomic_load(p, __ATOMIC_RELAXED, __HIP_MEMORY_SCOPE_AGENT); }
__device__ __forceinline__ unsigned xb_add(unsigned* p, unsigned v) { return __hip_atomic_fetch_add(p, v, __ATOMIC_RELAXED, __HIP_MEMORY_SCOPE_AGENT); }
__device__ __forceinline__ unsigned xb_xcc_id() { return (unsigned)__builtin_amdgcn_s_getreg((3 << 11) | 20) & 0xFu; }
#define XB_SPIN(cond, bar) do { unsigned _sp = 0; while (cond) { __builtin_amdgcn_s_sleep(1); \
    if ((++_sp & 255u) == 0u) { if (xb_ld(&(bar)[XB_TMO])) break; if (_sp > XB_SPIN_CAP) { atomicAdd(&(bar)[XB_TMO], 1u); break; } } } } while (0)

struct XcdBarrier { unsigned* bar; unsigned x; volatile LAS unsigned* st; };

__device__ __forceinline__ XcdBarrier xcd_barrier_post(unsigned* bar, volatile LAS unsigned* st) {
    XcdBarrier b; b.bar = bar; b.x = xb_xcc_id(); b.st = st;
    if (threadIdx.x == 0) (void)xb_add(&bar[XB_XCNT(b.x)], 1u);
    return b;
}
__device__ __forceinline__ void xcd_barrier_complete(unsigned* bar, unsigned x, unsigned& nloc, unsigned& nx) {
    const unsigned G = gridDim.x * gridDim.y * gridDim.z;
    unsigned sum, cnt, mine, sp = 0u;
    for (;;) {
        sum = 0u; cnt = 0u; mine = 0u;
#pragma unroll
        for (unsigned j = 0; j < 16; ++j) { const unsigned c = xb_ld(&bar[XB_XCNT(j)]); sum += c; cnt += (c > 0u) ? 1u : 0u; mine = (j == x) ? c : mine; }
        if (sum == G) break;
        __builtin_amdgcn_s_sleep(1);
        if ((++sp & 255u) == 0u) { if (xb_ld(&bar[XB_TMO])) break; if (sp > XB_SPIN_CAP) { atomicAdd(&bar[XB_TMO], 1u); break; } }
    }
    nloc = mine > 0u ? mine : 1u; nx = cnt > 0u ? cnt : 1u;
}
__device__ __forceinline__ void xcd_barrier(const XcdBarrier& b) {
    asm volatile("s_waitcnt vmcnt(0)" ::: "memory");
    __syncthreads();
    if (threadIdx.x == 0) {
        unsigned* bar = b.bar;
        __builtin_amdgcn_s_waitcnt(0);
        unsigned nloc = b.st[0], nx = b.st[1];
        if (nloc == 0u) { xcd_barrier_complete(bar, b.x, nloc, nx); b.st[0] = nloc; b.st[1] = nx; }
        const unsigned old = xb_add(&bar[XB_XSUB(b.x)], 1u);
        const unsigned gen = old / nloc;
        if (old + 1u == (gen + 1u) * nloc) {
            __builtin_amdgcn_fence(__ATOMIC_RELEASE, "agent");
            asm volatile("s_waitcnt vmcnt(0)" ::: "memory");
            const unsigned og = xb_add(&bar[XB_TOP], 1u);
            const unsigned tg = og / nx;
            if (og + 1u == (tg + 1u) * nx) xb_add(&bar[XB_TOPGEN], 1u);
            else XB_SPIN(xb_ld(&bar[XB_TOPGEN]) == tg, bar);
            __builtin_amdgcn_fence(__ATOMIC_ACQUIRE, "agent");
            xb_add(&bar[XB_XGEN(b.x)], 1u);
            asm volatile("s_waitcnt vmcnt(0)" ::: "memory");
        } else {
            XB_SPIN(xb_ld(&bar[XB_XGEN(b.x)]) == gen, bar);
            __builtin_amdgcn_fence(__ATOMIC_ACQUIRE, "agent");
            asm volatile("s_waitcnt vmcnt(0)" ::: "memory");
        }
    }
    __syncthreads();
}

namespace pg8 {
constexpr int BM = 256, BK = 64, HALF = 128, HTB = HALF * BK * 2, STAGE_BYTES = 8 * HTB, NXCD = 8, WGM = 8;
static_assert(STAGE_BYTES == RING_BYTES, "ring");
__host__ __device__ __forceinline__ int lds_byte(int r, int c) { const int st = (r >> 4) * 2 + (c >> 5), rr = r & 15, cc = c & 31, ob = rr * 64 + cc * 2; return st * 1024 + (ob ^ (((ob >> 9) & 1) << 5)); }
__host__ __device__ __forceinline__ void stage_rc(int b, int& R, int& C) { const int st = b / 1024, sb = b % 1024, swz = sb ^ (((sb >> 9) & 1) << 5); R = (st >> 1) * 16 + swz / 64; C = (st & 1) * 32 + (swz % 64) / 2; }
__host__ __device__ __forceinline__ int perm32(int rho) { const int n = rho >> 4, i = rho & 15; return 8 * (i >> 2) + 4 * n + (i & 3); }

struct Unit { int pm, pn; const char* A; const char* B; int rowbase, valid, aux; };

struct StaticOrder {
    int nM, nN, nwg, G, c; const char* A; const char* B; size_t tstep;
    __device__ void init(const void* A_, const void* B_, int M, int N, int K, int G_, int c_) { A = (const char*)A_; B = (const char*)B_; nM = M / BM; nN = N / BM; nwg = nM * nN; G = G_; c = c_; tstep = (size_t)BM * K * 2; }
    __device__ bool next(int i, Unit& u) const {
        const long L = (long)i * G + c; if (L >= nwg) return false;
        int wgid = (int)L; { const int q = nwg / NXCD, r = nwg % NXCD, xcd = wgid % NXCD, off = wgid / NXCD; wgid = (xcd < r ? xcd * (q + 1) : r * (q + 1) + (xcd - r) * q) + off; }
        const int nig = WGM * nN, gid = wgid / nig, fm = gid * WGM, gsz = (nM - fm) < WGM ? (nM - fm) : WGM;
        u.pm = fm + ((wgid % nig) % gsz); u.pn = (wgid % nig) / gsz;
        u.A = A + (size_t)u.pm * tstep; u.B = B + (size_t)u.pn * tstep; u.rowbase = u.pm * BM; u.valid = BM; u.aux = 0; return true;
    }
};

struct PairOrder {
    StaticOrder base; const char* A1; const char* B1;
    __device__ void init(const void* A0_, const void* B0_, const void* A1_, const void* B1_, int M, int N, int K, int G_, int c_) { base.init(A0_, B0_, M, N, K, G_, c_); A1 = (const char*)A1_; B1 = (const char*)B1_; }
    __device__ bool next(int i, Unit& u) const {
        if (!base.next(i >> 1, u)) return false;
        if (i & 1) { u.A = A1 + (size_t)u.pm * base.tstep; u.B = B1 + (size_t)u.pn * base.tstep; u.aux = 1; }
        return true;
    }
};

template <class Epi, class Sched, bool ALIGN_EPI, bool SP2, bool GATHER, bool F8 = false>
__device__ __forceinline__ void gemm_phase(LAS unsigned char* lds, const int K, const Sched& S, const Epi& E, const LAS unsigned short* gtab) {
    int tid_ = threadIdx.x; asm volatile("" : "+v"(tid_));
    const int tid = tid_, wid = __builtin_amdgcn_readfirstlane(tid >> 6), lane = tid & 63, wr = wid >> 2, wc = wid & 3, fr = lane & 15, fq = lane >> 4;
    const int nt = K / BK;
    unsigned voffA[2], voffB[2]; int RA[2], CA[2];
#pragma unroll
    for (int i = 0; i < 2; ++i) { int R, C; stage_rc(tid * 16 + i * 8192, R, C); const int Rb = (int)Epi::PERM == 2 ? (64 * (R >> 5) + 16 * ((R >> 2) & 3) + 4 * ((R >> 4) & 1) + (R & 3)) : (Epi::PERM ? ((R & ~31) + perm32(R & 31)) : R);
        RA[i] = R; CA[i] = C; voffA[i] = (unsigned)(R * K + C) * 2u; voffB[i] = (unsigned)(Rb * K + C) * 2u; }
    const size_t kstep = (size_t)(BK * 2);
    const size_t hstep = (size_t)HALF * K * 2;
    const size_t hstepB = (int)Epi::PERM == 2 ? (size_t)8 * K * 2 : hstep;
    const unsigned ldsw = (unsigned)wid * 1024u;
    const int aoff = lds_byte(wr * 64 + fr, fq * 8), boff = lds_byte(wc * 32 + fr, fq * 8);
    unsigned vA[2][2], nvA[2][2];
#define PG8_SA(b, h) (((b) * 2 + (h)) * HTB)
#define PG8_SB(b, h) ((4 + (b) * 2 + (h)) * HTB)
#define PG8_GL(gp, ldsoff) __builtin_amdgcn_global_load_lds((const unsigned*)(gp), (LAS unsigned*)(lds + (ldsoff)), 16, 0, 0)
#define PG8_STAGE(bufoff, gbase, voff) do { _Pragma("unroll") for (int _i = 0; _i < 2; ++_i) PG8_GL((const char*)(gbase) + (voff)[_i], (bufoff) + ldsw + _i * 8192); } while (0)
#define PG8_STA(bufoff, gbase, h, nx) do { if constexpr (GATHER) { \
        const unsigned _o0 = (nx) ? nvA[h][0] : vA[h][0], _o1 = (nx) ? nvA[h][1] : vA[h][1]; \
        PG8_GL((const char*)(gbase) + _o0, (bufoff) + ldsw); PG8_GL((const char*)(gbase) + _o1, (bufoff) + ldsw + 8192); \
    } else { PG8_STAGE(bufoff, (const char*)(gbase) + (h) * hstep, voffA); } } while (0)
#define PG8_GVA(dst, ul) do { _Pragma("unroll") for (int _h = 0; _h < 2; ++_h) _Pragma("unroll") for (int _i = 0; _i < 2; ++_i) \
        dst[_h][_i] = (unsigned)gtab[(ul) * 256 + _h * 128 + RA[_i]] * (unsigned)(K * 2) + (unsigned)(CA[_i] * 2); } while (0)
#define PG8_LDA(dst, b, h) do { _Pragma("unroll") for (int m = 0; m < 4; ++m) _Pragma("unroll") for (int k = 0; k < 2; ++k) dst[m][k] = *(const LAS bf16x8*)(lds + PG8_SA(b, h) + aoff + m * 2048 + k * 1024); } while (0)
#define PG8_LDB(dst, b, h) do { _Pragma("unroll") for (int n = 0; n < 2; ++n) _Pragma("unroll") for (int k = 0; k < 2; ++k) dst[n][k] = *(const LAS bf16x8*)(lds + PG8_SB(b, h) + boff + n * 2048 + k * 1024); } while (0)
#define PG8_MMA(ai, bj, At, Bt) do { __builtin_amdgcn_s_setprio(1); _Pragma("unroll") for (int m = 0; m < 4; ++m) _Pragma("unroll") for (int n = 0; n < 2; ++n) { \
        if constexpr (F8) { const i32x4 _b0 = __builtin_bit_cast(i32x4, Bt[n][0]), _b1 = __builtin_bit_cast(i32x4, Bt[n][1]), _a0 = __builtin_bit_cast(i32x4, At[m][0]), _a1 = __builtin_bit_cast(i32x4, At[m][1]); \
            const i32x8 _b8 = __builtin_shufflevector(_b0, _b1, 0, 1, 2, 3, 4, 5, 6, 7), _a8 = __builtin_shufflevector(_a0, _a1, 0, 1, 2, 3, 4, 5, 6, 7); \
            asm volatile("v_mfma_scale_f32_16x16x128_f8f6f4 %0, %1, %2, %0, %3, %4 op_sel_hi:[0,0,0]" : "+v"(acc[ai][bj][m][n]) : "v"(_b8), "v"(_a8), "v"(f8sc), "v"(f8one)); } \
        else { _Pragma("unroll") for (int k = 0; k < 2; ++k) acc[ai][bj][m][n] = __builtin_amdgcn_mfma_f32_16x16x32_bf16(Bt[n][k], At[m][k], acc[ai][bj][m][n], 0, 0, 0); } } __builtin_amdgcn_s_setprio(0); } while (0)
#define PG8_WAIT_V(n) asm volatile("s_waitcnt vmcnt(" #n ")" ::: "memory")
#define PG8_WAIT_L(n) asm volatile("s_waitcnt lgkmcnt(" #n ")" ::: "memory")
#define PG8_BAR __builtin_amdgcn_s_barrier()
#define PG8_SCHED __builtin_amdgcn_sched_barrier(0)
    Unit cur, nxt; int ui = 0;
    if (!S.next(0, cur)) return;
    if constexpr (GATHER) { PG8_GVA(vA, 0); }
    int f8sc = 0x7F7F7F7F;
    const int f8one = 0x7F7F7F7F;
    f32x4 acc[2][2][4][2];
#pragma unroll
    for (int a = 0; a < 2; ++a)
#pragma unroll
        for (int b = 0; b < 2; ++b)
#pragma unroll
            for (int m = 0; m < 4; ++m)
#pragma unroll
                for (int n = 0; n < 2; ++n) acc[a][b][m][n] = (f32x4){0.f, 0.f, 0.f, 0.f};
    bf16x8 At[4][2], B0[2][2], B1[2][2];
    const char* cA = cur.A; const char* cB = cur.B;
    if constexpr (SP2) {
        PG8_STAGE(PG8_SB(0, 0), cB, voffB); PG8_STAGE(PG8_SB(0, 1), cB + hstepB, voffB); PG8_STA(PG8_SA(0, 0), cA, 0, false); PG8_STA(PG8_SA(0, 1), cA, 1, false);
        if (wr == 1) PG8_BAR;
        PG8_WAIT_V(2); PG8_BAR;
        PG8_STAGE(PG8_SB(1, 0), cB + kstep, voffB); PG8_STA(PG8_SA(1, 0), cA + kstep, 0, false); PG8_STAGE(PG8_SB(1, 1), cB + hstepB + kstep, voffB);
        PG8_WAIT_V(6); PG8_BAR;
    } else {
        PG8_STAGE(PG8_SB(0, 0), cB, voffB); PG8_STA(PG8_SA(0, 0), cA, 0, false); PG8_STAGE(PG8_SB(0, 1), cB + hstepB, voffB); PG8_STA(PG8_SA(0, 1), cA, 1, false);
        if (wr == 1) PG8_BAR;
        PG8_WAIT_V(4); PG8_BAR;
        PG8_STAGE(PG8_SB(1, 0), cB + kstep, voffB); PG8_STA(PG8_SA(1, 0), cA + kstep, 0, false); PG8_STAGE(PG8_SB(1, 1), cB + hstepB + kstep, voffB);
        PG8_WAIT_V(6); PG8_BAR;
    }
    for (;;) {
        if constexpr (F8) f8sc = 0x01010101 * (127 - E.f8exp(cur));
        bool has_next = false; const char* nA = cA; const char* nB = cB;
#define PG8_NEXT_UNIT() do { has_next = S.next(ui + 1, nxt); nA = has_next ? nxt.A : cA; nB = has_next ? nxt.B : cB; \
        if constexpr (GATHER) { if (has_next) { PG8_GVA(nvA, ui + 1); } else { _Pragma("unroll") for (int _h = 0; _h < 2; ++_h) _Pragma("unroll") for (int _i = 0; _i < 2; ++_i) nvA[_h][_i] = vA[_h][_i]; } } } while (0)
        if (nt < 4 || !SP2) PG8_NEXT_UNIT();
        for (int t = 0; t < nt; t += 2) {
            const bool last = (t == nt - 2);
            const char* a1 = cA + (size_t)(t + 1) * kstep;
            const char* a2 = last ? nA : cA + (size_t)(t + 2) * kstep; const char* b2 = last ? nB : cB + (size_t)(t + 2) * kstep;
            const char* a3 = a2 + kstep; const char* b3 = b2 + kstep;
            if constexpr (SP2) {
            PG8_LDB(B0, 0, 0); PG8_LDB(B1, 0, 1); PG8_SCHED; PG8_LDA(At, 0, 0); PG8_STA(PG8_SA(1, 1), a1, 1, false);
            PG8_WAIT_V(8); PG8_WAIT_L(0); PG8_BAR; PG8_MMA(0, 0, At, B0); PG8_MMA(0, 1, At, B1); if (t == 0 && nt >= 4) { PG8_SCHED; PG8_NEXT_UNIT(); PG8_SCHED; } PG8_BAR; PG8_SCHED;
            PG8_LDA(At, 0, 1); PG8_STAGE(PG8_SB(0, 0), b2, voffB); PG8_STAGE(PG8_SB(0, 1), b2 + hstepB, voffB); PG8_STA(PG8_SA(0, 0), a2, 0, last);
            PG8_WAIT_V(8); PG8_WAIT_L(0); PG8_BAR; PG8_MMA(1, 0, At, B0); PG8_MMA(1, 1, At, B1); PG8_BAR; PG8_SCHED;
            PG8_LDB(B0, 1, 0); PG8_LDB(B1, 1, 1); PG8_SCHED; PG8_LDA(At, 1, 0); PG8_STA(PG8_SA(0, 1), a2, 1, last);
            PG8_WAIT_V(8); PG8_WAIT_L(0); PG8_BAR; PG8_MMA(0, 0, At, B0); PG8_MMA(0, 1, At, B1); PG8_BAR; PG8_SCHED;
            PG8_LDA(At, 1, 1); PG8_STAGE(PG8_SB(1, 0), b3, voffB); PG8_STAGE(PG8_SB(1, 1), b3 + hstepB, voffB); PG8_STA(PG8_SA(1, 0), a3, 0, last);
            PG8_WAIT_V(8); PG8_WAIT_L(0); PG8_BAR; PG8_MMA(1, 0, At, B0); PG8_MMA(1, 1, At, B1); PG8_BAR; PG8_SCHED;
            } else {
            PG8_LDB(B0, 0, 0); PG8_SCHED; PG8_LDA(At, 0, 0); PG8_STA(PG8_SA(1, 1), a1, 1, false);
            PG8_WAIT_L(8); PG8_BAR; PG8_WAIT_L(0); PG8_MMA(0, 0, At, B0); PG8_BAR; PG8_SCHED;
            PG8_LDB(B1, 0, 1); PG8_STAGE(PG8_SB(0, 0), b2, voffB);
            PG8_BAR; PG8_WAIT_L(0); PG8_MMA(0, 1, At, B1); PG8_BAR;
            PG8_LDA(At, 0, 1); PG8_STA(PG8_SA(0, 0), a2, 0, last);
            PG8_BAR; PG8_WAIT_L(0); PG8_MMA(1, 0, At, B0); PG8_BAR; PG8_SCHED;
            PG8_STAGE(PG8_SB(0, 1), b2 + hstepB, voffB);
            PG8_WAIT_V(6); PG8_BAR; PG8_MMA(1, 1, At, B1); PG8_BAR;
            PG8_LDB(B0, 1, 0); PG8_SCHED; PG8_LDA(At, 1, 0); PG8_STA(PG8_SA(0, 1), a2, 1, last);
            PG8_WAIT_L(8); PG8_BAR; PG8_WAIT_L(0); PG8_MMA(0, 0, At, B0); PG8_BAR; PG8_SCHED;
            PG8_LDB(B1, 1, 1); PG8_STAGE(PG8_SB(1, 0), b3, voffB);
            PG8_BAR; PG8_WAIT_L(0); PG8_MMA(0, 1, At, B1); PG8_BAR;
            PG8_LDA(At, 1, 1); PG8_STA(PG8_SA(1, 0), a3, 0, last);
            PG8_BAR; PG8_WAIT_L(0); PG8_MMA(1, 0, At, B0); PG8_BAR; PG8_SCHED;
            PG8_STAGE(PG8_SB(1, 1), b3 + hstepB, voffB);
            PG8_WAIT_V(6); PG8_BAR; PG8_MMA(1, 1, At, B1); PG8_BAR;
            }
        }
        if constexpr (F8) asm volatile("s_nop 15\n\ts_nop 15" ::: "memory");
        if constexpr (ALIGN_EPI) { if (wr == 0) PG8_BAR; }
        { int l2 = lane; asm volatile("" : "+v"(l2)); E(acc, cur, wr, wc, l2 & 15, l2 >> 4); }
        if (!has_next) break;
#pragma unroll
        for (int a = 0; a < 2; ++a)
#pragma unroll
            for (int b = 0; b < 2; ++b)
#pragma unroll
                for (int m = 0; m < 4; ++m)
#pragma unroll
                    for (int n = 0; n < 2; ++n) acc[a][b][m][n] = (f32x4){0.f, 0.f, 0.f, 0.f};
        cur = nxt; cA = nA; cB = nB; ++ui;
        if constexpr (GATHER) {
#pragma unroll
            for (int _h = 0; _h < 2; ++_h)
#pragma unroll
                for (int _i = 0; _i < 2; ++_i) vA[_h][_i] = nvA[_h][_i];
        }
        if constexpr (ALIGN_EPI) { if (wr == 1) PG8_BAR; }
    }
    PG8_WAIT_V(0);
    if constexpr (!ALIGN_EPI) { if (wr == 0) PG8_BAR; }
    PG8_BAR;
#undef PG8_SA
#undef PG8_SB
#undef PG8_GL
#undef PG8_STAGE
#undef PG8_STA
#undef PG8_GVA
#undef PG8_LDA
#undef PG8_LDB
#undef PG8_MMA
#undef PG8_WAIT_V
#undef PG8_WAIT_L
#undef PG8_BAR
#undef PG8_SCHED
}
}
namespace epi {
__device__ __forceinline__ float clamp_f8(float v) { return __builtin_fminf(__builtin_fmaxf(v, -448.0f), 448.0f); }
__device__ __forceinline__ unsigned pack4_f8(float a, float b, float c, float d) { int w = __builtin_amdgcn_cvt_pk_fp8_f32(clamp_f8(a), clamp_f8(b), 0, false); return (unsigned)__builtin_amdgcn_cvt_pk_fp8_f32(clamp_f8(c), clamp_f8(d), w, true); }
using pg8::Unit;
template <int ACT> struct StoreBf16 {
    static constexpr bool PERM = true;
    bf16_t* O; int ldc;
    __device__ __forceinline__ int f8exp(const Unit&) const { return 8; }
    __device__ __forceinline__ void operator()(const f32x4 (&acc)[2][2][4][2], const Unit& u, int wr, int wc, int fr, int fq) const {
        const int row0 = u.pm * 256 + wr * 64 + fr, col0 = u.pn * 256 + wc * 32 + 8 * fq;
#pragma unroll
        for (int ai = 0; ai < 2; ++ai)
#pragma unroll
            for (int m = 0; m < 4; ++m) { bf16_t* rowp = O + (size_t)(row0 + ai * 128 + m * 16) * ldc + col0;
#pragma unroll
                for (int bj = 0; bj < 2; ++bj) { f32x4 v0 = acc[ai][bj][m][0], v1 = acc[ai][bj][m][1];
                    if (ACT == 1) {
#pragma unroll
                        for (int j = 0; j < 4; ++j) { v0[j] = sigmoidf_(v0[j] * DS2); v1[j] = sigmoidf_(v1[j] * DS2); } }
                    u32x4 w; w.x = cvtpk(v0[0], v0[1]); w.y = cvtpk(v0[2], v0[3]); w.z = cvtpk(v1[0], v1[1]); w.w = cvtpk(v1[2], v1[3]);
                    *(u32x4*)(rowp + bj * 128) = w; } }
    }
};
template <int MODE> struct GateMul {
    static constexpr bool PERM = true;
    const bf16_t* gate; int goff; const bf16_t* prev; bf16_t* O;
    __device__ __forceinline__ void operator()(const f32x4 (&acc)[2][2][4][2], const Unit& u, int wr, int wc, int fr, int fq) const {
        const int row0 = u.pm * 256 + wr * 64 + fr, col0 = u.pn * 256 + wc * 32 + 8 * fq;
#pragma unroll
        for (int ai = 0; ai < 2; ++ai)
#pragma unroll
            for (int m = 0; m < 4; ++m) { const size_t row = (size_t)(row0 + ai * 128 + m * 16);
#pragma unroll
                for (int bj = 0; bj < 2; ++bj) { const int col = col0 + bj * 128;
                    const u32x4 g = *(const u32x4*)(gate + row * 4096 + goff + col);
                    f32x4 v0 = acc[ai][bj][m][0], v1 = acc[ai][bj][m][1];
                    v0[0] *= bf_lo(g.x); v0[1] *= bf_hi(g.x); v0[2] *= bf_lo(g.y); v0[3] *= bf_hi(g.y);
                    v1[0] *= bf_lo(g.z); v1[1] *= bf_hi(g.z); v1[2] *= bf_lo(g.w); v1[3] *= bf_hi(g.w);
                    if (MODE == 1) { const u32x4 p = *(const u32x4*)(prev + row * 2048 + col);
                        v0[0] += bf_lo(p.x); v0[1] += bf_hi(p.x); v0[2] += bf_lo(p.y); v0[3] += bf_hi(p.y);
                        v1[0] += bf_lo(p.z); v1[1] += bf_hi(p.z); v1[2] += bf_lo(p.w); v1[3] += bf_hi(p.w); }
                    if (O78F8 && MODE == 1) { *(u32x2*)((unsigned char*)O + row * 2048 + col) = (u32x2){pack4_f8(v0[0] * F8_SG, v0[1] * F8_SG, v0[2] * F8_SG, v0[3] * F8_SG), pack4_f8(v1[0] * F8_SG, v1[1] * F8_SG, v1[2] * F8_SG, v1[3] * F8_SG)}; }
                    else { u32x4 w; w.x = cvtpk(v0[0], v0[1]); w.y = cvtpk(v0[2], v0[3]); w.z = cvtpk(v1[0], v1[1]); w.w = cvtpk(v1[2], v1[3]);
                    *(u32x4*)(O + row * 2048 + col) = w; } } }
    }
};
struct Resid {
    static constexpr bool PERM = false;
    const float* base; float* out; const float* gate; int goff;
    __device__ __forceinline__ void operator()(const f32x4 (&acc)[2][2][4][2], const Unit& u, int wr, int wc, int fr, int fq) const {
        const int row0 = u.pm * 256 + wr * 64 + fr, col0 = u.pn * 256 + wc * 32 + 4 * fq;
        const int b = (u.pm * 256) / SEQ;
        f32x4 gv[2][2];
#pragma unroll
        for (int bj = 0; bj < 2; ++bj)
#pragma unroll
            for (int n = 0; n < 2; ++n) gv[bj][n] = *(const f32x4*)(gate + (size_t)b * 12288 + goff + col0 + bj * 128 + n * 16);
#pragma unroll
        for (int ai = 0; ai < 2; ++ai)
#pragma unroll
            for (int m = 0; m < 4; ++m) { const size_t off = (size_t)(row0 + ai * 128 + m * 16) * 2048 + col0;
#pragma unroll
                for (int bj = 0; bj < 2; ++bj)
#pragma unroll
                    for (int n = 0; n < 2; ++n) { const f32x4 bs = *(const f32x4*)(base + off + bj * 128 + n * 16);
                        *(f32x4*)(out + off + bj * 128 + n * 16) = bs + gv[bj][n] * acc[ai][bj][m][n]; } }
    }
};
struct SwiGLU {
    static constexpr bool PERM = true;
    bf16_t* O;
    __device__ __forceinline__ void operator()(const f32x4 (&acc)[2][2][4][2], const Unit& u, int wr, int wc, int fr, int fq) const {
        const int r0 = wr * 64 + fr, col0 = u.pn * 128 + wc * 32 + 8 * fq;
#pragma unroll
        for (int ai = 0; ai < 2; ++ai)
#pragma unroll
            for (int m = 0; m < 4; ++m) { const int r = r0 + ai * 128 + m * 16;
                f32x4 v0, v1;
#pragma unroll
                for (int j = 0; j < 4; ++j) { v0[j] = siluf_(acc[ai][0][m][0][j]) * acc[ai][1][m][0][j]; v1[j] = siluf_(acc[ai][0][m][1][j]) * acc[ai][1][m][1][j]; }
                u32x4 w; w.x = cvtpk(v0[0], v0[1]); w.y = cvtpk(v0[2], v0[3]); w.z = cvtpk(v1[0], v1[1]); w.w = cvtpk(v1[2], v1[3]);
                if (r < u.valid) *(u32x4*)(O + (size_t)(u.rowbase + r) * 512 + col0) = w; }
    }
};
struct SwiGLU8 {
    static constexpr bool PERM = true;
    unsigned char* O;
    __device__ __forceinline__ int f8exp(const Unit&) const { return 9; }
    __device__ __forceinline__ void operator()(const f32x4 (&acc)[2][2][4][2], const Unit& u, int wr, int wc, int fr, int fq) const {
        const int r0 = wr * 64 + fr, col0 = u.pn * 128 + wc * 32 + 8 * fq;
        constexpr float ds = 1.0f, us = F8_SA;
#pragma unroll
        for (int ai = 0; ai < 2; ++ai)
#pragma unroll
            for (int m = 0; m < 4; ++m) { const int r = r0 + ai * 128 + m * 16;
                f32x4 v0, v1;
#pragma unroll
                for (int j = 0; j < 4; ++j) { v0[j] = siluf_(acc[ai][0][m][0][j] * ds) * (acc[ai][1][m][0][j] * us); v1[j] = siluf_(acc[ai][0][m][1][j] * ds) * (acc[ai][1][m][1][j] * us); }
                if (r < u.valid) *(u32x2*)(O + (size_t)(u.rowbase + r) * 512 + col0) = (u32x2){pack4_f8(v0[0], v0[1], v0[2], v0[3]), pack4_f8(v1[0], v1[1], v1[2], v1[3])}; }
    }
};
struct DownY {
    static constexpr int PERM = 2;
    unsigned char* O;
    __device__ __forceinline__ int f8exp(const Unit&) const { return 8; }
    __device__ __forceinline__ void operator()(const f32x4 (&acc)[2][2][4][2], const Unit& u, int wr, int wc, int fr, int fq) const {
        const int r0 = wr * 64 + fr, col0 = u.pn * 256 + wc * 64 + 16 * fq;
#pragma unroll
        for (int ai = 0; ai < 2; ++ai)
#pragma unroll
            for (int m = 0; m < 4; ++m) { const int r = r0 + ai * 128 + m * 16;
                if (r < u.valid) {
                    const f32x4 v0 = acc[ai][0][m][0], v1 = acc[ai][0][m][1], v2 = acc[ai][1][m][0], v3 = acc[ai][1][m][1];
                    int w0 = __builtin_amdgcn_cvt_pk_fp8_f32(v0[0], v0[1], 0, false); w0 = __builtin_amdgcn_cvt_pk_fp8_f32(v0[2], v0[3], w0, true);
                    int w1 = __builtin_amdgcn_cvt_pk_fp8_f32(v1[0], v1[1], 0, false); w1 = __builtin_amdgcn_cvt_pk_fp8_f32(v1[2], v1[3], w1, true);
                    int w2 = __builtin_amdgcn_cvt_pk_fp8_f32(v2[0], v2[1], 0, false); w2 = __builtin_amdgcn_cvt_pk_fp8_f32(v2[2], v2[3], w2, true);
                    int w3 = __builtin_amdgcn_cvt_pk_fp8_f32(v3[0], v3[1], 0, false); w3 = __builtin_amdgcn_cvt_pk_fp8_f32(v3[2], v3[3], w3, true);
                    *(u32x4*)(O + (size_t)(u.rowbase + r) * 2048 + col0) = (u32x4){(unsigned)w0, (unsigned)w1, (unsigned)w2, (unsigned)w3}; } }
    }
};
struct StoreQK {
    static constexpr bool PERM = true;
    bf16_t* Q; bf16_t* KT; float qscale;
    __device__ __forceinline__ void operator()(const f32x4 (&acc)[2][2][4][2], const Unit& u, int wr, int wc, int fr, int fq) const {
        const int row0 = u.pm * 256 + wr * 64 + fr, col0 = u.pn * 256 + wc * 32 + 8 * fq;
        const bool isk = (u.pn >= 4);
#pragma unroll
        for (int ai = 0; ai < 2; ++ai)
#pragma unroll
            for (int m = 0; m < 4; ++m) { const int row = row0 + ai * 128 + m * 16;
#pragma unroll
                for (int bj = 0; bj < 2; ++bj) { const float sc = (isk ? 1.0f : qscale) * DS2; const f32x4 v0 = acc[ai][bj][m][0] * sc, v1 = acc[ai][bj][m][1] * sc; const int col = col0 + bj * 128;
                    u32x4 w; w.x = cvtpk(v0[0], v0[1]); w.y = cvtpk(v0[2], v0[3]); w.z = cvtpk(v1[0], v1[1]); w.w = cvtpk(v1[2], v1[3]);
                    bf16_t* p = isk ? KT + ((((size_t)((col - 1024) >> 7) * 256 + (row >> 6)) * 64 + (row & 63)) * 128 + (col & 127)) : Q + (size_t)row * 1024 + col;
                    *(u32x4*)p = w; } }
    }
};
struct StoreQK8 {
    static constexpr bool PERM = true;
    unsigned char* Q; unsigned char* KT; float qs, ks;
    __device__ __forceinline__ void operator()(const f32x4 (&acc)[2][2][4][2], const Unit& u, int wr, int wc, int fr, int fq) const {
        const int row0 = u.pm * 256 + wr * 64 + fr, col0 = u.pn * 256 + wc * 32 + 8 * fq;
        const bool isk = (u.pn >= 4);
#pragma unroll
        for (int ai = 0; ai < 2; ++ai)
#pragma unroll
            for (int m = 0; m < 4; ++m) { const int row = row0 + ai * 128 + m * 16;
#pragma unroll
                for (int bj = 0; bj < 2; ++bj) { const float sc = isk ? 1.0f : qs;        const f32x4 v0 = acc[ai][bj][m][0] * sc, v1 = acc[ai][bj][m][1] * sc; const int col = col0 + bj * 128;
                    unsigned char* p = isk ? KT + ((((size_t)((col - 1024) >> 7) * 256 + (row >> 6)) * 64 + (row & 63)) * 128 + (col & 127)) : Q + (size_t)row * 1024 + col;
                    *(u32x2*)p = (u32x2){pack4_f8(v0[0], v0[1], v0[2], v0[3]), pack4_f8(v1[0], v1[1], v1[2], v1[3])}; }
                __builtin_amdgcn_sched_barrier(0); }
    }
};
struct StoreQKboth {
    static constexpr bool PERM = true;
    StoreQK b16; unsigned char* Q8; unsigned char* KT8;
    __device__ __forceinline__ void operator()(const f32x4 (&acc)[2][2][4][2], const Unit& u, int wr, int wc, int fr, int fq) const {
        b16(acc, u, wr, wc, fr, fq);
        const int row0 = u.pm * 256 + wr * 64 + fr, col0 = u.pn * 256 + wc * 32 + 8 * fq;
        const bool isk = (u.pn >= 4);
        const float sc = isk ? att::D8_KS : att::MB8_QS;
#pragma unroll
        for (int ai = 0; ai < 2; ++ai)
#pragma unroll
            for (int m = 0; m < 4; ++m) { const int row = row0 + ai * 128 + m * 16;
#pragma unroll
                for (int bj = 0; bj < 2; ++bj) { const f32x4 v0 = acc[ai][bj][m][0] * sc, v1 = acc[ai][bj][m][1] * sc; const int col = col0 + bj * 128;
                    unsigned char* p = isk ? KT8 + ((((size_t)((col - 1024) >> 7) * 256 + (row >> 6)) * 64 + (row & 63)) * 128 + (col & 127)) : Q8 + (size_t)row * 1024 + col;
                    *(u32x2*)p = (u32x2){pack4_f8(v0[0], v0[1], v0[2], v0[3]), pack4_f8(v1[0], v1[1], v1[2], v1[3])}; }
                __builtin_amdgcn_sched_barrier(0); }
    }
};
struct StoreVT8 {
    static constexpr bool PERM = true;
    unsigned char* VT; float vs;
    __device__ __forceinline__ void operator()(const f32x4 (&acc)[2][2][4][2], const Unit& u, int wr, int wc, int fr, int fq) const {
        const int row0 = u.pm * 256 + wr * 64 + fr, col0 = u.pn * 256 + wc * 32 + 8 * fq;
#pragma unroll
        for (int ai = 0; ai < 2; ++ai)
#pragma unroll
            for (int m = 0; m < 4; ++m) { const int f = row0 + ai * 128 + m * 16;
#pragma unroll
                for (int bj = 0; bj < 2; ++bj) { const f32x4 v0 = acc[ai][bj][m][0], v1 = acc[ai][bj][m][1]; const int tok = col0 + bj * 128, k = tok & 63;
                    unsigned char* p = VT + ((((size_t)(f >> 7) * 256 + (tok >> 6)) * 128 + (f & 127)) * 64 + (k >> 5) * 16 + ((k & 31) >> 3) * 4);
                    *(unsigned*)p = pack4_f8(v0[0], v0[1], v0[2], v0[3]); *(unsigned*)(p + 32) = pack4_f8(v1[0], v1[1], v1[2], v1[3]); }
                __builtin_amdgcn_sched_barrier(0); }
    }
};
struct StoreVT {
    static constexpr bool PERM = true;
    bf16_t* VT;
    __device__ __forceinline__ void operator()(const f32x4 (&acc)[2][2][4][2], const Unit& u, int wr, int wc, int fr, int fq) const {
        const int row0 = u.pm * 256 + wr * 64 + fr, col0 = u.pn * 256 + wc * 32 + 8 * fq;
#pragma unroll
        for (int ai = 0; ai < 2; ++ai)
#pragma unroll
            for (int m = 0; m < 4; ++m) { const int f = row0 + ai * 128 + m * 16;
#pragma unroll
                for (int bj = 0; bj < 2; ++bj) { const f32x4 v0 = acc[ai][bj][m][0] * DS2, v1 = acc[ai][bj][m][1] * DS2; const int tok = col0 + bj * 128;
                    u32x4 w; w.x = cvtpk(v0[0], v0[1]); w.y = cvtpk(v0[2], v0[3]); w.z = cvtpk(v1[0], v1[1]); w.w = cvtpk(v1[2], v1[3]);
                    *(u32x4*)(VT + ((((size_t)(f >> 7) * 256 + (tok >> 6)) * 128 + (f & 127)) * 64 + (tok & 63))) = w; } }
    }
};
struct ProjEpi {
    static constexpr bool PERM = true, HAS_MID = false;
    StoreQK8 qkd; StoreQKboth qkm; StoreBf16<1> gates;
    __device__ __forceinline__ int f8exp(const Unit& u) const { return (u.pn >= 4 && u.pn < 8) ? P2_EXP - 2 : P2_EXP; }
    __device__ __forceinline__ void operator()(const f32x4 (&acc)[2][2][4][2], const Unit& u, int wr, int wc, int fr, int fq) const {
        Unit v = u;
        if (u.pn < 8) qkd(acc, v, wr, wc, fr, fq);
        else if (u.pn < 16) { v.pn = u.pn - 8; qkm(acc, v, wr, wc, fr, fq); }
        else { v.pn = u.pn - 16; gates(acc, v, wr, wc, fr, fq); }
    }
};
struct ProjVT {
    static constexpr bool PERM = true, HAS_MID = false;
    StoreVT8 vd; StoreVT8 vm;
    __device__ __forceinline__ int f8exp(const Unit& u) const { return P2_EXP - 3; }
    __device__ __forceinline__ void operator()(const f32x4 (&acc)[2][2][4][2], const Unit& u, int wr, int wc, int fr, int fq) const {
        Unit v = u;
        if (u.pm < 4) vd(acc, v, wr, wc, fr, fq); else { v.pm = u.pm - 4; vm(acc, v, wr, wc, fr, fq); }
    }
};
struct GatePair {
    static constexpr bool PERM = true, HAS_MID = false;
    GateMul<0> e0; GateMul<1> e1;
    __device__ __forceinline__ int f8exp(const Unit& u) const { return u.aux == 0 ? 9 : 11; }
    __device__ __forceinline__ void operator()(const f32x4 (&acc)[2][2][4][2], const Unit& u, int wr, int wc, int fr, int fq) const {
        if (u.aux == 0) e0(acc, u, wr, wc, fr, fq); else e1(acc, u, wr, wc, fr, fq);
    }
};
struct ResidBf16 {
    static constexpr bool PERM = true, HAS_MID = false;
    const float* base; bf16_t* out; const float* gate; int goff;
    __device__ __forceinline__ int f8exp(const Unit&) const { return 10; }
    __device__ __forceinline__ void operator()(const f32x4 (&acc)[2][2][4][2], const Unit& u, int wr, int wc, int fr, int fq) const {
        const int row0 = u.pm * 256 + wr * 64 + fr, col0 = u.pn * 256 + wc * 32 + 8 * fq;
        const int b = (u.pm * 256) / SEQ;
        f32x4 gv[2][2];
#pragma unroll
        for (int bj = 0; bj < 2; ++bj)
#pragma unroll
            for (int n = 0; n < 2; ++n) gv[bj][n] = *(const f32x4*)(gate + (size_t)b * 12288 + goff + col0 + bj * 128 + n * 4);
#pragma unroll
        for (int ai = 0; ai < 2; ++ai)
#pragma unroll
            for (int m = 0; m < 4; ++m) { const size_t off = (size_t)(row0 + ai * 128 + m * 16) * 2048 + col0;
#pragma unroll
                for (int bj = 0; bj < 2; ++bj) {
                    const f32x4 b0 = *(const f32x4*)(base + off + bj * 128), b1 = *(const f32x4*)(base + off + bj * 128 + 4);
                    const f32x4 v0 = b0 + gv[bj][0] * acc[ai][bj][m][0], v1 = b1 + gv[bj][1] * acc[ai][bj][m][1];
                    u32x4 w; w.x = cvtpk(v0[0], v0[1]); w.y = cvtpk(v0[2], v0[3]); w.z = cvtpk(v1[0], v1[1]); w.w = cvtpk(v1[2], v1[3]);
                    *(u32x4*)(out + off + bj * 128) = w; } }
    }
};
}
namespace att {
constexpr int KROW = 272;
constexpr int VROW = 144;
constexpr int KBUF = 64 * KROW;
constexpr int VBUF = 128 * VROW;
constexpr int OFF_K = 0, OFF_V = 2 * KBUF, OFF_TAB = OFF_V + 2 * VBUF, OFF_G = OFF_TAB + 512, OFF_END = OFF_G + 512;
static_assert(OFF_END <= RING_BYTES, "attention LDS");
__device__ __forceinline__ int crow(int i, int hh) { return (i & 3) + 8 * (i >> 2) + 4 * hh; }

__device__ __forceinline__ int t5_bucket(int n) {
    if (n < 16) return n;
    int b = 16;
    b += (n >= 19); b += (n >= 21); b += (n >= 24); b += (n >= 27); b += (n >= 31); b += (n >= 35); b += (n >= 40); b += (n >= 46);
    b += (n >= 52); b += (n >= 59); b += (n >= 67); b += (n >= 77); b += (n >= 87); b += (n >= 99); b += (n >= 113);
    return b;
}
__device__ __forceinline__ void fill_bias_tab(LAS float* tab, const float* rel_bias, int col) {
    if (threadIdx.x < 128) { const int n = threadIdx.x; tab[n] = (rel_bias[t5_bucket(n) * 16 + col] - rel_bias[31 * 16 + col]) * LOG2E; }
}

struct TileRegs { u32x4 k[2]; u32x4 v[2]; };
__device__ __forceinline__ void tile_load(TileRegs& R, const bf16_t* kt, const bf16_t* vt, int tid) {
#pragma unroll
    for (int i = 0; i < 2; ++i) { const int c = tid + 512 * i; R.k[i] = *(const u32x4*)(kt + c * 8); }
#pragma unroll
    for (int i = 0; i < 2; ++i) { const int c = tid + 512 * i; R.v[i] = *(const u32x4*)(vt + c * 8); }
}
__device__ __forceinline__ void tile_store(const TileRegs& R, LAS unsigned char* kb, LAS unsigned char* vb, int tid) {
#pragma unroll
    for (int i = 0; i < 2; ++i) { const int c = tid + 512 * i; *(LAS u32x4*)(kb + (c >> 4) * KROW + (c & 15) * 16) = R.k[i]; }
#pragma unroll
    for (int i = 0; i < 2; ++i) { const int c = tid + 512 * i;
        LAS unsigned char* p = vb + (c >> 3) * VROW + ((c & 7) >> 1) * 32 + (c & 1) * 8;
        *(LAS u32x2*)p = (u32x2){R.v[i].x, R.v[i].y}; *(LAS u32x2*)(p + 16) = (u32x2){R.v[i].z, R.v[i].w}; }
}

template <int NMAP, int KS>
__device__ __forceinline__ void attn_half(const LAS unsigned char* kb, const LAS unsigned char* vb, int kh, const bf16x8 (&qf)[NMAP][KS], f32x16 (&O)[NMAP][4],
                                          float (&mrun)[NMAP], float (&lrun)[NMAP], int qpos, int kvpos0, bool need_mask, bool need_bias, const LAS float* btab, float sc, int r, int hh, int kcolbase) {
    bf16x8 P[NMAP][2];
#pragma unroll
    for (int m = 0; m < NMAP; ++m) {
        f32x16 s;
#pragma unroll
        for (int i = 0; i < 16; ++i) s[i] = 0.f;
#pragma unroll
        for (int ks = 0; ks < KS; ++ks) {
            const bf16x8 kf = *(const LAS bf16x8*)(kb + (32 * kh + r) * KROW + (kcolbase + m * 16 * KS + 16 * ks + 8 * hh) * 2);
            s = __builtin_amdgcn_mfma_f32_32x32x16_bf16(kf, qf[m][ks], s, 0, 0, 0);
        }
#pragma unroll
        for (int i = 0; i < 16; ++i) s[i] *= sc;
        if (need_bias) {
#pragma unroll
            for (int i = 0; i < 16; ++i) { int rel = qpos - (kvpos0 + crow(i, hh)); rel = rel < 0 ? 0 : (rel > 127 ? 127 : rel); s[i] += btab[rel]; }
        }
        if (need_mask) {
#pragma unroll
            for (int i = 0; i < 16; ++i) { if (kvpos0 + crow(i, hh) > qpos) s[i] = -INFINITY; }
        }
        float mx = s[0];
#pragma unroll
        for (int i = 1; i < 16; ++i) mx = fmaxf(mx, s[i]);
        mx = fmaxf(mx, __shfl_xor(mx, 32));
        const float mnew = fmaxf(mrun[m], mx);
        const float alpha = fast_exp2(mrun[m] - mnew);
        float sum = 0.f;
#pragma unroll
        for (int i = 0; i < 16; ++i) { const float p = fast_exp2(s[i] - mnew); sum += p; s[i] = p; }
        lrun[m] = lrun[m] * alpha + sum; mrun[m] = mnew;
#pragma unroll
        for (int dt = 0; dt < 4; ++dt)
#pragma unroll
            for (int i = 0; i < 16; ++i) O[m][dt][i] *= alpha;
#pragma unroll
        for (int st = 0; st < 2; ++st) { u32x4 w; w.x = cvtpk(s[8 * st + 0], s[8 * st + 1]); w.y = cvtpk(s[8 * st + 2], s[8 * st + 3]); w.z = cvtpk(s[8 * st + 4], s[8 * st + 5]); w.w = cvtpk(s[8 * st + 6], s[8 * st + 7]);
            P[m][st] = __builtin_bit_cast(bf16x8, w); }
    }
#pragma unroll
    for (int dt = 0; dt < 4; ++dt)
#pragma unroll
        for (int st = 0; st < 2; ++st) {
            const bf16x8 vf = *(const LAS bf16x8*)(vb + (32 * dt + r) * VROW + (2 * kh + st) * 32 + hh * 16);
#pragma unroll
            for (int m = 0; m < NMAP; ++m) O[m][dt] = __builtin_amdgcn_mfma_f32_32x32x16_bf16(vf, P[m][st], O[m][dt], 0, 0, 0);
        }
}

#define SBAR() __builtin_amdgcn_sched_barrier(0)
constexpr int TBUF = KBUF + VBUF;
constexpr int D_OFF_TAB = 3 * TBUF, D_OFF_G = D_OFF_TAB + 512;
static_assert(D_OFF_G + 512 <= RING_BYTES, "diff attention LDS");
constexpr float D_C = 0.125f * LOG2E;
__device__ __forceinline__ void d_load_kf(bf16x8 (&kf)[4], const LAS unsigned char* kb, int kh, int r, int hh, int kcol) {
#pragma unroll
    for (int ks = 0; ks < 4; ++ks) kf[ks] = *(const LAS bf16x8*)(kb + (32 * kh + r) * KROW + (kcol + 16 * ks + 8 * hh) * 2);
}
constexpr float D_THR = 8.0f;
__device__ __forceinline__ float max3_(float a, float b, float c) { float r; asm("v_max3_f32 %0, %1, %2, %3" : "=v"(r) : "v"(a), "v"(b), "v"(c)); return r; }
template <int MODE, bool LOADV, bool PREFK>
__device__ __forceinline__ void d_half_a(const bf16x8 (&kf)[4], bf16x8 (&kfn)[4], const LAS unsigned char* knext, int khn, const LAS unsigned char* vb, int kh,
                                         const bf16x8 (&qf)[4], f32x16 (&o)[4], float& mref, float& lrun, int qpos, int kvpos0, bool need_mask, bool need_bias, bool first,
                                         const LAS float* btab, int r, int hh, int kcol, bf16x8 (&vf)[4], bf16x8 (&P)[2]) {
    if (LOADV) {
#pragma unroll
        for (int dt = 0; dt < 2; ++dt)
#pragma unroll
            for (int st = 0; st < 2; ++st) vf[2 * dt + st] = *(const LAS bf16x8*)(vb + (32 * dt + r) * VROW + (2 * kh + st) * 32 + hh * 16);
    }
    SBAR();
    f32x16 s;
#pragma unroll
    for (int i = 0; i < 16; ++i) s[i] = 0.f;
    __builtin_amdgcn_s_setprio(1);
#pragma unroll
    for (int ks = 0; ks < 4; ++ks) { if (MODE != 3) s = __builtin_amdgcn_mfma_f32_32x32x16_bf16(kf[ks], qf[ks], s, 0, 0, 0); else { s[ks] += __builtin_bit_cast(float, (int)kf[ks][0]); s[4 + ks] += __builtin_bit_cast(float, (int)qf[ks][1]); } }
    __builtin_amdgcn_s_setprio(0);
    if (PREFK) d_load_kf(kfn, knext, khn, r, hh, kcol);
    SBAR();
    if (MODE == 4) { P[0] = qf[0]; P[1] = qf[1]; mref = fmaxf(mref, s[0]); } else {
    if (need_bias) {
#pragma unroll
        for (int i = 0; i < 16; ++i) { int rel = qpos - (kvpos0 + crow(i, hh)); rel = rel < 0 ? 0 : (rel > 127 ? 127 : rel); s[i] += btab[rel]; }
    }
    if (need_mask) {
#pragma unroll
        for (int i = 0; i < 16; ++i) { if (kvpos0 + crow(i, hh) > qpos) s[i] = -INFINITY; }
    }
    float mx = max3_(s[0], s[1], s[2]);
    mx = max3_(mx, s[3], s[4]); mx = max3_(mx, s[5], s[6]); mx = max3_(mx, s[7], s[8]); mx = max3_(mx, s[9], s[10]); mx = max3_(mx, s[11], s[12]); mx = max3_(mx, s[13], s[14]);
    { auto rr = __builtin_amdgcn_permlane32_swap(__float_as_uint(mx), __float_as_uint(mx), false, false); mx = max3_(s[15], __uint_as_float(rr[0]), __uint_as_float(rr[1])); }
    if (first || __any(mx - mref > D_THR)) {
        const float mn = first ? mx : fmaxf(mref, mx);
        const float alpha = first ? 0.f : fast_exp2(mref - mn);
        mref = mn; lrun *= alpha;
#pragma unroll
        for (int dt = 0; dt < 4; ++dt)
#pragma unroll
            for (int i = 0; i < 16; ++i) o[dt][i] *= alpha;
    }
    float sum = 0.f;
#pragma unroll
    for (int i = 0; i < 16; ++i) { const float p = fast_exp2(s[i] - mref); sum += p; s[i] = p; }
    lrun += sum;
#pragma unroll
    for (int st = 0; st < 2; ++st) { u32x4 w; w.x = cvtpk(s[8 * st + 0], s[8 * st + 1]); w.y = cvtpk(s[8 * st + 2], s[8 * st + 3]); w.z = cvtpk(s[8 * st + 4], s[8 * st + 5]); w.w = cvtpk(s[8 * st + 6], s[8 * st + 7]);
        P[st] = __builtin_bit_cast(bf16x8, w); }
    }
}
template <int MODE, bool LOADV>
__device__ __forceinline__ void d_half_b(f32x16 (&o)[4], bf16x8 (&vf)[4], const bf16x8 (&P)[2], const LAS unsigned char* vb, int kh, int r, int hh) {
    if (LOADV) {
#pragma unroll
        for (int dt = 0; dt < 2; ++dt)
#pragma unroll
            for (int st = 0; st < 2; ++st) vf[2 * dt + st] = *(const LAS bf16x8*)(vb + (32 * dt + r) * VROW + (2 * kh + st) * 32 + hh * 16);
    }
    bf16x8 vg[4];
#pragma unroll
    for (int dt = 2; dt < 4; ++dt)
#pragma unroll
        for (int st = 0; st < 2; ++st) vg[2 * (dt - 2) + st] = *(const LAS bf16x8*)(vb + (32 * dt + r) * VROW + (2 * kh + st) * 32 + hh * 16);
    asm volatile("s_waitcnt lgkmcnt(4)" ::: "memory"); SBAR();
    __builtin_amdgcn_s_setprio(1);
#pragma unroll
    for (int dt = 0; dt < 2; ++dt)
#pragma unroll
        for (int st = 0; st < 2; ++st) {
            if (MODE != 3) o[dt] = __builtin_amdgcn_mfma_f32_32x32x16_bf16(vf[2 * dt + st], P[st], o[dt], 0, 0, 0);
            else o[dt][st] += __builtin_bit_cast(float, (int)vf[2 * dt + st][0]) * __builtin_bit_cast(float, (int)P[st][0]);
        }
    asm volatile("s_waitcnt lgkmcnt(0)" ::: "memory"); SBAR();
#pragma unroll
    for (int dt = 2; dt < 4; ++dt)
#pragma unroll
        for (int st = 0; st < 2; ++st) {
            if (MODE != 3) o[dt] = __builtin_amdgcn_mfma_f32_32x32x16_bf16(vg[2 * (dt - 2) + st], P[st], o[dt], 0, 0, 0);
            else o[dt][st] += __builtin_bit_cast(float, (int)vg[2 * (dt - 2) + st][0]) * __builtin_bit_cast(float, (int)P[st][0]);
        }
    __builtin_amdgcn_s_setprio(0);
}
template <int MODE>
__device__ __forceinline__ void diff_unit(LAS unsigned char* lds, int b, int h, int qt, const bf16_t* QD, const bf16_t* KDT, const bf16_t* VDT, bf16_t* AD, const float* subln, const float* rel_bias) {
    int tid_ = threadIdx.x; asm volatile("" : "+v"(tid_));
    const int tid = tid_, lane = tid & 63, r = lane & 31, hh = lane >> 5; const int wid = __builtin_amdgcn_readfirstlane(tid >> 6);
    const int map = wid >> 2, qsub = wid & 3;
    const int q0 = qt * 128, qw0 = q0 + 32 * qsub, qpos = qw0 + r;
    const size_t tok0 = (size_t)b * SEQ;
    const LAS float* btab = (const LAS float*)(lds + D_OFF_TAB);
    const LAS float* gtab = (const LAS float*)(lds + D_OFF_G);
    const int kcol = map * 64;
    bf16x8 qf[4];
#pragma unroll
    for (int ks = 0; ks < 4; ++ks) qf[ks] = *(const bf16x8*)(QD + (tok0 + qpos) * 1024 + h * 128 + map * 64 + 16 * ks + 8 * hh);
    f32x16 o[4];
#pragma unroll
    for (int dt = 0; dt < 4; ++dt)
#pragma unroll
        for (int i = 0; i < 16; ++i) o[dt][i] = 0.f;
    float mrun = 0.f, lrun = 0.f;
    const bf16_t* kbase = KDT + ((size_t)h * 256 + b * 128) * 8192;
    const bf16_t* vbase = VDT + ((size_t)h * 256 + b * 128) * 8192;
    const int NT = 2 * (qt + 1);
    TileRegs R;
    bf16x8 kfa[4], kfb[4];
    __syncthreads();
    fill_bias_tab((LAS float*)(lds + D_OFF_TAB), rel_bias, h);
    if (tid < 128) ((LAS float*)(lds + D_OFF_G))[tid] = subln[tid];
    tile_load(R, kbase, vbase, tid);
    tile_store(R, lds, lds + KBUF, tid);
    tile_load(R, kbase + 8192, vbase + 8192, tid);
    __syncthreads();
    if (MODE != 2) d_load_kf(kfa, lds, 0, r, hh, kcol);
    int bc = 0;
    bf16x8 vf[4], P[2];
#define D_STAGE() do { if (t + 1 < NT) tile_store(R, lds + bn * TBUF, lds + bn * TBUF + KBUF, tid); \
        if (t + 2 < NT) tile_load(R, kbase + (size_t)(MODE == 1 ? 0 : t + 2) * 8192, vbase + (size_t)(MODE == 1 ? 0 : t + 2) * 8192, tid); \
        __syncthreads(); } while (0)
    if (wid < 4) {
#pragma unroll 1
        for (int t = 0; t < NT; ++t) {
            const int bn = (bc == 2) ? 0 : bc + 1;
            const LAS unsigned char* kb = lds + bc * TBUF; const LAS unsigned char* vb = kb + KBUF;
            const int k0 = 64 * t;
            { const bool nm = (k0 + 31 > qw0), nb = (qw0 - (k0 + 31) < 113);
              if (MODE != 2) { d_half_a<MODE, true, true>(kfa, kfb, kb, 1, vb, 0, qf, o, mrun, lrun, qpos, k0, nm, nb, t == 0, btab, r, hh, kcol, vf, P); d_half_b<MODE, false>(o, vf, P, vb, 0, r, hh); } }
            D_STAGE();
            { const bool nm = (k0 + 63 > qw0), nb = (qw0 - (k0 + 63) < 113);
              if (MODE != 2) { d_half_a<MODE, true, true>(kfb, kfa, lds + bn * TBUF, 0, vb, 1, qf, o, mrun, lrun, qpos, k0 + 32, nm, nb, false, btab, r, hh, kcol, vf, P); d_half_b<MODE, false>(o, vf, P, vb, 1, r, hh); } }
            bc = bn;
        }
    } else {
#pragma unroll 1
        for (int t = 0; t < NT; ++t) {
            const int bn = (bc == 2) ? 0 : bc + 1;
            const LAS unsigned char* kb = lds + bc * TBUF; const LAS unsigned char* vb = kb + KBUF;
            const int k0 = 64 * t;
            { const bool nm = (k0 + 31 > qw0), nb = (qw0 - (k0 + 31) < 113);
              if (MODE != 2) d_half_a<MODE, false, false>(kfa, kfb, kb, 1, vb, 0, qf, o, mrun, lrun, qpos, k0, nm, nb, t == 0, btab, r, hh, kcol, vf, P); }
            D_STAGE();
            if (MODE != 2) { d_half_b<MODE, true>(o, vf, P, vb, 0, r, hh); d_load_kf(kfb, kb, 1, r, hh, kcol); }
            { const bool nm = (k0 + 63 > qw0), nb = (qw0 - (k0 + 63) < 113);
              if (MODE != 2) { d_half_a<MODE, true, true>(kfb, kfa, lds + bn * TBUF, 0, vb, 1, qf, o, mrun, lrun, qpos, k0 + 32, nm, nb, false, btab, r, hh, kcol, vf, P); d_half_b<MODE, false>(o, vf, P, vb, 1, r, hh); } }
            bc = bn;
        }
    }
#undef D_STAGE
    __syncthreads();
    const float l = lrun + __shfl_xor(lrun, 32);
    LAS float* xch = (LAS float*)lds + qsub * 4096 + lane;
    if (map == 1) {
        const float lam = *(const LAS float*)(lds + MISC_OFF + 68);
        const float f = lam / l;
#pragma unroll
        for (int dt = 0; dt < 4; ++dt)
#pragma unroll
            for (int i = 0; i < 16; ++i) xch[(dt * 16 + i) * 64] = o[dt][i] * f;
    }
    __syncthreads();
    if (map == 0) {
        const float i0 = 1.0f / l;
        float ss = 0.f;
#pragma unroll
        for (int dt = 0; dt < 4; ++dt)
#pragma unroll
            for (int i = 0; i < 16; ++i) { const float v = o[dt][i] * i0 - xch[(dt * 16 + i) * 64]; o[dt][i] = v; ss += v * v; }
        ss += __shfl_xor(ss, 32);
        const float rs = 0.8f / sqrtf(ss * (1.0f / 128.0f) + RMS_EPS);
        bf16_t* orow = AD + (tok0 + qpos) * 1024 + h * 128;
#pragma unroll
        for (int dt = 0; dt < 4; ++dt)
#pragma unroll
            for (int g = 0; g < 4; ++g) { const int d = 32 * dt + 8 * g + 4 * hh;
                const f32x4 gg = *(const LAS f32x4*)(gtab + d);
                u32x2 w; w.x = cvtpk(o[dt][4 * g + 0] * rs * gg[0], o[dt][4 * g + 1] * rs * gg[1]); w.y = cvtpk(o[dt][4 * g + 2] * rs * gg[2], o[dt][4 * g + 3] * rs * gg[3]);
                *(u32x2*)(orow + d) = w; }
    }
}

constexpr int KROW8 = 144, VROW8 = 80, KBUF8 = 64 * KROW8, VBUF8 = 128 * VROW8, TBUF8 = KBUF8 + VBUF8;
static_assert(4 * TBUF8 <= D_OFF_TAB, "fp8 diff attention LDS");
constexpr float D8_C = 1.0f / 64.0f, D8_THR = 3.0f * 64.0f, D8_SH = 5.0f;
struct TileRegs8 { u32x4 k, v; };
__device__ __forceinline__ void tile_load8(TileRegs8& R, const unsigned char* kt, const unsigned char* vt, int tid) { R.k = *(const u32x4*)(kt + tid * 16); R.v = *(const u32x4*)(vt + tid * 16); }
__device__ __forceinline__ void tile_store8(const TileRegs8& R, LAS unsigned char* kb, LAS unsigned char* vb, int tid) {
    *(LAS u32x4*)(kb + (tid >> 3) * KROW8 + (tid & 7) * 16) = R.k; *(LAS u32x4*)(vb + (tid >> 2) * VROW8 + (tid & 3) * 16) = R.v; }
__device__ __forceinline__ i32x8 cat8(const i32x4 a, const i32x4 b) { return __builtin_shufflevector(a, b, 0, 1, 2, 3, 4, 5, 6, 7); }
__device__ __forceinline__ void d8_load_kf(i32x8 (&kf)[2], const LAS unsigned char* kb, int r, int hh, int kcolb) {
#pragma unroll
    for (int kh = 0; kh < 2; ++kh) { const LAS unsigned char* q = kb + (32 * kh + r) * KROW8 + kcolb + 32 * hh; kf[kh] = cat8(*(const LAS i32x4*)q, *(const LAS i32x4*)(q + 16)); }
}
template <int DT0>
__device__ __forceinline__ void d8_load_vf2(i32x8 (&vf)[2], const LAS unsigned char* vb, int r, int hh) {
#pragma unroll
    for (int dt = 0; dt < 2; ++dt) { const LAS unsigned char* q = vb + (32 * (DT0 + dt) + r) * VROW8 + 32 * hh; vf[dt] = cat8(*(const LAS i32x4*)q, *(const LAS i32x4*)(q + 16)); }
}
__device__ __forceinline__ void d8_scores(f32x16& s0, f32x16& s1, const i32x8 (&kf)[2], const i32x8& qf) {
    f32x16 z;
#pragma unroll
    for (int i = 0; i < 16; ++i) z[i] = 0.f;
    __builtin_amdgcn_s_setprio(1);
    s0 = __builtin_amdgcn_mfma_scale_f32_32x32x64_f8f6f4(kf[0], qf, z, 0, 0, 0, 0x7F7F7F7F, 0, 0x7F7F7F7F);
    s1 = __builtin_amdgcn_mfma_scale_f32_32x32x64_f8f6f4(kf[1], qf, z, 0, 0, 0, 0x7F7F7F7F, 0, 0x7F7F7F7F);
    __builtin_amdgcn_s_setprio(0);
}
template <bool ROW = false>
__device__ __forceinline__ i32x8 d8_softmax(f32x16& s0, f32x16& s1, f32x16 (&o)[4], float& mref, float& lrun, int qpos, int k0, bool need_mask, bool need_bias, bool first, const LAS float* btab, int hh) {
    if (need_bias) {
#pragma unroll
        for (int i = 0; i < 16; ++i) { int rel = qpos - (k0 + crow(i, hh)); rel = rel < 0 ? 0 : (rel > 127 ? 127 : rel); s0[i] += btab[rel]; }
        SBAR();
#pragma unroll
        for (int i = 0; i < 16; ++i) { int rel = qpos - (k0 + 32 + crow(i, hh)); rel = rel < 0 ? 0 : (rel > 127 ? 127 : rel); s1[i] += btab[rel]; }
        SBAR();
    }
    if (need_mask) {
#pragma unroll
        for (int i = 0; i < 16; ++i) { if (k0 + crow(i, hh) > qpos) s0[i] = -INFINITY; if (k0 + 32 + crow(i, hh) > qpos) s1[i] = -INFINITY; }
    }
    float mx = max3_(s0[0], s0[1], s0[2]);
#pragma unroll
    for (int i = 3; i < 15; i += 2) mx = max3_(mx, s0[i], s0[i + 1]);
    mx = max3_(mx, s0[15], s1[0]);
#pragma unroll
    for (int i = 1; i < 15; i += 2) mx = max3_(mx, s1[i], s1[i + 1]);
    { auto rr = __builtin_amdgcn_permlane32_swap(__float_as_uint(mx), __float_as_uint(mx), false, false); mx = max3_(s1[15], __uint_as_float(rr[0]), __uint_as_float(rr[1])); }
    if constexpr (ROW) {
        const bool up = (mx - mref > D8_THR);
        if (__any(up)) {
            const float alpha = up ? fast_exp2((mref - mx) * D8_C) : 1.0f;
            if (up) mref = mx;
            lrun *= alpha;
            asm volatile("s_nop 15\n\ts_nop 15" ::: "memory");
#pragma unroll
            for (int dt = 0; dt < 4; ++dt)
#pragma unroll
                for (int i = 0; i < 16; ++i) o[dt][i] *= alpha;
        }
    } else
    if (first || __any(mx - mref > D8_THR)) {
        const float mn = first ? mx : fmaxf(mref, mx);
        const float alpha = first ? 0.f : fast_exp2((mref - mn) * D8_C);
        mref = mn; lrun *= alpha;
        asm volatile("s_nop 15\n\ts_nop 15" ::: "memory");
#pragma unroll
        for (int dt = 0; dt < 4; ++dt)
#pragma unroll
            for (int i = 0; i < 16; ++i) o[dt][i] *= alpha;
    }
    const float off = D8_SH - mref * D8_C;
    float sum0 = 0.f, sum1 = 0.f;
    i32x8 P;
    const f32x2 c2 = {D8_C, D8_C}, off2 = {off, off};
    f32x2 sum2 = {0.f, 0.f};
#pragma unroll
    for (int g = 0; g < 4; ++g) {
        const f32x2 a0 = __builtin_elementwise_fma((f32x2){s0[4 * g], s0[4 * g + 1]}, c2, off2), a1 = __builtin_elementwise_fma((f32x2){s0[4 * g + 2], s0[4 * g + 3]}, c2, off2);
        const f32x2 b0 = __builtin_elementwise_fma((f32x2){s1[4 * g], s1[4 * g + 1]}, c2, off2), b1 = __builtin_elementwise_fma((f32x2){s1[4 * g + 2], s1[4 * g + 3]}, c2, off2);
        const f32x2 e0 = {fast_exp2(a0[0]), fast_exp2(a0[1])}, e1 = {fast_exp2(a1[0]), fast_exp2(a1[1])}, f0 = {fast_exp2(b0[0]), fast_exp2(b0[1])}, f1 = {fast_exp2(b1[0]), fast_exp2(b1[1])};
        sum2 += (e0 + e1) + (f0 + f1);
        int w0 = __builtin_amdgcn_cvt_pk_fp8_f32(e0[0], e0[1], 0, false); w0 = __builtin_amdgcn_cvt_pk_fp8_f32(e1[0], e1[1], w0, true);
        int w1 = __builtin_amdgcn_cvt_pk_fp8_f32(f0[0], f0[1], 0, false); w1 = __builtin_amdgcn_cvt_pk_fp8_f32(f1[0], f1[1], w1, true);
        P[g] = w0; P[4 + g] = w1; }
    sum0 = sum2[0]; sum1 = sum2[1];
    lrun += sum0 + sum1;
    return P;
}
__device__ __forceinline__ void d8_pv(f32x16 (&o)[4], const i32x8 (&va)[2], const i32x8& P, const LAS unsigned char* vb, int r, int hh) {
    i32x8 vg[2];
    d8_load_vf2<2>(vg, vb, r, hh);
    asm volatile("s_waitcnt lgkmcnt(4)" ::: "memory"); SBAR();
    __builtin_amdgcn_s_setprio(1);
#pragma unroll
    for (int dt = 0; dt < 2; ++dt) asm volatile("v_mfma_scale_f32_32x32x64_f8f6f4 %0, %1, %2, %0, %3, %3 op_sel_hi:[0,0,0]" : "+v"(o[dt]) : "v"(va[dt]), "v"(P), "v"(0x7F7F7F7F));
    asm volatile("s_waitcnt lgkmcnt(0)" ::: "memory"); SBAR();
#pragma unroll
    for (int dt = 0; dt < 2; ++dt) asm volatile("v_mfma_scale_f32_32x32x64_f8f6f4 %0, %1, %2, %0, %3, %3 op_sel_hi:[0,0,0]" : "+v"(o[2 + dt]) : "v"(vg[dt]), "v"(P), "v"(0x7F7F7F7F));
    __builtin_amdgcn_s_setprio(0);
}
__device__ __forceinline__ void diff_unit8(LAS unsigned char* lds, int b, int h, int qt, const unsigned char* QD, const unsigned char* KDT, const unsigned char* VDT, bf16_t* AD, const float* subln, const float* rel_bias) {
    int tid_ = threadIdx.x; asm volatile("" : "+v"(tid_));
    const int tid = tid_, lane = tid & 63, r = lane & 31, hh = lane >> 5; const int wid = __builtin_amdgcn_readfirstlane(tid >> 6);
    const int map = wid >> 2, qsub = wid & 3;
    const int q0 = qt * 128, qw0 = q0 + 32 * qsub, qpos = qw0 + r;
    const size_t tok0 = (size_t)b * SEQ;
    const LAS float* btab = (const LAS float*)(lds + D_OFF_TAB);
    const LAS float* gtab = (const LAS float*)(lds + D_OFF_G);
    const int kcolb = map * 64;
    i32x8 qf;
    { const unsigned char* qp = QD + (tok0 + qpos) * 1024 + h * 128 + map * 64 + 32 * hh; qf = cat8(*(const i32x4*)qp, *(const i32x4*)(qp + 16)); }
    f32x16 o[4];
#pragma unroll
    for (int dt = 0; dt < 4; ++dt)
#pragma unroll
        for (int i = 0; i < 16; ++i) o[dt][i] = 0.f;
    float mrun = 0.f, lrun = 0.f;
    const unsigned char* kbase = KDT + ((size_t)h * 256 + b * 128) * 8192;
    const unsigned char* vbase = VDT + ((size_t)h * 256 + b * 128) * 8192;
    const int NT = 2 * (qt + 1);
    TileRegs8 R;
    __syncthreads();
    if (tid < 128) { const int n = tid; ((LAS float*)(lds + D_OFF_TAB))[n] = (rel_bias[t5_bucket(n) * 16 + h] - rel_bias[31 * 16 + h]) * (LOG2E * 64.0f); ((LAS float*)(lds + D_OFF_G))[n] = subln[n]; }
    tile_load8(R, kbase, vbase, tid); tile_store8(R, lds, lds + KBUF8, tid);
    tile_load8(R, kbase + 8192, vbase + 8192, tid); tile_store8(R, lds + TBUF8, lds + TBUF8 + KBUF8, tid);
    if (NT > 2) tile_load8(R, kbase + 2 * 8192, vbase + 2 * 8192, tid);
    __syncthreads();
    i32x8 kf[2], vf[2];
    d8_load_kf(kf, lds, r, hh, kcolb);
#define D8_STAGE(t) do { if ((t) + 2 < NT) tile_store8(R, lds + (((t) + 2) & 3) * TBUF8, lds + (((t) + 2) & 3) * TBUF8 + KBUF8, tid); \
        if ((t) + 3 < NT) tile_load8(R, kbase + (size_t)((t) + 3) * 8192, vbase + (size_t)((t) + 3) * 8192, tid); \
        __syncthreads(); } while (0)
#pragma unroll 1
    for (int t = 0; t < NT; ++t) {
        const int k0 = 64 * t; const LAS unsigned char* tb = lds + (t & 3) * TBUF8;
        f32x16 s0, s1; d8_scores(s0, s1, kf, qf);
        d8_load_vf2<0>(vf, tb + KBUF8, r, hh); d8_load_kf(kf, lds + ((t + 1) & 3) * TBUF8, r, hh, kcolb); SBAR();
        const i32x8 P = d8_softmax(s0, s1, o, mrun, lrun, qpos, k0, (k0 + 63 > qw0), (qw0 - (k0 + 63) < 113), t == 0, btab, hh);
        if (wid >= 4) D8_STAGE(t);
        d8_pv(o, vf, P, tb + KBUF8, r, hh);
        if (wid < 4) D8_STAGE(t);
    }
#undef D8_STAGE
    __syncthreads();
    asm volatile("s_nop 15\n\ts_nop 15\n\ts_nop 15\n\ts_nop 15" ::: "memory");
    const float l = (lrun + __shfl_xor(lrun, 32)) * D8_VS;
    LAS float* xch = (LAS float*)lds + qsub * 4096 + lane;
    if (map == 1) {
        const float lam = *(const LAS float*)(lds + MISC_OFF + 68);
        const float f = lam / l;
#pragma unroll
        for (int dt = 0; dt < 4; ++dt)
#pragma unroll
            for (int i = 0; i < 16; ++i) xch[(dt * 16 + i) * 64] = o[dt][i] * f;
    }
    __syncthreads();
    if (map == 0) {
        const float i0 = 1.0f / l;
        float ss = 0.f;
#pragma unroll
        for (int dt = 0; dt < 4; ++dt)
#pragma unroll
            for (int i = 0; i < 16; ++i) { const float v = o[dt][i] * i0 - xch[(dt * 16 + i) * 64]; o[dt][i] = v; ss += v * v; }
        ss += __shfl_xor(ss, 32);
        const float rs = 0.8f / sqrtf(ss * (1.0f / 128.0f) + RMS_EPS);
        bf16_t* orow = AD + (tok0 + qpos) * 1024 + h * 128;
#pragma unroll
        for (int dt = 0; dt < 4; ++dt)
#pragma unroll
            for (int g = 0; g < 4; ++g) { const int d = 32 * dt + 8 * g + 4 * hh;
                const f32x4 gg = *(const LAS f32x4*)(gtab + d);
                if constexpr (O78F8) { const float r8 = rs * F8_SAD;
                    *(unsigned*)((unsigned char*)AD + (tok0 + qpos) * 1024 + h * 128 + d) = epi::pack4_f8(o[dt][4 * g + 0] * r8 * gg[0], o[dt][4 * g + 1] * r8 * gg[1], o[dt][4 * g + 2] * r8 * gg[2], o[dt][4 * g + 3] * r8 * gg[3]); }
                else { u32x2 w; w.x = cvtpk(o[dt][4 * g + 0] * rs * gg[0], o[dt][4 * g + 1] * rs * gg[1]); w.y = cvtpk(o[dt][4 * g + 2] * rs * gg[2], o[dt][4 * g + 3] * rs * gg[3]);
                *(u32x2*)(orow + d) = w; } }
    }
}

__device__ __forceinline__ void moba_unit(LAS unsigned char* lds, int b, int h, int n, const int* list, int cnt, const bf16_t* QM, const bf16_t* KMT, const bf16_t* VMT, bf16_t* PARTS, float* ML, const float* rel_bias) {
    int tid_ = threadIdx.x; asm volatile("" : "+v"(tid_));
    const int tid = tid_, lane = tid & 63, r = lane & 31, hh = lane >> 5; const int wid = __builtin_amdgcn_readfirstlane(tid >> 6);
    const size_t tok0 = (size_t)b * SEQ;
    const LAS float* btab = (const LAS float*)(lds + OFF_TAB);
    const float sc = 0.08838834764831845f * LOG2E;
    const bool own = (list == nullptr);
    const int li = 32 * wid + r;
    const bool lane_valid = li < cnt;
    int qpos, slot;
    if (own) { qpos = 256 * n + li; slot = 3; }
    else { const int e = list[lane_valid ? li : 0]; qpos = e >> 2; slot = e & 3; }
    const bool wave_active = (32 * wid < cnt);
    bf16x8 qf[1][8];
#pragma unroll
    for (int ks = 0; ks < 8; ++ks) qf[0][ks] = *(const bf16x8*)(QM + (tok0 + qpos) * 1024 + h * 128 + 16 * ks + 8 * hh);
    f32x16 O[1][4];
#pragma unroll
    for (int dt = 0; dt < 4; ++dt)
#pragma unroll
        for (int i = 0; i < 16; ++i) O[0][dt][i] = 0.f;
    float mrun[1] = {-INFINITY}, lrun[1] = {0.f};
    const bf16_t* kbase = KMT + ((size_t)h * 256 + b * 128 + 4 * n) * 8192;
    const bf16_t* vbase = VMT + ((size_t)h * 256 + b * 128 + 4 * n) * 8192;
    const int qw0 = 256 * n + 32 * wid;
    TileRegs R;
    __syncthreads();
    fill_bias_tab((LAS float*)(lds + OFF_TAB), rel_bias, 8 + h);
    tile_load(R, kbase, vbase, tid);
    tile_store(R, lds + OFF_K, lds + OFF_V, tid);
    __syncthreads();
#pragma unroll 1
    for (int t = 0; t < 4; ++t) {
        const int cur = t & 1;
        if (t + 1 < 4) tile_load(R, kbase + (size_t)(t + 1) * 8192, vbase + (size_t)(t + 1) * 8192, tid);
        if (wave_active) {
#pragma unroll 1
            for (int kh = 0; kh < 2; ++kh) {
                const int kp = 256 * n + 64 * t + 32 * kh;
                bool run = true, need_mask = false, need_bias;
                if (own) { run = (kp <= qw0 + 31); need_mask = (kp + 31 > qw0); need_bias = true; }
                else { need_bias = __any(qpos - (kp + 31) < 113); }
                if (run) attn_half<1, 8>(lds + OFF_K + cur * KBUF, lds + OFF_V + cur * VBUF, kh, qf, O, mrun, lrun, qpos, kp, need_mask, need_bias, btab, sc, r, hh, 0);
            }
        }
        if (t + 1 < 4) tile_store(R, lds + OFF_K + (cur ^ 1) * KBUF, lds + OFF_V + (cur ^ 1) * VBUF, tid);
        __syncthreads();
    }
    const float l = lrun[0] + __shfl_xor(lrun[0], 32);
    const float il = 1.0f / l;
    if (lane_valid) {
        const size_t pidx = ((tok0 + qpos) * 8 + h) * 4 + slot;
        bf16_t* orow = PARTS + pidx * 128;
#pragma unroll
        for (int dt = 0; dt < 4; ++dt)
#pragma unroll
            for (int g = 0; g < 4; ++g) { const int d = 32 * dt + 8 * g + 4 * hh;
                u32x2 w; w.x = cvtpk(O[0][dt][4 * g + 0] * il, O[0][dt][4 * g + 1] * il); w.y = cvtpk(O[0][dt][4 * g + 2] * il, O[0][dt][4 * g + 3] * il);
                *(u32x2*)(orow + d) = w; }
        if (hh == 0) *(f32x2*)(ML + pidx * 2) = (f32x2){mrun[0], l};
    }
}
constexpr int MB_K = 0, MB_V = 4 * KBUF, MB_INC = MB_V + 4 * VBUF, MB_TAB = MB_INC + 2048, MB_END = MB_TAB + 512;
static_assert(MB_END <= MISC_OFF, "MoBA block LDS");
__device__ __forceinline__ void moba_block(LAS unsigned char* lds, int b, int h, int n, const int* list, int cntl, int c0, int c1, const bf16_t* QM, const bf16_t* KMT, const bf16_t* VMT, bf16_t* PARTS, float* ML, const float* rel_bias) {
    int tid_ = threadIdx.x; asm volatile("" : "+v"(tid_));
    const int tid = tid_, lane = tid & 63, r = lane & 31, hh = lane >> 5; const int wid = __builtin_amdgcn_readfirstlane(tid >> 6);
    const size_t tok0 = (size_t)b * SEQ;
    const LAS float* btab = (const LAS float*)(lds + MB_TAB);
    const float sc = 0.08838834764831845f * LOG2E;
    const bf16_t* kbase = KMT + ((size_t)h * 256 + b * 128 + 4 * n) * 8192;
    const bf16_t* vbase = VMT + ((size_t)h * 256 + b * 128 + 4 * n) * 8192;
    __syncthreads();
    fill_bias_tab((LAS float*)(lds + MB_TAB), rel_bias, 8 + h);
    const int li = 32 * wid + r;
    const int cA = c0, cB = c0 + 1;
    const bool ownA = (cA == 0);
    const int cntA = ownA ? 256 : ((cntl - 256 * (cA - 1)) < 256 ? (cntl - 256 * (cA - 1)) : 256);
    const int cntB = (cB < c1) ? ((cntl - 256 * (cB - 1)) < 256 ? (cntl - 256 * (cB - 1)) : 256) : 0;
    const bool hasA = (32 * wid < cntA), hasB = (32 * wid < cntB);
    const bool lvA = li < cntA, lvB = li < cntB;
    int eA = 0, eB = 0;
    if (hasA && !ownA) eA = list[256 * (cA - 1) + (lvA ? li : 0)];
    if (hasB) eB = list[256 * (cB - 1) + (lvB ? li : 0)];
    TileRegs R, R2;
    tile_load(R, kbase, vbase, tid); tile_load(R2, kbase + 8192, vbase + 8192, tid);
    tile_store(R, lds + MB_K, lds + MB_V, tid); tile_load(R, kbase + 2 * 8192, vbase + 2 * 8192, tid);
    const int qposA = ownA ? 256 * n + li : (eA >> 2), slotA = ownA ? 3 : (eA & 3);
    const int qposB = eB >> 2, slotB = eB & 3;
    bf16x8 qfA[1][8], qfB[1][8];
    if (hasA) {
#pragma unroll
        for (int ks = 0; ks < 8; ++ks) qfA[0][ks] = *(const bf16x8*)(QM + (tok0 + qposA) * 1024 + h * 128 + 16 * ks + 8 * hh);
    }
    if (hasB) {
#pragma unroll
        for (int ks = 0; ks < 8; ++ks) qfB[0][ks] = *(const bf16x8*)(QM + (tok0 + qposB) * 1024 + h * 128 + 16 * ks + 8 * hh);
    }
    tile_store(R2, lds + MB_K + KBUF, lds + MB_V + VBUF, tid); tile_load(R2, kbase + 3 * 8192, vbase + 3 * 8192, tid);
    tile_store(R, lds + MB_K + 2 * KBUF, lds + MB_V + 2 * VBUF, tid);
    tile_store(R2, lds + MB_K + 3 * KBUF, lds + MB_V + 3 * VBUF, tid);
    __syncthreads();
#define MB_CHUNK(HAS, OWN, QF, QPOS, SLOT, LV) do { if (HAS) { \
        f32x16 O[1][4]; \
        _Pragma("unroll") for (int dt = 0; dt < 4; ++dt) _Pragma("unroll") for (int i = 0; i < 16; ++i) O[0][dt][i] = 0.f; \
        float mrun[1] = {-INFINITY}, lrun[1] = {0.f}; \
        const int qw0 = 256 * n + 32 * wid; \
        _Pragma("unroll 1") for (int t8 = 0; t8 < 8; ++t8) { \
            const int t = t8 >> 1, kh = t8 & 1; const int kp = 256 * n + 32 * t8; \
            bool run = true, need_mask = false, need_bias; \
            if (OWN) { run = (kp <= qw0 + 31); need_mask = (kp + 31 > qw0); need_bias = true; } \
            else { need_bias = __any((QPOS) - (kp + 31) < 113); } \
            if (run) attn_half<1, 8>(lds + MB_K + t * KBUF, lds + MB_V + t * VBUF, kh, QF, O, mrun, lrun, QPOS, kp, need_mask, need_bias, btab, sc, r, hh, 0); \
        } \
        const float l = lrun[0] + __shfl_xor(lrun[0], 32); const float il = 1.0f / l; \
        if (LV) { const size_t pidx = ((tok0 + (QPOS)) * 8 + h) * 4 + (SLOT); bf16_t* orow = PARTS + pidx * 128; \
            _Pragma("unroll") for (int dt = 0; dt < 4; ++dt) _Pragma("unroll") for (int g = 0; g < 4; ++g) { const int d = 32 * dt + 8 * g + 4 * hh; \
                u32x2 w; w.x = cvtpk(O[0][dt][4 * g + 0] * il, O[0][dt][4 * g + 1] * il); w.y = cvtpk(O[0][dt][4 * g + 2] * il, O[0][dt][4 * g + 3] * il); \
                *(u32x2*)(orow + d) = w; } \
            if (hh == 0) *(f32x2*)(ML + pidx * 2) = (f32x2){mrun[0], l}; } } } while (0)
    MB_CHUNK(hasA, ownA, qfA, qposA, slotA, lvA);
    MB_CHUNK(hasB, false, qfB, qposB, slotB, lvB);
#undef MB_CHUNK
}
constexpr int MB8_TAB = 4 * TBUF8;
static_assert(MB8_TAB + 512 <= MB_INC, "fp8 MoBA block LDS");
__device__ __forceinline__ void moba_block8(LAS unsigned char* lds, int b, int h, int n, const int* list, int cntl, int c0, int c1, const unsigned char* QM8, const unsigned char* KMT8, const unsigned char* VMT8, bf16_t* PARTS, float* ML, const float* rel_bias) {
    int tid_ = threadIdx.x; asm volatile("" : "+v"(tid_));
    const int tid = tid_, lane = tid & 63, r = lane & 31, hh = lane >> 5; const int wid = __builtin_amdgcn_readfirstlane(tid >> 6);
    const size_t tok0 = (size_t)b * SEQ;
    const LAS float* btab = (const LAS float*)(lds + MB8_TAB);
    const unsigned char* kbase = KMT8 + ((size_t)h * 256 + b * 128 + 4 * n) * 8192;
    const unsigned char* vbase = VMT8 + ((size_t)h * 256 + b * 128 + 4 * n) * 8192;
    __syncthreads();
    if (tid < 128) { const int q = tid; ((LAS float*)(lds + MB8_TAB))[q] = (rel_bias[t5_bucket(q) * 16 + 8 + h] - rel_bias[31 * 16 + 8 + h]) * (LOG2E * 64.0f); }
    const int li = 32 * wid + r;
    const int cA = c0, cB = c0 + 1;
    const bool ownA = (cA == 0);
    const int cntA = ownA ? 256 : ((cntl - 256 * (cA - 1)) < 256 ? (cntl - 256 * (cA - 1)) : 256);
    const int cntB = (cB < c1) ? ((cntl - 256 * (cB - 1)) < 256 ? (cntl - 256 * (cB - 1)) : 256) : 0;
    const bool hasA = (32 * wid < cntA), hasB = (32 * wid < cntB);
    const bool lvA = li < cntA, lvB = li < cntB;
    int eA = 0, eB = 0;
    if (hasA && !ownA) eA = list[256 * (cA - 1) + (lvA ? li : 0)];
    if (hasB) eB = list[256 * (cB - 1) + (lvB ? li : 0)];
    TileRegs8 R0, R1, R2, R3;
    tile_load8(R0, kbase, vbase, tid); tile_load8(R1, kbase + 8192, vbase + 8192, tid); tile_load8(R2, kbase + 2 * 8192, vbase + 2 * 8192, tid); tile_load8(R3, kbase + 3 * 8192, vbase + 3 * 8192, tid);
    SBAR();
    tile_store8(R0, lds, lds + KBUF8, tid);
    const int qposA = ownA ? 256 * n + li : (eA >> 2), slotA = ownA ? 3 : (eA & 3);
    const int qposB = eB >> 2, slotB = eB & 3;
    i32x8 qf[2];
    if (hasA) { const unsigned char* qp = QM8 + (tok0 + qposA) * 1024 + h * 128 + 32 * hh; qf[0] = cat8(*(const i32x4*)qp, *(const i32x4*)(qp + 16)); qf[1] = cat8(*(const i32x4*)(qp + 64), *(const i32x4*)(qp + 80)); }
    tile_store8(R1, lds + TBUF8, lds + TBUF8 + KBUF8, tid);
    tile_store8(R2, lds + 2 * TBUF8, lds + 2 * TBUF8 + KBUF8, tid);
    tile_store8(R3, lds + 3 * TBUF8, lds + 3 * TBUF8 + KBUF8, tid);
    __syncthreads();
#define MB8_LOADQB() do { if (hasB) { const unsigned char* qp = QM8 + (tok0 + qposB) * 1024 + h * 128 + 32 * hh; qf[0] = cat8(*(const i32x4*)qp, *(const i32x4*)(qp + 16)); qf[1] = cat8(*(const i32x4*)(qp + 64), *(const i32x4*)(qp + 80)); } } while (0)
#define MB8_CHUNK(HAS, OWN, QPOS, SLOT, LV, NEXTQ) do { if (HAS) { \
        f32x16 o[4]; \
        _Pragma("unroll") for (int dt = 0; dt < 4; ++dt) _Pragma("unroll") for (int i = 0; i < 16; ++i) o[dt][i] = 0.f; \
        float mref = -INFINITY, lrun = 0.f; \
        const int qw0 = 256 * n + 32 * wid; \
        _Pragma("unroll 1") for (int t = 0; t < 4; ++t) { \
            const int kp = 256 * n + 64 * t; const LAS unsigned char* tb = lds + t * TBUF8; \
            bool run = true, need_mask = false, need_bias; \
            if (OWN) { run = (kp <= qw0 + 31); need_mask = (kp + 63 > qw0); need_bias = (qw0 - (kp + 63) < 113); } \
            else { need_bias = __any((QPOS) - (kp + 63) < 113); } \
            if (run) { \
                i32x8 ka[2], kc[2], vf[2]; \
                d8_load_kf(ka, tb, r, hh, 0); d8_load_kf(kc, tb, r, hh, 64); \
                f32x16 s0, s1; d8_scores(s0, s1, ka, qf[0]); \
                __builtin_amdgcn_s_setprio(1); \
                s0 = __builtin_amdgcn_mfma_scale_f32_32x32x64_f8f6f4(kc[0], qf[1], s0, 0, 0, 0, 0x7F7F7F7F, 0, 0x7F7F7F7F); \
                s1 = __builtin_amdgcn_mfma_scale_f32_32x32x64_f8f6f4(kc[1], qf[1], s1, 0, 0, 0, 0x7F7F7F7F, 0, 0x7F7F7F7F); \
                __builtin_amdgcn_s_setprio(0); \
                d8_load_vf2<0>(vf, tb + KBUF8, r, hh); SBAR(); \
                const i32x8 P = d8_softmax<true>(s0, s1, o, mref, lrun, QPOS, kp, need_mask, need_bias, false, btab, hh); \
                d8_pv(o, vf, P, tb + KBUF8, r, hh); \
            } \
        } \
        NEXTQ; \
        asm volatile("s_nop 15\n\ts_nop 15\n\ts_nop 15\n\ts_nop 15" ::: "memory");        \
        const float l = lrun + __shfl_xor(lrun, 32); const float il = 1.0f / (l * D8_VS); \
        if (LV) { const size_t pidx = ((tok0 + (QPOS)) * 8 + h) * 4 + (SLOT); bf16_t* orow = PARTS + pidx * 128; \
            _Pragma("unroll") for (int dt = 0; dt < 4; ++dt) _Pragma("unroll") for (int g = 0; g < 4; ++g) { const int d = 32 * dt + 8 * g + 4 * hh; \
                u32x2 w; w.x = cvtpk(o[dt][4 * g + 0] * il, o[dt][4 * g + 1] * il); w.y = cvtpk(o[dt][4 * g + 2] * il, o[dt][4 * g + 3] * il); \
                *(u32x2*)(orow + d) = w; } \
            if (hh == 0) *(f32x2*)(ML + pidx * 2) = (f32x2){mref * D8_C - D8_SH, l}; } } else { NEXTQ; } } while (0)
    MB8_CHUNK(hasA, ownA, qposA, slotA, lvA, MB8_LOADQB());
    MB8_CHUNK(hasB, false, qposB, slotB, lvB, (void)0);
#undef MB8_CHUNK
#undef MB8_LOADQB
}
}

struct Ctx {
    LAS unsigned char* lds;
    unsigned char* ws; unsigned* ctl;
    const float* const* in; float* out;
    int tid, lane, wave, G, blk;
};
enum { I_X = 0, I_C, I_WADA, I_BADA, I_GMIX, I_GFFN, I_WIN, I_LAMBDA, I_SUBLN, I_RELB, I_WOD, I_WOM, I_WOUT, I_WROUTER, I_RBIAS, I_WEG, I_WEU, I_WED, I_WSG, I_WSU, I_WSD, I_GFINAL };

constexpr int TR_SCR = 64 * 65 * 4 + 128;
static_assert(8 * TR_SCR <= RING_BYTES + 16384, "transpose scratch");
template <bool NT>
__device__ __forceinline__ void transpose_item(const float* __restrict__ W, int K, int N, bf16_t* __restrict__ WT, int drow0, int k0, int n0, LAS float* scr, int lane) {
    const int nq = lane & 15, kr = lane >> 4;
    f32x4 v[16];
#pragma unroll
    for (int i = 0; i < 16; ++i) { const f32x4* p = (const f32x4*)(W + (size_t)(k0 + 4 * i + kr) * N + n0 + 4 * nq); v[i] = NT ? __builtin_nontemporal_load(p) : *p; }
#pragma unroll
    for (int i = 0; i < 16; ++i) { LAS float* d = scr + (4 * i + kr) * 65 + 4 * nq; d[0] = v[i][0]; d[1] = v[i][1]; d[2] = v[i][2]; d[3] = v[i][3]; }
    LDS_WAIT(); asm volatile("" ::: "memory");
    const int c = lane & 7;
#pragma unroll
    for (int j = 0; j < 8; ++j) { const int n = (lane >> 3) + 8 * j; const LAS float* s = scr + (8 * c) * 65 + n;
        u32x4 o; o.x = cvtpk(s[0 * 65], s[1 * 65]); o.y = cvtpk(s[2 * 65], s[3 * 65]); o.z = cvtpk(s[4 * 65], s[5 * 65]); o.w = cvtpk(s[6 * 65], s[7 * 65]);
        u32x4* q = (u32x4*)(WT + (size_t)(drow0 + n) * K + k0 + 8 * c); if (NT) __builtin_nontemporal_store(o, q); else *q = o; }
    LDS_WAIT(); asm volatile("" ::: "memory");
}
template <bool NT>
__device__ __forceinline__ void transpose_item_f8(const float* __restrict__ W, int K, int N, unsigned char* __restrict__ WT, int drow0, int k0, int n0, LAS float* scr, int lane, float scale) {
    const int nq = lane & 15, kr = lane >> 4;
    f32x4 v[16];
#pragma unroll
    for (int i = 0; i < 16; ++i) { const f32x4* p = (const f32x4*)(W + (size_t)(k0 + 4 * i + kr) * N + n0 + 4 * nq); v[i] = NT ? __builtin_nontemporal_load(p) : *p; }
#pragma unroll
    for (int i = 0; i < 16; ++i) { LAS float* d = scr + (4 * i + kr) * 65 + 4 * nq; d[0] = v[i][0] * scale; d[1] = v[i][1] * scale; d[2] = v[i][2] * scale; d[3] = v[i][3] * scale; }
    LDS_WAIT(); asm volatile("" ::: "memory");
    const int c = lane & 7;
#pragma unroll
    for (int j = 0; j < 8; ++j) { const int n = (lane >> 3) + 8 * j; const LAS float* s = scr + (8 * c) * 65 + n;
        const u32x2 o = {epi::pack4_f8(s[0 * 65], s[1 * 65], s[2 * 65], s[3 * 65]), epi::pack4_f8(s[4 * 65], s[5 * 65], s[6 * 65], s[7 * 65])};
        u32x2* q = (u32x2*)(WT + (size_t)(drow0 + n) * K + k0 + 8 * c); if (NT) __builtin_nontemporal_store(o, q); else *q = o; }
    LDS_WAIT(); asm volatile("" ::: "memory");
}
struct CvItemF8 { const float* W; unsigned char* WT; int K, N, drow0, k0, n0; float scale; };
__device__ __forceinline__ void transpose_pair_f8(const CvItemF8& A, const CvItemF8& B, LAS float* scr, int lane) {
    const int nq = lane & 15, kr = lane >> 4, c = lane & 7;
    f32x4 va[16], vb[16];
#pragma unroll
    for (int i = 0; i < 16; ++i) va[i] = __builtin_nontemporal_load((const f32x4*)(A.W + (size_t)(A.k0 + 4 * i + kr) * A.N + A.n0 + 4 * nq));
#pragma unroll
    for (int i = 0; i < 16; ++i) vb[i] = __builtin_nontemporal_load((const f32x4*)(B.W + (size_t)(B.k0 + 4 * i + kr) * B.N + B.n0 + 4 * nq));
    __builtin_amdgcn_sched_barrier(0);
#pragma unroll
    for (int i = 0; i < 16; ++i) { LAS float* d = scr + (4 * i + kr) * 65 + 4 * nq; d[0] = va[i][0] * A.scale; d[1] = va[i][1] * A.scale; d[2] = va[i][2] * A.scale; d[3] = va[i][3] * A.scale; }
    LDS_WAIT(); asm volatile("" ::: "memory");
#pragma unroll
    for (int j = 0; j < 8; ++j) { const int n = (lane >> 3) + 8 * j; const LAS float* s = scr + (8 * c) * 65 + n;
        const u32x2 o = {epi::pack4_f8(s[0 * 65], s[1 * 65], s[2 * 65], s[3 * 65]), epi::pack4_f8(s[4 * 65], s[5 * 65], s[6 * 65], s[7 * 65])};
        __builtin_nontemporal_store(o, (u32x2*)(A.WT + (size_t)(A.drow0 + n) * A.K + A.k0 + 8 * c)); }
    LDS_WAIT(); asm volatile("" ::: "memory");
#pragma unroll
    for (int i = 0; i < 16; ++i) { LAS float* d = scr + (4 * i + kr) * 65 + 4 * nq; d[0] = vb[i][0] * B.scale; d[1] = vb[i][1] * B.scale; d[2] = vb[i][2] * B.scale; d[3] = vb[i][3] * B.scale; }
    LDS_WAIT(); asm volatile("" ::: "memory");
#pragma unroll
    for (int j = 0; j < 8; ++j) { const int n = (lane >> 3) + 8 * j; const LAS float* s = scr + (8 * c) * 65 + n;
        const u32x2 o = {epi::pack4_f8(s[0 * 65], s[1 * 65], s[2 * 65], s[3 * 65]), epi::pack4_f8(s[4 * 65], s[5 * 65], s[6 * 65], s[7 * 65])};
        __builtin_nontemporal_store(o, (u32x2*)(B.WT + (size_t)(B.drow0 + n) * B.K + B.k0 + 8 * c)); }
    LDS_WAIT(); asm volatile("" ::: "memory");
}
__device__ __forceinline__ int gu_row(int n0, int up) { return 256 * (n0 >> 7) + 128 * up + (n0 & 127); }

__device__ __forceinline__ int win_row(int n) { return n < 2048 ? n : (n < 3072 ? 8192 + (n - 2048) : (n < 5120 ? 2048 + (n - 3072) : (n < 6144 ? 9216 + (n - 5120) : 4096 + (n - 6144)))); }
__device__ __forceinline__ void p0_prologue(Ctx& F) {
    const int gw = F.blk * 8 + F.wave, NGW = F.G * 8;
    unsigned char* ws = F.ws;
    {
        const float* wada = F.in[I_WADA]; const float* c = F.in[I_C]; float* modp = (float*)(ws + WS_MODP);
        for (int it = gw; it < 48 * 32; it += NGW) {
            const int cc = it % 48, ks = it / 48, col = 256 * cc + 4 * F.lane;
            f32x4 a0 = {0.f, 0.f, 0.f, 0.f}, a1 = {0.f, 0.f, 0.f, 0.f};
#pragma unroll 8
            for (int k = 64 * ks; k < 64 * ks + 64; ++k) {
                const f32x4 w = *(const f32x4*)(wada + (size_t)k * 12288 + col);
                const float c0 = c[k], c1 = c[2048 + k];
                a0 += w * siluf_(c0); a1 += w * siluf_(c1);
            }
            *(f32x4*)(modp + ((size_t)ks * 2 + 0) * 12288 + col) = a0;
            *(f32x4*)(modp + ((size_t)ks * 2 + 1) * 12288 + col) = a1;
        }
    }
    {
        LAS float* scr = (LAS float*)(F.lds + F.wave * TR_SCR);
        constexpr int I0 = 5120, I1 = I0 + 512, I2 = I1 + 512, I3 = I2 + 1024, I4 = I3 + 256, I5 = I4 + 256, I6 = I5 + 256;
        for (int it = gw; it < I6; it += NGW) {
            if (it < I0) { const int r = it, kb = r / 160, nb = r % 160; if constexpr (P2F8) transpose_item_f8<false>(F.in[I_WIN], 2048, 10240, ws + WS_W_IN_T, win_row(64 * nb), 64 * kb, 64 * nb, scr, F.lane, F8_SW); else transpose_item<false>(F.in[I_WIN], 2048, 10240, (bf16_t*)(ws + WS_W_IN_T), win_row(64 * nb), 64 * kb, 64 * nb, scr, F.lane); }
            else if (it < I1) { const int r = it - I0, kb = r / 32, nb = r % 32; if constexpr (O78F8) transpose_item_f8<false>(F.in[I_WOD], 1024, 2048, ws + WS_W_OD_T, 64 * nb, 64 * kb, 64 * nb, scr, F.lane, F8_SWO); else transpose_item<false>(F.in[I_WOD], 1024, 2048, (bf16_t*)(ws + WS_W_OD_T), 64 * nb, 64 * kb, 64 * nb, scr, F.lane); }
            else if (it < I2) { const int r = it - I1, kb = r / 32, nb = r % 32; if constexpr (O78F8) transpose_item_f8<false>(F.in[I_WOM], 1024, 2048, ws + WS_W_OM_T, 64 * nb, 64 * kb, 64 * nb, scr, F.lane, F8_SWO); else transpose_item<false>(F.in[I_WOM], 1024, 2048, (bf16_t*)(ws + WS_W_OM_T), 64 * nb, 64 * kb, 64 * nb, scr, F.lane); }
            else if (it < I3) { const int r = it - I2, kb = r / 32, nb = r % 32; if constexpr (O78F8) transpose_item_f8<false>(F.in[I_WOUT], 2048, 2048, ws + WS_W_OUT_T, 64 * nb, 64 * kb, 64 * nb, scr, F.lane, F8_SWOUT); else transpose_item<false>(F.in[I_WOUT], 2048, 2048, (bf16_t*)(ws + WS_W_OUT_T), 64 * nb, 64 * kb, 64 * nb, scr, F.lane); }
            else if (it < I4) { const int r = it - I3, kb = r / 8, nb = r % 8; transpose_item_f8<false>(F.in[I_WSG], 2048, 512, ws + WS_W_SHGU_T, gu_row(64 * nb, 0), 64 * kb, 64 * nb, scr, F.lane, F8_SW); }
            else if (it < I5) { const int r = it - I4, kb = r / 8, nb = r % 8; transpose_item_f8<false>(F.in[I_WSU], 2048, 512, ws + WS_W_SHGU_T, gu_row(64 * nb, 1), 64 * kb, 64 * nb, scr, F.lane, F8_SW); }
            else { const int r = it - I5, kb = r / 32, nb = r % 32; transpose_item_f8<false>(F.in[I_WSD], 512, 2048, ws + WS_W_SHD_T, 64 * nb, 64 * kb, 64 * nb, scr, F.lane, F8_SD); }
        }
    }
    {
        const float* wr = F.in[I_WROUTER]; bf16_t* hi = (bf16_t*)(ws + WS_WR); bf16_t* lo = hi + 64 * 2048;
        for (int idx = F.blk * 512 + F.tid; idx < 2048 * 64; idx += F.G * 512) {
            const int k = idx >> 6, e = idx & 63; const float w = wr[idx];
            const unsigned h16 = cvtpk(w, 0.f) & 0xffffu; const float res = w - __uint_as_float(h16 << 16);
            hi[e * 2048 + k] = (bf16_t)h16; lo[e * 2048 + k] = (bf16_t)(cvtpk(res, 0.f) & 0xffffu);
        }
    }
}

constexpr int CV_NCHUNK = 1536;
struct CvItem { const float* W; unsigned char* WT; int K, N, drow0, k0, n0; float scale; };
__device__ __forceinline__ CvItem cv_decode(Ctx& F, int it) {
    unsigned char* ws = F.ws; CvItem c;
    if (it < 16384) { const int r = it, e = r >> 8, r2 = r & 255, kb = r2 / 8, nb = r2 % 8;
        c.W = F.in[I_WEG] + (size_t)e * 2048 * 512; c.WT = ws + WS_W_EGU_T + (size_t)e * 1024 * 2048; c.scale = F8_SW; c.K = 2048; c.N = 512; c.drow0 = gu_row(64 * nb, 0); c.k0 = 64 * kb; c.n0 = 64 * nb; }
    else if (it < 32768) { const int r = it - 16384, e = r >> 8, r2 = r & 255, kb = r2 / 8, nb = r2 % 8;
        c.W = F.in[I_WEU] + (size_t)e * 2048 * 512; c.WT = ws + WS_W_EGU_T + (size_t)e * 1024 * 2048; c.scale = F8_SW; c.K = 2048; c.N = 512; c.drow0 = gu_row(64 * nb, 1); c.k0 = 64 * kb; c.n0 = 64 * nb; }
    else { const int r = it - 32768, e = r >> 8, r2 = r & 255, kb = r2 / 32, nb = r2 % 32;
        c.W = F.in[I_WED] + (size_t)e * 512 * 2048; c.WT = ws + WS_W_ED_T + (size_t)e * 2048 * 512; c.scale = F8_SD; c.K = 512; c.N = 2048; c.drow0 = 64 * nb; c.k0 = 64 * kb; c.n0 = 64 * nb; }
    return c;
}
__device__ __forceinline__ void convert_chunk(Ctx& F, int chunk) {
    LAS float* scr = (LAS float*)(F.lds + F.wave * TR_SCR);
    int lane = F.lane; asm volatile("" : "+v"(lane));
    const int it0 = chunk * 32 + F.wave * 4;
#pragma unroll 1
    for (int i = 0; i < 4; i += 2) { const CvItem a = cv_decode(F, it0 + i), b = cv_decode(F, it0 + i + 1);
        transpose_pair_f8(CvItemF8{a.W, a.WT, a.K, a.N, a.drow0, a.k0, a.n0, a.scale}, CvItemF8{b.W, b.WT, b.K, b.N, b.drow0, b.k0, b.n0, b.scale}, scr, lane); }
}
__device__ __forceinline__ int queue_take(Ctx& F, unsigned* head) {
    volatile LAS int* slot = (volatile LAS int*)(F.lds + MISC_OFF + 64);
    __syncthreads();
    if (F.tid == 0) *slot = (int)__hip_atomic_fetch_add(head, 1u, RLX_AGENT);
    __syncthreads();
    return *slot;
}

__device__ __forceinline__ void fill_mod_tables(Ctx& F, const float* gain, int shift_off, int scale_off, bool from_partials, int bsel = -1) {
    LAS float* A = (LAS float*)F.lds; LAS float* Bt = (LAS float*)(F.lds + 16384);
    const float* modp = (const float*)(F.ws + WS_MODP); const float* modf = (const float*)(F.ws + WS_MOD); const float* bada = F.in[I_BADA];
    const int lo = bsel < 0 ? 0 : bsel * 2048, hi = bsel < 0 ? 4096 : lo + 2048;
    for (int idx = lo + F.tid; idx < hi; idx += 512) {
        const int b = idx >> 11, c = idx & 2047;
        float sh, scl;
        if (from_partials) {
            sh = bada[shift_off + c]; scl = bada[scale_off + c];
#pragma unroll 16
            for (int ks = 0; ks < 32; ++ks) { sh += modp[((size_t)ks * 2 + b) * 12288 + shift_off + c]; scl += modp[((size_t)ks * 2 + b) * 12288 + scale_off + c]; }
        } else { sh = modf[b * 12288 + shift_off + c]; scl = modf[b * 12288 + scale_off + c]; }
        A[idx] = gain[c] * (1.0f + scl); Bt[idx] = sh;
    }
    __syncthreads();
}

__device__ __forceinline__ void p1_norm(Ctx& F) {
    { const float* modp = (const float*)(F.ws + WS_MODP); float* modf = (float*)(F.ws + WS_MOD); const float* bada = F.in[I_BADA];
      for (int idx = F.blk * 512 + F.tid; idx < 2 * 12288; idx += F.G * 512) { const int b = idx / 12288, j = idx % 12288; float s = bada[j];
#pragma unroll 8
          for (int ks = 0; ks < 32; ++ks) s += modp[((size_t)ks * 2 + b) * 12288 + j];
          modf[idx] = s; } }
    const int rpb = T / F.G;
    const bool one_batch = (F.G * rpb == T) && (SEQ % rpb == 0);
    const int row_lo = one_batch ? F.blk * rpb : 0, row_hi = one_batch ? row_lo + rpb : T, rstep = one_batch ? 8 : F.G * 8, r0 = one_batch ? row_lo + F.wave : F.blk * 8 + F.wave;
    fill_mod_tables(F, F.in[I_GMIX], 0, 2048, true, one_batch ? row_lo / SEQ : -1);
    const LAS float* A = (const LAS float*)F.lds; const LAS float* Bt = (const LAS float*)(F.lds + 16384);
    const float* x = F.in[I_X]; bf16_t* H = (bf16_t*)(F.ws + WS_H);
    for (int row = r0; row < row_hi; row += 2 * rstep) {
        const int row2 = row + rstep; const bool has2 = row2 < row_hi;
        const int b = row / SEQ, b2 = has2 ? row2 / SEQ : b;
        const f32x4* xr = (const f32x4*)(x + (size_t)row * 2048) + F.lane;
        const f32x4* xr2 = (const f32x4*)(x + (size_t)(has2 ? row2 : row) * 2048) + F.lane;
        f32x4 v[8], v2[8]; float ss = 0.f, ss2 = 0.f;
#pragma unroll
        for (int j = 0; j < 8; ++j) { v[j] = __builtin_nontemporal_load(xr + 64 * j); v2[j] = __builtin_nontemporal_load(xr2 + 64 * j); }
#pragma unroll
        for (int j = 0; j < 8; ++j) { ss += (v[j].x * v[j].x + v[j].y * v[j].y) + (v[j].z * v[j].z + v[j].w * v[j].w); ss2 += (v2[j].x * v2[j].x + v2[j].y * v2[j].y) + (v2[j].z * v2[j].z + v2[j].w * v2[j].w); }
        const float rstd = 1.0f / sqrtf(wave_sum(ss) * (1.0f / 2048.0f) + RMS_EPS), rstd2 = 1.0f / sqrtf(wave_sum(ss2) * (1.0f / 2048.0f) + RMS_EPS);
        unsigned long long* o8 = (unsigned long long*)(H + (size_t)row * 2048) + F.lane;
        unsigned long long* o82 = (unsigned long long*)(H + (size_t)row2 * 2048) + F.lane;
#pragma unroll
        for (int j = 0; j < 8; ++j) { const int c = 4 * F.lane + 256 * j;
            const f32x4 a = *(const LAS f32x4*)(A + b * 2048 + c), sft = *(const LAS f32x4*)(Bt + b * 2048 + c);
            const f32x4 y = v[j] * rstd * a + sft;
            if constexpr (P2F8) ((unsigned*)((unsigned char*)H + (size_t)row * 2048))[F.lane + 64 * j] = epi::pack4_f8(y.x * F8_SH, y.y * F8_SH, y.z * F8_SH, y.w * F8_SH);
            else o8[64 * j] = (unsigned long long)cvtpk(y.x, y.y) | ((unsigned long long)cvtpk(y.z, y.w) << 32);
            if (has2) { const f32x4 a2 = *(const LAS f32x4*)(A + b2 * 2048 + c), sft2 = *(const LAS f32x4*)(Bt + b2 * 2048 + c);
                const f32x4 y2 = v2[j] * rstd2 * a2 + sft2;
                if constexpr (P2F8) ((unsigned*)((unsigned char*)H + (size_t)row2 * 2048))[F.lane + 64 * j] = epi::pack4_f8(y2.x * F8_SH, y2.y * F8_SH, y2.z * F8_SH, y2.w * F8_SH);
                else o82[64 * j] = (unsigned long long)cvtpk(y2.x, y2.y) | ((unsigned long long)cvtpk(y2.z, y2.w) << 32); } }
    }
}

__device__ __forceinline__ void p3_kmean(Ctx& F) {
    const bf16_t* KMT = (const bf16_t*)(F.ws + WS_KMT); float* KM = (float*)(F.ws + WS_KMEAN);
    LAS float* red = (LAS float*)F.lds;
    for (int item = F.blk; item < 512; item += F.G) {
        const int b = item >> 8, h = (item >> 5) & 7, n = item & 31;
        const int cp = F.tid & 63, rg = F.tid >> 6;
        const bf16_t* base = KMT + (((size_t)h * 256 + b * 128 + 4 * n) * 64 + 32 * rg) * 128 + 2 * cp;
        float s0 = 0.f, s1 = 0.f;
#pragma unroll 8
        for (int rr = 0; rr < 32; ++rr) { const unsigned u = *(const unsigned*)(base + (size_t)rr * 128); s0 += bf_lo(u); s1 += bf_hi(u); }
        __syncthreads();
        red[rg * 128 + 2 * cp] = s0; red[rg * 128 + 2 * cp + 1] = s1;
        __syncthreads();
        if (F.tid < 128) { float s = 0.f;
#pragma unroll
            for (int g = 0; g < 8; ++g) s += red[g * 128 + F.tid];
            KM[(size_t)item * 128 + F.tid] = s * (1.0f / 256.0f); }
    }
    __syncthreads();
}

__device__ __forceinline__ void p4_gating(Ctx& F) {
    const bf16_t* QM = (const bf16_t*)(F.ws + WS_QM); const float* KM = (const float*)(F.ws + WS_KMEAN);
    float* ML = (float*)(F.ws + WS_ML); int* MLIST = (int*)(F.ws + WS_MLIST); unsigned* mcnt = F.ctl + CW_MCNT;
    for (int grp = F.blk; grp < T / 64; grp += F.G) {
        const int h = F.wave, tok = grp * 64 + F.lane, b = tok / SEQ, qs = tok % SEQ, cur = qs >> 8;
        const int curu = __builtin_amdgcn_readfirstlane(cur), bu = __builtin_amdgcn_readfirstlane(b);
        float q[128];
        const u32x4* qp = (const u32x4*)(QM + (size_t)tok * 1024 + h * 128);
#pragma unroll
        for (int i = 0; i < 16; ++i) { const u32x4 u = qp[i]; q[8 * i + 0] = bf_lo(u.x); q[8 * i + 1] = bf_hi(u.x); q[8 * i + 2] = bf_lo(u.y); q[8 * i + 3] = bf_hi(u.y);
            q[8 * i + 4] = bf_lo(u.z); q[8 * i + 5] = bf_hi(u.z); q[8 * i + 6] = bf_lo(u.w); q[8 * i + 7] = bf_hi(u.w); }
        float v0 = -INFINITY, v1 = -INFINITY, v2 = -INFINITY; int i0 = -1, i1 = -1, i2 = -1;
        const float* kmb = KM + (size_t)((bu * 8 + h) * 32) * 128;
        for (int n = 0; n < curu; ++n) {
            const float* km = kmb + n * 128;
            float a0 = 0.f, a1 = 0.f, a2 = 0.f, a3 = 0.f;
#pragma unroll
            for (int d = 0; d < 128; d += 4) { a0 += q[d] * km[d]; a1 += q[d + 1] * km[d + 1]; a2 += q[d + 2] * km[d + 2]; a3 += q[d + 3] * km[d + 3]; }
            const float s = (a0 + a1) + (a2 + a3);
            if (s > v0) { v2 = v1; i2 = i1; v1 = v0; i1 = i0; v0 = s; i0 = n; }
            else if (s > v1) { v2 = v1; i2 = i1; v1 = s; i1 = n; }
            else if (s > v2) { v2 = s; i2 = n; }
        }
        float* ml = ML + ((size_t)tok * 8 + h) * 8;
        if (i0 < 0) *(f32x2*)(ml + 0) = (f32x2){-INFINITY, 0.f};
        if (i1 < 0) *(f32x2*)(ml + 2) = (f32x2){-INFINITY, 0.f};
        if (i2 < 0) *(f32x2*)(ml + 4) = (f32x2){-INFINITY, 0.f};
        for (int n = 0; n < curu; ++n) {
            const bool hit = (i0 == n) || (i1 == n) || (i2 == n);
            const unsigned long long mask = __ballot(hit);
            if (mask) {
                const int cntw = __popcll(mask);
                unsigned base = 0;
                if (F.lane == 0) base = __hip_atomic_fetch_add(mcnt + ((bu * 8 + h) * 32 + n), (unsigned)cntw, RLX_AGENT);
                base = __builtin_amdgcn_readfirstlane(base);
                if (hit) { const int pos = base + __popcll(mask & ((1ull << F.lane) - 1ull)); const int slot = (i0 == n) ? 0 : ((i1 == n) ? 1 : 2);
                    MLIST[(size_t)((bu * 8 + h) * 32 + n) * 8192 + pos] = (qs << 2) | slot; }
            }
        }
    }
}

__device__ __forceinline__ void p6_merge(Ctx& F) {
    const bf16_t* PARTS = (const bf16_t*)(F.ws + WS_PARTS); const float* ML = (const float*)(F.ws + WS_ML); bf16_t* AM = (bf16_t*)(F.ws + WS_AM);
    const int gw = F.blk * 8 + F.wave, NGW = F.G * 8;
    for (int tok = gw; tok < T; tok += NGW) {
        f32x4 ml01[2], ml23[2]; u32x4 pu[2][4];
#pragma unroll
        for (int i = 0; i < 2; ++i) {
            const int item = F.lane + 64 * i, h = item >> 4, ch = item & 15;
            const float* ml = ML + ((size_t)tok * 8 + h) * 8;
            ml01[i] = *(const f32x4*)ml; ml23[i] = *(const f32x4*)(ml + 4);
            const bf16_t* pb = PARTS + (((size_t)tok * 8 + h) * 4) * 128 + ch * 8;
#pragma unroll
            for (int s4 = 0; s4 < 4; ++s4) pu[i][s4] = __builtin_nontemporal_load((const u32x4*)(pb + s4 * 128));
        }
#pragma unroll
        for (int i = 0; i < 2; ++i) {
            const int item = F.lane + 64 * i, h = item >> 4, ch = item & 15;
            const float m0 = ml01[i][0], l0 = ml01[i][1], m1 = ml01[i][2], l1 = ml01[i][3], m2 = ml23[i][0], l2 = ml23[i][1], m3 = ml23[i][2], l3 = ml23[i][3];
            const float M = fmaxf(fmaxf(m0, m1), fmaxf(m2, m3));
            const float w0 = l0 * fast_exp2(m0 - M), w1 = l1 * fast_exp2(m1 - M), w2 = l2 * fast_exp2(m2 - M), w3 = l3 * fast_exp2(m3 - M);
            const float inv = 1.0f / (w0 + w1 + w2 + w3);
            float acc[8];
#pragma unroll
            for (int j = 0; j < 8; ++j) acc[j] = 0.f;
            const float ws4[4] = {w0, w1, w2, w3};
#pragma unroll
            for (int s4 = 0; s4 < 4; ++s4) {
                const float w = ws4[s4]; u32x4 u = pu[i][s4];
                if (!(w > 0.f)) u = (u32x4){0u, 0u, 0u, 0u};
                acc[0] += w * bf_lo(u.x); acc[1] += w * bf_hi(u.x); acc[2] += w * bf_lo(u.y); acc[3] += w * bf_hi(u.y);
                acc[4] += w * bf_lo(u.z); acc[5] += w * bf_hi(u.z); acc[6] += w * bf_lo(u.w); acc[7] += w * bf_hi(u.w);
            }
            if constexpr (O78F8) { const float i8 = inv * F8_SAM;
                *(u32x2*)((unsigned char*)AM + (size_t)tok * 1024 + h * 128 + ch * 8) = (u32x2){epi::pack4_f8(acc[0] * i8, acc[1] * i8, acc[2] * i8, acc[3] * i8), epi::pack4_f8(acc[4] * i8, acc[5] * i8, acc[6] * i8, acc[7] * i8)}; }
            else { u32x4 o; o.x = cvtpk(acc[0] * inv, acc[1] * inv); o.y = cvtpk(acc[2] * inv, acc[3] * inv); o.z = cvtpk(acc[4] * inv, acc[5] * inv); o.w = cvtpk(acc[6] * inv, acc[7] * inv);
            *(u32x4*)(AM + (size_t)tok * 1024 + h * 128 + ch * 8) = o; }
        }
    }
}
constexpr int P9_RSTD = 32768, P9_LG = 33792, P9_LGROW = 68, P9_LCNT = P9_LG + 2 * 64 * P9_LGROW * 4, P9_LBASE = P9_LCNT + 256, P9_END = P9_LBASE + 256;
static_assert(P9_END <= RING_BYTES, "P9 LDS");
__device__ __forceinline__ void p9_route(Ctx& F) {
    fill_mod_tables(F, F.in[I_GFFN], 6144, 8192, false);
    const LAS float* A2 = (const LAS float*)F.lds; const LAS float* B2 = (const LAS float*)(F.lds + 16384);
    LAS float* rstd_l = (LAS float*)(F.lds + P9_RSTD); LAS float* LG = (LAS float*)(F.lds + P9_LG);
    LAS int* lcnt = (LAS int*)(F.lds + P9_LCNT); LAS int* lbase = (LAS int*)(F.lds + P9_LBASE);
    const bf16_t* x1 = (const bf16_t*)(F.ws + WS_X1); bf16_t* H2 = (bf16_t*)(F.ws + WS_H2); unsigned char* H2F8 = F.ws + WS_H2F8;
    const bf16_t* WRH = (const bf16_t*)(F.ws + WS_WR); const bf16_t* WRL = WRH + 64 * 2048;
    const float* rbias = F.in[I_RBIAS];
    int* ELIST = (int*)(F.ws + WS_ELIST); int* TOKE = (int*)(F.ws + WS_TOKE); float* TOKW = (float*)(F.ws + WS_TOKW);
    unsigned* ecnt = F.ctl + CW_ECNT;
    for (int grp = F.blk; grp < T / 64; grp += F.G) {
        const int tokb = grp * 64, b = tokb / SEQ;
        if (F.tid < 64) lcnt[F.tid] = 0;
        for (int i = 0; i < 8; i += 4) {
            const int tl = F.wave * 8 + i;
            u32x4 va[4][4];
#pragma unroll
            for (int q = 0; q < 4; ++q) { const u32x4* xr = (const u32x4*)(x1 + (size_t)(tokb + tl + q) * 2048) + F.lane;
#pragma unroll
                for (int j = 0; j < 4; ++j) va[q][j] = xr[64 * j]; }
#pragma unroll
            for (int q = 0; q < 4; ++q) { float ss = 0.f;
#pragma unroll
                for (int j = 0; j < 4; ++j) { const u32x4 u = va[q][j];
                    const float a0 = bf_lo(u.x), a1 = bf_hi(u.x), a2 = bf_lo(u.y), a3 = bf_hi(u.y), a4 = bf_lo(u.z), a5 = bf_hi(u.z), a6 = bf_lo(u.w), a7 = bf_hi(u.w);
                    ss += ((a0 * a0 + a1 * a1) + (a2 * a2 + a3 * a3)) + ((a4 * a4 + a5 * a5) + (a6 * a6 + a7 * a7)); }
                ss = wave_sum(ss);
                if (F.lane == 0) rstd_l[tl + q] = 1.0f / sqrtf(ss * (1.0f / 2048.0f) + RMS_EPS); }
        }
        __syncthreads();
        {
            const int tg = F.wave & 3, kh = F.wave >> 2, tc = F.lane & 15, kg = F.lane >> 4;
            const int tl = 16 * tg + tc; const float rs = rstd_l[tl];
            const bf16_t* xrow = x1 + (size_t)(tokb + tl) * 2048;
            bf16_t* hrow = H2 + (size_t)(tokb + tl) * 2048;
            f32x4 acc[4];
#pragma unroll
            for (int nt = 0; nt < 4; ++nt) acc[nt] = (f32x4){0.f, 0.f, 0.f, 0.f};
#pragma unroll 2
            for (int s = 32 * kh; s < 32 * kh + 32; ++s) {
                const int c0 = 32 * s + 8 * kg;
                const u32x4 xu = *(const u32x4*)(xrow + c0);
                const f32x4 xa = {bf_lo(xu.x), bf_hi(xu.x), bf_lo(xu.y), bf_hi(xu.y)}, xb = {bf_lo(xu.z), bf_hi(xu.z), bf_lo(xu.w), bf_hi(xu.w)};
                const f32x4 aa = *(const LAS f32x4*)(A2 + b * 2048 + c0), ab = *(const LAS f32x4*)(A2 + b * 2048 + c0 + 4);
                const f32x4 ba = *(const LAS f32x4*)(B2 + b * 2048 + c0), bb = *(const LAS f32x4*)(B2 + b * 2048 + c0 + 4);
                const f32x4 ya = xa * rs * aa + ba, yb = xb * rs * ab + bb;
                u32x4 hi; hi.x = cvtpk(ya[0], ya[1]); hi.y = cvtpk(ya[2], ya[3]); hi.z = cvtpk(yb[0], yb[1]); hi.w = cvtpk(yb[2], yb[3]);
                *(u32x2*)(H2F8 + (size_t)(tokb + tl) * 2048 + c0) = (u32x2){epi::pack4_f8(ya[0] * F8_SH, ya[1] * F8_SH, ya[2] * F8_SH, ya[3] * F8_SH), epi::pack4_f8(yb[0] * F8_SH, yb[1] * F8_SH, yb[2] * F8_SH, yb[3] * F8_SH)};
                u32x4 lo; lo.x = cvtpk(ya[0] - bf_lo(hi.x), ya[1] - bf_hi(hi.x)); lo.y = cvtpk(ya[2] - bf_lo(hi.y), ya[3] - bf_hi(hi.y));
                lo.z = cvtpk(yb[0] - bf_lo(hi.z), yb[1] - bf_hi(hi.z)); lo.w = cvtpk(yb[2] - bf_lo(hi.w), yb[3] - bf_hi(hi.w));
                const bf16x8 hf = __builtin_bit_cast(bf16x8, hi), lf = __builtin_bit_cast(bf16x8, lo);
#pragma unroll
                for (int nt = 0; nt < 4; ++nt) {
                    const bf16x8 wh = *(const bf16x8*)(WRH + (size_t)(16 * nt + tc) * 2048 + c0), wl = *(const bf16x8*)(WRL + (size_t)(16 * nt + tc) * 2048 + c0);
                    acc[nt] = __builtin_amdgcn_mfma_f32_16x16x32_bf16(wh, hf, acc[nt], 0, 0, 0);
                    acc[nt] = __builtin_amdgcn_mfma_f32_16x16x32_bf16(wh, lf, acc[nt], 0, 0, 0);
                    acc[nt] = __builtin_amdgcn_mfma_f32_16x16x32_bf16(wl, hf, acc[nt], 0, 0, 0);
                }
            }
#pragma unroll
            for (int nt = 0; nt < 4; ++nt) *(LAS f32x4*)(LG + (kh * 64 + tl) * P9_LGROW + 16 * nt + 4 * kg) = acc[nt];
        }
        __syncthreads();
        int se[8], sslot[8]; float sw[8];
        if (F.tid < 64) {
            LAS float* row0 = LG + F.tid * P9_LGROW; const LAS float* row1 = LG + (64 + F.tid) * P9_LGROW;
            float sl[64];
#pragma unroll
            for (int e = 0; e < 64; ++e) { const float s = sigmoidf_(row0[e] + row1[e]); row0[e] = s; sl[e] = s + rbias[e]; }
            float gs[8];
#pragma unroll
            for (int g = 0; g < 8; ++g) { float m1 = -INFINITY, m2 = -INFINITY;
#pragma unroll
                for (int j = 0; j < 8; ++j) { const float v = sl[8 * g + j]; if (v > m1) { m2 = m1; m1 = v; } else if (v > m2) m2 = v; }
                gs[g] = m1 + m2; }
            unsigned gmask = 0u;
#pragma unroll
            for (int it = 0; it < 4; ++it) { float best = -INFINITY; int bi = 0;
#pragma unroll
                for (int g = 0; g < 8; ++g) { const bool free_ = !((gmask >> g) & 1u); if (free_ && gs[g] > best) { best = gs[g]; bi = g; } }
                gmask |= 1u << bi; }
            unsigned long long picked = 0ull; float wsum = 0.f;
#pragma unroll
            for (int it = 0; it < 8; ++it) { float best = -INFINITY; int bi = 0;
#pragma unroll
                for (int e = 0; e < 64; ++e) { const bool ok = ((gmask >> (e >> 3)) & 1u) && !((picked >> e) & 1ull); if (ok && sl[e] > best) { best = sl[e]; bi = e; } }
                picked |= 1ull << bi; se[it] = bi; const float s = row0[bi]; sw[it] = s; wsum += s; }
            const float inv = 2.5f / wsum;
#pragma unroll
            for (int k = 0; k < 8; ++k) { sw[k] *= inv; sslot[k] = __hip_atomic_fetch_add(lcnt + se[k], 1, __ATOMIC_RELAXED, __HIP_MEMORY_SCOPE_WORKGROUP); }
        }
        __syncthreads();
        if (F.tid < 64) { const int c = lcnt[F.tid]; lbase[F.tid] = c > 0 ? (int)__hip_atomic_fetch_add(ecnt + F.tid, (unsigned)c, RLX_AGENT) : 0; }
        __syncthreads();
        if (F.tid < 64) { const int tok = tokb + F.tid;
#pragma unroll
            for (int k = 0; k < 8; ++k) { const int slot = lbase[se[k]] + sslot[k];
                ELIST[(size_t)se[k] * 16384 + slot] = tok; TOKE[tok * 8 + k] = (se[k] << 16) | slot; TOKW[tok * 8 + k] = sw[k]; } }
        __syncthreads();
    }
}

constexpr int MT_CNT = 0, MT_TST = 256, MT_COFF = 768, MT_GTAB = 2048;
__device__ __forceinline__ void moe_tables(Ctx& F) {
    LAS int* cnt = (LAS int*)(F.lds + LDSX_OFF + MT_CNT); LAS int* tst = (LAS int*)(F.lds + LDSX_OFF + MT_TST); LAS int* coff = (LAS int*)(F.lds + LDSX_OFF + MT_COFF);
    if (F.tid < 64) cnt[F.tid] = (int)__hip_atomic_load(F.ctl + CW_ECNT + F.tid, RLX_AGENT);
    __syncthreads();
    if (F.tid == 0) { int t = 0, c = 0; for (int e = 0; e < 64; ++e) { tst[e] = t; coff[e] = c; const int n = cnt[e]; t += (n + 255) >> 8; c += n; } tst[64] = t; coff[64] = c; }
    __syncthreads();
}
struct MoeSched {
    const LAS int* cnt; const LAS int* tst; const LAS int* coff; int G, c, npn_log2; const char* A; const char* B; size_t a_tile_bytes, b_exp_bytes, b_tile_bytes; bool compact;
    __device__ __forceinline__ bool next(int i, pg8::Unit& u) const {
        const int ntile = tst[64];
        const long L = (long)i * G + c; if (L >= ((long)ntile << npn_log2)) return false;
        const int rt = (int)(L >> npn_log2), pn = (int)(L & ((1 << npn_log2) - 1));
        int lo = 0, hi = 64;
#pragma unroll
        for (int s = 0; s < 6; ++s) { const int mid = (lo + hi) >> 1; if (tst[mid] <= rt) lo = mid; else hi = mid; }
        int e = lo;
        e = __builtin_amdgcn_readfirstlane(e);
        const int j = rt - __builtin_amdgcn_readfirstlane(tst[e]);
        const int n = __builtin_amdgcn_readfirstlane(cnt[e]);
        u.pm = rt; u.pn = pn; u.aux = e;
        u.valid = (n - 256 * j) < 256 ? (n - 256 * j) : 256;
        u.rowbase = compact ? (__builtin_amdgcn_readfirstlane(coff[e]) + 256 * j) : rt * 256;
        u.A = A + (size_t)rt * a_tile_bytes; u.B = B + (size_t)e * b_exp_bytes + (size_t)pn * b_tile_bytes;
        return true;
    }
};

__device__ __forceinline__ void p12_combine(Ctx& F) {
    moe_tables(F);
    const LAS int* coff = (const LAS int*)(F.lds + LDSX_OFF + MT_COFF);
    const unsigned char* Y = (const unsigned char*)(F.ws + WS_Y); const int* TOKE = (const int*)(F.ws + WS_TOKE); const float* TOKW = (const float*)(F.ws + WS_TOKW);
    const float* modf = (const float*)(F.ws + WS_MOD); const float* gfin = F.in[I_GFINAL]; const bf16_t* SHOUT = (const bf16_t*)(F.ws + WS_SHOUT);
    float* out = F.out;
    const int gw = F.blk * 8 + F.wave, NGW = F.G * 8;
    for (int tok = gw; tok < T; tok += NGW) {
        const int b = tok / SEQ;
        f32x4 acc[8];
        int es8[8]; float w8[8];
#pragma unroll
        for (int k = 0; k < 8; ++k) { es8[k] = TOKE[tok * 8 + k]; w8[k] = TOKW[tok * 8 + k]; }
        f32x4* xr = (f32x4*)(out + (size_t)tok * 2048) + F.lane;
        f32x4 v[8];
        { const unsigned long long* x1r = (const unsigned long long*)((const bf16_t*)(F.ws + WS_X1) + (size_t)tok * 2048) + F.lane;
#pragma unroll
          for (int j = 0; j < 8; ++j) { const unsigned long long u = __builtin_nontemporal_load(x1r + 64 * j); const unsigned lo = (unsigned)u, hi = (unsigned)(u >> 32);
              v[j] = (f32x4){bf_lo(lo), bf_hi(lo), bf_lo(hi), bf_hi(hi)}; } }
        { const unsigned long long* sr = (const unsigned long long*)(SHOUT + (size_t)tok * 2048) + F.lane;
#pragma unroll
          for (int j = 0; j < 8; ++j) { const unsigned long long u = __builtin_nontemporal_load(sr + 64 * j); const unsigned lo = (unsigned)u, hi = (unsigned)(u >> 32);
              acc[j].x = bf_lo(lo); acc[j].y = bf_hi(lo); acc[j].z = bf_lo(hi); acc[j].w = bf_hi(hi); } }
#pragma unroll
        for (int kk = 0; kk < 8; kk += 4) {
            unsigned yu[4][8];
#pragma unroll
            for (int k = 0; k < 4; ++k) { const int e = es8[kk + k] >> 16, slot = es8[kk + k] & 0xffff;
                const unsigned* yr = (const unsigned*)(Y + (size_t)(coff[e] + slot) * 2048) + F.lane;
#pragma unroll
                for (int j = 0; j < 8; ++j) yu[k][j] = __builtin_nontemporal_load(yr + 64 * j); }
#pragma unroll
            for (int k = 0; k < 4; ++k) { const float w = w8[kk + k];
#pragma unroll
                for (int j = 0; j < 8; ++j) { const int u = (int)yu[k][j]; const f32x2 lo = __builtin_amdgcn_cvt_pk_f32_fp8(u, false), hi = __builtin_amdgcn_cvt_pk_f32_fp8(u, true);
                    acc[j].x += w * lo[0]; acc[j].y += w * lo[1]; acc[j].z += w * hi[0]; acc[j].w += w * hi[1]; } }
        }
        float ss = 0.f;
#pragma unroll
        for (int j = 0; j < 8; ++j) { const int c = 4 * F.lane + 256 * j; const f32x4 g2 = *(const f32x4*)(modf + b * 12288 + 10240 + c);
            v[j] = v[j] + g2 * acc[j]; ss += (v[j].x * v[j].x + v[j].y * v[j].y) + (v[j].z * v[j].z + v[j].w * v[j].w); }
        const float rstd = 1.0f / sqrtf(wave_sum(ss) * (1.0f / 2048.0f) + RMS_EPS);
#pragma unroll
        for (int j = 0; j < 8; ++j) { const int c = 4 * F.lane + 256 * j; const f32x4 g = *(const f32x4*)(gfin + c); __builtin_nontemporal_store(v[j] * rstd * g, xr + 64 * j); }
    }
}
struct Args { const float* in[22]; float* out; unsigned char* ws; int ph_lo, ph_hi; };
static_assert(sizeof(Args) == 22 * 8 + 8 + 8 + 8, "Args has no padding");

__global__ void __launch_bounds__(512, 2) fwd_kernel(Args args) {
    extern __shared__ __attribute__((aligned(16))) unsigned char lds_raw[];
    Ctx F;
    F.lds = (LAS unsigned char*)lds_raw;
    F.tid = threadIdx.x; F.lane = F.tid & 63; F.wave = __builtin_amdgcn_readfirstlane(F.tid >> 6);
    F.G = gridDim.x; F.blk = blockIdx.x;
    F.ws = args.ws; F.ctl = (unsigned*)(args.ws + WS_CTL); F.out = args.out;
    F.in = args.in;
    volatile LAS unsigned* MISC = (volatile LAS unsigned*)(F.lds + MISC_OFF);
    if (F.tid < 32) MISC[F.tid] = 0u;
    __syncthreads();
    XcdBarrier bar; bar.bar = F.ctl + CW_BAR; bar.x = 0; bar.st = nullptr;
    if (MK_N_LAUNCHES == 1) bar = xcd_barrier_post(F.ctl + CW_BAR, MISC + 8);
    const int lo = args.ph_lo, hi = args.ph_hi;
    unsigned char* ws = args.ws;
#define IN(k) (lo <= (k) && (k) < hi && ((PHASE_MASK >> (k)) & 1u))
#define SEAM(k) do { if (MK_N_LAUNCHES == 1 && (k) + 1 < hi) xcd_barrier(bar); } while (0)
#define NREP(k) (((REP_MASK >> (k)) & 1u) ? 2 : 1)
    typedef pg8::StaticOrder SO;

    if (lo <= 0 && 0 < hi) { if (IN(0)) { for (int rep_ = 0; rep_ < NREP(0); ++rep_) { if (rep_) xcd_barrier(bar); p0_prologue(F); } } SEAM(0); }
    if (lo <= 1 && 1 < hi) { if (IN(1)) { for (int rep_ = 0; rep_ < NREP(1); ++rep_) { if (rep_) xcd_barrier(bar); p1_norm(F); } } SEAM(1); }
    if (lo <= 2 && 2 < hi) {
        if (IN(2)) {
#pragma unroll 1
        for (int rep_ = 0; rep_ < NREP(2); ++rep_) { if (rep_) xcd_barrier(bar);
            const char* H = (const char*)(ws + WS_H); const char* W = (const char*)(ws + WS_W_IN_T);
            constexpr int KP = P2F8 ? 1024 : 2048;
            { SO S; S.init(H, W, T, 8192, KP, F.G, F.blk);
              epi::ProjEpi E{epi::StoreQK8{ws + WS_QD, ws + WS_KDT, att::D8_QS, att::D8_KS}, epi::StoreQKboth{epi::StoreQK{(bf16_t*)(ws + WS_QM), (bf16_t*)(ws + WS_KMT), 1.0f}, ws + WS_QM8, ws + WS_KMT8}, epi::StoreBf16<1>{(bf16_t*)(ws + WS_GATES), 4096}};
              pg8::gemm_phase<epi::ProjEpi, SO, true, true, false, P2F8>(F.lds, KP, S, E, nullptr); }
            { SO S; S.init(W + (size_t)8192 * KP * 2, H, 2048, T, KP, F.G, F.blk); epi::ProjVT E{epi::StoreVT8{ws + WS_VDT, att::D8_VS}, epi::StoreVT8{ws + WS_VMT8, att::D8_VS}};
              pg8::gemm_phase<epi::ProjVT, SO, true, true, false, P2F8>(F.lds, KP, S, E, nullptr); }
        }
        }
        SEAM(2);
    }
    if (lo <= 3 && 3 < hi) {
        if (IN(3)) {
#pragma unroll 1
        for (int rep_ = 0; rep_ < NREP(3); ++rep_) { if (rep_) xcd_barrier(bar);
            const float* lv = F.in[I_LAMBDA];
            float d1 = 0.f, d2 = 0.f;
            for (int i = 0; i < 64; ++i) { d1 += lv[i] * lv[64 + i]; d2 += lv[128 + i] * lv[192 + i]; }
            if (F.tid == 0) *(LAS float*)(F.lds + MISC_OFF + 68) = expf(d1) - expf(d2) + 0.2f;
            {
                const int x = (int)(xb_xcc_id() & 7u);
                const bool converter = ((F.blk >> 3) & 3) == 3;
                const int CV_PER = (F.G == 256) ? 18 : 0, CV_STATIC = 64 * CV_PER;
                if (converter) {
                    const int cvid = (F.blk >> 5) * 8 + (F.blk & 7);
#pragma unroll 1
                    for (int c = cvid * CV_PER; c < (cvid + 1) * CV_PER; ++c) { __syncthreads(); convert_chunk(F, c); }
                    for (int c = CV_STATIC + queue_take(F, F.ctl + CW_CQ); c < CV_NCHUNK; c = CV_STATIC + queue_take(F, F.ctl + CW_CQ)) { __syncthreads(); convert_chunk(F, c); }
                }
#pragma unroll 1
                for (int k = 0; k < 8; ++k) {
                    const int xq = (x + k) & 7;
#pragma unroll 1
                    for (int i = queue_take(F, F.ctl + CW_AQ + 64 * xq); i < 128; i = queue_take(F, F.ctl + CW_AQ + 64 * xq)) {
                        const int bh = 2 * xq + (i & 1), qt = 63 - (i >> 1);
                        att::diff_unit8(F.lds, bh >> 3, bh & 7, qt, ws + WS_QD, ws + WS_KDT, ws + WS_VDT, (bf16_t*)(ws + WS_AD), F.in[I_SUBLN], F.in[I_RELB]);
                    }
                }
                for (int c = CV_STATIC + queue_take(F, F.ctl + CW_CQ); c < CV_NCHUNK; c = CV_STATIC + queue_take(F, F.ctl + CW_CQ)) { __syncthreads(); convert_chunk(F, c); }
            }
            __syncthreads();
            p3_kmean(F);
        }
        }
        SEAM(3);
    }
    if (lo <= 4 && 4 < hi) { if (IN(4)) p4_gating(F); SEAM(4); }
    if (lo <= 5 && 5 < hi) {
        if (IN(5)) {
#pragma unroll 1
        for (int rep_ = 0; rep_ < NREP(5); ++rep_) { if (rep_) xcd_barrier(bar);
            constexpr int MB_CPU = 2;
            LAS int* pre = (LAS int*)(F.lds + LDSX_OFF);
            const unsigned* mcnt = F.ctl + CW_MCNT;
            const int mycnt = (int)__hip_atomic_load(mcnt + F.tid, RLX_AGENT);
            pre[F.tid] = (1 + ((mycnt + 255) >> 8) + MB_CPU - 1) / MB_CPU;
            __syncthreads();
            int src = 0;
            for (int off = 1; off < 512; off <<= 1) { const int v = pre[src * 512 + F.tid] + (F.tid >= off ? pre[src * 512 + F.tid - off] : 0); pre[(src ^ 1) * 512 + F.tid] = v; src ^= 1; __syncthreads(); }
            LAS int* inc = (LAS int*)(F.lds + att::MB_INC);
            inc[F.tid] = pre[src * 512 + F.tid];
            __syncthreads();
            const int total = inc[511];
            for (int u = F.blk; u < total; u += F.G) {
                int lo_ = -1, hi_ = 511;
#pragma unroll
                for (int st = 0; st < 9; ++st) { const int mid = (lo_ + hi_) >> 1; if (inc[mid] > u) hi_ = mid; else lo_ = mid; }
                const int l = __builtin_amdgcn_readfirstlane(hi_);
                const int before = l > 0 ? __builtin_amdgcn_readfirstlane(inc[l - 1]) : 0;
                const int j = u - before;
                const int cntl = (int)__builtin_amdgcn_readfirstlane(__hip_atomic_load(mcnt + l, RLX_AGENT));
                const int nch = 1 + ((cntl + 255) >> 8);
                const int c0 = j * MB_CPU, c1 = (c0 + MB_CPU) < nch ? (c0 + MB_CPU) : nch;
                att::moba_block8(F.lds, l >> 8, (l >> 5) & 7, l & 31, (const int*)(ws + WS_MLIST) + (size_t)l * 8192, cntl, c0, c1, ws + WS_QM8, ws + WS_KMT8, ws + WS_VMT8, (bf16_t*)(ws + WS_PARTS), (float*)(ws + WS_ML), F.in[I_RELB]);
            }
            __syncthreads();
        }
        }
        SEAM(5);
    }
    if (lo <= 6 && 6 < hi) { if (IN(6)) { for (int rep_ = 0; rep_ < NREP(6); ++rep_) { if (rep_) xcd_barrier(bar); p6_merge(F); } } SEAM(6); }
    if (lo <= 7 && 7 < hi) {
        if (IN(7)) {
#pragma unroll 1
        for (int rep_ = 0; rep_ < NREP(7); ++rep_) { if (rep_) xcd_barrier(bar);
            { pg8::PairOrder S; S.init(ws + WS_AD, ws + WS_W_OD_T, ws + WS_AM, ws + WS_W_OM_T, T, 2048, O78F8 ? 512 : 1024, F.G, F.blk);
              epi::GatePair E{epi::GateMul<0>{(const bf16_t*)(ws + WS_GATES), 0, nullptr, (bf16_t*)(ws + WS_T1)}, epi::GateMul<1>{(const bf16_t*)(ws + WS_GATES), 2048, (const bf16_t*)(ws + WS_T1), (bf16_t*)(ws + WS_G)}};
              pg8::gemm_phase<epi::GatePair, pg8::PairOrder, true, true, false, O78F8>(F.lds, O78F8 ? 512 : 1024, S, E, nullptr); }
        }
        }
        SEAM(7);
    }
    if (lo <= 8 && 8 < hi) {
        if (IN(8)) {
#pragma unroll 1
        for (int rep_ = 0; rep_ < NREP(8); ++rep_) { if (rep_) xcd_barrier(bar);
            SO S; S.init(ws + WS_G, ws + WS_W_OUT_T, T, 2048, O78F8 ? 1024 : 2048, F.G, F.blk); epi::ResidBf16 E{F.in[I_X], (bf16_t*)(ws + WS_X1), (const float*)(ws + WS_MOD), 4096};
            pg8::gemm_phase<epi::ResidBf16, SO, true, true, false, O78F8>(F.lds, O78F8 ? 1024 : 2048, S, E, nullptr);
        }
        }
        SEAM(8);
    }
    if (lo <= 9 && 9 < hi) { if (IN(9)) p9_route(F); SEAM(9); }
    if (lo <= 10 && 10 < hi) {
        if (IN(10)) {
#pragma unroll 1
        for (int rep_ = 0; rep_ < NREP(10); ++rep_) { if (rep_) xcd_barrier(bar);
            moe_tables(F);
            MoeSched S{(const LAS int*)(F.lds + LDSX_OFF + MT_CNT), (const LAS int*)(F.lds + LDSX_OFF + MT_TST), (const LAS int*)(F.lds + LDSX_OFF + MT_COFF), F.G, F.blk, 2,
                       (const char*)(ws + WS_H2F8), (const char*)(ws + WS_W_EGU_T), 0, (size_t)1024 * 2048, (size_t)256 * 2048, false};
            LAS unsigned short* gtab = (LAS unsigned short*)(F.lds + LDSX_OFF + MT_GTAB);
            { const int* ELIST = (const int*)(ws + WS_ELIST); pg8::Unit u;
              for (int i = 0; i < 24 && S.next(i, u); ++i) { if (F.tid < 256) { const int j = u.pm - S.tst[u.aux]; gtab[i * 256 + F.tid] = (unsigned short)(F.tid < u.valid ? ELIST[(size_t)u.aux * 16384 + 256 * j + F.tid] : 0); } } }
            __syncthreads();
            { epi::SwiGLU8 E{ws + WS_ACT}; pg8::gemm_phase<epi::SwiGLU8, MoeSched, true, true, true, true>(F.lds, 1024, S, E, gtab); }
            { SO S2; S2.init(ws + WS_H2F8, ws + WS_W_SHGU_T, T, 1024, 1024, F.G, F.blk); epi::SwiGLU8 E{ws + WS_SHACT};
              pg8::gemm_phase<epi::SwiGLU8, SO, true, true, false, true>(F.lds, 1024, S2, E, nullptr); }
        }
        }
        SEAM(10);
    }
    if (lo <= 11 && 11 < hi) {
        if (IN(11)) {
            moe_tables(F);
            MoeSched S{(const LAS int*)(F.lds + LDSX_OFF + MT_CNT), (const LAS int*)(F.lds + LDSX_OFF + MT_TST), (const LAS int*)(F.lds + LDSX_OFF + MT_COFF), F.G, F.blk, 3,
                       (const char*)(ws + WS_ACT), (const char*)(ws + WS_W_ED_T), (size_t)256 * 512, (size_t)2048 * 512, (size_t)256 * 512, true};
#pragma unroll 1
            for (int rep_ = 0; rep_ < NREP(11); ++rep_) { if (rep_) xcd_barrier(bar);
            { epi::DownY E{(unsigned char*)(ws + WS_Y)}; pg8::gemm_phase<epi::DownY, MoeSched, true, true, false, true>(F.lds, 256, S, E, nullptr); } }
            { SO S2; S2.init(ws + WS_SHACT, ws + WS_W_SHD_T, T, 2048, 256, F.G, F.blk); epi::StoreBf16<2> E{(bf16_t*)(ws + WS_SHOUT), 2048};
              pg8::gemm_phase<epi::StoreBf16<2>, SO, true, true, false, true>(F.lds, 256, S2, E, nullptr); }
        }
        SEAM(11);
    }
    if (lo <= 12 && 12 < hi) { if (IN(12)) p12_combine(F); }
#undef IN
#undef SEAM
}

extern "C" void kernel_launch(void* const* d_in, const int* in_sizes, int n_in, void* d_out, int out_size, void* d_ws, size_t ws_size, hipStream_t stream) {
    static int grid = 0;
    if (grid == 0) {
        if (n_in != 22 || in_sizes[0] != T * D || out_size != T * D || ws_size < WS_END) { fprintf(stderr, "kernel_launch: unexpected shapes (n_in %d, in0 %d, out %d, ws %zu < %zu); nothing launched\n", n_in, n_in > 0 ? in_sizes[0] : -1, out_size, ws_size, (size_t)WS_END); grid = -1; return; }
        int dev = 0, cus = 0, per_cu = 0;
        if (hipGetDevice(&dev) != hipSuccess || hipDeviceGetAttribute(&cus, hipDeviceAttributeMultiprocessorCount, dev) != hipSuccess) { grid = -1; return; }
        if (hipFuncSetAttribute((const void*)fwd_kernel, hipFuncAttributeMaxDynamicSharedMemorySize, LDS_BYTES) != hipSuccess) { fprintf(stderr, "kernel_launch: hipFuncSetAttribute failed\n"); grid = -1; return; }
        if (hipOccupancyMaxActiveBlocksPerMultiprocessor(&per_cu, (const void*)fwd_kernel, 512, LDS_BYTES) != hipSuccess || per_cu < 1) fprintf(stderr, "kernel_launch: occupancy query says %d\n", per_cu);
        (void)hipGetLastError();
        grid = cus;
    }
    if (grid < 0) return;
    if (hipMemsetAsync((char*)d_ws + WS_CTL, 0, CTL_ZERO_BYTES, stream) != hipSuccess) { fprintf(stderr, "kernel_launch: memset failed\n"); return; }
    Args a{};
    for (int i = 0; i < 22; ++i) a.in[i] = (const float*)d_in[i];
    a.out = (float*)d_out; a.ws = (unsigned char*)d_ws;
    for (int li = 0; li < MK_N_LAUNCHES; ++li) {
        a.ph_lo = (MK_N_LAUNCHES == 1) ? 0 : li; a.ph_hi = (MK_N_LAUNCHES == 1) ? NPHASE : li + 1;
        hipLaunchKernelGGL(fwd_kernel, dim3(grid), dim3(512), LDS_BYTES, stream, a);
        const hipError_t le = hipPeekAtLastError();
        if (le != hipSuccess) { fprintf(stderr, "kernel_launch: launch %d failed: %s\n", li, hipGetErrorName(le)); break; }
    }
}
```

```cpp
#include <hip/hip_runtime.h>
#include <cstdio>
#include <cstdint>

#define LAS __attribute__((address_space(3)))
#define GAS __attribute__((address_space(1)))
typedef unsigned short bf16_t;
typedef short bf16x8 __attribute__((ext_vector_type(8)));
typedef short s16x4 __attribute__((ext_vector_type(4)));
typedef int i32x4 __attribute__((ext_vector_type(4)));
typedef int i32x8 __attribute__((ext_vector_type(8)));
typedef float f32x4 __attribute__((ext_vector_type(4)));
typedef float f32x2 __attribute__((ext_vector_type(2)));
typedef float f32x16 __attribute__((ext_vector_type(16)));
typedef unsigned u32x4 __attribute__((ext_vector_type(4)));
typedef unsigned u32x2 __attribute__((ext_vector_type(2)));
typedef __bf16 bf16x2_t __attribute__((ext_vector_type(2)));

#ifndef MK_N_LAUNCHES
#define MK_N_LAUNCHES 1
#endif
#ifndef REP_MASK
#define REP_MASK 0u
#endif
#ifndef PHASE_MASK
#define PHASE_MASK 0xFFFFFFFFu
#endif

constexpr int NB = 2, SEQ = 8192, T = NB * SEQ, D = 2048, NH = 8, INC = 10240, NE = 64, EDIM = 512, TOPK = 8;
constexpr int NPHASE = 13;
constexpr float RMS_EPS = 1e-6f;
constexpr float LOG2E = 1.4426950408889634f;

constexpr size_t MiB = 1u << 20;
constexpr size_t WS_CTL = 0, CTL_ZERO_BYTES = 1 * MiB;
constexpr size_t WS_MODP = 1 * MiB;
constexpr size_t WS_MOD = 4 * MiB;
constexpr size_t WS_KMEAN = 4 * MiB + 256 * 1024;
constexpr size_t WS_WR = 4 * MiB + 512 * 1024;
constexpr size_t WS_TOKE = 5 * MiB;
constexpr size_t WS_TOKW = 5 * MiB + 512 * 1024;
constexpr size_t WS_W_IN_T = 8 * MiB;
constexpr size_t WS_W_OD_T = 48 * MiB;
constexpr size_t WS_W_OM_T = 52 * MiB;
constexpr size_t WS_W_OUT_T = 56 * MiB;
constexpr size_t WS_W_SHGU_T = 64 * MiB;
constexpr size_t WS_W_SHD_T = 68 * MiB;
constexpr size_t WS_ELIST = 70 * MiB;
constexpr size_t WS_W_ED_T = 76 * MiB;
constexpr size_t WS_W_EGU_T = 204 * MiB;
constexpr size_t WS_H = 460 * MiB;
constexpr size_t WS_QD = 524 * MiB;
constexpr size_t WS_KDT = 556 * MiB;
constexpr size_t WS_VDT = 588 * MiB;
constexpr size_t WS_QM = 620 * MiB;
constexpr size_t WS_KMT = 652 * MiB;
constexpr size_t WS_VMT = 684 * MiB;
constexpr size_t WS_GATES = 716 * MiB;
constexpr size_t WS_AD = 844 * MiB;
constexpr size_t WS_AM = 876 * MiB;
constexpr size_t WS_ML = 908 * MiB;
constexpr size_t WS_MLIST = 912 * MiB;
constexpr size_t WS_PARTS = 460 * MiB;
constexpr size_t WS_G = 460 * MiB;
constexpr size_t WS_T1 = 524 * MiB;
constexpr size_t WS_X1 = 524 * MiB;
constexpr size_t WS_H2 = 588 * MiB;
constexpr size_t WS_ACT = 716 * MiB;
constexpr size_t WS_H2F8 = 800 * MiB;
constexpr float F8_SH = 8.0f, F8_SW = 64.0f, F8_SA = 8.0f, F8_SD = 32.0f;
namespace att { constexpr float D8_QS = 0.125f * LOG2E * 16.0f, D8_KS = 4.0f, D8_VS = 8.0f; }
constexpr size_t WS_QM8 = 604 * MiB, WS_VMT8 = 684 * MiB, WS_KMT8 = 700 * MiB;
namespace att { constexpr float MB8_QS = 0.08838834764831845f * LOG2E * 16.0f; }
constexpr bool O78F8 = true;
constexpr float F8_SAD = 16.0f, F8_SAM = 64.0f, F8_SWO = 32.0f, F8_SG = 16.0f, F8_SWOUT = 64.0f;
constexpr bool P2F8 = true;
constexpr float DS2 = 1.0f;
constexpr int P2_EXP = 9;
constexpr size_t WS_SHACT = 860 * MiB;
constexpr size_t WS_SHOUT = 588 * MiB;
constexpr size_t WS_Y = 204 * MiB;
constexpr size_t WS_END = 928 * MiB;
static_assert(WS_Y + (size_t)131072 * 2048 * 2 <= WS_ACT, "Y must not reach ACT");
static_assert(WS_ACT + (size_t)147456 * 512 * 2 <= WS_SHACT && WS_SHACT + (size_t)T * 512 * 2 <= WS_END, "act map");
static_assert(WS_PARTS + (size_t)T * 8 * 4 * 128 * 2 <= WS_VDT, "parts overlay");

constexpr int CW_BAR = 4096;
constexpr int CW_ECNT = 8192;
constexpr int CW_MCNT = 8448;
constexpr int CW_AQ = 9216;
constexpr int CW_CQ = 9216 + 64 * 8;

constexpr int RING_BYTES = 131072;
constexpr int LDSX_OFF = RING_BYTES;
constexpr int MISC_OFF = RING_BYTES + 16384;
constexpr int LDS_BYTES = MISC_OFF + 128;

#define LDS_WAIT() asm volatile("s_waitcnt lgkmcnt(0)" ::: "memory")
#define VM_WAIT() asm volatile("s_waitcnt vmcnt(0)" ::: "memory")
#define RLX_AGENT __ATOMIC_RELAXED, __HIP_MEMORY_SCOPE_AGENT

__device__ __forceinline__ unsigned cvtpk(float lo, float hi) { f32x2 v = {lo, hi}; bf16x2_t b = __builtin_convertvector(v, bf16x2_t); return __builtin_bit_cast(unsigned, b); }
__device__ __forceinline__ float bf_lo(unsigned u) { return __uint_as_float(u << 16); }
__device__ __forceinline__ float bf_hi(unsigned u) { return __uint_as_float(u & 0xffff0000u); }
__device__ __forceinline__ float wave_sum(float v) {
#pragma unroll
    for (int o = 1; o < 64; o <<= 1) v += __shfl_xor(v, o);
    return v;
}
__device__ __forceinline__ float fast_exp2(float x) { return __builtin_amdgcn_exp2f(x); }
__device__ __forceinline__ float fast_rcp(float x) { return __builtin_amdgcn_rcpf(x); }
__device__ __forceinline__ float sigmoidf_(float x) { return fast_rcp(1.0f + fast_exp2(-x * LOG2E)); }
__device__ __forceinline__ float siluf_(float x) { return x * sigmoidf_(x); }

#define XB_TMO      128
#define XB_XCNT(j)  (256  + 64 * (j))
#define XB_XSUB(j)  (1280 + 64 * (j))
#define XB_XGEN(j)  (2304 + 64 * (j))
#define XB_TOP      3328
#define XB_TOPGEN   3392
#define XCD_BAR_WORDS 3456
#define XB_SPIN_CAP (1u << 22)

__device__ __forceinline__ unsigned xb_ld(unsigned* p)              { return __hip_atomic_load(p, __ATOMIC_RELAXED, __HIP_MEMORY_SCOPE_AGENT); }
__device__ __forceinline__ unsigned xb_add(unsigned* p, unsigned v) { return __hip_atomic_fetch_add(p, v, __ATOMIC_RELAXED, __HIP_MEMORY_SCOPE_AGENT); }
__device__ __forceinline__ unsigned xb_xcc_id() { return (unsigned)__builtin_amdgcn_s_getreg((3 << 11) | 20) & 0xFu; }
#define XB_SPIN(cond, bar) do { unsigned _sp = 0; while (cond) { __builtin_amdgcn_s_sleep(1); \
    if ((++_sp & 255u) == 0u) { if (xb_ld(&(bar)[XB_TMO])) break; if (_sp > XB_SPIN_CAP) { atomicAdd(&(bar)[XB_TMO], 1u); break; } } } } while (0)

struct XcdBarrier { unsigned* bar; unsigned x; volatile LAS unsigned* st; };

__device__ __forceinline__ XcdBarrier xcd_barrier_post(unsigned* bar, volatile LAS unsigned* st) {
    XcdBarrier b; b.bar = bar; b.x = xb_xcc_id(); b.st = st;
    if (threadIdx.x == 0) (void)xb_add(&bar[XB_XCNT(b.x)], 1u);
    return b;
}
__device__ __forceinline__ void xcd_barrier_complete(unsigned* bar, unsigned x, unsigned& nloc, unsigned& nx) {
    const unsigned G = gridDim.x * gridDim.y * gridDim.z;
    unsigned sum, cnt, mine, sp = 0u;
    for (;;) {
        sum = 0u; cnt = 0u; mine = 0u;
#pragma unroll
        for (unsigned j = 0; j < 16; ++j) { const unsigned c = xb_ld(&bar[XB_XCNT(j)]); sum += c; cnt += (c > 0u) ? 1u : 0u; mine = (j == x) ? c : mine; }
        if (sum == G) break;
        __builtin_amdgcn_s_sleep(1);
        if ((++sp & 255u) == 0u) { if (xb_ld(&bar[XB_TMO])) break; if (sp > XB_SPIN_CAP) { atomicAdd(&bar[XB_TMO], 1u); break; } }
    }
    nloc = mine > 0u ? mine : 1u; nx = cnt > 0u ? cnt : 1u;
}
__device__ __forceinline__ void xcd_barrier(const XcdBarrier& b) {
    asm volatile("s_waitcnt vmcnt(0)" ::: "memory");
    __syncthreads();
    if (threadIdx.x == 0) {
        unsigned* bar = b.bar;
        __builtin_amdgcn_s_waitcnt(0);
        unsigned nloc = b.st[0], nx = b.st[1];
        if (nloc == 0u) { xcd_barrier_complete(bar, b.x, nloc, nx); b.st[0] = nloc; b.st[1] = nx; }
        const unsigned old = xb_add(&bar[XB_XSUB(b.x)], 1u);
        const unsigned gen = old / nloc;
        if (old + 1u == (gen + 1u) * nloc) {
            __builtin_amdgcn_fence(__ATOMIC_RELEASE, "agent");
            asm volatile("s_waitcnt vmcnt(0)" ::: "memory");
            const unsigned og = xb_add(&bar[XB_TOP], 1u);
            const unsigned tg = og / nx;
            if (og + 1u == (tg + 1u) * nx) xb_add(&bar[XB_TOPGEN], 1u);
            else XB_SPIN(xb_ld(&bar[XB_TOPGEN]) == tg, bar);
            __builtin_amdgcn_fence(__ATOMIC_ACQUIRE, "agent");
            xb_add(&bar[XB_XGEN(b.x)], 1u);
            asm volatile("s_waitcnt vmcnt(0)" ::: "memory");
        } else {
            XB_SPIN(xb_ld(&bar[XB_XGEN(b.x)]) == gen, bar);
            __builtin_amdgcn_fence(__ATOMIC_ACQUIRE, "agent");
            asm volatile("s_waitcnt vmcnt(0)" ::: "memory");
        }
    }
    __syncthreads();
}

namespace pg8 {
constexpr int BM = 256, BK = 64, HALF = 128, HTB = HALF * BK * 2, STAGE_BYTES = 8 * HTB, NXCD = 8, WGM = 8;
static_assert(STAGE_BYTES == RING_BYTES, "ring");
__host__ __device__ __forceinline__ int lds_byte(int r, int c) { const int st = (r >> 4) * 2 + (c >> 5), rr = r & 15, cc = c & 31, ob = rr * 64 + cc * 2; return st * 1024 + (ob ^ (((ob >> 9) & 1) << 5)); }
__host__ __device__ __forceinline__ void stage_rc(int b, int& R, int& C) { const int st = b / 1024, sb = b % 1024, swz = sb ^ (((sb >> 9) & 1) << 5); R = (st >> 1) * 16 + swz / 64; C = (st & 1) * 32 + (swz % 64) / 2; }
__host__ __device__ __forceinline__ int perm32(int rho) { const int n = rho >> 4, i = rho & 15; return 8 * (i >> 2) + 4 * n + (i & 3); }

struct Unit { int pm, pn; const char* A; const char* B; int rowbase, valid, aux; };

struct StaticOrder {
    int nM, nN, nwg, G, c; const char* A; const char* B; size_t tstep;
    __device__ void init(const void* A_, const void* B_, int M, int N, int K, int G_, int c_) { A = (const char*)A_; B = (const char*)B_; nM = M / BM; nN = N / BM; nwg = nM * nN; G = G_; c = c_; tstep = (size_t)BM * K * 2; }
    __device__ bool next(int i, Unit& u) const {
        const long L = (long)i * G + c; if (L >= nwg) return false;
        int wgid = (int)L; { const int q = nwg / NXCD, r = nwg % NXCD, xcd = wgid % NXCD, off = wgid / NXCD; wgid = (xcd < r ? xcd * (q + 1) : r * (q + 1) + (xcd - r) * q) + off; }
        const int nig = WGM * nN, gid = wgid / nig, fm = gid * WGM, gsz = (nM - fm) < WGM ? (nM - fm) : WGM;
        u.pm = fm + ((wgid % nig) % gsz); u.pn = (wgid % nig) / gsz;
        u.A = A + (size_t)u.pm * tstep; u.B = B + (size_t)u.pn * tstep; u.rowbase = u.pm * BM; u.valid = BM; u.aux = 0; return true;
    }
};

struct PairOrder {
    StaticOrder base; const char* A1; const char* B1;
    __device__ void init(const void* A0_, const void* B0_, const void* A1_, const void* B1_, int M, int N, int K, int G_, int c_) { base.init(A0_, B0_, M, N, K, G_, c_); A1 = (const char*)A1_; B1 = (const char*)B1_; }
    __device__ bool next(int i, Unit& u) const {
        if (!base.next(i >> 1, u)) return false;
        if (i & 1) { u.A = A1 + (size_t)u.pm * base.tstep; u.B = B1 + (size_t)u.pn * base.tstep; u.aux = 1; }
        return true;
    }
};

template <class Epi, class Sched, bool ALIGN_EPI, bool SP2, bool GATHER, bool F8 = false>
__device__ __forceinline__ void gemm_phase(LAS unsigned char* lds, const int K, const Sched& S, const Epi& E, const LAS unsigned short* gtab) {
    int tid_ = threadIdx.x; asm volatile("" : "+v"(tid_));
    const int tid = tid_, wid = __builtin_amdgcn_readfirstlane(tid >> 6), lane = tid & 63, wr = wid >> 2, wc = wid & 3, fr = lane & 15, fq = lane >> 4;
    const int nt = K / BK;
    unsigned voffA[2], voffB[2]; int RA[2], CA[2];
#pragma unroll
    for (int i = 0; i < 2; ++i) { int R, C; stage_rc(tid * 16 + i * 8192, R, C); const int Rb = (int)Epi::PERM == 2 ? (64 * (R >> 5) + 16 * ((R >> 2) & 3) + 4 * ((R >> 4) & 1) + (R & 3)) : (Epi::PERM ? ((R & ~31) + perm32(R & 31)) : R);
        RA[i] = R; CA[i] = C; voffA[i] = (unsigned)(R * K + C) * 2u; voffB[i] = (unsigned)(Rb * K + C) * 2u; }
    const size_t kstep = (size_t)(BK * 2);
    const size_t hstep = (size_t)HALF * K * 2;
    const size_t hstepB = (int)Epi::PERM == 2 ? (size_t)8 * K * 2 : hstep;
    const unsigned ldsw = (unsigned)wid * 1024u;
    const int aoff = lds_byte(wr * 64 + fr, fq * 8), boff = lds_byte(wc * 32 + fr, fq * 8);
    unsigned vA[2][2], nvA[2][2];
#define PG8_SA(b, h) (((b) * 2 + (h)) * HTB)
#define PG8_SB(b, h) ((4 + (b) * 2 + (h)) * HTB)
#define PG8_GL(gp, ldsoff) __builtin_amdgcn_global_load_lds((const unsigned*)(gp), (LAS unsigned*)(lds + (ldsoff)), 16, 0, 0)
#define PG8_STAGE(bufoff, gbase, voff) do { _Pragma("unroll") for (int _i = 0; _i < 2; ++_i) PG8_GL((const char*)(gbase) + (voff)[_i], (bufoff) + ldsw + _i * 8192); } while (0)
#define PG8_STA(bufoff, gbase, h, nx) do { if constexpr (GATHER) { \
        const unsigned _o0 = (nx) ? nvA[h][0] : vA[h][0], _o1 = (nx) ? nvA[h][1] : vA[h][1]; \
        PG8_GL((const char*)(gbase) + _o0, (bufoff) + ldsw); PG8_GL((const char*)(gbase) + _o1, (bufoff) + ldsw + 8192); \
    } else { PG8_STAGE(bufoff, (const char*)(gbase) + (h) * hstep, voffA); } } while (0)
#define PG8_GVA(dst, ul) do { _Pragma("unroll") for (int _h = 0; _h < 2; ++_h) _Pragma("unroll") for (int _i = 0; _i < 2; ++_i) \
        dst[_h][_i] = (unsigned)gtab[(ul) * 256 + _h * 128 + RA[_i]] * (unsigned)(K * 2) + (unsigned)(CA[_i] * 2); } while (0)
#define PG8_LDA(dst, b, h) do { _Pragma("unroll") for (int m = 0; m < 4; ++m) _Pragma("unroll") for (int k = 0; k < 2; ++k) dst[m][k] = *(const LAS bf16x8*)(lds + PG8_SA(b, h) + aoff + m * 2048 + k * 1024); } while (0)
#define PG8_LDB(dst, b, h) do { _Pragma("unroll") for (int n = 0; n < 2; ++n) _Pragma("unroll") for (int k = 0; k < 2; ++k) dst[n][k] = *(const LAS bf16x8*)(lds + PG8_SB(b, h) + boff + n * 2048 + k * 1024); } while (0)
#define PG8_MMA(ai, bj, At, Bt) do { __builtin_amdgcn_s_setprio(1); _Pragma("unroll") for (int m = 0; m < 4; ++m) _Pragma("unroll") for (int n = 0; n < 2; ++n) { \
        if constexpr (F8) { const i32x4 _b0 = __builtin_bit_cast(i32x4, Bt[n][0]), _b1 = __builtin_bit_cast(i32x4, Bt[n][1]), _a0 = __builtin_bit_cast(i32x4, At[m][0]), _a1 = __builtin_bit_cast(i32x4, At[m][1]); \
            const i32x8 _b8 = __builtin_shufflevector(_b0, _b1, 0, 1, 2, 3, 4, 5, 6, 7), _a8 = __builtin_shufflevector(_a0, _a1, 0, 1, 2, 3, 4, 5, 6, 7); \
            asm volatile("v_mfma_scale_f32_16x16x128_f8f6f4 %0, %1, %2, %0, %3, %4 op_sel_hi:[0,0,0]" : "+v"(acc[ai][bj][m][n]) : "v"(_b8), "v"(_a8), "v"(f8sc), "v"(f8one)); } \
        else { _Pragma("unroll") for (int k = 0; k < 2; ++k) acc[ai][bj][m][n] = __builtin_amdgcn_mfma_f32_16x16x32_bf16(Bt[n][k], At[m][k], acc[ai][bj][m][n], 0, 0, 0); } } __builtin_amdgcn_s_setprio(0); } while (0)
#define PG8_WAIT_V(n) asm volatile("s_waitcnt vmcnt(" #n ")" ::: "memory")
#define PG8_WAIT_L(n) asm volatile("s_waitcnt lgkmcnt(" #n ")" ::: "memory")
#define PG8_BAR __builtin_amdgcn_s_barrier()
#define PG8_SCHED __builtin_amdgcn_sched_barrier(0)
    Unit cur, nxt; int ui = 0;
    if (!S.next(0, cur)) return;
    if constexpr (GATHER) { PG8_GVA(vA, 0); }
    int f8sc = 0x7F7F7F7F;
    const int f8one = 0x7F7F7F7F;
    f32x4 acc[2][2][4][2];
#pragma unroll
    for (int a = 0; a < 2; ++a)
#pragma unroll
        for (int b = 0; b < 2; ++b)
#pragma unroll
            for (int m = 0; m < 4; ++m)
#pragma unroll
                for (int n = 0; n < 2; ++n) acc[a][b][m][n] = (f32x4){0.f, 0.f, 0.f, 0.f};
    bf16x8 At[4][2], B0[2][2], B1[2][2];
    const char* cA = cur.A; const char* cB = cur.B;
    if constexpr (SP2) {
        PG8_STAGE(PG8_SB(0, 0), cB, voffB); PG8_STAGE(PG8_SB(0, 1), cB + hstepB, voffB); PG8_STA(PG8_SA(0, 0), cA, 0, false); PG8_STA(PG8_SA(0, 1), cA, 1, false);
        if (wr == 1) PG8_BAR;
        PG8_WAIT_V(2); PG8_BAR;
        PG8_STAGE(PG8_SB(1, 0), cB + kstep, voffB); PG8_STA(PG8_SA(1, 0), cA + kstep, 0, false); PG8_STAGE(PG8_SB(1, 1), cB + hstepB + kstep, voffB);
        PG8_WAIT_V(6); PG8_BAR;
    } else {
        PG8_STAGE(PG8_SB(0, 0), cB, voffB); PG8_STA(PG8_SA(0, 0), cA, 0, false); PG8_STAGE(PG8_SB(0, 1), cB + hstepB, voffB); PG8_STA(PG8_SA(0, 1), cA, 1, false);
        if (wr == 1) PG8_BAR;
        PG8_WAIT_V(4); PG8_BAR;
        PG8_STAGE(PG8_SB(1, 0), cB + kstep, voffB); PG8_STA(PG8_SA(1, 0), cA + kstep, 0, false); PG8_STAGE(PG8_SB(1, 1), cB + hstepB + kstep, voffB);
        PG8_WAIT_V(6); PG8_BAR;
    }
    for (;;) {
        if constexpr (F8) f8sc = 0x01010101 * (127 - E.f8exp(cur));
        bool has_next = false; const char* nA = cA; const char* nB = cB;
#define PG8_NEXT_UNIT() do { has_next = S.next(ui + 1, nxt); nA = has_next ? nxt.A : cA; nB = has_next ? nxt.B : cB; \
        if constexpr (GATHER) { if (has_next) { PG8_GVA(nvA, ui + 1); } else { _Pragma("unroll") for (int _h = 0; _h < 2; ++_h) _Pragma("unroll") for (int _i = 0; _i < 2; ++_i) nvA[_h][_i] = vA[_h][_i]; } } } while (0)
        if (nt < 4 || !SP2) PG8_NEXT_UNIT();
        for (int t = 0; t < nt; t += 2) {
            const bool last = (t == nt - 2);
            const char* a1 = cA + (size_t)(t + 1) * kstep;
            const char* a2 = last ? nA : cA + (size_t)(t + 2) * kstep; const char* b2 = last ? nB : cB + (size_t)(t + 2) * kstep;
            const char* a3 = a2 + kstep; const char* b3 = b2 + kstep;
            if constexpr (SP2) {
            PG8_LDB(B0, 0, 0); PG8_LDB(B1, 0, 1); PG8_SCHED; PG8_LDA(At, 0, 0); PG8_STA(PG8_SA(1, 1), a1, 1, false);
            PG8_WAIT_V(8); PG8_WAIT_L(0); PG8_BAR; PG8_MMA(0, 0, At, B0); PG8_MMA(0, 1, At, B1); if (t == 0 && nt >= 4) { PG8_SCHED; PG8_NEXT_UNIT(); PG8_SCHED; } PG8_BAR; PG8_SCHED;
            PG8_LDA(At, 0, 1); PG8_STAGE(PG8_SB(0, 0), b2, voffB); PG8_STAGE(PG8_SB(0, 1), b2 + hstepB, voffB); PG8_STA(PG8_SA(0, 0), a2, 0, last);
            PG8_WAIT_V(8); PG8_WAIT_L(0); PG8_BAR; PG8_MMA(1, 0, At, B0); PG8_MMA(1, 1, At, B1); PG8_BAR; PG8_SCHED;
            PG8_LDB(B0, 1, 0); PG8_LDB(B1, 1, 1); PG8_SCHED; PG8_LDA(At, 1, 0); PG8_STA(PG8_SA(0, 1), a2, 1, last);
            PG8_WAIT_V(8); PG8_WAIT_L(0); PG8_BAR; PG8_MMA(0, 0, At, B0); PG8_MMA(0, 1, At, B1); PG8_BAR; PG8_SCHED;
            PG8_LDA(At, 1, 1); PG8_STAGE(PG8_SB(1, 0), b3, voffB); PG8_STAGE(PG8_SB(1, 1), b3 + hstepB, voffB); PG8_STA(PG8_SA(1, 0), a3, 0, last);
            PG8_WAIT_V(8); PG8_WAIT_L(0); PG8_BAR; PG8_MMA(1, 0, At, B0); PG8_MMA(1, 1, At, B1); PG8_BAR; PG8_SCHED;
            } else {
            PG8_LDB(B0, 0, 0); PG8_SCHED; PG8_LDA(At, 0, 0); PG8_STA(PG8_SA(1, 1), a1, 1, false);
            PG8_WAIT_L(8); PG8_BAR; PG8_WAIT_L(0); PG8_MMA(0, 0, At, B0); PG8_BAR; PG8_SCHED;
            PG8_LDB(B1, 0, 1); PG8_STAGE(PG8_SB(0, 0), b2, voffB);
            PG8_BAR; PG8_WAIT_L(0); PG8_MMA(0, 1, At, B1); PG8_BAR;
            PG8_LDA(At, 0, 1); PG8_STA(PG8_SA(0, 0), a2, 0, last);
            PG8_BAR; PG8_WAIT_L(0); PG8_MMA(1, 0, At, B0); PG8_BAR; PG8_SCHED;
            PG8_STAGE(PG8_SB(0, 1), b2 + hstepB, voffB);
            PG8_WAIT_V(6); PG8_BAR; PG8_MMA(1, 1, At, B1); PG8_BAR;
            PG8_LDB(B0, 1, 0); PG8_SCHED; PG8_LDA(At, 1, 0); PG8_STA(PG8_SA(0, 1), a2, 1, last);
            PG8_WAIT_L(8); PG8_BAR; PG8_WAIT_L(0); PG8_MMA(0, 0, At, B0); PG8_BAR; PG8_SCHED;
            PG8_LDB(B1, 1, 1); PG8_STAGE(PG8_SB(1, 0), b3, voffB);
            PG8_BAR; PG8_WAIT_L(0); PG8_MMA(0, 1, At, B1); PG8_BAR;
            PG8_LDA(At, 1, 1); PG8_STA(PG8_SA(1, 0), a3, 0, last);
            PG8_BAR; PG8_WAIT_L(0); PG8_MMA(1, 0, At, B0); PG8_BAR; PG8_SCHED;
            PG8_STAGE(PG8_SB(1, 1), b3 + hstepB, voffB);
            PG8_WAIT_V(6); PG8_BAR; PG8_MMA(1, 1, At, B1); PG8_BAR;
            }
        }
        if constexpr (F8) asm volatile("s_nop 15\n\ts_nop 15" ::: "memory");
        if constexpr (ALIGN_EPI) { if (wr == 0) PG8_BAR; }
        { int l2 = lane; asm volatile("" : "+v"(l2)); E(acc, cur, wr, wc, l2 & 15, l2 >> 4); }
        if (!has_next) break;
#pragma unroll
        for (int a = 0; a < 2; ++a)
#pragma unroll
            for (int b = 0; b < 2; ++b)
#pragma unroll
                for (int m = 0; m < 4; ++m)
#pragma unroll
                    for (int n = 0; n < 2; ++n) acc[a][b][m][n] = (f32x4){0.f, 0.f, 0.f, 0.f};
        cur = nxt; cA = nA; cB = nB; ++ui;
        if constexpr (GATHER) {
#pragma unroll
            for (int _h = 0; _h < 2; ++_h)
#pragma unroll
                for (int _i = 0; _i < 2; ++_i) vA[_h][_i] = nvA[_h][_i];
        }
        if constexpr (ALIGN_EPI) { if (wr == 1) PG8_BAR; }
    }
    PG8_WAIT_V(0);
    if constexpr (!ALIGN_EPI) { if (wr == 0) PG8_BAR; }
    PG8_BAR;
#undef PG8_SA
#undef PG8_SB
#undef PG8_GL
#undef PG8_STAGE
#undef PG8_STA
#undef PG8_GVA
#undef PG8_LDA
#undef PG8_LDB
#undef PG8_MMA
#undef PG8_WAIT_V
#undef PG8_WAIT_L
#undef PG8_BAR
#undef PG8_SCHED
}
}
namespace epi {
__device__ __forceinline__ float clamp_f8(float v) { return __builtin_fminf(__builtin_fmaxf(v, -448.0f), 448.0f); }
__device__ __forceinline__ unsigned pack4_f8(float a, float b, float c, float d) { int w = __builtin_amdgcn_cvt_pk_fp8_f32(clamp_f8(a), clamp_f8(b), 0, false); return (unsigned)__builtin_amdgcn_cvt_pk_fp8_f32(clamp_f8(c), clamp_f8(d), w, true); }
using pg8::Unit;
template <int ACT> struct StoreBf16 {
    static constexpr bool PERM = true;
    bf16_t* O; int ldc;
    __device__ __forceinline__ int f8exp(const Unit&) const { return 8; }
    __device__ __forceinline__ void operator()(const f32x4 (&acc)[2][2][4][2], const Unit& u, int wr, int wc, int fr, int fq) const {
        const int row0 = u.pm * 256 + wr * 64 + fr, col0 = u.pn * 256 + wc * 32 + 8 * fq;
#pragma unroll
        for (int ai = 0; ai < 2; ++ai)
#pragma unroll
            for (int m = 0; m < 4; ++m) { bf16_t* rowp = O + (size_t)(row0 + ai * 128 + m * 16) * ldc + col0;
#pragma unroll
                for (int bj = 0; bj < 2; ++bj) { f32x4 v0 = acc[ai][bj][m][0], v1 = acc[ai][bj][m][1];
                    if (ACT == 1) {
#pragma unroll
                        for (int j = 0; j < 4; ++j) { v0[j] = sigmoidf_(v0[j] * DS2); v1[j] = sigmoidf_(v1[j] * DS2); } }
                    u32x4 w; w.x = cvtpk(v0[0], v0[1]); w.y = cvtpk(v0[2], v0[3]); w.z = cvtpk(v1[0], v1[1]); w.w = cvtpk(v1[2], v1[3]);
                    *(u32x4*)(rowp + bj * 128) = w; } }
    }
};
template <int MODE> struct GateMul {
    static constexpr bool PERM = true;
    const bf16_t* gate; int goff; const bf16_t* prev; bf16_t* O;
    __device__ __forceinline__ void operator()(const f32x4 (&acc)[2][2][4][2], const Unit& u, int wr, int wc, int fr, int fq) const {
        const int row0 = u.pm * 256 + wr * 64 + fr, col0 = u.pn * 256 + wc * 32 + 8 * fq;
#pragma unroll
        for (int ai = 0; ai < 2; ++ai)
#pragma unroll
            for (int m = 0; m < 4; ++m) { const size_t row = (size_t)(row0 + ai * 128 + m * 16);
#pragma unroll
                for (int bj = 0; bj < 2; ++bj) { const int col = col0 + bj * 128;
                    const u32x4 g = *(const u32x4*)(gate + row * 4096 + goff + col);
                    f32x4 v0 = acc[ai][bj][m][0], v1 = acc[ai][bj][m][1];
                    v0[0] *= bf_lo(g.x); v0[1] *= bf_hi(g.x); v0[2] *= bf_lo(g.y); v0[3] *= bf_hi(g.y);
                    v1[0] *= bf_lo(g.z); v1[1] *= bf_hi(g.z); v1[2] *= bf_lo(g.w); v1[3] *= bf_hi(g.w);
                    if (MODE == 1) { const u32x4 p = *(const u32x4*)(prev + row * 2048 + col);
                        v0[0] += bf_lo(p.x); v0[1] += bf_hi(p.x); v0[2] += bf_lo(p.y); v0[3] += bf_hi(p.y);
                        v1[0] += bf_lo(p.z); v1[1] += bf_hi(p.z); v1[2] += bf_lo(p.w); v1[3] += bf_hi(p.w); }
                    if (O78F8 && MODE == 1) { *(u32x2*)((unsigned char*)O + row * 2048 + col) = (u32x2){pack4_f8(v0[0] * F8_SG, v0[1] * F8_SG, v0[2] * F8_SG, v0[3] * F8_SG), pack4_f8(v1[0] * F8_SG, v1[1] * F8_SG, v1[2] * F8_SG, v1[3] * F8_SG)}; }
                    else { u32x4 w; w.x = cvtpk(v0[0], v0[1]); w.y = cvtpk(v0[2], v0[3]); w.z = cvtpk(v1[0], v1[1]); w.w = cvtpk(v1[2], v1[3]);
                    *(u32x4*)(O + row * 2048 + col) = w; } } }
    }
};
struct Resid {
    static constexpr bool PERM = false;
    const float* base; float* out; const float* gate; int goff;
    __device__ __forceinline__ void operator()(const f32x4 (&acc)[2][2][4][2], const Unit& u, int wr, int wc, int fr, int fq) const {
        const int row0 = u.pm * 256 + wr * 64 + fr, col0 = u.pn * 256 + wc * 32 + 4 * fq;
        const int b = (u.pm * 256) / SEQ;
        f32x4 gv[2][2];
#pragma unroll
        for (int bj = 0; bj < 2; ++bj)
#pragma unroll
            for (int n = 0; n < 2; ++n) gv[bj][n] = *(const f32x4*)(gate + (size_t)b * 12288 + goff + col0 + bj * 128 + n * 16);
#pragma unroll
        for (int ai = 0; ai < 2; ++ai)
#pragma unroll
            for (int m = 0; m < 4; ++m) { const size_t off = (size_t)(row0 + ai * 128 + m * 16) * 2048 + col0;
#pragma unroll
                for (int bj = 0; bj < 2; ++bj)
#pragma unroll
                    for (int n = 0; n < 2; ++n) { const f32x4 bs = *(const f32x4*)(base + off + bj * 128 + n * 16);
                        *(f32x4*)(out + off + bj * 128 + n * 16) = bs + gv[bj][n] * acc[ai][bj][m][n]; } }
    }
};
struct SwiGLU {
    static constexpr bool PERM = true;
    bf16_t* O;
    __device__ __forceinline__ void operator()(const f32x4 (&acc)[2][2][4][2], const Unit& u, int wr, int wc, int fr, int fq) const {
        const int r0 = wr * 64 + fr, col0 = u.pn * 128 + wc * 32 + 8 * fq;
#pragma unroll
        for (int ai = 0; ai < 2; ++ai)
#pragma unroll
            for (int m = 0; m < 4; ++m) { const int r = r0 + ai * 128 + m * 16;
                f32x4 v0, v1;
#pragma unroll
                for (int j = 0; j < 4; ++j) { v0[j] = siluf_(acc[ai][0][m][0][j]) * acc[ai][1][m][0][j]; v1[j] = siluf_(acc[ai][0][m][1][j]) * acc[ai][1][m][1][j]; }
                u32x4 w; w.x = cvtpk(v0[0], v0[1]); w.y = cvtpk(v0[2], v0[3]); w.z = cvtpk(v1[0], v1[1]); w.w = cvtpk(v1[2], v1[3]);
                if (r < u.valid) *(u32x4*)(O + (size_t)(u.rowbase + r) * 512 + col0) = w; }
    }
};
struct SwiGLU8 {
    static constexpr bool PERM = true;
    unsigned char* O;
    __device__ __forceinline__ int f8exp(const Unit&) const { return 9; }
    __device__ __forceinline__ void operator()(const f32x4 (&acc)[2][2][4][2], const Unit& u, int wr, int wc, int fr, int fq) const {
        const int r0 = wr * 64 + fr, col0 = u.pn * 128 + wc * 32 + 8 * fq;
        constexpr float ds = 1.0f, us = F8_SA;
#pragma unroll
        for (int ai = 0; ai < 2; ++ai)
#pragma unroll
            for (int m = 0; m < 4; ++m) { const int r = r0 + ai * 128 + m * 16;
                f32x4 v0, v1;
#pragma unroll
                for (int j = 0; j < 4; ++j) { v0[j] = siluf_(acc[ai][0][m][0][j] * ds) * (acc[ai][1][m][0][j] * us); v1[j] = siluf_(acc[ai][0][m][1][j] * ds) * (acc[ai][1][m][1][j] * us); }
                if (r < u.valid) *(u32x2*)(O + (size_t)(u.rowbase + r) * 512 + col0) = (u32x2){pack4_f8(v0[0], v0[1], v0[2], v0[3]), pack4_f8(v1[0], v1[1], v1[2], v1[3])}; }
    }
};
struct DownY {
    static constexpr int PERM = 2;
    unsigned char* O;
    __device__ __forceinline__ int f8exp(const Unit&) const { return 8; }
    __device__ __forceinline__ void operator()(const f32x4 (&acc)[2][2][4][2], const Unit& u, int wr, int wc, int fr, int fq) const {
        const int r0 = wr * 64 + fr, col0 = u.pn * 256 + wc * 64 + 16 * fq;
#pragma unroll
        for (int ai = 0; ai < 2; ++ai)
#pragma unroll
            for (int m = 0; m < 4; ++m) { const int r = r0 + ai * 128 + m * 16;
                if (r < u.valid) {
                    const f32x4 v0 = acc[ai][0][m][0], v1 = acc[ai][0][m][1], v2 = acc[ai][1][m][0], v3 = acc[ai][1][m][1];
                    int w0 = __builtin_amdgcn_cvt_pk_fp8_f32(v0[0], v0[1], 0, false); w0 = __builtin_amdgcn_cvt_pk_fp8_f32(v0[2], v0[3], w0, true);
                    int w1 = __builtin_amdgcn_cvt_pk_fp8_f32(v1[0], v1[1], 0, false); w1 = __builtin_amdgcn_cvt_pk_fp8_f32(v1[2], v1[3], w1, true);
                    int w2 = __builtin_amdgcn_cvt_pk_fp8_f32(v2[0], v2[1], 0, false); w2 = __builtin_amdgcn_cvt_pk_fp8_f32(v2[2], v2[3], w2, true);
                    int w3 = __builtin_amdgcn_cvt_pk_fp8_f32(v3[0], v3[1], 0, false); w3 = __builtin_amdgcn_cvt_pk_fp8_f32(v3[2], v3[3], w3, true);
                    *(u32x4*)(O + (size_t)(u.rowbase + r) * 2048 + col0) = (u32x4){(unsigned)w0, (unsigned)w1, (unsigned)w2, (unsigned)w3}; } }
    }
};
struct DownShared8 {
    static constexpr int PERM = 2;
    unsigned char* O;
    __device__ __forceinline__ int f8exp(const Unit&) const { return 8; }
    __device__ __forceinline__ void operator()(const f32x4 (&acc)[2][2][4][2], const Unit& u, int wr, int wc, int fr, int fq) const {
        const int r0 = u.pm * 256 + wr * 64 + fr, col0 = u.pn * 256 + wc * 64 + 16 * fq;
#pragma unroll
        for (int ai = 0; ai < 2; ++ai)
#pragma unroll
            for (int m = 0; m < 4; ++m) { const int r = r0 + ai * 128 + m * 16;
                const f32x4 v0 = acc[ai][0][m][0], v1 = acc[ai][0][m][1], v2 = acc[ai][1][m][0], v3 = acc[ai][1][m][1];
                *(u32x4*)(O + (size_t)r * 2048 + col0) = (u32x4){pack4_f8(v0[0], v0[1], v0[2], v0[3]), pack4_f8(v1[0], v1[1], v1[2], v1[3]), pack4_f8(v2[0], v2[1], v2[2], v2[3]), pack4_f8(v3[0], v3[1], v3[2], v3[3])}; }
    }
};
struct StoreQK {
    static constexpr bool PERM = true;
    bf16_t* Q; bf16_t* KT; float qscale;
    __device__ __forceinline__ void operator()(const f32x4 (&acc)[2][2][4][2], const Unit& u, int wr, int wc, int fr, int fq) const {
        const int row0 = u.pm * 256 + wr * 64 + fr, col0 = u.pn * 256 + wc * 32 + 8 * fq;
        const bool isk = (u.pn >= 4);
#pragma unroll
        for (int ai = 0; ai < 2; ++ai)
#pragma unroll
            for (int m = 0; m < 4; ++m) { const int row = row0 + ai * 128 + m * 16;
#pragma unroll
                for (int bj = 0; bj < 2; ++bj) { const float sc = (isk ? 1.0f : qscale) * DS2; const f32x4 v0 = acc[ai][bj][m][0] * sc, v1 = acc[ai][bj][m][1] * sc; const int col = col0 + bj * 128;
                    u32x4 w; w.x = cvtpk(v0[0], v0[1]); w.y = cvtpk(v0[2], v0[3]); w.z = cvtpk(v1[0], v1[1]); w.w = cvtpk(v1[2], v1[3]);
                    bf16_t* p = isk ? KT + ((((size_t)((col - 1024) >> 7) * 256 + (row >> 6)) * 64 + (row & 63)) * 128 + (col & 127)) : Q + (size_t)row * 1024 + col;
                    *(u32x4*)p = w; } }
    }
};
struct StoreQK8 {
    static constexpr bool PERM = true;
    unsigned char* Q; unsigned char* KT; float qs, ks;
    __device__ __forceinline__ void operator()(const f32x4 (&acc)[2][2][4][2], const Unit& u, int wr, int wc, int fr, int fq) const {
        const int row0 = u.pm * 256 + wr * 64 + fr, col0 = u.pn * 256 + wc * 32 + 8 * fq;
        const bool isk = (u.pn >= 4);
#pragma unroll
        for (int ai = 0; ai < 2; ++ai)
#pragma unroll
            for (int m = 0; m < 4; ++m) { const int row = row0 + ai * 128 + m * 16;
#pragma unroll
                for (int bj = 0; bj < 2; ++bj) { const float sc = isk ? 1.0f : qs;        const f32x4 v0 = acc[ai][bj][m][0] * sc, v1 = acc[ai][bj][m][1] * sc; const int col = col0 + bj * 128;
                    unsigned char* p = isk ? KT + ((((size_t)((col - 1024) >> 7) * 256 + (row >> 6)) * 64 + (row & 63)) * 128 + (col & 127)) : Q + (size_t)row * 1024 + col;
                    *(u32x2*)p = (u32x2){pack4_f8(v0[0], v0[1], v0[2], v0[3]), pack4_f8(v1[0], v1[1], v1[2], v1[3])}; }
                __builtin_amdgcn_sched_barrier(0); }
    }
};
struct StoreQKboth {
    static constexpr bool PERM = true;
    StoreQK b16; unsigned char* Q8; unsigned char* KT8;
    __device__ __forceinline__ void operator()(const f32x4 (&acc)[2][2][4][2], const Unit& u, int wr, int wc, int fr, int fq) const {
        b16(acc, u, wr, wc, fr, fq);
        const int row0 = u.pm * 256 + wr * 64 + fr, col0 = u.pn * 256 + wc * 32 + 8 * fq;
        const bool isk = (u.pn >= 4);
        const float sc = isk ? att::D8_KS : att::MB8_QS;
#pragma unroll
        for (int ai = 0; ai < 2; ++ai)
#pragma unroll
            for (int m = 0; m < 4; ++m) { const int row = row0 + ai * 128 + m * 16;
#pragma unroll
                for (int bj = 0; bj < 2; ++bj) { const f32x4 v0 = acc[ai][bj][m][0] * sc, v1 = acc[ai][bj][m][1] * sc; const int col = col0 + bj * 128;
                    unsigned char* p = isk ? KT8 + ((((size_t)((col - 1024) >> 7) * 256 + (row >> 6)) * 64 + (row & 63)) * 128 + (col & 127)) : Q8 + (size_t)row * 1024 + col;
                    *(u32x2*)p = (u32x2){pack4_f8(v0[0], v0[1], v0[2], v0[3]), pack4_f8(v1[0], v1[1], v1[2], v1[3])}; }
                __builtin_amdgcn_sched_barrier(0); }
    }
};
struct StoreVT8 {
    static constexpr bool PERM = true;
    unsigned char* VT; float vs;
    __device__ __forceinline__ void operator()(const f32x4 (&acc)[2][2][4][2], const Unit& u, int wr, int wc, int fr, int fq) const {
        const int row0 = u.pm * 256 + wr * 64 + fr, col0 = u.pn * 256 + wc * 32 + 8 * fq;
#pragma unroll
        for (int ai = 0; ai < 2; ++ai)
#pragma unroll
            for (int m = 0; m < 4; ++m) { const int f = row0 + ai * 128 + m * 16;
#pragma unroll
                for (int bj = 0; bj < 2; ++bj) { const f32x4 v0 = acc[ai][bj][m][0], v1 = acc[ai][bj][m][1]; const int tok = col0 + bj * 128, k = tok & 63;
                    unsigned char* p = VT + ((((size_t)(f >> 7) * 256 + (tok >> 6)) * 128 + (f & 127)) * 64 + (k >> 5) * 16 + ((k & 31) >> 3) * 4);
                    *(unsigned*)p = pack4_f8(v0[0], v0[1], v0[2], v0[3]); *(unsigned*)(p + 32) = pack4_f8(v1[0], v1[1], v1[2], v1[3]); }
                __builtin_amdgcn_sched_barrier(0); }
    }
};
struct StoreVT {
    static constexpr bool PERM = true;
    bf16_t* VT;
    __device__ __forceinline__ void operator()(const f32x4 (&acc)[2][2][4][2], const Unit& u, int wr, int wc, int fr, int fq) const {
        const int row0 = u.pm * 256 + wr * 64 + fr, col0 = u.pn * 256 + wc * 32 + 8 * fq;
#pragma unroll
        for (int ai = 0; ai < 2; ++ai)
#pragma unroll
            for (int m = 0; m < 4; ++m) { const int f = row0 + ai * 128 + m * 16;
#pragma unroll
                for (int bj = 0; bj < 2; ++bj) { const f32x4 v0 = acc[ai][bj][m][0] * DS2, v1 = acc[ai][bj][m][1] * DS2; const int tok = col0 + bj * 128;
                    u32x4 w; w.x = cvtpk(v0[0], v0[1]); w.y = cvtpk(v0[2], v0[3]); w.z = cvtpk(v1[0], v1[1]); w.w = cvtpk(v1[2], v1[3]);
                    *(u32x4*)(VT + ((((size_t)(f >> 7) * 256 + (tok >> 6)) * 128 + (f & 127)) * 64 + (tok & 63))) = w; } }
    }
};
struct ProjEpi {
    static constexpr bool PERM = true, HAS_MID = false;
    StoreQK8 qkd; StoreQKboth qkm; StoreBf16<1> gates;
    __device__ __forceinline__ int f8exp(const Unit& u) const { return (u.pn >= 4 && u.pn < 8) ? P2_EXP - 2 : P2_EXP; }
    __device__ __forceinline__ void operator()(const f32x4 (&acc)[2][2][4][2], const Unit& u, int wr, int wc, int fr, int fq) const {
        Unit v = u;
        if (u.pn < 8) qkd(acc, v, wr, wc, fr, fq);
        else if (u.pn < 16) { v.pn = u.pn - 8; qkm(acc, v, wr, wc, fr, fq); }
        else { v.pn = u.pn - 16; gates(acc, v, wr, wc, fr, fq); }
    }
};
struct ProjVT {
    static constexpr bool PERM = true, HAS_MID = false;
    StoreVT8 vd; StoreVT8 vm;
    __device__ __forceinline__ int f8exp(const Unit& u) const { return P2_EXP - 3; }
    __device__ __forceinline__ void operator()(const f32x4 (&acc)[2][2][4][2], const Unit& u, int wr, int wc, int fr, int fq) const {
        Unit v = u;
        if (u.pm < 4) vd(acc, v, wr, wc, fr, fq); else { v.pm = u.pm - 4; vm(acc, v, wr, wc, fr, fq); }
    }
};
struct GatePair {
    static constexpr bool PERM = true, HAS_MID = false;
    GateMul<0> e0; GateMul<1> e1;
    __device__ __forceinline__ int f8exp(const Unit& u) const { return u.aux == 0 ? 9 : 11; }
    __device__ __forceinline__ void operator()(const f32x4 (&acc)[2][2][4][2], const Unit& u, int wr, int wc, int fr, int fq) const {
        if (u.aux == 0) e0(acc, u, wr, wc, fr, fq); else e1(acc, u, wr, wc, fr, fq);
    }
};
struct ResidBf16 {
    static constexpr bool PERM = true, HAS_MID = false;
    const float* base; bf16_t* out; const float* gate; int goff;
    __device__ __forceinline__ int f8exp(const Unit&) const { return 10; }
    __device__ __forceinline__ void operator()(const f32x4 (&acc)[2][2][4][2], const Unit& u, int wr, int wc, int fr, int fq) const {
        const int row0 = u.pm * 256 + wr * 64 + fr, col0 = u.pn * 256 + wc * 32 + 8 * fq;
        const int b = (u.pm * 256) / SEQ;
        f32x4 gv[2][2];
#pragma unroll
        for (int bj = 0; bj < 2; ++bj)
#pragma unroll
            for (int n = 0; n < 2; ++n) gv[bj][n] = *(const f32x4*)(gate + (size_t)b * 12288 + goff + col0 + bj * 128 + n * 4);
#pragma unroll
        for (int ai = 0; ai < 2; ++ai)
#pragma unroll
            for (int m = 0; m < 4; ++m) { const size_t off = (size_t)(row0 + ai * 128 + m * 16) * 2048 + col0;
#pragma unroll
                for (int bj = 0; bj < 2; ++bj) {
                    const f32x4 b0 = *(const f32x4*)(base + off + bj * 128), b1 = *(const f32x4*)(base + off + bj * 128 + 4);
                    const f32x4 v0 = b0 + gv[bj][0] * acc[ai][bj][m][0], v1 = b1 + gv[bj][1] * acc[ai][bj][m][1];
                    u32x4 w; w.x = cvtpk(v0[0], v0[1]); w.y = cvtpk(v0[2], v0[3]); w.z = cvtpk(v1[0], v1[1]); w.w = cvtpk(v1[2], v1[3]);
                    *(u32x4*)(out + off + bj * 128) = w; } }
    }
};
}
namespace att {
constexpr int KROW = 272;
constexpr int VROW = 144;
constexpr int KBUF = 64 * KROW;
constexpr int VBUF = 128 * VROW;
constexpr int OFF_K = 0, OFF_V = 2 * KBUF, OFF_TAB = OFF_V + 2 * VBUF, OFF_G = OFF_TAB + 512, OFF_END = OFF_G + 512;
static_assert(OFF_END <= RING_BYTES, "attention LDS");
__device__ __forceinline__ int crow(int i, int hh) { return (i & 3) + 8 * (i >> 2) + 4 * hh; }

__device__ __forceinline__ int t5_bucket(int n) {
    if (n < 16) return n;
    int b = 16;
    b += (n >= 19); b += (n >= 21); b += (n >= 24); b += (n >= 27); b += (n >= 31); b += (n >= 35); b += (n >= 40); b += (n >= 46);
    b += (n >= 52); b += (n >= 59); b += (n >= 67); b += (n >= 77); b += (n >= 87); b += (n >= 99); b += (n >= 113);
    return b;
}
__device__ __forceinline__ void fill_bias_tab(LAS float* tab, const float* rel_bias, int col) {
    if (threadIdx.x < 128) { const int n = threadIdx.x; tab[n] = (rel_bias[t5_bucket(n) * 16 + col] - rel_bias[31 * 16 + col]) * LOG2E; }
}

struct TileRegs { u32x4 k[2]; u32x4 v[2]; };
__device__ __forceinline__ void tile_load(TileRegs& R, const bf16_t* kt, const bf16_t* vt, int tid) {
#pragma unroll
    for (int i = 0; i < 2; ++i) { const int c = tid + 512 * i; R.k[i] = *(const u32x4*)(kt + c * 8); }
#pragma unroll
    for (int i = 0; i < 2; ++i) { const int c = tid + 512 * i; R.v[i] = *(const u32x4*)(vt + c * 8); }
}
__device__ __forceinline__ void tile_store(const TileRegs& R, LAS unsigned char* kb, LAS unsigned char* vb, int tid) {
#pragma unroll
    for (int i = 0; i < 2; ++i) { const int c = tid + 512 * i; *(LAS u32x4*)(kb + (c >> 4) * KROW + (c & 15) * 16) = R.k[i]; }
#pragma unroll
    for (int i = 0; i < 2; ++i) { const int c = tid + 512 * i;
        LAS unsigned char* p = vb + (c >> 3) * VROW + ((c & 7) >> 1) * 32 + (c & 1) * 8;
        *(LAS u32x2*)p = (u32x2){R.v[i].x, R.v[i].y}; *(LAS u32x2*)(p + 16) = (u32x2){R.v[i].z, R.v[i].w}; }
}

template <int NMAP, int KS>
__device__ __forceinline__ void attn_half(const LAS unsigned char* kb, const LAS unsigned char* vb, int kh, const bf16x8 (&qf)[NMAP][KS], f32x16 (&O)[NMAP][4],
                                          float (&mrun)[NMAP], float (&lrun)[NMAP], int qpos, int kvpos0, bool need_mask, bool need_bias, const LAS float* btab, float sc, int r, int hh, int kcolbase) {
    bf16x8 P[NMAP][2];
#pragma unroll
    for (int m = 0; m < NMAP; ++m) {
        f32x16 s;
#pragma unroll
        for (int i = 0; i < 16; ++i) s[i] = 0.f;
#pragma unroll
        for (int ks = 0; ks < KS; ++ks) {
            const bf16x8 kf = *(const LAS bf16x8*)(kb + (32 * kh + r) * KROW + (kcolbase + m * 16 * KS + 16 * ks + 8 * hh) * 2);
            s = __builtin_amdgcn_mfma_f32_32x32x16_bf16(kf, qf[m][ks], s, 0, 0, 0);
        }
#pragma unroll
        for (int i = 0; i < 16; ++i) s[i] *= sc;
        if (need_bias) {
#pragma unroll
            for (int i = 0; i < 16; ++i) { int rel = qpos - (kvpos0 + crow(i, hh)); rel = rel < 0 ? 0 : (rel > 127 ? 127 : rel); s[i] += btab[rel]; }
        }
        if (need_mask) {
#pragma unroll
            for (int i = 0; i < 16; ++i) { if (kvpos0 + crow(i, hh) > qpos) s[i] = -INFINITY; }
        }
        float mx = s[0];
#pragma unroll
        for (int i = 1; i < 16; ++i) mx = fmaxf(mx, s[i]);
        mx = fmaxf(mx, __shfl_xor(mx, 32));
        const float mnew = fmaxf(mrun[m], mx);
        const float alpha = fast_exp2(mrun[m] - mnew);
        float sum = 0.f;
#pragma unroll
        for (int i = 0; i < 16; ++i) { const float p = fast_exp2(s[i] - mnew); sum += p; s[i] = p; }
        lrun[m] = lrun[m] * alpha + sum; mrun[m] = mnew;
#pragma unroll
        for (int dt = 0; dt < 4; ++dt)
#pragma unroll
            for (int i = 0; i < 16; ++i) O[m][dt][i] *= alpha;
#pragma unroll
        for (int st = 0; st < 2; ++st) { u32x4 w; w.x = cvtpk(s[8 * st + 0], s[8 * st + 1]); w.y = cvtpk(s[8 * st + 2], s[8 * st + 3]); w.z = cvtpk(s[8 * st + 4], s[8 * st + 5]); w.w = cvtpk(s[8 * st + 6], s[8 * st + 7]);
            P[m][st] = __builtin_bit_cast(bf16x8, w); }
    }
#pragma unroll
    for (int dt = 0; dt < 4; ++dt)
#pragma unroll
        for (int st = 0; st < 2; ++st) {
            const bf16x8 vf = *(const LAS bf16x8*)(vb + (32 * dt + r) * VROW + (2 * kh + st) * 32 + hh * 16);
#pragma unroll
            for (int m = 0; m < NMAP; ++m) O[m][dt] = __builtin_amdgcn_mfma_f32_32x32x16_bf16(vf, P[m][st], O[m][dt], 0, 0, 0);
        }
}

#define SBAR() __builtin_amdgcn_sched_barrier(0)
constexpr int TBUF = KBUF + VBUF;
constexpr int D_OFF_TAB = 3 * TBUF, D_OFF_G = D_OFF_TAB + 512;
static_assert(D_OFF_G + 512 <= RING_BYTES, "diff attention LDS");
constexpr float D_C = 0.125f * LOG2E;
__device__ __forceinline__ void d_load_kf(bf16x8 (&kf)[4], const LAS unsigned char* kb, int kh, int r, int hh, int kcol) {
#pragma unroll
    for (int ks = 0; ks < 4; ++ks) kf[ks] = *(const LAS bf16x8*)(kb + (32 * kh + r) * KROW + (kcol + 16 * ks + 8 * hh) * 2);
}
constexpr float D_THR = 8.0f;
__device__ __forceinline__ float max3_(float a, float b, float c) { float r; asm("v_max3_f32 %0, %1, %2, %3" : "=v"(r) : "v"(a), "v"(b), "v"(c)); return r; }
template <int MODE, bool LOADV, bool PREFK>
__device__ __forceinline__ void d_half_a(const bf16x8 (&kf)[4], bf16x8 (&kfn)[4], const LAS unsigned char* knext, int khn, const LAS unsigned char* vb, int kh,
                                         const bf16x8 (&qf)[4], f32x16 (&o)[4], float& mref, float& lrun, int qpos, int kvpos0, bool need_mask, bool need_bias, bool first,
                                         const LAS float* btab, int r, int hh, int kcol, bf16x8 (&vf)[4], bf16x8 (&P)[2]) {
    if (LOADV) {
#pragma unroll
        for (int dt = 0; dt < 2; ++dt)
#pragma unroll
            for (int st = 0; st < 2; ++st) vf[2 * dt + st] = *(const LAS bf16x8*)(vb + (32 * dt + r) * VROW + (2 * kh + st) * 32 + hh * 16);
    }
    SBAR();
    f32x16 s;
#pragma unroll
    for (int i = 0; i < 16; ++i) s[i] = 0.f;
    __builtin_amdgcn_s_setprio(1);
#pragma unroll
    for (int ks = 0; ks < 4; ++ks) { if (MODE != 3) s = __builtin_amdgcn_mfma_f32_32x32x16_bf16(kf[ks], qf[ks], s, 0, 0, 0); else { s[ks] += __builtin_bit_cast(float, (int)kf[ks][0]); s[4 + ks] += __builtin_bit_cast(float, (int)qf[ks][1]); } }
    __builtin_amdgcn_s_setprio(0);
    if (PREFK) d_load_kf(kfn, knext, khn, r, hh, kcol);
    SBAR();
    if (MODE == 4) { P[0] = qf[0]; P[1] = qf[1]; mref = fmaxf(mref, s[0]); } else {
    if (need_bias) {
#pragma unroll
        for (int i = 0; i < 16; ++i) { int rel = qpos - (kvpos0 + crow(i, hh)); rel = rel < 0 ? 0 : (rel > 127 ? 127 : rel); s[i] += btab[rel]; }
    }
    if (need_mask) {
#pragma unroll
        for (int i = 0; i < 16; ++i) { if (kvpos0 + crow(i, hh) > qpos) s[i] = -INFINITY; }
    }
    float mx = max3_(s[0], s[1], s[2]);
    mx = max3_(mx, s[3], s[4]); mx = max3_(mx, s[5], s[6]); mx = max3_(mx, s[7], s[8]); mx = max3_(mx, s[9], s[10]); mx = max3_(mx, s[11], s[12]); mx = max3_(mx, s[13], s[14]);
    { auto rr = __builtin_amdgcn_permlane32_swap(__float_as_uint(mx), __float_as_uint(mx), false, false); mx = max3_(s[15], __uint_as_float(rr[0]), __uint_as_float(rr[1])); }
    if (first || __any(mx - mref > D_THR)) {
        const float mn = first ? mx : fmaxf(mref, mx);
        const float alpha = first ? 0.f : fast_exp2(mref - mn);
        mref = mn; lrun *= alpha;
#pragma unroll
        for (int dt = 0; dt < 4; ++dt)
#pragma unroll
            for (int i = 0; i < 16; ++i) o[dt][i] *= alpha;
    }
    float sum = 0.f;
#pragma unroll
    for (int i = 0; i < 16; ++i) { const float p = fast_exp2(s[i] - mref); sum += p; s[i] = p; }
    lrun += sum;
#pragma unroll
    for (int st = 0; st < 2; ++st) { u32x4 w; w.x = cvtpk(s[8 * st + 0], s[8 * st + 1]); w.y = cvtpk(s[8 * st + 2], s[8 * st + 3]); w.z = cvtpk(s[8 * st + 4], s[8 * st + 5]); w.w = cvtpk(s[8 * st + 6], s[8 * st + 7]);
        P[st] = __builtin_bit_cast(bf16x8, w); }
    }
}
template <int MODE, bool LOADV>
__device__ __forceinline__ void d_half_b(f32x16 (&o)[4], bf16x8 (&vf)[4], const bf16x8 (&P)[2], const LAS unsigned char* vb, int kh, int r, int hh) {
    if (LOADV) {
#pragma unroll
        for (int dt = 0; dt < 2; ++dt)
#pragma unroll
            for (int st = 0; st < 2; ++st) vf[2 * dt + st] = *(const LAS bf16x8*)(vb + (32 * dt + r) * VROW + (2 * kh + st) * 32 + hh * 16);
    }
    bf16x8 vg[4];
#pragma unroll
    for (int dt = 2; dt < 4; ++dt)
#pragma unroll
        for (int st = 0; st < 2; ++st) vg[2 * (dt - 2) + st] = *(const LAS bf16x8*)(vb + (32 * dt + r) * VROW + (2 * kh + st) * 32 + hh * 16);
    asm volatile("s_waitcnt lgkmcnt(4)" ::: "memory"); SBAR();
    __builtin_amdgcn_s_setprio(1);
#pragma unroll
    for (int dt = 0; dt < 2; ++dt)
#pragma unroll
        for (int st = 0; st < 2; ++st) {
            if (MODE != 3) o[dt] = __builtin_amdgcn_mfma_f32_32x32x16_bf16(vf[2 * dt + st], P[st], o[dt], 0, 0, 0);
            else o[dt][st] += __builtin_bit_cast(float, (int)vf[2 * dt + st][0]) * __builtin_bit_cast(float, (int)P[st][0]);
        }
    asm volatile("s_waitcnt lgkmcnt(0)" ::: "memory"); SBAR();
#pragma unroll
    for (int dt = 2; dt < 4; ++dt)
#pragma unroll
        for (int st = 0; st < 2; ++st) {
            if (MODE != 3) o[dt] = __builtin_amdgcn_mfma_f32_32x32x16_bf16(vg[2 * (dt - 2) + st], P[st], o[dt], 0, 0, 0);
            else o[dt][st] += __builtin_bit_cast(float, (int)vg[2 * (dt - 2) + st][0]) * __builtin_bit_cast(float, (int)P[st][0]);
        }
    __builtin_amdgcn_s_setprio(0);
}
template <int MODE>
__device__ __forceinline__ void diff_unit(LAS unsigned char* lds, int b, int h, int qt, const bf16_t* QD, const bf16_t* KDT, const bf16_t* VDT, bf16_t* AD, const float* subln, const float* rel_bias) {
    int tid_ = threadIdx.x; asm volatile("" : "+v"(tid_));
    const int tid = tid_, lane = tid & 63, r = lane & 31, hh = lane >> 5; const int wid = __builtin_amdgcn_readfirstlane(tid >> 6);
    const int map = wid >> 2, qsub = wid & 3;
    const int q0 = qt * 128, qw0 = q0 + 32 * qsub, qpos = qw0 + r;
    const size_t tok0 = (size_t)b * SEQ;
    const LAS float* btab = (const LAS float*)(lds + D_OFF_TAB);
    const LAS float* gtab = (const LAS float*)(lds + D_OFF_G);
    const int kcol = map * 64;
    bf16x8 qf[4];
#pragma unroll
    for (int ks = 0; ks < 4; ++ks) qf[ks] = *(const bf16x8*)(QD + (tok0 + qpos) * 1024 + h * 128 + map * 64 + 16 * ks + 8 * hh);
    f32x16 o[4];
#pragma unroll
    for (int dt = 0; dt < 4; ++dt)
#pragma unroll
        for (int i = 0; i < 16; ++i) o[dt][i] = 0.f;
    float mrun = 0.f, lrun = 0.f;
    const bf16_t* kbase = KDT + ((size_t)h * 256 + b * 128) * 8192;
    const bf16_t* vbase = VDT + ((size_t)h * 256 + b * 128) * 8192;
    const int NT = 2 * (qt + 1);
    TileRegs R;
    bf16x8 kfa[4], kfb[4];
    __syncthreads();
    fill_bias_tab((LAS float*)(lds + D_OFF_TAB), rel_bias, h);
    if (tid < 128) ((LAS float*)(lds + D_OFF_G))[tid] = subln[tid];
    tile_load(R, kbase, vbase, tid);
    tile_store(R, lds, lds + KBUF, tid);
    tile_load(R, kbase + 8192, vbase + 8192, tid);
    __syncthreads();
    if (MODE != 2) d_load_kf(kfa, lds, 0, r, hh, kcol);
    int bc = 0;
    bf16x8 vf[4], P[2];
#define D_STAGE() do { if (t + 1 < NT) tile_store(R, lds + bn * TBUF, lds + bn * TBUF + KBUF, tid); \
        if (t + 2 < NT) tile_load(R, kbase + (size_t)(MODE == 1 ? 0 : t + 2) * 8192, vbase + (size_t)(MODE == 1 ? 0 : t + 2) * 8192, tid); \
        __syncthreads(); } while (0)
    if (wid < 4) {
#pragma unroll 1
        for (int t = 0; t < NT; ++t) {
            const int bn = (bc == 2) ? 0 : bc + 1;
            const LAS unsigned char* kb = lds + bc * TBUF; const LAS unsigned char* vb = kb + KBUF;
            const int k0 = 64 * t;
            { const bool nm = (k0 + 31 > qw0), nb = (qw0 - (k0 + 31) < 113);
              if (MODE != 2) { d_half_a<MODE, true, true>(kfa, kfb, kb, 1, vb, 0, qf, o, mrun, lrun, qpos, k0, nm, nb, t == 0, btab, r, hh, kcol, vf, P); d_half_b<MODE, false>(o, vf, P, vb, 0, r, hh); } }
            D_STAGE();
            { const bool nm = (k0 + 63 > qw0), nb = (qw0 - (k0 + 63) < 113);
              if (MODE != 2) { d_half_a<MODE, true, true>(kfb, kfa, lds + bn * TBUF, 0, vb, 1, qf, o, mrun, lrun, qpos, k0 + 32, nm, nb, false, btab, r, hh, kcol, vf, P); d_half_b<MODE, false>(o, vf, P, vb, 1, r, hh); } }
            bc = bn;
        }
    } else {
#pragma unroll 1
        for (int t = 0; t < NT; ++t) {
            const int bn = (bc == 2) ? 0 : bc + 1;
            const LAS unsigned char* kb = lds + bc * TBUF; const LAS unsigned char* vb = kb + KBUF;
            const int k0 = 64 * t;
            { const bool nm = (k0 + 31 > qw0), nb = (qw0 - (k0 + 31) < 113);
              if (MODE != 2) d_half_a<MODE, false, false>(kfa, kfb, kb, 1, vb, 0, qf, o, mrun, lrun, qpos, k0, nm, nb, t == 0, btab, r, hh, kcol, vf, P); }
            D_STAGE();
            if (MODE != 2) { d_half_b<MODE, true>(o, vf, P, vb, 0, r, hh); d_load_kf(kfb, kb, 1, r, hh, kcol); }
            { const bool nm = (k0 + 63 > qw0), nb = (qw0 - (k0 + 63) < 113);
              if (MODE != 2) { d_half_a<MODE, true, true>(kfb, kfa, lds + bn * TBUF, 0, vb, 1, qf, o, mrun, lrun, qpos, k0 + 32, nm, nb, false, btab, r, hh, kcol, vf, P); d_half_b<MODE, false>(o, vf, P, vb, 1, r, hh); } }
            bc = bn;
        }
    }
#undef D_STAGE
    __syncthreads();
    const float l = lrun + __shfl_xor(lrun, 32);
    LAS float* xch = (LAS float*)lds + qsub * 4096 + lane;
    if (map == 1) {
        const float lam = *(const LAS float*)(lds + MISC_OFF + 68);
        const float f = lam / l;
#pragma unroll
        for (int dt = 0; dt < 4; ++dt)
#pragma unroll
            for (int i = 0; i < 16; ++i) xch[(dt * 16 + i) * 64] = o[dt][i] * f;
    }
    __syncthreads();
    if (map == 0) {
        const float i0 = 1.0f / l;
        float ss = 0.f;
#pragma unroll
        for (int dt = 0; dt < 4; ++dt)
#pragma unroll
            for (int i = 0; i < 16; ++i) { const float v = o[dt][i] * i0 - xch[(dt * 16 + i) * 64]; o[dt][i] = v; ss += v * v; }
        ss += __shfl_xor(ss, 32);
        const float rs = 0.8f / sqrtf(ss * (1.0f / 128.0f) + RMS_EPS);
        bf16_t* orow = AD + (tok0 + qpos) * 1024 + h * 128;
#pragma unroll
        for (int dt = 0; dt < 4; ++dt)
#pragma unroll
            for (int g = 0; g < 4; ++g) { const int d = 32 * dt + 8 * g + 4 * hh;
                const f32x4 gg = *(const LAS f32x4*)(gtab + d);
                u32x2 w; w.x = cvtpk(o[dt][4 * g + 0] * rs * gg[0], o[dt][4 * g + 1] * rs * gg[1]); w.y = cvtpk(o[dt][4 * g + 2] * rs * gg[2], o[dt][4 * g + 3] * rs * gg[3]);
                *(u32x2*)(orow + d) = w; }
    }
}

constexpr int KROW8 = 144, VROW8 = 80, KBUF8 = 64 * KROW8, VBUF8 = 128 * VROW8, TBUF8 = KBUF8 + VBUF8;
static_assert(4 * TBUF8 <= D_OFF_TAB, "fp8 diff attention LDS");
constexpr float D8_C = 1.0f / 64.0f, D8_THR = 3.0f * 64.0f, D8_SH = 5.0f;
struct TileRegs8 { u32x4 k, v; };
__device__ __forceinline__ void tile_load8(TileRegs8& R, const unsigned char* kt, const unsigned char* vt, int tid) { R.k = *(const u32x4*)(kt + tid * 16); R.v = *(const u32x4*)(vt + tid * 16); }
__device__ __forceinline__ void tile_store8(const TileRegs8& R, LAS unsigned char* kb, LAS unsigned char* vb, int tid) {
    *(LAS u32x4*)(kb + (tid >> 3) * KROW8 + (tid & 7) * 16) = R.k; *(LAS u32x4*)(vb + (tid >> 2) * VROW8 + (tid & 3) * 16) = R.v; }
__device__ __forceinline__ i32x8 cat8(const i32x4 a, const i32x4 b) { return __builtin_shufflevector(a, b, 0, 1, 2, 3, 4, 5, 6, 7); }
__device__ __forceinline__ void d8_load_kf(i32x8 (&kf)[2], const LAS unsigned char* kb, int r, int hh, int kcolb) {
#pragma unroll
    for (int kh = 0; kh < 2; ++kh) { const LAS unsigned char* q = kb + (32 * kh + r) * KROW8 + kcolb + 32 * hh; kf[kh] = cat8(*(const LAS i32x4*)q, *(const LAS i32x4*)(q + 16)); }
}
template <int DT0>
__device__ __forceinline__ void d8_load_vf2(i32x8 (&vf)[2], const LAS unsigned char* vb, int r, int hh) {
#pragma unroll
    for (int dt = 0; dt < 2; ++dt) { const LAS unsigned char* q = vb + (32 * (DT0 + dt) + r) * VROW8 + 32 * hh; vf[dt] = cat8(*(const LAS i32x4*)q, *(const LAS i32x4*)(q + 16)); }
}
__device__ __forceinline__ void d8_scores(f32x16& s0, f32x16& s1, const i32x8 (&kf)[2], const i32x8& qf) {
    f32x16 z;
#pragma unroll
    for (int i = 0; i < 16; ++i) z[i] = 0.f;
    __builtin_amdgcn_s_setprio(1);
    s0 = __builtin_amdgcn_mfma_scale_f32_32x32x64_f8f6f4(kf[0], qf, z, 0, 0, 0, 0x7F7F7F7F, 0, 0x7F7F7F7F);
    s1 = __builtin_amdgcn_mfma_scale_f32_32x32x64_f8f6f4(kf[1], qf, z, 0, 0, 0, 0x7F7F7F7F, 0, 0x7F7F7F7F);
    __builtin_amdgcn_s_setprio(0);
}
template <bool ROW = false>
__device__ __forceinline__ i32x8 d8_softmax(f32x16& s0, f32x16& s1, f32x16 (&o)[4], float& mref, float& lrun, int qpos, int k0, bool need_mask, bool need_bias, bool first, const LAS float* btab, int hh) {
    if (need_bias) {
#pragma unroll
        for (int i = 0; i < 16; ++i) { int rel = qpos - (k0 + crow(i, hh)); rel = rel < 0 ? 0 : (rel > 127 ? 127 : rel); s0[i] += btab[rel]; }
        SBAR();
#pragma unroll
        for (int i = 0; i < 16; ++i) { int rel = qpos - (k0 + 32 + crow(i, hh)); rel = rel < 0 ? 0 : (rel > 127 ? 127 : rel); s1[i] += btab[rel]; }
        SBAR();
    }
    if (need_mask) {
#pragma unroll
        for (int i = 0; i < 16; ++i) { if (k0 + crow(i, hh) > qpos) s0[i] = -INFINITY; if (k0 + 32 + crow(i, hh) > qpos) s1[i] = -INFINITY; }
    }
    float mx = max3_(s0[0], s0[1], s0[2]);
#pragma unroll
    for (int i = 3; i < 15; i += 2) mx = max3_(mx, s0[i], s0[i + 1]);
    mx = max3_(mx, s0[15], s1[0]);
#pragma unroll
    for (int i = 1; i < 15; i += 2) mx = max3_(mx, s1[i], s1[i + 1]);
    { auto rr = __builtin_amdgcn_permlane32_swap(__float_as_uint(mx), __float_as_uint(mx), false, false); mx = max3_(s1[15], __uint_as_float(rr[0]), __uint_as_float(rr[1])); }
    if constexpr (ROW) {
        const bool up = (mx - mref > D8_THR);
        if (__any(up)) {
            const float alpha = up ? fast_exp2((mref - mx) * D8_C) : 1.0f;
            if (up) mref = mx;
            lrun *= alpha;
            asm volatile("s_nop 15\n\ts_nop 15" ::: "memory");
#pragma unroll
            for (int dt = 0; dt < 4; ++dt)
#pragma unroll
                for (int i = 0; i < 16; ++i) o[dt][i] *= alpha;
        }
    } else
    if (first || __any(mx - mref > D8_THR)) {
        const float mn = first ? mx : fmaxf(mref, mx);
        const float alpha = first ? 0.f : fast_exp2((mref - mn) * D8_C);
        mref = mn; lrun *= alpha;
        asm volatile("s_nop 15\n\ts_nop 15" ::: "memory");
#pragma unroll
        for (int dt = 0; dt < 4; ++dt)
#pragma unroll
            for (int i = 0; i < 16; ++i) o[dt][i] *= alpha;
    }
    const float off = D8_SH - mref * D8_C;
    float sum0 = 0.f, sum1 = 0.f;
    i32x8 P;
    const f32x2 c2 = {D8_C, D8_C}, off2 = {off, off};
    f32x2 sum2 = {0.f, 0.f};
#pragma unroll
    for (int g = 0; g < 4; ++g) {
        const f32x2 a0 = __builtin_elementwise_fma((f32x2){s0[4 * g], s0[4 * g + 1]}, c2, off2), a1 = __builtin_elementwise_fma((f32x2){s0[4 * g + 2], s0[4 * g + 3]}, c2, off2);
        const f32x2 b0 = __builtin_elementwise_fma((f32x2){s1[4 * g], s1[4 * g + 1]}, c2, off2), b1 = __builtin_elementwise_fma((f32x2){s1[4 * g + 2], s1[4 * g + 3]}, c2, off2);
        const f32x2 e0 = {fast_exp2(a0[0]), fast_exp2(a0[1])}, e1 = {fast_exp2(a1[0]), fast_exp2(a1[1])}, f0 = {fast_exp2(b0[0]), fast_exp2(b0[1])}, f1 = {fast_exp2(b1[0]), fast_exp2(b1[1])};
        sum2 += (e0 + e1) + (f0 + f1);
        int w0 = __builtin_amdgcn_cvt_pk_fp8_f32(e0[0], e0[1], 0, false); w0 = __builtin_amdgcn_cvt_pk_fp8_f32(e1[0], e1[1], w0, true);
        int w1 = __builtin_amdgcn_cvt_pk_fp8_f32(f0[0], f0[1], 0, false); w1 = __builtin_amdgcn_cvt_pk_fp8_f32(f1[0], f1[1], w1, true);
        P[g] = w0; P[4 + g] = w1; }
    sum0 = sum2[0]; sum1 = sum2[1];
    lrun += sum0 + sum1;
    return P;
}
__device__ __forceinline__ void d8_pv(f32x16 (&o)[4], const i32x8 (&va)[2], const i32x8& P, const LAS unsigned char* vb, int r, int hh) {
    i32x8 vg[2];
    d8_load_vf2<2>(vg, vb, r, hh);
    asm volatile("s_waitcnt lgkmcnt(4)" ::: "memory"); SBAR();
    __builtin_amdgcn_s_setprio(1);
#pragma unroll
    for (int dt = 0; dt < 2; ++dt) asm volatile("v_mfma_scale_f32_32x32x64_f8f6f4 %0, %1, %2, %0, %3, %3 op_sel_hi:[0,0,0]" : "+v"(o[dt]) : "v"(va[dt]), "v"(P), "v"(0x7F7F7F7F));
    asm volatile("s_waitcnt lgkmcnt(0)" ::: "memory"); SBAR();
#pragma unroll
    for (int dt = 0; dt < 2; ++dt) asm volatile("v_mfma_scale_f32_32x32x64_f8f6f4 %0, %1, %2, %0, %3, %3 op_sel_hi:[0,0,0]" : "+v"(o[2 + dt]) : "v"(vg[dt]), "v"(P), "v"(0x7F7F7F7F));
    __builtin_amdgcn_s_setprio(0);
}
__device__ __forceinline__ void diff_unit8(LAS unsigned char* lds, int b, int h, int qt, const unsigned char* QD, const unsigned char* KDT, const unsigned char* VDT, bf16_t* AD, const float* subln, const float* rel_bias) {
    int tid_ = threadIdx.x; asm volatile("" : "+v"(tid_));
    const int tid = tid_, lane = tid & 63, r = lane & 31, hh = lane >> 5; const int wid = __builtin_amdgcn_readfirstlane(tid >> 6);
    const int map = wid >> 2, qsub = wid & 3;
    const int q0 = qt * 128, qw0 = q0 + 32 * qsub, qpos = qw0 + r;
    const size_t tok0 = (size_t)b * SEQ;
    const LAS float* btab = (const LAS float*)(lds + D_OFF_TAB);
    const LAS float* gtab = (const LAS float*)(lds + D_OFF_G);
    const int kcolb = map * 64;
    i32x8 qf;
    { const unsigned char* qp = QD + (tok0 + qpos) * 1024 + h * 128 + map * 64 + 32 * hh; qf = cat8(*(const i32x4*)qp, *(const i32x4*)(qp + 16)); }
    f32x16 o[4];
#pragma unroll
    for (int dt = 0; dt < 4; ++dt)
#pragma unroll
        for (int i = 0; i < 16; ++i) o[dt][i] = 0.f;
    float mrun = 0.f, lrun = 0.f;
    const unsigned char* kbase = KDT + ((size_t)h * 256 + b * 128) * 8192;
    const unsigned char* vbase = VDT + ((size_t)h * 256 + b * 128) * 8192;
    const int NT = 2 * (qt + 1);
    TileRegs8 R;
    __syncthreads();
    if (tid < 128) { const int n = tid; ((LAS float*)(lds + D_OFF_TAB))[n] = (rel_bias[t5_bucket(n) * 16 + h] - rel_bias[31 * 16 + h]) * (LOG2E * 64.0f); ((LAS float*)(lds + D_OFF_G))[n] = subln[n]; }
    tile_load8(R, kbase, vbase, tid); tile_store8(R, lds, lds + KBUF8, tid);
    tile_load8(R, kbase + 8192, vbase + 8192, tid); tile_store8(R, lds + TBUF8, lds + TBUF8 + KBUF8, tid);
    if (NT > 2) tile_load8(R, kbase + 2 * 8192, vbase + 2 * 8192, tid);
    __syncthreads();
    i32x8 kf[2], vf[2];
    d8_load_kf(kf, lds, r, hh, kcolb);
#define D8_STAGE(t) do { if ((t) + 2 < NT) tile_store8(R, lds + (((t) + 2) & 3) * TBUF8, lds + (((t) + 2) & 3) * TBUF8 + KBUF8, tid); \
        if ((t) + 3 < NT) tile_load8(R, kbase + (size_t)((t) + 3) * 8192, vbase + (size_t)((t) + 3) * 8192, tid); \
        __syncthreads(); } while (0)
#pragma unroll 1
    for (int t = 0; t < NT; ++t) {
        const int k0 = 64 * t; const LAS unsigned char* tb = lds + (t & 3) * TBUF8;
        f32x16 s0, s1; d8_scores(s0, s1, kf, qf);
        d8_load_vf2<0>(vf, tb + KBUF8, r, hh); d8_load_kf(kf, lds + ((t + 1) & 3) * TBUF8, r, hh, kcolb); SBAR();
        const i32x8 P = d8_softmax(s0, s1, o, mrun, lrun, qpos, k0, (k0 + 63 > qw0), (qw0 - (k0 + 63) < 113), t == 0, btab, hh);
        if (wid >= 4) D8_STAGE(t);
        d8_pv(o, vf, P, tb + KBUF8, r, hh);
        if (wid < 4) D8_STAGE(t);
    }
#undef D8_STAGE
    __syncthreads();
    asm volatile("s_nop 15\n\ts_nop 15\n\ts_nop 15\n\ts_nop 15" ::: "memory");
    const float l = (lrun + __shfl_xor(lrun, 32)) * D8_VS;
    LAS float* xch = (LAS float*)lds + qsub * 4096 + lane;
    if (map == 1) {
        const float lam = *(const LAS float*)(lds + MISC_OFF + 68);
        const float f = lam / l;
#pragma unroll
        for (int dt = 0; dt < 4; ++dt)
#pragma unroll
            for (int i = 0; i < 16; ++i) xch[(dt * 16 + i) * 64] = o[dt][i] * f;
    }
    __syncthreads();
    if (map == 0) {
        const float i0 = 1.0f / l;
        float ss = 0.f;
#pragma unroll
        for (int dt = 0; dt < 4; ++dt)
#pragma unroll
            for (int i = 0; i < 16; ++i) { const float v = o[dt][i] * i0 - xch[(dt * 16 + i) * 64]; o[dt][i] = v; ss += v * v; }
        ss += __shfl_xor(ss, 32);
        const float rs = 0.8f / sqrtf(ss * (1.0f / 128.0f) + RMS_EPS);
        bf16_t* orow = AD + (tok0 + qpos) * 1024 + h * 128;
#pragma unroll
        for (int dt = 0; dt < 4; ++dt)
#pragma unroll
            for (int g = 0; g < 4; ++g) { const int d = 32 * dt + 8 * g + 4 * hh;
                const f32x4 gg = *(const LAS f32x4*)(gtab + d);
                if constexpr (O78F8) { const float r8 = rs * F8_SAD;
                    *(unsigned*)((unsigned char*)AD + (tok0 + qpos) * 1024 + h * 128 + d) = epi::pack4_f8(o[dt][4 * g + 0] * r8 * gg[0], o[dt][4 * g + 1] * r8 * gg[1], o[dt][4 * g + 2] * r8 * gg[2], o[dt][4 * g + 3] * r8 * gg[3]); }
                else { u32x2 w; w.x = cvtpk(o[dt][4 * g + 0] * rs * gg[0], o[dt][4 * g + 1] * rs * gg[1]); w.y = cvtpk(o[dt][4 * g + 2] * rs * gg[2], o[dt][4 * g + 3] * rs * gg[3]);
                *(u32x2*)(orow + d) = w; } }
    }
}

__device__ __forceinline__ void moba_unit(LAS unsigned char* lds, int b, int h, int n, const int* list, int cnt, const bf16_t* QM, const bf16_t* KMT, const bf16_t* VMT, bf16_t* PARTS, float* ML, const float* rel_bias) {
    int tid_ = threadIdx.x; asm volatile("" : "+v"(tid_));
    const int tid = tid_, lane = tid & 63, r = lane & 31, hh = lane >> 5; const int wid = __builtin_amdgcn_readfirstlane(tid >> 6);
    const size_t tok0 = (size_t)b * SEQ;
    const LAS float* btab = (const LAS float*)(lds + OFF_TAB);
    const float sc = 0.08838834764831845f * LOG2E;
    const bool own = (list == nullptr);
    const int li = 32 * wid + r;
    const bool lane_valid = li < cnt;
    int qpos, slot;
    if (own) { qpos = 256 * n + li; slot = 3; }
    else { const int e = list[lane_valid ? li : 0]; qpos = e >> 2; slot = e & 3; }
    const bool wave_active = (32 * wid < cnt);
    bf16x8 qf[1][8];
#pragma unroll
    for (int ks = 0; ks < 8; ++ks) qf[0][ks] = *(const bf16x8*)(QM + (tok0 + qpos) * 1024 + h * 128 + 16 * ks + 8 * hh);
    f32x16 O[1][4];
#pragma unroll
    for (int dt = 0; dt < 4; ++dt)
#pragma unroll
        for (int i = 0; i < 16; ++i) O[0][dt][i] = 0.f;
    float mrun[1] = {-INFINITY}, lrun[1] = {0.f};
    const bf16_t* kbase = KMT + ((size_t)h * 256 + b * 128 + 4 * n) * 8192;
    const bf16_t* vbase = VMT + ((size_t)h * 256 + b * 128 + 4 * n) * 8192;
    const int qw0 = 256 * n + 32 * wid;
    TileRegs R;
    __syncthreads();
    fill_bias_tab((LAS float*)(lds + OFF_TAB), rel_bias, 8 + h);
    tile_load(R, kbase, vbase, tid);
    tile_store(R, lds + OFF_K, lds + OFF_V, tid);
    __syncthreads();
#pragma unroll 1
    for (int t = 0; t < 4; ++t) {
        const int cur = t & 1;
        if (t + 1 < 4) tile_load(R, kbase + (size_t)(t + 1) * 8192, vbase + (size_t)(t + 1) * 8192, tid);
        if (wave_active) {
#pragma unroll 1
            for (int kh = 0; kh < 2; ++kh) {
                const int kp = 256 * n + 64 * t + 32 * kh;
                bool run = true, need_mask = false, need_bias;
                if (own) { run = (kp <= qw0 + 31); need_mask = (kp + 31 > qw0); need_bias = true; }
                else { need_bias = __any(qpos - (kp + 31) < 113); }
                if (run) attn_half<1, 8>(lds + OFF_K + cur * KBUF, lds + OFF_V + cur * VBUF, kh, qf, O, mrun, lrun, qpos, kp, need_mask, need_bias, btab, sc, r, hh, 0);
            }
        }
        if (t + 1 < 4) tile_store(R, lds + OFF_K + (cur ^ 1) * KBUF, lds + OFF_V + (cur ^ 1) * VBUF, tid);
        __syncthreads();
    }
    const float l = lrun[0] + __shfl_xor(lrun[0], 32);
    const float il = 1.0f / l;
    if (lane_valid) {
        const size_t pidx = ((tok0 + qpos) * 8 + h) * 4 + slot;
        bf16_t* orow = PARTS + pidx * 128;
#pragma unroll
        for (int dt = 0; dt < 4; ++dt)
#pragma unroll
            for (int g = 0; g < 4; ++g) { const int d = 32 * dt + 8 * g + 4 * hh;
                u32x2 w; w.x = cvtpk(O[0][dt][4 * g + 0] * il, O[0][dt][4 * g + 1] * il); w.y = cvtpk(O[0][dt][4 * g + 2] * il, O[0][dt][4 * g + 3] * il);
                *(u32x2*)(orow + d) = w; }
        if (hh == 0) *(f32x2*)(ML + pidx * 2) = (f32x2){mrun[0], l};
    }
}
constexpr int MB_K = 0, MB_V = 4 * KBUF, MB_INC = MB_V + 4 * VBUF, MB_TAB = MB_INC + 2048, MB_END = MB_TAB + 512;
static_assert(MB_END <= MISC_OFF, "MoBA block LDS");
__device__ __forceinline__ void moba_block(LAS unsigned char* lds, int b, int h, int n, const int* list, int cntl, int c0, int c1, const bf16_t* QM, const bf16_t* KMT, const bf16_t* VMT, bf16_t* PARTS, float* ML, const float* rel_bias) {
    int tid_ = threadIdx.x; asm volatile("" : "+v"(tid_));
    const int tid = tid_, lane = tid & 63, r = lane & 31, hh = lane >> 5; const int wid = __builtin_amdgcn_readfirstlane(tid >> 6);
    const size_t tok0 = (size_t)b * SEQ;
    const LAS float* btab = (const LAS float*)(lds + MB_TAB);
    const float sc = 0.08838834764831845f * LOG2E;
    const bf16_t* kbase = KMT + ((size_t)h * 256 + b * 128 + 4 * n) * 8192;
    const bf16_t* vbase = VMT + ((size_t)h * 256 + b * 128 + 4 * n) * 8192;
    __syncthreads();
    fill_bias_tab((LAS float*)(lds + MB_TAB), rel_bias, 8 + h);
    const int li = 32 * wid + r;
    const int cA = c0, cB = c0 + 1;
    const bool ownA = (cA == 0);
    const int cntA = ownA ? 256 : ((cntl - 256 * (cA - 1)) < 256 ? (cntl - 256 * (cA - 1)) : 256);
    const int cntB = (cB < c1) ? ((cntl - 256 * (cB - 1)) < 256 ? (cntl - 256 * (cB - 1)) : 256) : 0;
    const bool hasA = (32 * wid < cntA), hasB = (32 * wid < cntB);
    const bool lvA = li < cntA, lvB = li < cntB;
    int eA = 0, eB = 0;
    if (hasA && !ownA) eA = list[256 * (cA - 1) + (lvA ? li : 0)];
    if (hasB) eB = list[256 * (cB - 1) + (lvB ? li : 0)];
    TileRegs R, R2;
    tile_load(R, kbase, vbase, tid); tile_load(R2, kbase + 8192, vbase + 8192, tid);
    tile_store(R, lds + MB_K, lds + MB_V, tid); tile_load(R, kbase + 2 * 8192, vbase + 2 * 8192, tid);
    const int qposA = ownA ? 256 * n + li : (eA >> 2), slotA = ownA ? 3 : (eA & 3);
    const int qposB = eB >> 2, slotB = eB & 3;
    bf16x8 qfA[1][8], qfB[1][8];
    if (hasA) {
#pragma unroll
        for (int ks = 0; ks < 8; ++ks) qfA[0][ks] = *(const bf16x8*)(QM + (tok0 + qposA) * 1024 + h * 128 + 16 * ks + 8 * hh);
    }
    if (hasB) {
#pragma unroll
        for (int ks = 0; ks < 8; ++ks) qfB[0][ks] = *(const bf16x8*)(QM + (tok0 + qposB) * 1024 + h * 128 + 16 * ks + 8 * hh);
    }
    tile_store(R2, lds + MB_K + KBUF, lds + MB_V + VBUF, tid); tile_load(R2, kbase + 3 * 8192, vbase + 3 * 8192, tid);
    tile_store(R, lds + MB_K + 2 * KBUF, lds + MB_V + 2 * VBUF, tid);
    tile_store(R2, lds + MB_K + 3 * KBUF, lds + MB_V + 3 * VBUF, tid);
    __syncthreads();
#define MB_CHUNK(HAS, OWN, QF, QPOS, SLOT, LV) do { if (HAS) { \
        f32x16 O[1][4]; \
        _Pragma("unroll") for (int dt = 0; dt < 4; ++dt) _Pragma("unroll") for (int i = 0; i < 16; ++i) O[0][dt][i] = 0.f; \
        float mrun[1] = {-INFINITY}, lrun[1] = {0.f}; \
        const int qw0 = 256 * n + 32 * wid; \
        _Pragma("unroll 1") for (int t8 = 0; t8 < 8; ++t8) { \
            const int t = t8 >> 1, kh = t8 & 1; const int kp = 256 * n + 32 * t8; \
            bool run = true, need_mask = false, need_bias; \
            if (OWN) { run = (kp <= qw0 + 31); need_mask = (kp + 31 > qw0); need_bias = true; } \
            else { need_bias = __any((QPOS) - (kp + 31) < 113); } \
            if (run) attn_half<1, 8>(lds + MB_K + t * KBUF, lds + MB_V + t * VBUF, kh, QF, O, mrun, lrun, QPOS, kp, need_mask, need_bias, btab, sc, r, hh, 0); \
        } \
        const float l = lrun[0] + __shfl_xor(lrun[0], 32); const float il = 1.0f / l; \
        if (LV) { const size_t pidx = ((tok0 + (QPOS)) * 8 + h) * 4 + (SLOT); bf16_t* orow = PARTS + pidx * 128; \
            _Pragma("unroll") for (int dt = 0; dt < 4; ++dt) _Pragma("unroll") for (int g = 0; g < 4; ++g) { const int d = 32 * dt + 8 * g + 4 * hh; \
                u32x2 w; w.x = cvtpk(O[0][dt][4 * g + 0] * il, O[0][dt][4 * g + 1] * il); w.y = cvtpk(O[0][dt][4 * g + 2] * il, O[0][dt][4 * g + 3] * il); \
                *(u32x2*)(orow + d) = w; } \
            if (hh == 0) *(f32x2*)(ML + pidx * 2) = (f32x2){mrun[0], l}; } } } while (0)
    MB_CHUNK(hasA, ownA, qfA, qposA, slotA, lvA);
    MB_CHUNK(hasB, false, qfB, qposB, slotB, lvB);
#undef MB_CHUNK
}
constexpr int MB8_TAB = 4 * TBUF8;
static_assert(MB8_TAB + 512 <= MB_INC, "fp8 MoBA block LDS");
__device__ __forceinline__ void moba_block8(LAS unsigned char* lds, int b, int h, int n, const int* list, int cntl, int c0, int c1, const unsigned char* QM8, const unsigned char* KMT8, const unsigned char* VMT8, bf16_t* PARTS, float* ML, const float* rel_bias) {
    int tid_ = threadIdx.x; asm volatile("" : "+v"(tid_));
    const int tid = tid_, lane = tid & 63, r = lane & 31, hh = lane >> 5; const int wid = __builtin_amdgcn_readfirstlane(tid >> 6);
    const size_t tok0 = (size_t)b * SEQ;
    const LAS float* btab = (const LAS float*)(lds + MB8_TAB);
    const unsigned char* kbase = KMT8 + ((size_t)h * 256 + b * 128 + 4 * n) * 8192;
    const unsigned char* vbase = VMT8 + ((size_t)h * 256 + b * 128 + 4 * n) * 8192;
    __syncthreads();
    if (tid < 128) { const int q = tid; ((LAS float*)(lds + MB8_TAB))[q] = (rel_bias[t5_bucket(q) * 16 + 8 + h] - rel_bias[31 * 16 + 8 + h]) * (LOG2E * 64.0f); }
    const int li = 32 * wid + r;
    const int cA = c0, cB = c0 + 1;
    const bool ownA = (cA == 0);
    const int cntA = ownA ? 256 : ((cntl - 256 * (cA - 1)) < 256 ? (cntl - 256 * (cA - 1)) : 256);
    const int cntB = (cB < c1) ? ((cntl - 256 * (cB - 1)) < 256 ? (cntl - 256 * (cB - 1)) : 256) : 0;
    const bool hasA = (32 * wid < cntA), hasB = (32 * wid < cntB);
    const bool lvA = li < cntA, lvB = li < cntB;
    int eA = 0, eB = 0;
    if (hasA && !ownA) eA = list[256 * (cA - 1) + (lvA ? li : 0)];
    if (hasB) eB = list[256 * (cB - 1) + (lvB ? li : 0)];
    TileRegs8 R0, R1, R2, R3;
    tile_load8(R0, kbase, vbase, tid); tile_load8(R1, kbase + 8192, vbase + 8192, tid); tile_load8(R2, kbase + 2 * 8192, vbase + 2 * 8192, tid); tile_load8(R3, kbase + 3 * 8192, vbase + 3 * 8192, tid);
    SBAR();
    tile_store8(R0, lds, lds + KBUF8, tid);
    const int qposA = ownA ? 256 * n + li : (eA >> 2), slotA = ownA ? 3 : (eA & 3);
    const int qposB = eB >> 2, slotB = eB & 3;
    i32x8 qf[2];
    if (hasA) { const unsigned char* qp = QM8 + (tok0 + qposA) * 1024 + h * 128 + 32 * hh; qf[0] = cat8(*(const i32x4*)qp, *(const i32x4*)(qp + 16)); qf[1] = cat8(*(const i32x4*)(qp + 64), *(const i32x4*)(qp + 80)); }
    tile_store8(R1, lds + TBUF8, lds + TBUF8 + KBUF8, tid);
    tile_store8(R2, lds + 2 * TBUF8, lds + 2 * TBUF8 + KBUF8, tid);
    tile_store8(R3, lds + 3 * TBUF8, lds + 3 * TBUF8 + KBUF8, tid);
    __syncthreads();
#define MB8_LOADQB() do { if (hasB) { const unsigned char* qp = QM8 + (tok0 + qposB) * 1024 + h * 128 + 32 * hh; qf[0] = cat8(*(const i32x4*)qp, *(const i32x4*)(qp + 16)); qf[1] = cat8(*(const i32x4*)(qp + 64), *(const i32x4*)(qp + 80)); } } while (0)
#define MB8_CHUNK(HAS, OWN, QPOS, SLOT, LV, NEXTQ) do { if (HAS) { \
        f32x16 o[4]; \
        _Pragma("unroll") for (int dt = 0; dt < 4; ++dt) _Pragma("unroll") for (int i = 0; i < 16; ++i) o[dt][i] = 0.f; \
        float mref = -INFINITY, lrun = 0.f; \
        const int qw0 = 256 * n + 32 * wid; \
        _Pragma("unroll 1") for (int t = 0; t < 4; ++t) { \
            const int kp = 256 * n + 64 * t; const LAS unsigned char* tb = lds + t * TBUF8; \
            bool run = true, need_mask = false, need_bias; \
            if (OWN) { run = (kp <= qw0 + 31); need_mask = (kp + 63 > qw0); need_bias = (qw0 - (kp + 63) < 113); } \
            else { need_bias = __any((QPOS) - (kp + 63) < 113); } \
            if (run) { \
                i32x8 ka[2], kc[2], vf[2]; \
                d8_load_kf(ka, tb, r, hh, 0); d8_load_kf(kc, tb, r, hh, 64); \
                f32x16 s0, s1; d8_scores(s0, s1, ka, qf[0]); \
                __builtin_amdgcn_s_setprio(1); \
                s0 = __builtin_amdgcn_mfma_scale_f32_32x32x64_f8f6f4(kc[0], qf[1], s0, 0, 0, 0, 0x7F7F7F7F, 0, 0x7F7F7F7F); \
                s1 = __builtin_amdgcn_mfma_scale_f32_32x32x64_f8f6f4(kc[1], qf[1], s1, 0, 0, 0, 0x7F7F7F7F, 0, 0x7F7F7F7F); \
                __builtin_amdgcn_s_setprio(0); \
                d8_load_vf2<0>(vf, tb + KBUF8, r, hh); SBAR(); \
                const i32x8 P = d8_softmax<true>(s0, s1, o, mref, lrun, QPOS, kp, need_mask, need_bias, false, btab, hh); \
                d8_pv(o, vf, P, tb + KBUF8, r, hh); \
            } \
        } \
        NEXTQ; \
        asm volatile("s_nop 15\n\ts_nop 15\n\ts_nop 15\n\ts_nop 15" ::: "memory");        \
        const float l = lrun + __shfl_xor(lrun, 32); const float il = 1.0f / (l * D8_VS); \
        if (LV) { const size_t pidx = ((tok0 + (QPOS)) * 8 + h) * 4 + (SLOT); bf16_t* orow = PARTS + pidx * 128; \
            _Pragma("unroll") for (int dt = 0; dt < 4; ++dt) _Pragma("unroll") for (int g = 0; g < 4; ++g) { const int d = 32 * dt + 8 * g + 4 * hh; \
                u32x2 w; w.x = cvtpk(o[dt][4 * g + 0] * il, o[dt][4 * g + 1] * il); w.y = cvtpk(o[dt][4 * g + 2] * il, o[dt][4 * g + 3] * il); \
                *(u32x2*)(orow + d) = w; } \
            if (hh == 0) *(f32x2*)(ML + pidx * 2) = (f32x2){mref * D8_C - D8_SH, l}; } } else { NEXTQ; } } while (0)
    MB8_CHUNK(hasA, ownA, qposA, slotA, lvA, MB8_LOADQB());
    MB8_CHUNK(hasB, false, qposB, slotB, lvB, (void)0);
#undef MB8_CHUNK
#undef MB8_LOADQB
}
}

struct Ctx {
    LAS unsigned char* lds;
    unsigned char* ws; unsigned* ctl;
    const float* const* in; float* out;
    int tid, lane, wave, G, blk;
};
enum { I_X = 0, I_C, I_WADA, I_BADA, I_GMIX, I_GFFN, I_WIN, I_LAMBDA, I_SUBLN, I_RELB, I_WOD, I_WOM, I_WOUT, I_WROUTER, I_RBIAS, I_WEG, I_WEU, I_WED, I_WSG, I_WSU, I_WSD, I_GFINAL };

constexpr int TR_SCR = 64 * 65 * 4 + 128;
static_assert(8 * TR_SCR <= RING_BYTES + 16384, "transpose scratch");
template <bool NT>
__device__ __forceinline__ void transpose_item(const float* __restrict__ W, int K, int N, bf16_t* __restrict__ WT, int drow0, int k0, int n0, LAS float* scr, int lane) {
    const int nq = lane & 15, kr = lane >> 4;
    f32x4 v[16];
#pragma unroll
    for (int i = 0; i < 16; ++i) { const f32x4* p = (const f32x4*)(W + (size_t)(k0 + 4 * i + kr) * N + n0 + 4 * nq); v[i] = NT ? __builtin_nontemporal_load(p) : *p; }
#pragma unroll
    for (int i = 0; i < 16; ++i) { LAS float* d = scr + (4 * i + kr) * 65 + 4 * nq; d[0] = v[i][0]; d[1] = v[i][1]; d[2] = v[i][2]; d[3] = v[i][3]; }
    LDS_WAIT(); asm volatile("" ::: "memory");
    const int c = lane & 7;
#pragma unroll
    for (int j = 0; j < 8; ++j) { const int n = (lane >> 3) + 8 * j; const LAS float* s = scr + (8 * c) * 65 + n;
        u32x4 o; o.x = cvtpk(s[0 * 65], s[1 * 65]); o.y = cvtpk(s[2 * 65], s[3 * 65]); o.z = cvtpk(s[4 * 65], s[5 * 65]); o.w = cvtpk(s[6 * 65], s[7 * 65]);
        u32x4* q = (u32x4*)(WT + (size_t)(drow0 + n) * K + k0 + 8 * c); if (NT) __builtin_nontemporal_store(o, q); else *q = o; }
    LDS_WAIT(); asm volatile("" ::: "memory");
}
template <bool NT>
__device__ __forceinline__ void transpose_item_f8(const float* __restrict__ W, int K, int N, unsigned char* __restrict__ WT, int drow0, int k0, int n0, LAS float* scr, int lane, float scale) {
    const int nq = lane & 15, kr = lane >> 4;
    f32x4 v[16];
#pragma unroll
    for (int i = 0; i < 16; ++i) { const f32x4* p = (const f32x4*)(W + (size_t)(k0 + 4 * i + kr) * N + n0 + 4 * nq); v[i] = NT ? __builtin_nontemporal_load(p) : *p; }
#pragma unroll
    for (int i = 0; i < 16; ++i) { LAS float* d = scr + (4 * i + kr) * 65 + 4 * nq; d[0] = v[i][0] * scale; d[1] = v[i][1] * scale; d[2] = v[i][2] * scale; d[3] = v[i][3] * scale; }
    LDS_WAIT(); asm volatile("" ::: "memory");
    const int c = lane & 7;
#pragma unroll
    for (int j = 0; j < 8; ++j) { const int n = (lane >> 3) + 8 * j; const LAS float* s = scr + (8 * c) * 65 + n;
        const u32x2 o = {epi::pack4_f8(s[0 * 65], s[1 * 65], s[2 * 65], s[3 * 65]), epi::pack4_f8(s[4 * 65], s[5 * 65], s[6 * 65], s[7 * 65])};
        u32x2* q = (u32x2*)(WT + (size_t)(drow0 + n) * K + k0 + 8 * c); if (NT) __builtin_nontemporal_store(o, q); else *q = o; }
    LDS_WAIT(); asm volatile("" ::: "memory");
}
struct CvItemF8 { const float* W; unsigned char* WT; int K, N, drow0, k0, n0; float scale; };
__device__ __forceinline__ void transpose_pair_f8(const CvItemF8& A, const CvItemF8& B, LAS float* scr, int lane) {
    const int nq = lane & 15, kr = lane >> 4, c = lane & 7;
    f32x4 va[16], vb[16];
#pragma unroll
    for (int i = 0; i < 16; ++i) va[i] = __builtin_nontemporal_load((const f32x4*)(A.W + (size_t)(A.k0 + 4 * i + kr) * A.N + A.n0 + 4 * nq));
#pragma unroll
    for (int i = 0; i < 16; ++i) vb[i] = __builtin_nontemporal_load((const f32x4*)(B.W + (size_t)(B.k0 + 4 * i + kr) * B.N + B.n0 + 4 * nq));
    __builtin_amdgcn_sched_barrier(0);
#pragma unroll
    for (int i = 0; i < 16; ++i) { LAS float* d = scr + (4 * i + kr) * 65 + 4 * nq; d[0] = va[i][0] * A.scale; d[1] = va[i][1] * A.scale; d[2] = va[i][2] * A.scale; d[3] = va[i][3] * A.scale; }
    LDS_WAIT(); asm volatile("" ::: "memory");
#pragma unroll
    for (int j = 0; j < 8; ++j) { const int n = (lane >> 3) + 8 * j; const LAS float* s = scr + (8 * c) * 65 + n;
        const u32x2 o = {epi::pack4_f8(s[0 * 65], s[1 * 65], s[2 * 65], s[3 * 65]), epi::pack4_f8(s[4 * 65], s[5 * 65], s[6 * 65], s[7 * 65])};
        __builtin_nontemporal_store(o, (u32x2*)(A.WT + (size_t)(A.drow0 + n) * A.K + A.k0 + 8 * c)); }
    LDS_WAIT(); asm volatile("" ::: "memory");
#pragma unroll
    for (int i = 0; i < 16; ++i) { LAS float* d = scr + (4 * i + kr) * 65 + 4 * nq; d[0] = vb[i][0] * B.scale; d[1] = vb[i][1] * B.scale; d[2] = vb[i][2] * B.scale; d[3] = vb[i][3] * B.scale; }
    LDS_WAIT(); asm volatile("" ::: "memory");
#pragma unroll
    for (int j = 0; j < 8; ++j) { const int n = (lane >> 3) + 8 * j; const LAS float* s = scr + (8 * c) * 65 + n;
        const u32x2 o = {epi::pack4_f8(s[0 * 65], s[1 * 65], s[2 * 65], s[3 * 65]), epi::pack4_f8(s[4 * 65], s[5 * 65], s[6 * 65], s[7 * 65])};
        __builtin_nontemporal_store(o, (u32x2*)(B.WT + (size_t)(B.drow0 + n) * B.K + B.k0 + 8 * c)); }
    LDS_WAIT(); asm volatile("" ::: "memory");
}
__device__ __forceinline__ int gu_row(int n0, int up) { return 256 * (n0 >> 7) + 128 * up + (n0 & 127); }

__device__ __forceinline__ int win_row(int n) { return n < 2048 ? n : (n < 3072 ? 8192 + (n - 2048) : (n < 5120 ? 2048 + (n - 3072) : (n < 6144 ? 9216 + (n - 5120) : 4096 + (n - 6144)))); }
__device__ __forceinline__ void p0_prologue(Ctx& F) {
    const int gw = F.blk * 8 + F.wave, NGW = F.G * 8;
    unsigned char* ws = F.ws;
    {
        const float* wada = F.in[I_WADA]; const float* c = F.in[I_C]; float* modp = (float*)(ws + WS_MODP);
        for (int it = gw; it < 48 * 32; it += NGW) {
            const int cc = it % 48, ks = it / 48, col = 256 * cc + 4 * F.lane;
            f32x4 a0 = {0.f, 0.f, 0.f, 0.f}, a1 = {0.f, 0.f, 0.f, 0.f};
#pragma unroll 8
            for (int k = 64 * ks; k < 64 * ks + 64; ++k) {
                const f32x4 w = *(const f32x4*)(wada + (size_t)k * 12288 + col);
                const float c0 = c[k], c1 = c[2048 + k];
                a0 += w * siluf_(c0); a1 += w * siluf_(c1);
            }
            *(f32x4*)(modp + ((size_t)ks * 2 + 0) * 12288 + col) = a0;
            *(f32x4*)(modp + ((size_t)ks * 2 + 1) * 12288 + col) = a1;
        }
    }
    {
        LAS float* scr = (LAS float*)(F.lds + F.wave * TR_SCR);
        constexpr int I0 = 5120, I1 = I0 + 512, I2 = I1 + 512, I3 = I2 + 1024, I4 = I3 + 256, I5 = I4 + 256, I6 = I5 + 256;
        for (int it = gw; it < I6; it += NGW) {
            if (it < I0) { const int r = it, kb = r / 160, nb = r % 160; if constexpr (P2F8) transpose_item_f8<false>(F.in[I_WIN], 2048, 10240, ws + WS_W_IN_T, win_row(64 * nb), 64 * kb, 64 * nb, scr, F.lane, F8_SW); else transpose_item<false>(F.in[I_WIN], 2048, 10240, (bf16_t*)(ws + WS_W_IN_T), win_row(64 * nb), 64 * kb, 64 * nb, scr, F.lane); }
            else if (it < I1) { const int r = it - I0, kb = r / 32, nb = r % 32; if constexpr (O78F8) transpose_item_f8<false>(F.in[I_WOD], 1024, 2048, ws + WS_W_OD_T, 64 * nb, 64 * kb, 64 * nb, scr, F.lane, F8_SWO); else transpose_item<false>(F.in[I_WOD], 1024, 2048, (bf16_t*)(ws + WS_W_OD_T), 64 * nb, 64 * kb, 64 * nb, scr, F.lane); }
            else if (it < I2) { const int r = it - I1, kb = r / 32, nb = r % 32; if constexpr (O78F8) transpose_item_f8<false>(F.in[I_WOM], 1024, 2048, ws + WS_W_OM_T, 64 * nb, 64 * kb, 64 * nb, scr, F.lane, F8_SWO); else transpose_item<false>(F.in[I_WOM], 1024, 2048, (bf16_t*)(ws + WS_W_OM_T), 64 * nb, 64 * kb, 64 * nb, scr, F.lane); }
            else if (it < I3) { const int r = it - I2, kb = r / 32, nb = r % 32; if constexpr (O78F8) transpose_item_f8<false>(F.in[I_WOUT], 2048, 2048, ws + WS_W_OUT_T, 64 * nb, 64 * kb, 64 * nb, scr, F.lane, F8_SWOUT); else transpose_item<false>(F.in[I_WOUT], 2048, 2048, (bf16_t*)(ws + WS_W_OUT_T), 64 * nb, 64 * kb, 64 * nb, scr, F.lane); }
            else if (it < I4) { const int r = it - I3, kb = r / 8, nb = r % 8; transpose_item_f8<false>(F.in[I_WSG], 2048, 512, ws + WS_W_SHGU_T, gu_row(64 * nb, 0), 64 * kb, 64 * nb, scr, F.lane, F8_SW); }
            else if (it < I5) { const int r = it - I4, kb = r / 8, nb = r % 8; transpose_item_f8<false>(F.in[I_WSU], 2048, 512, ws + WS_W_SHGU_T, gu_row(64 * nb, 1), 64 * kb, 64 * nb, scr, F.lane, F8_SW); }
            else { const int r = it - I5, kb = r / 32, nb = r % 32; transpose_item_f8<false>(F.in[I_WSD], 512, 2048, ws + WS_W_SHD_T, 64 * nb, 64 * kb, 64 * nb, scr, F.lane, F8_SD); }
        }
    }
    {
        const float* wr = F.in[I_WROUTER]; bf16_t* hi = (bf16_t*)(ws + WS_WR); bf16_t* lo = hi + 64 * 2048;
        for (int idx = F.blk * 512 + F.tid; idx < 2048 * 64; idx += F.G * 512) {
            const int k = idx >> 6, e = idx & 63; const float w = wr[idx];
            const unsigned h16 = cvtpk(w, 0.f) & 0xffffu; const float res = w - __uint_as_float(h16 << 16);
            hi[e * 2048 + k] = (bf16_t)h16; lo[e * 2048 + k] = (bf16_t)(cvtpk(res, 0.f) & 0xffffu);
        }
    }
}

constexpr int CV_NCHUNK = 1536;
struct CvItem { const float* W; unsigned char* WT; int K, N, drow0, k0, n0; float scale; };
__device__ __forceinline__ CvItem cv_decode(Ctx& F, int it) {
    unsigned char* ws = F.ws; CvItem c;
    if (it < 16384) { const int r = it, e = r >> 8, r2 = r & 255, kb = r2 / 8, nb = r2 % 8;
        c.W = F.in[I_WEG] + (size_t)e * 2048 * 512; c.WT = ws + WS_W_EGU_T + (size_t)e * 1024 * 2048; c.scale = F8_SW; c.K = 2048; c.N = 512; c.drow0 = gu_row(64 * nb, 0); c.k0 = 64 * kb; c.n0 = 64 * nb; }
    else if (it < 32768) { const int r = it - 16384, e = r >> 8, r2 = r & 255, kb = r2 / 8, nb = r2 % 8;
        c.W = F.in[I_WEU] + (size_t)e * 2048 * 512; c.WT = ws + WS_W_EGU_T + (size_t)e * 1024 * 2048; c.scale = F8_SW; c.K = 2048; c.N = 512; c.drow0 = gu_row(64 * nb, 1); c.k0 = 64 * kb; c.n0 = 64 * nb; }
    else { const int r = it - 32768, e = r >> 8, r2 = r & 255, kb = r2 / 32, nb = r2 % 32;
        c.W = F.in[I_WED] + (size_t)e * 512 * 2048; c.WT = ws + WS_W_ED_T + (size_t)e * 2048 * 512; c.scale = F8_SD; c.K = 512; c.N = 2048; c.drow0 = 64 * nb; c.k0 = 64 * kb; c.n0 = 64 * nb; }
    return c;
}
__device__ __forceinline__ void convert_chunk(Ctx& F, int chunk) {
    LAS float* scr = (LAS float*)(F.lds + F.wave * TR_SCR);
    int lane = F.lane; asm volatile("" : "+v"(lane));
    const int it0 = chunk * 32 + F.wave * 4;
#pragma unroll 1
    for (int i = 0; i < 4; i += 2) { const CvItem a = cv_decode(F, it0 + i), b = cv_decode(F, it0 + i + 1);
        transpose_pair_f8(CvItemF8{a.W, a.WT, a.K, a.N, a.drow0, a.k0, a.n0, a.scale}, CvItemF8{b.W, b.WT, b.K, b.N, b.drow0, b.k0, b.n0, b.scale}, scr, lane); }
}
__device__ __forceinline__ int queue_take(Ctx& F, unsigned* head) {
    volatile LAS int* slot = (volatile LAS int*)(F.lds + MISC_OFF + 64);
    __syncthreads();
    if (F.tid == 0) *slot = (int)__hip_atomic_fetch_add(head, 1u, RLX_AGENT);
    __syncthreads();
    return *slot;
}

__device__ __forceinline__ void fill_mod_tables(Ctx& F, const float* gain, int shift_off, int scale_off, bool from_partials, int bsel = -1) {
    LAS float* A = (LAS float*)F.lds; LAS float* Bt = (LAS float*)(F.lds + 16384);
    const float* modp = (const float*)(F.ws + WS_MODP); const float* modf = (const float*)(F.ws + WS_MOD); const float* bada = F.in[I_BADA];
    const int lo = bsel < 0 ? 0 : bsel * 2048, hi = bsel < 0 ? 4096 : lo + 2048;
    for (int idx = lo + F.tid; idx < hi; idx += 512) {
        const int b = idx >> 11, c = idx & 2047;
        float sh, scl;
        if (from_partials) {
            sh = bada[shift_off + c]; scl = bada[scale_off + c];
#pragma unroll 16
            for (int ks = 0; ks < 32; ++ks) { sh += modp[((size_t)ks * 2 + b) * 12288 + shift_off + c]; scl += modp[((size_t)ks * 2 + b) * 12288 + scale_off + c]; }
        } else { sh = modf[b * 12288 + shift_off + c]; scl = modf[b * 12288 + scale_off + c]; }
        A[idx] = gain[c] * (1.0f + scl); Bt[idx] = sh;
    }
    __syncthreads();
}

__device__ __forceinline__ void p1_norm(Ctx& F) {
    { const float* modp = (const float*)(F.ws + WS_MODP); float* modf = (float*)(F.ws + WS_MOD); const float* bada = F.in[I_BADA];
      for (int idx = F.blk * 512 + F.tid; idx < 2 * 12288; idx += F.G * 512) { const int b = idx / 12288, j = idx % 12288; float s = bada[j];
#pragma unroll 8
          for (int ks = 0; ks < 32; ++ks) s += modp[((size_t)ks * 2 + b) * 12288 + j];
          modf[idx] = s; } }
    const int rpb = T / F.G;
    const bool one_batch = (F.G * rpb == T) && (SEQ % rpb == 0);
    const int row_lo = one_batch ? F.blk * rpb : 0, row_hi = one_batch ? row_lo + rpb : T, rstep = one_batch ? 8 : F.G * 8, r0 = one_batch ? row_lo + F.wave : F.blk * 8 + F.wave;
    fill_mod_tables(F, F.in[I_GMIX], 0, 2048, true, one_batch ? row_lo / SEQ : -1);
    const LAS float* A = (const LAS float*)F.lds; const LAS float* Bt = (const LAS float*)(F.lds + 16384);
    const float* x = F.in[I_X]; bf16_t* H = (bf16_t*)(F.ws + WS_H);
    for (int row = r0; row < row_hi; row += 2 * rstep) {
        const int row2 = row + rstep; const bool has2 = row2 < row_hi;
        const int b = row / SEQ, b2 = has2 ? row2 / SEQ : b;
        const f32x4* xr = (const f32x4*)(x + (size_t)row * 2048) + F.lane;
        const f32x4* xr2 = (const f32x4*)(x + (size_t)(has2 ? row2 : row) * 2048) + F.lane;
        f32x4 v[8], v2[8]; float ss = 0.f, ss2 = 0.f;
#pragma unroll
        for (int j = 0; j < 8; ++j) { v[j] = __builtin_nontemporal_load(xr + 64 * j); v2[j] = __builtin_nontemporal_load(xr2 + 64 * j); }
#pragma unroll
        for (int j = 0; j < 8; ++j) { ss += (v[j].x * v[j].x + v[j].y * v[j].y) + (v[j].z * v[j].z + v[j].w * v[j].w); ss2 += (v2[j].x * v2[j].x + v2[j].y * v2[j].y) + (v2[j].z * v2[j].z + v2[j].w * v2[j].w); }
        const float rstd = 1.0f / sqrtf(wave_sum(ss) * (1.0f / 2048.0f) + RMS_EPS), rstd2 = 1.0f / sqrtf(wave_sum(ss2) * (1.0f / 2048.0f) + RMS_EPS);
        unsigned long long* o8 = (unsigned long long*)(H + (size_t)row * 2048) + F.lane;
        unsigned long long* o82 = (unsigned long long*)(H + (size_t)row2 * 2048) + F.lane;
#pragma unroll
        for (int j = 0; j < 8; ++j) { const int c = 4 * F.lane + 256 * j;
            const f32x4 a = *(const LAS f32x4*)(A + b * 2048 + c), sft = *(const LAS f32x4*)(Bt + b * 2048 + c);
            const f32x4 y = v[j] * rstd * a + sft;
            if constexpr (P2F8) ((unsigned*)((unsigned char*)H + (size_t)row * 2048))[F.lane + 64 * j] = epi::pack4_f8(y.x * F8_SH, y.y * F8_SH, y.z * F8_SH, y.w * F8_SH);
            else o8[64 * j] = (unsigned long long)cvtpk(y.x, y.y) | ((unsigned long long)cvtpk(y.z, y.w) << 32);
            if (has2) { const f32x4 a2 = *(const LAS f32x4*)(A + b2 * 2048 + c), sft2 = *(const LAS f32x4*)(Bt + b2 * 2048 + c);
                const f32x4 y2 = v2[j] * rstd2 * a2 + sft2;
                if constexpr (P2F8) ((unsigned*)((unsigned char*)H + (size_t)row2 * 2048))[F.lane + 64 * j] = epi::pack4_f8(y2.x * F8_SH, y2.y * F8_SH, y2.z * F8_SH, y2.w * F8_SH);
                else o82[64 * j] = (unsigned long long)cvtpk(y2.x, y2.y) | ((unsigned long long)cvtpk(y2.z, y2.w) << 32); } }
    }
}

__device__ __forceinline__ void p3_kmean(Ctx& F) {
    const bf16_t* KMT = (const bf16_t*)(F.ws + WS_KMT); float* KM = (float*)(F.ws + WS_KMEAN);
    LAS float* red = (LAS float*)F.lds;
    for (int item = F.blk; item < 512; item += F.G) {
        const int b = item >> 8, h = (item >> 5) & 7, n = item & 31;
        const int cp = F.tid & 63, rg = F.tid >> 6;
        const bf16_t* base = KMT + (((size_t)h * 256 + b * 128 + 4 * n) * 64 + 32 * rg) * 128 + 2 * cp;
        float s0 = 0.f, s1 = 0.f;
#pragma unroll 8
        for (int rr = 0; rr < 32; ++rr) { const unsigned u = *(const unsigned*)(base + (size_t)rr * 128); s0 += bf_lo(u); s1 += bf_hi(u); }
        __syncthreads();
        red[rg * 128 + 2 * cp] = s0; red[rg * 128 + 2 * cp + 1] = s1;
        __syncthreads();
        if (F.tid < 128) { float s = 0.f;
#pragma unroll
            for (int g = 0; g < 8; ++g) s += red[g * 128 + F.tid];
            KM[(size_t)item * 128 + F.tid] = s * (1.0f / 256.0f); }
    }
    __syncthreads();
}

__device__ __forceinline__ void p4_gating(Ctx& F) {
    const bf16_t* QM = (const bf16_t*)(F.ws + WS_QM); const float* KM = (const float*)(F.ws + WS_KMEAN);
    float* ML = (float*)(F.ws + WS_ML); int* MLIST = (int*)(F.ws + WS_MLIST); unsigned* mcnt = F.ctl + CW_MCNT;
    for (int grp = F.blk; grp < T / 64; grp += F.G) {
        const int h = F.wave, tok = grp * 64 + F.lane, b = tok / SEQ, qs = tok % SEQ, cur = qs >> 8;
        const int curu = __builtin_amdgcn_readfirstlane(cur), bu = __builtin_amdgcn_readfirstlane(b);
        float q[128];
        const u32x4* qp = (const u32x4*)(QM + (size_t)tok * 1024 + h * 128);
#pragma unroll
        for (int i = 0; i < 16; ++i) { const u32x4 u = qp[i]; q[8 * i + 0] = bf_lo(u.x); q[8 * i + 1] = bf_hi(u.x); q[8 * i + 2] = bf_lo(u.y); q[8 * i + 3] = bf_hi(u.y);
            q[8 * i + 4] = bf_lo(u.z); q[8 * i + 5] = bf_hi(u.z); q[8 * i + 6] = bf_lo(u.w); q[8 * i + 7] = bf_hi(u.w); }
        float v0 = -INFINITY, v1 = -INFINITY, v2 = -INFINITY; int i0 = -1, i1 = -1, i2 = -1;
        const float* kmb = KM + (size_t)((bu * 8 + h) * 32) * 128;
        for (int n = 0; n < curu; ++n) {
            const float* km = kmb + n * 128;
            float a0 = 0.f, a1 = 0.f, a2 = 0.f, a3 = 0.f;
#pragma unroll
            for (int d = 0; d < 128; d += 4) { a0 += q[d] * km[d]; a1 += q[d + 1] * km[d + 1]; a2 += q[d + 2] * km[d + 2]; a3 += q[d + 3] * km[d + 3]; }
            const float s = (a0 + a1) + (a2 + a3);
            if (s > v0) { v2 = v1; i2 = i1; v1 = v0; i1 = i0; v0 = s; i0 = n; }
            else if (s > v1) { v2 = v1; i2 = i1; v1 = s; i1 = n; }
            else if (s > v2) { v2 = s; i2 = n; }
        }
        float* ml = ML + ((size_t)tok * 8 + h) * 8;
        if (i0 < 0) *(f32x2*)(ml + 0) = (f32x2){-INFINITY, 0.f};
        if (i1 < 0) *(f32x2*)(ml + 2) = (f32x2){-INFINITY, 0.f};
        if (i2 < 0) *(f32x2*)(ml + 4) = (f32x2){-INFINITY, 0.f};
        for (int n = 0; n < curu; ++n) {
            const bool hit = (i0 == n) || (i1 == n) || (i2 == n);
            const unsigned long long mask = __ballot(hit);
            if (mask) {
                const int cntw = __popcll(mask);
                unsigned base = 0;
                if (F.lane == 0) base = __hip_atomic_fetch_add(mcnt + ((bu * 8 + h) * 32 + n), (unsigned)cntw, RLX_AGENT);
                base = __builtin_amdgcn_readfirstlane(base);
                if (hit) { const int pos = base + __popcll(mask & ((1ull << F.lane) - 1ull)); const int slot = (i0 == n) ? 0 : ((i1 == n) ? 1 : 2);
                    MLIST[(size_t)((bu * 8 + h) * 32 + n) * 8192 + pos] = (qs << 2) | slot; }
            }
        }
    }
}

__device__ __forceinline__ void p6_merge(Ctx& F) {
    const bf16_t* PARTS = (const bf16_t*)(F.ws + WS_PARTS); const float* ML = (const float*)(F.ws + WS_ML); bf16_t* AM = (bf16_t*)(F.ws + WS_AM);
    const int gw = F.blk * 8 + F.wave, NGW = F.G * 8;
    for (int tok = gw; tok < T; tok += NGW) {
        f32x4 ml01[2], ml23[2]; u32x4 pu[2][4];
#pragma unroll
        for (int i = 0; i < 2; ++i) {
            const int item = F.lane + 64 * i, h = item >> 4, ch = item & 15;
            const float* ml = ML + ((size_t)tok * 8 + h) * 8;
            ml01[i] = *(const f32x4*)ml; ml23[i] = *(const f32x4*)(ml + 4);
            const bf16_t* pb = PARTS + (((size_t)tok * 8 + h) * 4) * 128 + ch * 8;
#pragma unroll
            for (int s4 = 0; s4 < 4; ++s4) pu[i][s4] = __builtin_nontemporal_load((const u32x4*)(pb + s4 * 128));
        }
#pragma unroll
        for (int i = 0; i < 2; ++i) {
            const int item = F.lane + 64 * i, h = item >> 4, ch = item & 15;
            const float m0 = ml01[i][0], l0 = ml01[i][1], m1 = ml01[i][2], l1 = ml01[i][3], m2 = ml23[i][0], l2 = ml23[i][1], m3 = ml23[i][2], l3 = ml23[i][3];
            const float M = fmaxf(fmaxf(m0, m1), fmaxf(m2, m3));
            const float w0 = l0 * fast_exp2(m0 - M), w1 = l1 * fast_exp2(m1 - M), w2 = l2 * fast_exp2(m2 - M), w3 = l3 * fast_exp2(m3 - M);
            const float inv = 1.0f / (w0 + w1 + w2 + w3);
            float acc[8];
#pragma unroll
            for (int j = 0; j < 8; ++j) acc[j] = 0.f;
            const float ws4[4] = {w0, w1, w2, w3};
#pragma unroll
            for (int s4 = 0; s4 < 4; ++s4) {
                const float w = ws4[s4]; u32x4 u = pu[i][s4];
                if (!(w > 0.f)) u = (u32x4){0u, 0u, 0u, 0u};
                acc[0] += w * bf_lo(u.x); acc[1] += w * bf_hi(u.x); acc[2] += w * bf_lo(u.y); acc[3] += w * bf_hi(u.y);
                acc[4] += w * bf_lo(u.z); acc[5] += w * bf_hi(u.z); acc[6] += w * bf_lo(u.w); acc[7] += w * bf_hi(u.w);
            }
            if constexpr (O78F8) { const float i8 = inv * F8_SAM;
                *(u32x2*)((unsigned char*)AM + (size_t)tok * 1024 + h * 128 + ch * 8) = (u32x2){epi::pack4_f8(acc[0] * i8, acc[1] * i8, acc[2] * i8, acc[3] * i8), epi::pack4_f8(acc[4] * i8, acc[5] * i8, acc[6] * i8, acc[7] * i8)}; }
            else { u32x4 o; o.x = cvtpk(acc[0] * inv, acc[1] * inv); o.y = cvtpk(acc[2] * inv, acc[3] * inv); o.z = cvtpk(acc[4] * inv, acc[5] * inv); o.w = cvtpk(acc[6] * inv, acc[7] * inv);
            *(u32x4*)(AM + (size_t)tok * 1024 + h * 128 + ch * 8) = o; }
        }
    }
}
constexpr int P9_RSTD = 32768, P9_LG = 33792, P9_LGROW = 68, P9_LCNT = P9_LG + 2 * 64 * P9_LGROW * 4, P9_LBASE = P9_LCNT + 256, P9_END = P9_LBASE + 256;
static_assert(P9_END <= RING_BYTES, "P9 LDS");
__device__ __forceinline__ void p9_route(Ctx& F) {
    fill_mod_tables(F, F.in[I_GFFN], 6144, 8192, false);
    const LAS float* A2 = (const LAS float*)F.lds; const LAS float* B2 = (const LAS float*)(F.lds + 16384);
    LAS float* rstd_l = (LAS float*)(F.lds + P9_RSTD); LAS float* LG = (LAS float*)(F.lds + P9_LG);
    LAS int* lcnt = (LAS int*)(F.lds + P9_LCNT); LAS int* lbase = (LAS int*)(F.lds + P9_LBASE);
    const bf16_t* x1 = (const bf16_t*)(F.ws + WS_X1); bf16_t* H2 = (bf16_t*)(F.ws + WS_H2); unsigned char* H2F8 = F.ws + WS_H2F8;
    const bf16_t* WRH = (const bf16_t*)(F.ws + WS_WR); const bf16_t* WRL = WRH + 64 * 2048;
    const float* rbias = F.in[I_RBIAS];
    int* ELIST = (int*)(F.ws + WS_ELIST); int* TOKE = (int*)(F.ws + WS_TOKE); float* TOKW = (float*)(F.ws + WS_TOKW);
    unsigned* ecnt = F.ctl + CW_ECNT;
    for (int grp = F.blk; grp < T / 64; grp += F.G) {
        const int tokb = grp * 64, b = tokb / SEQ;
        if (F.tid < 64) lcnt[F.tid] = 0;
        for (int i = 0; i < 8; i += 4) {
            const int tl = F.wave * 8 + i;
            u32x4 va[4][4];
#pragma unroll
            for (int q = 0; q < 4; ++q) { const u32x4* xr = (const u32x4*)(x1 + (size_t)(tokb + tl + q) * 2048) + F.lane;
#pragma unroll
                for (int j = 0; j < 4; ++j) va[q][j] = xr[64 * j]; }
#pragma unroll
            for (int q = 0; q < 4; ++q) { float ss = 0.f;
#pragma unroll
                for (int j = 0; j < 4; ++j) { const u32x4 u = va[q][j];
                    const float a0 = bf_lo(u.x), a1 = bf_hi(u.x), a2 = bf_lo(u.y), a3 = bf_hi(u.y), a4 = bf_lo(u.z), a5 = bf_hi(u.z), a6 = bf_lo(u.w), a7 = bf_hi(u.w);
                    ss += ((a0 * a0 + a1 * a1) + (a2 * a2 + a3 * a3)) + ((a4 * a4 + a5 * a5) + (a6 * a6 + a7 * a7)); }
                ss = wave_sum(ss);
                if (F.lane == 0) rstd_l[tl + q] = 1.0f / sqrtf(ss * (1.0f / 2048.0f) + RMS_EPS); }
        }
        __syncthreads();
        {
            const int tg = F.wave & 3, kh = F.wave >> 2, tc = F.lane & 15, kg = F.lane >> 4;
            const int tl = 16 * tg + tc; const float rs = rstd_l[tl];
            const bf16_t* xrow = x1 + (size_t)(tokb + tl) * 2048;
            bf16_t* hrow = H2 + (size_t)(tokb + tl) * 2048;
            f32x4 acc[4];
#pragma unroll
            for (int nt = 0; nt < 4; ++nt) acc[nt] = (f32x4){0.f, 0.f, 0.f, 0.f};
#pragma unroll 2
            for (int s = 32 * kh; s < 32 * kh + 32; ++s) {
                const int c0 = 32 * s + 8 * kg;
                const u32x4 xu = *(const u32x4*)(xrow + c0);
                const f32x4 xa = {bf_lo(xu.x), bf_hi(xu.x), bf_lo(xu.y), bf_hi(xu.y)}, xb = {bf_lo(xu.z), bf_hi(xu.z), bf_lo(xu.w), bf_hi(xu.w)};
                const f32x4 aa = *(const LAS f32x4*)(A2 + b * 2048 + c0), ab = *(const LAS f32x4*)(A2 + b * 2048 + c0 + 4);
                const f32x4 ba = *(const LAS f32x4*)(B2 + b * 2048 + c0), bb = *(const LAS f32x4*)(B2 + b * 2048 + c0 + 4);
                const f32x4 ya = xa * rs * aa + ba, yb = xb * rs * ab + bb;
                u32x4 hi; hi.x = cvtpk(ya[0], ya[1]); hi.y = cvtpk(ya[2], ya[3]); hi.z = cvtpk(yb[0], yb[1]); hi.w = cvtpk(yb[2], yb[3]);
                *(u32x2*)(H2F8 + (size_t)(tokb + tl) * 2048 + c0) = (u32x2){epi::pack4_f8(ya[0] * F8_SH, ya[1] * F8_SH, ya[2] * F8_SH, ya[3] * F8_SH), epi::pack4_f8(yb[0] * F8_SH, yb[1] * F8_SH, yb[2] * F8_SH, yb[3] * F8_SH)};
                u32x4 lo; lo.x = cvtpk(ya[0] - bf_lo(hi.x), ya[1] - bf_hi(hi.x)); lo.y = cvtpk(ya[2] - bf_lo(hi.y), ya[3] - bf_hi(hi.y));
                lo.z = cvtpk(yb[0] - bf_lo(hi.z), yb[1] - bf_hi(hi.z)); lo.w = cvtpk(yb[2] - bf_lo(hi.w), yb[3] - bf_hi(hi.w));
                const bf16x8 hf = __builtin_bit_cast(bf16x8, hi), lf = __builtin_bit_cast(bf16x8, lo);
#pragma unroll
                for (int nt = 0; nt < 4; ++nt) {
                    const bf16x8 wh = *(const bf16x8*)(WRH + (size_t)(16 * nt + tc) * 2048 + c0), wl = *(const bf16x8*)(WRL + (size_t)(16 * nt + tc) * 2048 + c0);
                    acc[nt] = __builtin_amdgcn_mfma_f32_16x16x32_bf16(wh, hf, acc[nt], 0, 0, 0);
                    acc[nt] = __builtin_amdgcn_mfma_f32_16x16x32_bf16(wh, lf, acc[nt], 0, 0, 0);
                    acc[nt] = __builtin_amdgcn_mfma_f32_16x16x32_bf16(wl, hf, acc[nt], 0, 0, 0);
                }
            }
#pragma unroll
            for (int nt = 0; nt < 4; ++nt) *(LAS f32x4*)(LG + (kh * 64 + tl) * P9_LGROW + 16 * nt + 4 * kg) = acc[nt];
        }
        __syncthreads();
        int se[8], sslot[8]; float sw[8];
        if (F.tid < 64) {
            LAS float* row0 = LG + F.tid * P9_LGROW; const LAS float* row1 = LG + (64 + F.tid) * P9_LGROW;
            float sl[64];
#pragma unroll
            for (int e = 0; e < 64; ++e) { const float s = sigmoidf_(row0[e] + row1[e]); row0[e] = s; sl[e] = s + rbias[e]; }
            float gs[8];
#pragma unroll
            for (int g = 0; g < 8; ++g) { float m1 = -INFINITY, m2 = -INFINITY;
#pragma unroll
                for (int j = 0; j < 8; ++j) { const float v = sl[8 * g + j]; if (v > m1) { m2 = m1; m1 = v; } else if (v > m2) m2 = v; }
                gs[g] = m1 + m2; }
            unsigned gmask = 0u;
#pragma unroll
            for (int it = 0; it < 4; ++it) { float best = -INFINITY; int bi = 0;
#pragma unroll
                for (int g = 0; g < 8; ++g) { const bool free_ = !((gmask >> g) & 1u); if (free_ && gs[g] > best) { best = gs[g]; bi = g; } }
                gmask |= 1u << bi; }
            unsigned long long picked = 0ull; float wsum = 0.f;
#pragma unroll
            for (int it = 0; it < 8; ++it) { float best = -INFINITY; int bi = 0;
#pragma unroll
                for (int e = 0; e < 64; ++e) { const bool ok = ((gmask >> (e >> 3)) & 1u) && !((picked >> e) & 1ull); if (ok && sl[e] > best) { best = sl[e]; bi = e; } }
                picked |= 1ull << bi; se[it] = bi; const float s = row0[bi]; sw[it] = s; wsum += s; }
            const float inv = 2.5f / wsum;
#pragma unroll
            for (int k = 0; k < 8; ++k) { sw[k] *= inv; sslot[k] = __hip_atomic_fetch_add(lcnt + se[k], 1, __ATOMIC_RELAXED, __HIP_MEMORY_SCOPE_WORKGROUP); }
        }
        __syncthreads();
        if (F.tid < 64) { const int c = lcnt[F.tid]; lbase[F.tid] = c > 0 ? (int)__hip_atomic_fetch_add(ecnt + F.tid, (unsigned)c, RLX_AGENT) : 0; }
        __syncthreads();
        if (F.tid < 64) { const int tok = tokb + F.tid;
#pragma unroll
            for (int k = 0; k < 8; ++k) { const int slot = lbase[se[k]] + sslot[k];
                ELIST[(size_t)se[k] * 16384 + slot] = tok; TOKE[tok * 8 + k] = (se[k] << 16) | slot; TOKW[tok * 8 + k] = sw[k]; } }
        __syncthreads();
    }
}

constexpr int MT_CNT = 0, MT_TST = 256, MT_COFF = 768, MT_GTAB = 2048;
__device__ __forceinline__ void moe_tables(Ctx& F) {
    LAS int* cnt = (LAS int*)(F.lds + LDSX_OFF + MT_CNT); LAS int* tst = (LAS int*)(F.lds + LDSX_OFF + MT_TST); LAS int* coff = (LAS int*)(F.lds + LDSX_OFF + MT_COFF);
    if (F.tid < 64) cnt[F.tid] = (int)__hip_atomic_load(F.ctl + CW_ECNT + F.tid, RLX_AGENT);
    __syncthreads();
    if (F.tid == 0) { int t = 0, c = 0; for (int e = 0; e < 64; ++e) { tst[e] = t; coff[e] = c; const int n = cnt[e]; t += (n + 255) >> 8; c += n; } tst[64] = t; coff[64] = c; }
    __syncthreads();
}
struct MoeSched {
    const LAS int* cnt; const LAS int* tst; const LAS int* coff; int G, c, npn_log2; const char* A; const char* B; size_t a_tile_bytes, b_exp_bytes, b_tile_bytes; bool compact;
    __device__ __forceinline__ bool next(int i, pg8::Unit& u) const {
        const int ntile = tst[64];
        const long L = (long)i * G + c; if (L >= ((long)ntile << npn_log2)) return false;
        const int rt = (int)(L >> npn_log2), pn = (int)(L & ((1 << npn_log2) - 1));
        int lo = 0, hi = 64;
#pragma unroll
        for (int s = 0; s < 6; ++s) { const int mid = (lo + hi) >> 1; if (tst[mid] <= rt) lo = mid; else hi = mid; }
        int e = lo;
        e = __builtin_amdgcn_readfirstlane(e);
        const int j = rt - __builtin_amdgcn_readfirstlane(tst[e]);
        const int n = __builtin_amdgcn_readfirstlane(cnt[e]);
        u.pm = rt; u.pn = pn; u.aux = e;
        u.valid = (n - 256 * j) < 256 ? (n - 256 * j) : 256;
        u.rowbase = compact ? (__builtin_amdgcn_readfirstlane(coff[e]) + 256 * j) : rt * 256;
        u.A = A + (size_t)rt * a_tile_bytes; u.B = B + (size_t)e * b_exp_bytes + (size_t)pn * b_tile_bytes;
        return true;
    }
};

__device__ __forceinline__ void p12_combine(Ctx& F) {
    moe_tables(F);
    const LAS int* coff = (const LAS int*)(F.lds + LDSX_OFF + MT_COFF);
    const unsigned char* Y = (const unsigned char*)(F.ws + WS_Y); const int* TOKE = (const int*)(F.ws + WS_TOKE); const float* TOKW = (const float*)(F.ws + WS_TOKW);
    const float* modf = (const float*)(F.ws + WS_MOD); const float* gfin = F.in[I_GFINAL]; const bf16_t* SHOUT = (const bf16_t*)(F.ws + WS_SHOUT);
    float* out = F.out;
    const int gw = F.blk * 8 + F.wave, NGW = F.G * 8;
    for (int tok = gw; tok < T; tok += NGW) {
        const int b = tok / SEQ;
        f32x4 acc[8];
        int es8[8]; float w8[8];
#pragma unroll
        for (int k = 0; k < 8; ++k) { es8[k] = TOKE[tok * 8 + k]; w8[k] = TOKW[tok * 8 + k]; }
        f32x4* xr = (f32x4*)(out + (size_t)tok * 2048) + F.lane;
        f32x4 v[8];
        { const unsigned long long* x1r = (const unsigned long long*)((const bf16_t*)(F.ws + WS_X1) + (size_t)tok * 2048) + F.lane;
#pragma unroll
          for (int j = 0; j < 8; ++j) { const unsigned long long u = __builtin_nontemporal_load(x1r + 64 * j); const unsigned lo = (unsigned)u, hi = (unsigned)(u >> 32);
              v[j] = (f32x4){bf_lo(lo), bf_hi(lo), bf_lo(hi), bf_hi(hi)}; } }
        { const unsigned* sr = (const unsigned*)((const unsigned char*)SHOUT + (size_t)tok * 2048) + F.lane;
#pragma unroll
          for (int j = 0; j < 8; ++j) { const int u = (int)__builtin_nontemporal_load(sr + 64 * j); const f32x2 lo = __builtin_amdgcn_cvt_pk_f32_fp8(u, false), hi = __builtin_amdgcn_cvt_pk_f32_fp8(u, true);
              acc[j].x = lo[0]; acc[j].y = lo[1]; acc[j].z = hi[0]; acc[j].w = hi[1]; } }
#pragma unroll
        for (int kk = 0; kk < 8; kk += 4) {
            unsigned yu[4][8];
#pragma unroll
            for (int k = 0; k < 4; ++k) { const int e = es8[kk + k] >> 16, slot = es8[kk + k] & 0xffff;
                const unsigned* yr = (const unsigned*)(Y + (size_t)(coff[e] + slot) * 2048) + F.lane;
#pragma unroll
                for (int j = 0; j < 8; ++j) yu[k][j] = __builtin_nontemporal_load(yr + 64 * j); }
#pragma unroll
            for (int k = 0; k < 4; ++k) { const float w = w8[kk + k];
#pragma unroll
                for (int j = 0; j < 8; ++j) { const int u = (int)yu[k][j]; const f32x2 lo = __builtin_amdgcn_cvt_pk_f32_fp8(u, false), hi = __builtin_amdgcn_cvt_pk_f32_fp8(u, true);
                    acc[j].x += w * lo[0]; acc[j].y += w * lo[1]; acc[j].z += w * hi[0]; acc[j].w += w * hi[1]; } }
        }
        float ss = 0.f;
#pragma unroll
        for (int j = 0; j < 8; ++j) { const int c = 4 * F.lane + 256 * j; const f32x4 g2 = *(const f32x4*)(modf + b * 12288 + 10240 + c);
            v[j] = v[j] + g2 * acc[j]; ss += (v[j].x * v[j].x + v[j].y * v[j].y) + (v[j].z * v[j].z + v[j].w * v[j].w); }
        const float rstd = 1.0f / sqrtf(wave_sum(ss) * (1.0f / 2048.0f) + RMS_EPS);
#pragma unroll
        for (int j = 0; j < 8; ++j) { const int c = 4 * F.lane + 256 * j; const f32x4 g = *(const f32x4*)(gfin + c); __builtin_nontemporal_store(v[j] * rstd * g, xr + 64 * j); }
    }
}
struct Args { const float* in[22]; float* out; unsigned char* ws; int ph_lo, ph_hi; };
static_assert(sizeof(Args) == 22 * 8 + 8 + 8 + 8, "Args has no padding");

__global__ void __launch_bounds__(512, 2) fwd_kernel(Args args) {
    extern __shared__ __attribute__((aligned(16))) unsigned char lds_raw[];
    Ctx F;
    F.lds = (LAS unsigned char*)lds_raw;
    F.tid = threadIdx.x; F.lane = F.tid & 63; F.wave = __builtin_amdgcn_readfirstlane(F.tid >> 6);
    F.G = gridDim.x; F.blk = blockIdx.x;
    F.ws = args.ws; F.ctl = (unsigned*)(args.ws + WS_CTL); F.out = args.out;
    F.in = args.in;
    volatile LAS unsigned* MISC = (volatile LAS unsigned*)(F.lds + MISC_OFF);
    if (F.tid < 32) MISC[F.tid] = 0u;
    __syncthreads();
    XcdBarrier bar; bar.bar = F.ctl + CW_BAR; bar.x = 0; bar.st = nullptr;
    if (MK_N_LAUNCHES == 1) bar = xcd_barrier_post(F.ctl + CW_BAR, MISC + 8);
    const int lo = args.ph_lo, hi = args.ph_hi;
    unsigned char* ws = args.ws;
#define IN(k) (lo <= (k) && (k) < hi && ((PHASE_MASK >> (k)) & 1u))
#define SEAM(k) do { if (MK_N_LAUNCHES == 1 && (k) + 1 < hi) xcd_barrier(bar); } while (0)
#define NREP(k) (((REP_MASK >> (k)) & 1u) ? 2 : 1)
    typedef pg8::StaticOrder SO;

    if (lo <= 0 && 0 < hi) { if (IN(0)) { for (int rep_ = 0; rep_ < NREP(0); ++rep_) { if (rep_) xcd_barrier(bar); p0_prologue(F); } } SEAM(0); }
    if (lo <= 1 && 1 < hi) { if (IN(1)) { for (int rep_ = 0; rep_ < NREP(1); ++rep_) { if (rep_) xcd_barrier(bar); p1_norm(F); } } SEAM(1); }
    if (lo <= 2 && 2 < hi) {
        if (IN(2)) {
#pragma unroll 1
        for (int rep_ = 0; rep_ < NREP(2); ++rep_) { if (rep_) xcd_barrier(bar);
            const char* H = (const char*)(ws + WS_H); const char* W = (const char*)(ws + WS_W_IN_T);
            constexpr int KP = P2F8 ? 1024 : 2048;
            { SO S; S.init(H, W, T, 8192, KP, F.G, F.blk);
              epi::ProjEpi E{epi::StoreQK8{ws + WS_QD, ws + WS_KDT, att::D8_QS, att::D8_KS}, epi::StoreQKboth{epi::StoreQK{(bf16_t*)(ws + WS_QM), (bf16_t*)(ws + WS_KMT), 1.0f}, ws + WS_QM8, ws + WS_KMT8}, epi::StoreBf16<1>{(bf16_t*)(ws + WS_GATES), 4096}};
              pg8::gemm_phase<epi::ProjEpi, SO, true, true, false, P2F8>(F.lds, KP, S, E, nullptr); }
            { SO S; S.init(W + (size_t)8192 * KP * 2, H, 2048, T, KP, F.G, F.blk); epi::ProjVT E{epi::StoreVT8{ws + WS_VDT, att::D8_VS}, epi::StoreVT8{ws + WS_VMT8, att::D8_VS}};
              pg8::gemm_phase<epi::ProjVT, SO, true, true, false, P2F8>(F.lds, KP, S, E, nullptr); }
        }
        }
        SEAM(2);
    }
    if (lo <= 3 && 3 < hi) {
        if (IN(3)) {
#pragma unroll 1
        for (int rep_ = 0; rep_ < NREP(3); ++rep_) { if (rep_) xcd_barrier(bar);
            const float* lv = F.in[I_LAMBDA];
            float d1 = 0.f, d2 = 0.f;
            for (int i = 0; i < 64; ++i) { d1 += lv[i] * lv[64 + i]; d2 += lv[128 + i] * lv[192 + i]; }
            if (F.tid == 0) *(LAS float*)(F.lds + MISC_OFF + 68) = expf(d1) - expf(d2) + 0.2f;
            {
                const int x = (int)(xb_xcc_id() & 7u);
                const bool converter = ((F.blk >> 3) & 3) == 3;
                if (converter) { for (int c = queue_take(F, F.ctl + CW_CQ); c < CV_NCHUNK; c = queue_take(F, F.ctl + CW_CQ)) { __syncthreads(); convert_chunk(F, c); } }
#pragma unroll 1
                for (int k = 0; k < 8; ++k) {
                    const int xq = (x + k) & 7;
#pragma unroll 1
                    for (int i = queue_take(F, F.ctl + CW_AQ + 64 * xq); i < 128; i = queue_take(F, F.ctl + CW_AQ + 64 * xq)) {
                        const int bh = 2 * xq + (i & 1), qt = 63 - (i >> 1);
                        att::diff_unit8(F.lds, bh >> 3, bh & 7, qt, ws + WS_QD, ws + WS_KDT, ws + WS_VDT, (bf16_t*)(ws + WS_AD), F.in[I_SUBLN], F.in[I_RELB]);
                    }
                }
                for (int c = queue_take(F, F.ctl + CW_CQ); c < CV_NCHUNK; c = queue_take(F, F.ctl + CW_CQ)) { __syncthreads(); convert_chunk(F, c); }
            }
            __syncthreads();
            p3_kmean(F);
        }
        }
        SEAM(3);
    }
    if (lo <= 4 && 4 < hi) { if (IN(4)) p4_gating(F); SEAM(4); }
    if (lo <= 5 && 5 < hi) {
        if (IN(5)) {
#pragma unroll 1
        for (int rep_ = 0; rep_ < NREP(5); ++rep_) { if (rep_) xcd_barrier(bar);
            constexpr int MB_CPU = 2;
            LAS int* pre = (LAS int*)(F.lds + LDSX_OFF);
            const unsigned* mcnt = F.ctl + CW_MCNT;
            const int mycnt = (int)__hip_atomic_load(mcnt + F.tid, RLX_AGENT);
            pre[F.tid] = (1 + ((mycnt + 255) >> 8) + MB_CPU - 1) / MB_CPU;
            __syncthreads();
            int src = 0;
            for (int off = 1; off < 512; off <<= 1) { const int v = pre[src * 512 + F.tid] + (F.tid >= off ? pre[src * 512 + F.tid - off] : 0); pre[(src ^ 1) * 512 + F.tid] = v; src ^= 1; __syncthreads(); }
            LAS int* inc = (LAS int*)(F.lds + att::MB_INC);
            inc[F.tid] = pre[src * 512 + F.tid];
            __syncthreads();
            const int total = inc[511];
            for (int u = F.blk; u < total; u += F.G) {
                int lo_ = -1, hi_ = 511;
#pragma unroll
                for (int st = 0; st < 9; ++st) { const int mid = (lo_ + hi_) >> 1; if (inc[mid] > u) hi_ = mid; else lo_ = mid; }
                const int l = __builtin_amdgcn_readfirstlane(hi_);
                const int before = l > 0 ? __builtin_amdgcn_readfirstlane(inc[l - 1]) : 0;
                const int j = u - before;
                const int cntl = (int)__builtin_amdgcn_readfirstlane(__hip_atomic_load(mcnt + l, RLX_AGENT));
                const int nch = 1 + ((cntl + 255) >> 8);
                const int c0 = j * MB_CPU, c1 = (c0 + MB_CPU) < nch ? (c0 + MB_CPU) : nch;
                att::moba_block8(F.lds, l >> 8, (l >> 5) & 7, l & 31, (const int*)(ws + WS_MLIST) + (size_t)l * 8192, cntl, c0, c1, ws + WS_QM8, ws + WS_KMT8, ws + WS_VMT8, (bf16_t*)(ws + WS_PARTS), (float*)(ws + WS_ML), F.in[I_RELB]);
            }
            __syncthreads();
        }
        }
        SEAM(5);
    }
    if (lo <= 6 && 6 < hi) { if (IN(6)) { for (int rep_ = 0; rep_ < NREP(6); ++rep_) { if (rep_) xcd_barrier(bar); p6_merge(F); } } SEAM(6); }
    if (lo <= 7 && 7 < hi) {
        if (IN(7)) {
#pragma unroll 1
        for (int rep_ = 0; rep_ < NREP(7); ++rep_) { if (rep_) xcd_barrier(bar);
            { pg8::PairOrder S; S.init(ws + WS_AD, ws + WS_W_OD_T, ws + WS_AM, ws + WS_W_OM_T, T, 2048, O78F8 ? 512 : 1024, F.G, F.blk);
              epi::GatePair E{epi::GateMul<0>{(const bf16_t*)(ws + WS_GATES), 0, nullptr, (bf16_t*)(ws + WS_T1)}, epi::GateMul<1>{(const bf16_t*)(ws + WS_GATES), 2048, (const bf16_t*)(ws + WS_T1), (bf16_t*)(ws + WS_G)}};
              pg8::gemm_phase<epi::GatePair, pg8::PairOrder, true, true, false, O78F8>(F.lds, O78F8 ? 512 : 1024, S, E, nullptr); }
        }
        }
        SEAM(7);
    }
    if (lo <= 8 && 8 < hi) {
        if (IN(8)) {
#pragma unroll 1
        for (int rep_ = 0; rep_ < NREP(8); ++rep_) { if (rep_) xcd_barrier(bar);
            SO S; S.init(ws + WS_G, ws + WS_W_OUT_T, T, 2048, O78F8 ? 1024 : 2048, F.G, F.blk); epi::ResidBf16 E{F.in[I_X], (bf16_t*)(ws + WS_X1), (const float*)(ws + WS_MOD), 4096};
            pg8::gemm_phase<epi::ResidBf16, SO, true, true, false, O78F8>(F.lds, O78F8 ? 1024 : 2048, S, E, nullptr);
        }
        }
        SEAM(8);
    }
    if (lo <= 9 && 9 < hi) { if (IN(9)) p9_route(F); SEAM(9); }
    if (lo <= 10 && 10 < hi) {
        if (IN(10)) {
#pragma unroll 1
        for (int rep_ = 0; rep_ < NREP(10); ++rep_) { if (rep_) xcd_barrier(bar);
            moe_tables(F);
            MoeSched S{(const LAS int*)(F.lds + LDSX_OFF + MT_CNT), (const LAS int*)(F.lds + LDSX_OFF + MT_TST), (const LAS int*)(F.lds + LDSX_OFF + MT_COFF), F.G, F.blk, 2,
                       (const char*)(ws + WS_H2F8), (const char*)(ws + WS_W_EGU_T), 0, (size_t)1024 * 2048, (size_t)256 * 2048, false};
            LAS unsigned short* gtab = (LAS unsigned short*)(F.lds + LDSX_OFF + MT_GTAB);
            { const int* ELIST = (const int*)(ws + WS_ELIST); pg8::Unit u;
              for (int i = 0; i < 24 && S.next(i, u); ++i) { if (F.tid < 256) { const int j = u.pm - S.tst[u.aux]; gtab[i * 256 + F.tid] = (unsigned short)(F.tid < u.valid ? ELIST[(size_t)u.aux * 16384 + 256 * j + F.tid] : 0); } } }
            __syncthreads();
            { epi::SwiGLU8 E{ws + WS_ACT}; pg8::gemm_phase<epi::SwiGLU8, MoeSched, true, true, true, true>(F.lds, 1024, S, E, gtab); }
            { SO S2; S2.init(ws + WS_H2F8, ws + WS_W_SHGU_T, T, 1024, 1024, F.G, F.blk); epi::SwiGLU8 E{ws + WS_SHACT};
              pg8::gemm_phase<epi::SwiGLU8, SO, true, true, false, true>(F.lds, 1024, S2, E, nullptr); }
        }
        }
        SEAM(10);
    }
    if (lo <= 11 && 11 < hi) {
        if (IN(11)) {
            moe_tables(F);
            MoeSched S{(const LAS int*)(F.lds + LDSX_OFF + MT_CNT), (const LAS int*)(F.lds + LDSX_OFF + MT_TST), (const LAS int*)(F.lds + LDSX_OFF + MT_COFF), F.G, F.blk, 3,
                       (const char*)(ws + WS_ACT), (const char*)(ws + WS_W_ED_T), (size_t)256 * 512, (size_t)2048 * 512, (size_t)256 * 512, true};
#pragma unroll 1
            for (int rep_ = 0; rep_ < NREP(11); ++rep_) { if (rep_) xcd_barrier(bar);
            { epi::DownY E{(unsigned char*)(ws + WS_Y)}; pg8::gemm_phase<epi::DownY, MoeSched, true, true, false, true>(F.lds, 256, S, E, nullptr); } }
            { SO S2; S2.init(ws + WS_SHACT, ws + WS_W_SHD_T, T, 2048, 256, F.G, F.blk); epi::DownShared8 E{ws + WS_SHOUT};
              pg8::gemm_phase<epi::DownShared8, SO, true, true, false, true>(F.lds, 256, S2, E, nullptr); }
        }
        SEAM(11);
    }
    if (lo <= 12 && 12 < hi) { if (IN(12)) p12_combine(F); }
#undef IN
#undef SEAM
}

extern "C" void kernel_launch(void* const* d_in, const int* in_sizes, int n_in, void* d_out, int out_size, void* d_ws, size_t ws_size, hipStream_t stream) {
    static int grid = 0;
    if (grid == 0) {
        if (n_in != 22 || in_sizes[0] != T * D || out_size != T * D || ws_size < WS_END) { fprintf(stderr, "kernel_launch: unexpected shapes (n_in %d, in0 %d, out %d, ws %zu < %zu); nothing launched\n", n_in, n_in > 0 ? in_sizes[0] : -1, out_size, ws_size, (size_t)WS_END); grid = -1; return; }
        int dev = 0, cus = 0, per_cu = 0;
        if (hipGetDevice(&dev) != hipSuccess || hipDeviceGetAttribute(&cus, hipDeviceAttributeMultiprocessorCount, dev) != hipSuccess) { grid = -1; return; }
        if (hipFuncSetAttribute((const void*)fwd_kernel, hipFuncAttributeMaxDynamicSharedMemorySize, LDS_BYTES) != hipSuccess) { fprintf(stderr, "kernel_launch: hipFuncSetAttribute failed\n"); grid = -1; return; }
        if (hipOccupancyMaxActiveBlocksPerMultiprocessor(&per_cu, (const void*)fwd_kernel, 512, LDS_BYTES) != hipSuccess || per_cu < 1) fprintf(stderr, "kernel_launch: occupancy query says %d\n", per_cu);
        (void)hipGetLastError();
        grid = cus;
    }
    if (grid < 0) return;
    if (hipMemsetAsync((char*)d_ws + WS_CTL, 0, CTL_ZERO_BYTES, stream) != hipSuccess) { fprintf(stderr, "kernel_launch: memset failed\n"); return; }
    Args a{};
    for (int i = 0; i < 22; ++i) a.in[i] = (const float*)d_in[i];
    a.out = (float*)d_out; a.ws = (unsigned char*)d_ws;
    for (int li = 0; li < MK_N_LAUNCHES; ++li) {
        a.ph_lo = (MK_N_LAUNCHES == 1) ? 0 : li; a.ph_hi = (MK_N_LAUNCHES == 1) ? NPHASE : li + 1;
        hipLaunchKernelGGL(fwd_kernel, dim3(grid), dim3(512), LDS_BYTES, stream, a);
        const hipError_t le = hipPeekAtLastError();
        if (le != hipSuccess) { fprintf(stderr, "kernel_launch: launch %d failed: %s\n", li, hipGetErrorName(le)); break; }
    }
}
```

```cpp
#include <hip/hip_runtime.h>
#include <cstdio>
#include <cstdint>

#define LAS __attribute__((address_space(3)))
#define GAS __attribute__((address_space(1)))
typedef unsigned short bf16_t;
typedef short bf16x8 __attribute__((ext_vector_type(8)));
typedef short s16x4 __attribute__((ext_vector_type(4)));
typedef int i32x4 __attribute__((ext_vector_type(4)));
typedef int i32x8 __attribute__((ext_vector_type(8)));
typedef float f32x4 __attribute__((ext_vector_type(4)));
typedef float f32x2 __attribute__((ext_vector_type(2)));
typedef float f32x16 __attribute__((ext_vector_type(16)));
typedef unsigned u32x4 __attribute__((ext_vector_type(4)));
typedef unsigned u32x2 __attribute__((ext_vector_type(2)));
typedef __bf16 bf16x2_t __attribute__((ext_vector_type(2)));

#ifndef MK_N_LAUNCHES
#define MK_N_LAUNCHES 1
#endif
#ifndef REP_MASK
#define REP_MASK 0u
#endif
#ifndef PHASE_MASK
#define PHASE_MASK 0xFFFFFFFFu
#endif

constexpr int NB = 2, SEQ = 8192, T = NB * SEQ, D = 2048, NH = 8, INC = 10240, NE = 64, EDIM = 512, TOPK = 8;
constexpr int NPHASE = 13;
constexpr float RMS_EPS = 1e-6f;
constexpr float LOG2E = 1.4426950408889634f;

constexpr size_t MiB = 1u << 20;
constexpr size_t WS_CTL = 0, CTL_ZERO_BYTES = 1 * MiB;
constexpr size_t WS_MODP = 1 * MiB;
constexpr size_t WS_MOD = 4 * MiB;
constexpr size_t WS_KMEAN = 4 * MiB + 256 * 1024;
constexpr size_t WS_WR = 4 * MiB + 512 * 1024;
constexpr size_t WS_TOKE = 5 * MiB;
constexpr size_t WS_TOKW = 5 * MiB + 512 * 1024;
constexpr size_t WS_W_IN_T = 8 * MiB;
constexpr size_t WS_W_OD_T = 48 * MiB;
constexpr size_t WS_W_OM_T = 52 * MiB;
constexpr size_t WS_W_OUT_T = 56 * MiB;
constexpr size_t WS_W_SHGU_T = 64 * MiB;
constexpr size_t WS_W_SHD_T = 68 * MiB;
constexpr size_t WS_ELIST = 70 * MiB;
constexpr size_t WS_W_ED_T = 76 * MiB;
constexpr size_t WS_W_EGU_T = 204 * MiB;
constexpr size_t WS_H = 460 * MiB;
constexpr size_t WS_QD = 524 * MiB;
constexpr size_t WS_KDT = 556 * MiB;
constexpr size_t WS_VDT = 588 * MiB;
constexpr size_t WS_QM = 620 * MiB;
constexpr size_t WS_KMT = 652 * MiB;
constexpr size_t WS_VMT = 684 * MiB;
constexpr size_t WS_GATES = 716 * MiB;
constexpr size_t WS_AD = 844 * MiB;
constexpr size_t WS_AM = 876 * MiB;
constexpr size_t WS_ML = 908 * MiB;
constexpr size_t WS_MLIST = 912 * MiB;
constexpr size_t WS_PARTS = 460 * MiB;
constexpr size_t WS_G = 460 * MiB;
constexpr size_t WS_T1 = 524 * MiB;
constexpr size_t WS_X1 = 524 * MiB;
constexpr size_t WS_H2 = 588 * MiB;
constexpr size_t WS_ACT = 716 * MiB;
constexpr size_t WS_H2F8 = 800 * MiB;
constexpr float F8_SH = 8.0f, F8_SW = 64.0f, F8_SA = 8.0f, F8_SD = 32.0f;
namespace att { constexpr float D8_QS = 0.125f * LOG2E * 16.0f, D8_KS = 4.0f, D8_VS = 8.0f; }
constexpr size_t WS_QM8 = 604 * MiB, WS_VMT8 = 684 * MiB, WS_KMT8 = 700 * MiB;
namespace att { constexpr float MB8_QS = 0.08838834764831845f * LOG2E * 16.0f; }
constexpr float F8_SPART = 16.0f;
constexpr bool O78F8 = true;
constexpr float F8_SAD = 16.0f, F8_SAM = 64.0f, F8_SWO = 32.0f, F8_SG = 16.0f, F8_SWOUT = 64.0f;
constexpr bool P2F8 = true;
constexpr float DS2 = 1.0f;
constexpr int P2_EXP = 9;
constexpr size_t WS_SHACT = 860 * MiB;
constexpr size_t WS_SHOUT = 588 * MiB;
constexpr size_t WS_Y = 204 * MiB;
constexpr size_t WS_END = 928 * MiB;
static_assert(WS_Y + (size_t)131072 * 2048 * 2 <= WS_ACT, "Y must not reach ACT");
static_assert(WS_ACT + (size_t)147456 * 512 * 2 <= WS_SHACT && WS_SHACT + (size_t)T * 512 * 2 <= WS_END, "act map");
static_assert(WS_PARTS + (size_t)T * 8 * 4 * 128 * 2 <= WS_VDT, "parts overlay");

constexpr int CW_BAR = 4096;
constexpr int CW_ECNT = 8192;
constexpr int CW_MCNT = 8448;
constexpr int CW_AQ = 9216;
constexpr int CW_CQ = 9216 + 64 * 8;

constexpr int RING_BYTES = 131072;
constexpr int LDSX_OFF = RING_BYTES;
constexpr int MISC_OFF = RING_BYTES + 16384;
constexpr int LDS_BYTES = MISC_OFF + 128;

#define LDS_WAIT() asm volatile("s_waitcnt lgkmcnt(0)" ::: "memory")
#define VM_WAIT() asm volatile("s_waitcnt vmcnt(0)" ::: "memory")
#define RLX_AGENT __ATOMIC_RELAXED, __HIP_MEMORY_SCOPE_AGENT

__device__ __forceinline__ unsigned cvtpk(float lo, float hi) { f32x2 v = {lo, hi}; bf16x2_t b = __builtin_convertvector(v, bf16x2_t); return __builtin_bit_cast(unsigned, b); }
__device__ __forceinline__ float bf_lo(unsigned u) { return __uint_as_float(u << 16); }
__device__ __forceinline__ float bf_hi(unsigned u) { return __uint_as_float(u & 0xffff0000u); }
__device__ __forceinline__ float wave_sum(float v) {
#pragma unroll
    for (int o = 1; o < 64; o <<= 1) v += __shfl_xor(v, o);
    return v;
}
__device__ __forceinline__ float fast_exp2(float x) { return __builtin_amdgcn_exp2f(x); }
__device__ __forceinline__ float fast_rcp(float x) { return __builtin_amdgcn_rcpf(x); }
__device__ __forceinline__ float sigmoidf_(float x) { return fast_rcp(1.0f + fast_exp2(-x * LOG2E)); }
__device__ __forceinline__ float siluf_(float x) { return x * sigmoidf_(x); }

#define XB_TMO      128
#define XB_XCNT(j)  (256  + 64 * (j))
#define XB_XSUB(j)  (1280 + 64 * (j))
#define XB_XGEN(j)  (2304 + 64 * (j))
#define XB_TOP      3328
#define XB_TOPGEN   3392
#define XCD_BAR_WORDS 3456
#define XB_SPIN_CAP (1u << 22)

__device__ __forceinline__ unsigned xb_ld(unsigned* p)              { return __hip_atomic_load(p, __ATOMIC_RELAXED, __HIP_MEMORY_SCOPE_AGENT); }
__device__ __forceinline__ unsigned xb_add(unsigned* p, unsigned v) { return __hip_atomic_fetch_add(p, v, __ATOMIC_RELAXED, __HIP_MEMORY_SCOPE_AGENT); }
__device__ __forceinline__ unsigned xb_xcc_id() { return (unsigned)__builtin_amdgcn_s_getreg((3 << 11) | 20) & 0xFu; }
#define XB_SPIN(cond, bar) do { unsigned _sp = 0; while (cond) { __builtin_amdgcn_s_sleep(1); \
    if ((++_sp & 255u) == 0u) { if (xb_ld(&(bar)[XB_TMO])) break; if (_sp > XB_SPIN_CAP) { atomicAdd(&(bar)[XB_TMO], 1u); break; } } } } while (0)

struct XcdBarrier { unsigned* bar; unsigned x; volatile LAS unsigned* st; };

__device__ __forceinline__ XcdBarrier xcd_barrier_post(unsigned* bar, volatile LAS unsigned* st) {
    XcdBarrier b; b.bar = bar; b.x = xb_xcc_id(); b.st = st;
    if (threadIdx.x == 0) (void)xb_add(&bar[XB_XCNT(b.x)], 1u);
    return b;
}
__device__ __forceinline__ void xcd_barrier_complete(unsigned* bar, unsigned x, unsigned& nloc, unsigned& nx) {
    const unsigned G = gridDim.x * gridDim.y * gridDim.z;
    unsigned sum, cnt, mine, sp = 0u;
    for (;;) {
        sum = 0u; cnt = 0u; mine = 0u;
#pragma unroll
        for (unsigned j = 0; j < 16; ++j) { const unsigned c = xb_ld(&bar[XB_XCNT(j)]); sum += c; cnt += (c > 0u) ? 1u : 0u; mine = (j == x) ? c : mine; }
        if (sum == G) break;
        __builtin_amdgcn_s_sleep(1);
        if ((++sp & 255u) == 0u) { if (xb_ld(&bar[XB_TMO])) break; if (sp > XB_SPIN_CAP) { atomicAdd(&bar[XB_TMO], 1u); break; } }
    }
    nloc = mine > 0u ? mine : 1u; nx = cnt > 0u ? cnt : 1u;
}
__device__ __forceinline__ void xcd_barrier(const XcdBarrier& b) {
    asm volatile("s_waitcnt vmcnt(0)" ::: "memory");
    __syncthreads();
    if (threadIdx.x == 0) {
        unsigned* bar = b.bar;
        __builtin_amdgcn_s_waitcnt(0);
        unsigned nloc = b.st[0], nx = b.st[1];
        if (nloc == 0u) { xcd_barrier_complete(bar, b.x, nloc, nx); b.st[0] = nloc; b.st[1] = nx; }
        const unsigned old = xb_add(&bar[XB_XSUB(b.x)], 1u);
        const unsigned gen = old / nloc;
        if (old + 1u == (gen + 1u) * nloc) {
            __builtin_amdgcn_fence(__ATOMIC_RELEASE, "agent");
            asm volatile("s_waitcnt vmcnt(0)" ::: "memory");
            const unsigned og = xb_add(&bar[XB_TOP], 1u);
            const unsigned tg = og / nx;
            if (og + 1u == (tg + 1u) * nx) xb_add(&bar[XB_TOPGEN], 1u);
            else XB_SPIN(xb_ld(&bar[XB_TOPGEN]) == tg, bar);
            __builtin_amdgcn_fence(__ATOMIC_ACQUIRE, "agent");
            xb_add(&bar[XB_XGEN(b.x)], 1u);
            asm volatile("s_waitcnt vmcnt(0)" ::: "memory");
        } else {
            XB_SPIN(xb_ld(&bar[XB_XGEN(b.x)]) == gen, bar);
            __builtin_amdgcn_fence(__ATOMIC_ACQUIRE, "agent");
            asm volatile("s_waitcnt vmcnt(0)" ::: "memory");
        }
    }
    __syncthreads();
}

namespace pg8 {
constexpr int BM = 256, BK = 64, HALF = 128, HTB = HALF * BK * 2, STAGE_BYTES = 8 * HTB, NXCD = 8, WGM = 8;
static_assert(STAGE_BYTES == RING_BYTES, "ring");
__host__ __device__ __forceinline__ int lds_byte(int r, int c) { const int st = (r >> 4) * 2 + (c >> 5), rr = r & 15, cc = c & 31, ob = rr * 64 + cc * 2; return st * 1024 + (ob ^ (((ob >> 9) & 1) << 5)); }
__host__ __device__ __forceinline__ void stage_rc(int b, int& R, int& C) { const int st = b / 1024, sb = b % 1024, swz = sb ^ (((sb >> 9) & 1) << 5); R = (st >> 1) * 16 + swz / 64; C = (st & 1) * 32 + (swz % 64) / 2; }
__host__ __device__ __forceinline__ int perm32(int rho) { const int n = rho >> 4, i = rho & 15; return 8 * (i >> 2) + 4 * n + (i & 3); }

struct Unit { int pm, pn; const char* A; const char* B; int rowbase, valid, aux; };

struct StaticOrder {
    int nM, nN, nwg, G, c; const char* A; const char* B; size_t tstep;
    __device__ void init(const void* A_, const void* B_, int M, int N, int K, int G_, int c_) { A = (const char*)A_; B = (const char*)B_; nM = M / BM; nN = N / BM; nwg = nM * nN; G = G_; c = c_; tstep = (size_t)BM * K * 2; }
    __device__ bool next(int i, Unit& u) const {
        const long L = (long)i * G + c; if (L >= nwg) return false;
        int wgid = (int)L; { const int q = nwg / NXCD, r = nwg % NXCD, xcd = wgid % NXCD, off = wgid / NXCD; wgid = (xcd < r ? xcd * (q + 1) : r * (q + 1) + (xcd - r) * q) + off; }
        const int nig = WGM * nN, gid = wgid / nig, fm = gid * WGM, gsz = (nM - fm) < WGM ? (nM - fm) : WGM;
        u.pm = fm + ((wgid % nig) % gsz); u.pn = (wgid % nig) / gsz;
        u.A = A + (size_t)u.pm * tstep; u.B = B + (size_t)u.pn * tstep; u.rowbase = u.pm * BM; u.valid = BM; u.aux = 0; return true;
    }
};

struct PairOrder {
    StaticOrder base; const char* A1; const char* B1;
    __device__ void init(const void* A0_, const void* B0_, const void* A1_, const void* B1_, int M, int N, int K, int G_, int c_) { base.init(A0_, B0_, M, N, K, G_, c_); A1 = (const char*)A1_; B1 = (const char*)B1_; }
    __device__ bool next(int i, Unit& u) const {
        if (!base.next(i >> 1, u)) return false;
        if (i & 1) { u.A = A1 + (size_t)u.pm * base.tstep; u.B = B1 + (size_t)u.pn * base.tstep; u.aux = 1; }
        return true;
    }
};

template <class Epi, class Sched, bool ALIGN_EPI, bool SP2, bool GATHER, bool F8 = false>
__device__ __forceinline__ void gemm_phase(LAS unsigned char* lds, const int K, const Sched& S, const Epi& E, const LAS unsigned short* gtab) {
    int tid_ = threadIdx.x; asm volatile("" : "+v"(tid_));
    const int tid = tid_, wid = __builtin_amdgcn_readfirstlane(tid >> 6), lane = tid & 63, wr = wid >> 2, wc = wid & 3, fr = lane & 15, fq = lane >> 4;
    const int nt = K / BK;
    unsigned voffA[2], voffB[2]; int RA[2], CA[2];
#pragma unroll
    for (int i = 0; i < 2; ++i) { int R, C; stage_rc(tid * 16 + i * 8192, R, C); const int Rb = (int)Epi::PERM == 2 ? (64 * (R >> 5) + 16 * ((R >> 2) & 3) + 4 * ((R >> 4) & 1) + (R & 3)) : (Epi::PERM ? ((R & ~31) + perm32(R & 31)) : R);
        RA[i] = R; CA[i] = C; voffA[i] = (unsigned)(R * K + C) * 2u; voffB[i] = (unsigned)(Rb * K + C) * 2u; }
    const size_t kstep = (size_t)(BK * 2);
    const size_t hstep = (size_t)HALF * K * 2;
    const size_t hstepB = (int)Epi::PERM == 2 ? (size_t)8 * K * 2 : hstep;
    const unsigned ldsw = (unsigned)wid * 1024u;
    const int aoff = lds_byte(wr * 64 + fr, fq * 8), boff = lds_byte(wc * 32 + fr, fq * 8);
    unsigned vA[2][2], nvA[2][2];
#define PG8_SA(b, h) (((b) * 2 + (h)) * HTB)
#define PG8_SB(b, h) ((4 + (b) * 2 + (h)) * HTB)
#define PG8_GL(gp, ldsoff) __builtin_amdgcn_global_load_lds((const unsigned*)(gp), (LAS unsigned*)(lds + (ldsoff)), 16, 0, 0)
#define PG8_STAGE(bufoff, gbase, voff) do { _Pragma("unroll") for (int _i = 0; _i < 2; ++_i) PG8_GL((const char*)(gbase) + (voff)[_i], (bufoff) + ldsw + _i * 8192); } while (0)
#define PG8_STA(bufoff, gbase, h, nx) do { if constexpr (GATHER) { \
        const unsigned _o0 = (nx) ? nvA[h][0] : vA[h][0], _o1 = (nx) ? nvA[h][1] : vA[h][1]; \
        PG8_GL((const char*)(gbase) + _o0, (bufoff) + ldsw); PG8_GL((const char*)(gbase) + _o1, (bufoff) + ldsw + 8192); \
    } else { PG8_STAGE(bufoff, (const char*)(gbase) + (h) * hstep, voffA); } } while (0)
#define PG8_GVA(dst, ul) do { _Pragma("unroll") for (int _h = 0; _h < 2; ++_h) _Pragma("unroll") for (int _i = 0; _i < 2; ++_i) \
        dst[_h][_i] = (unsigned)gtab[(ul) * 256 + _h * 128 + RA[_i]] * (unsigned)(K * 2) + (unsigned)(CA[_i] * 2); } while (0)
#define PG8_LDA(dst, b, h) do { _Pragma("unroll") for (int m = 0; m < 4; ++m) _Pragma("unroll") for (int k = 0; k < 2; ++k) dst[m][k] = *(const LAS bf16x8*)(lds + PG8_SA(b, h) + aoff + m * 2048 + k * 1024); } while (0)
#define PG8_LDB(dst, b, h) do { _Pragma("unroll") for (int n = 0; n < 2; ++n) _Pragma("unroll") for (int k = 0; k < 2; ++k) dst[n][k] = *(const LAS bf16x8*)(lds + PG8_SB(b, h) + boff + n * 2048 + k * 1024); } while (0)
#define PG8_MMA(ai, bj, At, Bt) do { __builtin_amdgcn_s_setprio(1); _Pragma("unroll") for (int m = 0; m < 4; ++m) _Pragma("unroll") for (int n = 0; n < 2; ++n) { \
        if constexpr (F8) { const i32x4 _b0 = __builtin_bit_cast(i32x4, Bt[n][0]), _b1 = __builtin_bit_cast(i32x4, Bt[n][1]), _a0 = __builtin_bit_cast(i32x4, At[m][0]), _a1 = __builtin_bit_cast(i32x4, At[m][1]); \
            const i32x8 _b8 = __builtin_shufflevector(_b0, _b1, 0, 1, 2, 3, 4, 5, 6, 7), _a8 = __builtin_shufflevector(_a0, _a1, 0, 1, 2, 3, 4, 5, 6, 7); \
            asm volatile("v_mfma_scale_f32_16x16x128_f8f6f4 %0, %1, %2, %0, %3, %4 op_sel_hi:[0,0,0]" : "+v"(acc[ai][bj][m][n]) : "v"(_b8), "v"(_a8), "v"(f8sc), "v"(f8one)); } \
        else { _Pragma("unroll") for (int k = 0; k < 2; ++k) acc[ai][bj][m][n] = __builtin_amdgcn_mfma_f32_16x16x32_bf16(Bt[n][k], At[m][k], acc[ai][bj][m][n], 0, 0, 0); } } __builtin_amdgcn_s_setprio(0); } while (0)
#define PG8_WAIT_V(n) asm volatile("s_waitcnt vmcnt(" #n ")" ::: "memory")
#define PG8_WAIT_L(n) asm volatile("s_waitcnt lgkmcnt(" #n ")" ::: "memory")
#define PG8_BAR __builtin_amdgcn_s_barrier()
#define PG8_SCHED __builtin_amdgcn_sched_barrier(0)
    Unit cur, nxt; int ui = 0;
    if (!S.next(0, cur)) return;
    if constexpr (GATHER) { PG8_GVA(vA, 0); }
    int f8sc = 0x7F7F7F7F;
    const int f8one = 0x7F7F7F7F;
    f32x4 acc[2][2][4][2];
#pragma unroll
    for (int a = 0; a < 2; ++a)
#pragma unroll
        for (int b = 0; b < 2; ++b)
#pragma unroll
            for (int m = 0; m < 4; ++m)
#pragma unroll
                for (int n = 0; n < 2; ++n) acc[a][b][m][n] = (f32x4){0.f, 0.f, 0.f, 0.f};
    bf16x8 At[4][2], B0[2][2], B1[2][2];
    const char* cA = cur.A; const char* cB = cur.B;
    if constexpr (SP2) {
        PG8_STAGE(PG8_SB(0, 0), cB, voffB); PG8_STAGE(PG8_SB(0, 1), cB + hstepB, voffB); PG8_STA(PG8_SA(0, 0), cA, 0, false); PG8_STA(PG8_SA(0, 1), cA, 1, false);
        if (wr == 1) PG8_BAR;
        PG8_WAIT_V(2); PG8_BAR;
        PG8_STAGE(PG8_SB(1, 0), cB + kstep, voffB); PG8_STA(PG8_SA(1, 0), cA + kstep, 0, false); PG8_STAGE(PG8_SB(1, 1), cB + hstepB + kstep, voffB);
        PG8_WAIT_V(6); PG8_BAR;
    } else {
        PG8_STAGE(PG8_SB(0, 0), cB, voffB); PG8_STA(PG8_SA(0, 0), cA, 0, false); PG8_STAGE(PG8_SB(0, 1), cB + hstepB, voffB); PG8_STA(PG8_SA(0, 1), cA, 1, false);
        if (wr == 1) PG8_BAR;
        PG8_WAIT_V(4); PG8_BAR;
        PG8_STAGE(PG8_SB(1, 0), cB + kstep, voffB); PG8_STA(PG8_SA(1, 0), cA + kstep, 0, false); PG8_STAGE(PG8_SB(1, 1), cB + hstepB + kstep, voffB);
        PG8_WAIT_V(6); PG8_BAR;
    }
    for (;;) {
        if constexpr (F8) f8sc = 0x01010101 * (127 - E.f8exp(cur));
        bool has_next = false; const char* nA = cA; const char* nB = cB;
#define PG8_NEXT_UNIT() do { has_next = S.next(ui + 1, nxt); nA = has_next ? nxt.A : cA; nB = has_next ? nxt.B : cB; \
        if constexpr (GATHER) { if (has_next) { PG8_GVA(nvA, ui + 1); } else { _Pragma("unroll") for (int _h = 0; _h < 2; ++_h) _Pragma("unroll") for (int _i = 0; _i < 2; ++_i) nvA[_h][_i] = vA[_h][_i]; } } } while (0)
        if (nt < 4 || !SP2) PG8_NEXT_UNIT();
        for (int t = 0; t < nt; t += 2) {
            const bool last = (t == nt - 2);
            const char* a1 = cA + (size_t)(t + 1) * kstep;
            const char* a2 = last ? nA : cA + (size_t)(t + 2) * kstep; const char* b2 = last ? nB : cB + (size_t)(t + 2) * kstep;
            const char* a3 = a2 + kstep; const char* b3 = b2 + kstep;
            if constexpr (SP2) {
            PG8_LDB(B0, 0, 0); PG8_LDB(B1, 0, 1); PG8_SCHED; PG8_LDA(At, 0, 0); PG8_STA(PG8_SA(1, 1), a1, 1, false);
            PG8_WAIT_V(8); PG8_WAIT_L(0); PG8_BAR; PG8_MMA(0, 0, At, B0); PG8_MMA(0, 1, At, B1); if (t == 0 && nt >= 4) { PG8_SCHED; PG8_NEXT_UNIT(); PG8_SCHED; } PG8_BAR; PG8_SCHED;
            PG8_LDA(At, 0, 1); PG8_STAGE(PG8_SB(0, 0), b2, voffB); PG8_STAGE(PG8_SB(0, 1), b2 + hstepB, voffB); PG8_STA(PG8_SA(0, 0), a2, 0, last);
            PG8_WAIT_V(8); PG8_WAIT_L(0); PG8_BAR; PG8_MMA(1, 0, At, B0); PG8_MMA(1, 1, At, B1); PG8_BAR; PG8_SCHED;
            PG8_LDB(B0, 1, 0); PG8_LDB(B1, 1, 1); PG8_SCHED; PG8_LDA(At, 1, 0); PG8_STA(PG8_SA(0, 1), a2, 1, last);
            PG8_WAIT_V(8); PG8_WAIT_L(0); PG8_BAR; PG8_MMA(0, 0, At, B0); PG8_MMA(0, 1, At, B1); PG8_BAR; PG8_SCHED;
            PG8_LDA(At, 1, 1); PG8_STAGE(PG8_SB(1, 0), b3, voffB); PG8_STAGE(PG8_SB(1, 1), b3 + hstepB, voffB); PG8_STA(PG8_SA(1, 0), a3, 0, last);
            PG8_WAIT_V(8); PG8_WAIT_L(0); PG8_BAR; PG8_MMA(1, 0, At, B0); PG8_MMA(1, 1, At, B1); PG8_BAR; PG8_SCHED;
            } else {
            PG8_LDB(B0, 0, 0); PG8_SCHED; PG8_LDA(At, 0, 0); PG8_STA(PG8_SA(1, 1), a1, 1, false);
            PG8_WAIT_L(8); PG8_BAR; PG8_WAIT_L(0); PG8_MMA(0, 0, At, B0); PG8_BAR; PG8_SCHED;
            PG8_LDB(B1, 0, 1); PG8_STAGE(PG8_SB(0, 0), b2, voffB);
            PG8_BAR; PG8_WAIT_L(0); PG8_MMA(0, 1, At, B1); PG8_BAR;
            PG8_LDA(At, 0, 1); PG8_STA(PG8_SA(0, 0), a2, 0, last);
            PG8_BAR; PG8_WAIT_L(0); PG8_MMA(1, 0, At, B0); PG8_BAR; PG8_SCHED;
            PG8_STAGE(PG8_SB(0, 1), b2 + hstepB, voffB);
            PG8_WAIT_V(6); PG8_BAR; PG8_MMA(1, 1, At, B1); PG8_BAR;
            PG8_LDB(B0, 1, 0); PG8_SCHED; PG8_LDA(At, 1, 0); PG8_STA(PG8_SA(0, 1), a2, 1, last);
            PG8_WAIT_L(8); PG8_BAR; PG8_WAIT_L(0); PG8_MMA(0, 0, At, B0); PG8_BAR; PG8_SCHED;
            PG8_LDB(B1, 1, 1); PG8_STAGE(PG8_SB(1, 0), b3, voffB);
            PG8_BAR; PG8_WAIT_L(0); PG8_MMA(0, 1, At, B1); PG8_BAR;
            PG8_LDA(At, 1, 1); PG8_STA(PG8_SA(1, 0), a3, 0, last);
            PG8_BAR; PG8_WAIT_L(0); PG8_MMA(1, 0, At, B0); PG8_BAR; PG8_SCHED;
            PG8_STAGE(PG8_SB(1, 1), b3 + hstepB, voffB);
            PG8_WAIT_V(6); PG8_BAR; PG8_MMA(1, 1, At, B1); PG8_BAR;
            }
        }
        if constexpr (F8) asm volatile("s_nop 15\n\ts_nop 15" ::: "memory");
        if constexpr (ALIGN_EPI) { if (wr == 0) PG8_BAR; }
        { int l2 = lane; asm volatile("" : "+v"(l2)); E(acc, cur, wr, wc, l2 & 15, l2 >> 4); }
        if (!has_next) break;
#pragma unroll
        for (int a = 0; a < 2; ++a)
#pragma unroll
            for (int b = 0; b < 2; ++b)
#pragma unroll
                for (int m = 0; m < 4; ++m)
#pragma unroll
                    for (int n = 0; n < 2; ++n) acc[a][b][m][n] = (f32x4){0.f, 0.f, 0.f, 0.f};
        cur = nxt; cA = nA; cB = nB; ++ui;
        if constexpr (GATHER) {
#pragma unroll
            for (int _h = 0; _h < 2; ++_h)
#pragma unroll
                for (int _i = 0; _i < 2; ++_i) vA[_h][_i] = nvA[_h][_i];
        }
        if constexpr (ALIGN_EPI) { if (wr == 1) PG8_BAR; }
    }
    PG8_WAIT_V(0);
    if constexpr (!ALIGN_EPI) { if (wr == 0) PG8_BAR; }
    PG8_BAR;
#undef PG8_SA
#undef PG8_SB
#undef PG8_GL
#undef PG8_STAGE
#undef PG8_STA
#undef PG8_GVA
#undef PG8_LDA
#undef PG8_LDB
#undef PG8_MMA
#undef PG8_WAIT_V
#undef PG8_WAIT_L
#undef PG8_BAR
#undef PG8_SCHED
}
}
namespace epi {
__device__ __forceinline__ float clamp_f8(float v) { return __builtin_fminf(__builtin_fmaxf(v, -448.0f), 448.0f); }
__device__ __forceinline__ unsigned pack4_f8(float a, float b, float c, float d) { int w = __builtin_amdgcn_cvt_pk_fp8_f32(clamp_f8(a), clamp_f8(b), 0, false); return (unsigned)__builtin_amdgcn_cvt_pk_fp8_f32(clamp_f8(c), clamp_f8(d), w, true); }
using pg8::Unit;
template <int ACT> struct StoreBf16 {
    static constexpr bool PERM = true;
    bf16_t* O; int ldc;
    __device__ __forceinline__ int f8exp(const Unit&) const { return 8; }
    __device__ __forceinline__ void operator()(const f32x4 (&acc)[2][2][4][2], const Unit& u, int wr, int wc, int fr, int fq) const {
        const int row0 = u.pm * 256 + wr * 64 + fr, col0 = u.pn * 256 + wc * 32 + 8 * fq;
#pragma unroll
        for (int ai = 0; ai < 2; ++ai)
#pragma unroll
            for (int m = 0; m < 4; ++m) { bf16_t* rowp = O + (size_t)(row0 + ai * 128 + m * 16) * ldc + col0;
#pragma unroll
                for (int bj = 0; bj < 2; ++bj) { f32x4 v0 = acc[ai][bj][m][0], v1 = acc[ai][bj][m][1];
                    if (ACT == 1) {
#pragma unroll
                        for (int j = 0; j < 4; ++j) { v0[j] = sigmoidf_(v0[j] * DS2); v1[j] = sigmoidf_(v1[j] * DS2); } }
                    u32x4 w; w.x = cvtpk(v0[0], v0[1]); w.y = cvtpk(v0[2], v0[3]); w.z = cvtpk(v1[0], v1[1]); w.w = cvtpk(v1[2], v1[3]);
                    *(u32x4*)(rowp + bj * 128) = w; } }
    }
};
template <int MODE> struct GateMul {
    static constexpr bool PERM = true;
    const bf16_t* gate; int goff; const bf16_t* prev; bf16_t* O;
    __device__ __forceinline__ void operator()(const f32x4 (&acc)[2][2][4][2], const Unit& u, int wr, int wc, int fr, int fq) const {
        const int row0 = u.pm * 256 + wr * 64 + fr, col0 = u.pn * 256 + wc * 32 + 8 * fq;
#pragma unroll
        for (int ai = 0; ai < 2; ++ai)
#pragma unroll
            for (int m = 0; m < 4; ++m) { const size_t row = (size_t)(row0 + ai * 128 + m * 16);
#pragma unroll
                for (int bj = 0; bj < 2; ++bj) { const int col = col0 + bj * 128;
                    const u32x4 g = *(const u32x4*)(gate + row * 4096 + goff + col);
                    f32x4 v0 = acc[ai][bj][m][0], v1 = acc[ai][bj][m][1];
                    v0[0] *= bf_lo(g.x); v0[1] *= bf_hi(g.x); v0[2] *= bf_lo(g.y); v0[3] *= bf_hi(g.y);
                    v1[0] *= bf_lo(g.z); v1[1] *= bf_hi(g.z); v1[2] *= bf_lo(g.w); v1[3] *= bf_hi(g.w);
                    if (MODE == 1) { const u32x4 p = *(const u32x4*)(prev + row * 2048 + col);
                        v0[0] += bf_lo(p.x); v0[1] += bf_hi(p.x); v0[2] += bf_lo(p.y); v0[3] += bf_hi(p.y);
                        v1[0] += bf_lo(p.z); v1[1] += bf_hi(p.z); v1[2] += bf_lo(p.w); v1[3] += bf_hi(p.w); }
                    if (O78F8 && MODE == 1) { *(u32x2*)((unsigned char*)O + row * 2048 + col) = (u32x2){pack4_f8(v0[0] * F8_SG, v0[1] * F8_SG, v0[2] * F8_SG, v0[3] * F8_SG), pack4_f8(v1[0] * F8_SG, v1[1] * F8_SG, v1[2] * F8_SG, v1[3] * F8_SG)}; }
                    else { u32x4 w; w.x = cvtpk(v0[0], v0[1]); w.y = cvtpk(v0[2], v0[3]); w.z = cvtpk(v1[0], v1[1]); w.w = cvtpk(v1[2], v1[3]);
                    *(u32x4*)(O + row * 2048 + col) = w; } } }
    }
};
struct Resid {
    static constexpr bool PERM = false;
    const float* base; float* out; const float* gate; int goff;
    __device__ __forceinline__ void operator()(const f32x4 (&acc)[2][2][4][2], const Unit& u, int wr, int wc, int fr, int fq) const {
        const int row0 = u.pm * 256 + wr * 64 + fr, col0 = u.pn * 256 + wc * 32 + 4 * fq;
        const int b = (u.pm * 256) / SEQ;
        f32x4 gv[2][2];
#pragma unroll
        for (int bj = 0; bj < 2; ++bj)
#pragma unroll
            for (int n = 0; n < 2; ++n) gv[bj][n] = *(const f32x4*)(gate + (size_t)b * 12288 + goff + col0 + bj * 128 + n * 16);
#pragma unroll
        for (int ai = 0; ai < 2; ++ai)
#pragma unroll
            for (int m = 0; m < 4; ++m) { const size_t off = (size_t)(row0 + ai * 128 + m * 16) * 2048 + col0;
#pragma unroll
                for (int bj = 0; bj < 2; ++bj)
#pragma unroll
                    for (int n = 0; n < 2; ++n) { const f32x4 bs = *(const f32x4*)(base + off + bj * 128 + n * 16);
                        *(f32x4*)(out + off + bj * 128 + n * 16) = bs + gv[bj][n] * acc[ai][bj][m][n]; } }
    }
};
struct SwiGLU {
    static constexpr bool PERM = true;
    bf16_t* O;
    __device__ __forceinline__ void operator()(const f32x4 (&acc)[2][2][4][2], const Unit& u, int wr, int wc, int fr, int fq) const {
        const int r0 = wr * 64 + fr, col0 = u.pn * 128 + wc * 32 + 8 * fq;
#pragma unroll
        for (int ai = 0; ai < 2; ++ai)
#pragma unroll
            for (int m = 0; m < 4; ++m) { const int r = r0 + ai * 128 + m * 16;
                f32x4 v0, v1;
#pragma unroll
                for (int j = 0; j < 4; ++j) { v0[j] = siluf_(acc[ai][0][m][0][j]) * acc[ai][1][m][0][j]; v1[j] = siluf_(acc[ai][0][m][1][j]) * acc[ai][1][m][1][j]; }
                u32x4 w; w.x = cvtpk(v0[0], v0[1]); w.y = cvtpk(v0[2], v0[3]); w.z = cvtpk(v1[0], v1[1]); w.w = cvtpk(v1[2], v1[3]);
                if (r < u.valid) *(u32x4*)(O + (size_t)(u.rowbase + r) * 512 + col0) = w; }
    }
};
struct SwiGLU8 {
    static constexpr bool PERM = true;
    unsigned char* O;
    __device__ __forceinline__ int f8exp(const Unit&) const { return 9; }
    __device__ __forceinline__ void operator()(const f32x4 (&acc)[2][2][4][2], const Unit& u, int wr, int wc, int fr, int fq) const {
        const int r0 = wr * 64 + fr, col0 = u.pn * 128 + wc * 32 + 8 * fq;
        constexpr float ds = 1.0f, us = F8_SA;
#pragma unroll
        for (int ai = 0; ai < 2; ++ai)
#pragma unroll
            for (int m = 0; m < 4; ++m) { const int r = r0 + ai * 128 + m * 16;
                f32x4 v0, v1;
#pragma unroll
                for (int j = 0; j < 4; ++j) { v0[j] = siluf_(acc[ai][0][m][0][j] * ds) * (acc[ai][1][m][0][j] * us); v1[j] = siluf_(acc[ai][0][m][1][j] * ds) * (acc[ai][1][m][1][j] * us); }
                if (r < u.valid) *(u32x2*)(O + (size_t)(u.rowbase + r) * 512 + col0) = (u32x2){pack4_f8(v0[0], v0[1], v0[2], v0[3]), pack4_f8(v1[0], v1[1], v1[2], v1[3])}; }
    }
};
struct DownY {
    static constexpr int PERM = 2;
    unsigned char* O;
    __device__ __forceinline__ int f8exp(const Unit&) const { return 8; }
    __device__ __forceinline__ void operator()(const f32x4 (&acc)[2][2][4][2], const Unit& u, int wr, int wc, int fr, int fq) const {
        const int r0 = wr * 64 + fr, col0 = u.pn * 256 + wc * 64 + 16 * fq;
#pragma unroll
        for (int ai = 0; ai < 2; ++ai)
#pragma unroll
            for (int m = 0; m < 4; ++m) { const int r = r0 + ai * 128 + m * 16;
                if (r < u.valid) {
                    const f32x4 v0 = acc[ai][0][m][0], v1 = acc[ai][0][m][1], v2 = acc[ai][1][m][0], v3 = acc[ai][1][m][1];
                    int w0 = __builtin_amdgcn_cvt_pk_fp8_f32(v0[0], v0[1], 0, false); w0 = __builtin_amdgcn_cvt_pk_fp8_f32(v0[2], v0[3], w0, true);
                    int w1 = __builtin_amdgcn_cvt_pk_fp8_f32(v1[0], v1[1], 0, false); w1 = __builtin_amdgcn_cvt_pk_fp8_f32(v1[2], v1[3], w1, true);
                    int w2 = __builtin_amdgcn_cvt_pk_fp8_f32(v2[0], v2[1], 0, false); w2 = __builtin_amdgcn_cvt_pk_fp8_f32(v2[2], v2[3], w2, true);
                    int w3 = __builtin_amdgcn_cvt_pk_fp8_f32(v3[0], v3[1], 0, false); w3 = __builtin_amdgcn_cvt_pk_fp8_f32(v3[2], v3[3], w3, true);
                    *(u32x4*)(O + (size_t)(u.rowbase + r) * 2048 + col0) = (u32x4){(unsigned)w0, (unsigned)w1, (unsigned)w2, (unsigned)w3}; } }
    }
};
struct DownShared8 {
    static constexpr int PERM = 2;
    unsigned char* O;
    __device__ __forceinline__ int f8exp(const Unit&) const { return 8; }
    __device__ __forceinline__ void operator()(const f32x4 (&acc)[2][2][4][2], const Unit& u, int wr, int wc, int fr, int fq) const {
        const int r0 = u.pm * 256 + wr * 64 + fr, col0 = u.pn * 256 + wc * 64 + 16 * fq;
#pragma unroll
        for (int ai = 0; ai < 2; ++ai)
#pragma unroll
            for (int m = 0; m < 4; ++m) { const int r = r0 + ai * 128 + m * 16;
                const f32x4 v0 = acc[ai][0][m][0], v1 = acc[ai][0][m][1], v2 = acc[ai][1][m][0], v3 = acc[ai][1][m][1];
                *(u32x4*)(O + (size_t)r * 2048 + col0) = (u32x4){pack4_f8(v0[0], v0[1], v0[2], v0[3]), pack4_f8(v1[0], v1[1], v1[2], v1[3]), pack4_f8(v2[0], v2[1], v2[2], v2[3]), pack4_f8(v3[0], v3[1], v3[2], v3[3])}; }
    }
};
struct StoreQK {
    static constexpr bool PERM = true;
    bf16_t* Q; bf16_t* KT; float qscale;
    __device__ __forceinline__ void operator()(const f32x4 (&acc)[2][2][4][2], const Unit& u, int wr, int wc, int fr, int fq) const {
        const int row0 = u.pm * 256 + wr * 64 + fr, col0 = u.pn * 256 + wc * 32 + 8 * fq;
        const bool isk = (u.pn >= 4);
#pragma unroll
        for (int ai = 0; ai < 2; ++ai)
#pragma unroll
            for (int m = 0; m < 4; ++m) { const int row = row0 + ai * 128 + m * 16;
#pragma unroll
                for (int bj = 0; bj < 2; ++bj) { const float sc = (isk ? 1.0f : qscale) * DS2; const f32x4 v0 = acc[ai][bj][m][0] * sc, v1 = acc[ai][bj][m][1] * sc; const int col = col0 + bj * 128;
                    u32x4 w; w.x = cvtpk(v0[0], v0[1]); w.y = cvtpk(v0[2], v0[3]); w.z = cvtpk(v1[0], v1[1]); w.w = cvtpk(v1[2], v1[3]);
                    bf16_t* p = isk ? KT + ((((size_t)((col - 1024) >> 7) * 256 + (row >> 6)) * 64 + (row & 63)) * 128 + (col & 127)) : Q + (size_t)row * 1024 + col;
                    *(u32x4*)p = w; } }
    }
};
struct StoreQK8 {
    static constexpr bool PERM = true;
    unsigned char* Q; unsigned char* KT; float qs, ks;
    __device__ __forceinline__ void operator()(const f32x4 (&acc)[2][2][4][2], const Unit& u, int wr, int wc, int fr, int fq) const {
        const int row0 = u.pm * 256 + wr * 64 + fr, col0 = u.pn * 256 + wc * 32 + 8 * fq;
        const bool isk = (u.pn >= 4);
#pragma unroll
        for (int ai = 0; ai < 2; ++ai)
#pragma unroll
            for (int m = 0; m < 4; ++m) { const int row = row0 + ai * 128 + m * 16;
#pragma unroll
                for (int bj = 0; bj < 2; ++bj) { const float sc = isk ? 1.0f : qs;        const f32x4 v0 = acc[ai][bj][m][0] * sc, v1 = acc[ai][bj][m][1] * sc; const int col = col0 + bj * 128;
                    unsigned char* p = isk ? KT + ((((size_t)((col - 1024) >> 7) * 256 + (row >> 6)) * 64 + (row & 63)) * 128 + (col & 127)) : Q + (size_t)row * 1024 + col;
                    *(u32x2*)p = (u32x2){pack4_f8(v0[0], v0[1], v0[2], v0[3]), pack4_f8(v1[0], v1[1], v1[2], v1[3])}; }
                __builtin_amdgcn_sched_barrier(0); }
    }
};
struct StoreQKboth {
    static constexpr bool PERM = true;
    StoreQK b16; unsigned char* Q8; unsigned char* KT8;
    __device__ __forceinline__ void operator()(const f32x4 (&acc)[2][2][4][2], const Unit& u, int wr, int wc, int fr, int fq) const {
        b16(acc, u, wr, wc, fr, fq);
        const int row0 = u.pm * 256 + wr * 64 + fr, col0 = u.pn * 256 + wc * 32 + 8 * fq;
        const bool isk = (u.pn >= 4);
        const float sc = isk ? att::D8_KS : att::MB8_QS;
#pragma unroll
        for (int ai = 0; ai < 2; ++ai)
#pragma unroll
            for (int m = 0; m < 4; ++m) { const int row = row0 + ai * 128 + m * 16;
#pragma unroll
                for (int bj = 0; bj < 2; ++bj) { const f32x4 v0 = acc[ai][bj][m][0] * sc, v1 = acc[ai][bj][m][1] * sc; const int col = col0 + bj * 128;
                    unsigned char* p = isk ? KT8 + ((((size_t)((col - 1024) >> 7) * 256 + (row >> 6)) * 64 + (row & 63)) * 128 + (col & 127)) : Q8 + (size_t)row * 1024 + col;
                    *(u32x2*)p = (u32x2){pack4_f8(v0[0], v0[1], v0[2], v0[3]), pack4_f8(v1[0], v1[1], v1[2], v1[3])}; }
                __builtin_amdgcn_sched_barrier(0); }
    }
};
struct StoreVT8 {
    static constexpr bool PERM = true;
    unsigned char* VT; float vs;
    __device__ __forceinline__ void operator()(const f32x4 (&acc)[2][2][4][2], const Unit& u, int wr, int wc, int fr, int fq) const {
        const int row0 = u.pm * 256 + wr * 64 + fr, col0 = u.pn * 256 + wc * 32 + 8 * fq;
#pragma unroll
        for (int ai = 0; ai < 2; ++ai)
#pragma unroll
            for (int m = 0; m < 4; ++m) { const int f = row0 + ai * 128 + m * 16;
#pragma unroll
                for (int bj = 0; bj < 2; ++bj) { const f32x4 v0 = acc[ai][bj][m][0], v1 = acc[ai][bj][m][1]; const int tok = col0 + bj * 128, k = tok & 63;
                    unsigned char* p = VT + ((((size_t)(f >> 7) * 256 + (tok >> 6)) * 128 + (f & 127)) * 64 + (k >> 5) * 16 + ((k & 31) >> 3) * 4);
                    *(unsigned*)p = pack4_f8(v0[0], v0[1], v0[2], v0[3]); *(unsigned*)(p + 32) = pack4_f8(v1[0], v1[1], v1[2], v1[3]); }
                __builtin_amdgcn_sched_barrier(0); }
    }
};
struct StoreVT {
    static constexpr bool PERM = true;
    bf16_t* VT;
    __device__ __forceinline__ void operator()(const f32x4 (&acc)[2][2][4][2], const Unit& u, int wr, int wc, int fr, int fq) const {
        const int row0 = u.pm * 256 + wr * 64 + fr, col0 = u.pn * 256 + wc * 32 + 8 * fq;
#pragma unroll
        for (int ai = 0; ai < 2; ++ai)
#pragma unroll
            for (int m = 0; m < 4; ++m) { const int f = row0 + ai * 128 + m * 16;
#pragma unroll
                for (int bj = 0; bj < 2; ++bj) { const f32x4 v0 = acc[ai][bj][m][0] * DS2, v1 = acc[ai][bj][m][1] * DS2; const int tok = col0 + bj * 128;
                    u32x4 w; w.x = cvtpk(v0[0], v0[1]); w.y = cvtpk(v0[2], v0[3]); w.z = cvtpk(v1[0], v1[1]); w.w = cvtpk(v1[2], v1[3]);
                    *(u32x4*)(VT + ((((size_t)(f >> 7) * 256 + (tok >> 6)) * 128 + (f & 127)) * 64 + (tok & 63))) = w; } }
    }
};
struct ProjEpi {
    static constexpr bool PERM = true, HAS_MID = false;
    StoreQK8 qkd; StoreQKboth qkm; StoreBf16<1> gates;
    __device__ __forceinline__ int f8exp(const Unit& u) const { return (u.pn >= 4 && u.pn < 8) ? P2_EXP - 2 : P2_EXP; }
    __device__ __forceinline__ void operator()(const f32x4 (&acc)[2][2][4][2], const Unit& u, int wr, int wc, int fr, int fq) const {
        Unit v = u;
        if (u.pn < 8) qkd(acc, v, wr, wc, fr, fq);
        else if (u.pn < 16) { v.pn = u.pn - 8; qkm(acc, v, wr, wc, fr, fq); }
        else { v.pn = u.pn - 16; gates(acc, v, wr, wc, fr, fq); }
    }
};
struct ProjVT {
    static constexpr bool PERM = true, HAS_MID = false;
    StoreVT8 vd; StoreVT8 vm;
    __device__ __forceinline__ int f8exp(const Unit& u) const { return P2_EXP - 3; }
    __device__ __forceinline__ void operator()(const f32x4 (&acc)[2][2][4][2], const Unit& u, int wr, int wc, int fr, int fq) const {
        Unit v = u;
        if (u.pm < 4) vd(acc, v, wr, wc, fr, fq); else { v.pm = u.pm - 4; vm(acc, v, wr, wc, fr, fq); }
    }
};
struct GatePair {
    static constexpr bool PERM = true, HAS_MID = false;
    GateMul<0> e0; GateMul<1> e1;
    __device__ __forceinline__ int f8exp(const Unit& u) const { return u.aux == 0 ? 9 : 11; }
    __device__ __forceinline__ void operator()(const f32x4 (&acc)[2][2][4][2], const Unit& u, int wr, int wc, int fr, int fq) const {
        if (u.aux == 0) e0(acc, u, wr, wc, fr, fq); else e1(acc, u, wr, wc, fr, fq);
    }
};
struct ResidBf16 {
    static constexpr bool PERM = true, HAS_MID = false;
    const float* base; bf16_t* out; const float* gate; int goff;
    __device__ __forceinline__ int f8exp(const Unit&) const { return 10; }
    __device__ __forceinline__ void operator()(const f32x4 (&acc)[2][2][4][2], const Unit& u, int wr, int wc, int fr, int fq) const {
        const int row0 = u.pm * 256 + wr * 64 + fr, col0 = u.pn * 256 + wc * 32 + 8 * fq;
        const int b = (u.pm * 256) / SEQ;
        f32x4 gv[2][2];
#pragma unroll
        for (int bj = 0; bj < 2; ++bj)
#pragma unroll
            for (int n = 0; n < 2; ++n) gv[bj][n] = *(const f32x4*)(gate + (size_t)b * 12288 + goff + col0 + bj * 128 + n * 4);
#pragma unroll
        for (int ai = 0; ai < 2; ++ai)
#pragma unroll
            for (int m = 0; m < 4; ++m) { const size_t off = (size_t)(row0 + ai * 128 + m * 16) * 2048 + col0;
#pragma unroll
                for (int bj = 0; bj < 2; ++bj) {
                    const f32x4 b0 = *(const f32x4*)(base + off + bj * 128), b1 = *(const f32x4*)(base + off + bj * 128 + 4);
                    const f32x4 v0 = b0 + gv[bj][0] * acc[ai][bj][m][0], v1 = b1 + gv[bj][1] * acc[ai][bj][m][1];
                    u32x4 w; w.x = cvtpk(v0[0], v0[1]); w.y = cvtpk(v0[2], v0[3]); w.z = cvtpk(v1[0], v1[1]); w.w = cvtpk(v1[2], v1[3]);
                    *(u32x4*)(out + off + bj * 128) = w; } }
    }
};
}
namespace att {
constexpr int KROW = 272;
constexpr int VROW = 144;
constexpr int KBUF = 64 * KROW;
constexpr int VBUF = 128 * VROW;
constexpr int OFF_K = 0, OFF_V = 2 * KBUF, OFF_TAB = OFF_V + 2 * VBUF, OFF_G = OFF_TAB + 512, OFF_END = OFF_G + 512;
static_assert(OFF_END <= RING_BYTES, "attention LDS");
__device__ __forceinline__ int crow(int i, int hh) { return (i & 3) + 8 * (i >> 2) + 4 * hh; }

__device__ __forceinline__ int t5_bucket(int n) {
    if (n < 16) return n;
    int b = 16;
    b += (n >= 19); b += (n >= 21); b += (n >= 24); b += (n >= 27); b += (n >= 31); b += (n >= 35); b += (n >= 40); b += (n >= 46);
    b += (n >= 52); b += (n >= 59); b += (n >= 67); b += (n >= 77); b += (n >= 87); b += (n >= 99); b += (n >= 113);
    return b;
}
__device__ __forceinline__ void fill_bias_tab(LAS float* tab, const float* rel_bias, int col) {
    if (threadIdx.x < 128) { const int n = threadIdx.x; tab[n] = (rel_bias[t5_bucket(n) * 16 + col] - rel_bias[31 * 16 + col]) * LOG2E; }
}

struct TileRegs { u32x4 k[2]; u32x4 v[2]; };
__device__ __forceinline__ void tile_load(TileRegs& R, const bf16_t* kt, const bf16_t* vt, int tid) {
#pragma unroll
    for (int i = 0; i < 2; ++i) { const int c = tid + 512 * i; R.k[i] = *(const u32x4*)(kt + c * 8); }
#pragma unroll
    for (int i = 0; i < 2; ++i) { const int c = tid + 512 * i; R.v[i] = *(const u32x4*)(vt + c * 8); }
}
__device__ __forceinline__ void tile_store(const TileRegs& R, LAS unsigned char* kb, LAS unsigned char* vb, int tid) {
#pragma unroll
    for (int i = 0; i < 2; ++i) { const int c = tid + 512 * i; *(LAS u32x4*)(kb + (c >> 4) * KROW + (c & 15) * 16) = R.k[i]; }
#pragma unroll
    for (int i = 0; i < 2; ++i) { const int c = tid + 512 * i;
        LAS unsigned char* p = vb + (c >> 3) * VROW + ((c & 7) >> 1) * 32 + (c & 1) * 8;
        *(LAS u32x2*)p = (u32x2){R.v[i].x, R.v[i].y}; *(LAS u32x2*)(p + 16) = (u32x2){R.v[i].z, R.v[i].w}; }
}

template <int NMAP, int KS>
__device__ __forceinline__ void attn_half(const LAS unsigned char* kb, const LAS unsigned char* vb, int kh, const bf16x8 (&qf)[NMAP][KS], f32x16 (&O)[NMAP][4],
                                          float (&mrun)[NMAP], float (&lrun)[NMAP], int qpos, int kvpos0, bool need_mask, bool need_bias, const LAS float* btab, float sc, int r, int hh, int kcolbase) {
    bf16x8 P[NMAP][2];
#pragma unroll
    for (int m = 0; m < NMAP; ++m) {
        f32x16 s;
#pragma unroll
        for (int i = 0; i < 16; ++i) s[i] = 0.f;
#pragma unroll
        for (int ks = 0; ks < KS; ++ks) {
            const bf16x8 kf = *(const LAS bf16x8*)(kb + (32 * kh + r) * KROW + (kcolbase + m * 16 * KS + 16 * ks + 8 * hh) * 2);
            s = __builtin_amdgcn_mfma_f32_32x32x16_bf16(kf, qf[m][ks], s, 0, 0, 0);
        }
#pragma unroll
        for (int i = 0; i < 16; ++i) s[i] *= sc;
        if (need_bias) {
#pragma unroll
            for (int i = 0; i < 16; ++i) { int rel = qpos - (kvpos0 + crow(i, hh)); rel = rel < 0 ? 0 : (rel > 127 ? 127 : rel); s[i] += btab[rel]; }
        }
        if (need_mask) {
#pragma unroll
            for (int i = 0; i < 16; ++i) { if (kvpos0 + crow(i, hh) > qpos) s[i] = -INFINITY; }
        }
        float mx = s[0];
#pragma unroll
        for (int i = 1; i < 16; ++i) mx = fmaxf(mx, s[i]);
        mx = fmaxf(mx, __shfl_xor(mx, 32));
        const float mnew = fmaxf(mrun[m], mx);
        const float alpha = fast_exp2(mrun[m] - mnew);
        float sum = 0.f;
#pragma unroll
        for (int i = 0; i < 16; ++i) { const float p = fast_exp2(s[i] - mnew); sum += p; s[i] = p; }
        lrun[m] = lrun[m] * alpha + sum; mrun[m] = mnew;
#pragma unroll
        for (int dt = 0; dt < 4; ++dt)
#pragma unroll
            for (int i = 0; i < 16; ++i) O[m][dt][i] *= alpha;
#pragma unroll
        for (int st = 0; st < 2; ++st) { u32x4 w; w.x = cvtpk(s[8 * st + 0], s[8 * st + 1]); w.y = cvtpk(s[8 * st + 2], s[8 * st + 3]); w.z = cvtpk(s[8 * st + 4], s[8 * st + 5]); w.w = cvtpk(s[8 * st + 6], s[8 * st + 7]);
            P[m][st] = __builtin_bit_cast(bf16x8, w); }
    }
#pragma unroll
    for (int dt = 0; dt < 4; ++dt)
#pragma unroll
        for (int st = 0; st < 2; ++st) {
            const bf16x8 vf = *(const LAS bf16x8*)(vb + (32 * dt + r) * VROW + (2 * kh + st) * 32 + hh * 16);
#pragma unroll
            for (int m = 0; m < NMAP; ++m) O[m][dt] = __builtin_amdgcn_mfma_f32_32x32x16_bf16(vf, P[m][st], O[m][dt], 0, 0, 0);
        }
}

#define SBAR() __builtin_amdgcn_sched_barrier(0)
constexpr int TBUF = KBUF + VBUF;
constexpr int D_OFF_TAB = 3 * TBUF, D_OFF_G = D_OFF_TAB + 512;
static_assert(D_OFF_G + 512 <= RING_BYTES, "diff attention LDS");
constexpr float D_C = 0.125f * LOG2E;
__device__ __forceinline__ void d_load_kf(bf16x8 (&kf)[4], const LAS unsigned char* kb, int kh, int r, int hh, int kcol) {
#pragma unroll
    for (int ks = 0; ks < 4; ++ks) kf[ks] = *(const LAS bf16x8*)(kb + (32 * kh + r) * KROW + (kcol + 16 * ks + 8 * hh) * 2);
}
constexpr float D_THR = 8.0f;
__device__ __forceinline__ float max3_(float a, float b, float c) { float r; asm("v_max3_f32 %0, %1, %2, %3" : "=v"(r) : "v"(a), "v"(b), "v"(c)); return r; }
template <int MODE, bool LOADV, bool PREFK>
__device__ __forceinline__ void d_half_a(const bf16x8 (&kf)[4], bf16x8 (&kfn)[4], const LAS unsigned char* knext, int khn, const LAS unsigned char* vb, int kh,
                                         const bf16x8 (&qf)[4], f32x16 (&o)[4], float& mref, float& lrun, int qpos, int kvpos0, bool need_mask, bool need_bias, bool first,
                                         const LAS float* btab, int r, int hh, int kcol, bf16x8 (&vf)[4], bf16x8 (&P)[2]) {
    if (LOADV) {
#pragma unroll
        for (int dt = 0; dt < 2; ++dt)
#pragma unroll
            for (int st = 0; st < 2; ++st) vf[2 * dt + st] = *(const LAS bf16x8*)(vb + (32 * dt + r) * VROW + (2 * kh + st) * 32 + hh * 16);
    }
    SBAR();
    f32x16 s;
#pragma unroll
    for (int i = 0; i < 16; ++i) s[i] = 0.f;
    __builtin_amdgcn_s_setprio(1);
#pragma unroll
    for (int ks = 0; ks < 4; ++ks) { if (MODE != 3) s = __builtin_amdgcn_mfma_f32_32x32x16_bf16(kf[ks], qf[ks], s, 0, 0, 0); else { s[ks] += __builtin_bit_cast(float, (int)kf[ks][0]); s[4 + ks] += __builtin_bit_cast(float, (int)qf[ks][1]); } }
    __builtin_amdgcn_s_setprio(0);
    if (PREFK) d_load_kf(kfn, knext, khn, r, hh, kcol);
    SBAR();
    if (MODE == 4) { P[0] = qf[0]; P[1] = qf[1]; mref = fmaxf(mref, s[0]); } else {
    if (need_bias) {
#pragma unroll
        for (int i = 0; i < 16; ++i) { int rel = qpos - (kvpos0 + crow(i, hh)); rel = rel < 0 ? 0 : (rel > 127 ? 127 : rel); s[i] += btab[rel]; }
    }
    if (need_mask) {
#pragma unroll
        for (int i = 0; i < 16; ++i) { if (kvpos0 + crow(i, hh) > qpos) s[i] = -INFINITY; }
    }
    float mx = max3_(s[0], s[1], s[2]);
    mx = max3_(mx, s[3], s[4]); mx = max3_(mx, s[5], s[6]); mx = max3_(mx, s[7], s[8]); mx = max3_(mx, s[9], s[10]); mx = max3_(mx, s[11], s[12]); mx = max3_(mx, s[13], s[14]);
    { auto rr = __builtin_amdgcn_permlane32_swap(__float_as_uint(mx), __float_as_uint(mx), false, false); mx = max3_(s[15], __uint_as_float(rr[0]), __uint_as_float(rr[1])); }
    if (first || __any(mx - mref > D_THR)) {
        const float mn = first ? mx : fmaxf(mref, mx);
        const float alpha = first ? 0.f : fast_exp2(mref - mn);
        mref = mn; lrun *= alpha;
#pragma unroll
        for (int dt = 0; dt < 4; ++dt)
#pragma unroll
            for (int i = 0; i < 16; ++i) o[dt][i] *= alpha;
    }
    float sum = 0.f;
#pragma unroll
    for (int i = 0; i < 16; ++i) { const float p = fast_exp2(s[i] - mref); sum += p; s[i] = p; }
    lrun += sum;
#pragma unroll
    for (int st = 0; st < 2; ++st) { u32x4 w; w.x = cvtpk(s[8 * st + 0], s[8 * st + 1]); w.y = cvtpk(s[8 * st + 2], s[8 * st + 3]); w.z = cvtpk(s[8 * st + 4], s[8 * st + 5]); w.w = cvtpk(s[8 * st + 6], s[8 * st + 7]);
        P[st] = __builtin_bit_cast(bf16x8, w); }
    }
}
template <int MODE, bool LOADV>
__device__ __forceinline__ void d_half_b(f32x16 (&o)[4], bf16x8 (&vf)[4], const bf16x8 (&P)[2], const LAS unsigned char* vb, int kh, int r, int hh) {
    if (LOADV) {
#pragma unroll
        for (int dt = 0; dt < 2; ++dt)
#pragma unroll
            for (int st = 0; st < 2; ++st) vf[2 * dt + st] = *(const LAS bf16x8*)(vb + (32 * dt + r) * VROW + (2 * kh + st) * 32 + hh * 16);
    }
    bf16x8 vg[4];
#pragma unroll
    for (int dt = 2; dt < 4; ++dt)
#pragma unroll
        for (int st = 0; st < 2; ++st) vg[2 * (dt - 2) + st] = *(const LAS bf16x8*)(vb + (32 * dt + r) * VROW + (2 * kh + st) * 32 + hh * 16);
    asm volatile("s_waitcnt lgkmcnt(4)" ::: "memory"); SBAR();
    __builtin_amdgcn_s_setprio(1);
#pragma unroll
    for (int dt = 0; dt < 2; ++dt)
#pragma unroll
        for (int st = 0; st < 2; ++st) {
            if (MODE != 3) o[dt] = __builtin_amdgcn_mfma_f32_32x32x16_bf16(vf[2 * dt + st], P[st], o[dt], 0, 0, 0);
            else o[dt][st] += __builtin_bit_cast(float, (int)vf[2 * dt + st][0]) * __builtin_bit_cast(float, (int)P[st][0]);
        }
    asm volatile("s_waitcnt lgkmcnt(0)" ::: "memory"); SBAR();
#pragma unroll
    for (int dt = 2; dt < 4; ++dt)
#pragma unroll
        for (int st = 0; st < 2; ++st) {
            if (MODE != 3) o[dt] = __builtin_amdgcn_mfma_f32_32x32x16_bf16(vg[2 * (dt - 2) + st], P[st], o[dt], 0, 0, 0);
            else o[dt][st] += __builtin_bit_cast(float, (int)vg[2 * (dt - 2) + st][0]) * __builtin_bit_cast(float, (int)P[st][0]);
        }
    __builtin_amdgcn_s_setprio(0);
}
template <int MODE>
__device__ __forceinline__ void diff_unit(LAS unsigned char* lds, int b, int h, int qt, const bf16_t* QD, const bf16_t* KDT, const bf16_t* VDT, bf16_t* AD, const float* subln, const float* rel_bias) {
    int tid_ = threadIdx.x; asm volatile("" : "+v"(tid_));
    const int tid = tid_, lane = tid & 63, r = lane & 31, hh = lane >> 5; const int wid = __builtin_amdgcn_readfirstlane(tid >> 6);
    const int map = wid >> 2, qsub = wid & 3;
    const int q0 = qt * 128, qw0 = q0 + 32 * qsub, qpos = qw0 + r;
    const size_t tok0 = (size_t)b * SEQ;
    const LAS float* btab = (const LAS float*)(lds + D_OFF_TAB);
    const LAS float* gtab = (const LAS float*)(lds + D_OFF_G);
    const int kcol = map * 64;
    bf16x8 qf[4];
#pragma unroll
    for (int ks = 0; ks < 4; ++ks) qf[ks] = *(const bf16x8*)(QD + (tok0 + qpos) * 1024 + h * 128 + map * 64 + 16 * ks + 8 * hh);
    f32x16 o[4];
#pragma unroll
    for (int dt = 0; dt < 4; ++dt)
#pragma unroll
        for (int i = 0; i < 16; ++i) o[dt][i] = 0.f;
    float mrun = 0.f, lrun = 0.f;
    const bf16_t* kbase = KDT + ((size_t)h * 256 + b * 128) * 8192;
    const bf16_t* vbase = VDT + ((size_t)h * 256 + b * 128) * 8192;
    const int NT = 2 * (qt + 1);
    TileRegs R;
    bf16x8 kfa[4], kfb[4];
    __syncthreads();
    fill_bias_tab((LAS float*)(lds + D_OFF_TAB), rel_bias, h);
    if (tid < 128) ((LAS float*)(lds + D_OFF_G))[tid] = subln[tid];
    tile_load(R, kbase, vbase, tid);
    tile_store(R, lds, lds + KBUF, tid);
    tile_load(R, kbase + 8192, vbase + 8192, tid);
    __syncthreads();
    if (MODE != 2) d_load_kf(kfa, lds, 0, r, hh, kcol);
    int bc = 0;
    bf16x8 vf[4], P[2];
#define D_STAGE() do { if (t + 1 < NT) tile_store(R, lds + bn * TBUF, lds + bn * TBUF + KBUF, tid); \
        if (t + 2 < NT) tile_load(R, kbase + (size_t)(MODE == 1 ? 0 : t + 2) * 8192, vbase + (size_t)(MODE == 1 ? 0 : t + 2) * 8192, tid); \
        __syncthreads(); } while (0)
    if (wid < 4) {
#pragma unroll 1
        for (int t = 0; t < NT; ++t) {
            const int bn = (bc == 2) ? 0 : bc + 1;
            const LAS unsigned char* kb = lds + bc * TBUF; const LAS unsigned char* vb = kb + KBUF;
            const int k0 = 64 * t;
            { const bool nm = (k0 + 31 > qw0), nb = (qw0 - (k0 + 31) < 113);
              if (MODE != 2) { d_half_a<MODE, true, true>(kfa, kfb, kb, 1, vb, 0, qf, o, mrun, lrun, qpos, k0, nm, nb, t == 0, btab, r, hh, kcol, vf, P); d_half_b<MODE, false>(o, vf, P, vb, 0, r, hh); } }
            D_STAGE();
            { const bool nm = (k0 + 63 > qw0), nb = (qw0 - (k0 + 63) < 113);
              if (MODE != 2) { d_half_a<MODE, true, true>(kfb, kfa, lds + bn * TBUF, 0, vb, 1, qf, o, mrun, lrun, qpos, k0 + 32, nm, nb, false, btab, r, hh, kcol, vf, P); d_half_b<MODE, false>(o, vf, P, vb, 1, r, hh); } }
            bc = bn;
        }
    } else {
#pragma unroll 1
        for (int t = 0; t < NT; ++t) {
            const int bn = (bc == 2) ? 0 : bc + 1;
            const LAS unsigned char* kb = lds + bc * TBUF; const LAS unsigned char* vb = kb + KBUF;
            const int k0 = 64 * t;
            { const bool nm = (k0 + 31 > qw0), nb = (qw0 - (k0 + 31) < 113);
              if (MODE != 2) d_half_a<MODE, false, false>(kfa, kfb, kb, 1, vb, 0, qf, o, mrun, lrun, qpos, k0, nm, nb, t == 0, btab, r, hh, kcol, vf, P); }
            D_STAGE();
            if (MODE != 2) { d_half_b<MODE, true>(o, vf, P, vb, 0, r, hh); d_load_kf(kfb, kb, 1, r, hh, kcol); }
            { const bool nm = (k0 + 63 > qw0), nb = (qw0 - (k0 + 63) < 113);
              if (MODE != 2) { d_half_a<MODE, true, true>(kfb, kfa, lds + bn * TBUF, 0, vb, 1, qf, o, mrun, lrun, qpos, k0 + 32, nm, nb, false, btab, r, hh, kcol, vf, P); d_half_b<MODE, false>(o, vf, P, vb, 1, r, hh); } }
            bc = bn;
        }
    }
#undef D_STAGE
    __syncthreads();
    const float l = lrun + __shfl_xor(lrun, 32);
    LAS float* xch = (LAS float*)lds + qsub * 4096 + lane;
    if (map == 1) {
        const float lam = *(const LAS float*)(lds + MISC_OFF + 68);
        const float f = lam / l;
#pragma unroll
        for (int dt = 0; dt < 4; ++dt)
#pragma unroll
            for (int i = 0; i < 16; ++i) xch[(dt * 16 + i) * 64] = o[dt][i] * f;
    }
    __syncthreads();
    if (map == 0) {
        const float i0 = 1.0f / l;
        float ss = 0.f;
#pragma unroll
        for (int dt = 0; dt < 4; ++dt)
#pragma unroll
            for (int i = 0; i < 16; ++i) { const float v = o[dt][i] * i0 - xch[(dt * 16 + i) * 64]; o[dt][i] = v; ss += v * v; }
        ss += __shfl_xor(ss, 32);
        const float rs = 0.8f / sqrtf(ss * (1.0f / 128.0f) + RMS_EPS);
        bf16_t* orow = AD + (tok0 + qpos) * 1024 + h * 128;
#pragma unroll
        for (int dt = 0; dt < 4; ++dt)
#pragma unroll
            for (int g = 0; g < 4; ++g) { const int d = 32 * dt + 8 * g + 4 * hh;
                const f32x4 gg = *(const LAS f32x4*)(gtab + d);
                u32x2 w; w.x = cvtpk(o[dt][4 * g + 0] * rs * gg[0], o[dt][4 * g + 1] * rs * gg[1]); w.y = cvtpk(o[dt][4 * g + 2] * rs * gg[2], o[dt][4 * g + 3] * rs * gg[3]);
                *(u32x2*)(orow + d) = w; }
    }
}

constexpr int KROW8 = 144, VROW8 = 80, KBUF8 = 64 * KROW8, VBUF8 = 128 * VROW8, TBUF8 = KBUF8 + VBUF8;
static_assert(4 * TBUF8 <= D_OFF_TAB, "fp8 diff attention LDS");
constexpr float D8_C = 1.0f / 64.0f, D8_THR = 3.0f * 64.0f, D8_SH = 5.0f;
struct TileRegs8 { u32x4 k, v; };
__device__ __forceinline__ void tile_load8(TileRegs8& R, const unsigned char* kt, const unsigned char* vt, int tid) { R.k = *(const u32x4*)(kt + tid * 16); R.v = *(const u32x4*)(vt + tid * 16); }
__device__ __forceinline__ void tile_store8(const TileRegs8& R, LAS unsigned char* kb, LAS unsigned char* vb, int tid) {
    *(LAS u32x4*)(kb + (tid >> 3) * KROW8 + (tid & 7) * 16) = R.k; *(LAS u32x4*)(vb + (tid >> 2) * VROW8 + (tid & 3) * 16) = R.v; }
__device__ __forceinline__ i32x8 cat8(const i32x4 a, const i32x4 b) { return __builtin_shufflevector(a, b, 0, 1, 2, 3, 4, 5, 6, 7); }
__device__ __forceinline__ void d8_load_kf(i32x8 (&kf)[2], const LAS unsigned char* kb, int r, int hh, int kcolb) {
#pragma unroll
    for (int kh = 0; kh < 2; ++kh) { const LAS unsigned char* q = kb + (32 * kh + r) * KROW8 + kcolb + 32 * hh; kf[kh] = cat8(*(const LAS i32x4*)q, *(const LAS i32x4*)(q + 16)); }
}
template <int DT0>
__device__ __forceinline__ void d8_load_vf2(i32x8 (&vf)[2], const LAS unsigned char* vb, int r, int hh) {
#pragma unroll
    for (int dt = 0; dt < 2; ++dt) { const LAS unsigned char* q = vb + (32 * (DT0 + dt) + r) * VROW8 + 32 * hh; vf[dt] = cat8(*(const LAS i32x4*)q, *(const LAS i32x4*)(q + 16)); }
}
__device__ __forceinline__ void d8_scores(f32x16& s0, f32x16& s1, const i32x8 (&kf)[2], const i32x8& qf) {
    f32x16 z;
#pragma unroll
    for (int i = 0; i < 16; ++i) z[i] = 0.f;
    __builtin_amdgcn_s_setprio(1);
    s0 = __builtin_amdgcn_mfma_scale_f32_32x32x64_f8f6f4(kf[0], qf, z, 0, 0, 0, 0x7F7F7F7F, 0, 0x7F7F7F7F);
    s1 = __builtin_amdgcn_mfma_scale_f32_32x32x64_f8f6f4(kf[1], qf, z, 0, 0, 0, 0x7F7F7F7F, 0, 0x7F7F7F7F);
    __builtin_amdgcn_s_setprio(0);
}
template <bool ROW = false>
__device__ __forceinline__ i32x8 d8_softmax(f32x16& s0, f32x16& s1, f32x16 (&o)[4], float& mref, float& lrun, int qpos, int k0, bool need_mask, bool need_bias, bool first, const LAS float* btab, int hh) {
    if (need_bias) {
#pragma unroll
        for (int i = 0; i < 16; ++i) { int rel = qpos - (k0 + crow(i, hh)); rel = rel < 0 ? 0 : (rel > 127 ? 127 : rel); s0[i] += btab[rel]; }
        SBAR();
#pragma unroll
        for (int i = 0; i < 16; ++i) { int rel = qpos - (k0 + 32 + crow(i, hh)); rel = rel < 0 ? 0 : (rel > 127 ? 127 : rel); s1[i] += btab[rel]; }
        SBAR();
    }
    if (need_mask) {
#pragma unroll
        for (int i = 0; i < 16; ++i) { if (k0 + crow(i, hh) > qpos) s0[i] = -INFINITY; if (k0 + 32 + crow(i, hh) > qpos) s1[i] = -INFINITY; }
    }
    float mx = max3_(s0[0], s0[1], s0[2]);
#pragma unroll
    for (int i = 3; i < 15; i += 2) mx = max3_(mx, s0[i], s0[i + 1]);
    mx = max3_(mx, s0[15], s1[0]);
#pragma unroll
    for (int i = 1; i < 15; i += 2) mx = max3_(mx, s1[i], s1[i + 1]);
    { auto rr = __builtin_amdgcn_permlane32_swap(__float_as_uint(mx), __float_as_uint(mx), false, false); mx = max3_(s1[15], __uint_as_float(rr[0]), __uint_as_float(rr[1])); }
    if constexpr (ROW) {
        const bool up = (mx - mref > D8_THR);
        if (__any(up)) {
            const float alpha = up ? fast_exp2((mref - mx) * D8_C) : 1.0f;
            if (up) mref = mx;
            lrun *= alpha;
            asm volatile("s_nop 15\n\ts_nop 15" ::: "memory");
#pragma unroll
            for (int dt = 0; dt < 4; ++dt)
#pragma unroll
                for (int i = 0; i < 16; ++i) o[dt][i] *= alpha;
        }
    } else
    if (first || __any(mx - mref > D8_THR)) {
        const float mn = first ? mx : fmaxf(mref, mx);
        const float alpha = first ? 0.f : fast_exp2((mref - mn) * D8_C);
        mref = mn; lrun *= alpha;
        asm volatile("s_nop 15\n\ts_nop 15" ::: "memory");
#pragma unroll
        for (int dt = 0; dt < 4; ++dt)
#pragma unroll
            for (int i = 0; i < 16; ++i) o[dt][i] *= alpha;
    }
    const float off = D8_SH - mref * D8_C;
    float sum0 = 0.f, sum1 = 0.f;
    i32x8 P;
    const f32x2 c2 = {D8_C, D8_C}, off2 = {off, off};
    f32x2 sum2 = {0.f, 0.f};
#pragma unroll
    for (int g = 0; g < 4; ++g) {
        const f32x2 a0 = __builtin_elementwise_fma((f32x2){s0[4 * g], s0[4 * g + 1]}, c2, off2), a1 = __builtin_elementwise_fma((f32x2){s0[4 * g + 2], s0[4 * g + 3]}, c2, off2);
        const f32x2 b0 = __builtin_elementwise_fma((f32x2){s1[4 * g], s1[4 * g + 1]}, c2, off2), b1 = __builtin_elementwise_fma((f32x2){s1[4 * g + 2], s1[4 * g + 3]}, c2, off2);
        const f32x2 e0 = {fast_exp2(a0[0]), fast_exp2(a0[1])}, e1 = {fast_exp2(a1[0]), fast_exp2(a1[1])}, f0 = {fast_exp2(b0[0]), fast_exp2(b0[1])}, f1 = {fast_exp2(b1[0]), fast_exp2(b1[1])};
        sum2 += (e0 + e1) + (f0 + f1);
        int w0 = __builtin_amdgcn_cvt_pk_fp8_f32(e0[0], e0[1], 0, false); w0 = __builtin_amdgcn_cvt_pk_fp8_f32(e1[0], e1[1], w0, true);
        int w1 = __builtin_amdgcn_cvt_pk_fp8_f32(f0[0], f0[1], 0, false); w1 = __builtin_amdgcn_cvt_pk_fp8_f32(f1[0], f1[1], w1, true);
        P[g] = w0; P[4 + g] = w1; }
    sum0 = sum2[0]; sum1 = sum2[1];
    lrun += sum0 + sum1;
    return P;
}
__device__ __forceinline__ void d8_pv(f32x16 (&o)[4], const i32x8 (&va)[2], const i32x8& P, const LAS unsigned char* vb, int r, int hh) {
    i32x8 vg[2];
    d8_load_vf2<2>(vg, vb, r, hh);
    asm volatile("s_waitcnt lgkmcnt(4)" ::: "memory"); SBAR();
    __builtin_amdgcn_s_setprio(1);
#pragma unroll
    for (int dt = 0; dt < 2; ++dt) asm volatile("v_mfma_scale_f32_32x32x64_f8f6f4 %0, %1, %2, %0, %3, %3 op_sel_hi:[0,0,0]" : "+v"(o[dt]) : "v"(va[dt]), "v"(P), "v"(0x7F7F7F7F));
    asm volatile("s_waitcnt lgkmcnt(0)" ::: "memory"); SBAR();
#pragma unroll
    for (int dt = 0; dt < 2; ++dt) asm volatile("v_mfma_scale_f32_32x32x64_f8f6f4 %0, %1, %2, %0, %3, %3 op_sel_hi:[0,0,0]" : "+v"(o[2 + dt]) : "v"(vg[dt]), "v"(P), "v"(0x7F7F7F7F));
    __builtin_amdgcn_s_setprio(0);
}
__device__ __forceinline__ void diff_unit8(LAS unsigned char* lds, int b, int h, int qt, const unsigned char* QD, const unsigned char* KDT, const unsigned char* VDT, bf16_t* AD, const float* subln, const float* rel_bias) {
    int tid_ = threadIdx.x; asm volatile("" : "+v"(tid_));
    const int tid = tid_, lane = tid & 63, r = lane & 31, hh = lane >> 5; const int wid = __builtin_amdgcn_readfirstlane(tid >> 6);
    const int map = wid >> 2, qsub = wid & 3;
    const int q0 = qt * 128, qw0 = q0 + 32 * qsub, qpos = qw0 + r;
    const size_t tok0 = (size_t)b * SEQ;
    const LAS float* btab = (const LAS float*)(lds + D_OFF_TAB);
    const LAS float* gtab = (const LAS float*)(lds + D_OFF_G);
    const int kcolb = map * 64;
    i32x8 qf;
    { const unsigned char* qp = QD + (tok0 + qpos) * 1024 + h * 128 + map * 64 + 32 * hh; qf = cat8(*(const i32x4*)qp, *(const i32x4*)(qp + 16)); }
    f32x16 o[4];
#pragma unroll
    for (int dt = 0; dt < 4; ++dt)
#pragma unroll
        for (int i = 0; i < 16; ++i) o[dt][i] = 0.f;
    float mrun = 0.f, lrun = 0.f;
    const unsigned char* kbase = KDT + ((size_t)h * 256 + b * 128) * 8192;
    const unsigned char* vbase = VDT + ((size_t)h * 256 + b * 128) * 8192;
    const int NT = 2 * (qt + 1);
    TileRegs8 R;
    __syncthreads();
    if (tid < 128) { const int n = tid; ((LAS float*)(lds + D_OFF_TAB))[n] = (rel_bias[t5_bucket(n) * 16 + h] - rel_bias[31 * 16 + h]) * (LOG2E * 64.0f); ((LAS float*)(lds + D_OFF_G))[n] = subln[n]; }
    tile_load8(R, kbase, vbase, tid); tile_store8(R, lds, lds + KBUF8, tid);
    tile_load8(R, kbase + 8192, vbase + 8192, tid); tile_store8(R, lds + TBUF8, lds + TBUF8 + KBUF8, tid);
    if (NT > 2) tile_load8(R, kbase + 2 * 8192, vbase + 2 * 8192, tid);
    __syncthreads();
    i32x8 kf[2], vf[2];
    d8_load_kf(kf, lds, r, hh, kcolb);
#define D8_STAGE(t) do { if ((t) + 2 < NT) tile_store8(R, lds + (((t) + 2) & 3) * TBUF8, lds + (((t) + 2) & 3) * TBUF8 + KBUF8, tid); \
        if ((t) + 3 < NT) tile_load8(R, kbase + (size_t)((t) + 3) * 8192, vbase + (size_t)((t) + 3) * 8192, tid); \
        __syncthreads(); } while (0)
#pragma unroll 1
    for (int t = 0; t < NT; ++t) {
        const int k0 = 64 * t; const LAS unsigned char* tb = lds + (t & 3) * TBUF8;
        f32x16 s0, s1; d8_scores(s0, s1, kf, qf);
        d8_load_vf2<0>(vf, tb + KBUF8, r, hh); d8_load_kf(kf, lds + ((t + 1) & 3) * TBUF8, r, hh, kcolb); SBAR();
        const i32x8 P = d8_softmax(s0, s1, o, mrun, lrun, qpos, k0, (k0 + 63 > qw0), (qw0 - (k0 + 63) < 113), t == 0, btab, hh);
        if (wid >= 4) D8_STAGE(t);
        d8_pv(o, vf, P, tb + KBUF8, r, hh);
        if (wid < 4) D8_STAGE(t);
    }
#undef D8_STAGE
    __syncthreads();
    asm volatile("s_nop 15\n\ts_nop 15\n\ts_nop 15\n\ts_nop 15" ::: "memory");
    const float l = (lrun + __shfl_xor(lrun, 32)) * D8_VS;
    LAS float* xch = (LAS float*)lds + qsub * 4096 + lane;
    if (map == 1) {
        const float lam = *(const LAS float*)(lds + MISC_OFF + 68);
        const float f = lam / l;
#pragma unroll
        for (int dt = 0; dt < 4; ++dt)
#pragma unroll
            for (int i = 0; i < 16; ++i) xch[(dt * 16 + i) * 64] = o[dt][i] * f;
    }
    __syncthreads();
    if (map == 0) {
        const float i0 = 1.0f / l;
        float ss = 0.f;
#pragma unroll
        for (int dt = 0; dt < 4; ++dt)
#pragma unroll
            for (int i = 0; i < 16; ++i) { const float v = o[dt][i] * i0 - xch[(dt * 16 + i) * 64]; o[dt][i] = v; ss += v * v; }
        ss += __shfl_xor(ss, 32);
        const float rs = 0.8f / sqrtf(ss * (1.0f / 128.0f) + RMS_EPS);
        bf16_t* orow = AD + (tok0 + qpos) * 1024 + h * 128;
#pragma unroll
        for (int dt = 0; dt < 4; ++dt)
#pragma unroll
            for (int g = 0; g < 4; ++g) { const int d = 32 * dt + 8 * g + 4 * hh;
                const f32x4 gg = *(const LAS f32x4*)(gtab + d);
                if constexpr (O78F8) { const float r8 = rs * F8_SAD;
                    *(unsigned*)((unsigned char*)AD + (tok0 + qpos) * 1024 + h * 128 + d) = epi::pack4_f8(o[dt][4 * g + 0] * r8 * gg[0], o[dt][4 * g + 1] * r8 * gg[1], o[dt][4 * g + 2] * r8 * gg[2], o[dt][4 * g + 3] * r8 * gg[3]); }
                else { u32x2 w; w.x = cvtpk(o[dt][4 * g + 0] * rs * gg[0], o[dt][4 * g + 1] * rs * gg[1]); w.y = cvtpk(o[dt][4 * g + 2] * rs * gg[2], o[dt][4 * g + 3] * rs * gg[3]);
                *(u32x2*)(orow + d) = w; } }
    }
}

__device__ __forceinline__ void moba_unit(LAS unsigned char* lds, int b, int h, int n, const int* list, int cnt, const bf16_t* QM, const bf16_t* KMT, const bf16_t* VMT, bf16_t* PARTS, float* ML, const float* rel_bias) {
    int tid_ = threadIdx.x; asm volatile("" : "+v"(tid_));
    const int tid = tid_, lane = tid & 63, r = lane & 31, hh = lane >> 5; const int wid = __builtin_amdgcn_readfirstlane(tid >> 6);
    const size_t tok0 = (size_t)b * SEQ;
    const LAS float* btab = (const LAS float*)(lds + OFF_TAB);
    const float sc = 0.08838834764831845f * LOG2E;
    const bool own = (list == nullptr);
    const int li = 32 * wid + r;
    const bool lane_valid = li < cnt;
    int qpos, slot;
    if (own) { qpos = 256 * n + li; slot = 3; }
    else { const int e = list[lane_valid ? li : 0]; qpos = e >> 2; slot = e & 3; }
    const bool wave_active = (32 * wid < cnt);
    bf16x8 qf[1][8];
#pragma unroll
    for (int ks = 0; ks < 8; ++ks) qf[0][ks] = *(const bf16x8*)(QM + (tok0 + qpos) * 1024 + h * 128 + 16 * ks + 8 * hh);
    f32x16 O[1][4];
#pragma unroll
    for (int dt = 0; dt < 4; ++dt)
#pragma unroll
        for (int i = 0; i < 16; ++i) O[0][dt][i] = 0.f;
    float mrun[1] = {-INFINITY}, lrun[1] = {0.f};
    const bf16_t* kbase = KMT + ((size_t)h * 256 + b * 128 + 4 * n) * 8192;
    const bf16_t* vbase = VMT + ((size_t)h * 256 + b * 128 + 4 * n) * 8192;
    const int qw0 = 256 * n + 32 * wid;
    TileRegs R;
    __syncthreads();
    fill_bias_tab((LAS float*)(lds + OFF_TAB), rel_bias, 8 + h);
    tile_load(R, kbase, vbase, tid);
    tile_store(R, lds + OFF_K, lds + OFF_V, tid);
    __syncthreads();
#pragma unroll 1
    for (int t = 0; t < 4; ++t) {
        const int cur = t & 1;
        if (t + 1 < 4) tile_load(R, kbase + (size_t)(t + 1) * 8192, vbase + (size_t)(t + 1) * 8192, tid);
        if (wave_active) {
#pragma unroll 1
            for (int kh = 0; kh < 2; ++kh) {
                const int kp = 256 * n + 64 * t + 32 * kh;
                bool run = true, need_mask = false, need_bias;
                if (own) { run = (kp <= qw0 + 31); need_mask = (kp + 31 > qw0); need_bias = true; }
                else { need_bias = __any(qpos - (kp + 31) < 113); }
                if (run) attn_half<1, 8>(lds + OFF_K + cur * KBUF, lds + OFF_V + cur * VBUF, kh, qf, O, mrun, lrun, qpos, kp, need_mask, need_bias, btab, sc, r, hh, 0);
            }
        }
        if (t + 1 < 4) tile_store(R, lds + OFF_K + (cur ^ 1) * KBUF, lds + OFF_V + (cur ^ 1) * VBUF, tid);
        __syncthreads();
    }
    const float l = lrun[0] + __shfl_xor(lrun[0], 32);
    const float il = 1.0f / l;
    if (lane_valid) {
        const size_t pidx = ((tok0 + qpos) * 8 + h) * 4 + slot;
        bf16_t* orow = PARTS + pidx * 128;
#pragma unroll
        for (int dt = 0; dt < 4; ++dt)
#pragma unroll
            for (int g = 0; g < 4; ++g) { const int d = 32 * dt + 8 * g + 4 * hh;
                u32x2 w; w.x = cvtpk(O[0][dt][4 * g + 0] * il, O[0][dt][4 * g + 1] * il); w.y = cvtpk(O[0][dt][4 * g + 2] * il, O[0][dt][4 * g + 3] * il);
                *(u32x2*)(orow + d) = w; }
        if (hh == 0) *(f32x2*)(ML + pidx * 2) = (f32x2){mrun[0], l};
    }
}
constexpr int MB_K = 0, MB_V = 4 * KBUF, MB_INC = MB_V + 4 * VBUF, MB_TAB = MB_INC + 2048, MB_END = MB_TAB + 512;
static_assert(MB_END <= MISC_OFF, "MoBA block LDS");
__device__ __forceinline__ void moba_block(LAS unsigned char* lds, int b, int h, int n, const int* list, int cntl, int c0, int c1, const bf16_t* QM, const bf16_t* KMT, const bf16_t* VMT, bf16_t* PARTS, float* ML, const float* rel_bias) {
    int tid_ = threadIdx.x; asm volatile("" : "+v"(tid_));
    const int tid = tid_, lane = tid & 63, r = lane & 31, hh = lane >> 5; const int wid = __builtin_amdgcn_readfirstlane(tid >> 6);
    const size_t tok0 = (size_t)b * SEQ;
    const LAS float* btab = (const LAS float*)(lds + MB_TAB);
    const float sc = 0.08838834764831845f * LOG2E;
    const bf16_t* kbase = KMT + ((size_t)h * 256 + b * 128 + 4 * n) * 8192;
    const bf16_t* vbase = VMT + ((size_t)h * 256 + b * 128 + 4 * n) * 8192;
    __syncthreads();
    fill_bias_tab((LAS float*)(lds + MB_TAB), rel_bias, 8 + h);
    const int li = 32 * wid + r;
    const int cA = c0, cB = c0 + 1;
    const bool ownA = (cA == 0);
    const int cntA = ownA ? 256 : ((cntl - 256 * (cA - 1)) < 256 ? (cntl - 256 * (cA - 1)) : 256);
    const int cntB = (cB < c1) ? ((cntl - 256 * (cB - 1)) < 256 ? (cntl - 256 * (cB - 1)) : 256) : 0;
    const bool hasA = (32 * wid < cntA), hasB = (32 * wid < cntB);
    const bool lvA = li < cntA, lvB = li < cntB;
    int eA = 0, eB = 0;
    if (hasA && !ownA) eA = list[256 * (cA - 1) + (lvA ? li : 0)];
    if (hasB) eB = list[256 * (cB - 1) + (lvB ? li : 0)];
    TileRegs R, R2;
    tile_load(R, kbase, vbase, tid); tile_load(R2, kbase + 8192, vbase + 8192, tid);
    tile_store(R, lds + MB_K, lds + MB_V, tid); tile_load(R, kbase + 2 * 8192, vbase + 2 * 8192, tid);
    const int qposA = ownA ? 256 * n + li : (eA >> 2), slotA = ownA ? 3 : (eA & 3);
    const int qposB = eB >> 2, slotB = eB & 3;
    bf16x8 qfA[1][8], qfB[1][8];
    if (hasA) {
#pragma unroll
        for (int ks = 0; ks < 8; ++ks) qfA[0][ks] = *(const bf16x8*)(QM + (tok0 + qposA) * 1024 + h * 128 + 16 * ks + 8 * hh);
    }
    if (hasB) {
#pragma unroll
        for (int ks = 0; ks < 8; ++ks) qfB[0][ks] = *(const bf16x8*)(QM + (tok0 + qposB) * 1024 + h * 128 + 16 * ks + 8 * hh);
    }
    tile_store(R2, lds + MB_K + KBUF, lds + MB_V + VBUF, tid); tile_load(R2, kbase + 3 * 8192, vbase + 3 * 8192, tid);
    tile_store(R, lds + MB_K + 2 * KBUF, lds + MB_V + 2 * VBUF, tid);
    tile_store(R2, lds + MB_K + 3 * KBUF, lds + MB_V + 3 * VBUF, tid);
    __syncthreads();
#define MB_CHUNK(HAS, OWN, QF, QPOS, SLOT, LV) do { if (HAS) { \
        f32x16 O[1][4]; \
        _Pragma("unroll") for (int dt = 0; dt < 4; ++dt) _Pragma("unroll") for (int i = 0; i < 16; ++i) O[0][dt][i] = 0.f; \
        float mrun[1] = {-INFINITY}, lrun[1] = {0.f}; \
        const int qw0 = 256 * n + 32 * wid; \
        _Pragma("unroll 1") for (int t8 = 0; t8 < 8; ++t8) { \
            const int t = t8 >> 1, kh = t8 & 1; const int kp = 256 * n + 32 * t8; \
            bool run = true, need_mask = false, need_bias; \
            if (OWN) { run = (kp <= qw0 + 31); need_mask = (kp + 31 > qw0); need_bias = true; } \
            else { need_bias = __any((QPOS) - (kp + 31) < 113); } \
            if (run) attn_half<1, 8>(lds + MB_K + t * KBUF, lds + MB_V + t * VBUF, kh, QF, O, mrun, lrun, QPOS, kp, need_mask, need_bias, btab, sc, r, hh, 0); \
        } \
        const float l = lrun[0] + __shfl_xor(lrun[0], 32); const float il = 1.0f / l; \
        if (LV) { const size_t pidx = ((tok0 + (QPOS)) * 8 + h) * 4 + (SLOT); bf16_t* orow = PARTS + pidx * 128; \
            _Pragma("unroll") for (int dt = 0; dt < 4; ++dt) _Pragma("unroll") for (int g = 0; g < 4; ++g) { const int d = 32 * dt + 8 * g + 4 * hh; \
                u32x2 w; w.x = cvtpk(O[0][dt][4 * g + 0] * il, O[0][dt][4 * g + 1] * il); w.y = cvtpk(O[0][dt][4 * g + 2] * il, O[0][dt][4 * g + 3] * il); \
                *(u32x2*)(orow + d) = w; } \
            if (hh == 0) *(f32x2*)(ML + pidx * 2) = (f32x2){mrun[0], l}; } } } while (0)
    MB_CHUNK(hasA, ownA, qfA, qposA, slotA, lvA);
    MB_CHUNK(hasB, false, qfB, qposB, slotB, lvB);
#undef MB_CHUNK
}
constexpr int MB8_TAB = 4 * TBUF8;
static_assert(MB8_TAB + 512 <= MB_INC, "fp8 MoBA block LDS");
__device__ __forceinline__ void moba_block8(LAS unsigned char* lds, int b, int h, int n, const int* list, int cntl, int c0, int c1, const unsigned char* QM8, const unsigned char* KMT8, const unsigned char* VMT8, bf16_t* PARTS, float* ML, const float* rel_bias) {
    int tid_ = threadIdx.x; asm volatile("" : "+v"(tid_));
    const int tid = tid_, lane = tid & 63, r = lane & 31, hh = lane >> 5; const int wid = __builtin_amdgcn_readfirstlane(tid >> 6);
    const size_t tok0 = (size_t)b * SEQ;
    const LAS float* btab = (const LAS float*)(lds + MB8_TAB);
    const unsigned char* kbase = KMT8 + ((size_t)h * 256 + b * 128 + 4 * n) * 8192;
    const unsigned char* vbase = VMT8 + ((size_t)h * 256 + b * 128 + 4 * n) * 8192;
    __syncthreads();
    if (tid < 128) { const int q = tid; ((LAS float*)(lds + MB8_TAB))[q] = (rel_bias[t5_bucket(q) * 16 + 8 + h] - rel_bias[31 * 16 + 8 + h]) * (LOG2E * 64.0f); }
    const int li = 32 * wid + r;
    const int cA = c0, cB = c0 + 1;
    const bool ownA = (cA == 0);
    const int cntA = ownA ? 256 : ((cntl - 256 * (cA - 1)) < 256 ? (cntl - 256 * (cA - 1)) : 256);
    const int cntB = (cB < c1) ? ((cntl - 256 * (cB - 1)) < 256 ? (cntl - 256 * (cB - 1)) : 256) : 0;
    const bool hasA = (32 * wid < cntA), hasB = (32 * wid < cntB);
    const bool lvA = li < cntA, lvB = li < cntB;
    int eA = 0, eB = 0;
    if (hasA && !ownA) eA = list[256 * (cA - 1) + (lvA ? li : 0)];
    if (hasB) eB = list[256 * (cB - 1) + (lvB ? li : 0)];
    TileRegs8 R0, R1, R2, R3;
    tile_load8(R0, kbase, vbase, tid); tile_load8(R1, kbase + 8192, vbase + 8192, tid); tile_load8(R2, kbase + 2 * 8192, vbase + 2 * 8192, tid); tile_load8(R3, kbase + 3 * 8192, vbase + 3 * 8192, tid);
    SBAR();
    tile_store8(R0, lds, lds + KBUF8, tid);
    const int qposA = ownA ? 256 * n + li : (eA >> 2), slotA = ownA ? 3 : (eA & 3);
    const int qposB = eB >> 2, slotB = eB & 3;
    i32x8 qf[2];
    if (hasA) { const unsigned char* qp = QM8 + (tok0 + qposA) * 1024 + h * 128 + 32 * hh; qf[0] = cat8(*(const i32x4*)qp, *(const i32x4*)(qp + 16)); qf[1] = cat8(*(const i32x4*)(qp + 64), *(const i32x4*)(qp + 80)); }
    tile_store8(R1, lds + TBUF8, lds + TBUF8 + KBUF8, tid);
    tile_store8(R2, lds + 2 * TBUF8, lds + 2 * TBUF8 + KBUF8, tid);
    tile_store8(R3, lds + 3 * TBUF8, lds + 3 * TBUF8 + KBUF8, tid);
    __syncthreads();
#define MB8_LOADQB() do { if (hasB) { const unsigned char* qp = QM8 + (tok0 + qposB) * 1024 + h * 128 + 32 * hh; qf[0] = cat8(*(const i32x4*)qp, *(const i32x4*)(qp + 16)); qf[1] = cat8(*(const i32x4*)(qp + 64), *(const i32x4*)(qp + 80)); } } while (0)
#define MB8_CHUNK(HAS, OWN, QPOS, SLOT, LV, NEXTQ) do { if (HAS) { \
        f32x16 o[4]; \
        _Pragma("unroll") for (int dt = 0; dt < 4; ++dt) _Pragma("unroll") for (int i = 0; i < 16; ++i) o[dt][i] = 0.f; \
        float mref = -INFINITY, lrun = 0.f; \
        const int qw0 = 256 * n + 32 * wid; \
        _Pragma("unroll 1") for (int t = 0; t < 4; ++t) { \
            const int kp = 256 * n + 64 * t; const LAS unsigned char* tb = lds + t * TBUF8; \
            bool run = true, need_mask = false, need_bias; \
            if (OWN) { run = (kp <= qw0 + 31); need_mask = (kp + 63 > qw0); need_bias = (qw0 - (kp + 63) < 113); } \
            else { need_bias = __any((QPOS) - (kp + 63) < 113); } \
            if (run) { \
                i32x8 ka[2], kc[2], vf[2]; \
                d8_load_kf(ka, tb, r, hh, 0); d8_load_kf(kc, tb, r, hh, 64); \
                f32x16 s0, s1; d8_scores(s0, s1, ka, qf[0]); \
                __builtin_amdgcn_s_setprio(1); \
                s0 = __builtin_amdgcn_mfma_scale_f32_32x32x64_f8f6f4(kc[0], qf[1], s0, 0, 0, 0, 0x7F7F7F7F, 0, 0x7F7F7F7F); \
                s1 = __builtin_amdgcn_mfma_scale_f32_32x32x64_f8f6f4(kc[1], qf[1], s1, 0, 0, 0, 0x7F7F7F7F, 0, 0x7F7F7F7F); \
                __builtin_amdgcn_s_setprio(0); \
                d8_load_vf2<0>(vf, tb + KBUF8, r, hh); SBAR(); \
                const i32x8 P = d8_softmax<true>(s0, s1, o, mref, lrun, QPOS, kp, need_mask, need_bias, false, btab, hh); \
                d8_pv(o, vf, P, tb + KBUF8, r, hh); \
            } \
        } \
        NEXTQ; \
        asm volatile("s_nop 15\n\ts_nop 15\n\ts_nop 15\n\ts_nop 15" ::: "memory");        \
        const float l = lrun + __shfl_xor(lrun, 32); const float il = 1.0f / (l * D8_VS); \
        { const float il8 = il * F8_SPART; const size_t pidx = ((tok0 + (QPOS)) * 8 + h) * 4 + (SLOT); unsigned char* orow = (unsigned char*)PARTS + pidx * 128; \
              \
            _Pragma("unroll") for (int dt = 0; dt < 4; ++dt) _Pragma("unroll") for (int g = 0; g < 4; g += 2) { \
                unsigned a_ = epi::pack4_f8(o[dt][4 * g + 0] * il8, o[dt][4 * g + 1] * il8, o[dt][4 * g + 2] * il8, o[dt][4 * g + 3] * il8); \
                unsigned b_ = epi::pack4_f8(o[dt][4 * g + 4] * il8, o[dt][4 * g + 5] * il8, o[dt][4 * g + 6] * il8, o[dt][4 * g + 7] * il8); \
                auto rr = __builtin_amdgcn_permlane32_swap(a_, b_, false, false); a_ = rr[0]; b_ = rr[1]; \
                if (LV) *(u32x2*)(orow + 32 * dt + 8 * g + 8 * hh) = (u32x2){a_, b_}; } } \
        if (LV) { const size_t pidx = ((tok0 + (QPOS)) * 8 + h) * 4 + (SLOT); \
            if (hh == 0) *(f32x2*)(ML + pidx * 2) = (f32x2){mref * D8_C - D8_SH, l}; } } else { NEXTQ; } } while (0)
    MB8_CHUNK(hasA, ownA, qposA, slotA, lvA, MB8_LOADQB());
    MB8_CHUNK(hasB, false, qposB, slotB, lvB, (void)0);
#undef MB8_CHUNK
#undef MB8_LOADQB
}
}

struct Ctx {
    LAS unsigned char* lds;
    unsigned char* ws; unsigned* ctl;
    const float* const* in; float* out;
    int tid, lane, wave, G, blk;
};
enum { I_X = 0, I_C, I_WADA, I_BADA, I_GMIX, I_GFFN, I_WIN, I_LAMBDA, I_SUBLN, I_RELB, I_WOD, I_WOM, I_WOUT, I_WROUTER, I_RBIAS, I_WEG, I_WEU, I_WED, I_WSG, I_WSU, I_WSD, I_GFINAL };

constexpr int TR_SCR = 64 * 65 * 4 + 128;
static_assert(8 * TR_SCR <= RING_BYTES + 16384, "transpose scratch");
template <bool NT>
__device__ __forceinline__ void transpose_item(const float* __restrict__ W, int K, int N, bf16_t* __restrict__ WT, int drow0, int k0, int n0, LAS float* scr, int lane) {
    const int nq = lane & 15, kr = lane >> 4;
    f32x4 v[16];
#pragma unroll
    for (int i = 0; i < 16; ++i) { const f32x4* p = (const f32x4*)(W + (size_t)(k0 + 4 * i + kr) * N + n0 + 4 * nq); v[i] = NT ? __builtin_nontemporal_load(p) : *p; }
#pragma unroll
    for (int i = 0; i < 16; ++i) { LAS float* d = scr + (4 * i + kr) * 65 + 4 * nq; d[0] = v[i][0]; d[1] = v[i][1]; d[2] = v[i][2]; d[3] = v[i][3]; }
    LDS_WAIT(); asm volatile("" ::: "memory");
    const int c = lane & 7;
#pragma unroll
    for (int j = 0; j < 8; ++j) { const int n = (lane >> 3) + 8 * j; const LAS float* s = scr + (8 * c) * 65 + n;
        u32x4 o; o.x = cvtpk(s[0 * 65], s[1 * 65]); o.y = cvtpk(s[2 * 65], s[3 * 65]); o.z = cvtpk(s[4 * 65], s[5 * 65]); o.w = cvtpk(s[6 * 65], s[7 * 65]);
        u32x4* q = (u32x4*)(WT + (size_t)(drow0 + n) * K + k0 + 8 * c); if (NT) __builtin_nontemporal_store(o, q); else *q = o; }
    LDS_WAIT(); asm volatile("" ::: "memory");
}
template <bool NT>
__device__ __forceinline__ void transpose_item_f8(const float* __restrict__ W, int K, int N, unsigned char* __restrict__ WT, int drow0, int k0, int n0, LAS float* scr, int lane, float scale) {
    const int nq = lane & 15, kr = lane >> 4;
    f32x4 v[16];
#pragma unroll
    for (int i = 0; i < 16; ++i) { const f32x4* p = (const f32x4*)(W + (size_t)(k0 + 4 * i + kr) * N + n0 + 4 * nq); v[i] = NT ? __builtin_nontemporal_load(p) : *p; }
#pragma unroll
    for (int i = 0; i < 16; ++i) { LAS float* d = scr + (4 * i + kr) * 65 + 4 * nq; d[0] = v[i][0] * scale; d[1] = v[i][1] * scale; d[2] = v[i][2] * scale; d[3] = v[i][3] * scale; }
    LDS_WAIT(); asm volatile("" ::: "memory");
    const int c = lane & 7;
#pragma unroll
    for (int j = 0; j < 8; ++j) { const int n = (lane >> 3) + 8 * j; const LAS float* s = scr + (8 * c) * 65 + n;
        const u32x2 o = {epi::pack4_f8(s[0 * 65], s[1 * 65], s[2 * 65], s[3 * 65]), epi::pack4_f8(s[4 * 65], s[5 * 65], s[6 * 65], s[7 * 65])};
        u32x2* q = (u32x2*)(WT + (size_t)(drow0 + n) * K + k0 + 8 * c); if (NT) __builtin_nontemporal_store(o, q); else *q = o; }
    LDS_WAIT(); asm volatile("" ::: "memory");
}
struct CvItemF8 { const float* W; unsigned char* WT; int K, N, drow0, k0, n0; float scale; };
__device__ __forceinline__ void transpose_pair_f8(const CvItemF8& A, const CvItemF8& B, LAS float* scr, int lane) {
    const int nq = lane & 15, kr = lane >> 4, c = lane & 7;
    f32x4 va[16], vb[16];
#pragma unroll
    for (int i = 0; i < 16; ++i) va[i] = __builtin_nontemporal_load((const f32x4*)(A.W + (size_t)(A.k0 + 4 * i + kr) * A.N + A.n0 + 4 * nq));
#pragma unroll
    for (int i = 0; i < 16; ++i) vb[i] = __builtin_nontemporal_load((const f32x4*)(B.W + (size_t)(B.k0 + 4 * i + kr) * B.N + B.n0 + 4 * nq));
    __builtin_amdgcn_sched_barrier(0);
#pragma unroll
    for (int i = 0; i < 16; ++i) { LAS float* d = scr + (4 * i + kr) * 65 + 4 * nq; d[0] = va[i][0] * A.scale; d[1] = va[i][1] * A.scale; d[2] = va[i][2] * A.scale; d[3] = va[i][3] * A.scale; }
    LDS_WAIT(); asm volatile("" ::: "memory");
#pragma unroll
    for (int j = 0; j < 8; ++j) { const int n = (lane >> 3) + 8 * j; const LAS float* s = scr + (8 * c) * 65 + n;
        const u32x2 o = {epi::pack4_f8(s[0 * 65], s[1 * 65], s[2 * 65], s[3 * 65]), epi::pack4_f8(s[4 * 65], s[5 * 65], s[6 * 65], s[7 * 65])};
        __builtin_nontemporal_store(o, (u32x2*)(A.WT + (size_t)(A.drow0 + n) * A.K + A.k0 + 8 * c)); }
    LDS_WAIT(); asm volatile("" ::: "memory");
#pragma unroll
    for (int i = 0; i < 16; ++i) { LAS float* d = scr + (4 * i + kr) * 65 + 4 * nq; d[0] = vb[i][0] * B.scale; d[1] = vb[i][1] * B.scale; d[2] = vb[i][2] * B.scale; d[3] = vb[i][3] * B.scale; }
    LDS_WAIT(); asm volatile("" ::: "memory");
#pragma unroll
    for (int j = 0; j < 8; ++j) { const int n = (lane >> 3) + 8 * j; const LAS float* s = scr + (8 * c) * 65 + n;
        const u32x2 o = {epi::pack4_f8(s[0 * 65], s[1 * 65], s[2 * 65], s[3 * 65]), epi::pack4_f8(s[4 * 65], s[5 * 65], s[6 * 65], s[7 * 65])};
        __builtin_nontemporal_store(o, (u32x2*)(B.WT + (size_t)(B.drow0 + n) * B.K + B.k0 + 8 * c)); }
    LDS_WAIT(); asm volatile("" ::: "memory");
}
__device__ __forceinline__ int gu_row(int n0, int up) { return 256 * (n0 >> 7) + 128 * up + (n0 & 127); }

__device__ __forceinline__ int win_row(int n) { return n < 2048 ? n : (n < 3072 ? 8192 + (n - 2048) : (n < 5120 ? 2048 + (n - 3072) : (n < 6144 ? 9216 + (n - 5120) : 4096 + (n - 6144)))); }
__device__ __forceinline__ void p0_prologue(Ctx& F) {
    const int gw = F.blk * 8 + F.wave, NGW = F.G * 8;
    unsigned char* ws = F.ws;
    {
        const float* wada = F.in[I_WADA]; const float* c = F.in[I_C]; float* modp = (float*)(ws + WS_MODP);
        for (int it = gw; it < 48 * 32; it += NGW) {
            const int cc = it % 48, ks = it / 48, col = 256 * cc + 4 * F.lane;
            f32x4 a0 = {0.f, 0.f, 0.f, 0.f}, a1 = {0.f, 0.f, 0.f, 0.f};
#pragma unroll 8
            for (int k = 64 * ks; k < 64 * ks + 64; ++k) {
                const f32x4 w = *(const f32x4*)(wada + (size_t)k * 12288 + col);
                const float c0 = c[k], c1 = c[2048 + k];
                a0 += w * siluf_(c0); a1 += w * siluf_(c1);
            }
            *(f32x4*)(modp + ((size_t)ks * 2 + 0) * 12288 + col) = a0;
            *(f32x4*)(modp + ((size_t)ks * 2 + 1) * 12288 + col) = a1;
        }
    }
    {
        LAS float* scr = (LAS float*)(F.lds + F.wave * TR_SCR);
        constexpr int I0 = 5120, I1 = I0 + 512, I2 = I1 + 512, I3 = I2 + 1024, I4 = I3 + 256, I5 = I4 + 256, I6 = I5 + 256;
        for (int it = gw; it < I6; it += NGW) {
            if (it < I0) { const int r = it, kb = r / 160, nb = r % 160; if constexpr (P2F8) transpose_item_f8<false>(F.in[I_WIN], 2048, 10240, ws + WS_W_IN_T, win_row(64 * nb), 64 * kb, 64 * nb, scr, F.lane, F8_SW); else transpose_item<false>(F.in[I_WIN], 2048, 10240, (bf16_t*)(ws + WS_W_IN_T), win_row(64 * nb), 64 * kb, 64 * nb, scr, F.lane); }
            else if (it < I1) { const int r = it - I0, kb = r / 32, nb = r % 32; if constexpr (O78F8) transpose_item_f8<false>(F.in[I_WOD], 1024, 2048, ws + WS_W_OD_T, 64 * nb, 64 * kb, 64 * nb, scr, F.lane, F8_SWO); else transpose_item<false>(F.in[I_WOD], 1024, 2048, (bf16_t*)(ws + WS_W_OD_T), 64 * nb, 64 * kb, 64 * nb, scr, F.lane); }
            else if (it < I2) { const int r = it - I1, kb = r / 32, nb = r % 32; if constexpr (O78F8) transpose_item_f8<false>(F.in[I_WOM], 1024, 2048, ws + WS_W_OM_T, 64 * nb, 64 * kb, 64 * nb, scr, F.lane, F8_SWO); else transpose_item<false>(F.in[I_WOM], 1024, 2048, (bf16_t*)(ws + WS_W_OM_T), 64 * nb, 64 * kb, 64 * nb, scr, F.lane); }
            else if (it < I3) { const int r = it - I2, kb = r / 32, nb = r % 32; if constexpr (O78F8) transpose_item_f8<false>(F.in[I_WOUT], 2048, 2048, ws + WS_W_OUT_T, 64 * nb, 64 * kb, 64 * nb, scr, F.lane, F8_SWOUT); else transpose_item<false>(F.in[I_WOUT], 2048, 2048, (bf16_t*)(ws + WS_W_OUT_T), 64 * nb, 64 * kb, 64 * nb, scr, F.lane); }
            else if (it < I4) { const int r = it - I3, kb = r / 8, nb = r % 8; transpose_item_f8<false>(F.in[I_WSG], 2048, 512, ws + WS_W_SHGU_T, gu_row(64 * nb, 0), 64 * kb, 64 * nb, scr, F.lane, F8_SW); }
            else if (it < I5) { const int r = it - I4, kb = r / 8, nb = r % 8; transpose_item_f8<false>(F.in[I_WSU], 2048, 512, ws + WS_W_SHGU_T, gu_row(64 * nb, 1), 64 * kb, 64 * nb, scr, F.lane, F8_SW); }
            else { const int r = it - I5, kb = r / 32, nb = r % 32; transpose_item_f8<false>(F.in[I_WSD], 512, 2048, ws + WS_W_SHD_T, 64 * nb, 64 * kb, 64 * nb, scr, F.lane, F8_SD); }
        }
    }
    {
        const float* wr = F.in[I_WROUTER]; bf16_t* hi = (bf16_t*)(ws + WS_WR); bf16_t* lo = hi + 64 * 2048;
        for (int idx = F.blk * 512 + F.tid; idx < 2048 * 64; idx += F.G * 512) {
            const int k = idx >> 6, e = idx & 63; const float w = wr[idx];
            const unsigned h16 = cvtpk(w, 0.f) & 0xffffu; const float res = w - __uint_as_float(h16 << 16);
            hi[e * 2048 + k] = (bf16_t)h16; lo[e * 2048 + k] = (bf16_t)(cvtpk(res, 0.f) & 0xffffu);
        }
    }
}

constexpr int CV_NCHUNK = 1536;
struct CvItem { const float* W; unsigned char* WT; int K, N, drow0, k0, n0; float scale; };
__device__ __forceinline__ CvItem cv_decode(Ctx& F, int it) {
    unsigned char* ws = F.ws; CvItem c;
    if (it < 16384) { const int r = it, e = r >> 8, r2 = r & 255, kb = r2 / 8, nb = r2 % 8;
        c.W = F.in[I_WEG] + (size_t)e * 2048 * 512; c.WT = ws + WS_W_EGU_T + (size_t)e * 1024 * 2048; c.scale = F8_SW; c.K = 2048; c.N = 512; c.drow0 = gu_row(64 * nb, 0); c.k0 = 64 * kb; c.n0 = 64 * nb; }
    else if (it < 32768) { const int r = it - 16384, e = r >> 8, r2 = r & 255, kb = r2 / 8, nb = r2 % 8;
        c.W = F.in[I_WEU] + (size_t)e * 2048 * 512; c.WT = ws + WS_W_EGU_T + (size_t)e * 1024 * 2048; c.scale = F8_SW; c.K = 2048; c.N = 512; c.drow0 = gu_row(64 * nb, 1); c.k0 = 64 * kb; c.n0 = 64 * nb; }
    else { const int r = it - 32768, e = r >> 8, r2 = r & 255, kb = r2 / 32, nb = r2 % 32;
        c.W = F.in[I_WED] + (size_t)e * 512 * 2048; c.WT = ws + WS_W_ED_T + (size_t)e * 2048 * 512; c.scale = F8_SD; c.K = 512; c.N = 2048; c.drow0 = 64 * nb; c.k0 = 64 * kb; c.n0 = 64 * nb; }
    return c;
}
__device__ __forceinline__ void convert_chunk(Ctx& F, int chunk) {
    LAS float* scr = (LAS float*)(F.lds + F.wave * TR_SCR);
    int lane = F.lane; asm volatile("" : "+v"(lane));
    const int it0 = chunk * 32 + F.wave * 4;
#pragma unroll 1
    for (int i = 0; i < 4; i += 2) { const CvItem a = cv_decode(F, it0 + i), b = cv_decode(F, it0 + i + 1);
        transpose_pair_f8(CvItemF8{a.W, a.WT, a.K, a.N, a.drow0, a.k0, a.n0, a.scale}, CvItemF8{b.W, b.WT, b.K, b.N, b.drow0, b.k0, b.n0, b.scale}, scr, lane); }
}
__device__ __forceinline__ int queue_take(Ctx& F, unsigned* head) {
    volatile LAS int* slot = (volatile LAS int*)(F.lds + MISC_OFF + 64);
    __syncthreads();
    if (F.tid == 0) *slot = (int)__hip_atomic_fetch_add(head, 1u, RLX_AGENT);
    __syncthreads();
    return *slot;
}

__device__ __forceinline__ void fill_mod_tables(Ctx& F, const float* gain, int shift_off, int scale_off, bool from_partials, int bsel = -1) {
    LAS float* A = (LAS float*)F.lds; LAS float* Bt = (LAS float*)(F.lds + 16384);
    const float* modp = (const float*)(F.ws + WS_MODP); const float* modf = (const float*)(F.ws + WS_MOD); const float* bada = F.in[I_BADA];
    const int lo = bsel < 0 ? 0 : bsel * 2048, hi = bsel < 0 ? 4096 : lo + 2048;
    for (int idx = lo + F.tid; idx < hi; idx += 512) {
        const int b = idx >> 11, c = idx & 2047;
        float sh, scl;
        if (from_partials) {
            sh = bada[shift_off + c]; scl = bada[scale_off + c];
#pragma unroll 16
            for (int ks = 0; ks < 32; ++ks) { sh += modp[((size_t)ks * 2 + b) * 12288 + shift_off + c]; scl += modp[((size_t)ks * 2 + b) * 12288 + scale_off + c]; }
        } else { sh = modf[b * 12288 + shift_off + c]; scl = modf[b * 12288 + scale_off + c]; }
        A[idx] = gain[c] * (1.0f + scl); Bt[idx] = sh;
    }
    __syncthreads();
}

__device__ __forceinline__ void p1_norm(Ctx& F) {
    { const float* modp = (const float*)(F.ws + WS_MODP); float* modf = (float*)(F.ws + WS_MOD); const float* bada = F.in[I_BADA];
      for (int idx = F.blk * 512 + F.tid; idx < 2 * 12288; idx += F.G * 512) { const int b = idx / 12288, j = idx % 12288; float s = bada[j];
#pragma unroll 8
          for (int ks = 0; ks < 32; ++ks) s += modp[((size_t)ks * 2 + b) * 12288 + j];
          modf[idx] = s; } }
    const int rpb = T / F.G;
    const bool one_batch = (F.G * rpb == T) && (SEQ % rpb == 0);
    const int row_lo = one_batch ? F.blk * rpb : 0, row_hi = one_batch ? row_lo + rpb : T, rstep = one_batch ? 8 : F.G * 8, r0 = one_batch ? row_lo + F.wave : F.blk * 8 + F.wave;
    fill_mod_tables(F, F.in[I_GMIX], 0, 2048, true, one_batch ? row_lo / SEQ : -1);
    const LAS float* A = (const LAS float*)F.lds; const LAS float* Bt = (const LAS float*)(F.lds + 16384);
    const float* x = F.in[I_X]; bf16_t* H = (bf16_t*)(F.ws + WS_H);
    for (int row = r0; row < row_hi; row += 2 * rstep) {
        const int row2 = row + rstep; const bool has2 = row2 < row_hi;
        const int b = row / SEQ, b2 = has2 ? row2 / SEQ : b;
        const f32x4* xr = (const f32x4*)(x + (size_t)row * 2048) + F.lane;
        const f32x4* xr2 = (const f32x4*)(x + (size_t)(has2 ? row2 : row) * 2048) + F.lane;
        f32x4 v[8], v2[8]; float ss = 0.f, ss2 = 0.f;
#pragma unroll
        for (int j = 0; j < 8; ++j) { v[j] = __builtin_nontemporal_load(xr + 64 * j); v2[j] = __builtin_nontemporal_load(xr2 + 64 * j); }
#pragma unroll
        for (int j = 0; j < 8; ++j) { ss += (v[j].x * v[j].x + v[j].y * v[j].y) + (v[j].z * v[j].z + v[j].w * v[j].w); ss2 += (v2[j].x * v2[j].x + v2[j].y * v2[j].y) + (v2[j].z * v2[j].z + v2[j].w * v2[j].w); }
        const float rstd = 1.0f / sqrtf(wave_sum(ss) * (1.0f / 2048.0f) + RMS_EPS), rstd2 = 1.0f / sqrtf(wave_sum(ss2) * (1.0f / 2048.0f) + RMS_EPS);
        unsigned long long* o8 = (unsigned long long*)(H + (size_t)row * 2048) + F.lane;
        unsigned long long* o82 = (unsigned long long*)(H + (size_t)row2 * 2048) + F.lane;
#pragma unroll
        for (int j = 0; j < 8; ++j) { const int c = 4 * F.lane + 256 * j;
            const f32x4 a = *(const LAS f32x4*)(A + b * 2048 + c), sft = *(const LAS f32x4*)(Bt + b * 2048 + c);
            const f32x4 y = v[j] * rstd * a + sft;
            if constexpr (P2F8) ((unsigned*)((unsigned char*)H + (size_t)row * 2048))[F.lane + 64 * j] = epi::pack4_f8(y.x * F8_SH, y.y * F8_SH, y.z * F8_SH, y.w * F8_SH);
            else o8[64 * j] = (unsigned long long)cvtpk(y.x, y.y) | ((unsigned long long)cvtpk(y.z, y.w) << 32);
            if (has2) { const f32x4 a2 = *(const LAS f32x4*)(A + b2 * 2048 + c), sft2 = *(const LAS f32x4*)(Bt + b2 * 2048 + c);
                const f32x4 y2 = v2[j] * rstd2 * a2 + sft2;
                if constexpr (P2F8) ((unsigned*)((unsigned char*)H + (size_t)row2 * 2048))[F.lane + 64 * j] = epi::pack4_f8(y2.x * F8_SH, y2.y * F8_SH, y2.z * F8_SH, y2.w * F8_SH);
                else o82[64 * j] = (unsigned long long)cvtpk(y2.x, y2.y) | ((unsigned long long)cvtpk(y2.z, y2.w) << 32); } }
    }
}

__device__ __forceinline__ void p3_kmean(Ctx& F) {
    const bf16_t* KMT = (const bf16_t*)(F.ws + WS_KMT); float* KM = (float*)(F.ws + WS_KMEAN);
    LAS float* red = (LAS float*)F.lds;
    for (int item = F.blk; item < 512; item += F.G) {
        const int b = item >> 8, h = (item >> 5) & 7, n = item & 31;
        const int cp = F.tid & 63, rg = F.tid >> 6;
        const bf16_t* base = KMT + (((size_t)h * 256 + b * 128 + 4 * n) * 64 + 32 * rg) * 128 + 2 * cp;
        float s0 = 0.f, s1 = 0.f;
#pragma unroll 8
        for (int rr = 0; rr < 32; ++rr) { const unsigned u = *(const unsigned*)(base + (size_t)rr * 128); s0 += bf_lo(u); s1 += bf_hi(u); }
        __syncthreads();
        red[rg * 128 + 2 * cp] = s0; red[rg * 128 + 2 * cp + 1] = s1;
        __syncthreads();
        if (F.tid < 128) { float s = 0.f;
#pragma unroll
            for (int g = 0; g < 8; ++g) s += red[g * 128 + F.tid];
            KM[(size_t)item * 128 + F.tid] = s * (1.0f / 256.0f); }
    }
    __syncthreads();
}

__device__ __forceinline__ void p4_gating(Ctx& F) {
    const bf16_t* QM = (const bf16_t*)(F.ws + WS_QM); const float* KM = (const float*)(F.ws + WS_KMEAN);
    float* ML = (float*)(F.ws + WS_ML); int* MLIST = (int*)(F.ws + WS_MLIST); unsigned* mcnt = F.ctl + CW_MCNT;
    for (int grp = F.blk; grp < T / 64; grp += F.G) {
        const int h = F.wave, tok = grp * 64 + F.lane, b = tok / SEQ, qs = tok % SEQ, cur = qs >> 8;
        const int curu = __builtin_amdgcn_readfirstlane(cur), bu = __builtin_amdgcn_readfirstlane(b);
        float q[128];
        const u32x4* qp = (const u32x4*)(QM + (size_t)tok * 1024 + h * 128);
#pragma unroll
        for (int i = 0; i < 16; ++i) { const u32x4 u = qp[i]; q[8 * i + 0] = bf_lo(u.x); q[8 * i + 1] = bf_hi(u.x); q[8 * i + 2] = bf_lo(u.y); q[8 * i + 3] = bf_hi(u.y);
            q[8 * i + 4] = bf_lo(u.z); q[8 * i + 5] = bf_hi(u.z); q[8 * i + 6] = bf_lo(u.w); q[8 * i + 7] = bf_hi(u.w); }
        float v0 = -INFINITY, v1 = -INFINITY, v2 = -INFINITY; int i0 = -1, i1 = -1, i2 = -1;
        const float* kmb = KM + (size_t)((bu * 8 + h) * 32) * 128;
        for (int n = 0; n < curu; ++n) {
            const float* km = kmb + n * 128;
            float a0 = 0.f, a1 = 0.f, a2 = 0.f, a3 = 0.f;
#pragma unroll
            for (int d = 0; d < 128; d += 4) { a0 += q[d] * km[d]; a1 += q[d + 1] * km[d + 1]; a2 += q[d + 2] * km[d + 2]; a3 += q[d + 3] * km[d + 3]; }
            const float s = (a0 + a1) + (a2 + a3);
            if (s > v0) { v2 = v1; i2 = i1; v1 = v0; i1 = i0; v0 = s; i0 = n; }
            else if (s > v1) { v2 = v1; i2 = i1; v1 = s; i1 = n; }
            else if (s > v2) { v2 = s; i2 = n; }
        }
        float* ml = ML + ((size_t)tok * 8 + h) * 8;
        if (i0 < 0) *(f32x2*)(ml + 0) = (f32x2){-INFINITY, 0.f};
        if (i1 < 0) *(f32x2*)(ml + 2) = (f32x2){-INFINITY, 0.f};
        if (i2 < 0) *(f32x2*)(ml + 4) = (f32x2){-INFINITY, 0.f};
        for (int n = 0; n < curu; ++n) {
            const bool hit = (i0 == n) || (i1 == n) || (i2 == n);
            const unsigned long long mask = __ballot(hit);
            if (mask) {
                const int cntw = __popcll(mask);
                unsigned base = 0;
                if (F.lane == 0) base = __hip_atomic_fetch_add(mcnt + ((bu * 8 + h) * 32 + n), (unsigned)cntw, RLX_AGENT);
                base = __builtin_amdgcn_readfirstlane(base);
                if (hit) { const int pos = base + __popcll(mask & ((1ull << F.lane) - 1ull)); const int slot = (i0 == n) ? 0 : ((i1 == n) ? 1 : 2);
                    MLIST[(size_t)((bu * 8 + h) * 32 + n) * 8192 + pos] = (qs << 2) | slot; }
            }
        }
    }
}

__device__ __forceinline__ void p6_merge(Ctx& F) {
    const bf16_t* PARTS = (const bf16_t*)(F.ws + WS_PARTS); const float* ML = (const float*)(F.ws + WS_ML); bf16_t* AM = (bf16_t*)(F.ws + WS_AM);
    const int gw = F.blk * 8 + F.wave, NGW = F.G * 8;
    for (int tok = gw; tok < T; tok += NGW) {
        f32x4 ml01[2], ml23[2]; u32x2 pu[2][4];
#pragma unroll
        for (int i = 0; i < 2; ++i) {
            const int item = F.lane + 64 * i, h = item >> 4, ch = item & 15;
            const float* ml = ML + ((size_t)tok * 8 + h) * 8;
            ml01[i] = *(const f32x4*)ml; ml23[i] = *(const f32x4*)(ml + 4);
            const unsigned char* pb = (const unsigned char*)PARTS + (((size_t)tok * 8 + h) * 4) * 128 + ch * 8;
#pragma unroll
            for (int s4 = 0; s4 < 4; ++s4) pu[i][s4] = __builtin_nontemporal_load((const u32x2*)(pb + s4 * 128));
        }
#pragma unroll
        for (int i = 0; i < 2; ++i) {
            const int item = F.lane + 64 * i, h = item >> 4, ch = item & 15;
            const float m0 = ml01[i][0], l0 = ml01[i][1], m1 = ml01[i][2], l1 = ml01[i][3], m2 = ml23[i][0], l2 = ml23[i][1], m3 = ml23[i][2], l3 = ml23[i][3];
            const float M = fmaxf(fmaxf(m0, m1), fmaxf(m2, m3));
            const float w0 = l0 * fast_exp2(m0 - M), w1 = l1 * fast_exp2(m1 - M), w2 = l2 * fast_exp2(m2 - M), w3 = l3 * fast_exp2(m3 - M);
            const float inv = 1.0f / (w0 + w1 + w2 + w3);
            float acc[8];
#pragma unroll
            for (int j = 0; j < 8; ++j) acc[j] = 0.f;
            const float ws4[4] = {w0, w1, w2, w3};
#pragma unroll
            for (int s4 = 0; s4 < 4; ++s4) {
                const float w = ws4[s4]; u32x2 u = pu[i][s4];
                if (!(w > 0.f)) u = (u32x2){0u, 0u};
                { const f32x2 a = __builtin_amdgcn_cvt_pk_f32_fp8((int)u.x, false), b = __builtin_amdgcn_cvt_pk_f32_fp8((int)u.x, true), c = __builtin_amdgcn_cvt_pk_f32_fp8((int)u.y, false), d = __builtin_amdgcn_cvt_pk_f32_fp8((int)u.y, true);
                  acc[0] += w * a[0]; acc[1] += w * a[1]; acc[2] += w * b[0]; acc[3] += w * b[1]; acc[4] += w * c[0]; acc[5] += w * c[1]; acc[6] += w * d[0]; acc[7] += w * d[1]; }
            }
            if constexpr (O78F8) { const float i8 = inv * (F8_SAM / F8_SPART);
                *(u32x2*)((unsigned char*)AM + (size_t)tok * 1024 + h * 128 + ch * 8) = (u32x2){epi::pack4_f8(acc[0] * i8, acc[1] * i8, acc[2] * i8, acc[3] * i8), epi::pack4_f8(acc[4] * i8, acc[5] * i8, acc[6] * i8, acc[7] * i8)}; }
            else { u32x4 o; o.x = cvtpk(acc[0] * inv, acc[1] * inv); o.y = cvtpk(acc[2] * inv, acc[3] * inv); o.z = cvtpk(acc[4] * inv, acc[5] * inv); o.w = cvtpk(acc[6] * inv, acc[7] * inv);
            *(u32x4*)(AM + (size_t)tok * 1024 + h * 128 + ch * 8) = o; }
        }
    }
}
constexpr int P9_RSTD = 32768, P9_LG = 33792, P9_LGROW = 68, P9_LCNT = P9_LG + 2 * 64 * P9_LGROW * 4, P9_LBASE = P9_LCNT + 256, P9_END = P9_LBASE + 256;
static_assert(P9_END <= RING_BYTES, "P9 LDS");
__device__ __forceinline__ void p9_route(Ctx& F) {
    fill_mod_tables(F, F.in[I_GFFN], 6144, 8192, false);
    const LAS float* A2 = (const LAS float*)F.lds; const LAS float* B2 = (const LAS float*)(F.lds + 16384);
    LAS float* rstd_l = (LAS float*)(F.lds + P9_RSTD); LAS float* LG = (LAS float*)(F.lds + P9_LG);
    LAS int* lcnt = (LAS int*)(F.lds + P9_LCNT); LAS int* lbase = (LAS int*)(F.lds + P9_LBASE);
    const bf16_t* x1 = (const bf16_t*)(F.ws + WS_X1); bf16_t* H2 = (bf16_t*)(F.ws + WS_H2); unsigned char* H2F8 = F.ws + WS_H2F8;
    const bf16_t* WRH = (const bf16_t*)(F.ws + WS_WR); const bf16_t* WRL = WRH + 64 * 2048;
    const float* rbias = F.in[I_RBIAS];
    int* ELIST = (int*)(F.ws + WS_ELIST); int* TOKE = (int*)(F.ws + WS_TOKE); float* TOKW = (float*)(F.ws + WS_TOKW);
    unsigned* ecnt = F.ctl + CW_ECNT;
    for (int grp = F.blk; grp < T / 64; grp += F.G) {
        const int tokb = grp * 64, b = tokb / SEQ;
        if (F.tid < 64) lcnt[F.tid] = 0;
        for (int i = 0; i < 8; i += 4) {
            const int tl = F.wave * 8 + i;
            u32x4 va[4][4];
#pragma unroll
            for (int q = 0; q < 4; ++q) { const u32x4* xr = (const u32x4*)(x1 + (size_t)(tokb + tl + q) * 2048) + F.lane;
#pragma unroll
                for (int j = 0; j < 4; ++j) va[q][j] = xr[64 * j]; }
#pragma unroll
            for (int q = 0; q < 4; ++q) { float ss = 0.f;
#pragma unroll
                for (int j = 0; j < 4; ++j) { const u32x4 u = va[q][j];
                    const float a0 = bf_lo(u.x), a1 = bf_hi(u.x), a2 = bf_lo(u.y), a3 = bf_hi(u.y), a4 = bf_lo(u.z), a5 = bf_hi(u.z), a6 = bf_lo(u.w), a7 = bf_hi(u.w);
                    ss += ((a0 * a0 + a1 * a1) + (a2 * a2 + a3 * a3)) + ((a4 * a4 + a5 * a5) + (a6 * a6 + a7 * a7)); }
                ss = wave_sum(ss);
                if (F.lane == 0) rstd_l[tl + q] = 1.0f / sqrtf(ss * (1.0f / 2048.0f) + RMS_EPS); }
        }
        __syncthreads();
        {
            const int tg = F.wave & 3, kh = F.wave >> 2, tc = F.lane & 15, kg = F.lane >> 4;
            const int tl = 16 * tg + tc; const float rs = rstd_l[tl];
            const bf16_t* xrow = x1 + (size_t)(tokb + tl) * 2048;
            bf16_t* hrow = H2 + (size_t)(tokb + tl) * 2048;
            f32x4 acc[4];
#pragma unroll
            for (int nt = 0; nt < 4; ++nt) acc[nt] = (f32x4){0.f, 0.f, 0.f, 0.f};
#pragma unroll 2
            for (int s = 32 * kh; s < 32 * kh + 32; ++s) {
                const int c0 = 32 * s + 8 * kg;
                const u32x4 xu = *(const u32x4*)(xrow + c0);
                const f32x4 xa = {bf_lo(xu.x), bf_hi(xu.x), bf_lo(xu.y), bf_hi(xu.y)}, xb = {bf_lo(xu.z), bf_hi(xu.z), bf_lo(xu.w), bf_hi(xu.w)};
                const f32x4 aa = *(const LAS f32x4*)(A2 + b * 2048 + c0), ab = *(const LAS f32x4*)(A2 + b * 2048 + c0 + 4);
                const f32x4 ba = *(const LAS f32x4*)(B2 + b * 2048 + c0), bb = *(const LAS f32x4*)(B2 + b * 2048 + c0 + 4);
                const f32x4 ya = xa * rs * aa + ba, yb = xb * rs * ab + bb;
                u32x4 hi; hi.x = cvtpk(ya[0], ya[1]); hi.y = cvtpk(ya[2], ya[3]); hi.z = cvtpk(yb[0], yb[1]); hi.w = cvtpk(yb[2], yb[3]);
                *(u32x2*)(H2F8 + (size_t)(tokb + tl) * 2048 + c0) = (u32x2){epi::pack4_f8(ya[0] * F8_SH, ya[1] * F8_SH, ya[2] * F8_SH, ya[3] * F8_SH), epi::pack4_f8(yb[0] * F8_SH, yb[1] * F8_SH, yb[2] * F8_SH, yb[3] * F8_SH)};
                u32x4 lo; lo.x = cvtpk(ya[0] - bf_lo(hi.x), ya[1] - bf_hi(hi.x)); lo.y = cvtpk(ya[2] - bf_lo(hi.y), ya[3] - bf_hi(hi.y));
                lo.z = cvtpk(yb[0] - bf_lo(hi.z), yb[1] - bf_hi(hi.z)); lo.w = cvtpk(yb[2] - bf_lo(hi.w), yb[3] - bf_hi(hi.w));
                const bf16x8 hf = __builtin_bit_cast(bf16x8, hi), lf = __builtin_bit_cast(bf16x8, lo);
#pragma unroll
                for (int nt = 0; nt < 4; ++nt) {
                    const bf16x8 wh = *(const bf16x8*)(WRH + (size_t)(16 * nt + tc) * 2048 + c0), wl = *(const bf16x8*)(WRL + (size_t)(16 * nt + tc) * 2048 + c0);
                    acc[nt] = __builtin_amdgcn_mfma_f32_16x16x32_bf16(wh, hf, acc[nt], 0, 0, 0);
                    acc[nt] = __builtin_amdgcn_mfma_f32_16x16x32_bf16(wh, lf, acc[nt], 0, 0, 0);
                    acc[nt] = __builtin_amdgcn_mfma_f32_16x16x32_bf16(wl, hf, acc[nt], 0, 0, 0);
                }
            }
#pragma unroll
            for (int nt = 0; nt < 4; ++nt) *(LAS f32x4*)(LG + (kh * 64 + tl) * P9_LGROW + 16 * nt + 4 * kg) = acc[nt];
        }
        __syncthreads();
        int se[8], sslot[8]; float sw[8];
        if (F.tid < 64) {
            LAS float* row0 = LG + F.tid * P9_LGROW; const LAS float* row1 = LG + (64 + F.tid) * P9_LGROW;
            float sl[64];
#pragma unroll
            for (int e = 0; e < 64; ++e) { const float s = sigmoidf_(row0[e] + row1[e]); row0[e] = s; sl[e] = s + rbias[e]; }
            float gs[8];
#pragma unroll
            for (int g = 0; g < 8; ++g) { float m1 = -INFINITY, m2 = -INFINITY;
#pragma unroll
                for (int j = 0; j < 8; ++j) { const float v = sl[8 * g + j]; if (v > m1) { m2 = m1; m1 = v; } else if (v > m2) m2 = v; }
                gs[g] = m1 + m2; }
            unsigned gmask = 0u;
#pragma unroll
            for (int it = 0; it < 4; ++it) { float best = -INFINITY; int bi = 0;
#pragma unroll
                for (int g = 0; g < 8; ++g) { const bool free_ = !((gmask >> g) & 1u); if (free_ && gs[g] > best) { best = gs[g]; bi = g; } }
                gmask |= 1u << bi; }
            unsigned long long picked = 0ull; float wsum = 0.f;
#pragma unroll
            for (int it = 0; it < 8; ++it) { float best = -INFINITY; int bi = 0;
#pragma unroll
                for (int e = 0; e < 64; ++e) { const bool ok = ((gmask >> (e >> 3)) & 1u) && !((picked >> e) & 1ull); if (ok && sl[e] > best) { best = sl[e]; bi = e; } }
                picked |= 1ull << bi; se[it] = bi; const float s = row0[bi]; sw[it] = s; wsum += s; }
            const float inv = 2.5f / wsum;
#pragma unroll
            for (int k = 0; k < 8; ++k) { sw[k] *= inv; sslot[k] = __hip_atomic_fetch_add(lcnt + se[k], 1, __ATOMIC_RELAXED, __HIP_MEMORY_SCOPE_WORKGROUP); }
        }
        __syncthreads();
        if (F.tid < 64) { const int c = lcnt[F.tid]; lbase[F.tid] = c > 0 ? (int)__hip_atomic_fetch_add(ecnt + F.tid, (unsigned)c, RLX_AGENT) : 0; }
        __syncthreads();
        if (F.tid < 64) { const int tok = tokb + F.tid;
#pragma unroll
            for (int k = 0; k < 8; ++k) { const int slot = lbase[se[k]] + sslot[k];
                ELIST[(size_t)se[k] * 16384 + slot] = tok; TOKE[tok * 8 + k] = (se[k] << 16) | slot; TOKW[tok * 8 + k] = sw[k]; } }
        __syncthreads();
    }
}

constexpr int MT_CNT = 0, MT_TST = 256, MT_COFF = 768, MT_GTAB = 2048;
__device__ __forceinline__ void moe_tables(Ctx& F) {
    LAS int* cnt = (LAS int*)(F.lds + LDSX_OFF + MT_CNT); LAS int* tst = (LAS int*)(F.lds + LDSX_OFF + MT_TST); LAS int* coff = (LAS int*)(F.lds + LDSX_OFF + MT_COFF);
    if (F.tid < 64) cnt[F.tid] = (int)__hip_atomic_load(F.ctl + CW_ECNT + F.tid, RLX_AGENT);
    __syncthreads();
    if (F.tid == 0) { int t = 0, c = 0; for (int e = 0; e < 64; ++e) { tst[e] = t; coff[e] = c; const int n = cnt[e]; t += (n + 255) >> 8; c += n; } tst[64] = t; coff[64] = c; }
    __syncthreads();
}
struct MoeSched {
    const LAS int* cnt; const LAS int* tst; const LAS int* coff; int G, c, npn_log2; const char* A; const char* B; size_t a_tile_bytes, b_exp_bytes, b_tile_bytes; bool compact;
    __device__ __forceinline__ bool next(int i, pg8::Unit& u) const {
        const int ntile = tst[64];
        const long L = (long)i * G + c; if (L >= ((long)ntile << npn_log2)) return false;
        const int rt = (int)(L >> npn_log2), pn = (int)(L & ((1 << npn_log2) - 1));
        int lo = 0, hi = 64;
#pragma unroll
        for (int s = 0; s < 6; ++s) { const int mid = (lo + hi) >> 1; if (tst[mid] <= rt) lo = mid; else hi = mid; }
        int e = lo;
        e = __builtin_amdgcn_readfirstlane(e);
        const int j = rt - __builtin_amdgcn_readfirstlane(tst[e]);
        const int n = __builtin_amdgcn_readfirstlane(cnt[e]);
        u.pm = rt; u.pn = pn; u.aux = e;
        u.valid = (n - 256 * j) < 256 ? (n - 256 * j) : 256;
        u.rowbase = compact ? (__builtin_amdgcn_readfirstlane(coff[e]) + 256 * j) : rt * 256;
        u.A = A + (size_t)rt * a_tile_bytes; u.B = B + (size_t)e * b_exp_bytes + (size_t)pn * b_tile_bytes;
        return true;
    }
};

__device__ __forceinline__ void p12_combine(Ctx& F) {
    moe_tables(F);
    const LAS int* coff = (const LAS int*)(F.lds + LDSX_OFF + MT_COFF);
    const unsigned char* Y = (const unsigned char*)(F.ws + WS_Y); const int* TOKE = (const int*)(F.ws + WS_TOKE); const float* TOKW = (const float*)(F.ws + WS_TOKW);
    const float* modf = (const float*)(F.ws + WS_MOD); const float* gfin = F.in[I_GFINAL]; const bf16_t* SHOUT = (const bf16_t*)(F.ws + WS_SHOUT);
    float* out = F.out;
    const int gw = F.blk * 8 + F.wave, NGW = F.G * 8;
    for (int tok = gw; tok < T; tok += NGW) {
        const int b = tok / SEQ;
        f32x4 acc[8];
        int es8[8]; float w8[8];
#pragma unroll
        for (int k = 0; k < 8; ++k) { es8[k] = TOKE[tok * 8 + k]; w8[k] = TOKW[tok * 8 + k]; }
        f32x4* xr = (f32x4*)(out + (size_t)tok * 2048) + F.lane;
        f32x4 v[8];
        { const unsigned long long* x1r = (const unsigned long long*)((const bf16_t*)(F.ws + WS_X1) + (size_t)tok * 2048) + F.lane;
#pragma unroll
          for (int j = 0; j < 8; ++j) { const unsigned long long u = __builtin_nontemporal_load(x1r + 64 * j); const unsigned lo = (unsigned)u, hi = (unsigned)(u >> 32);
              v[j] = (f32x4){bf_lo(lo), bf_hi(lo), bf_lo(hi), bf_hi(hi)}; } }
        { const unsigned* sr = (const unsigned*)((const unsigned char*)SHOUT + (size_t)tok * 2048) + F.lane;
#pragma unroll
          for (int j = 0; j < 8; ++j) { const int u = (int)__builtin_nontemporal_load(sr + 64 * j); const f32x2 lo = __builtin_amdgcn_cvt_pk_f32_fp8(u, false), hi = __builtin_amdgcn_cvt_pk_f32_fp8(u, true);
              acc[j].x = lo[0]; acc[j].y = lo[1]; acc[j].z = hi[0]; acc[j].w = hi[1]; } }
#pragma unroll
        for (int kk = 0; kk < 8; kk += 4) {
            unsigned yu[4][8];
#pragma unroll
            for (int k = 0; k < 4; ++k) { const int e = es8[kk + k] >> 16, slot = es8[kk + k] & 0xffff;
                const unsigned* yr = (const unsigned*)(Y + (size_t)(coff[e] + slot) * 2048) + F.lane;
#pragma unroll
                for (int j = 0; j < 8; ++j) yu[k][j] = __builtin_nontemporal_load(yr + 64 * j); }
#pragma unroll
            for (int k = 0; k < 4; ++k) { const float w = w8[kk + k];
#pragma unroll
                for (int j = 0; j < 8; ++j) { const int u = (int)yu[k][j]; const f32x2 lo = __builtin_amdgcn_cvt_pk_f32_fp8(u, false), hi = __builtin_amdgcn_cvt_pk_f32_fp8(u, true);
                    acc[j].x += w * lo[0]; acc[j].y += w * lo[1]; acc[j].z += w * hi[0]; acc[j].w += w * hi[1]; } }
        }
        float ss = 0.f;
#pragma unroll
        for (int j = 0; j < 8; ++j) { const int c = 4 * F.lane + 256 * j; const f32x4 g2 = *(const f32x4*)(modf + b * 12288 + 10240 + c);
            v[j] = v[j] + g2 * acc[j]; ss += (v[j].x * v[j].x + v[j].y * v[j].y) + (v[j].z * v[j].z + v[j].w * v[j].w); }
        const float rstd = 1.0f / sqrtf(wave_sum(ss) * (1.0f / 2048.0f) + RMS_EPS);
#pragma unroll
        for (int j = 0; j < 8; ++j) { const int c = 4 * F.lane + 256 * j; const f32x4 g = *(const f32x4*)(gfin + c); __builtin_nontemporal_store(v[j] * rstd * g, xr + 64 * j); }
    }
}
struct Args { const float* in[22]; float* out; unsigned char* ws; int ph_lo, ph_hi; };
static_assert(sizeof(Args) == 22 * 8 + 8 + 8 + 8, "Args has no padding");

__global__ void __launch_bounds__(512, 2) fwd_kernel(Args args) {
    extern __shared__ __attribute__((aligned(16))) unsigned char lds_raw[];
    Ctx F;
    F.lds = (LAS unsigned char*)lds_raw;
    F.tid = threadIdx.x; F.lane = F.tid & 63; F.wave = __builtin_amdgcn_readfirstlane(F.tid >> 6);
    F.G = gridDim.x; F.blk = blockIdx.x;
    F.ws = args.ws; F.ctl = (unsigned*)(args.ws + WS_CTL); F.out = args.out;
    F.in = args.in;
    volatile LAS unsigned* MISC = (volatile LAS unsigned*)(F.lds + MISC_OFF);
    if (F.tid < 32) MISC[F.tid] = 0u;
    __syncthreads();
    XcdBarrier bar; bar.bar = F.ctl + CW_BAR; bar.x = 0; bar.st = nullptr;
    if (MK_N_LAUNCHES == 1) bar = xcd_barrier_post(F.ctl + CW_BAR, MISC + 8);
    const int lo = args.ph_lo, hi = args.ph_hi;
    unsigned char* ws = args.ws;
#define IN(k) (lo <= (k) && (k) < hi && ((PHASE_MASK >> (k)) & 1u))
#define SEAM(k) do { if (MK_N_LAUNCHES == 1 && (k) + 1 < hi) xcd_barrier(bar); } while (0)
#define NREP(k) (((REP_MASK >> (k)) & 1u) ? 2 : 1)
    typedef pg8::StaticOrder SO;

    if (lo <= 0 && 0 < hi) { if (IN(0)) { for (int rep_ = 0; rep_ < NREP(0); ++rep_) { if (rep_) xcd_barrier(bar); p0_prologue(F); } } SEAM(0); }
    if (lo <= 1 && 1 < hi) { if (IN(1)) { for (int rep_ = 0; rep_ < NREP(1); ++rep_) { if (rep_) xcd_barrier(bar); p1_norm(F); } } SEAM(1); }
    if (lo <= 2 && 2 < hi) {
        if (IN(2)) {
#pragma unroll 1
        for (int rep_ = 0; rep_ < NREP(2); ++rep_) { if (rep_) xcd_barrier(bar);
            const char* H = (const char*)(ws + WS_H); const char* W = (const char*)(ws + WS_W_IN_T);
            constexpr int KP = P2F8 ? 1024 : 2048;
            { SO S; S.init(H, W, T, 8192, KP, F.G, F.blk);
              epi::ProjEpi E{epi::StoreQK8{ws + WS_QD, ws + WS_KDT, att::D8_QS, att::D8_KS}, epi::StoreQKboth{epi::StoreQK{(bf16_t*)(ws + WS_QM), (bf16_t*)(ws + WS_KMT), 1.0f}, ws + WS_QM8, ws + WS_KMT8}, epi::StoreBf16<1>{(bf16_t*)(ws + WS_GATES), 4096}};
              pg8::gemm_phase<epi::ProjEpi, SO, true, true, false, P2F8>(F.lds, KP, S, E, nullptr); }
            { SO S; S.init(W + (size_t)8192 * KP * 2, H, 2048, T, KP, F.G, F.blk); epi::ProjVT E{epi::StoreVT8{ws + WS_VDT, att::D8_VS}, epi::StoreVT8{ws + WS_VMT8, att::D8_VS}};
              pg8::gemm_phase<epi::ProjVT, SO, true, true, false, P2F8>(F.lds, KP, S, E, nullptr); }
        }
        }
        SEAM(2);
    }
    if (lo <= 3 && 3 < hi) {
        if (IN(3)) {
#pragma unroll 1
        for (int rep_ = 0; rep_ < NREP(3); ++rep_) { if (rep_) xcd_barrier(bar);
            const float* lv = F.in[I_LAMBDA];
            float d1 = 0.f, d2 = 0.f;
            for (int i = 0; i < 64; ++i) { d1 += lv[i] * lv[64 + i]; d2 += lv[128 + i] * lv[192 + i]; }
            if (F.tid == 0) *(LAS float*)(F.lds + MISC_OFF + 68) = expf(d1) - expf(d2) + 0.2f;
            {
                const int x = (int)(xb_xcc_id() & 7u);
                const bool converter = ((F.blk >> 3) & 3) == 3;
                if (converter) { for (int c = queue_take(F, F.ctl + CW_CQ); c < CV_NCHUNK; c = queue_take(F, F.ctl + CW_CQ)) { __syncthreads(); convert_chunk(F, c); } }
#pragma unroll 1
                for (int k = 0; k < 8; ++k) {
                    const int xq = (x + k) & 7;
#pragma unroll 1
                    for (int i = queue_take(F, F.ctl + CW_AQ + 64 * xq); i < 128; i = queue_take(F, F.ctl + CW_AQ + 64 * xq)) {
                        const int bh = 2 * xq + (i & 1), qt = 63 - (i >> 1);
                        att::diff_unit8(F.lds, bh >> 3, bh & 7, qt, ws + WS_QD, ws + WS_KDT, ws + WS_VDT, (bf16_t*)(ws + WS_AD), F.in[I_SUBLN], F.in[I_RELB]);
                    }
                }
                for (int c = queue_take(F, F.ctl + CW_CQ); c < CV_NCHUNK; c = queue_take(F, F.ctl + CW_CQ)) { __syncthreads(); convert_chunk(F, c); }
            }
            __syncthreads();
            p3_kmean(F);
        }
        }
        SEAM(3);
    }
    if (lo <= 4 && 4 < hi) { if (IN(4)) p4_gating(F); SEAM(4); }
    if (lo <= 5 && 5 < hi) {
        if (IN(5)) {
#pragma unroll 1
        for (int rep_ = 0; rep_ < NREP(5); ++rep_) { if (rep_) xcd_barrier(bar);
            constexpr int MB_CPU = 2;
            LAS int* pre = (LAS int*)(F.lds + LDSX_OFF);
            const unsigned* mcnt = F.ctl + CW_MCNT;
            const int mycnt = (int)__hip_atomic_load(mcnt + F.tid, RLX_AGENT);
            pre[F.tid] = (1 + ((mycnt + 255) >> 8) + MB_CPU - 1) / MB_CPU;
            __syncthreads();
            int src = 0;
            for (int off = 1; off < 512; off <<= 1) { const int v = pre[src * 512 + F.tid] + (F.tid >= off ? pre[src * 512 + F.tid - off] : 0); pre[(src ^ 1) * 512 + F.tid] = v; src ^= 1; __syncthreads(); }
            LAS int* inc = (LAS int*)(F.lds + att::MB_INC);
            inc[F.tid] = pre[src * 512 + F.tid];
            __syncthreads();
            const int total = inc[511];
            for (int u = F.blk; u < total; u += F.G) {
                int lo_ = -1, hi_ = 511;
#pragma unroll
                for (int st = 0; st < 9; ++st) { const int mid = (lo_ + hi_) >> 1; if (inc[mid] > u) hi_ = mid; else lo_ = mid; }
                const int l = __builtin_amdgcn_readfirstlane(hi_);
                const int before = l > 0 ? __builtin_amdgcn_readfirstlane(inc[l - 1]) : 0;
                const int j = u - before;
                const int cntl = (int)__builtin_amdgcn_readfirstlane(__hip_atomic_load(mcnt + l, RLX_AGENT));
                const int nch = 1 + ((cntl + 255) >> 8);
                const int c0 = j * MB_CPU, c1 = (c0 + MB_CPU) < nch ? (c0 + MB_CPU) : nch;
                att::moba_block8(F.lds, l >> 8, (l >> 5) & 7, l & 31, (const int*)(ws + WS_MLIST) + (size_t)l * 8192, cntl, c0, c1, ws + WS_QM8, ws + WS_KMT8, ws + WS_VMT8, (bf16_t*)(ws + WS_PARTS), (float*)(ws + WS_ML), F.in[I_RELB]);
            }
            __syncthreads();
        }
        }
        SEAM(5);
    }
    if (lo <= 6 && 6 < hi) { if (IN(6)) { for (int rep_ = 0; rep_ < NREP(6); ++rep_) { if (rep_) xcd_barrier(bar); p6_merge(F); } } SEAM(6); }
    if (lo <= 7 && 7 < hi) {
        if (IN(7)) {
#pragma unroll 1
        for (int rep_ = 0; rep_ < NREP(7); ++rep_) { if (rep_) xcd_barrier(bar);
            { pg8::PairOrder S; S.init(ws + WS_AD, ws + WS_W_OD_T, ws + WS_AM, ws + WS_W_OM_T, T, 2048, O78F8 ? 512 : 1024, F.G, F.blk);
              epi::GatePair E{epi::GateMul<0>{(const bf16_t*)(ws + WS_GATES), 0, nullptr, (bf16_t*)(ws + WS_T1)}, epi::GateMul<1>{(const bf16_t*)(ws + WS_GATES), 2048, (const bf16_t*)(ws + WS_T1), (bf16_t*)(ws + WS_G)}};
              pg8::gemm_phase<epi::GatePair, pg8::PairOrder, true, true, false, O78F8>(F.lds, O78F8 ? 512 : 1024, S, E, nullptr); }
        }
        }
        SEAM(7);
    }
    if (lo <= 8 && 8 < hi) {
        if (IN(8)) {
#pragma unroll 1
        for (int rep_ = 0; rep_ < NREP(8); ++rep_) { if (rep_) xcd_barrier(bar);
            SO S; S.init(ws + WS_G, ws + WS_W_OUT_T, T, 2048, O78F8 ? 1024 : 2048, F.G, F.blk); epi::ResidBf16 E{F.in[I_X], (bf16_t*)(ws + WS_X1), (const float*)(ws + WS_MOD), 4096};
            pg8::gemm_phase<epi::ResidBf16, SO, true, true, false, O78F8>(F.lds, O78F8 ? 1024 : 2048, S, E, nullptr);
        }
        }
        SEAM(8);
    }
    if (lo <= 9 && 9 < hi) { if (IN(9)) p9_route(F); SEAM(9); }
    if (lo <= 10 && 10 < hi) {
        if (IN(10)) {
#pragma unroll 1
        for (int rep_ = 0; rep_ < NREP(10); ++rep_) { if (rep_) xcd_barrier(bar);
            moe_tables(F);
            MoeSched S{(const LAS int*)(F.lds + LDSX_OFF + MT_CNT), (const LAS int*)(F.lds + LDSX_OFF + MT_TST), (const LAS int*)(F.lds + LDSX_OFF + MT_COFF), F.G, F.blk, 2,
                       (const char*)(ws + WS_H2F8), (const char*)(ws + WS_W_EGU_T), 0, (size_t)1024 * 2048, (size_t)256 * 2048, false};
            LAS unsigned short* gtab = (LAS unsigned short*)(F.lds + LDSX_OFF + MT_GTAB);
            { const int* ELIST = (const int*)(ws + WS_ELIST); pg8::Unit u;
              for (int i = 0; i < 24 && S.next(i, u); ++i) { if (F.tid < 256) { const int j = u.pm - S.tst[u.aux]; gtab[i * 256 + F.tid] = (unsigned short)(F.tid < u.valid ? ELIST[(size_t)u.aux * 16384 + 256 * j + F.tid] : 0); } } }
            __syncthreads();
            { epi::SwiGLU8 E{ws + WS_ACT}; pg8::gemm_phase<epi::SwiGLU8, MoeSched, true, true, true, true>(F.lds, 1024, S, E, gtab); }
            { SO S2; S2.init(ws + WS_H2F8, ws + WS_W_SHGU_T, T, 1024, 1024, F.G, F.blk); epi::SwiGLU8 E{ws + WS_SHACT};
              pg8::gemm_phase<epi::SwiGLU8, SO, true, true, false, true>(F.lds, 1024, S2, E, nullptr); }
        }
        }
        SEAM(10);
    }
    if (lo <= 11 && 11 < hi) {
        if (IN(11)) {
            moe_tables(F);
            MoeSched S{(const LAS int*)(F.lds + LDSX_OFF + MT_CNT), (const LAS int*)(F.lds + LDSX_OFF + MT_TST), (const LAS int*)(F.lds + LDSX_OFF + MT_COFF), F.G, F.blk, 3,
                       (const char*)(ws + WS_ACT), (const char*)(ws + WS_W_ED_T), (size_t)256 * 512, (size_t)2048 * 512, (size_t)256 * 512, true};
#pragma unroll 1
            for (int rep_ = 0; rep_ < NREP(11); ++rep_) { if (rep_) xcd_barrier(bar);
            { epi::DownY E{(unsigned char*)(ws + WS_Y)}; pg8::gemm_phase<epi::DownY, MoeSched, true, true, false, true>(F.lds, 256, S, E, nullptr); } }
            { SO S2; S2.init(ws + WS_SHACT, ws + WS_W_SHD_T, T, 2048, 256, F.G, F.blk); epi::DownShared8 E{ws + WS_SHOUT};
              pg8::gemm_phase<epi::DownShared8, SO, true, true, false, true>(F.lds, 256, S2, E, nullptr); }
        }
        SEAM(11);
    }
    if (lo <= 12 && 12 < hi) { if (IN(12)) p12_combine(F); }
#undef IN
#undef SEAM
}

extern "C" void kernel_launch(void* const* d_in, const int* in_sizes, int n_in, void* d_out, int out_size, void* d_ws, size_t ws_size, hipStream_t stream) {
    static int grid = 0;
    if (grid == 0) {
        if (n_in != 22 || in_sizes[0] != T * D || out_size != T * D || ws_size < WS_END) { fprintf(stderr, "kernel_launch: unexpected shapes (n_in %d, in0 %d, out %d, ws %zu < %zu); nothing launched\n", n_in, n_in > 0 ? in_sizes[0] : -1, out_size, ws_size, (size_t)WS_END); grid = -1; return; }
        int dev = 0, cus = 0, per_cu = 0;
        if (hipGetDevice(&dev) != hipSuccess || hipDeviceGetAttribute(&cus, hipDeviceAttributeMultiprocessorCount, dev) != hipSuccess) { grid = -1; return; }
        if (hipFuncSetAttribute((const void*)fwd_kernel, hipFuncAttributeMaxDynamicSharedMemorySize, LDS_BYTES) != hipSuccess) { fprintf(stderr, "kernel_launch: hipFuncSetAttribute failed\n"); grid = -1; return; }
        if (hipOccupancyMaxActiveBlocksPerMultiprocessor(&per_cu, (const void*)fwd_kernel, 512, LDS_BYTES) != hipSuccess || per_cu < 1) fprintf(stderr, "kernel_launch: occupancy query says %d\n", per_cu);
        (void)hipGetLastError();
        grid = cus;
    }
    if (grid < 0) return;
    if (hipMemsetAsync((char*)d_ws + WS_CTL, 0, CTL_ZERO_BYTES, stream) != hipSuccess) { fprintf(stderr, "kernel_launch: memset failed\n"); return; }
    Args a{};
    for (int i = 0; i < 22; ++i) a.in[i] = (const float*)d_in[i];
    a.out = (float*)d_out; a.ws = (unsigned char*)d_ws;
    for (int li = 0; li < MK_N_LAUNCHES; ++li) {
        a.ph_lo = (MK_N_LAUNCHES == 1) ? 0 : li; a.ph_hi = (MK_N_LAUNCHES == 1) ? NPHASE : li + 1;
        hipLaunchKernelGGL(fwd_kernel, dim3(grid), dim3(512), LDS_BYTES, stream, a);
        const hipError_t le = hipPeekAtLastError();
        if (le != hipSuccess) { fprintf(stderr, "kernel_launch: launch %d failed: %s\n", li, hipGetErrorName(le)); break; }
    }
}
```

```cpp
#include <hip/hip_runtime.h>
#include <cstdio>
#include <cstdint>

#define LAS __attribute__((address_space(3)))
#define GAS __attribute__((address_space(1)))
typedef unsigned short bf16_t;
typedef short bf16x8 __attribute__((ext_vector_type(8)));
typedef short s16x4 __attribute__((ext_vector_type(4)));
typedef int i32x4 __attribute__((ext_vector_type(4)));
typedef int i32x8 __attribute__((ext_vector_type(8)));
typedef float f32x4 __attribute__((ext_vector_type(4)));
typedef float f32x2 __attribute__((ext_vector_type(2)));
typedef float f32x16 __attribute__((ext_vector_type(16)));
typedef unsigned u32x4 __attribute__((ext_vector_type(4)));
typedef unsigned u32x2 __attribute__((ext_vector_type(2)));
typedef __bf16 bf16x2_t __attribute__((ext_vector_type(2)));

#ifndef MK_N_LAUNCHES
#define MK_N_LAUNCHES 1
#endif
#ifndef REP_MASK
#define REP_MASK 0u
#endif
#ifndef PHASE_MASK
#define PHASE_MASK 0xFFFFFFFFu
#endif

constexpr int NB = 2, SEQ = 8192, T = NB * SEQ, D = 2048, NH = 8, INC = 10240, NE = 64, EDIM = 512, TOPK = 8;
constexpr int NPHASE = 13;
constexpr float RMS_EPS = 1e-6f;
constexpr float LOG2E = 1.4426950408889634f;

constexpr size_t MiB = 1u << 20;
constexpr size_t WS_CTL = 0, CTL_ZERO_BYTES = 1 * MiB;
constexpr size_t WS_MODP = 1 * MiB;
constexpr size_t WS_MOD = 4 * MiB;
constexpr size_t WS_KMEAN = 4 * MiB + 256 * 1024;
constexpr size_t WS_WR = 4 * MiB + 512 * 1024;
constexpr size_t WS_TOKE = 5 * MiB;
constexpr size_t WS_TOKW = 5 * MiB + 512 * 1024;
constexpr size_t WS_W_IN_T = 8 * MiB;
constexpr size_t WS_W_OD_T = 48 * MiB;
constexpr size_t WS_W_OM_T = 52 * MiB;
constexpr size_t WS_W_OUT_T = 56 * MiB;
constexpr size_t WS_W_SHGU_T = 64 * MiB;
constexpr size_t WS_W_SHD_T = 68 * MiB;
constexpr size_t WS_ELIST = 70 * MiB;
constexpr size_t WS_W_ED_T = 76 * MiB;
constexpr size_t WS_W_EGU_T = 204 * MiB;
constexpr size_t WS_H = 460 * MiB;
constexpr size_t WS_QD = 524 * MiB;
constexpr size_t WS_KDT = 556 * MiB;
constexpr size_t WS_VDT = 588 * MiB;
constexpr size_t WS_QM = 620 * MiB;
constexpr size_t WS_KMT = 652 * MiB;
constexpr size_t WS_VMT = 684 * MiB;
constexpr size_t WS_GATES = 716 * MiB;
constexpr size_t WS_AD = 844 * MiB;
constexpr size_t WS_AM = 876 * MiB;
constexpr size_t WS_ML = 908 * MiB;
constexpr size_t WS_MLIST = 912 * MiB;
constexpr size_t WS_PARTS = 460 * MiB;
constexpr size_t WS_G = 460 * MiB;
constexpr size_t WS_T1 = 524 * MiB;
constexpr size_t WS_X1 = 524 * MiB;
constexpr size_t WS_H2 = 588 * MiB;
constexpr size_t WS_ACT = 716 * MiB;
constexpr size_t WS_H2F8 = 800 * MiB;
constexpr float F8_SH = 8.0f, F8_SW = 64.0f, F8_SA = 8.0f, F8_SD = 32.0f;
namespace att { constexpr float D8_QS = 0.125f * LOG2E * 16.0f, D8_KS = 4.0f, D8_VS = 8.0f; }
constexpr size_t WS_QM8 = 604 * MiB, WS_VMT8 = 684 * MiB, WS_KMT8 = 700 * MiB;
namespace att { constexpr float MB8_QS = 0.08838834764831845f * LOG2E * 16.0f; }
constexpr float F8_SPART = 16.0f;
constexpr float F8_SGATE = 256.0f;
constexpr bool O78F8 = true;
constexpr float F8_SAD = 16.0f, F8_SAM = 64.0f, F8_SWO = 32.0f, F8_SG = 16.0f, F8_SWOUT = 64.0f;
constexpr bool P2F8 = true;
constexpr float DS2 = 1.0f;
constexpr int P2_EXP = 9;
constexpr size_t WS_SHACT = 860 * MiB;
constexpr size_t WS_SHOUT = 588 * MiB;
constexpr size_t WS_Y = 204 * MiB;
constexpr size_t WS_END = 928 * MiB;
static_assert(WS_Y + (size_t)131072 * 2048 * 2 <= WS_ACT, "Y must not reach ACT");
static_assert(WS_ACT + (size_t)147456 * 512 * 2 <= WS_SHACT && WS_SHACT + (size_t)T * 512 * 2 <= WS_END, "act map");
static_assert(WS_PARTS + (size_t)T * 8 * 4 * 128 * 2 <= WS_VDT, "parts overlay");

constexpr int CW_BAR = 4096;
constexpr int CW_ECNT = 8192;
constexpr int CW_MCNT = 8448;
constexpr int CW_AQ = 9216;
constexpr int CW_CQ = 9216 + 64 * 8;

constexpr int RING_BYTES = 131072;
constexpr int LDSX_OFF = RING_BYTES;
constexpr int MISC_OFF = RING_BYTES + 16384;
constexpr int LDS_BYTES = MISC_OFF + 128;

#define LDS_WAIT() asm volatile("s_waitcnt lgkmcnt(0)" ::: "memory")
#define VM_WAIT() asm volatile("s_waitcnt vmcnt(0)" ::: "memory")
#define RLX_AGENT __ATOMIC_RELAXED, __HIP_MEMORY_SCOPE_AGENT

__device__ __forceinline__ unsigned cvtpk(float lo, float hi) { f32x2 v = {lo, hi}; bf16x2_t b = __builtin_convertvector(v, bf16x2_t); return __builtin_bit_cast(unsigned, b); }
__device__ __forceinline__ float bf_lo(unsigned u) { return __uint_as_float(u << 16); }
__device__ __forceinline__ float bf_hi(unsigned u) { return __uint_as_float(u & 0xffff0000u); }
__device__ __forceinline__ float wave_sum(float v) {
#pragma unroll
    for (int o = 1; o < 64; o <<= 1) v += __shfl_xor(v, o);
    return v;
}
__device__ __forceinline__ float fast_exp2(float x) { return __builtin_amdgcn_exp2f(x); }
__device__ __forceinline__ float fast_rcp(float x) { return __builtin_amdgcn_rcpf(x); }
__device__ __forceinline__ float sigmoidf_(float x) { return fast_rcp(1.0f + fast_exp2(-x * LOG2E)); }
__device__ __forceinline__ float siluf_(float x) { return x * sigmoidf_(x); }

#define XB_TMO      128
#define XB_XCNT(j)  (256  + 64 * (j))
#define XB_XSUB(j)  (1280 + 64 * (j))
#define XB_XGEN(j)  (2304 + 64 * (j))
#define XB_TOP      3328
#define XB_TOPGEN   3392
#define XCD_BAR_WORDS 3456
#define XB_SPIN_CAP (1u << 22)

__device__ __forceinline__ unsigned xb_ld(unsigned* p)              { return __hip_atomic_load(p, __ATOMIC_RELAXED, __HIP_MEMORY_SCOPE_AGENT); }
__device__ __forceinline__ unsigned xb_add(unsigned* p, unsigned v) { return __hip_atomic_fetch_add(p, v, __ATOMIC_RELAXED, __HIP_MEMORY_SCOPE_AGENT); }
__device__ __forceinline__ unsigned xb_xcc_id() { return (unsigned)__builtin_amdgcn_s_getreg((3 << 11) | 20) & 0xFu; }
#define XB_SPIN(cond, bar) do { unsigned _sp = 0; while (cond) { __builtin_amdgcn_s_sleep(1); \
    if ((++_sp & 255u) == 0u) { if (xb_ld(&(bar)[XB_TMO])) break; if (_sp > XB_SPIN_CAP) { atomicAdd(&(bar)[XB_TMO], 1u); break; } } } } while (0)

struct XcdBarrier { unsigned* bar; unsigned x; volatile LAS unsigned* st; };

__device__ __forceinline__ XcdBarrier xcd_barrier_post(unsigned* bar, volatile LAS unsigned* st) {
    XcdBarrier b; b.bar = bar; b.x = xb_xcc_id(); b.st = st;
    if (threadIdx.x == 0) (void)xb_add(&bar[XB_XCNT(b.x)], 1u);
    return b;
}
__device__ __forceinline__ void xcd_barrier_complete(unsigned* bar, unsigned x, unsigned& nloc, unsigned& nx) {
    const unsigned G = gridDim.x * gridDim.y * gridDim.z;
    unsigned sum, cnt, mine, sp = 0u;
    for (;;) {
        sum = 0u; cnt = 0u; mine = 0u;
#pragma unroll
        for (unsigned j = 0; j < 16; ++j) { const unsigned c = xb_ld(&bar[XB_XCNT(j)]); sum += c; cnt += (c > 0u) ? 1u : 0u; mine = (j == x) ? c : mine; }
        if (sum == G) break;
        __builtin_amdgcn_s_sleep(1);
        if ((++sp & 255u) == 0u) { if (xb_ld(&bar[XB_TMO])) break; if (sp > XB_SPIN_CAP) { atomicAdd(&bar[XB_TMO], 1u); break; } }
    }
    nloc = mine > 0u ? mine : 1u; nx = cnt > 0u ? cnt : 1u;
}
__device__ __forceinline__ void xcd_barrier(const XcdBarrier& b) {
    asm volatile("s_waitcnt vmcnt(0)" ::: "memory");
    __syncthreads();
    if (threadIdx.x == 0) {
        unsigned* bar = b.bar;
        __builtin_amdgcn_s_waitcnt(0);
        unsigned nloc = b.st[0], nx = b.st[1];
        if (nloc == 0u) { xcd_barrier_complete(bar, b.x, nloc, nx); b.st[0] = nloc; b.st[1] = nx; }
        const unsigned old = xb_add(&bar[XB_XSUB(b.x)], 1u);
        const unsigned gen = old / nloc;
        if (old + 1u == (gen + 1u) * nloc) {
            __builtin_amdgcn_fence(__ATOMIC_RELEASE, "agent");
            asm volatile("s_waitcnt vmcnt(0)" ::: "memory");
            const unsigned og = xb_add(&bar[XB_TOP], 1u);
            const unsigned tg = og / nx;
            if (og + 1u == (tg + 1u) * nx) xb_add(&bar[XB_TOPGEN], 1u);
            else XB_SPIN(xb_ld(&bar[XB_TOPGEN]) == tg, bar);
            __builtin_amdgcn_fence(__ATOMIC_ACQUIRE, "agent");
            xb_add(&bar[XB_XGEN(b.x)], 1u);
            asm volatile("s_waitcnt vmcnt(0)" ::: "memory");
        } else {
            XB_SPIN(xb_ld(&bar[XB_XGEN(b.x)]) == gen, bar);
            __builtin_amdgcn_fence(__ATOMIC_ACQUIRE, "agent");
            asm volatile("s_waitcnt vmcnt(0)" ::: "memory");
        }
    }
    __syncthreads();
}

namespace pg8 {
constexpr int BM = 256, BK = 64, HALF = 128, HTB = HALF * BK * 2, STAGE_BYTES = 8 * HTB, NXCD = 8, WGM = 8;
static_assert(STAGE_BYTES == RING_BYTES, "ring");
__host__ __device__ __forceinline__ int lds_byte(int r, int c) { const int st = (r >> 4) * 2 + (c >> 5), rr = r & 15, cc = c & 31, ob = rr * 64 + cc * 2; return st * 1024 + (ob ^ (((ob >> 9) & 1) << 5)); }
__host__ __device__ __forceinline__ void stage_rc(int b, int& R, int& C) { const int st = b / 1024, sb = b % 1024, swz = sb ^ (((sb >> 9) & 1) << 5); R = (st >> 1) * 16 + swz / 64; C = (st & 1) * 32 + (swz % 64) / 2; }
__host__ __device__ __forceinline__ int perm32(int rho) { const int n = rho >> 4, i = rho & 15; return 8 * (i >> 2) + 4 * n + (i & 3); }

struct Unit { int pm, pn; const char* A; const char* B; int rowbase, valid, aux; };

struct StaticOrder {
    int nM, nN, nwg, G, c; const char* A; const char* B; size_t tstep;
    __device__ void init(const void* A_, const void* B_, int M, int N, int K, int G_, int c_) { A = (const char*)A_; B = (const char*)B_; nM = M / BM; nN = N / BM; nwg = nM * nN; G = G_; c = c_; tstep = (size_t)BM * K * 2; }
    __device__ bool next(int i, Unit& u) const {
        const long L = (long)i * G + c; if (L >= nwg) return false;
        int wgid = (int)L; { const int q = nwg / NXCD, r = nwg % NXCD, xcd = wgid % NXCD, off = wgid / NXCD; wgid = (xcd < r ? xcd * (q + 1) : r * (q + 1) + (xcd - r) * q) + off; }
        const int nig = WGM * nN, gid = wgid / nig, fm = gid * WGM, gsz = (nM - fm) < WGM ? (nM - fm) : WGM;
        u.pm = fm + ((wgid % nig) % gsz); u.pn = (wgid % nig) / gsz;
        u.A = A + (size_t)u.pm * tstep; u.B = B + (size_t)u.pn * tstep; u.rowbase = u.pm * BM; u.valid = BM; u.aux = 0; return true;
    }
};

struct PairOrder {
    StaticOrder base; const char* A1; const char* B1;
    __device__ void init(const void* A0_, const void* B0_, const void* A1_, const void* B1_, int M, int N, int K, int G_, int c_) { base.init(A0_, B0_, M, N, K, G_, c_); A1 = (const char*)A1_; B1 = (const char*)B1_; }
    __device__ bool next(int i, Unit& u) const {
        if (!base.next(i >> 1, u)) return false;
        if (i & 1) { u.A = A1 + (size_t)u.pm * base.tstep; u.B = B1 + (size_t)u.pn * base.tstep; u.aux = 1; }
        return true;
    }
};

template <class Epi, class Sched, bool ALIGN_EPI, bool SP2, bool GATHER, bool F8 = false>
__device__ __forceinline__ void gemm_phase(LAS unsigned char* lds, const int K, const Sched& S, const Epi& E, const LAS unsigned short* gtab) {
    int tid_ = threadIdx.x; asm volatile("" : "+v"(tid_));
    const int tid = tid_, wid = __builtin_amdgcn_readfirstlane(tid >> 6), lane = tid & 63, wr = wid >> 2, wc = wid & 3, fr = lane & 15, fq = lane >> 4;
    const int nt = K / BK;
    unsigned voffA[2], voffB[2]; int RA[2], CA[2];
#pragma unroll
    for (int i = 0; i < 2; ++i) { int R, C; stage_rc(tid * 16 + i * 8192, R, C); const int Rb = (int)Epi::PERM == 2 ? (64 * (R >> 5) + 16 * ((R >> 2) & 3) + 4 * ((R >> 4) & 1) + (R & 3)) : (Epi::PERM ? ((R & ~31) + perm32(R & 31)) : R);
        RA[i] = R; CA[i] = C; voffA[i] = (unsigned)(R * K + C) * 2u; voffB[i] = (unsigned)(Rb * K + C) * 2u; }
    const size_t kstep = (size_t)(BK * 2);
    const size_t hstep = (size_t)HALF * K * 2;
    const size_t hstepB = (int)Epi::PERM == 2 ? (size_t)8 * K * 2 : hstep;
    const unsigned ldsw = (unsigned)wid * 1024u;
    const int aoff = lds_byte(wr * 64 + fr, fq * 8), boff = lds_byte(wc * 32 + fr, fq * 8);
    unsigned vA[2][2], nvA[2][2];
#define PG8_SA(b, h) (((b) * 2 + (h)) * HTB)
#define PG8_SB(b, h) ((4 + (b) * 2 + (h)) * HTB)
#define PG8_GL(gp, ldsoff) __builtin_amdgcn_global_load_lds((const unsigned*)(gp), (LAS unsigned*)(lds + (ldsoff)), 16, 0, 0)
#define PG8_STAGE(bufoff, gbase, voff) do { _Pragma("unroll") for (int _i = 0; _i < 2; ++_i) PG8_GL((const char*)(gbase) + (voff)[_i], (bufoff) + ldsw + _i * 8192); } while (0)
#define PG8_STA(bufoff, gbase, h, nx) do { if constexpr (GATHER) { \
        const unsigned _o0 = (nx) ? nvA[h][0] : vA[h][0], _o1 = (nx) ? nvA[h][1] : vA[h][1]; \
        PG8_GL((const char*)(gbase) + _o0, (bufoff) + ldsw); PG8_GL((const char*)(gbase) + _o1, (bufoff) + ldsw + 8192); \
    } else { PG8_STAGE(bufoff, (const char*)(gbase) + (h) * hstep, voffA); } } while (0)
#define PG8_GVA(dst, ul) do { _Pragma("unroll") for (int _h = 0; _h < 2; ++_h) _Pragma("unroll") for (int _i = 0; _i < 2; ++_i) \
        dst[_h][_i] = (unsigned)gtab[(ul) * 256 + _h * 128 + RA[_i]] * (unsigned)(K * 2) + (unsigned)(CA[_i] * 2); } while (0)
#define PG8_LDA(dst, b, h) do { _Pragma("unroll") for (int m = 0; m < 4; ++m) _Pragma("unroll") for (int k = 0; k < 2; ++k) dst[m][k] = *(const LAS bf16x8*)(lds + PG8_SA(b, h) + aoff + m * 2048 + k * 1024); } while (0)
#define PG8_LDB(dst, b, h) do { _Pragma("unroll") for (int n = 0; n < 2; ++n) _Pragma("unroll") for (int k = 0; k < 2; ++k) dst[n][k] = *(const LAS bf16x8*)(lds + PG8_SB(b, h) + boff + n * 2048 + k * 1024); } while (0)
#define PG8_MMA(ai, bj, At, Bt) do { __builtin_amdgcn_s_setprio(1); _Pragma("unroll") for (int m = 0; m < 4; ++m) _Pragma("unroll") for (int n = 0; n < 2; ++n) { \
        if constexpr (F8) { const i32x4 _b0 = __builtin_bit_cast(i32x4, Bt[n][0]), _b1 = __builtin_bit_cast(i32x4, Bt[n][1]), _a0 = __builtin_bit_cast(i32x4, At[m][0]), _a1 = __builtin_bit_cast(i32x4, At[m][1]); \
            const i32x8 _b8 = __builtin_shufflevector(_b0, _b1, 0, 1, 2, 3, 4, 5, 6, 7), _a8 = __builtin_shufflevector(_a0, _a1, 0, 1, 2, 3, 4, 5, 6, 7); \
            asm volatile("v_mfma_scale_f32_16x16x128_f8f6f4 %0, %1, %2, %0, %3, %4 op_sel_hi:[0,0,0]" : "+v"(acc[ai][bj][m][n]) : "v"(_b8), "v"(_a8), "v"(f8sc), "v"(f8one)); } \
        else { _Pragma("unroll") for (int k = 0; k < 2; ++k) acc[ai][bj][m][n] = __builtin_amdgcn_mfma_f32_16x16x32_bf16(Bt[n][k], At[m][k], acc[ai][bj][m][n], 0, 0, 0); } } __builtin_amdgcn_s_setprio(0); } while (0)
#define PG8_WAIT_V(n) asm volatile("s_waitcnt vmcnt(" #n ")" ::: "memory")
#define PG8_WAIT_L(n) asm volatile("s_waitcnt lgkmcnt(" #n ")" ::: "memory")
#define PG8_BAR __builtin_amdgcn_s_barrier()
#define PG8_SCHED __builtin_amdgcn_sched_barrier(0)
    Unit cur, nxt; int ui = 0;
    if (!S.next(0, cur)) return;
    if constexpr (GATHER) { PG8_GVA(vA, 0); }
    int f8sc = 0x7F7F7F7F;
    const int f8one = 0x7F7F7F7F;
    f32x4 acc[2][2][4][2];
#pragma unroll
    for (int a = 0; a < 2; ++a)
#pragma unroll
        for (int b = 0; b < 2; ++b)
#pragma unroll
            for (int m = 0; m < 4; ++m)
#pragma unroll
                for (int n = 0; n < 2; ++n) acc[a][b][m][n] = (f32x4){0.f, 0.f, 0.f, 0.f};
    bf16x8 At[4][2], B0[2][2], B1[2][2];
    const char* cA = cur.A; const char* cB = cur.B;
    if constexpr (SP2) {
        PG8_STAGE(PG8_SB(0, 0), cB, voffB); PG8_STAGE(PG8_SB(0, 1), cB + hstepB, voffB); PG8_STA(PG8_SA(0, 0), cA, 0, false); PG8_STA(PG8_SA(0, 1), cA, 1, false);
        if (wr == 1) PG8_BAR;
        PG8_WAIT_V(2); PG8_BAR;
        PG8_STAGE(PG8_SB(1, 0), cB + kstep, voffB); PG8_STA(PG8_SA(1, 0), cA + kstep, 0, false); PG8_STAGE(PG8_SB(1, 1), cB + hstepB + kstep, voffB);
        PG8_WAIT_V(6); PG8_BAR;
    } else {
        PG8_STAGE(PG8_SB(0, 0), cB, voffB); PG8_STA(PG8_SA(0, 0), cA, 0, false); PG8_STAGE(PG8_SB(0, 1), cB + hstepB, voffB); PG8_STA(PG8_SA(0, 1), cA, 1, false);
        if (wr == 1) PG8_BAR;
        PG8_WAIT_V(4); PG8_BAR;
        PG8_STAGE(PG8_SB(1, 0), cB + kstep, voffB); PG8_STA(PG8_SA(1, 0), cA + kstep, 0, false); PG8_STAGE(PG8_SB(1, 1), cB + hstepB + kstep, voffB);
        PG8_WAIT_V(6); PG8_BAR;
    }
    for (;;) {
        if constexpr (F8) f8sc = 0x01010101 * (127 - E.f8exp(cur));
        bool has_next = false; const char* nA = cA; const char* nB = cB;
#define PG8_NEXT_UNIT() do { has_next = S.next(ui + 1, nxt); nA = has_next ? nxt.A : cA; nB = has_next ? nxt.B : cB; \
        if constexpr (GATHER) { if (has_next) { PG8_GVA(nvA, ui + 1); } else { _Pragma("unroll") for (int _h = 0; _h < 2; ++_h) _Pragma("unroll") for (int _i = 0; _i < 2; ++_i) nvA[_h][_i] = vA[_h][_i]; } } } while (0)
        if (nt < 4 || !SP2) PG8_NEXT_UNIT();
        for (int t = 0; t < nt; t += 2) {
            const bool last = (t == nt - 2);
            const char* a1 = cA + (size_t)(t + 1) * kstep;
            const char* a2 = last ? nA : cA + (size_t)(t + 2) * kstep; const char* b2 = last ? nB : cB + (size_t)(t + 2) * kstep;
            const char* a3 = a2 + kstep; const char* b3 = b2 + kstep;
            if constexpr (SP2) {
            PG8_LDB(B0, 0, 0); PG8_LDB(B1, 0, 1); PG8_SCHED; PG8_LDA(At, 0, 0); PG8_STA(PG8_SA(1, 1), a1, 1, false);
            PG8_WAIT_V(8); PG8_WAIT_L(0); PG8_BAR; PG8_MMA(0, 0, At, B0); PG8_MMA(0, 1, At, B1); if (t == 0 && nt >= 4) { PG8_SCHED; PG8_NEXT_UNIT(); PG8_SCHED; } PG8_BAR; PG8_SCHED;
            PG8_LDA(At, 0, 1); PG8_STAGE(PG8_SB(0, 0), b2, voffB); PG8_STAGE(PG8_SB(0, 1), b2 + hstepB, voffB); PG8_STA(PG8_SA(0, 0), a2, 0, last);
            PG8_WAIT_V(8); PG8_WAIT_L(0); PG8_BAR; PG8_MMA(1, 0, At, B0); PG8_MMA(1, 1, At, B1); PG8_BAR; PG8_SCHED;
            PG8_LDB(B0, 1, 0); PG8_LDB(B1, 1, 1); PG8_SCHED; PG8_LDA(At, 1, 0); PG8_STA(PG8_SA(0, 1), a2, 1, last);
            PG8_WAIT_V(8); PG8_WAIT_L(0); PG8_BAR; PG8_MMA(0, 0, At, B0); PG8_MMA(0, 1, At, B1); PG8_BAR; PG8_SCHED;
            PG8_LDA(At, 1, 1); PG8_STAGE(PG8_SB(1, 0), b3, voffB); PG8_STAGE(PG8_SB(1, 1), b3 + hstepB, voffB); PG8_STA(PG8_SA(1, 0), a3, 0, last);
            PG8_WAIT_V(8); PG8_WAIT_L(0); PG8_BAR; PG8_MMA(1, 0, At, B0); PG8_MMA(1, 1, At, B1); PG8_BAR; PG8_SCHED;
            } else {
            PG8_LDB(B0, 0, 0); PG8_SCHED; PG8_LDA(At, 0, 0); PG8_STA(PG8_SA(1, 1), a1, 1, false);
            PG8_WAIT_L(8); PG8_BAR; PG8_WAIT_L(0); PG8_MMA(0, 0, At, B0); PG8_BAR; PG8_SCHED;
            PG8_LDB(B1, 0, 1); PG8_STAGE(PG8_SB(0, 0), b2, voffB);
            PG8_BAR; PG8_WAIT_L(0); PG8_MMA(0, 1, At, B1); PG8_BAR;
            PG8_LDA(At, 0, 1); PG8_STA(PG8_SA(0, 0), a2, 0, last);
            PG8_BAR; PG8_WAIT_L(0); PG8_MMA(1, 0, At, B0); PG8_BAR; PG8_SCHED;
            PG8_STAGE(PG8_SB(0, 1), b2 + hstepB, voffB);
            PG8_WAIT_V(6); PG8_BAR; PG8_MMA(1, 1, At, B1); PG8_BAR;
            PG8_LDB(B0, 1, 0); PG8_SCHED; PG8_LDA(At, 1, 0); PG8_STA(PG8_SA(0, 1), a2, 1, last);
            PG8_WAIT_L(8); PG8_BAR; PG8_WAIT_L(0); PG8_MMA(0, 0, At, B0); PG8_BAR; PG8_SCHED;
            PG8_LDB(B1, 1, 1); PG8_STAGE(PG8_SB(1, 0), b3, voffB);
            PG8_BAR; PG8_WAIT_L(0); PG8_MMA(0, 1, At, B1); PG8_BAR;
            PG8_LDA(At, 1, 1); PG8_STA(PG8_SA(1, 0), a3, 0, last);
            PG8_BAR; PG8_WAIT_L(0); PG8_MMA(1, 0, At, B0); PG8_BAR; PG8_SCHED;
            PG8_STAGE(PG8_SB(1, 1), b3 + hstepB, voffB);
            PG8_WAIT_V(6); PG8_BAR; PG8_MMA(1, 1, At, B1); PG8_BAR;
            }
        }
        if constexpr (F8) asm volatile("s_nop 15\n\ts_nop 15" ::: "memory");
        if constexpr (ALIGN_EPI) { if (wr == 0) PG8_BAR; }
        { int l2 = lane; asm volatile("" : "+v"(l2)); E(acc, cur, wr, wc, l2 & 15, l2 >> 4); }
        if (!has_next) break;
#pragma unroll
        for (int a = 0; a < 2; ++a)
#pragma unroll
            for (int b = 0; b < 2; ++b)
#pragma unroll
                for (int m = 0; m < 4; ++m)
#pragma unroll
                    for (int n = 0; n < 2; ++n) acc[a][b][m][n] = (f32x4){0.f, 0.f, 0.f, 0.f};
        cur = nxt; cA = nA; cB = nB; ++ui;
        if constexpr (GATHER) {
#pragma unroll
            for (int _h = 0; _h < 2; ++_h)
#pragma unroll
                for (int _i = 0; _i < 2; ++_i) vA[_h][_i] = nvA[_h][_i];
        }
        if constexpr (ALIGN_EPI) { if (wr == 1) PG8_BAR; }
    }
    PG8_WAIT_V(0);
    if constexpr (!ALIGN_EPI) { if (wr == 0) PG8_BAR; }
    PG8_BAR;
#undef PG8_SA
#undef PG8_SB
#undef PG8_GL
#undef PG8_STAGE
#undef PG8_STA
#undef PG8_GVA
#undef PG8_LDA
#undef PG8_LDB
#undef PG8_MMA
#undef PG8_WAIT_V
#undef PG8_WAIT_L
#undef PG8_BAR
#undef PG8_SCHED
}
}
namespace epi {
__device__ __forceinline__ float clamp_f8(float v) { return __builtin_fminf(__builtin_fmaxf(v, -448.0f), 448.0f); }
__device__ __forceinline__ unsigned pack4_f8(float a, float b, float c, float d) { int w = __builtin_amdgcn_cvt_pk_fp8_f32(clamp_f8(a), clamp_f8(b), 0, false); return (unsigned)__builtin_amdgcn_cvt_pk_fp8_f32(clamp_f8(c), clamp_f8(d), w, true); }
using pg8::Unit;
template <int ACT> struct StoreBf16 {
    static constexpr bool PERM = true;
    bf16_t* O; int ldc;
    __device__ __forceinline__ int f8exp(const Unit&) const { return 8; }
    __device__ __forceinline__ void operator()(const f32x4 (&acc)[2][2][4][2], const Unit& u, int wr, int wc, int fr, int fq) const {
        const int row0 = u.pm * 256 + wr * 64 + fr, col0 = u.pn * 256 + wc * 32 + 8 * fq;
#pragma unroll
        for (int ai = 0; ai < 2; ++ai)
#pragma unroll
            for (int m = 0; m < 4; ++m) { bf16_t* rowp = O + (size_t)(row0 + ai * 128 + m * 16) * ldc + col0;
#pragma unroll
                for (int bj = 0; bj < 2; ++bj) { f32x4 v0 = acc[ai][bj][m][0], v1 = acc[ai][bj][m][1];
                    if (ACT == 1) {
#pragma unroll
                        for (int j = 0; j < 4; ++j) { v0[j] = sigmoidf_(v0[j] * DS2); v1[j] = sigmoidf_(v1[j] * DS2); } }
                    if (ACT == 1) { *(u32x2*)((unsigned char*)O + (size_t)(row0 + ai * 128 + m * 16) * ldc + col0 + bj * 128) = (u32x2){pack4_f8(v0[0] * F8_SGATE, v0[1] * F8_SGATE, v0[2] * F8_SGATE, v0[3] * F8_SGATE), pack4_f8(v1[0] * F8_SGATE, v1[1] * F8_SGATE, v1[2] * F8_SGATE, v1[3] * F8_SGATE)}; }
                    else { u32x4 w; w.x = cvtpk(v0[0], v0[1]); w.y = cvtpk(v0[2], v0[3]); w.z = cvtpk(v1[0], v1[1]); w.w = cvtpk(v1[2], v1[3]);
                    *(u32x4*)(rowp + bj * 128) = w; } } }
    }
};
template <int MODE> struct GateMul {
    static constexpr bool PERM = true;
    const bf16_t* gate; int goff; const bf16_t* prev; bf16_t* O;
    __device__ __forceinline__ void operator()(const f32x4 (&acc)[2][2][4][2], const Unit& u, int wr, int wc, int fr, int fq) const {
        const int row0 = u.pm * 256 + wr * 64 + fr, col0 = u.pn * 256 + wc * 32 + 8 * fq;
#pragma unroll
        for (int ai = 0; ai < 2; ++ai)
#pragma unroll
            for (int m = 0; m < 4; ++m) { const size_t row = (size_t)(row0 + ai * 128 + m * 16);
#pragma unroll
                for (int bj = 0; bj < 2; ++bj) { const int col = col0 + bj * 128;
                    const u32x2 g = *(const u32x2*)((const unsigned char*)gate + row * 4096 + goff + col);
                    f32x4 v0 = acc[ai][bj][m][0], v1 = acc[ai][bj][m][1];
                    { const f32x2 ga = __builtin_amdgcn_cvt_pk_f32_fp8((int)g.x, false), gb = __builtin_amdgcn_cvt_pk_f32_fp8((int)g.x, true), gc = __builtin_amdgcn_cvt_pk_f32_fp8((int)g.y, false), gd = __builtin_amdgcn_cvt_pk_f32_fp8((int)g.y, true);
                      v0[0] *= ga[0]; v0[1] *= ga[1]; v0[2] *= gb[0]; v0[3] *= gb[1]; v1[0] *= gc[0]; v1[1] *= gc[1]; v1[2] *= gd[0]; v1[3] *= gd[1]; }
                    if (MODE == 1) { const u32x2 p = *(const u32x2*)((const unsigned char*)prev + row * 2048 + col);
                        const f32x2 pa = __builtin_amdgcn_cvt_pk_f32_fp8((int)p.x, false), pb = __builtin_amdgcn_cvt_pk_f32_fp8((int)p.x, true), pc = __builtin_amdgcn_cvt_pk_f32_fp8((int)p.y, false), pd = __builtin_amdgcn_cvt_pk_f32_fp8((int)p.y, true);
                        constexpr float ip = 1.0f / F8_SG;
                        v0[0] = __builtin_fmaf(pa[0], ip, v0[0]); v0[1] = __builtin_fmaf(pa[1], ip, v0[1]); v0[2] = __builtin_fmaf(pb[0], ip, v0[2]); v0[3] = __builtin_fmaf(pb[1], ip, v0[3]);
                        v1[0] = __builtin_fmaf(pc[0], ip, v1[0]); v1[1] = __builtin_fmaf(pc[1], ip, v1[1]); v1[2] = __builtin_fmaf(pd[0], ip, v1[2]); v1[3] = __builtin_fmaf(pd[1], ip, v1[3]); }
                    if (O78F8) { *(u32x2*)((unsigned char*)O + row * 2048 + col) = (u32x2){pack4_f8(v0[0] * F8_SG, v0[1] * F8_SG, v0[2] * F8_SG, v0[3] * F8_SG), pack4_f8(v1[0] * F8_SG, v1[1] * F8_SG, v1[2] * F8_SG, v1[3] * F8_SG)}; }
                    else { u32x4 w; w.x = cvtpk(v0[0], v0[1]); w.y = cvtpk(v0[2], v0[3]); w.z = cvtpk(v1[0], v1[1]); w.w = cvtpk(v1[2], v1[3]);
                    *(u32x4*)(O + row * 2048 + col) = w; } } }
    }
};
struct Resid {
    static constexpr bool PERM = false;
    const float* base; float* out; const float* gate; int goff;
    __device__ __forceinline__ void operator()(const f32x4 (&acc)[2][2][4][2], const Unit& u, int wr, int wc, int fr, int fq) const {
        const int row0 = u.pm * 256 + wr * 64 + fr, col0 = u.pn * 256 + wc * 32 + 4 * fq;
        const int b = (u.pm * 256) / SEQ;
        f32x4 gv[2][2];
#pragma unroll
        for (int bj = 0; bj < 2; ++bj)
#pragma unroll
            for (int n = 0; n < 2; ++n) gv[bj][n] = *(const f32x4*)(gate + (size_t)b * 12288 + goff + col0 + bj * 128 + n * 16);
#pragma unroll
        for (int ai = 0; ai < 2; ++ai)
#pragma unroll
            for (int m = 0; m < 4; ++m) { const size_t off = (size_t)(row0 + ai * 128 + m * 16) * 2048 + col0;
#pragma unroll
                for (int bj = 0; bj < 2; ++bj)
#pragma unroll
                    for (int n = 0; n < 2; ++n) { const f32x4 bs = *(const f32x4*)(base + off + bj * 128 + n * 16);
                        *(f32x4*)(out + off + bj * 128 + n * 16) = bs + gv[bj][n] * acc[ai][bj][m][n]; } }
    }
};
struct SwiGLU {
    static constexpr bool PERM = true;
    bf16_t* O;
    __device__ __forceinline__ void operator()(const f32x4 (&acc)[2][2][4][2], const Unit& u, int wr, int wc, int fr, int fq) const {
        const int r0 = wr * 64 + fr, col0 = u.pn * 128 + wc * 32 + 8 * fq;
#pragma unroll
        for (int ai = 0; ai < 2; ++ai)
#pragma unroll
            for (int m = 0; m < 4; ++m) { const int r = r0 + ai * 128 + m * 16;
                f32x4 v0, v1;
#pragma unroll
                for (int j = 0; j < 4; ++j) { v0[j] = siluf_(acc[ai][0][m][0][j]) * acc[ai][1][m][0][j]; v1[j] = siluf_(acc[ai][0][m][1][j]) * acc[ai][1][m][1][j]; }
                u32x4 w; w.x = cvtpk(v0[0], v0[1]); w.y = cvtpk(v0[2], v0[3]); w.z = cvtpk(v1[0], v1[1]); w.w = cvtpk(v1[2], v1[3]);
                if (r < u.valid) *(u32x4*)(O + (size_t)(u.rowbase + r) * 512 + col0) = w; }
    }
};
struct SwiGLU8 {
    static constexpr bool PERM = true;
    unsigned char* O;
    __device__ __forceinline__ int f8exp(const Unit&) const { return 9; }
    __device__ __forceinline__ void operator()(const f32x4 (&acc)[2][2][4][2], const Unit& u, int wr, int wc, int fr, int fq) const {
        const int r0 = wr * 64 + fr, col0 = u.pn * 128 + wc * 32 + 8 * fq;
        constexpr float ds = 1.0f, us = F8_SA;
#pragma unroll
        for (int ai = 0; ai < 2; ++ai)
#pragma unroll
            for (int m = 0; m < 4; ++m) { const int r = r0 + ai * 128 + m * 16;
                f32x4 v0, v1;
#pragma unroll
                for (int j = 0; j < 4; ++j) { v0[j] = siluf_(acc[ai][0][m][0][j] * ds) * (acc[ai][1][m][0][j] * us); v1[j] = siluf_(acc[ai][0][m][1][j] * ds) * (acc[ai][1][m][1][j] * us); }
                if (r < u.valid) *(u32x2*)(O + (size_t)(u.rowbase + r) * 512 + col0) = (u32x2){pack4_f8(v0[0], v0[1], v0[2], v0[3]), pack4_f8(v1[0], v1[1], v1[2], v1[3])}; }
    }
};
struct DownY {
    static constexpr int PERM = 2;
    unsigned char* O;
    __device__ __forceinline__ int f8exp(const Unit&) const { return 8; }
    __device__ __forceinline__ void operator()(const f32x4 (&acc)[2][2][4][2], const Unit& u, int wr, int wc, int fr, int fq) const {
        const int r0 = wr * 64 + fr, col0 = u.pn * 256 + wc * 64 + 16 * fq;
#pragma unroll
        for (int ai = 0; ai < 2; ++ai)
#pragma unroll
            for (int m = 0; m < 4; ++m) { const int r = r0 + ai * 128 + m * 16;
                if (r < u.valid) {
                    const f32x4 v0 = acc[ai][0][m][0], v1 = acc[ai][0][m][1], v2 = acc[ai][1][m][0], v3 = acc[ai][1][m][1];
                    int w0 = __builtin_amdgcn_cvt_pk_fp8_f32(v0[0], v0[1], 0, false); w0 = __builtin_amdgcn_cvt_pk_fp8_f32(v0[2], v0[3], w0, true);
                    int w1 = __builtin_amdgcn_cvt_pk_fp8_f32(v1[0], v1[1], 0, false); w1 = __builtin_amdgcn_cvt_pk_fp8_f32(v1[2], v1[3], w1, true);
                    int w2 = __builtin_amdgcn_cvt_pk_fp8_f32(v2[0], v2[1], 0, false); w2 = __builtin_amdgcn_cvt_pk_fp8_f32(v2[2], v2[3], w2, true);
                    int w3 = __builtin_amdgcn_cvt_pk_fp8_f32(v3[0], v3[1], 0, false); w3 = __builtin_amdgcn_cvt_pk_fp8_f32(v3[2], v3[3], w3, true);
                    *(u32x4*)(O + (size_t)(u.rowbase + r) * 2048 + col0) = (u32x4){(unsigned)w0, (unsigned)w1, (unsigned)w2, (unsigned)w3}; } }
    }
};
struct DownShared8 {
    static constexpr int PERM = 2;
    unsigned char* O;
    __device__ __forceinline__ int f8exp(const Unit&) const { return 8; }
    __device__ __forceinline__ void operator()(const f32x4 (&acc)[2][2][4][2], const Unit& u, int wr, int wc, int fr, int fq) const {
        const int r0 = u.pm * 256 + wr * 64 + fr, col0 = u.pn * 256 + wc * 64 + 16 * fq;
#pragma unroll
        for (int ai = 0; ai < 2; ++ai)
#pragma unroll
            for (int m = 0; m < 4; ++m) { const int r = r0 + ai * 128 + m * 16;
                const f32x4 v0 = acc[ai][0][m][0], v1 = acc[ai][0][m][1], v2 = acc[ai][1][m][0], v3 = acc[ai][1][m][1];
                *(u32x4*)(O + (size_t)r * 2048 + col0) = (u32x4){pack4_f8(v0[0], v0[1], v0[2], v0[3]), pack4_f8(v1[0], v1[1], v1[2], v1[3]), pack4_f8(v2[0], v2[1], v2[2], v2[3]), pack4_f8(v3[0], v3[1], v3[2], v3[3])}; }
    }
};
struct StoreQK {
    static constexpr bool PERM = true;
    bf16_t* Q; bf16_t* KT; float qscale;
    __device__ __forceinline__ void operator()(const f32x4 (&acc)[2][2][4][2], const Unit& u, int wr, int wc, int fr, int fq) const {
        const int row0 = u.pm * 256 + wr * 64 + fr, col0 = u.pn * 256 + wc * 32 + 8 * fq;
        const bool isk = (u.pn >= 4);
#pragma unroll
        for (int ai = 0; ai < 2; ++ai)
#pragma unroll
            for (int m = 0; m < 4; ++m) { const int row = row0 + ai * 128 + m * 16;
#pragma unroll
                for (int bj = 0; bj < 2; ++bj) { const float sc = (isk ? 1.0f : qscale) * DS2; const f32x4 v0 = acc[ai][bj][m][0] * sc, v1 = acc[ai][bj][m][1] * sc; const int col = col0 + bj * 128;
                    u32x4 w; w.x = cvtpk(v0[0], v0[1]); w.y = cvtpk(v0[2], v0[3]); w.z = cvtpk(v1[0], v1[1]); w.w = cvtpk(v1[2], v1[3]);
                    bf16_t* p = isk ? KT + ((((size_t)((col - 1024) >> 7) * 256 + (row >> 6)) * 64 + (row & 63)) * 128 + (col & 127)) : Q + (size_t)row * 1024 + col;
                    *(u32x4*)p = w; } }
    }
};
struct StoreQK8 {
    static constexpr bool PERM = true;
    unsigned char* Q; unsigned char* KT; float qs, ks;
    __device__ __forceinline__ void operator()(const f32x4 (&acc)[2][2][4][2], const Unit& u, int wr, int wc, int fr, int fq) const {
        const int row0 = u.pm * 256 + wr * 64 + fr, col0 = u.pn * 256 + wc * 32 + 8 * fq;
        const bool isk = (u.pn >= 4);
#pragma unroll
        for (int ai = 0; ai < 2; ++ai)
#pragma unroll
            for (int m = 0; m < 4; ++m) { const int row = row0 + ai * 128 + m * 16;
#pragma unroll
                for (int bj = 0; bj < 2; ++bj) { const float sc = isk ? 1.0f : qs;        const f32x4 v0 = acc[ai][bj][m][0] * sc, v1 = acc[ai][bj][m][1] * sc; const int col = col0 + bj * 128;
                    unsigned char* p = isk ? KT + ((((size_t)((col - 1024) >> 7) * 256 + (row >> 6)) * 64 + (row & 63)) * 128 + (col & 127)) : Q + (size_t)row * 1024 + col;
                    *(u32x2*)p = (u32x2){pack4_f8(v0[0], v0[1], v0[2], v0[3]), pack4_f8(v1[0], v1[1], v1[2], v1[3])}; }
                __builtin_amdgcn_sched_barrier(0); }
    }
};
struct StoreQKboth {
    static constexpr bool PERM = true;
    StoreQK b16; unsigned char* Q8; unsigned char* KT8;
    __device__ __forceinline__ void operator()(const f32x4 (&acc)[2][2][4][2], const Unit& u, int wr, int wc, int fr, int fq) const {
        b16(acc, u, wr, wc, fr, fq);
        const int row0 = u.pm * 256 + wr * 64 + fr, col0 = u.pn * 256 + wc * 32 + 8 * fq;
        const bool isk = (u.pn >= 4);
        const float sc = isk ? att::D8_KS : att::MB8_QS;
#pragma unroll
        for (int ai = 0; ai < 2; ++ai)
#pragma unroll
            for (int m = 0; m < 4; ++m) { const int row = row0 + ai * 128 + m * 16;
#pragma unroll
                for (int bj = 0; bj < 2; ++bj) { const f32x4 v0 = acc[ai][bj][m][0] * sc, v1 = acc[ai][bj][m][1] * sc; const int col = col0 + bj * 128;
                    unsigned char* p = isk ? KT8 + ((((size_t)((col - 1024) >> 7) * 256 + (row >> 6)) * 64 + (row & 63)) * 128 + (col & 127)) : Q8 + (size_t)row * 1024 + col;
                    *(u32x2*)p = (u32x2){pack4_f8(v0[0], v0[1], v0[2], v0[3]), pack4_f8(v1[0], v1[1], v1[2], v1[3])}; }
                __builtin_amdgcn_sched_barrier(0); }
    }
};
struct StoreVT8 {
    static constexpr bool PERM = true;
    unsigned char* VT; float vs;
    __device__ __forceinline__ void operator()(const f32x4 (&acc)[2][2][4][2], const Unit& u, int wr, int wc, int fr, int fq) const {
        const int row0 = u.pm * 256 + wr * 64 + fr, col0 = u.pn * 256 + wc * 32 + 8 * fq;
#pragma unroll
        for (int ai = 0; ai < 2; ++ai)
#pragma unroll
            for (int m = 0; m < 4; ++m) { const int f = row0 + ai * 128 + m * 16;
#pragma unroll
                for (int bj = 0; bj < 2; ++bj) { const f32x4 v0 = acc[ai][bj][m][0], v1 = acc[ai][bj][m][1]; const int tok = col0 + bj * 128, k = tok & 63;
                    unsigned char* p = VT + ((((size_t)(f >> 7) * 256 + (tok >> 6)) * 128 + (f & 127)) * 64 + (k >> 5) * 16 + ((k & 31) >> 3) * 4);
                    *(unsigned*)p = pack4_f8(v0[0], v0[1], v0[2], v0[3]); *(unsigned*)(p + 32) = pack4_f8(v1[0], v1[1], v1[2], v1[3]); }
                __builtin_amdgcn_sched_barrier(0); }
    }
};
struct StoreVT {
    static constexpr bool PERM = true;
    bf16_t* VT;
    __device__ __forceinline__ void operator()(const f32x4 (&acc)[2][2][4][2], const Unit& u, int wr, int wc, int fr, int fq) const {
        const int row0 = u.pm * 256 + wr * 64 + fr, col0 = u.pn * 256 + wc * 32 + 8 * fq;
#pragma unroll
        for (int ai = 0; ai < 2; ++ai)
#pragma unroll
            for (int m = 0; m < 4; ++m) { const int f = row0 + ai * 128 + m * 16;
#pragma unroll
                for (int bj = 0; bj < 2; ++bj) { const f32x4 v0 = acc[ai][bj][m][0] * DS2, v1 = acc[ai][bj][m][1] * DS2; const int tok = col0 + bj * 128;
                    u32x4 w; w.x = cvtpk(v0[0], v0[1]); w.y = cvtpk(v0[2], v0[3]); w.z = cvtpk(v1[0], v1[1]); w.w = cvtpk(v1[2], v1[3]);
                    *(u32x4*)(VT + ((((size_t)(f >> 7) * 256 + (tok >> 6)) * 128 + (f & 127)) * 64 + (tok & 63))) = w; } }
    }
};
struct ProjEpi {
    static constexpr bool PERM = true, HAS_MID = false;
    StoreQK8 qkd; StoreQKboth qkm; StoreBf16<1> gates;
    __device__ __forceinline__ int f8exp(const Unit& u) const { return (u.pn >= 4 && u.pn < 8) ? P2_EXP - 2 : P2_EXP; }
    __device__ __forceinline__ void operator()(const f32x4 (&acc)[2][2][4][2], const Unit& u, int wr, int wc, int fr, int fq) const {
        Unit v = u;
        if (u.pn < 8) qkd(acc, v, wr, wc, fr, fq);
        else if (u.pn < 16) { v.pn = u.pn - 8; qkm(acc, v, wr, wc, fr, fq); }
        else { v.pn = u.pn - 16; gates(acc, v, wr, wc, fr, fq); }
    }
};
struct ProjVT {
    static constexpr bool PERM = true, HAS_MID = false;
    StoreVT8 vd; StoreVT8 vm;
    __device__ __forceinline__ int f8exp(const Unit& u) const { return P2_EXP - 3; }
    __device__ __forceinline__ void operator()(const f32x4 (&acc)[2][2][4][2], const Unit& u, int wr, int wc, int fr, int fq) const {
        Unit v = u;
        if (u.pm < 4) vd(acc, v, wr, wc, fr, fq); else { v.pm = u.pm - 4; vm(acc, v, wr, wc, fr, fq); }
    }
};
struct GatePair {
    static constexpr bool PERM = true, HAS_MID = false;
    GateMul<0> e0; GateMul<1> e1;
    __device__ __forceinline__ int f8exp(const Unit& u) const { return u.aux == 0 ? 9 + 8 : 11 + 8; }
    __device__ __forceinline__ void operator()(const f32x4 (&acc)[2][2][4][2], const Unit& u, int wr, int wc, int fr, int fq) const {
        if (u.aux == 0) e0(acc, u, wr, wc, fr, fq); else e1(acc, u, wr, wc, fr, fq);
    }
};
struct ResidBf16 {
    static constexpr bool PERM = true, HAS_MID = false;
    const float* base; bf16_t* out; const float* gate; int goff;
    __device__ __forceinline__ int f8exp(const Unit&) const { return 10; }
    __device__ __forceinline__ void operator()(const f32x4 (&acc)[2][2][4][2], const Unit& u, int wr, int wc, int fr, int fq) const {
        const int row0 = u.pm * 256 + wr * 64 + fr, col0 = u.pn * 256 + wc * 32 + 8 * fq;
        const int b = (u.pm * 256) / SEQ;
        f32x4 gv[2][2];
#pragma unroll
        for (int bj = 0; bj < 2; ++bj)
#pragma unroll
            for (int n = 0; n < 2; ++n) gv[bj][n] = *(const f32x4*)(gate + (size_t)b * 12288 + goff + col0 + bj * 128 + n * 4);
#pragma unroll
        for (int ai = 0; ai < 2; ++ai)
#pragma unroll
            for (int m = 0; m < 4; ++m) { const size_t off = (size_t)(row0 + ai * 128 + m * 16) * 2048 + col0;
#pragma unroll
                for (int bj = 0; bj < 2; ++bj) {
                    const f32x4 b0 = *(const f32x4*)(base + off + bj * 128), b1 = *(const f32x4*)(base + off + bj * 128 + 4);
                    const f32x4 v0 = b0 + gv[bj][0] * acc[ai][bj][m][0], v1 = b1 + gv[bj][1] * acc[ai][bj][m][1];
                    u32x4 w; w.x = cvtpk(v0[0], v0[1]); w.y = cvtpk(v0[2], v0[3]); w.z = cvtpk(v1[0], v1[1]); w.w = cvtpk(v1[2], v1[3]);
                    *(u32x4*)(out + off + bj * 128) = w; } }
    }
};
}
namespace att {
constexpr int KROW = 272;
constexpr int VROW = 144;
constexpr int KBUF = 64 * KROW;
constexpr int VBUF = 128 * VROW;
constexpr int OFF_K = 0, OFF_V = 2 * KBUF, OFF_TAB = OFF_V + 2 * VBUF, OFF_G = OFF_TAB + 512, OFF_END = OFF_G + 512;
static_assert(OFF_END <= RING_BYTES, "attention LDS");
__device__ __forceinline__ int crow(int i, int hh) { return (i & 3) + 8 * (i >> 2) + 4 * hh; }

__device__ __forceinline__ int t5_bucket(int n) {
    if (n < 16) return n;
    int b = 16;
    b += (n >= 19); b += (n >= 21); b += (n >= 24); b += (n >= 27); b += (n >= 31); b += (n >= 35); b += (n >= 40); b += (n >= 46);
    b += (n >= 52); b += (n >= 59); b += (n >= 67); b += (n >= 77); b += (n >= 87); b += (n >= 99); b += (n >= 113);
    return b;
}
__device__ __forceinline__ void fill_bias_tab(LAS float* tab, const float* rel_bias, int col) {
    if (threadIdx.x < 128) { const int n = threadIdx.x; tab[n] = (rel_bias[t5_bucket(n) * 16 + col] - rel_bias[31 * 16 + col]) * LOG2E; }
}

struct TileRegs { u32x4 k[2]; u32x4 v[2]; };
__device__ __forceinline__ void tile_load(TileRegs& R, const bf16_t* kt, const bf16_t* vt, int tid) {
#pragma unroll
    for (int i = 0; i < 2; ++i) { const int c = tid + 512 * i; R.k[i] = *(const u32x4*)(kt + c * 8); }
#pragma unroll
    for (int i = 0; i < 2; ++i) { const int c = tid + 512 * i; R.v[i] = *(const u32x4*)(vt + c * 8); }
}
__device__ __forceinline__ void tile_store(const TileRegs& R, LAS unsigned char* kb, LAS unsigned char* vb, int tid) {
#pragma unroll
    for (int i = 0; i < 2; ++i) { const int c = tid + 512 * i; *(LAS u32x4*)(kb + (c >> 4) * KROW + (c & 15) * 16) = R.k[i]; }
#pragma unroll
    for (int i = 0; i < 2; ++i) { const int c = tid + 512 * i;
        LAS unsigned char* p = vb + (c >> 3) * VROW + ((c & 7) >> 1) * 32 + (c & 1) * 8;
        *(LAS u32x2*)p = (u32x2){R.v[i].x, R.v[i].y}; *(LAS u32x2*)(p + 16) = (u32x2){R.v[i].z, R.v[i].w}; }
}

template <int NMAP, int KS>
__device__ __forceinline__ void attn_half(const LAS unsigned char* kb, const LAS unsigned char* vb, int kh, const bf16x8 (&qf)[NMAP][KS], f32x16 (&O)[NMAP][4],
                                          float (&mrun)[NMAP], float (&lrun)[NMAP], int qpos, int kvpos0, bool need_mask, bool need_bias, const LAS float* btab, float sc, int r, int hh, int kcolbase) {
    bf16x8 P[NMAP][2];
#pragma unroll
    for (int m = 0; m < NMAP; ++m) {
        f32x16 s;
#pragma unroll
        for (int i = 0; i < 16; ++i) s[i] = 0.f;
#pragma unroll
        for (int ks = 0; ks < KS; ++ks) {
            const bf16x8 kf = *(const LAS bf16x8*)(kb + (32 * kh + r) * KROW + (kcolbase + m * 16 * KS + 16 * ks + 8 * hh) * 2);
            s = __builtin_amdgcn_mfma_f32_32x32x16_bf16(kf, qf[m][ks], s, 0, 0, 0);
        }
#pragma unroll
        for (int i = 0; i < 16; ++i) s[i] *= sc;
        if (need_bias) {
#pragma unroll
            for (int i = 0; i < 16; ++i) { int rel = qpos - (kvpos0 + crow(i, hh)); rel = rel < 0 ? 0 : (rel > 127 ? 127 : rel); s[i] += btab[rel]; }
        }
        if (need_mask) {
#pragma unroll
            for (int i = 0; i < 16; ++i) { if (kvpos0 + crow(i, hh) > qpos) s[i] = -INFINITY; }
        }
        float mx = s[0];
#pragma unroll
        for (int i = 1; i < 16; ++i) mx = fmaxf(mx, s[i]);
        mx = fmaxf(mx, __shfl_xor(mx, 32));
        const float mnew = fmaxf(mrun[m], mx);
        const float alpha = fast_exp2(mrun[m] - mnew);
        float sum = 0.f;
#pragma unroll
        for (int i = 0; i < 16; ++i) { const float p = fast_exp2(s[i] - mnew); sum += p; s[i] = p; }
        lrun[m] = lrun[m] * alpha + sum; mrun[m] = mnew;
#pragma unroll
        for (int dt = 0; dt < 4; ++dt)
#pragma unroll
            for (int i = 0; i < 16; ++i) O[m][dt][i] *= alpha;
#pragma unroll
        for (int st = 0; st < 2; ++st) { u32x4 w; w.x = cvtpk(s[8 * st + 0], s[8 * st + 1]); w.y = cvtpk(s[8 * st + 2], s[8 * st + 3]); w.z = cvtpk(s[8 * st + 4], s[8 * st + 5]); w.w = cvtpk(s[8 * st + 6], s[8 * st + 7]);
            P[m][st] = __builtin_bit_cast(bf16x8, w); }
    }
#pragma unroll
    for (int dt = 0; dt < 4; ++dt)
#pragma unroll
        for (int st = 0; st < 2; ++st) {
            const bf16x8 vf = *(const LAS bf16x8*)(vb + (32 * dt + r) * VROW + (2 * kh + st) * 32 + hh * 16);
#pragma unroll
            for (int m = 0; m < NMAP; ++m) O[m][dt] = __builtin_amdgcn_mfma_f32_32x32x16_bf16(vf, P[m][st], O[m][dt], 0, 0, 0);
        }
}

#define SBAR() __builtin_amdgcn_sched_barrier(0)
constexpr int TBUF = KBUF + VBUF;
constexpr int D_OFF_TAB = 3 * TBUF, D_OFF_G = D_OFF_TAB + 512;
static_assert(D_OFF_G + 512 <= RING_BYTES, "diff attention LDS");
constexpr float D_C = 0.125f * LOG2E;
__device__ __forceinline__ void d_load_kf(bf16x8 (&kf)[4], const LAS unsigned char* kb, int kh, int r, int hh, int kcol) {
#pragma unroll
    for (int ks = 0; ks < 4; ++ks) kf[ks] = *(const LAS bf16x8*)(kb + (32 * kh + r) * KROW + (kcol + 16 * ks + 8 * hh) * 2);
}
constexpr float D_THR = 8.0f;
__device__ __forceinline__ float max3_(float a, float b, float c) { float r; asm("v_max3_f32 %0, %1, %2, %3" : "=v"(r) : "v"(a), "v"(b), "v"(c)); return r; }
template <int MODE, bool LOADV, bool PREFK>
__device__ __forceinline__ void d_half_a(const bf16x8 (&kf)[4], bf16x8 (&kfn)[4], const LAS unsigned char* knext, int khn, const LAS unsigned char* vb, int kh,
                                         const bf16x8 (&qf)[4], f32x16 (&o)[4], float& mref, float& lrun, int qpos, int kvpos0, bool need_mask, bool need_bias, bool first,
                                         const LAS float* btab, int r, int hh, int kcol, bf16x8 (&vf)[4], bf16x8 (&P)[2]) {
    if (LOADV) {
#pragma unroll
        for (int dt = 0; dt < 2; ++dt)
#pragma unroll
            for (int st = 0; st < 2; ++st) vf[2 * dt + st] = *(const LAS bf16x8*)(vb + (32 * dt + r) * VROW + (2 * kh + st) * 32 + hh * 16);
    }
    SBAR();
    f32x16 s;
#pragma unroll
    for (int i = 0; i < 16; ++i) s[i] = 0.f;
    __builtin_amdgcn_s_setprio(1);
#pragma unroll
    for (int ks = 0; ks < 4; ++ks) { if (MODE != 3) s = __builtin_amdgcn_mfma_f32_32x32x16_bf16(kf[ks], qf[ks], s, 0, 0, 0); else { s[ks] += __builtin_bit_cast(float, (int)kf[ks][0]); s[4 + ks] += __builtin_bit_cast(float, (int)qf[ks][1]); } }
    __builtin_amdgcn_s_setprio(0);
    if (PREFK) d_load_kf(kfn, knext, khn, r, hh, kcol);
    SBAR();
    if (MODE == 4) { P[0] = qf[0]; P[1] = qf[1]; mref = fmaxf(mref, s[0]); } else {
    if (need_bias) {
#pragma unroll
        for (int i = 0; i < 16; ++i) { int rel = qpos - (kvpos0 + crow(i, hh)); rel = rel < 0 ? 0 : (rel > 127 ? 127 : rel); s[i] += btab[rel]; }
    }
    if (need_mask) {
#pragma unroll
        for (int i = 0; i < 16; ++i) { if (kvpos0 + crow(i, hh) > qpos) s[i] = -INFINITY; }
    }
    float mx = max3_(s[0], s[1], s[2]);
    mx = max3_(mx, s[3], s[4]); mx = max3_(mx, s[5], s[6]); mx = max3_(mx, s[7], s[8]); mx = max3_(mx, s[9], s[10]); mx = max3_(mx, s[11], s[12]); mx = max3_(mx, s[13], s[14]);
    { auto rr = __builtin_amdgcn_permlane32_swap(__float_as_uint(mx), __float_as_uint(mx), false, false); mx = max3_(s[15], __uint_as_float(rr[0]), __uint_as_float(rr[1])); }
    if (first || __any(mx - mref > D_THR)) {
        const float mn = first ? mx : fmaxf(mref, mx);
        const float alpha = first ? 0.f : fast_exp2(mref - mn);
        mref = mn; lrun *= alpha;
#pragma unroll
        for (int dt = 0; dt < 4; ++dt)
#pragma unroll
            for (int i = 0; i < 16; ++i) o[dt][i] *= alpha;
    }
    float sum = 0.f;
#pragma unroll
    for (int i = 0; i < 16; ++i) { const float p = fast_exp2(s[i] - mref); sum += p; s[i] = p; }
    lrun += sum;
#pragma unroll
    for (int st = 0; st < 2; ++st) { u32x4 w; w.x = cvtpk(s[8 * st + 0], s[8 * st + 1]); w.y = cvtpk(s[8 * st + 2], s[8 * st + 3]); w.z = cvtpk(s[8 * st + 4], s[8 * st + 5]); w.w = cvtpk(s[8 * st + 6], s[8 * st + 7]);
        P[st] = __builtin_bit_cast(bf16x8, w); }
    }
}
template <int MODE, bool LOADV>
__device__ __forceinline__ void d_half_b(f32x16 (&o)[4], bf16x8 (&vf)[4], const bf16x8 (&P)[2], const LAS unsigned char* vb, int kh, int r, int hh) {
    if (LOADV) {
#pragma unroll
        for (int dt = 0; dt < 2; ++dt)
#pragma unroll
            for (int st = 0; st < 2; ++st) vf[2 * dt + st] = *(const LAS bf16x8*)(vb + (32 * dt + r) * VROW + (2 * kh + st) * 32 + hh * 16);
    }
    bf16x8 vg[4];
#pragma unroll
    for (int dt = 2; dt < 4; ++dt)
#pragma unroll
        for (int st = 0; st < 2; ++st) vg[2 * (dt - 2) + st] = *(const LAS bf16x8*)(vb + (32 * dt + r) * VROW + (2 * kh + st) * 32 + hh * 16);
    asm volatile("s_waitcnt lgkmcnt(4)" ::: "memory"); SBAR();
    __builtin_amdgcn_s_setprio(1);
#pragma unroll
    for (int dt = 0; dt < 2; ++dt)
#pragma unroll
        for (int st = 0; st < 2; ++st) {
            if (MODE != 3) o[dt] = __builtin_amdgcn_mfma_f32_32x32x16_bf16(vf[2 * dt + st], P[st], o[dt], 0, 0, 0);
            else o[dt][st] += __builtin_bit_cast(float, (int)vf[2 * dt + st][0]) * __builtin_bit_cast(float, (int)P[st][0]);
        }
    asm volatile("s_waitcnt lgkmcnt(0)" ::: "memory"); SBAR();
#pragma unroll
    for (int dt = 2; dt < 4; ++dt)
#pragma unroll
        for (int st = 0; st < 2; ++st) {
            if (MODE != 3) o[dt] = __builtin_amdgcn_mfma_f32_32x32x16_bf16(vg[2 * (dt - 2) + st], P[st], o[dt], 0, 0, 0);
            else o[dt][st] += __builtin_bit_cast(float, (int)vg[2 * (dt - 2) + st][0]) * __builtin_bit_cast(float, (int)P[st][0]);
        }
    __builtin_amdgcn_s_setprio(0);
}
template <int MODE>
__device__ __forceinline__ void diff_unit(LAS unsigned char* lds, int b, int h, int qt, const bf16_t* QD, const bf16_t* KDT, const bf16_t* VDT, bf16_t* AD, const float* subln, const float* rel_bias) {
    int tid_ = threadIdx.x; asm volatile("" : "+v"(tid_));
    const int tid = tid_, lane = tid & 63, r = lane & 31, hh = lane >> 5; const int wid = __builtin_amdgcn_readfirstlane(tid >> 6);
    const int map = wid >> 2, qsub = wid & 3;
    const int q0 = qt * 128, qw0 = q0 + 32 * qsub, qpos = qw0 + r;
    const size_t tok0 = (size_t)b * SEQ;
    const LAS float* btab = (const LAS float*)(lds + D_OFF_TAB);
    const LAS float* gtab = (const LAS float*)(lds + D_OFF_G);
    const int kcol = map * 64;
    bf16x8 qf[4];
#pragma unroll
    for (int ks = 0; ks < 4; ++ks) qf[ks] = *(const bf16x8*)(QD + (tok0 + qpos) * 1024 + h * 128 + map * 64 + 16 * ks + 8 * hh);
    f32x16 o[4];
#pragma unroll
    for (int dt = 0; dt < 4; ++dt)
#pragma unroll
        for (int i = 0; i < 16; ++i) o[dt][i] = 0.f;
    float mrun = 0.f, lrun = 0.f;
    const bf16_t* kbase = KDT + ((size_t)h * 256 + b * 128) * 8192;
    const bf16_t* vbase = VDT + ((size_t)h * 256 + b * 128) * 8192;
    const int NT = 2 * (qt + 1);
    TileRegs R;
    bf16x8 kfa[4], kfb[4];
    __syncthreads();
    fill_bias_tab((LAS float*)(lds + D_OFF_TAB), rel_bias, h);
    if (tid < 128) ((LAS float*)(lds + D_OFF_G))[tid] = subln[tid];
    tile_load(R, kbase, vbase, tid);
    tile_store(R, lds, lds + KBUF, tid);
    tile_load(R, kbase + 8192, vbase + 8192, tid);
    __syncthreads();
    if (MODE != 2) d_load_kf(kfa, lds, 0, r, hh, kcol);
    int bc = 0;
    bf16x8 vf[4], P[2];
#define D_STAGE() do { if (t + 1 < NT) tile_store(R, lds + bn * TBUF, lds + bn * TBUF + KBUF, tid); \
        if (t + 2 < NT) tile_load(R, kbase + (size_t)(MODE == 1 ? 0 : t + 2) * 8192, vbase + (size_t)(MODE == 1 ? 0 : t + 2) * 8192, tid); \
        __syncthreads(); } while (0)
    if (wid < 4) {
#pragma unroll 1
        for (int t = 0; t < NT; ++t) {
            const int bn = (bc == 2) ? 0 : bc + 1;
            const LAS unsigned char* kb = lds + bc * TBUF; const LAS unsigned char* vb = kb + KBUF;
            const int k0 = 64 * t;
            { const bool nm = (k0 + 31 > qw0), nb = (qw0 - (k0 + 31) < 113);
              if (MODE != 2) { d_half_a<MODE, true, true>(kfa, kfb, kb, 1, vb, 0, qf, o, mrun, lrun, qpos, k0, nm, nb, t == 0, btab, r, hh, kcol, vf, P); d_half_b<MODE, false>(o, vf, P, vb, 0, r, hh); } }
            D_STAGE();
            { const bool nm = (k0 + 63 > qw0), nb = (qw0 - (k0 + 63) < 113);
              if (MODE != 2) { d_half_a<MODE, true, true>(kfb, kfa, lds + bn * TBUF, 0, vb, 1, qf, o, mrun, lrun, qpos, k0 + 32, nm, nb, false, btab, r, hh, kcol, vf, P); d_half_b<MODE, false>(o, vf, P, vb, 1, r, hh); } }
            bc = bn;
        }
    } else {
#pragma unroll 1
        for (int t = 0; t < NT; ++t) {
            const int bn = (bc == 2) ? 0 : bc + 1;
            const LAS unsigned char* kb = lds + bc * TBUF; const LAS unsigned char* vb = kb + KBUF;
            const int k0 = 64 * t;
            { const bool nm = (k0 + 31 > qw0), nb = (qw0 - (k0 + 31) < 113);
              if (MODE != 2) d_half_a<MODE, false, false>(kfa, kfb, kb, 1, vb, 0, qf, o, mrun, lrun, qpos, k0, nm, nb, t == 0, btab, r, hh, kcol, vf, P); }
            D_STAGE();
            if (MODE != 2) { d_half_b<MODE, true>(o, vf, P, vb, 0, r, hh); d_load_kf(kfb, kb, 1, r, hh, kcol); }
            { const bool nm = (k0 + 63 > qw0), nb = (qw0 - (k0 + 63) < 113);
              if (MODE != 2) { d_half_a<MODE, true, true>(kfb, kfa, lds + bn * TBUF, 0, vb, 1, qf, o, mrun, lrun, qpos, k0 + 32, nm, nb, false, btab, r, hh, kcol, vf, P); d_half_b<MODE, false>(o, vf, P, vb, 1, r, hh); } }
            bc = bn;
        }
    }
#undef D_STAGE
    __syncthreads();
    const float l = lrun + __shfl_xor(lrun, 32);
    LAS float* xch = (LAS float*)lds + qsub * 4096 + lane;
    if (map == 1) {
        const float lam = *(const LAS float*)(lds + MISC_OFF + 68);
        const float f = lam / l;
#pragma unroll
        for (int dt = 0; dt < 4; ++dt)
#pragma unroll
            for (int i = 0; i < 16; ++i) xch[(dt * 16 + i) * 64] = o[dt][i] * f;
    }
    __syncthreads();
    if (map == 0) {
        const float i0 = 1.0f / l;
        float ss = 0.f;
#pragma unroll
        for (int dt = 0; dt < 4; ++dt)
#pragma unroll
            for (int i = 0; i < 16; ++i) { const float v = o[dt][i] * i0 - xch[(dt * 16 + i) * 64]; o[dt][i] = v; ss += v * v; }
        ss += __shfl_xor(ss, 32);
        const float rs = 0.8f / sqrtf(ss * (1.0f / 128.0f) + RMS_EPS);
        bf16_t* orow = AD + (tok0 + qpos) * 1024 + h * 128;
#pragma unroll
        for (int dt = 0; dt < 4; ++dt)
#pragma unroll
            for (int g = 0; g < 4; ++g) { const int d = 32 * dt + 8 * g + 4 * hh;
                const f32x4 gg = *(const LAS f32x4*)(gtab + d);
                u32x2 w; w.x = cvtpk(o[dt][4 * g + 0] * rs * gg[0], o[dt][4 * g + 1] * rs * gg[1]); w.y = cvtpk(o[dt][4 * g + 2] * rs * gg[2], o[dt][4 * g + 3] * rs * gg[3]);
                *(u32x2*)(orow + d) = w; }
    }
}

constexpr int KROW8 = 144, VROW8 = 80, KBUF8 = 64 * KROW8, VBUF8 = 128 * VROW8, TBUF8 = KBUF8 + VBUF8;
static_assert(4 * TBUF8 <= D_OFF_TAB, "fp8 diff attention LDS");
constexpr float D8_C = 1.0f / 64.0f, D8_THR = 3.0f * 64.0f, D8_SH = 5.0f;
struct TileRegs8 { u32x4 k, v; };
__device__ __forceinline__ void tile_load8(TileRegs8& R, const unsigned char* kt, const unsigned char* vt, int tid) { R.k = *(const u32x4*)(kt + tid * 16); R.v = *(const u32x4*)(vt + tid * 16); }
__device__ __forceinline__ void tile_store8(const TileRegs8& R, LAS unsigned char* kb, LAS unsigned char* vb, int tid) {
    *(LAS u32x4*)(kb + (tid >> 3) * KROW8 + (tid & 7) * 16) = R.k; *(LAS u32x4*)(vb + (tid >> 2) * VROW8 + (tid & 3) * 16) = R.v; }
__device__ __forceinline__ i32x8 cat8(const i32x4 a, const i32x4 b) { return __builtin_shufflevector(a, b, 0, 1, 2, 3, 4, 5, 6, 7); }
__device__ __forceinline__ void d8_load_kf(i32x8 (&kf)[2], const LAS unsigned char* kb, int r, int hh, int kcolb) {
#pragma unroll
    for (int kh = 0; kh < 2; ++kh) { const LAS unsigned char* q = kb + (32 * kh + r) * KROW8 + kcolb + 32 * hh; kf[kh] = cat8(*(const LAS i32x4*)q, *(const LAS i32x4*)(q + 16)); }
}
template <int DT0>
__device__ __forceinline__ void d8_load_vf2(i32x8 (&vf)[2], const LAS unsigned char* vb, int r, int hh) {
#pragma unroll
    for (int dt = 0; dt < 2; ++dt) { const LAS unsigned char* q = vb + (32 * (DT0 + dt) + r) * VROW8 + 32 * hh; vf[dt] = cat8(*(const LAS i32x4*)q, *(const LAS i32x4*)(q + 16)); }
}
__device__ __forceinline__ void d8_scores(f32x16& s0, f32x16& s1, const i32x8 (&kf)[2], const i32x8& qf) {
    f32x16 z;
#pragma unroll
    for (int i = 0; i < 16; ++i) z[i] = 0.f;
    __builtin_amdgcn_s_setprio(1);
    s0 = __builtin_amdgcn_mfma_scale_f32_32x32x64_f8f6f4(kf[0], qf, z, 0, 0, 0, 0x7F7F7F7F, 0, 0x7F7F7F7F);
    s1 = __builtin_amdgcn_mfma_scale_f32_32x32x64_f8f6f4(kf[1], qf, z, 0, 0, 0, 0x7F7F7F7F, 0, 0x7F7F7F7F);
    __builtin_amdgcn_s_setprio(0);
}
template <bool ROW = false>
__device__ __forceinline__ i32x8 d8_softmax(f32x16& s0, f32x16& s1, f32x16 (&o)[4], float& mref, float& lrun, int qpos, int k0, bool need_mask, bool need_bias, bool first, const LAS float* btab, int hh) {
    if (need_bias) {
#pragma unroll
        for (int i = 0; i < 16; ++i) { int rel = qpos - (k0 + crow(i, hh)); rel = rel < 0 ? 0 : (rel > 127 ? 127 : rel); s0[i] += btab[rel]; }
        SBAR();
#pragma unroll
        for (int i = 0; i < 16; ++i) { int rel = qpos - (k0 + 32 + crow(i, hh)); rel = rel < 0 ? 0 : (rel > 127 ? 127 : rel); s1[i] += btab[rel]; }
        SBAR();
    }
    if (need_mask) {
#pragma unroll
        for (int i = 0; i < 16; ++i) { if (k0 + crow(i, hh) > qpos) s0[i] = -INFINITY; if (k0 + 32 + crow(i, hh) > qpos) s1[i] = -INFINITY; }
    }
    float mx = max3_(s0[0], s0[1], s0[2]);
#pragma unroll
    for (int i = 3; i < 15; i += 2) mx = max3_(mx, s0[i], s0[i + 1]);
    mx = max3_(mx, s0[15], s1[0]);
#pragma unroll
    for (int i = 1; i < 15; i += 2) mx = max3_(mx, s1[i], s1[i + 1]);
    { auto rr = __builtin_amdgcn_permlane32_swap(__float_as_uint(mx), __float_as_uint(mx), false, false); mx = max3_(s1[15], __uint_as_float(rr[0]), __uint_as_float(rr[1])); }
    if constexpr (ROW) {
        const bool up = (mx - mref > D8_THR);
        if (__any(up)) {
            const float alpha = up ? fast_exp2((mref - mx) * D8_C) : 1.0f;
            if (up) mref = mx;
            lrun *= alpha;
            asm volatile("s_nop 15\n\ts_nop 15" ::: "memory");
#pragma unroll
            for (int dt = 0; dt < 4; ++dt)
#pragma unroll
                for (int i = 0; i < 16; ++i) o[dt][i] *= alpha;
        }
    } else
    if (first || __any(mx - mref > D8_THR)) {
        const float mn = first ? mx : fmaxf(mref, mx);
        const float alpha = first ? 0.f : fast_exp2((mref - mn) * D8_C);
        mref = mn; lrun *= alpha;
        asm volatile("s_nop 15\n\ts_nop 15" ::: "memory");
#pragma unroll
        for (int dt = 0; dt < 4; ++dt)
#pragma unroll
            for (int i = 0; i < 16; ++i) o[dt][i] *= alpha;
    }
    const float off = D8_SH - mref * D8_C;
    float sum0 = 0.f, sum1 = 0.f;
    i32x8 P;
    const f32x2 c2 = {D8_C, D8_C}, off2 = {off, off};
    f32x2 sum2 = {0.f, 0.f};
#pragma unroll
    for (int g = 0; g < 4; ++g) {
        const f32x2 a0 = __builtin_elementwise_fma((f32x2){s0[4 * g], s0[4 * g + 1]}, c2, off2), a1 = __builtin_elementwise_fma((f32x2){s0[4 * g + 2], s0[4 * g + 3]}, c2, off2);
        const f32x2 b0 = __builtin_elementwise_fma((f32x2){s1[4 * g], s1[4 * g + 1]}, c2, off2), b1 = __builtin_elementwise_fma((f32x2){s1[4 * g + 2], s1[4 * g + 3]}, c2, off2);
        const f32x2 e0 = {fast_exp2(a0[0]), fast_exp2(a0[1])}, e1 = {fast_exp2(a1[0]), fast_exp2(a1[1])}, f0 = {fast_exp2(b0[0]), fast_exp2(b0[1])}, f1 = {fast_exp2(b1[0]), fast_exp2(b1[1])};
        sum2 += (e0 + e1) + (f0 + f1);
        int w0 = __builtin_amdgcn_cvt_pk_fp8_f32(e0[0], e0[1], 0, false); w0 = __builtin_amdgcn_cvt_pk_fp8_f32(e1[0], e1[1], w0, true);
        int w1 = __builtin_amdgcn_cvt_pk_fp8_f32(f0[0], f0[1], 0, false); w1 = __builtin_amdgcn_cvt_pk_fp8_f32(f1[0], f1[1], w1, true);
        P[g] = w0; P[4 + g] = w1; }
    sum0 = sum2[0]; sum1 = sum2[1];
    lrun += sum0 + sum1;
    return P;
}
__device__ __forceinline__ void d8_pv(f32x16 (&o)[4], const i32x8 (&va)[2], const i32x8& P, const LAS unsigned char* vb, int r, int hh) {
    i32x8 vg[2];
    d8_load_vf2<2>(vg, vb, r, hh);
    asm volatile("s_waitcnt lgkmcnt(4)" ::: "memory"); SBAR();
    __builtin_amdgcn_s_setprio(1);
#pragma unroll
    for (int dt = 0; dt < 2; ++dt) asm volatile("v_mfma_scale_f32_32x32x64_f8f6f4 %0, %1, %2, %0, %3, %3 op_sel_hi:[0,0,0]" : "+v"(o[dt]) : "v"(va[dt]), "v"(P), "v"(0x7F7F7F7F));
    asm volatile("s_waitcnt lgkmcnt(0)" ::: "memory"); SBAR();
#pragma unroll
    for (int dt = 0; dt < 2; ++dt) asm volatile("v_mfma_scale_f32_32x32x64_f8f6f4 %0, %1, %2, %0, %3, %3 op_sel_hi:[0,0,0]" : "+v"(o[2 + dt]) : "v"(vg[dt]), "v"(P), "v"(0x7F7F7F7F));
    __builtin_amdgcn_s_setprio(0);
}
__device__ __forceinline__ void diff_unit8(LAS unsigned char* lds, int b, int h, int qt, const unsigned char* QD, const unsigned char* KDT, const unsigned char* VDT, bf16_t* AD, const float* subln, const float* rel_bias) {
    int tid_ = threadIdx.x; asm volatile("" : "+v"(tid_));
    const int tid = tid_, lane = tid & 63, r = lane & 31, hh = lane >> 5; const int wid = __builtin_amdgcn_readfirstlane(tid >> 6);
    const int map = wid >> 2, qsub = wid & 3;
    const int q0 = qt * 128, qw0 = q0 + 32 * qsub, qpos = qw0 + r;
    const size_t tok0 = (size_t)b * SEQ;
    const LAS float* btab = (const LAS float*)(lds + D_OFF_TAB);
    const LAS float* gtab = (const LAS float*)(lds + D_OFF_G);
    const int kcolb = map * 64;
    i32x8 qf;
    { const unsigned char* qp = QD + (tok0 + qpos) * 1024 + h * 128 + map * 64 + 32 * hh; qf = cat8(*(const i32x4*)qp, *(const i32x4*)(qp + 16)); }
    f32x16 o[4];
#pragma unroll
    for (int dt = 0; dt < 4; ++dt)
#pragma unroll
        for (int i = 0; i < 16; ++i) o[dt][i] = 0.f;
    float mrun = 0.f, lrun = 0.f;
    const unsigned char* kbase = KDT + ((size_t)h * 256 + b * 128) * 8192;
    const unsigned char* vbase = VDT + ((size_t)h * 256 + b * 128) * 8192;
    const int NT = 2 * (qt + 1);
    TileRegs8 R;
    __syncthreads();
    if (tid < 128) { const int n = tid; ((LAS float*)(lds + D_OFF_TAB))[n] = (rel_bias[t5_bucket(n) * 16 + h] - rel_bias[31 * 16 + h]) * (LOG2E * 64.0f); ((LAS float*)(lds + D_OFF_G))[n] = subln[n]; }
    tile_load8(R, kbase, vbase, tid); tile_store8(R, lds, lds + KBUF8, tid);
    tile_load8(R, kbase + 8192, vbase + 8192, tid); tile_store8(R, lds + TBUF8, lds + TBUF8 + KBUF8, tid);
    if (NT > 2) tile_load8(R, kbase + 2 * 8192, vbase + 2 * 8192, tid);
    __syncthreads();
    i32x8 kf[2], vf[2];
    d8_load_kf(kf, lds, r, hh, kcolb);
#define D8_STAGE(t) do { if ((t) + 2 < NT) tile_store8(R, lds + (((t) + 2) & 3) * TBUF8, lds + (((t) + 2) & 3) * TBUF8 + KBUF8, tid); \
        if ((t) + 3 < NT) tile_load8(R, kbase + (size_t)((t) + 3) * 8192, vbase + (size_t)((t) + 3) * 8192, tid); \
        __syncthreads(); } while (0)
#pragma unroll 1
    for (int t = 0; t < NT; ++t) {
        const int k0 = 64 * t; const LAS unsigned char* tb = lds + (t & 3) * TBUF8;
        f32x16 s0, s1; d8_scores(s0, s1, kf, qf);
        d8_load_vf2<0>(vf, tb + KBUF8, r, hh); d8_load_kf(kf, lds + ((t + 1) & 3) * TBUF8, r, hh, kcolb); SBAR();
        const i32x8 P = d8_softmax(s0, s1, o, mrun, lrun, qpos, k0, (k0 + 63 > qw0), (qw0 - (k0 + 63) < 113), t == 0, btab, hh);
        if (wid >= 4) D8_STAGE(t);
        d8_pv(o, vf, P, tb + KBUF8, r, hh);
        if (wid < 4) D8_STAGE(t);
    }
#undef D8_STAGE
    __syncthreads();
    asm volatile("s_nop 15\n\ts_nop 15\n\ts_nop 15\n\ts_nop 15" ::: "memory");
    const float l = (lrun + __shfl_xor(lrun, 32)) * D8_VS;
    LAS float* xch = (LAS float*)lds + qsub * 4096 + lane;
    if (map == 1) {
        const float lam = *(const LAS float*)(lds + MISC_OFF + 68);
        const float f = lam / l;
#pragma unroll
        for (int dt = 0; dt < 4; ++dt)
#pragma unroll
            for (int i = 0; i < 16; ++i) xch[(dt * 16 + i) * 64] = o[dt][i] * f;
    }
    __syncthreads();
    if (map == 0) {
        const float i0 = 1.0f / l;
        float ss = 0.f;
#pragma unroll
        for (int dt = 0; dt < 4; ++dt)
#pragma unroll
            for (int i = 0; i < 16; ++i) { const float v = o[dt][i] * i0 - xch[(dt * 16 + i) * 64]; o[dt][i] = v; ss += v * v; }
        ss += __shfl_xor(ss, 32);
        const float rs = 0.8f / sqrtf(ss * (1.0f / 128.0f) + RMS_EPS);
        bf16_t* orow = AD + (tok0 + qpos) * 1024 + h * 128;
#pragma unroll
        for (int dt = 0; dt < 4; ++dt)
#pragma unroll
            for (int g = 0; g < 4; ++g) { const int d = 32 * dt + 8 * g + 4 * hh;
                const f32x4 gg = *(const LAS f32x4*)(gtab + d);
                if constexpr (O78F8) { const float r8 = rs * F8_SAD;
                    *(unsigned*)((unsigned char*)AD + (tok0 + qpos) * 1024 + h * 128 + d) = epi::pack4_f8(o[dt][4 * g + 0] * r8 * gg[0], o[dt][4 * g + 1] * r8 * gg[1], o[dt][4 * g + 2] * r8 * gg[2], o[dt][4 * g + 3] * r8 * gg[3]); }
                else { u32x2 w; w.x = cvtpk(o[dt][4 * g + 0] * rs * gg[0], o[dt][4 * g + 1] * rs * gg[1]); w.y = cvtpk(o[dt][4 * g + 2] * rs * gg[2], o[dt][4 * g + 3] * rs * gg[3]);
                *(u32x2*)(orow + d) = w; } }
    }
}

__device__ __forceinline__ void moba_unit(LAS unsigned char* lds, int b, int h, int n, const int* list, int cnt, const bf16_t* QM, const bf16_t* KMT, const bf16_t* VMT, bf16_t* PARTS, float* ML, const float* rel_bias) {
    int tid_ = threadIdx.x; asm volatile("" : "+v"(tid_));
    const int tid = tid_, lane = tid & 63, r = lane & 31, hh = lane >> 5; const int wid = __builtin_amdgcn_readfirstlane(tid >> 6);
    const size_t tok0 = (size_t)b * SEQ;
    const LAS float* btab = (const LAS float*)(lds + OFF_TAB);
    const float sc = 0.08838834764831845f * LOG2E;
    const bool own = (list == nullptr);
    const int li = 32 * wid + r;
    const bool lane_valid = li < cnt;
    int qpos, slot;
    if (own) { qpos = 256 * n + li; slot = 3; }
    else { const int e = list[lane_valid ? li : 0]; qpos = e >> 2; slot = e & 3; }
    const bool wave_active = (32 * wid < cnt);
    bf16x8 qf[1][8];
#pragma unroll
    for (int ks = 0; ks < 8; ++ks) qf[0][ks] = *(const bf16x8*)(QM + (tok0 + qpos) * 1024 + h * 128 + 16 * ks + 8 * hh);
    f32x16 O[1][4];
#pragma unroll
    for (int dt = 0; dt < 4; ++dt)
#pragma unroll
        for (int i = 0; i < 16; ++i) O[0][dt][i] = 0.f;
    float mrun[1] = {-INFINITY}, lrun[1] = {0.f};
    const bf16_t* kbase = KMT + ((size_t)h * 256 + b * 128 + 4 * n) * 8192;
    const bf16_t* vbase = VMT + ((size_t)h * 256 + b * 128 + 4 * n) * 8192;
    const int qw0 = 256 * n + 32 * wid;
    TileRegs R;
    __syncthreads();
    fill_bias_tab((LAS float*)(lds + OFF_TAB), rel_bias, 8 + h);
    tile_load(R, kbase, vbase, tid);
    tile_store(R, lds + OFF_K, lds + OFF_V, tid);
    __syncthreads();
#pragma unroll 1
    for (int t = 0; t < 4; ++t) {
        const int cur = t & 1;
        if (t + 1 < 4) tile_load(R, kbase + (size_t)(t + 1) * 8192, vbase + (size_t)(t + 1) * 8192, tid);
        if (wave_active) {
#pragma unroll 1
            for (int kh = 0; kh < 2; ++kh) {
                const int kp = 256 * n + 64 * t + 32 * kh;
                bool run = true, need_mask = false, need_bias;
                if (own) { run = (kp <= qw0 + 31); need_mask = (kp + 31 > qw0); need_bias = true; }
                else { need_bias = __any(qpos - (kp + 31) < 113); }
                if (run) attn_half<1, 8>(lds + OFF_K + cur * KBUF, lds + OFF_V + cur * VBUF, kh, qf, O, mrun, lrun, qpos, kp, need_mask, need_bias, btab, sc, r, hh, 0);
            }
        }
        if (t + 1 < 4) tile_store(R, lds + OFF_K + (cur ^ 1) * KBUF, lds + OFF_V + (cur ^ 1) * VBUF, tid);
        __syncthreads();
    }
    const float l = lrun[0] + __shfl_xor(lrun[0], 32);
    const float il = 1.0f / l;
    if (lane_valid) {
        const size_t pidx = ((tok0 + qpos) * 8 + h) * 4 + slot;
        bf16_t* orow = PARTS + pidx * 128;
#pragma unroll
        for (int dt = 0; dt < 4; ++dt)
#pragma unroll
            for (int g = 0; g < 4; ++g) { const int d = 32 * dt + 8 * g + 4 * hh;
                u32x2 w; w.x = cvtpk(O[0][dt][4 * g + 0] * il, O[0][dt][4 * g + 1] * il); w.y = cvtpk(O[0][dt][4 * g + 2] * il, O[0][dt][4 * g + 3] * il);
                *(u32x2*)(orow + d) = w; }
        if (hh == 0) *(f32x2*)(ML + pidx * 2) = (f32x2){mrun[0], l};
    }
}
constexpr int MB_K = 0, MB_V = 4 * KBUF, MB_INC = MB_V + 4 * VBUF, MB_TAB = MB_INC + 2048, MB_END = MB_TAB + 512;
static_assert(MB_END <= MISC_OFF, "MoBA block LDS");
__device__ __forceinline__ void moba_block(LAS unsigned char* lds, int b, int h, int n, const int* list, int cntl, int c0, int c1, const bf16_t* QM, const bf16_t* KMT, const bf16_t* VMT, bf16_t* PARTS, float* ML, const float* rel_bias) {
    int tid_ = threadIdx.x; asm volatile("" : "+v"(tid_));
    const int tid = tid_, lane = tid & 63, r = lane & 31, hh = lane >> 5; const int wid = __builtin_amdgcn_readfirstlane(tid >> 6);
    const size_t tok0 = (size_t)b * SEQ;
    const LAS float* btab = (const LAS float*)(lds + MB_TAB);
    const float sc = 0.08838834764831845f * LOG2E;
    const bf16_t* kbase = KMT + ((size_t)h * 256 + b * 128 + 4 * n) * 8192;
    const bf16_t* vbase = VMT + ((size_t)h * 256 + b * 128 + 4 * n) * 8192;
    __syncthreads();
    fill_bias_tab((LAS float*)(lds + MB_TAB), rel_bias, 8 + h);
    const int li = 32 * wid + r;
    const int cA = c0, cB = c0 + 1;
    const bool ownA = (cA == 0);
    const int cntA = ownA ? 256 : ((cntl - 256 * (cA - 1)) < 256 ? (cntl - 256 * (cA - 1)) : 256);
    const int cntB = (cB < c1) ? ((cntl - 256 * (cB - 1)) < 256 ? (cntl - 256 * (cB - 1)) : 256) : 0;
    const bool hasA = (32 * wid < cntA), hasB = (32 * wid < cntB);
    const bool lvA = li < cntA, lvB = li < cntB;
    int eA = 0, eB = 0;
    if (hasA && !ownA) eA = list[256 * (cA - 1) + (lvA ? li : 0)];
    if (hasB) eB = list[256 * (cB - 1) + (lvB ? li : 0)];
    TileRegs R, R2;
    tile_load(R, kbase, vbase, tid); tile_load(R2, kbase + 8192, vbase + 8192, tid);
    tile_store(R, lds + MB_K, lds + MB_V, tid); tile_load(R, kbase + 2 * 8192, vbase + 2 * 8192, tid);
    const int qposA = ownA ? 256 * n + li : (eA >> 2), slotA = ownA ? 3 : (eA & 3);
    const int qposB = eB >> 2, slotB = eB & 3;
    bf16x8 qfA[1][8], qfB[1][8];
    if (hasA) {
#pragma unroll
        for (int ks = 0; ks < 8; ++ks) qfA[0][ks] = *(const bf16x8*)(QM + (tok0 + qposA) * 1024 + h * 128 + 16 * ks + 8 * hh);
    }
    if (hasB) {
#pragma unroll
        for (int ks = 0; ks < 8; ++ks) qfB[0][ks] = *(const bf16x8*)(QM + (tok0 + qposB) * 1024 + h * 128 + 16 * ks + 8 * hh);
    }
    tile_store(R2, lds + MB_K + KBUF, lds + MB_V + VBUF, tid); tile_load(R2, kbase + 3 * 8192, vbase + 3 * 8192, tid);
    tile_store(R, lds + MB_K + 2 * KBUF, lds + MB_V + 2 * VBUF, tid);
    tile_store(R2, lds + MB_K + 3 * KBUF, lds + MB_V + 3 * VBUF, tid);
    __syncthreads();
#define MB_CHUNK(HAS, OWN, QF, QPOS, SLOT, LV) do { if (HAS) { \
        f32x16 O[1][4]; \
        _Pragma("unroll") for (int dt = 0; dt < 4; ++dt) _Pragma("unroll") for (int i = 0; i < 16; ++i) O[0][dt][i] = 0.f; \
        float mrun[1] = {-INFINITY}, lrun[1] = {0.f}; \
        const int qw0 = 256 * n + 32 * wid; \
        _Pragma("unroll 1") for (int t8 = 0; t8 < 8; ++t8) { \
            const int t = t8 >> 1, kh = t8 & 1; const int kp = 256 * n + 32 * t8; \
            bool run = true, need_mask = false, need_bias; \
            if (OWN) { run = (kp <= qw0 + 31); need_mask = (kp + 31 > qw0); need_bias = true; } \
            else { need_bias = __any((QPOS) - (kp + 31) < 113); } \
            if (run) attn_half<1, 8>(lds + MB_K + t * KBUF, lds + MB_V + t * VBUF, kh, QF, O, mrun, lrun, QPOS, kp, need_mask, need_bias, btab, sc, r, hh, 0); \
        } \
        const float l = lrun[0] + __shfl_xor(lrun[0], 32); const float il = 1.0f / l; \
        if (LV) { const size_t pidx = ((tok0 + (QPOS)) * 8 + h) * 4 + (SLOT); bf16_t* orow = PARTS + pidx * 128; \
            _Pragma("unroll") for (int dt = 0; dt < 4; ++dt) _Pragma("unroll") for (int g = 0; g < 4; ++g) { const int d = 32 * dt + 8 * g + 4 * hh; \
                u32x2 w; w.x = cvtpk(O[0][dt][4 * g + 0] * il, O[0][dt][4 * g + 1] * il); w.y = cvtpk(O[0][dt][4 * g + 2] * il, O[0][dt][4 * g + 3] * il); \
                *(u32x2*)(orow + d) = w; } \
            if (hh == 0) *(f32x2*)(ML + pidx * 2) = (f32x2){mrun[0], l}; } } } while (0)
    MB_CHUNK(hasA, ownA, qfA, qposA, slotA, lvA);
    MB_CHUNK(hasB, false, qfB, qposB, slotB, lvB);
#undef MB_CHUNK
}
constexpr int MB8_TAB = 4 * TBUF8;
static_assert(MB8_TAB + 512 <= MB_INC, "fp8 MoBA block LDS");
__device__ __forceinline__ void moba_block8(LAS unsigned char* lds, int b, int h, int n, const int* list, int cntl, int c0, int c1, const unsigned char* QM8, const unsigned char* KMT8, const unsigned char* VMT8, bf16_t* PARTS, float* ML, const float* rel_bias) {
    int tid_ = threadIdx.x; asm volatile("" : "+v"(tid_));
    const int tid = tid_, lane = tid & 63, r = lane & 31, hh = lane >> 5; const int wid = __builtin_amdgcn_readfirstlane(tid >> 6);
    const size_t tok0 = (size_t)b * SEQ;
    const LAS float* btab = (const LAS float*)(lds + MB8_TAB);
    const unsigned char* kbase = KMT8 + ((size_t)h * 256 + b * 128 + 4 * n) * 8192;
    const unsigned char* vbase = VMT8 + ((size_t)h * 256 + b * 128 + 4 * n) * 8192;
    __syncthreads();
    if (tid < 128) { const int q = tid; ((LAS float*)(lds + MB8_TAB))[q] = (rel_bias[t5_bucket(q) * 16 + 8 + h] - rel_bias[31 * 16 + 8 + h]) * (LOG2E * 64.0f); }
    const int li = 32 * wid + r;
    const int cA = c0, cB = c0 + 1;
    const bool ownA = (cA == 0);
    const int cntA = ownA ? 256 : ((cntl - 256 * (cA - 1)) < 256 ? (cntl - 256 * (cA - 1)) : 256);
    const int cntB = (cB < c1) ? ((cntl - 256 * (cB - 1)) < 256 ? (cntl - 256 * (cB - 1)) : 256) : 0;
    const bool hasA = (32 * wid < cntA), hasB = (32 * wid < cntB);
    const bool lvA = li < cntA, lvB = li < cntB;
    int eA = 0, eB = 0;
    if (hasA && !ownA) eA = list[256 * (cA - 1) + (lvA ? li : 0)];
    if (hasB) eB = list[256 * (cB - 1) + (lvB ? li : 0)];
    TileRegs8 R0, R1, R2, R3;
    tile_load8(R0, kbase, vbase, tid); tile_load8(R1, kbase + 8192, vbase + 8192, tid); tile_load8(R2, kbase + 2 * 8192, vbase + 2 * 8192, tid); tile_load8(R3, kbase + 3 * 8192, vbase + 3 * 8192, tid);
    SBAR();
    tile_store8(R0, lds, lds + KBUF8, tid);
    const int qposA = ownA ? 256 * n + li : (eA >> 2), slotA = ownA ? 3 : (eA & 3);
    const int qposB = eB >> 2, slotB = eB & 3;
    i32x8 qf[2];
    if (hasA) { const unsigned char* qp = QM8 + (tok0 + qposA) * 1024 + h * 128 + 32 * hh; qf[0] = cat8(*(const i32x4*)qp, *(const i32x4*)(qp + 16)); qf[1] = cat8(*(const i32x4*)(qp + 64), *(const i32x4*)(qp + 80)); }
    tile_store8(R1, lds + TBUF8, lds + TBUF8 + KBUF8, tid);
    tile_store8(R2, lds + 2 * TBUF8, lds + 2 * TBUF8 + KBUF8, tid);
    tile_store8(R3, lds + 3 * TBUF8, lds + 3 * TBUF8 + KBUF8, tid);
    __syncthreads();
#define MB8_LOADQB() do { if (hasB) { const unsigned char* qp = QM8 + (tok0 + qposB) * 1024 + h * 128 + 32 * hh; qf[0] = cat8(*(const i32x4*)qp, *(const i32x4*)(qp + 16)); qf[1] = cat8(*(const i32x4*)(qp + 64), *(const i32x4*)(qp + 80)); } } while (0)
#define MB8_CHUNK(HAS, OWN, QPOS, SLOT, LV, NEXTQ) do { if (HAS) { \
        f32x16 o[4]; \
        _Pragma("unroll") for (int dt = 0; dt < 4; ++dt) _Pragma("unroll") for (int i = 0; i < 16; ++i) o[dt][i] = 0.f; \
        float mref = -INFINITY, lrun = 0.f; \
        const int qw0 = 256 * n + 32 * wid; \
        _Pragma("unroll 1") for (int t = 0; t < 4; ++t) { \
            const int kp = 256 * n + 64 * t; const LAS unsigned char* tb = lds + t * TBUF8; \
            bool run = true, need_mask = false, need_bias; \
            if (OWN) { run = (kp <= qw0 + 31); need_mask = (kp + 63 > qw0); need_bias = (qw0 - (kp + 63) < 113); } \
            else { need_bias = __any((QPOS) - (kp + 63) < 113); } \
            if (run) { \
                i32x8 ka[2], kc[2], vf[2]; \
                d8_load_kf(ka, tb, r, hh, 0); d8_load_kf(kc, tb, r, hh, 64); \
                f32x16 s0, s1; d8_scores(s0, s1, ka, qf[0]); \
                __builtin_amdgcn_s_setprio(1); \
                s0 = __builtin_amdgcn_mfma_scale_f32_32x32x64_f8f6f4(kc[0], qf[1], s0, 0, 0, 0, 0x7F7F7F7F, 0, 0x7F7F7F7F); \
                s1 = __builtin_amdgcn_mfma_scale_f32_32x32x64_f8f6f4(kc[1], qf[1], s1, 0, 0, 0, 0x7F7F7F7F, 0, 0x7F7F7F7F); \
                __builtin_amdgcn_s_setprio(0); \
                d8_load_vf2<0>(vf, tb + KBUF8, r, hh); SBAR(); \
                const i32x8 P = d8_softmax<true>(s0, s1, o, mref, lrun, QPOS, kp, need_mask, need_bias, false, btab, hh); \
                d8_pv(o, vf, P, tb + KBUF8, r, hh); \
            } \
        } \
        NEXTQ; \
        asm volatile("s_nop 15\n\ts_nop 15\n\ts_nop 15\n\ts_nop 15" ::: "memory");        \
        const float l = lrun + __shfl_xor(lrun, 32); const float il = 1.0f / (l * D8_VS); \
        { const float il8 = il * F8_SPART; const size_t pidx = ((tok0 + (QPOS)) * 8 + h) * 4 + (SLOT); unsigned char* orow = (unsigned char*)PARTS + pidx * 128; \
              \
            _Pragma("unroll") for (int dt = 0; dt < 4; ++dt) _Pragma("unroll") for (int g = 0; g < 4; g += 2) { \
                unsigned a_ = epi::pack4_f8(o[dt][4 * g + 0] * il8, o[dt][4 * g + 1] * il8, o[dt][4 * g + 2] * il8, o[dt][4 * g + 3] * il8); \
                unsigned b_ = epi::pack4_f8(o[dt][4 * g + 4] * il8, o[dt][4 * g + 5] * il8, o[dt][4 * g + 6] * il8, o[dt][4 * g + 7] * il8); \
                auto rr = __builtin_amdgcn_permlane32_swap(a_, b_, false, false); a_ = rr[0]; b_ = rr[1]; \
                if (LV) *(u32x2*)(orow + 32 * dt + 8 * g + 8 * hh) = (u32x2){a_, b_}; } } \
        if (LV) { const size_t pidx = ((tok0 + (QPOS)) * 8 + h) * 4 + (SLOT); \
            if (hh == 0) *(f32x2*)(ML + pidx * 2) = (f32x2){mref * D8_C - D8_SH, l}; } } else { NEXTQ; } } while (0)
    MB8_CHUNK(hasA, ownA, qposA, slotA, lvA, MB8_LOADQB());
    MB8_CHUNK(hasB, false, qposB, slotB, lvB, (void)0);
#undef MB8_CHUNK
#undef MB8_LOADQB
}
}

struct Ctx {
    LAS unsigned char* lds;
    unsigned char* ws; unsigned* ctl;
    const float* const* in; float* out;
    int tid, lane, wave, G, blk;
};
enum { I_X = 0, I_C, I_WADA, I_BADA, I_GMIX, I_GFFN, I_WIN, I_LAMBDA, I_SUBLN, I_RELB, I_WOD, I_WOM, I_WOUT, I_WROUTER, I_RBIAS, I_WEG, I_WEU, I_WED, I_WSG, I_WSU, I_WSD, I_GFINAL };

constexpr int TR_SCR = 64 * 65 * 4 + 128;
static_assert(8 * TR_SCR <= RING_BYTES + 16384, "transpose scratch");
template <bool NT>
__device__ __forceinline__ void transpose_item(const float* __restrict__ W, int K, int N, bf16_t* __restrict__ WT, int drow0, int k0, int n0, LAS float* scr, int lane) {
    const int nq = lane & 15, kr = lane >> 4;
    f32x4 v[16];
#pragma unroll
    for (int i = 0; i < 16; ++i) { const f32x4* p = (const f32x4*)(W + (size_t)(k0 + 4 * i + kr) * N + n0 + 4 * nq); v[i] = NT ? __builtin_nontemporal_load(p) : *p; }
#pragma unroll
    for (int i = 0; i < 16; ++i) { LAS float* d = scr + (4 * i + kr) * 65 + 4 * nq; d[0] = v[i][0]; d[1] = v[i][1]; d[2] = v[i][2]; d[3] = v[i][3]; }
    LDS_WAIT(); asm volatile("" ::: "memory");
    const int c = lane & 7;
#pragma unroll
    for (int j = 0; j < 8; ++j) { const int n = (lane >> 3) + 8 * j; const LAS float* s = scr + (8 * c) * 65 + n;
        u32x4 o; o.x = cvtpk(s[0 * 65], s[1 * 65]); o.y = cvtpk(s[2 * 65], s[3 * 65]); o.z = cvtpk(s[4 * 65], s[5 * 65]); o.w = cvtpk(s[6 * 65], s[7 * 65]);
        u32x4* q = (u32x4*)(WT + (size_t)(drow0 + n) * K + k0 + 8 * c); if (NT) __builtin_nontemporal_store(o, q); else *q = o; }
    LDS_WAIT(); asm volatile("" ::: "memory");
}
template <bool NT>
__device__ __forceinline__ void transpose_item_f8(const float* __restrict__ W, int K, int N, unsigned char* __restrict__ WT, int drow0, int k0, int n0, LAS float* scr, int lane, float scale) {
    const int nq = lane & 15, kr = lane >> 4;
    f32x4 v[16];
#pragma unroll
    for (int i = 0; i < 16; ++i) { const f32x4* p = (const f32x4*)(W + (size_t)(k0 + 4 * i + kr) * N + n0 + 4 * nq); v[i] = NT ? __builtin_nontemporal_load(p) : *p; }
#pragma unroll
    for (int i = 0; i < 16; ++i) { LAS float* d = scr + (4 * i + kr) * 65 + 4 * nq; d[0] = v[i][0] * scale; d[1] = v[i][1] * scale; d[2] = v[i][2] * scale; d[3] = v[i][3] * scale; }
    LDS_WAIT(); asm volatile("" ::: "memory");
    const int c = lane & 7;
#pragma unroll
    for (int j = 0; j < 8; ++j) { const int n = (lane >> 3) + 8 * j; const LAS float* s = scr + (8 * c) * 65 + n;
        const u32x2 o = {epi::pack4_f8(s[0 * 65], s[1 * 65], s[2 * 65], s[3 * 65]), epi::pack4_f8(s[4 * 65], s[5 * 65], s[6 * 65], s[7 * 65])};
        u32x2* q = (u32x2*)(WT + (size_t)(drow0 + n) * K + k0 + 8 * c); if (NT) __builtin_nontemporal_store(o, q); else *q = o; }
    LDS_WAIT(); asm volatile("" ::: "memory");
}
struct CvItemF8 { const float* W; unsigned char* WT; int K, N, drow0, k0, n0; float scale; };
__device__ __forceinline__ void transpose_pair_f8(const CvItemF8& A, const CvItemF8& B, LAS float* scr, int lane) {
    const int nq = lane & 15, kr = lane >> 4, c = lane & 7;
    f32x4 va[16], vb[16];
#pragma unroll
    for (int i = 0; i < 16; ++i) va[i] = __builtin_nontemporal_load((const f32x4*)(A.W + (size_t)(A.k0 + 4 * i + kr) * A.N + A.n0 + 4 * nq));
#pragma unroll
    for (int i = 0; i < 16; ++i) vb[i] = __builtin_nontemporal_load((const f32x4*)(B.W + (size_t)(B.k0 + 4 * i + kr) * B.N + B.n0 + 4 * nq));
    __builtin_amdgcn_sched_barrier(0);
#pragma unroll
    for (int i = 0; i < 16; ++i) { LAS float* d = scr + (4 * i + kr) * 65 + 4 * nq; d[0] = va[i][0] * A.scale; d[1] = va[i][1] * A.scale; d[2] = va[i][2] * A.scale; d[3] = va[i][3] * A.scale; }
    LDS_WAIT(); asm volatile("" ::: "memory");
#pragma unroll
    for (int j = 0; j < 8; ++j) { const int n = (lane >> 3) + 8 * j; const LAS float* s = scr + (8 * c) * 65 + n;
        const u32x2 o = {epi::pack4_f8(s[0 * 65], s[1 * 65], s[2 * 65], s[3 * 65]), epi::pack4_f8(s[4 * 65], s[5 * 65], s[6 * 65], s[7 * 65])};
        __builtin_nontemporal_store(o, (u32x2*)(A.WT + (size_t)(A.drow0 + n) * A.K + A.k0 + 8 * c)); }
    LDS_WAIT(); asm volatile("" ::: "memory");
#pragma unroll
    for (int i = 0; i < 16; ++i) { LAS float* d = scr + (4 * i + kr) * 65 + 4 * nq; d[0] = vb[i][0] * B.scale; d[1] = vb[i][1] * B.scale; d[2] = vb[i][2] * B.scale; d[3] = vb[i][3] * B.scale; }
    LDS_WAIT(); asm volatile("" ::: "memory");
#pragma unroll
    for (int j = 0; j < 8; ++j) { const int n = (lane >> 3) + 8 * j; const LAS float* s = scr + (8 * c) * 65 + n;
        const u32x2 o = {epi::pack4_f8(s[0 * 65], s[1 * 65], s[2 * 65], s[3 * 65]), epi::pack4_f8(s[4 * 65], s[5 * 65], s[6 * 65], s[7 * 65])};
        __builtin_nontemporal_store(o, (u32x2*)(B.WT + (size_t)(B.drow0 + n) * B.K + B.k0 + 8 * c)); }
    LDS_WAIT(); asm volatile("" ::: "memory");
}
__device__ __forceinline__ int gu_row(int n0, int up) { return 256 * (n0 >> 7) + 128 * up + (n0 & 127); }

__device__ __forceinline__ int win_row(int n) { return n < 2048 ? n : (n < 3072 ? 8192 + (n - 2048) : (n < 5120 ? 2048 + (n - 3072) : (n < 6144 ? 9216 + (n - 5120) : 4096 + (n - 6144)))); }
__device__ __forceinline__ void p0_prologue(Ctx& F) {
    const int gw = F.blk * 8 + F.wave, NGW = F.G * 8;
    unsigned char* ws = F.ws;
    {
        const float* wada = F.in[I_WADA]; const float* c = F.in[I_C]; float* modp = (float*)(ws + WS_MODP);
        for (int it = gw; it < 48 * 32; it += NGW) {
            const int cc = it % 48, ks = it / 48, col = 256 * cc + 4 * F.lane;
            f32x4 a0 = {0.f, 0.f, 0.f, 0.f}, a1 = {0.f, 0.f, 0.f, 0.f};
#pragma unroll 8
            for (int k = 64 * ks; k < 64 * ks + 64; ++k) {
                const f32x4 w = *(const f32x4*)(wada + (size_t)k * 12288 + col);
                const float c0 = c[k], c1 = c[2048 + k];
                a0 += w * siluf_(c0); a1 += w * siluf_(c1);
            }
            *(f32x4*)(modp + ((size_t)ks * 2 + 0) * 12288 + col) = a0;
            *(f32x4*)(modp + ((size_t)ks * 2 + 1) * 12288 + col) = a1;
        }
    }
    {
        LAS float* scr = (LAS float*)(F.lds + F.wave * TR_SCR);
        constexpr int I0 = 5120, I1 = I0 + 512, I2 = I1 + 512, I3 = I2 + 1024, I4 = I3 + 256, I5 = I4 + 256, I6 = I5 + 256;
        for (int it = gw; it < I6; it += NGW) {
            if (it < I0) { const int r = it, kb = r / 160, nb = r % 160; if constexpr (P2F8) transpose_item_f8<false>(F.in[I_WIN], 2048, 10240, ws + WS_W_IN_T, win_row(64 * nb), 64 * kb, 64 * nb, scr, F.lane, F8_SW); else transpose_item<false>(F.in[I_WIN], 2048, 10240, (bf16_t*)(ws + WS_W_IN_T), win_row(64 * nb), 64 * kb, 64 * nb, scr, F.lane); }
            else if (it < I1) { const int r = it - I0, kb = r / 32, nb = r % 32; if constexpr (O78F8) transpose_item_f8<false>(F.in[I_WOD], 1024, 2048, ws + WS_W_OD_T, 64 * nb, 64 * kb, 64 * nb, scr, F.lane, F8_SWO); else transpose_item<false>(F.in[I_WOD], 1024, 2048, (bf16_t*)(ws + WS_W_OD_T), 64 * nb, 64 * kb, 64 * nb, scr, F.lane); }
            else if (it < I2) { const int r = it - I1, kb = r / 32, nb = r % 32; if constexpr (O78F8) transpose_item_f8<false>(F.in[I_WOM], 1024, 2048, ws + WS_W_OM_T, 64 * nb, 64 * kb, 64 * nb, scr, F.lane, F8_SWO); else transpose_item<false>(F.in[I_WOM], 1024, 2048, (bf16_t*)(ws + WS_W_OM_T), 64 * nb, 64 * kb, 64 * nb, scr, F.lane); }
            else if (it < I3) { const int r = it - I2, kb = r / 32, nb = r % 32; if constexpr (O78F8) transpose_item_f8<false>(F.in[I_WOUT], 2048, 2048, ws + WS_W_OUT_T, 64 * nb, 64 * kb, 64 * nb, scr, F.lane, F8_SWOUT); else transpose_item<false>(F.in[I_WOUT], 2048, 2048, (bf16_t*)(ws + WS_W_OUT_T), 64 * nb, 64 * kb, 64 * nb, scr, F.lane); }
            else if (it < I4) { const int r = it - I3, kb = r / 8, nb = r % 8; transpose_item_f8<false>(F.in[I_WSG], 2048, 512, ws + WS_W_SHGU_T, gu_row(64 * nb, 0), 64 * kb, 64 * nb, scr, F.lane, F8_SW); }
            else if (it < I5) { const int r = it - I4, kb = r / 8, nb = r % 8; transpose_item_f8<false>(F.in[I_WSU], 2048, 512, ws + WS_W_SHGU_T, gu_row(64 * nb, 1), 64 * kb, 64 * nb, scr, F.lane, F8_SW); }
            else { const int r = it - I5, kb = r / 32, nb = r % 32; transpose_item_f8<false>(F.in[I_WSD], 512, 2048, ws + WS_W_SHD_T, 64 * nb, 64 * kb, 64 * nb, scr, F.lane, F8_SD); }
        }
    }
    {
        const float* wr = F.in[I_WROUTER]; bf16_t* hi = (bf16_t*)(ws + WS_WR); bf16_t* lo = hi + 64 * 2048;
        for (int idx = F.blk * 512 + F.tid; idx < 2048 * 64; idx += F.G * 512) {
            const int k = idx >> 6, e = idx & 63; const float w = wr[idx];
            const unsigned h16 = cvtpk(w, 0.f) & 0xffffu; const float res = w - __uint_as_float(h16 << 16);
            hi[e * 2048 + k] = (bf16_t)h16; lo[e * 2048 + k] = (bf16_t)(cvtpk(res, 0.f) & 0xffffu);
        }
    }
}

constexpr int CV_NCHUNK = 1536;
struct CvItem { const float* W; unsigned char* WT; int K, N, drow0, k0, n0; float scale; };
__device__ __forceinline__ CvItem cv_decode(Ctx& F, int it) {
    unsigned char* ws = F.ws; CvItem c;
    if (it < 16384) { const int r = it, e = r >> 8, r2 = r & 255, kb = r2 / 8, nb = r2 % 8;
        c.W = F.in[I_WEG] + (size_t)e * 2048 * 512; c.WT = ws + WS_W_EGU_T + (size_t)e * 1024 * 2048; c.scale = F8_SW; c.K = 2048; c.N = 512; c.drow0 = gu_row(64 * nb, 0); c.k0 = 64 * kb; c.n0 = 64 * nb; }
    else if (it < 32768) { const int r = it - 16384, e = r >> 8, r2 = r & 255, kb = r2 / 8, nb = r2 % 8;
        c.W = F.in[I_WEU] + (size_t)e * 2048 * 512; c.WT = ws + WS_W_EGU_T + (size_t)e * 1024 * 2048; c.scale = F8_SW; c.K = 2048; c.N = 512; c.drow0 = gu_row(64 * nb, 1); c.k0 = 64 * kb; c.n0 = 64 * nb; }
    else { const int r = it - 32768, e = r >> 8, r2 = r & 255, kb = r2 / 32, nb = r2 % 32;
        c.W = F.in[I_WED] + (size_t)e * 512 * 2048; c.WT = ws + WS_W_ED_T + (size_t)e * 2048 * 512; c.scale = F8_SD; c.K = 512; c.N = 2048; c.drow0 = 64 * nb; c.k0 = 64 * kb; c.n0 = 64 * nb; }
    return c;
}
__device__ __forceinline__ void convert_chunk(Ctx& F, int chunk) {
    LAS float* scr = (LAS float*)(F.lds + F.wave * TR_SCR);
    int lane = F.lane; asm volatile("" : "+v"(lane));
    const int it0 = chunk * 32 + F.wave * 4;
#pragma unroll 1
    for (int i = 0; i < 4; i += 2) { const CvItem a = cv_decode(F, it0 + i), b = cv_decode(F, it0 + i + 1);
        transpose_pair_f8(CvItemF8{a.W, a.WT, a.K, a.N, a.drow0, a.k0, a.n0, a.scale}, CvItemF8{b.W, b.WT, b.K, b.N, b.drow0, b.k0, b.n0, b.scale}, scr, lane); }
}
__device__ __forceinline__ int queue_take(Ctx& F, unsigned* head) {
    volatile LAS int* slot = (volatile LAS int*)(F.lds + MISC_OFF + 64);
    __syncthreads();
    if (F.tid == 0) *slot = (int)__hip_atomic_fetch_add(head, 1u, RLX_AGENT);
    __syncthreads();
    return *slot;
}

__device__ __forceinline__ void fill_mod_tables(Ctx& F, const float* gain, int shift_off, int scale_off, bool from_partials, int bsel = -1) {
    LAS float* A = (LAS float*)F.lds; LAS float* Bt = (LAS float*)(F.lds + 16384);
    const float* modp = (const float*)(F.ws + WS_MODP); const float* modf = (const float*)(F.ws + WS_MOD); const float* bada = F.in[I_BADA];
    const int lo = bsel < 0 ? 0 : bsel * 2048, hi = bsel < 0 ? 4096 : lo + 2048;
    for (int idx = lo + F.tid; idx < hi; idx += 512) {
        const int b = idx >> 11, c = idx & 2047;
        float sh, scl;
        if (from_partials) {
            sh = bada[shift_off + c]; scl = bada[scale_off + c];
#pragma unroll 16
            for (int ks = 0; ks < 32; ++ks) { sh += modp[((size_t)ks * 2 + b) * 12288 + shift_off + c]; scl += modp[((size_t)ks * 2 + b) * 12288 + scale_off + c]; }
        } else { sh = modf[b * 12288 + shift_off + c]; scl = modf[b * 12288 + scale_off + c]; }
        A[idx] = gain[c] * (1.0f + scl); Bt[idx] = sh;
    }
    __syncthreads();
}

__device__ __forceinline__ void p1_norm(Ctx& F) {
    { const float* modp = (const float*)(F.ws + WS_MODP); float* modf = (float*)(F.ws + WS_MOD); const float* bada = F.in[I_BADA];
      for (int idx = F.blk * 512 + F.tid; idx < 2 * 12288; idx += F.G * 512) { const int b = idx / 12288, j = idx % 12288; float s = bada[j];
#pragma unroll 8
          for (int ks = 0; ks < 32; ++ks) s += modp[((size_t)ks * 2 + b) * 12288 + j];
          modf[idx] = s; } }
    const int rpb = T / F.G;
    const bool one_batch = (F.G * rpb == T) && (SEQ % rpb == 0);
    const int row_lo = one_batch ? F.blk * rpb : 0, row_hi = one_batch ? row_lo + rpb : T, rstep = one_batch ? 8 : F.G * 8, r0 = one_batch ? row_lo + F.wave : F.blk * 8 + F.wave;
    fill_mod_tables(F, F.in[I_GMIX], 0, 2048, true, one_batch ? row_lo / SEQ : -1);
    const LAS float* A = (const LAS float*)F.lds; const LAS float* Bt = (const LAS float*)(F.lds + 16384);
    const float* x = F.in[I_X]; bf16_t* H = (bf16_t*)(F.ws + WS_H);
    for (int row = r0; row < row_hi; row += 2 * rstep) {
        const int row2 = row + rstep; const bool has2 = row2 < row_hi;
        const int b = row / SEQ, b2 = has2 ? row2 / SEQ : b;
        const f32x4* xr = (const f32x4*)(x + (size_t)row * 2048) + F.lane;
        const f32x4* xr2 = (const f32x4*)(x + (size_t)(has2 ? row2 : row) * 2048) + F.lane;
        f32x4 v[8], v2[8]; float ss = 0.f, ss2 = 0.f;
#pragma unroll
        for (int j = 0; j < 8; ++j) { v[j] = __builtin_nontemporal_load(xr + 64 * j); v2[j] = __builtin_nontemporal_load(xr2 + 64 * j); }
#pragma unroll
        for (int j = 0; j < 8; ++j) { ss += (v[j].x * v[j].x + v[j].y * v[j].y) + (v[j].z * v[j].z + v[j].w * v[j].w); ss2 += (v2[j].x * v2[j].x + v2[j].y * v2[j].y) + (v2[j].z * v2[j].z + v2[j].w * v2[j].w); }
        const float rstd = 1.0f / sqrtf(wave_sum(ss) * (1.0f / 2048.0f) + RMS_EPS), rstd2 = 1.0f / sqrtf(wave_sum(ss2) * (1.0f / 2048.0f) + RMS_EPS);
        unsigned long long* o8 = (unsigned long long*)(H + (size_t)row * 2048) + F.lane;
        unsigned long long* o82 = (unsigned long long*)(H + (size_t)row2 * 2048) + F.lane;
#pragma unroll
        for (int j = 0; j < 8; ++j) { const int c = 4 * F.lane + 256 * j;
            const f32x4 a = *(const LAS f32x4*)(A + b * 2048 + c), sft = *(const LAS f32x4*)(Bt + b * 2048 + c);
            const f32x4 y = v[j] * rstd * a + sft;
            if constexpr (P2F8) ((unsigned*)((unsigned char*)H + (size_t)row * 2048))[F.lane + 64 * j] = epi::pack4_f8(y.x * F8_SH, y.y * F8_SH, y.z * F8_SH, y.w * F8_SH);
            else o8[64 * j] = (unsigned long long)cvtpk(y.x, y.y) | ((unsigned long long)cvtpk(y.z, y.w) << 32);
            if (has2) { const f32x4 a2 = *(const LAS f32x4*)(A + b2 * 2048 + c), sft2 = *(const LAS f32x4*)(Bt + b2 * 2048 + c);
                const f32x4 y2 = v2[j] * rstd2 * a2 + sft2;
                if constexpr (P2F8) ((unsigned*)((unsigned char*)H + (size_t)row2 * 2048))[F.lane + 64 * j] = epi::pack4_f8(y2.x * F8_SH, y2.y * F8_SH, y2.z * F8_SH, y2.w * F8_SH);
                else o82[64 * j] = (unsigned long long)cvtpk(y2.x, y2.y) | ((unsigned long long)cvtpk(y2.z, y2.w) << 32); } }
    }
}

__device__ __forceinline__ void p3_kmean(Ctx& F) {
    const bf16_t* KMT = (const bf16_t*)(F.ws + WS_KMT); float* KM = (float*)(F.ws + WS_KMEAN);
    LAS float* red = (LAS float*)F.lds;
    for (int item = F.blk; item < 512; item += F.G) {
        const int b = item >> 8, h = (item >> 5) & 7, n = item & 31;
        const int cp = F.tid & 63, rg = F.tid >> 6;
        const bf16_t* base = KMT + (((size_t)h * 256 + b * 128 + 4 * n) * 64 + 32 * rg) * 128 + 2 * cp;
        float s0 = 0.f, s1 = 0.f;
#pragma unroll 8
        for (int rr = 0; rr < 32; ++rr) { const unsigned u = *(const unsigned*)(base + (size_t)rr * 128); s0 += bf_lo(u); s1 += bf_hi(u); }
        __syncthreads();
        red[rg * 128 + 2 * cp] = s0; red[rg * 128 + 2 * cp + 1] = s1;
        __syncthreads();
        if (F.tid < 128) { float s = 0.f;
#pragma unroll
            for (int g = 0; g < 8; ++g) s += red[g * 128 + F.tid];
            KM[(size_t)item * 128 + F.tid] = s * (1.0f / 256.0f); }
    }
    __syncthreads();
}

__device__ __forceinline__ void p4_gating(Ctx& F) {
    const bf16_t* QM = (const bf16_t*)(F.ws + WS_QM); const float* KM = (const float*)(F.ws + WS_KMEAN);
    float* ML = (float*)(F.ws + WS_ML); int* MLIST = (int*)(F.ws + WS_MLIST); unsigned* mcnt = F.ctl + CW_MCNT;
    for (int grp = F.blk; grp < T / 64; grp += F.G) {
        const int h = F.wave, tok = grp * 64 + F.lane, b = tok / SEQ, qs = tok % SEQ, cur = qs >> 8;
        const int curu = __builtin_amdgcn_readfirstlane(cur), bu = __builtin_amdgcn_readfirstlane(b);
        float q[128];
        const u32x4* qp = (const u32x4*)(QM + (size_t)tok * 1024 + h * 128);
#pragma unroll
        for (int i = 0; i < 16; ++i) { const u32x4 u = qp[i]; q[8 * i + 0] = bf_lo(u.x); q[8 * i + 1] = bf_hi(u.x); q[8 * i + 2] = bf_lo(u.y); q[8 * i + 3] = bf_hi(u.y);
            q[8 * i + 4] = bf_lo(u.z); q[8 * i + 5] = bf_hi(u.z); q[8 * i + 6] = bf_lo(u.w); q[8 * i + 7] = bf_hi(u.w); }
        float v0 = -INFINITY, v1 = -INFINITY, v2 = -INFINITY; int i0 = -1, i1 = -1, i2 = -1;
        const float* kmb = KM + (size_t)((bu * 8 + h) * 32) * 128;
        for (int n = 0; n < curu; ++n) {
            const float* km = kmb + n * 128;
            float a0 = 0.f, a1 = 0.f, a2 = 0.f, a3 = 0.f;
#pragma unroll
            for (int d = 0; d < 128; d += 4) { a0 += q[d] * km[d]; a1 += q[d + 1] * km[d + 1]; a2 += q[d + 2] * km[d + 2]; a3 += q[d + 3] * km[d + 3]; }
            const float s = (a0 + a1) + (a2 + a3);
            if (s > v0) { v2 = v1; i2 = i1; v1 = v0; i1 = i0; v0 = s; i0 = n; }
            else if (s > v1) { v2 = v1; i2 = i1; v1 = s; i1 = n; }
            else if (s > v2) { v2 = s; i2 = n; }
        }
        float* ml = ML + ((size_t)tok * 8 + h) * 8;
        if (i0 < 0) *(f32x2*)(ml + 0) = (f32x2){-INFINITY, 0.f};
        if (i1 < 0) *(f32x2*)(ml + 2) = (f32x2){-INFINITY, 0.f};
        if (i2 < 0) *(f32x2*)(ml + 4) = (f32x2){-INFINITY, 0.f};
        for (int n = 0; n < curu; ++n) {
            const bool hit = (i0 == n) || (i1 == n) || (i2 == n);
            const unsigned long long mask = __ballot(hit);
            if (mask) {
                const int cntw = __popcll(mask);
                unsigned base = 0;
                if (F.lane == 0) base = __hip_atomic_fetch_add(mcnt + ((bu * 8 + h) * 32 + n), (unsigned)cntw, RLX_AGENT);
                base = __builtin_amdgcn_readfirstlane(base);
                if (hit) { const int pos = base + __popcll(mask & ((1ull << F.lane) - 1ull)); const int slot = (i0 == n) ? 0 : ((i1 == n) ? 1 : 2);
                    MLIST[(size_t)((bu * 8 + h) * 32 + n) * 8192 + pos] = (qs << 2) | slot; }
            }
        }
    }
}

__device__ __forceinline__ void p6_merge(Ctx& F) {
    const bf16_t* PARTS = (const bf16_t*)(F.ws + WS_PARTS); const float* ML = (const float*)(F.ws + WS_ML); bf16_t* AM = (bf16_t*)(F.ws + WS_AM);
    const int gw = F.blk * 8 + F.wave, NGW = F.G * 8;
    for (int tok = gw; tok < T; tok += NGW) {
        f32x4 ml01[2], ml23[2]; u32x2 pu[2][4];
#pragma unroll
        for (int i = 0; i < 2; ++i) {
            const int item = F.lane + 64 * i, h = item >> 4, ch = item & 15;
            const float* ml = ML + ((size_t)tok * 8 + h) * 8;
            ml01[i] = *(const f32x4*)ml; ml23[i] = *(const f32x4*)(ml + 4);
            const unsigned char* pb = (const unsigned char*)PARTS + (((size_t)tok * 8 + h) * 4) * 128 + ch * 8;
#pragma unroll
            for (int s4 = 0; s4 < 4; ++s4) pu[i][s4] = __builtin_nontemporal_load((const u32x2*)(pb + s4 * 128));
        }
#pragma unroll
        for (int i = 0; i < 2; ++i) {
            const int item = F.lane + 64 * i, h = item >> 4, ch = item & 15;
            const float m0 = ml01[i][0], l0 = ml01[i][1], m1 = ml01[i][2], l1 = ml01[i][3], m2 = ml23[i][0], l2 = ml23[i][1], m3 = ml23[i][2], l3 = ml23[i][3];
            const float M = fmaxf(fmaxf(m0, m1), fmaxf(m2, m3));
            const float w0 = l0 * fast_exp2(m0 - M), w1 = l1 * fast_exp2(m1 - M), w2 = l2 * fast_exp2(m2 - M), w3 = l3 * fast_exp2(m3 - M);
            const float inv = 1.0f / (w0 + w1 + w2 + w3);
            float acc[8];
#pragma unroll
            for (int j = 0; j < 8; ++j) acc[j] = 0.f;
            const float ws4[4] = {w0, w1, w2, w3};
#pragma unroll
            for (int s4 = 0; s4 < 4; ++s4) {
                const float w = ws4[s4]; u32x2 u = pu[i][s4];
                if (!(w > 0.f)) u = (u32x2){0u, 0u};
                { const f32x2 a = __builtin_amdgcn_cvt_pk_f32_fp8((int)u.x, false), b = __builtin_amdgcn_cvt_pk_f32_fp8((int)u.x, true), c = __builtin_amdgcn_cvt_pk_f32_fp8((int)u.y, false), d = __builtin_amdgcn_cvt_pk_f32_fp8((int)u.y, true);
                  acc[0] += w * a[0]; acc[1] += w * a[1]; acc[2] += w * b[0]; acc[3] += w * b[1]; acc[4] += w * c[0]; acc[5] += w * c[1]; acc[6] += w * d[0]; acc[7] += w * d[1]; }
            }
            if constexpr (O78F8) { const float i8 = inv * (F8_SAM / F8_SPART);
                *(u32x2*)((unsigned char*)AM + (size_t)tok * 1024 + h * 128 + ch * 8) = (u32x2){epi::pack4_f8(acc[0] * i8, acc[1] * i8, acc[2] * i8, acc[3] * i8), epi::pack4_f8(acc[4] * i8, acc[5] * i8, acc[6] * i8, acc[7] * i8)}; }
            else { u32x4 o; o.x = cvtpk(acc[0] * inv, acc[1] * inv); o.y = cvtpk(acc[2] * inv, acc[3] * inv); o.z = cvtpk(acc[4] * inv, acc[5] * inv); o.w = cvtpk(acc[6] * inv, acc[7] * inv);
            *(u32x4*)(AM + (size_t)tok * 1024 + h * 128 + ch * 8) = o; }
        }
    }
}
constexpr int P9_RSTD = 32768, P9_LG = 33792, P9_LGROW = 68, P9_LCNT = P9_LG + 2 * 64 * P9_LGROW * 4, P9_LBASE = P9_LCNT + 256, P9_END = P9_LBASE + 256;
static_assert(P9_END <= RING_BYTES, "P9 LDS");
__device__ __forceinline__ void p9_route(Ctx& F) {
    fill_mod_tables(F, F.in[I_GFFN], 6144, 8192, false);
    const LAS float* A2 = (const LAS float*)F.lds; const LAS float* B2 = (const LAS float*)(F.lds + 16384);
    LAS float* rstd_l = (LAS float*)(F.lds + P9_RSTD); LAS float* LG = (LAS float*)(F.lds + P9_LG);
    LAS int* lcnt = (LAS int*)(F.lds + P9_LCNT); LAS int* lbase = (LAS int*)(F.lds + P9_LBASE);
    const bf16_t* x1 = (const bf16_t*)(F.ws + WS_X1); bf16_t* H2 = (bf16_t*)(F.ws + WS_H2); unsigned char* H2F8 = F.ws + WS_H2F8;
    const bf16_t* WRH = (const bf16_t*)(F.ws + WS_WR); const bf16_t* WRL = WRH + 64 * 2048;
    const float* rbias = F.in[I_RBIAS];
    int* ELIST = (int*)(F.ws + WS_ELIST); int* TOKE = (int*)(F.ws + WS_TOKE); float* TOKW = (float*)(F.ws + WS_TOKW);
    unsigned* ecnt = F.ctl + CW_ECNT;
    for (int grp = F.blk; grp < T / 64; grp += F.G) {
        const int tokb = grp * 64, b = tokb / SEQ;
        if (F.tid < 64) lcnt[F.tid] = 0;
        for (int i = 0; i < 8; i += 4) {
            const int tl = F.wave * 8 + i;
            u32x4 va[4][4];
#pragma unroll
            for (int q = 0; q < 4; ++q) { const u32x4* xr = (const u32x4*)(x1 + (size_t)(tokb + tl + q) * 2048) + F.lane;
#pragma unroll
                for (int j = 0; j < 4; ++j) va[q][j] = xr[64 * j]; }
#pragma unroll
            for (int q = 0; q < 4; ++q) { float ss = 0.f;
#pragma unroll
                for (int j = 0; j < 4; ++j) { const u32x4 u = va[q][j];
                    const float a0 = bf_lo(u.x), a1 = bf_hi(u.x), a2 = bf_lo(u.y), a3 = bf_hi(u.y), a4 = bf_lo(u.z), a5 = bf_hi(u.z), a6 = bf_lo(u.w), a7 = bf_hi(u.w);
                    ss += ((a0 * a0 + a1 * a1) + (a2 * a2 + a3 * a3)) + ((a4 * a4 + a5 * a5) + (a6 * a6 + a7 * a7)); }
                ss = wave_sum(ss);
                if (F.lane == 0) rstd_l[tl + q] = 1.0f / sqrtf(ss * (1.0f / 2048.0f) + RMS_EPS); }
        }
        __syncthreads();
        {
            const int tg = F.wave & 3, kh = F.wave >> 2, tc = F.lane & 15, kg = F.lane >> 4;
            const int tl = 16 * tg + tc; const float rs = rstd_l[tl];
            const bf16_t* xrow = x1 + (size_t)(tokb + tl) * 2048;
            bf16_t* hrow = H2 + (size_t)(tokb + tl) * 2048;
            f32x4 acc[4];
#pragma unroll
            for (int nt = 0; nt < 4; ++nt) acc[nt] = (f32x4){0.f, 0.f, 0.f, 0.f};
#pragma unroll 2
            for (int s = 32 * kh; s < 32 * kh + 32; ++s) {
                const int c0 = 32 * s + 8 * kg;
                const u32x4 xu = *(const u32x4*)(xrow + c0);
                const f32x4 xa = {bf_lo(xu.x), bf_hi(xu.x), bf_lo(xu.y), bf_hi(xu.y)}, xb = {bf_lo(xu.z), bf_hi(xu.z), bf_lo(xu.w), bf_hi(xu.w)};
                const f32x4 aa = *(const LAS f32x4*)(A2 + b * 2048 + c0), ab = *(const LAS f32x4*)(A2 + b * 2048 + c0 + 4);
                const f32x4 ba = *(const LAS f32x4*)(B2 + b * 2048 + c0), bb = *(const LAS f32x4*)(B2 + b * 2048 + c0 + 4);
                const f32x4 ya = xa * rs * aa + ba, yb = xb * rs * ab + bb;
                u32x4 hi; hi.x = cvtpk(ya[0], ya[1]); hi.y = cvtpk(ya[2], ya[3]); hi.z = cvtpk(yb[0], yb[1]); hi.w = cvtpk(yb[2], yb[3]);
                *(u32x2*)(H2F8 + (size_t)(tokb + tl) * 2048 + c0) = (u32x2){epi::pack4_f8(ya[0] * F8_SH, ya[1] * F8_SH, ya[2] * F8_SH, ya[3] * F8_SH), epi::pack4_f8(yb[0] * F8_SH, yb[1] * F8_SH, yb[2] * F8_SH, yb[3] * F8_SH)};
                u32x4 lo; lo.x = cvtpk(ya[0] - bf_lo(hi.x), ya[1] - bf_hi(hi.x)); lo.y = cvtpk(ya[2] - bf_lo(hi.y), ya[3] - bf_hi(hi.y));
                lo.z = cvtpk(yb[0] - bf_lo(hi.z), yb[1] - bf_hi(hi.z)); lo.w = cvtpk(yb[2] - bf_lo(hi.w), yb[3] - bf_hi(hi.w));
                const bf16x8 hf = __builtin_bit_cast(bf16x8, hi), lf = __builtin_bit_cast(bf16x8, lo);
#pragma unroll
                for (int nt = 0; nt < 4; ++nt) {
                    const bf16x8 wh = *(const bf16x8*)(WRH + (size_t)(16 * nt + tc) * 2048 + c0), wl = *(const bf16x8*)(WRL + (size_t)(16 * nt + tc) * 2048 + c0);
                    acc[nt] = __builtin_amdgcn_mfma_f32_16x16x32_bf16(wh, hf, acc[nt], 0, 0, 0);
                    acc[nt] = __builtin_amdgcn_mfma_f32_16x16x32_bf16(wh, lf, acc[nt], 0, 0, 0);
                    acc[nt] = __builtin_amdgcn_mfma_f32_16x16x32_bf16(wl, hf, acc[nt], 0, 0, 0);
                }
            }
#pragma unroll
            for (int nt = 0; nt < 4; ++nt) *(LAS f32x4*)(LG + (kh * 64 + tl) * P9_LGROW + 16 * nt + 4 * kg) = acc[nt];
        }
        __syncthreads();
        int se[8], sslot[8]; float sw[8];
        if (F.tid < 64) {
            LAS float* row0 = LG + F.tid * P9_LGROW; const LAS float* row1 = LG + (64 + F.tid) * P9_LGROW;
            float sl[64];
#pragma unroll
            for (int e = 0; e < 64; ++e) { const float s = sigmoidf_(row0[e] + row1[e]); row0[e] = s; sl[e] = s + rbias[e]; }
            float gs[8];
#pragma unroll
            for (int g = 0; g < 8; ++g) { float m1 = -INFINITY, m2 = -INFINITY;
#pragma unroll
                for (int j = 0; j < 8; ++j) { const float v = sl[8 * g + j]; if (v > m1) { m2 = m1; m1 = v; } else if (v > m2) m2 = v; }
                gs[g] = m1 + m2; }
            unsigned gmask = 0u;
#pragma unroll
            for (int it = 0; it < 4; ++it) { float best = -INFINITY; int bi = 0;
#pragma unroll
                for (int g = 0; g < 8; ++g) { const bool free_ = !((gmask >> g) & 1u); if (free_ && gs[g] > best) { best = gs[g]; bi = g; } }
                gmask |= 1u << bi; }
            unsigned long long picked = 0ull; float wsum = 0.f;
#pragma unroll
            for (int it = 0; it < 8; ++it) { float best = -INFINITY; int bi = 0;
#pragma unroll
                for (int e = 0; e < 64; ++e) { const bool ok = ((gmask >> (e >> 3)) & 1u) && !((picked >> e) & 1ull); if (ok && sl[e] > best) { best = sl[e]; bi = e; } }
                picked |= 1ull << bi; se[it] = bi; const float s = row0[bi]; sw[it] = s; wsum += s; }
            const float inv = 2.5f / wsum;
#pragma unroll
            for (int k = 0; k < 8; ++k) { sw[k] *= inv; sslot[k] = __hip_atomic_fetch_add(lcnt + se[k], 1, __ATOMIC_RELAXED, __HIP_MEMORY_SCOPE_WORKGROUP); }
        }
        __syncthreads();
        if (F.tid < 64) { const int c = lcnt[F.tid]; lbase[F.tid] = c > 0 ? (int)__hip_atomic_fetch_add(ecnt + F.tid, (unsigned)c, RLX_AGENT) : 0; }
        __syncthreads();
        if (F.tid < 64) { const int tok = tokb + F.tid;
#pragma unroll
            for (int k = 0; k < 8; ++k) { const int slot = lbase[se[k]] + sslot[k];
                ELIST[(size_t)se[k] * 16384 + slot] = tok; TOKE[tok * 8 + k] = (se[k] << 16) | slot; TOKW[tok * 8 + k] = sw[k]; } }
        __syncthreads();
    }
}

constexpr int MT_CNT = 0, MT_TST = 256, MT_COFF = 768, MT_GTAB = 2048;
__device__ __forceinline__ void moe_tables(Ctx& F) {
    LAS int* cnt = (LAS int*)(F.lds + LDSX_OFF + MT_CNT); LAS int* tst = (LAS int*)(F.lds + LDSX_OFF + MT_TST); LAS int* coff = (LAS int*)(F.lds + LDSX_OFF + MT_COFF);
    if (F.tid < 64) cnt[F.tid] = (int)__hip_atomic_load(F.ctl + CW_ECNT + F.tid, RLX_AGENT);
    __syncthreads();
    if (F.tid == 0) { int t = 0, c = 0; for (int e = 0; e < 64; ++e) { tst[e] = t; coff[e] = c; const int n = cnt[e]; t += (n + 255) >> 8; c += n; } tst[64] = t; coff[64] = c; }
    __syncthreads();
}
struct MoeSched {
    const LAS int* cnt; const LAS int* tst; const LAS int* coff; int G, c, npn_log2; const char* A; const char* B; size_t a_tile_bytes, b_exp_bytes, b_tile_bytes; bool compact;
    __device__ __forceinline__ bool next(int i, pg8::Unit& u) const {
        const int ntile = tst[64];
        const long L = (long)i * G + c; if (L >= ((long)ntile << npn_log2)) return false;
        const int rt = (int)(L >> npn_log2), pn = (int)(L & ((1 << npn_log2) - 1));
        int lo = 0, hi = 64;
#pragma unroll
        for (int s = 0; s < 6; ++s) { const int mid = (lo + hi) >> 1; if (tst[mid] <= rt) lo = mid; else hi = mid; }
        int e = lo;
        e = __builtin_amdgcn_readfirstlane(e);
        const int j = rt - __builtin_amdgcn_readfirstlane(tst[e]);
        const int n = __builtin_amdgcn_readfirstlane(cnt[e]);
        u.pm = rt; u.pn = pn; u.aux = e;
        u.valid = (n - 256 * j) < 256 ? (n - 256 * j) : 256;
        u.rowbase = compact ? (__builtin_amdgcn_readfirstlane(coff[e]) + 256 * j) : rt * 256;
        u.A = A + (size_t)rt * a_tile_bytes; u.B = B + (size_t)e * b_exp_bytes + (size_t)pn * b_tile_bytes;
        return true;
    }
};

__device__ __forceinline__ void p12_combine(Ctx& F) {
    moe_tables(F);
    const LAS int* coff = (const LAS int*)(F.lds + LDSX_OFF + MT_COFF);
    const unsigned char* Y = (const unsigned char*)(F.ws + WS_Y); const int* TOKE = (const int*)(F.ws + WS_TOKE); const float* TOKW = (const float*)(F.ws + WS_TOKW);
    const float* modf = (const float*)(F.ws + WS_MOD); const float* gfin = F.in[I_GFINAL]; const bf16_t* SHOUT = (const bf16_t*)(F.ws + WS_SHOUT);
    float* out = F.out;
    const int gw = F.blk * 8 + F.wave, NGW = F.G * 8;
    for (int tok = gw; tok < T; tok += NGW) {
        const int b = tok / SEQ;
        f32x4 acc[8];
        int es8[8]; float w8[8];
#pragma unroll
        for (int k = 0; k < 8; ++k) { es8[k] = TOKE[tok * 8 + k]; w8[k] = TOKW[tok * 8 + k]; }
        f32x4* xr = (f32x4*)(out + (size_t)tok * 2048) + F.lane;
        f32x4 v[8];
        { const unsigned long long* x1r = (const unsigned long long*)((const bf16_t*)(F.ws + WS_X1) + (size_t)tok * 2048) + F.lane;
#pragma unroll
          for (int j = 0; j < 8; ++j) { const unsigned long long u = __builtin_nontemporal_load(x1r + 64 * j); const unsigned lo = (unsigned)u, hi = (unsigned)(u >> 32);
              v[j] = (f32x4){bf_lo(lo), bf_hi(lo), bf_lo(hi), bf_hi(hi)}; } }
        { const unsigned* sr = (const unsigned*)((const unsigned char*)SHOUT + (size_t)tok * 2048) + F.lane;
#pragma unroll
          for (int j = 0; j < 8; ++j) { const int u = (int)__builtin_nontemporal_load(sr + 64 * j); const f32x2 lo = __builtin_amdgcn_cvt_pk_f32_fp8(u, false), hi = __builtin_amdgcn_cvt_pk_f32_fp8(u, true);
              acc[j].x = lo[0]; acc[j].y = lo[1]; acc[j].z = hi[0]; acc[j].w = hi[1]; } }
#pragma unroll
        for (int kk = 0; kk < 8; kk += 4) {
            unsigned yu[4][8];
#pragma unroll
            for (int k = 0; k < 4; ++k) { const int e = es8[kk + k] >> 16, slot = es8[kk + k] & 0xffff;
                const unsigned* yr = (const unsigned*)(Y + (size_t)(coff[e] + slot) * 2048) + F.lane;
#pragma unroll
                for (int j = 0; j < 8; ++j) yu[k][j] = __builtin_nontemporal_load(yr + 64 * j); }
#pragma unroll
            for (int k = 0; k < 4; ++k) { const float w = w8[kk + k];
#pragma unroll
                for (int j = 0; j < 8; ++j) { const int u = (int)yu[k][j]; const f32x2 lo = __builtin_amdgcn_cvt_pk_f32_fp8(u, false), hi = __builtin_amdgcn_cvt_pk_f32_fp8(u, true);
                    acc[j].x += w * lo[0]; acc[j].y += w * lo[1]; acc[j].z += w * hi[0]; acc[j].w += w * hi[1]; } }
        }
        float ss = 0.f;
#pragma unroll
        for (int j = 0; j < 8; ++j) { const int c = 4 * F.lane + 256 * j; const f32x4 g2 = *(const f32x4*)(modf + b * 12288 + 10240 + c);
            v[j] = v[j] + g2 * acc[j]; ss += (v[j].x * v[j].x + v[j].y * v[j].y) + (v[j].z * v[j].z + v[j].w * v[j].w); }
        const float rstd = 1.0f / sqrtf(wave_sum(ss) * (1.0f / 2048.0f) + RMS_EPS);
#pragma unroll
        for (int j = 0; j < 8; ++j) { const int c = 4 * F.lane + 256 * j; const f32x4 g = *(const f32x4*)(gfin + c); __builtin_nontemporal_store(v[j] * rstd * g, xr + 64 * j); }
    }
}
struct Args { const float* in[22]; float* out; unsigned char* ws; int ph_lo, ph_hi; };
static_assert(sizeof(Args) == 22 * 8 + 8 + 8 + 8, "Args has no padding");

__global__ void __launch_bounds__(512, 2) fwd_kernel(Args args) {
    extern __shared__ __attribute__((aligned(16))) unsigned char lds_raw[];
    Ctx F;
    F.lds = (LAS unsigned char*)lds_raw;
    F.tid = threadIdx.x; F.lane = F.tid & 63; F.wave = __builtin_amdgcn_readfirstlane(F.tid >> 6);
    F.G = gridDim.x; F.blk = blockIdx.x;
    F.ws = args.ws; F.ctl = (unsigned*)(args.ws + WS_CTL); F.out = args.out;
    F.in = args.in;
    volatile LAS unsigned* MISC = (volatile LAS unsigned*)(F.lds + MISC_OFF);
    if (F.tid < 32) MISC[F.tid] = 0u;
    __syncthreads();
    XcdBarrier bar; bar.bar = F.ctl + CW_BAR; bar.x = 0; bar.st = nullptr;
    if (MK_N_LAUNCHES == 1) bar = xcd_barrier_post(F.ctl + CW_BAR, MISC + 8);
    const int lo = args.ph_lo, hi = args.ph_hi;
    unsigned char* ws = args.ws;
#define IN(k) (lo <= (k) && (k) < hi && ((PHASE_MASK >> (k)) & 1u))
#define SEAM(k) do { if (MK_N_LAUNCHES == 1 && (k) + 1 < hi) xcd_barrier(bar); } while (0)
#define NREP(k) (((REP_MASK >> (k)) & 1u) ? 2 : 1)
    typedef pg8::StaticOrder SO;

    if (lo <= 0 && 0 < hi) { if (IN(0)) { for (int rep_ = 0; rep_ < NREP(0); ++rep_) { if (rep_) xcd_barrier(bar); p0_prologue(F); } } SEAM(0); }
    if (lo <= 1 && 1 < hi) { if (IN(1)) { for (int rep_ = 0; rep_ < NREP(1); ++rep_) { if (rep_) xcd_barrier(bar); p1_norm(F); } } SEAM(1); }
    if (lo <= 2 && 2 < hi) {
        if (IN(2)) {
#pragma unroll 1
        for (int rep_ = 0; rep_ < NREP(2); ++rep_) { if (rep_) xcd_barrier(bar);
            const char* H = (const char*)(ws + WS_H); const char* W = (const char*)(ws + WS_W_IN_T);
            constexpr int KP = P2F8 ? 1024 : 2048;
            { SO S; S.init(H, W, T, 8192, KP, F.G, F.blk);
              epi::ProjEpi E{epi::StoreQK8{ws + WS_QD, ws + WS_KDT, att::D8_QS, att::D8_KS}, epi::StoreQKboth{epi::StoreQK{(bf16_t*)(ws + WS_QM), (bf16_t*)(ws + WS_KMT), 1.0f}, ws + WS_QM8, ws + WS_KMT8}, epi::StoreBf16<1>{(bf16_t*)(ws + WS_GATES), 4096}};
              pg8::gemm_phase<epi::ProjEpi, SO, true, true, false, P2F8>(F.lds, KP, S, E, nullptr); }
            { SO S; S.init(W + (size_t)8192 * KP * 2, H, 2048, T, KP, F.G, F.blk); epi::ProjVT E{epi::StoreVT8{ws + WS_VDT, att::D8_VS}, epi::StoreVT8{ws + WS_VMT8, att::D8_VS}};
              pg8::gemm_phase<epi::ProjVT, SO, true, true, false, P2F8>(F.lds, KP, S, E, nullptr); }
        }
        }
        SEAM(2);
    }
    if (lo <= 3 && 3 < hi) {
        if (IN(3)) {
#pragma unroll 1
        for (int rep_ = 0; rep_ < NREP(3); ++rep_) { if (rep_) xcd_barrier(bar);
            const float* lv = F.in[I_LAMBDA];
            float d1 = 0.f, d2 = 0.f;
            for (int i = 0; i < 64; ++i) { d1 += lv[i] * lv[64 + i]; d2 += lv[128 + i] * lv[192 + i]; }
            if (F.tid == 0) *(LAS float*)(F.lds + MISC_OFF + 68) = expf(d1) - expf(d2) + 0.2f;
            {
                const int x = (int)(xb_xcc_id() & 7u);
                const bool converter = ((F.blk >> 3) & 3) == 3;
                if (converter) { for (int c = queue_take(F, F.ctl + CW_CQ); c < CV_NCHUNK; c = queue_take(F, F.ctl + CW_CQ)) { __syncthreads(); convert_chunk(F, c); } }
#pragma unroll 1
                for (int k = 0; k < 8; ++k) {
                    const int xq = (x + k) & 7;
#pragma unroll 1
                    for (int i = queue_take(F, F.ctl + CW_AQ + 64 * xq); i < 128; i = queue_take(F, F.ctl + CW_AQ + 64 * xq)) {
                        const int bh = 2 * xq + (i & 1), qt = 63 - (i >> 1);
                        att::diff_unit8(F.lds, bh >> 3, bh & 7, qt, ws + WS_QD, ws + WS_KDT, ws + WS_VDT, (bf16_t*)(ws + WS_AD), F.in[I_SUBLN], F.in[I_RELB]);
                    }
                }
                for (int c = queue_take(F, F.ctl + CW_CQ); c < CV_NCHUNK; c = queue_take(F, F.ctl + CW_CQ)) { __syncthreads(); convert_chunk(F, c); }
            }
            __syncthreads();
            p3_kmean(F);
        }
        }
        SEAM(3);
    }
    if (lo <= 4 && 4 < hi) { if (IN(4)) p4_gating(F); SEAM(4); }
    if (lo <= 5 && 5 < hi) {
        if (IN(5)) {
#pragma unroll 1
        for (int rep_ = 0; rep_ < NREP(5); ++rep_) { if (rep_) xcd_barrier(bar);
            constexpr int MB_CPU = 2;
            LAS int* pre = (LAS int*)(F.lds + LDSX_OFF);
            const unsigned* mcnt = F.ctl + CW_MCNT;
            const int mycnt = (int)__hip_atomic_load(mcnt + F.tid, RLX_AGENT);
            pre[F.tid] = (1 + ((mycnt + 255) >> 8) + MB_CPU - 1) / MB_CPU;
            __syncthreads();
            int src = 0;
            for (int off = 1; off < 512; off <<= 1) { const int v = pre[src * 512 + F.tid] + (F.tid >= off ? pre[src * 512 + F.tid - off] : 0); pre[(src ^ 1) * 512 + F.tid] = v; src ^= 1; __syncthreads(); }
            LAS int* inc = (LAS int*)(F.lds + att::MB_INC);
            inc[F.tid] = pre[src * 512 + F.tid];
            __syncthreads();
            const int total = inc[511];
            for (int u = F.blk; u < total; u += F.G) {
                int lo_ = -1, hi_ = 511;
#pragma unroll
                for (int st = 0; st < 9; ++st) { const int mid = (lo_ + hi_) >> 1; if (inc[mid] > u) hi_ = mid; else lo_ = mid; }
                const int l = __builtin_amdgcn_readfirstlane(hi_);
                const int before = l > 0 ? __builtin_amdgcn_readfirstlane(inc[l - 1]) : 0;
                const int j = u - before;
                const int cntl = (int)__builtin_amdgcn_readfirstlane(__hip_atomic_load(mcnt + l, RLX_AGENT));
                const int nch = 1 + ((cntl + 255) >> 8);
                const int c0 = j * MB_CPU, c1 = (c0 + MB_CPU) < nch ? (c0 + MB_CPU) : nch;
                att::moba_block8(F.lds, l >> 8, (l >> 5) & 7, l & 31, (const int*)(ws + WS_MLIST) + (size_t)l * 8192, cntl, c0, c1, ws + WS_QM8, ws + WS_KMT8, ws + WS_VMT8, (bf16_t*)(ws + WS_PARTS), (float*)(ws + WS_ML), F.in[I_RELB]);
            }
            __syncthreads();
        }
        }
        SEAM(5);
    }
    if (lo <= 6 && 6 < hi) { if (IN(6)) { for (int rep_ = 0; rep_ < NREP(6); ++rep_) { if (rep_) xcd_barrier(bar); p6_merge(F); } } SEAM(6); }
    if (lo <= 7 && 7 < hi) {
        if (IN(7)) {
#pragma unroll 1
        for (int rep_ = 0; rep_ < NREP(7); ++rep_) { if (rep_) xcd_barrier(bar);
            { pg8::PairOrder S; S.init(ws + WS_AD, ws + WS_W_OD_T, ws + WS_AM, ws + WS_W_OM_T, T, 2048, O78F8 ? 512 : 1024, F.G, F.blk);
              epi::GatePair E{epi::GateMul<0>{(const bf16_t*)(ws + WS_GATES), 0, nullptr, (bf16_t*)(ws + WS_T1)}, epi::GateMul<1>{(const bf16_t*)(ws + WS_GATES), 2048, (const bf16_t*)(ws + WS_T1), (bf16_t*)(ws + WS_G)}};
              pg8::gemm_phase<epi::GatePair, pg8::PairOrder, true, true, false, O78F8>(F.lds, O78F8 ? 512 : 1024, S, E, nullptr); }
        }
        }
        SEAM(7);
    }
    if (lo <= 8 && 8 < hi) {
        if (IN(8)) {
#pragma unroll 1
        for (int rep_ = 0; rep_ < NREP(8); ++rep_) { if (rep_) xcd_barrier(bar);
            SO S; S.init(ws + WS_G, ws + WS_W_OUT_T, T, 2048, O78F8 ? 1024 : 2048, F.G, F.blk); epi::ResidBf16 E{F.in[I_X], (bf16_t*)(ws + WS_X1), (const float*)(ws + WS_MOD), 4096};
            pg8::gemm_phase<epi::ResidBf16, SO, true, true, false, O78F8>(F.lds, O78F8 ? 1024 : 2048, S, E, nullptr);
        }
        }
        SEAM(8);
    }
    if (lo <= 9 && 9 < hi) { if (IN(9)) p9_route(F); SEAM(9); }
    if (lo <= 10 && 10 < hi) {
        if (IN(10)) {
#pragma unroll 1
        for (int rep_ = 0; rep_ < NREP(10); ++rep_) { if (rep_) xcd_barrier(bar);
            moe_tables(F);
            MoeSched S{(const LAS int*)(F.lds + LDSX_OFF + MT_CNT), (const LAS int*)(F.lds + LDSX_OFF + MT_TST), (const LAS int*)(F.lds + LDSX_OFF + MT_COFF), F.G, F.blk, 2,
                       (const char*)(ws + WS_H2F8), (const char*)(ws + WS_W_EGU_T), 0, (size_t)1024 * 2048, (size_t)256 * 2048, false};
            LAS unsigned short* gtab = (LAS unsigned short*)(F.lds + LDSX_OFF + MT_GTAB);
            { const int* ELIST = (const int*)(ws + WS_ELIST); pg8::Unit u;
              for (int i = 0; i < 24 && S.next(i, u); ++i) { if (F.tid < 256) { const int j = u.pm - S.tst[u.aux]; gtab[i * 256 + F.tid] = (unsigned short)(F.tid < u.valid ? ELIST[(size_t)u.aux * 16384 + 256 * j + F.tid] : 0); } } }
            __syncthreads();
            { epi::SwiGLU8 E{ws + WS_ACT}; pg8::gemm_phase<epi::SwiGLU8, MoeSched, true, true, true, true>(F.lds, 1024, S, E, gtab); }
            { SO S2; S2.init(ws + WS_H2F8, ws + WS_W_SHGU_T, T, 1024, 1024, F.G, F.blk); epi::SwiGLU8 E{ws + WS_SHACT};
              pg8::gemm_phase<epi::SwiGLU8, SO, true, true, false, true>(F.lds, 1024, S2, E, nullptr); }
        }
        }
        SEAM(10);
    }
    if (lo <= 11 && 11 < hi) {
        if (IN(11)) {
            moe_tables(F);
            MoeSched S{(const LAS int*)(F.lds + LDSX_OFF + MT_CNT), (const LAS int*)(F.lds + LDSX_OFF + MT_TST), (const LAS int*)(F.lds + LDSX_OFF + MT_COFF), F.G, F.blk, 3,
                       (const char*)(ws + WS_ACT), (const char*)(ws + WS_W_ED_T), (size_t)256 * 512, (size_t)2048 * 512, (size_t)256 * 512, true};
#pragma unroll 1
            for (int rep_ = 0; rep_ < NREP(11); ++rep_) { if (rep_) xcd_barrier(bar);
            { epi::DownY E{(unsigned char*)(ws + WS_Y)}; pg8::gemm_phase<epi::DownY, MoeSched, true, true, false, true>(F.lds, 256, S, E, nullptr); } }
            { SO S2; S2.init(ws + WS_SHACT, ws + WS_W_SHD_T, T, 2048, 256, F.G, F.blk); epi::DownShared8 E{ws + WS_SHOUT};
              pg8::gemm_phase<epi::DownShared8, SO, true, true, false, true>(F.lds, 256, S2, E, nullptr); }
        }
        SEAM(11);
    }
    if (lo <= 12 && 12 < hi) { if (IN(12)) p12_combine(F); }
#undef IN
#undef SEAM
}

extern "C" void kernel_launch(void* const* d_in, const int* in_sizes, int n_in, void* d_out, int out_size, void* d_ws, size_t ws_size, hipStream_t stream) {
    static int grid = 0;
    if (grid == 0) {
        if (n_in != 22 || in_sizes[0] != T * D || out_size != T * D || ws_size < WS_END) { fprintf(stderr, "kernel_launch: unexpected shapes (n_in %d, in0 %d, out %d, ws %zu < %zu); nothing launched\n", n_in, n_in > 0 ? in_sizes[0] : -1, out_size, ws_size, (size_t)WS_END); grid = -1; return; }
        int dev = 0, cus = 0, per_cu = 0;
        if (hipGetDevice(&dev) != hipSuccess || hipDeviceGetAttribute(&cus, hipDeviceAttributeMultiprocessorCount, dev) != hipSuccess) { grid = -1; return; }
        if (hipFuncSetAttribute((const void*)fwd_kernel, hipFuncAttributeMaxDynamicSharedMemorySize, LDS_BYTES) != hipSuccess) { fprintf(stderr, "kernel_launch: hipFuncSetAttribute failed\n"); grid = -1; return; }
        if (hipOccupancyMaxActiveBlocksPerMultiprocessor(&per_cu, (const void*)fwd_kernel, 512, LDS_BYTES) != hipSuccess || per_cu < 1) fprintf(stderr, "kernel_launch: occupancy query says %d\n", per_cu);
        (void)hipGetLastError();
        grid = cus;
    }
    if (grid < 0) return;
    if (hipMemsetAsync((char*)d_ws + WS_CTL, 0, CTL_ZERO_BYTES, stream) != hipSuccess) { fprintf(stderr, "kernel_launch: memset failed\n"); return; }
    Args a{};
    for (int i = 0; i < 22; ++i) a.in[i] = (const float*)d_in[i];
    a.out = (float*)d_out; a.ws = (unsigned char*)d_ws;
    for (int li = 0; li < MK_N_LAUNCHES; ++li) {
        a.ph_lo = (MK_N_LAUNCHES == 1) ? 0 : li; a.ph_hi = (MK_N_LAUNCHES == 1) ? NPHASE : li + 1;
        hipLaunchKernelGGL(fwd_kernel, dim3(grid), dim3(512), LDS_BYTES, stream, a);
        const hipError_t le = hipPeekAtLastError();
        if (le != hipSuccess) { fprintf(stderr, "kernel_launch: launch %d failed: %s\n", li, hipGetErrorName(le)); break; }
    }
}
```

```cpp
#include <hip/hip_runtime.h>
#include <cstdio>
#include <cstdint>

#define LAS __attribute__((address_space(3)))
#define GAS __attribute__((address_space(1)))
typedef unsigned short bf16_t;
typedef short bf16x8 __attribute__((ext_vector_type(8)));
typedef short s16x4 __attribute__((ext_vector_type(4)));
typedef int i32x4 __attribute__((ext_vector_type(4)));
typedef int i32x8 __attribute__((ext_vector_type(8)));
typedef float f32x4 __attribute__((ext_vector_type(4)));
typedef float f32x2 __attribute__((ext_vector_type(2)));
typedef float f32x16 __attribute__((ext_vector_type(16)));
typedef unsigned u32x4 __attribute__((ext_vector_type(4)));
typedef unsigned u32x2 __attribute__((ext_vector_type(2)));
typedef __bf16 bf16x2_t __attribute__((ext_vector_type(2)));

#ifndef MK_N_LAUNCHES
#define MK_N_LAUNCHES 1
#endif
#ifndef REP_MASK
#define REP_MASK 0u
#endif
#ifndef PHASE_MASK
#define PHASE_MASK 0xFFFFFFFFu
#endif

constexpr int NB = 2, SEQ = 8192, T = NB * SEQ, D = 2048, NH = 8, INC = 10240, NE = 64, EDIM = 512, TOPK = 8;
constexpr int NPHASE = 13;
constexpr float RMS_EPS = 1e-6f;
constexpr float LOG2E = 1.4426950408889634f;

constexpr size_t MiB = 1u << 20;
constexpr size_t WS_CTL = 0, CTL_ZERO_BYTES = 1 * MiB;
constexpr size_t WS_MODP = 1 * MiB;
constexpr size_t WS_MOD = 4 * MiB;
constexpr size_t WS_KMEAN = 4 * MiB + 256 * 1024;
constexpr size_t WS_WR = 4 * MiB + 512 * 1024;
constexpr size_t WS_TOKE = 5 * MiB;
constexpr size_t WS_TOKW = 5 * MiB + 512 * 1024;
constexpr size_t WS_W_IN_T = 8 * MiB;
constexpr size_t WS_W_OD_T = 48 * MiB;
constexpr size_t WS_W_OM_T = 52 * MiB;
constexpr size_t WS_W_OUT_T = 56 * MiB;
constexpr size_t WS_W_SHGU_T = 64 * MiB;
constexpr size_t WS_W_SHD_T = 68 * MiB;
constexpr size_t WS_ELIST = 70 * MiB;
constexpr size_t WS_W_ED_T = 76 * MiB;
constexpr size_t WS_W_EGU_T = 204 * MiB;
constexpr size_t WS_H = 460 * MiB;
constexpr size_t WS_QD = 524 * MiB;
constexpr size_t WS_KDT = 556 * MiB;
constexpr size_t WS_VDT = 588 * MiB;
constexpr size_t WS_QM = 620 * MiB;
constexpr size_t WS_KMT = 652 * MiB;
constexpr size_t WS_VMT = 684 * MiB;
constexpr size_t WS_GATES = 716 * MiB;
constexpr size_t WS_AD = 844 * MiB;
constexpr size_t WS_AM = 876 * MiB;
constexpr size_t WS_ML = 908 * MiB;
constexpr size_t WS_MLIST = 912 * MiB;
constexpr size_t WS_PARTS = 460 * MiB;
constexpr size_t WS_G = 460 * MiB;
constexpr size_t WS_T1 = 524 * MiB;
constexpr size_t WS_X1 = 524 * MiB;
constexpr size_t WS_H2 = 588 * MiB;
constexpr size_t WS_ACT = 716 * MiB;
constexpr size_t WS_H2F8 = 800 * MiB;
constexpr float F8_SH = 8.0f, F8_SW = 64.0f, F8_SA = 8.0f, F8_SD = 32.0f;
namespace att { constexpr float D8_QS = 0.125f * LOG2E * 16.0f, D8_KS = 4.0f, D8_VS = 8.0f; }
constexpr size_t WS_QM8 = 604 * MiB, WS_VMT8 = 684 * MiB, WS_KMT8 = 700 * MiB;
namespace att { constexpr float MB8_QS = 0.08838834764831845f * LOG2E * 16.0f; }
constexpr float F8_SPART = 16.0f;
constexpr float F8_SGATE = 256.0f;
constexpr bool O78F8 = true;
constexpr float F8_SAD = 16.0f, F8_SAM = 64.0f, F8_SWO = 32.0f, F8_SG = 16.0f, F8_SWOUT = 64.0f;
constexpr bool P2F8 = true;
constexpr float DS2 = 1.0f;
constexpr int P2_EXP = 9;
constexpr size_t WS_SHACT = 860 * MiB;
constexpr size_t WS_SHOUT = 588 * MiB;
constexpr size_t WS_Y = 204 * MiB;
constexpr size_t WS_END = 928 * MiB;
static_assert(WS_Y + (size_t)131072 * 2048 * 2 <= WS_ACT, "Y must not reach ACT");
static_assert(WS_ACT + (size_t)147456 * 512 * 2 <= WS_SHACT && WS_SHACT + (size_t)T * 512 * 2 <= WS_END, "act map");
static_assert(WS_PARTS + (size_t)T * 8 * 4 * 128 * 2 <= WS_VDT, "parts overlay");

constexpr int CW_BAR = 4096;
constexpr int CW_ECNT = 8192;
constexpr int CW_MCNT = 8448;
constexpr int CW_AQ = 9216;
constexpr int CW_CQ = 9216 + 64 * 8;

constexpr int RING_BYTES = 131072;
constexpr int LDSX_OFF = RING_BYTES;
constexpr int MISC_OFF = RING_BYTES + 16384;
constexpr int LDS_BYTES = MISC_OFF + 128;

#define LDS_WAIT() asm volatile("s_waitcnt lgkmcnt(0)" ::: "memory")
#define VM_WAIT() asm volatile("s_waitcnt vmcnt(0)" ::: "memory")
#define RLX_AGENT __ATOMIC_RELAXED, __HIP_MEMORY_SCOPE_AGENT

__device__ __forceinline__ unsigned cvtpk(float lo, float hi) { f32x2 v = {lo, hi}; bf16x2_t b = __builtin_convertvector(v, bf16x2_t); return __builtin_bit_cast(unsigned, b); }
__device__ __forceinline__ float bf_lo(unsigned u) { return __uint_as_float(u << 16); }
__device__ __forceinline__ float bf_hi(unsigned u) { return __uint_as_float(u & 0xffff0000u); }
__device__ __forceinline__ float wave_sum(float v) {
#pragma unroll
    for (int o = 1; o < 64; o <<= 1) v += __shfl_xor(v, o);
    return v;
}
__device__ __forceinline__ float fast_exp2(float x) { return __builtin_amdgcn_exp2f(x); }
__device__ __forceinline__ float fast_rcp(float x) { return __builtin_amdgcn_rcpf(x); }
__device__ __forceinline__ float sigmoidf_(float x) { return fast_rcp(1.0f + fast_exp2(-x * LOG2E)); }
__device__ __forceinline__ float siluf_(float x) { return x * sigmoidf_(x); }

#define XB_TMO      128
#define XB_XCNT(j)  (256  + 64 * (j))
#define XB_XSUB(j)  (1280 + 64 * (j))
#define XB_XGEN(j)  (2304 + 64 * (j))
#define XB_TOP      3328
#define XB_TOPGEN   3392
#define XCD_BAR_WORDS 3456
#define XB_SPIN_CAP (1u << 22)

__device__ __forceinline__ unsigned xb_ld(unsigned* p)              { return __hip_atomic_load(p, __ATOMIC_RELAXED, __HIP_MEMORY_SCOPE_AGENT); }
__device__ __forceinline__ unsigned xb_add(unsigned* p, unsigned v) { return __hip_atomic_fetch_add(p, v, __ATOMIC_RELAXED, __HIP_MEMORY_SCOPE_AGENT); }
__device__ __forceinline__ unsigned xb_xcc_id() { return (unsigned)__builtin_amdgcn_s_getreg((3 << 11) | 20) & 0xFu; }
#define XB_SPIN(cond, bar) do { unsigned _sp = 0; while (cond) { __builtin_amdgcn_s_sleep(1); \
    if ((++_sp & 255u) == 0u) { if (xb_ld(&(bar)[XB_TMO])) break; if (_sp > XB_SPIN_CAP) { atomicAdd(&(bar)[XB_TMO], 1u); break; } } } } while (0)

struct XcdBarrier { unsigned* bar; unsigned x; volatile LAS unsigned* st; };

__device__ __forceinline__ XcdBarrier xcd_barrier_post(unsigned* bar, volatile LAS unsigned* st) {
    XcdBarrier b; b.bar = bar; b.x = xb_xcc_id(); b.st = st;
    if (threadIdx.x == 0) (void)xb_add(&bar[XB_XCNT(b.x)], 1u);
    return b;
}
__device__ __forceinline__ void xcd_barrier_complete(unsigned* bar, unsigned x, unsigned& nloc, unsigned& nx) {
    const unsigned G = gridDim.x * gridDim.y * gridDim.z;
    unsigned sum, cnt, mine, sp = 0u;
    for (;;) {
        sum = 0u; cnt = 0u; mine = 0u;
#pragma unroll
        for (unsigned j = 0; j < 16; ++j) { const unsigned c = xb_ld(&bar[XB_XCNT(j)]); sum += c; cnt += (c > 0u) ? 1u : 0u; mine = (j == x) ? c : mine; }
        if (sum == G) break;
        __builtin_amdgcn_s_sleep(1);
        if ((++sp & 255u) == 0u) { if (xb_ld(&bar[XB_TMO])) break; if (sp > XB_SPIN_CAP) { atomicAdd(&bar[XB_TMO], 1u); break; } }
    }
    nloc = mine > 0u ? mine : 1u; nx = cnt > 0u ? cnt : 1u;
}
__device__ __forceinline__ void xcd_barrier(const XcdBarrier& b) {
    asm volatile("s_waitcnt vmcnt(0)" ::: "memory");
    __syncthreads();
    if (threadIdx.x == 0) {
        unsigned* bar = b.bar;
        __builtin_amdgcn_s_waitcnt(0);
        unsigned nloc = b.st[0], nx = b.st[1];
        if (nloc == 0u) { xcd_barrier_complete(bar, b.x, nloc, nx); b.st[0] = nloc; b.st[1] = nx; }
        const unsigned old = xb_add(&bar[XB_XSUB(b.x)], 1u);
        const unsigned gen = old / nloc;
        if (old + 1u == (gen + 1u) * nloc) {
            __builtin_amdgcn_fence(__ATOMIC_RELEASE, "agent");
            asm volatile("s_waitcnt vmcnt(0)" ::: "memory");
            const unsigned og = xb_add(&bar[XB_TOP], 1u);
            const unsigned tg = og / nx;
            if (og + 1u == (tg + 1u) * nx) xb_add(&bar[XB_TOPGEN], 1u);
            else XB_SPIN(xb_ld(&bar[XB_TOPGEN]) == tg, bar);
            __builtin_amdgcn_fence(__ATOMIC_ACQUIRE, "agent");
            xb_add(&bar[XB_XGEN(b.x)], 1u);
            asm volatile("s_waitcnt vmcnt(0)" ::: "memory");
        } else {
            XB_SPIN(xb_ld(&bar[XB_XGEN(b.x)]) == gen, bar);
            __builtin_amdgcn_fence(__ATOMIC_ACQUIRE, "agent");
            asm volatile("s_waitcnt vmcnt(0)" ::: "memory");
        }
    }
    __syncthreads();
}

namespace pg8 {
constexpr int BM = 256, BK = 64, HALF = 128, HTB = HALF * BK * 2, STAGE_BYTES = 8 * HTB, NXCD = 8, WGM = 8;
static_assert(STAGE_BYTES == RING_BYTES, "ring");
__host__ __device__ __forceinline__ int lds_byte(int r, int c) { const int st = (r >> 4) * 2 + (c >> 5), rr = r & 15, cc = c & 31, ob = rr * 64 + cc * 2; return st * 1024 + (ob ^ (((ob >> 9) & 1) << 5)); }
__host__ __device__ __forceinline__ void stage_rc(int b, int& R, int& C) { const int st = b / 1024, sb = b % 1024, swz = sb ^ (((sb >> 9) & 1) << 5); R = (st >> 1) * 16 + swz / 64; C = (st & 1) * 32 + (swz % 64) / 2; }
__host__ __device__ __forceinline__ int perm32(int rho) { const int n = rho >> 4, i = rho & 15; return 8 * (i >> 2) + 4 * n + (i & 3); }

struct Unit { int pm, pn; const char* A; const char* B; int rowbase, valid, aux; };

struct StaticOrder {
    int nM, nN, nwg, G, c; const char* A; const char* B; size_t tstep;
    __device__ void init(const void* A_, const void* B_, int M, int N, int K, int G_, int c_) { A = (const char*)A_; B = (const char*)B_; nM = M / BM; nN = N / BM; nwg = nM * nN; G = G_; c = c_; tstep = (size_t)BM * K * 2; }
    __device__ bool next(int i, Unit& u) const {
        const long L = (long)i * G + c; if (L >= nwg) return false;
        int wgid = (int)L; { const int q = nwg / NXCD, r = nwg % NXCD, xcd = wgid % NXCD, off = wgid / NXCD; wgid = (xcd < r ? xcd * (q + 1) : r * (q + 1) + (xcd - r) * q) + off; }
        const int nig = WGM * nN, gid = wgid / nig, fm = gid * WGM, gsz = (nM - fm) < WGM ? (nM - fm) : WGM;
        u.pm = fm + ((wgid % nig) % gsz); u.pn = (wgid % nig) / gsz;
        u.A = A + (size_t)u.pm * tstep; u.B = B + (size_t)u.pn * tstep; u.rowbase = u.pm * BM; u.valid = BM; u.aux = 0; return true;
    }
};

struct PairOrder {
    StaticOrder base; const char* A1; const char* B1;
    __device__ void init(const void* A0_, const void* B0_, const void* A1_, const void* B1_, int M, int N, int K, int G_, int c_) { base.init(A0_, B0_, M, N, K, G_, c_); A1 = (const char*)A1_; B1 = (const char*)B1_; }
    __device__ bool next(int i, Unit& u) const {
        if (!base.next(i >> 1, u)) return false;
        if (i & 1) { u.A = A1 + (size_t)u.pm * base.tstep; u.B = B1 + (size_t)u.pn * base.tstep; u.aux = 1; }
        return true;
    }
};

template <class Epi, class Sched, bool ALIGN_EPI, bool SP2, bool GATHER, bool F8 = false>
__device__ __forceinline__ void gemm_phase(LAS unsigned char* lds, const int K, const Sched& S, const Epi& E, const LAS unsigned short* gtab) {
    int tid_ = threadIdx.x; asm volatile("" : "+v"(tid_));
    const int tid = tid_, wid = __builtin_amdgcn_readfirstlane(tid >> 6), lane = tid & 63, wr = wid >> 2, wc = wid & 3, fr = lane & 15, fq = lane >> 4;
    const int nt = K / BK;
    unsigned voffA[2], voffB[2]; int RA[2], CA[2];
#pragma unroll
    for (int i = 0; i < 2; ++i) { int R, C; stage_rc(tid * 16 + i * 8192, R, C); const int Rb = (int)Epi::PERM == 2 ? (64 * (R >> 5) + 16 * ((R >> 2) & 3) + 4 * ((R >> 4) & 1) + (R & 3)) : (Epi::PERM ? ((R & ~31) + perm32(R & 31)) : R);
        RA[i] = R; CA[i] = C; voffA[i] = (unsigned)(R * K + C) * 2u; voffB[i] = (unsigned)(Rb * K + C) * 2u; }
    const size_t kstep = (size_t)(BK * 2);
    const size_t hstep = (size_t)HALF * K * 2;
    const size_t hstepB = (int)Epi::PERM == 2 ? (size_t)8 * K * 2 : hstep;
    const unsigned ldsw = (unsigned)wid * 1024u;
    const int aoff = lds_byte(wr * 64 + fr, fq * 8), boff = lds_byte(wc * 32 + fr, fq * 8);
    unsigned vA[2][2], nvA[2][2];
#define PG8_SA(b, h) (((b) * 2 + (h)) * HTB)
#define PG8_SB(b, h) ((4 + (b) * 2 + (h)) * HTB)
#define PG8_GL(gp, ldsoff) __builtin_amdgcn_global_load_lds((const unsigned*)(gp), (LAS unsigned*)(lds + (ldsoff)), 16, 0, 0)
#define PG8_STAGE(bufoff, gbase, voff) do { _Pragma("unroll") for (int _i = 0; _i < 2; ++_i) PG8_GL((const char*)(gbase) + (voff)[_i], (bufoff) + ldsw + _i * 8192); } while (0)
#define PG8_STA(bufoff, gbase, h, nx) do { if constexpr (GATHER) { \
        const unsigned _o0 = (nx) ? nvA[h][0] : vA[h][0], _o1 = (nx) ? nvA[h][1] : vA[h][1]; \
        PG8_GL((const char*)(gbase) + _o0, (bufoff) + ldsw); PG8_GL((const char*)(gbase) + _o1, (bufoff) + ldsw + 8192); \
    } else { PG8_STAGE(bufoff, (const char*)(gbase) + (h) * hstep, voffA); } } while (0)
#define PG8_GVA(dst, ul) do { _Pragma("unroll") for (int _h = 0; _h < 2; ++_h) _Pragma("unroll") for (int _i = 0; _i < 2; ++_i) \
        dst[_h][_i] = (unsigned)gtab[(ul) * 256 + _h * 128 + RA[_i]] * (unsigned)(K * 2) + (unsigned)(CA[_i] * 2); } while (0)
#define PG8_LDA(dst, b, h) do { _Pragma("unroll") for (int m = 0; m < 4; ++m) _Pragma("unroll") for (int k = 0; k < 2; ++k) dst[m][k] = *(const LAS bf16x8*)(lds + PG8_SA(b, h) + aoff + m * 2048 + k * 1024); } while (0)
#define PG8_LDB(dst, b, h) do { _Pragma("unroll") for (int n = 0; n < 2; ++n) _Pragma("unroll") for (int k = 0; k < 2; ++k) dst[n][k] = *(const LAS bf16x8*)(lds + PG8_SB(b, h) + boff + n * 2048 + k * 1024); } while (0)
#define PG8_MMA(ai, bj, At, Bt) do { __builtin_amdgcn_s_setprio(1); _Pragma("unroll") for (int m = 0; m < 4; ++m) _Pragma("unroll") for (int n = 0; n < 2; ++n) { \
        if constexpr (F8) { const i32x4 _b0 = __builtin_bit_cast(i32x4, Bt[n][0]), _b1 = __builtin_bit_cast(i32x4, Bt[n][1]), _a0 = __builtin_bit_cast(i32x4, At[m][0]), _a1 = __builtin_bit_cast(i32x4, At[m][1]); \
            const i32x8 _b8 = __builtin_shufflevector(_b0, _b1, 0, 1, 2, 3, 4, 5, 6, 7), _a8 = __builtin_shufflevector(_a0, _a1, 0, 1, 2, 3, 4, 5, 6, 7); \
            asm volatile("v_mfma_scale_f32_16x16x128_f8f6f4 %0, %1, %2, %0, %3, %4 op_sel_hi:[0,0,0]" : "+v"(acc[ai][bj][m][n]) : "v"(_b8), "v"(_a8), "v"(f8sc), "v"(f8one)); } \
        else { _Pragma("unroll") for (int k = 0; k < 2; ++k) acc[ai][bj][m][n] = __builtin_amdgcn_mfma_f32_16x16x32_bf16(Bt[n][k], At[m][k], acc[ai][bj][m][n], 0, 0, 0); } } __builtin_amdgcn_s_setprio(0); } while (0)
#define PG8_WAIT_V(n) asm volatile("s_waitcnt vmcnt(" #n ")" ::: "memory")
#define PG8_WAIT_L(n) asm volatile("s_waitcnt lgkmcnt(" #n ")" ::: "memory")
#define PG8_BAR __builtin_amdgcn_s_barrier()
#define PG8_SCHED __builtin_amdgcn_sched_barrier(0)
    Unit cur, nxt; int ui = 0;
    if (!S.next(0, cur)) return;
    if constexpr (GATHER) { PG8_GVA(vA, 0); }
    int f8sc = 0x7F7F7F7F;
    const int f8one = 0x7F7F7F7F;
    f32x4 acc[2][2][4][2];
#pragma unroll
    for (int a = 0; a < 2; ++a)
#pragma unroll
        for (int b = 0; b < 2; ++b)
#pragma unroll
            for (int m = 0; m < 4; ++m)
#pragma unroll
                for (int n = 0; n < 2; ++n) acc[a][b][m][n] = (f32x4){0.f, 0.f, 0.f, 0.f};
    bf16x8 At[4][2], B0[2][2], B1[2][2];
    const char* cA = cur.A; const char* cB = cur.B;
    if constexpr (SP2) {
        PG8_STAGE(PG8_SB(0, 0), cB, voffB); PG8_STAGE(PG8_SB(0, 1), cB + hstepB, voffB); PG8_STA(PG8_SA(0, 0), cA, 0, false); PG8_STA(PG8_SA(0, 1), cA, 1, false);
        if (wr == 1) PG8_BAR;
        PG8_WAIT_V(2); PG8_BAR;
        PG8_STAGE(PG8_SB(1, 0), cB + kstep, voffB); PG8_STA(PG8_SA(1, 0), cA + kstep, 0, false); PG8_STAGE(PG8_SB(1, 1), cB + hstepB + kstep, voffB);
        PG8_WAIT_V(6); PG8_BAR;
    } else {
        PG8_STAGE(PG8_SB(0, 0), cB, voffB); PG8_STA(PG8_SA(0, 0), cA, 0, false); PG8_STAGE(PG8_SB(0, 1), cB + hstepB, voffB); PG8_STA(PG8_SA(0, 1), cA, 1, false);
        if (wr == 1) PG8_BAR;
        PG8_WAIT_V(4); PG8_BAR;
        PG8_STAGE(PG8_SB(1, 0), cB + kstep, voffB); PG8_STA(PG8_SA(1, 0), cA + kstep, 0, false); PG8_STAGE(PG8_SB(1, 1), cB + hstepB + kstep, voffB);
        PG8_WAIT_V(6); PG8_BAR;
    }
    for (;;) {
        if constexpr (F8) f8sc = 0x01010101 * (127 - E.f8exp(cur));
        bool has_next = false; const char* nA = cA; const char* nB = cB;
#define PG8_NEXT_UNIT() do { has_next = S.next(ui + 1, nxt); nA = has_next ? nxt.A : cA; nB = has_next ? nxt.B : cB; \
        if constexpr (GATHER) { if (has_next) { PG8_GVA(nvA, ui + 1); } else { _Pragma("unroll") for (int _h = 0; _h < 2; ++_h) _Pragma("unroll") for (int _i = 0; _i < 2; ++_i) nvA[_h][_i] = vA[_h][_i]; } } } while (0)
        if (nt < 4 || !SP2) PG8_NEXT_UNIT();
        for (int t = 0; t < nt; t += 2) {
            const bool last = (t == nt - 2);
            const char* a1 = cA + (size_t)(t + 1) * kstep;
            const char* a2 = last ? nA : cA + (size_t)(t + 2) * kstep; const char* b2 = last ? nB : cB + (size_t)(t + 2) * kstep;
            const char* a3 = a2 + kstep; const char* b3 = b2 + kstep;
            if constexpr (SP2) {
            PG8_LDB(B0, 0, 0); PG8_LDB(B1, 0, 1); PG8_SCHED; PG8_LDA(At, 0, 0); PG8_STA(PG8_SA(1, 1), a1, 1, false);
            PG8_WAIT_V(8); PG8_WAIT_L(0); PG8_BAR; PG8_MMA(0, 0, At, B0); PG8_MMA(0, 1, At, B1); if (t == 0 && nt >= 4) { PG8_SCHED; PG8_NEXT_UNIT(); PG8_SCHED; } PG8_BAR; PG8_SCHED;
            PG8_LDA(At, 0, 1); PG8_STAGE(PG8_SB(0, 0), b2, voffB); PG8_STAGE(PG8_SB(0, 1), b2 + hstepB, voffB); PG8_STA(PG8_SA(0, 0), a2, 0, last);
            PG8_WAIT_V(8); PG8_WAIT_L(0); PG8_BAR; PG8_MMA(1, 0, At, B0); PG8_MMA(1, 1, At, B1); PG8_BAR; PG8_SCHED;
            PG8_LDB(B0, 1, 0); PG8_LDB(B1, 1, 1); PG8_SCHED; PG8_LDA(At, 1, 0); PG8_STA(PG8_SA(0, 1), a2, 1, last);
            PG8_WAIT_V(8); PG8_WAIT_L(0); PG8_BAR; PG8_MMA(0, 0, At, B0); PG8_MMA(0, 1, At, B1); PG8_BAR; PG8_SCHED;
            PG8_LDA(At, 1, 1); PG8_STAGE(PG8_SB(1, 0), b3, voffB); PG8_STAGE(PG8_SB(1, 1), b3 + hstepB, voffB); PG8_STA(PG8_SA(1, 0), a3, 0, last);
            PG8_WAIT_V(8); PG8_WAIT_L(0); PG8_BAR; PG8_MMA(1, 0, At, B0); PG8_MMA(1, 1, At, B1); PG8_BAR; PG8_SCHED;
            } else {
            PG8_LDB(B0, 0, 0); PG8_SCHED; PG8_LDA(At, 0, 0); PG8_STA(PG8_SA(1, 1), a1, 1, false);
            PG8_WAIT_L(8); PG8_BAR; PG8_WAIT_L(0); PG8_MMA(0, 0, At, B0); PG8_BAR; PG8_SCHED;
            PG8_LDB(B1, 0, 1); PG8_STAGE(PG8_SB(0, 0), b2, voffB);
            PG8_BAR; PG8_WAIT_L(0); PG8_MMA(0, 1, At, B1); PG8_BAR;
            PG8_LDA(At, 0, 1); PG8_STA(PG8_SA(0, 0), a2, 0, last);
            PG8_BAR; PG8_WAIT_L(0); PG8_MMA(1, 0, At, B0); PG8_BAR; PG8_SCHED;
            PG8_STAGE(PG8_SB(0, 1), b2 + hstepB, voffB);
            PG8_WAIT_V(6); PG8_BAR; PG8_MMA(1, 1, At, B1); PG8_BAR;
            PG8_LDB(B0, 1, 0); PG8_SCHED; PG8_LDA(At, 1, 0); PG8_STA(PG8_SA(0, 1), a2, 1, last);
            PG8_WAIT_L(8); PG8_BAR; PG8_WAIT_L(0); PG8_MMA(0, 0, At, B0); PG8_BAR; PG8_SCHED;
            PG8_LDB(B1, 1, 1); PG8_STAGE(PG8_SB(1, 0), b3, voffB);
            PG8_BAR; PG8_WAIT_L(0); PG8_MMA(0, 1, At, B1); PG8_BAR;
            PG8_LDA(At, 1, 1); PG8_STA(PG8_SA(1, 0), a3, 0, last);
            PG8_BAR; PG8_WAIT_L(0); PG8_MMA(1, 0, At, B0); PG8_BAR; PG8_SCHED;
            PG8_STAGE(PG8_SB(1, 1), b3 + hstepB, voffB);
            PG8_WAIT_V(6); PG8_BAR; PG8_MMA(1, 1, At, B1); PG8_BAR;
            }
        }
        if constexpr (F8) asm volatile("s_nop 15\n\ts_nop 15" ::: "memory");
        if constexpr (ALIGN_EPI) { if (wr == 0) PG8_BAR; }
        { int l2 = lane; asm volatile("" : "+v"(l2)); E(acc, cur, wr, wc, l2 & 15, l2 >> 4); }
        if (!has_next) break;
#pragma unroll
        for (int a = 0; a < 2; ++a)
#pragma unroll
            for (int b = 0; b < 2; ++b)
#pragma unroll
                for (int m = 0; m < 4; ++m)
#pragma unroll
                    for (int n = 0; n < 2; ++n) acc[a][b][m][n] = (f32x4){0.f, 0.f, 0.f, 0.f};
        cur = nxt; cA = nA; cB = nB; ++ui;
        if constexpr (GATHER) {
#pragma unroll
            for (int _h = 0; _h < 2; ++_h)
#pragma unroll
                for (int _i = 0; _i < 2; ++_i) vA[_h][_i] = nvA[_h][_i];
        }
        if constexpr (ALIGN_EPI) { if (wr == 1) PG8_BAR; }
    }
    PG8_WAIT_V(0);
    if constexpr (!ALIGN_EPI) { if (wr == 0) PG8_BAR; }
    PG8_BAR;
#undef PG8_SA
#undef PG8_SB
#undef PG8_GL
#undef PG8_STAGE
#undef PG8_STA
#undef PG8_GVA
#undef PG8_LDA
#undef PG8_LDB
#undef PG8_MMA
#undef PG8_WAIT_V
#undef PG8_WAIT_L
#undef PG8_BAR
#undef PG8_SCHED
}
}
namespace epi {
__device__ __forceinline__ float clamp_f8(float v) { return __builtin_fminf(__builtin_fmaxf(v, -448.0f), 448.0f); }
__device__ __forceinline__ unsigned pack4_f8(float a, float b, float c, float d) { int w = __builtin_amdgcn_cvt_pk_fp8_f32(clamp_f8(a), clamp_f8(b), 0, false); return (unsigned)__builtin_amdgcn_cvt_pk_fp8_f32(clamp_f8(c), clamp_f8(d), w, true); }
using pg8::Unit;
template <int ACT> struct StoreBf16 {
    static constexpr bool PERM = true;
    bf16_t* O; int ldc;
    __device__ __forceinline__ int f8exp(const Unit&) const { return 8; }
    __device__ __forceinline__ void operator()(const f32x4 (&acc)[2][2][4][2], const Unit& u, int wr, int wc, int fr, int fq) const {
        const int row0 = u.pm * 256 + wr * 64 + fr, col0 = u.pn * 256 + wc * 32 + 8 * fq;
#pragma unroll
        for (int ai = 0; ai < 2; ++ai)
#pragma unroll
            for (int m = 0; m < 4; ++m) { bf16_t* rowp = O + (size_t)(row0 + ai * 128 + m * 16) * ldc + col0;
#pragma unroll
                for (int bj = 0; bj < 2; ++bj) { f32x4 v0 = acc[ai][bj][m][0], v1 = acc[ai][bj][m][1];
                    if (ACT == 1) {
#pragma unroll
                        for (int j = 0; j < 4; ++j) { v0[j] = sigmoidf_(v0[j] * DS2); v1[j] = sigmoidf_(v1[j] * DS2); } }
                    if (ACT == 1) { *(u32x2*)((unsigned char*)O + (size_t)(row0 + ai * 128 + m * 16) * ldc + col0 + bj * 128) = (u32x2){pack4_f8(v0[0] * F8_SGATE, v0[1] * F8_SGATE, v0[2] * F8_SGATE, v0[3] * F8_SGATE), pack4_f8(v1[0] * F8_SGATE, v1[1] * F8_SGATE, v1[2] * F8_SGATE, v1[3] * F8_SGATE)}; }
                    else { u32x4 w; w.x = cvtpk(v0[0], v0[1]); w.y = cvtpk(v0[2], v0[3]); w.z = cvtpk(v1[0], v1[1]); w.w = cvtpk(v1[2], v1[3]);
                    *(u32x4*)(rowp + bj * 128) = w; } } }
    }
};
__device__ __forceinline__ f32x4 mul4_f8(f32x4 v, unsigned w) { const f32x2 lo = __builtin_amdgcn_cvt_pk_f32_fp8((int)w, false), hi = __builtin_amdgcn_cvt_pk_f32_fp8((int)w, true); v[0] *= lo[0]; v[1] *= lo[1]; v[2] *= hi[0]; v[3] *= hi[1]; return v; }
__device__ __forceinline__ f32x4 fma4_f8(unsigned w, float s, f32x4 v) { const f32x2 lo = __builtin_amdgcn_cvt_pk_f32_fp8((int)w, false), hi = __builtin_amdgcn_cvt_pk_f32_fp8((int)w, true);
    v[0] = __builtin_fmaf(lo[0], s, v[0]); v[1] = __builtin_fmaf(lo[1], s, v[1]); v[2] = __builtin_fmaf(hi[0], s, v[2]); v[3] = __builtin_fmaf(hi[1], s, v[3]); return v; }
template <int MODE> struct GateMul {
    static constexpr int PERM = 2;
    const bf16_t* gate; int goff; const bf16_t* prev; bf16_t* O;
    __device__ __forceinline__ void operator()(const f32x4 (&acc)[2][2][4][2], const Unit& u, int wr, int wc, int fr, int fq) const {
        const int row0 = u.pm * 256 + wr * 64 + fr, col = u.pn * 256 + wc * 64 + 16 * fq;
#pragma unroll
        for (int ai = 0; ai < 2; ++ai)
#pragma unroll
            for (int m = 0; m < 4; ++m) { const size_t row = (size_t)(row0 + ai * 128 + m * 16);
                const u32x4 g = *(const u32x4*)((const unsigned char*)gate + row * 4096 + goff + col);
                f32x4 v0 = mul4_f8(acc[ai][0][m][0], g.x), v1 = mul4_f8(acc[ai][0][m][1], g.y), v2 = mul4_f8(acc[ai][1][m][0], g.z), v3 = mul4_f8(acc[ai][1][m][1], g.w);
                if (MODE == 1) { const u32x4 p = *(const u32x4*)((const unsigned char*)prev + row * 2048 + col);
                    constexpr float ip = 1.0f / F8_SG;
                    v0 = fma4_f8(p.x, ip, v0); v1 = fma4_f8(p.y, ip, v1); v2 = fma4_f8(p.z, ip, v2); v3 = fma4_f8(p.w, ip, v3); }
                *(u32x4*)((unsigned char*)O + row * 2048 + col) = (u32x4){pack4_f8(v0[0] * F8_SG, v0[1] * F8_SG, v0[2] * F8_SG, v0[3] * F8_SG), pack4_f8(v1[0] * F8_SG, v1[1] * F8_SG, v1[2] * F8_SG, v1[3] * F8_SG),
                                                                           pack4_f8(v2[0] * F8_SG, v2[1] * F8_SG, v2[2] * F8_SG, v2[3] * F8_SG), pack4_f8(v3[0] * F8_SG, v3[1] * F8_SG, v3[2] * F8_SG, v3[3] * F8_SG)}; }
    }
};
struct Resid {
    static constexpr bool PERM = false;
    const float* base; float* out; const float* gate; int goff;
    __device__ __forceinline__ void operator()(const f32x4 (&acc)[2][2][4][2], const Unit& u, int wr, int wc, int fr, int fq) const {
        const int row0 = u.pm * 256 + wr * 64 + fr, col0 = u.pn * 256 + wc * 32 + 4 * fq;
        const int b = (u.pm * 256) / SEQ;
        f32x4 gv[2][2];
#pragma unroll
        for (int bj = 0; bj < 2; ++bj)
#pragma unroll
            for (int n = 0; n < 2; ++n) gv[bj][n] = *(const f32x4*)(gate + (size_t)b * 12288 + goff + col0 + bj * 128 + n * 16);
#pragma unroll
        for (int ai = 0; ai < 2; ++ai)
#pragma unroll
            for (int m = 0; m < 4; ++m) { const size_t off = (size_t)(row0 + ai * 128 + m * 16) * 2048 + col0;
#pragma unroll
                for (int bj = 0; bj < 2; ++bj)
#pragma unroll
                    for (int n = 0; n < 2; ++n) { const f32x4 bs = *(const f32x4*)(base + off + bj * 128 + n * 16);
                        *(f32x4*)(out + off + bj * 128 + n * 16) = bs + gv[bj][n] * acc[ai][bj][m][n]; } }
    }
};
struct SwiGLU {
    static constexpr bool PERM = true;
    bf16_t* O;
    __device__ __forceinline__ void operator()(const f32x4 (&acc)[2][2][4][2], const Unit& u, int wr, int wc, int fr, int fq) const {
        const int r0 = wr * 64 + fr, col0 = u.pn * 128 + wc * 32 + 8 * fq;
#pragma unroll
        for (int ai = 0; ai < 2; ++ai)
#pragma unroll
            for (int m = 0; m < 4; ++m) { const int r = r0 + ai * 128 + m * 16;
                f32x4 v0, v1;
#pragma unroll
                for (int j = 0; j < 4; ++j) { v0[j] = siluf_(acc[ai][0][m][0][j]) * acc[ai][1][m][0][j]; v1[j] = siluf_(acc[ai][0][m][1][j]) * acc[ai][1][m][1][j]; }
                u32x4 w; w.x = cvtpk(v0[0], v0[1]); w.y = cvtpk(v0[2], v0[3]); w.z = cvtpk(v1[0], v1[1]); w.w = cvtpk(v1[2], v1[3]);
                if (r < u.valid) *(u32x4*)(O + (size_t)(u.rowbase + r) * 512 + col0) = w; }
    }
};
struct SwiGLU8 {
    static constexpr bool PERM = true;
    unsigned char* O;
    __device__ __forceinline__ int f8exp(const Unit&) const { return 9; }
    __device__ __forceinline__ void operator()(const f32x4 (&acc)[2][2][4][2], const Unit& u, int wr, int wc, int fr, int fq) const {
        const int r0 = wr * 64 + fr, col0 = u.pn * 128 + wc * 32 + 8 * fq;
        constexpr float ds = 1.0f, us = F8_SA;
#pragma unroll
        for (int ai = 0; ai < 2; ++ai)
#pragma unroll
            for (int m = 0; m < 4; ++m) { const int r = r0 + ai * 128 + m * 16;
                f32x4 v0, v1;
#pragma unroll
                for (int j = 0; j < 4; ++j) { v0[j] = siluf_(acc[ai][0][m][0][j] * ds) * (acc[ai][1][m][0][j] * us); v1[j] = siluf_(acc[ai][0][m][1][j] * ds) * (acc[ai][1][m][1][j] * us); }
                if (r < u.valid) *(u32x2*)(O + (size_t)(u.rowbase + r) * 512 + col0) = (u32x2){pack4_f8(v0[0], v0[1], v0[2], v0[3]), pack4_f8(v1[0], v1[1], v1[2], v1[3])}; }
    }
};
struct DownY {
    static constexpr int PERM = 2;
    unsigned char* O;
    __device__ __forceinline__ int f8exp(const Unit&) const { return 8; }
    __device__ __forceinline__ void operator()(const f32x4 (&acc)[2][2][4][2], const Unit& u, int wr, int wc, int fr, int fq) const {
        const int r0 = wr * 64 + fr, col0 = u.pn * 256 + wc * 64 + 16 * fq;
#pragma unroll
        for (int ai = 0; ai < 2; ++ai)
#pragma unroll
            for (int m = 0; m < 4; ++m) { const int r = r0 + ai * 128 + m * 16;
                if (r < u.valid) {
                    const f32x4 v0 = acc[ai][0][m][0], v1 = acc[ai][0][m][1], v2 = acc[ai][1][m][0], v3 = acc[ai][1][m][1];
                    int w0 = __builtin_amdgcn_cvt_pk_fp8_f32(v0[0], v0[1], 0, false); w0 = __builtin_amdgcn_cvt_pk_fp8_f32(v0[2], v0[3], w0, true);
                    int w1 = __builtin_amdgcn_cvt_pk_fp8_f32(v1[0], v1[1], 0, false); w1 = __builtin_amdgcn_cvt_pk_fp8_f32(v1[2], v1[3], w1, true);
                    int w2 = __builtin_amdgcn_cvt_pk_fp8_f32(v2[0], v2[1], 0, false); w2 = __builtin_amdgcn_cvt_pk_fp8_f32(v2[2], v2[3], w2, true);
                    int w3 = __builtin_amdgcn_cvt_pk_fp8_f32(v3[0], v3[1], 0, false); w3 = __builtin_amdgcn_cvt_pk_fp8_f32(v3[2], v3[3], w3, true);
                    *(u32x4*)(O + (size_t)(u.rowbase + r) * 2048 + col0) = (u32x4){(unsigned)w0, (unsigned)w1, (unsigned)w2, (unsigned)w3}; } }
    }
};
struct DownShared8 {
    static constexpr int PERM = 2;
    unsigned char* O;
    __device__ __forceinline__ int f8exp(const Unit&) const { return 8; }
    __device__ __forceinline__ void operator()(const f32x4 (&acc)[2][2][4][2], const Unit& u, int wr, int wc, int fr, int fq) const {
        const int r0 = u.pm * 256 + wr * 64 + fr, col0 = u.pn * 256 + wc * 64 + 16 * fq;
#pragma unroll
        for (int ai = 0; ai < 2; ++ai)
#pragma unroll
            for (int m = 0; m < 4; ++m) { const int r = r0 + ai * 128 + m * 16;
                const f32x4 v0 = acc[ai][0][m][0], v1 = acc[ai][0][m][1], v2 = acc[ai][1][m][0], v3 = acc[ai][1][m][1];
                *(u32x4*)(O + (size_t)r * 2048 + col0) = (u32x4){pack4_f8(v0[0], v0[1], v0[2], v0[3]), pack4_f8(v1[0], v1[1], v1[2], v1[3]), pack4_f8(v2[0], v2[1], v2[2], v2[3]), pack4_f8(v3[0], v3[1], v3[2], v3[3])}; }
    }
};
struct StoreQK {
    static constexpr bool PERM = true;
    bf16_t* Q; bf16_t* KT; float qscale;
    __device__ __forceinline__ void operator()(const f32x4 (&acc)[2][2][4][2], const Unit& u, int wr, int wc, int fr, int fq) const {
        const int row0 = u.pm * 256 + wr * 64 + fr, col0 = u.pn * 256 + wc * 32 + 8 * fq;
        const bool isk = (u.pn >= 4);
#pragma unroll
        for (int ai = 0; ai < 2; ++ai)
#pragma unroll
            for (int m = 0; m < 4; ++m) { const int row = row0 + ai * 128 + m * 16;
#pragma unroll
                for (int bj = 0; bj < 2; ++bj) { const float sc = (isk ? 1.0f : qscale) * DS2; const f32x4 v0 = acc[ai][bj][m][0] * sc, v1 = acc[ai][bj][m][1] * sc; const int col = col0 + bj * 128;
                    u32x4 w; w.x = cvtpk(v0[0], v0[1]); w.y = cvtpk(v0[2], v0[3]); w.z = cvtpk(v1[0], v1[1]); w.w = cvtpk(v1[2], v1[3]);
                    bf16_t* p = isk ? KT + ((((size_t)((col - 1024) >> 7) * 256 + (row >> 6)) * 64 + (row & 63)) * 128 + (col & 127)) : Q + (size_t)row * 1024 + col;
                    *(u32x4*)p = w; } }
    }
};
struct StoreQK8 {
    static constexpr bool PERM = true;
    unsigned char* Q; unsigned char* KT; float qs, ks;
    __device__ __forceinline__ void operator()(const f32x4 (&acc)[2][2][4][2], const Unit& u, int wr, int wc, int fr, int fq) const {
        const int row0 = u.pm * 256 + wr * 64 + fr, col0 = u.pn * 256 + wc * 32 + 8 * fq;
        const bool isk = (u.pn >= 4);
#pragma unroll
        for (int ai = 0; ai < 2; ++ai)
#pragma unroll
            for (int m = 0; m < 4; ++m) { const int row = row0 + ai * 128 + m * 16;
#pragma unroll
                for (int bj = 0; bj < 2; ++bj) { const float sc = isk ? 1.0f : qs;        const f32x4 v0 = acc[ai][bj][m][0] * sc, v1 = acc[ai][bj][m][1] * sc; const int col = col0 + bj * 128;
                    unsigned char* p = isk ? KT + ((((size_t)((col - 1024) >> 7) * 256 + (row >> 6)) * 64 + (row & 63)) * 128 + (col & 127)) : Q + (size_t)row * 1024 + col;
                    *(u32x2*)p = (u32x2){pack4_f8(v0[0], v0[1], v0[2], v0[3]), pack4_f8(v1[0], v1[1], v1[2], v1[3])}; }
                __builtin_amdgcn_sched_barrier(0); }
    }
};
struct StoreQKboth {
    static constexpr bool PERM = true;
    StoreQK b16; unsigned char* Q8; unsigned char* KT8;
    __device__ __forceinline__ void operator()(const f32x4 (&acc)[2][2][4][2], const Unit& u, int wr, int wc, int fr, int fq) const {
        b16(acc, u, wr, wc, fr, fq);
        const int row0 = u.pm * 256 + wr * 64 + fr, col0 = u.pn * 256 + wc * 32 + 8 * fq;
        const bool isk = (u.pn >= 4);
        const float sc = isk ? att::D8_KS : att::MB8_QS;
#pragma unroll
        for (int ai = 0; ai < 2; ++ai)
#pragma unroll
            for (int m = 0; m < 4; ++m) { const int row = row0 + ai * 128 + m * 16;
#pragma unroll
                for (int bj = 0; bj < 2; ++bj) { const f32x4 v0 = acc[ai][bj][m][0] * sc, v1 = acc[ai][bj][m][1] * sc; const int col = col0 + bj * 128;
                    unsigned char* p = isk ? KT8 + ((((size_t)((col - 1024) >> 7) * 256 + (row >> 6)) * 64 + (row & 63)) * 128 + (col & 127)) : Q8 + (size_t)row * 1024 + col;
                    *(u32x2*)p = (u32x2){pack4_f8(v0[0], v0[1], v0[2], v0[3]), pack4_f8(v1[0], v1[1], v1[2], v1[3])}; }
                __builtin_amdgcn_sched_barrier(0); }
    }
};
struct StoreVT8 {
    static constexpr bool PERM = true;
    unsigned char* VT; float vs;
    __device__ __forceinline__ void operator()(const f32x4 (&acc)[2][2][4][2], const Unit& u, int wr, int wc, int fr, int fq) const {
        const int row0 = u.pm * 256 + wr * 64 + fr, col0 = u.pn * 256 + wc * 32 + 8 * fq;
#pragma unroll
        for (int ai = 0; ai < 2; ++ai)
#pragma unroll
            for (int m = 0; m < 4; ++m) { const int f = row0 + ai * 128 + m * 16;
#pragma unroll
                for (int bj = 0; bj < 2; ++bj) { const f32x4 v0 = acc[ai][bj][m][0], v1 = acc[ai][bj][m][1]; const int tok = col0 + bj * 128, k = tok & 63;
                    unsigned char* p = VT + ((((size_t)(f >> 7) * 256 + (tok >> 6)) * 128 + (f & 127)) * 64 + (k >> 5) * 16 + ((k & 31) >> 3) * 4);
                    *(unsigned*)p = pack4_f8(v0[0], v0[1], v0[2], v0[3]); *(unsigned*)(p + 32) = pack4_f8(v1[0], v1[1], v1[2], v1[3]); }
                __builtin_amdgcn_sched_barrier(0); }
    }
};
struct StoreVT {
    static constexpr bool PERM = true;
    bf16_t* VT;
    __device__ __forceinline__ void operator()(const f32x4 (&acc)[2][2][4][2], const Unit& u, int wr, int wc, int fr, int fq) const {
        const int row0 = u.pm * 256 + wr * 64 + fr, col0 = u.pn * 256 + wc * 32 + 8 * fq;
#pragma unroll
        for (int ai = 0; ai < 2; ++ai)
#pragma unroll
            for (int m = 0; m < 4; ++m) { const int f = row0 + ai * 128 + m * 16;
#pragma unroll
                for (int bj = 0; bj < 2; ++bj) { const f32x4 v0 = acc[ai][bj][m][0] * DS2, v1 = acc[ai][bj][m][1] * DS2; const int tok = col0 + bj * 128;
                    u32x4 w; w.x = cvtpk(v0[0], v0[1]); w.y = cvtpk(v0[2], v0[3]); w.z = cvtpk(v1[0], v1[1]); w.w = cvtpk(v1[2], v1[3]);
                    *(u32x4*)(VT + ((((size_t)(f >> 7) * 256 + (tok >> 6)) * 128 + (f & 127)) * 64 + (tok & 63))) = w; } }
    }
};
struct ProjEpi {
    static constexpr bool PERM = true, HAS_MID = false;
    StoreQK8 qkd; StoreQKboth qkm; StoreBf16<1> gates;
    __device__ __forceinline__ int f8exp(const Unit& u) const { return (u.pn >= 4 && u.pn < 8) ? P2_EXP - 2 : P2_EXP; }
    __device__ __forceinline__ void operator()(const f32x4 (&acc)[2][2][4][2], const Unit& u, int wr, int wc, int fr, int fq) const {
        Unit v = u;
        if (u.pn < 8) qkd(acc, v, wr, wc, fr, fq);
        else if (u.pn < 16) { v.pn = u.pn - 8; qkm(acc, v, wr, wc, fr, fq); }
        else { v.pn = u.pn - 16; gates(acc, v, wr, wc, fr, fq); }
    }
};
struct ProjVT {
    static constexpr bool PERM = true, HAS_MID = false;
    StoreVT8 vd; StoreVT8 vm;
    __device__ __forceinline__ int f8exp(const Unit& u) const { return P2_EXP - 3; }
    __device__ __forceinline__ void operator()(const f32x4 (&acc)[2][2][4][2], const Unit& u, int wr, int wc, int fr, int fq) const {
        Unit v = u;
        if (u.pm < 4) vd(acc, v, wr, wc, fr, fq); else { v.pm = u.pm - 4; vm(acc, v, wr, wc, fr, fq); }
    }
};
struct GatePair {
    static constexpr int PERM = 2; static constexpr bool HAS_MID = false;
    GateMul<0> e0; GateMul<1> e1;
    __device__ __forceinline__ int f8exp(const Unit& u) const { return u.aux == 0 ? 9 + 8 : 11 + 8; }
    __device__ __forceinline__ void operator()(const f32x4 (&acc)[2][2][4][2], const Unit& u, int wr, int wc, int fr, int fq) const {
        if (u.aux == 0) e0(acc, u, wr, wc, fr, fq); else e1(acc, u, wr, wc, fr, fq);
    }
};
struct ResidBf16 {
    static constexpr bool PERM = true, HAS_MID = false;
    const float* base; bf16_t* out; const float* gate; int goff;
    __device__ __forceinline__ int f8exp(const Unit&) const { return 10; }
    __device__ __forceinline__ void operator()(const f32x4 (&acc)[2][2][4][2], const Unit& u, int wr, int wc, int fr, int fq) const {
        const int row0 = u.pm * 256 + wr * 64 + fr, col0 = u.pn * 256 + wc * 32 + 8 * fq;
        const int b = (u.pm * 256) / SEQ;
        f32x4 gv[2][2];
#pragma unroll
        for (int bj = 0; bj < 2; ++bj)
#pragma unroll
            for (int n = 0; n < 2; ++n) gv[bj][n] = *(const f32x4*)(gate + (size_t)b * 12288 + goff + col0 + bj * 128 + n * 4);
#pragma unroll
        for (int ai = 0; ai < 2; ++ai)
#pragma unroll
            for (int m = 0; m < 4; ++m) { const size_t off = (size_t)(row0 + ai * 128 + m * 16) * 2048 + col0;
#pragma unroll
                for (int bj = 0; bj < 2; ++bj) {
                    const f32x4 b0 = *(const f32x4*)(base + off + bj * 128), b1 = *(const f32x4*)(base + off + bj * 128 + 4);
                    const f32x4 v0 = b0 + gv[bj][0] * acc[ai][bj][m][0], v1 = b1 + gv[bj][1] * acc[ai][bj][m][1];
                    u32x4 w; w.x = cvtpk(v0[0], v0[1]); w.y = cvtpk(v0[2], v0[3]); w.z = cvtpk(v1[0], v1[1]); w.w = cvtpk(v1[2], v1[3]);
                    *(u32x4*)(out + off + bj * 128) = w; } }
    }
};
}
namespace att {
constexpr int KROW = 272;
constexpr int VROW = 144;
constexpr int KBUF = 64 * KROW;
constexpr int VBUF = 128 * VROW;
constexpr int OFF_K = 0, OFF_V = 2 * KBUF, OFF_TAB = OFF_V + 2 * VBUF, OFF_G = OFF_TAB + 512, OFF_END = OFF_G + 512;
static_assert(OFF_END <= RING_BYTES, "attention LDS");
__device__ __forceinline__ int crow(int i, int hh) { return (i & 3) + 8 * (i >> 2) + 4 * hh; }

__device__ __forceinline__ int t5_bucket(int n) {
    if (n < 16) return n;
    int b = 16;
    b += (n >= 19); b += (n >= 21); b += (n >= 24); b += (n >= 27); b += (n >= 31); b += (n >= 35); b += (n >= 40); b += (n >= 46);
    b += (n >= 52); b += (n >= 59); b += (n >= 67); b += (n >= 77); b += (n >= 87); b += (n >= 99); b += (n >= 113);
    return b;
}
__device__ __forceinline__ void fill_bias_tab(LAS float* tab, const float* rel_bias, int col) {
    if (threadIdx.x < 128) { const int n = threadIdx.x; tab[n] = (rel_bias[t5_bucket(n) * 16 + col] - rel_bias[31 * 16 + col]) * LOG2E; }
}

struct TileRegs { u32x4 k[2]; u32x4 v[2]; };
__device__ __forceinline__ void tile_load(TileRegs& R, const bf16_t* kt, const bf16_t* vt, int tid) {
#pragma unroll
    for (int i = 0; i < 2; ++i) { const int c = tid + 512 * i; R.k[i] = *(const u32x4*)(kt + c * 8); }
#pragma unroll
    for (int i = 0; i < 2; ++i) { const int c = tid + 512 * i; R.v[i] = *(const u32x4*)(vt + c * 8); }
}
__device__ __forceinline__ void tile_store(const TileRegs& R, LAS unsigned char* kb, LAS unsigned char* vb, int tid) {
#pragma unroll
    for (int i = 0; i < 2; ++i) { const int c = tid + 512 * i; *(LAS u32x4*)(kb + (c >> 4) * KROW + (c & 15) * 16) = R.k[i]; }
#pragma unroll
    for (int i = 0; i < 2; ++i) { const int c = tid + 512 * i;
        LAS unsigned char* p = vb + (c >> 3) * VROW + ((c & 7) >> 1) * 32 + (c & 1) * 8;
        *(LAS u32x2*)p = (u32x2){R.v[i].x, R.v[i].y}; *(LAS u32x2*)(p + 16) = (u32x2){R.v[i].z, R.v[i].w}; }
}

template <int NMAP, int KS>
__device__ __forceinline__ void attn_half(const LAS unsigned char* kb, const LAS unsigned char* vb, int kh, const bf16x8 (&qf)[NMAP][KS], f32x16 (&O)[NMAP][4],
                                          float (&mrun)[NMAP], float (&lrun)[NMAP], int qpos, int kvpos0, bool need_mask, bool need_bias, const LAS float* btab, float sc, int r, int hh, int kcolbase) {
    bf16x8 P[NMAP][2];
#pragma unroll
    for (int m = 0; m < NMAP; ++m) {
        f32x16 s;
#pragma unroll
        for (int i = 0; i < 16; ++i) s[i] = 0.f;
#pragma unroll
        for (int ks = 0; ks < KS; ++ks) {
            const bf16x8 kf = *(const LAS bf16x8*)(kb + (32 * kh + r) * KROW + (kcolbase + m * 16 * KS + 16 * ks + 8 * hh) * 2);
            s = __builtin_amdgcn_mfma_f32_32x32x16_bf16(kf, qf[m][ks], s, 0, 0, 0);
        }
#pragma unroll
        for (int i = 0; i < 16; ++i) s[i] *= sc;
        if (need_bias) {
#pragma unroll
            for (int i = 0; i < 16; ++i) { int rel = qpos - (kvpos0 + crow(i, hh)); rel = rel < 0 ? 0 : (rel > 127 ? 127 : rel); s[i] += btab[rel]; }
        }
        if (need_mask) {
#pragma unroll
            for (int i = 0; i < 16; ++i) { if (kvpos0 + crow(i, hh) > qpos) s[i] = -INFINITY; }
        }
        float mx = s[0];
#pragma unroll
        for (int i = 1; i < 16; ++i) mx = fmaxf(mx, s[i]);
        mx = fmaxf(mx, __shfl_xor(mx, 32));
        const float mnew = fmaxf(mrun[m], mx);
        const float alpha = fast_exp2(mrun[m] - mnew);
        float sum = 0.f;
#pragma unroll
        for (int i = 0; i < 16; ++i) { const float p = fast_exp2(s[i] - mnew); sum += p; s[i] = p; }
        lrun[m] = lrun[m] * alpha + sum; mrun[m] = mnew;
#pragma unroll
        for (int dt = 0; dt < 4; ++dt)
#pragma unroll
            for (int i = 0; i < 16; ++i) O[m][dt][i] *= alpha;
#pragma unroll
        for (int st = 0; st < 2; ++st) { u32x4 w; w.x = cvtpk(s[8 * st + 0], s[8 * st + 1]); w.y = cvtpk(s[8 * st + 2], s[8 * st + 3]); w.z = cvtpk(s[8 * st + 4], s[8 * st + 5]); w.w = cvtpk(s[8 * st + 6], s[8 * st + 7]);
            P[m][st] = __builtin_bit_cast(bf16x8, w); }
    }
#pragma unroll
    for (int dt = 0; dt < 4; ++dt)
#pragma unroll
        for (int st = 0; st < 2; ++st) {
            const bf16x8 vf = *(const LAS bf16x8*)(vb + (32 * dt + r) * VROW + (2 * kh + st) * 32 + hh * 16);
#pragma unroll
            for (int m = 0; m < NMAP; ++m) O[m][dt] = __builtin_amdgcn_mfma_f32_32x32x16_bf16(vf, P[m][st], O[m][dt], 0, 0, 0);
        }
}

#define SBAR() __builtin_amdgcn_sched_barrier(0)
constexpr int TBUF = KBUF + VBUF;
constexpr int D_OFF_TAB = 3 * TBUF, D_OFF_G = D_OFF_TAB + 512;
static_assert(D_OFF_G + 512 <= RING_BYTES, "diff attention LDS");
constexpr float D_C = 0.125f * LOG2E;
__device__ __forceinline__ void d_load_kf(bf16x8 (&kf)[4], const LAS unsigned char* kb, int kh, int r, int hh, int kcol) {
#pragma unroll
    for (int ks = 0; ks < 4; ++ks) kf[ks] = *(const LAS bf16x8*)(kb + (32 * kh + r) * KROW + (kcol + 16 * ks + 8 * hh) * 2);
}
constexpr float D_THR = 8.0f;
__device__ __forceinline__ float max3_(float a, float b, float c) { float r; asm("v_max3_f32 %0, %1, %2, %3" : "=v"(r) : "v"(a), "v"(b), "v"(c)); return r; }
template <int MODE, bool LOADV, bool PREFK>
__device__ __forceinline__ void d_half_a(const bf16x8 (&kf)[4], bf16x8 (&kfn)[4], const LAS unsigned char* knext, int khn, const LAS unsigned char* vb, int kh,
                                         const bf16x8 (&qf)[4], f32x16 (&o)[4], float& mref, float& lrun, int qpos, int kvpos0, bool need_mask, bool need_bias, bool first,
                                         const LAS float* btab, int r, int hh, int kcol, bf16x8 (&vf)[4], bf16x8 (&P)[2]) {
    if (LOADV) {
#pragma unroll
        for (int dt = 0; dt < 2; ++dt)
#pragma unroll
            for (int st = 0; st < 2; ++st) vf[2 * dt + st] = *(const LAS bf16x8*)(vb + (32 * dt + r) * VROW + (2 * kh + st) * 32 + hh * 16);
    }
    SBAR();
    f32x16 s;
#pragma unroll
    for (int i = 0; i < 16; ++i) s[i] = 0.f;
    __builtin_amdgcn_s_setprio(1);
#pragma unroll
    for (int ks = 0; ks < 4; ++ks) { if (MODE != 3) s = __builtin_amdgcn_mfma_f32_32x32x16_bf16(kf[ks], qf[ks], s, 0, 0, 0); else { s[ks] += __builtin_bit_cast(float, (int)kf[ks][0]); s[4 + ks] += __builtin_bit_cast(float, (int)qf[ks][1]); } }
    __builtin_amdgcn_s_setprio(0);
    if (PREFK) d_load_kf(kfn, knext, khn, r, hh, kcol);
    SBAR();
    if (MODE == 4) { P[0] = qf[0]; P[1] = qf[1]; mref = fmaxf(mref, s[0]); } else {
    if (need_bias) {
#pragma unroll
        for (int i = 0; i < 16; ++i) { int rel = qpos - (kvpos0 + crow(i, hh)); rel = rel < 0 ? 0 : (rel > 127 ? 127 : rel); s[i] += btab[rel]; }
    }
    if (need_mask) {
#pragma unroll
        for (int i = 0; i < 16; ++i) { if (kvpos0 + crow(i, hh) > qpos) s[i] = -INFINITY; }
    }
    float mx = max3_(s[0], s[1], s[2]);
    mx = max3_(mx, s[3], s[4]); mx = max3_(mx, s[5], s[6]); mx = max3_(mx, s[7], s[8]); mx = max3_(mx, s[9], s[10]); mx = max3_(mx, s[11], s[12]); mx = max3_(mx, s[13], s[14]);
    { auto rr = __builtin_amdgcn_permlane32_swap(__float_as_uint(mx), __float_as_uint(mx), false, false); mx = max3_(s[15], __uint_as_float(rr[0]), __uint_as_float(rr[1])); }
    if (first || __any(mx - mref > D_THR)) {
        const float mn = first ? mx : fmaxf(mref, mx);
        const float alpha = first ? 0.f : fast_exp2(mref - mn);
        mref = mn; lrun *= alpha;
#pragma unroll
        for (int dt = 0; dt < 4; ++dt)
#pragma unroll
            for (int i = 0; i < 16; ++i) o[dt][i] *= alpha;
    }
    float sum = 0.f;
#pragma unroll
    for (int i = 0; i < 16; ++i) { const float p = fast_exp2(s[i] - mref); sum += p; s[i] = p; }
    lrun += sum;
#pragma unroll
    for (int st = 0; st < 2; ++st) { u32x4 w; w.x = cvtpk(s[8 * st + 0], s[8 * st + 1]); w.y = cvtpk(s[8 * st + 2], s[8 * st + 3]); w.z = cvtpk(s[8 * st + 4], s[8 * st + 5]); w.w = cvtpk(s[8 * st + 6], s[8 * st + 7]);
        P[st] = __builtin_bit_cast(bf16x8, w); }
    }
}
template <int MODE, bool LOADV>
__device__ __forceinline__ void d_half_b(f32x16 (&o)[4], bf16x8 (&vf)[4], const bf16x8 (&P)[2], const LAS unsigned char* vb, int kh, int r, int hh) {
    if (LOADV) {
#pragma unroll
        for (int dt = 0; dt < 2; ++dt)
#pragma unroll
            for (int st = 0; st < 2; ++st) vf[2 * dt + st] = *(const LAS bf16x8*)(vb + (32 * dt + r) * VROW + (2 * kh + st) * 32 + hh * 16);
    }
    bf16x8 vg[4];
#pragma unroll
    for (int dt = 2; dt < 4; ++dt)
#pragma unroll
        for (int st = 0; st < 2; ++st) vg[2 * (dt - 2) + st] = *(const LAS bf16x8*)(vb + (32 * dt + r) * VROW + (2 * kh + st) * 32 + hh * 16);
    asm volatile("s_waitcnt lgkmcnt(4)" ::: "memory"); SBAR();
    __builtin_amdgcn_s_setprio(1);
#pragma unroll
    for (int dt = 0; dt < 2; ++dt)
#pragma unroll
        for (int st = 0; st < 2; ++st) {
            if (MODE != 3) o[dt] = __builtin_amdgcn_mfma_f32_32x32x16_bf16(vf[2 * dt + st], P[st], o[dt], 0, 0, 0);
            else o[dt][st] += __builtin_bit_cast(float, (int)vf[2 * dt + st][0]) * __builtin_bit_cast(float, (int)P[st][0]);
        }
    asm volatile("s_waitcnt lgkmcnt(0)" ::: "memory"); SBAR();
#pragma unroll
    for (int dt = 2; dt < 4; ++dt)
#pragma unroll
        for (int st = 0; st < 2; ++st) {
            if (MODE != 3) o[dt] = __builtin_amdgcn_mfma_f32_32x32x16_bf16(vg[2 * (dt - 2) + st], P[st], o[dt], 0, 0, 0);
            else o[dt][st] += __builtin_bit_cast(float, (int)vg[2 * (dt - 2) + st][0]) * __builtin_bit_cast(float, (int)P[st][0]);
        }
    __builtin_amdgcn_s_setprio(0);
}
template <int MODE>
__device__ __forceinline__ void diff_unit(LAS unsigned char* lds, int b, int h, int qt, const bf16_t* QD, const bf16_t* KDT, const bf16_t* VDT, bf16_t* AD, const float* subln, const float* rel_bias) {
    int tid_ = threadIdx.x; asm volatile("" : "+v"(tid_));
    const int tid = tid_, lane = tid & 63, r = lane & 31, hh = lane >> 5; const int wid = __builtin_amdgcn_readfirstlane(tid >> 6);
    const int map = wid >> 2, qsub = wid & 3;
    const int q0 = qt * 128, qw0 = q0 + 32 * qsub, qpos = qw0 + r;
    const size_t tok0 = (size_t)b * SEQ;
    const LAS float* btab = (const LAS float*)(lds + D_OFF_TAB);
    const LAS float* gtab = (const LAS float*)(lds + D_OFF_G);
    const int kcol = map * 64;
    bf16x8 qf[4];
#pragma unroll
    for (int ks = 0; ks < 4; ++ks) qf[ks] = *(const bf16x8*)(QD + (tok0 + qpos) * 1024 + h * 128 + map * 64 + 16 * ks + 8 * hh);
    f32x16 o[4];
#pragma unroll
    for (int dt = 0; dt < 4; ++dt)
#pragma unroll
        for (int i = 0; i < 16; ++i) o[dt][i] = 0.f;
    float mrun = 0.f, lrun = 0.f;
    const bf16_t* kbase = KDT + ((size_t)h * 256 + b * 128) * 8192;
    const bf16_t* vbase = VDT + ((size_t)h * 256 + b * 128) * 8192;
    const int NT = 2 * (qt + 1);
    TileRegs R;
    bf16x8 kfa[4], kfb[4];
    __syncthreads();
    fill_bias_tab((LAS float*)(lds + D_OFF_TAB), rel_bias, h);
    if (tid < 128) ((LAS float*)(lds + D_OFF_G))[tid] = subln[tid];
    tile_load(R, kbase, vbase, tid);
    tile_store(R, lds, lds + KBUF, tid);
    tile_load(R, kbase + 8192, vbase + 8192, tid);
    __syncthreads();
    if (MODE != 2) d_load_kf(kfa, lds, 0, r, hh, kcol);
    int bc = 0;
    bf16x8 vf[4], P[2];
#define D_STAGE() do { if (t + 1 < NT) tile_store(R, lds + bn * TBUF, lds + bn * TBUF + KBUF, tid); \
        if (t + 2 < NT) tile_load(R, kbase + (size_t)(MODE == 1 ? 0 : t + 2) * 8192, vbase + (size_t)(MODE == 1 ? 0 : t + 2) * 8192, tid); \
        __syncthreads(); } while (0)
    if (wid < 4) {
#pragma unroll 1
        for (int t = 0; t < NT; ++t) {
            const int bn = (bc == 2) ? 0 : bc + 1;
            const LAS unsigned char* kb = lds + bc * TBUF; const LAS unsigned char* vb = kb + KBUF;
            const int k0 = 64 * t;
            { const bool nm = (k0 + 31 > qw0), nb = (qw0 - (k0 + 31) < 113);
              if (MODE != 2) { d_half_a<MODE, true, true>(kfa, kfb, kb, 1, vb, 0, qf, o, mrun, lrun, qpos, k0, nm, nb, t == 0, btab, r, hh, kcol, vf, P); d_half_b<MODE, false>(o, vf, P, vb, 0, r, hh); } }
            D_STAGE();
            { const bool nm = (k0 + 63 > qw0), nb = (qw0 - (k0 + 63) < 113);
              if (MODE != 2) { d_half_a<MODE, true, true>(kfb, kfa, lds + bn * TBUF, 0, vb, 1, qf, o, mrun, lrun, qpos, k0 + 32, nm, nb, false, btab, r, hh, kcol, vf, P); d_half_b<MODE, false>(o, vf, P, vb, 1, r, hh); } }
            bc = bn;
        }
    } else {
#pragma unroll 1
        for (int t = 0; t < NT; ++t) {
            const int bn = (bc == 2) ? 0 : bc + 1;
            const LAS unsigned char* kb = lds + bc * TBUF; const LAS unsigned char* vb = kb + KBUF;
            const int k0 = 64 * t;
            { const bool nm = (k0 + 31 > qw0), nb = (qw0 - (k0 + 31) < 113);
              if (MODE != 2) d_half_a<MODE, false, false>(kfa, kfb, kb, 1, vb, 0, qf, o, mrun, lrun, qpos, k0, nm, nb, t == 0, btab, r, hh, kcol, vf, P); }
            D_STAGE();
            if (MODE != 2) { d_half_b<MODE, true>(o, vf, P, vb, 0, r, hh); d_load_kf(kfb, kb, 1, r, hh, kcol); }
            { const bool nm = (k0 + 63 > qw0), nb = (qw0 - (k0 + 63) < 113);
              if (MODE != 2) { d_half_a<MODE, true, true>(kfb, kfa, lds + bn * TBUF, 0, vb, 1, qf, o, mrun, lrun, qpos, k0 + 32, nm, nb, false, btab, r, hh, kcol, vf, P); d_half_b<MODE, false>(o, vf, P, vb, 1, r, hh); } }
            bc = bn;
        }
    }
#undef D_STAGE
    __syncthreads();
    const float l = lrun + __shfl_xor(lrun, 32);
    LAS float* xch = (LAS float*)lds + qsub * 4096 + lane;
    if (map == 1) {
        const float lam = *(const LAS float*)(lds + MISC_OFF + 68);
        const float f = lam / l;
#pragma unroll
        for (int dt = 0; dt < 4; ++dt)
#pragma unroll
            for (int i = 0; i < 16; ++i) xch[(dt * 16 + i) * 64] = o[dt][i] * f;
    }
    __syncthreads();
    if (map == 0) {
        const float i0 = 1.0f / l;
        float ss = 0.f;
#pragma unroll
        for (int dt = 0; dt < 4; ++dt)
#pragma unroll
            for (int i = 0; i < 16; ++i) { const float v = o[dt][i] * i0 - xch[(dt * 16 + i) * 64]; o[dt][i] = v; ss += v * v; }
        ss += __shfl_xor(ss, 32);
        const float rs = 0.8f / sqrtf(ss * (1.0f / 128.0f) + RMS_EPS);
        bf16_t* orow = AD + (tok0 + qpos) * 1024 + h * 128;
#pragma unroll
        for (int dt = 0; dt < 4; ++dt)
#pragma unroll
            for (int g = 0; g < 4; ++g) { const int d = 32 * dt + 8 * g + 4 * hh;
                const f32x4 gg = *(const LAS f32x4*)(gtab + d);
                u32x2 w; w.x = cvtpk(o[dt][4 * g + 0] * rs * gg[0], o[dt][4 * g + 1] * rs * gg[1]); w.y = cvtpk(o[dt][4 * g + 2] * rs * gg[2], o[dt][4 * g + 3] * rs * gg[3]);
                *(u32x2*)(orow + d) = w; }
    }
}

constexpr int KROW8 = 144, VROW8 = 80, KBUF8 = 64 * KROW8, VBUF8 = 128 * VROW8, TBUF8 = KBUF8 + VBUF8;
static_assert(4 * TBUF8 <= D_OFF_TAB, "fp8 diff attention LDS");
constexpr float D8_C = 1.0f / 64.0f, D8_THR = 3.0f * 64.0f, D8_SH = 5.0f;
struct TileRegs8 { u32x4 k, v; };
__device__ __forceinline__ void tile_load8(TileRegs8& R, const unsigned char* kt, const unsigned char* vt, int tid) { R.k = *(const u32x4*)(kt + tid * 16); R.v = *(const u32x4*)(vt + tid * 16); }
__device__ __forceinline__ void tile_store8(const TileRegs8& R, LAS unsigned char* kb, LAS unsigned char* vb, int tid) {
    *(LAS u32x4*)(kb + (tid >> 3) * KROW8 + (tid & 7) * 16) = R.k; *(LAS u32x4*)(vb + (tid >> 2) * VROW8 + (tid & 3) * 16) = R.v; }
__device__ __forceinline__ i32x8 cat8(const i32x4 a, const i32x4 b) { return __builtin_shufflevector(a, b, 0, 1, 2, 3, 4, 5, 6, 7); }
__device__ __forceinline__ void d8_load_kf(i32x8 (&kf)[2], const LAS unsigned char* kb, int r, int hh, int kcolb) {
#pragma unroll
    for (int kh = 0; kh < 2; ++kh) { const LAS unsigned char* q = kb + (32 * kh + r) * KROW8 + kcolb + 32 * hh; kf[kh] = cat8(*(const LAS i32x4*)q, *(const LAS i32x4*)(q + 16)); }
}
template <int DT0>
__device__ __forceinline__ void d8_load_vf2(i32x8 (&vf)[2], const LAS unsigned char* vb, int r, int hh) {
#pragma unroll
    for (int dt = 0; dt < 2; ++dt) { const LAS unsigned char* q = vb + (32 * (DT0 + dt) + r) * VROW8 + 32 * hh; vf[dt] = cat8(*(const LAS i32x4*)q, *(const LAS i32x4*)(q + 16)); }
}
__device__ __forceinline__ void d8_scores(f32x16& s0, f32x16& s1, const i32x8 (&kf)[2], const i32x8& qf) {
    f32x16 z;
#pragma unroll
    for (int i = 0; i < 16; ++i) z[i] = 0.f;
    __builtin_amdgcn_s_setprio(1);
    s0 = __builtin_amdgcn_mfma_scale_f32_32x32x64_f8f6f4(kf[0], qf, z, 0, 0, 0, 0x7F7F7F7F, 0, 0x7F7F7F7F);
    s1 = __builtin_amdgcn_mfma_scale_f32_32x32x64_f8f6f4(kf[1], qf, z, 0, 0, 0, 0x7F7F7F7F, 0, 0x7F7F7F7F);
    __builtin_amdgcn_s_setprio(0);
}
template <bool ROW = false>
__device__ __forceinline__ i32x8 d8_softmax(f32x16& s0, f32x16& s1, f32x16 (&o)[4], float& mref, float& lrun, int qpos, int k0, bool need_mask, bool need_bias, bool first, const LAS float* btab, int hh) {
    if (need_bias) {
#pragma unroll
        for (int i = 0; i < 16; ++i) { int rel = qpos - (k0 + crow(i, hh)); rel = rel < 0 ? 0 : (rel > 127 ? 127 : rel); s0[i] += btab[rel]; }
        SBAR();
#pragma unroll
        for (int i = 0; i < 16; ++i) { int rel = qpos - (k0 + 32 + crow(i, hh)); rel = rel < 0 ? 0 : (rel > 127 ? 127 : rel); s1[i] += btab[rel]; }
        SBAR();
    }
    if (need_mask) {
#pragma unroll
        for (int i = 0; i < 16; ++i) { if (k0 + crow(i, hh) > qpos) s0[i] = -INFINITY; if (k0 + 32 + crow(i, hh) > qpos) s1[i] = -INFINITY; }
    }
    float mx = max3_(s0[0], s0[1], s0[2]);
#pragma unroll
    for (int i = 3; i < 15; i += 2) mx = max3_(mx, s0[i], s0[i + 1]);
    mx = max3_(mx, s0[15], s1[0]);
#pragma unroll
    for (int i = 1; i < 15; i += 2) mx = max3_(mx, s1[i], s1[i + 1]);
    { auto rr = __builtin_amdgcn_permlane32_swap(__float_as_uint(mx), __float_as_uint(mx), false, false); mx = max3_(s1[15], __uint_as_float(rr[0]), __uint_as_float(rr[1])); }
    if constexpr (ROW) {
        const bool up = (mx - mref > D8_THR);
        if (__any(up)) {
            const float alpha = up ? fast_exp2((mref - mx) * D8_C) : 1.0f;
            if (up) mref = mx;
            lrun *= alpha;
            asm volatile("s_nop 15\n\ts_nop 15" ::: "memory");
#pragma unroll
            for (int dt = 0; dt < 4; ++dt)
#pragma unroll
                for (int i = 0; i < 16; ++i) o[dt][i] *= alpha;
        }
    } else
    if (first || __any(mx - mref > D8_THR)) {
        const float mn = first ? mx : fmaxf(mref, mx);
        const float alpha = first ? 0.f : fast_exp2((mref - mn) * D8_C);
        mref = mn; lrun *= alpha;
        asm volatile("s_nop 15\n\ts_nop 15" ::: "memory");
#pragma unroll
        for (int dt = 0; dt < 4; ++dt)
#pragma unroll
            for (int i = 0; i < 16; ++i) o[dt][i] *= alpha;
    }
    const float off = D8_SH - mref * D8_C;
    float sum0 = 0.f, sum1 = 0.f;
    i32x8 P;
    const f32x2 c2 = {D8_C, D8_C}, off2 = {off, off};
    f32x2 sum2 = {0.f, 0.f};
#pragma unroll
    for (int g = 0; g < 4; ++g) {
        const f32x2 a0 = __builtin_elementwise_fma((f32x2){s0[4 * g], s0[4 * g + 1]}, c2, off2), a1 = __builtin_elementwise_fma((f32x2){s0[4 * g + 2], s0[4 * g + 3]}, c2, off2);
        const f32x2 b0 = __builtin_elementwise_fma((f32x2){s1[4 * g], s1[4 * g + 1]}, c2, off2), b1 = __builtin_elementwise_fma((f32x2){s1[4 * g + 2], s1[4 * g + 3]}, c2, off2);
        const f32x2 e0 = {fast_exp2(a0[0]), fast_exp2(a0[1])}, e1 = {fast_exp2(a1[0]), fast_exp2(a1[1])}, f0 = {fast_exp2(b0[0]), fast_exp2(b0[1])}, f1 = {fast_exp2(b1[0]), fast_exp2(b1[1])};
        sum2 += (e0 + e1) + (f0 + f1);
        int w0 = __builtin_amdgcn_cvt_pk_fp8_f32(e0[0], e0[1], 0, false); w0 = __builtin_amdgcn_cvt_pk_fp8_f32(e1[0], e1[1], w0, true);
        int w1 = __builtin_amdgcn_cvt_pk_fp8_f32(f0[0], f0[1], 0, false); w1 = __builtin_amdgcn_cvt_pk_fp8_f32(f1[0], f1[1], w1, true);
        P[g] = w0; P[4 + g] = w1; }
    sum0 = sum2[0]; sum1 = sum2[1];
    lrun += sum0 + sum1;
    return P;
}
__device__ __forceinline__ void d8_pv(f32x16 (&o)[4], const i32x8 (&va)[2], const i32x8& P, const LAS unsigned char* vb, int r, int hh) {
    i32x8 vg[2];
    d8_load_vf2<2>(vg, vb, r, hh);
    asm volatile("s_waitcnt lgkmcnt(4)" ::: "memory"); SBAR();
    __builtin_amdgcn_s_setprio(1);
#pragma unroll
    for (int dt = 0; dt < 2; ++dt) asm volatile("v_mfma_scale_f32_32x32x64_f8f6f4 %0, %1, %2, %0, %3, %3 op_sel_hi:[0,0,0]" : "+v"(o[dt]) : "v"(va[dt]), "v"(P), "v"(0x7F7F7F7F));
    asm volatile("s_waitcnt lgkmcnt(0)" ::: "memory"); SBAR();
#pragma unroll
    for (int dt = 0; dt < 2; ++dt) asm volatile("v_mfma_scale_f32_32x32x64_f8f6f4 %0, %1, %2, %0, %3, %3 op_sel_hi:[0,0,0]" : "+v"(o[2 + dt]) : "v"(vg[dt]), "v"(P), "v"(0x7F7F7F7F));
    __builtin_amdgcn_s_setprio(0);
}
__device__ __forceinline__ void diff_unit8(LAS unsigned char* lds, int b, int h, int qt, const unsigned char* QD, const unsigned char* KDT, const unsigned char* VDT, bf16_t* AD, const float* subln, const float* rel_bias) {
    int tid_ = threadIdx.x; asm volatile("" : "+v"(tid_));
    const int tid = tid_, lane = tid & 63, r = lane & 31, hh = lane >> 5; const int wid = __builtin_amdgcn_readfirstlane(tid >> 6);
    const int map = wid >> 2, qsub = wid & 3;
    const int q0 = qt * 128, qw0 = q0 + 32 * qsub, qpos = qw0 + r;
    const size_t tok0 = (size_t)b * SEQ;
    const LAS float* btab = (const LAS float*)(lds + D_OFF_TAB);
    const LAS float* gtab = (const LAS float*)(lds + D_OFF_G);
    const int kcolb = map * 64;
    i32x8 qf;
    { const unsigned char* qp = QD + (tok0 + qpos) * 1024 + h * 128 + map * 64 + 32 * hh; qf = cat8(*(const i32x4*)qp, *(const i32x4*)(qp + 16)); }
    f32x16 o[4];
#pragma unroll
    for (int dt = 0; dt < 4; ++dt)
#pragma unroll
        for (int i = 0; i < 16; ++i) o[dt][i] = 0.f;
    float mrun = 0.f, lrun = 0.f;
    const unsigned char* kbase = KDT + ((size_t)h * 256 + b * 128) * 8192;
    const unsigned char* vbase = VDT + ((size_t)h * 256 + b * 128) * 8192;
    const int NT = 2 * (qt + 1);
    TileRegs8 R;
    __syncthreads();
    if (tid < 128) { const int n = tid; ((LAS float*)(lds + D_OFF_TAB))[n] = (rel_bias[t5_bucket(n) * 16 + h] - rel_bias[31 * 16 + h]) * (LOG2E * 64.0f); ((LAS float*)(lds + D_OFF_G))[n] = subln[n]; }
    tile_load8(R, kbase, vbase, tid); tile_store8(R, lds, lds + KBUF8, tid);
    tile_load8(R, kbase + 8192, vbase + 8192, tid); tile_store8(R, lds + TBUF8, lds + TBUF8 + KBUF8, tid);
    if (NT > 2) tile_load8(R, kbase + 2 * 8192, vbase + 2 * 8192, tid);
    __syncthreads();
    i32x8 kf[2], vf[2];
    d8_load_kf(kf, lds, r, hh, kcolb);
#define D8_STAGE(t) do { if ((t) + 2 < NT) tile_store8(R, lds + (((t) + 2) & 3) * TBUF8, lds + (((t) + 2) & 3) * TBUF8 + KBUF8, tid); \
        if ((t) + 3 < NT) tile_load8(R, kbase + (size_t)((t) + 3) * 8192, vbase + (size_t)((t) + 3) * 8192, tid); \
        __syncthreads(); } while (0)
#pragma unroll 1
    for (int t = 0; t < NT; ++t) {
        const int k0 = 64 * t; const LAS unsigned char* tb = lds + (t & 3) * TBUF8;
        f32x16 s0, s1; d8_scores(s0, s1, kf, qf);
        d8_load_vf2<0>(vf, tb + KBUF8, r, hh); d8_load_kf(kf, lds + ((t + 1) & 3) * TBUF8, r, hh, kcolb); SBAR();
        const i32x8 P = d8_softmax(s0, s1, o, mrun, lrun, qpos, k0, (k0 + 63 > qw0), (qw0 - (k0 + 63) < 113), t == 0, btab, hh);
        if (wid >= 4) D8_STAGE(t);
        d8_pv(o, vf, P, tb + KBUF8, r, hh);
        if (wid < 4) D8_STAGE(t);
    }
#undef D8_STAGE
    __syncthreads();
    asm volatile("s_nop 15\n\ts_nop 15\n\ts_nop 15\n\ts_nop 15" ::: "memory");
    const float l = (lrun + __shfl_xor(lrun, 32)) * D8_VS;
    LAS float* xch = (LAS float*)lds + qsub * 4096 + lane;
    if (map == 1) {
        const float lam = *(const LAS float*)(lds + MISC_OFF + 68);
        const float f = lam / l;
#pragma unroll
        for (int dt = 0; dt < 4; ++dt)
#pragma unroll
            for (int i = 0; i < 16; ++i) xch[(dt * 16 + i) * 64] = o[dt][i] * f;
    }
    __syncthreads();
    if (map == 0) {
        const float i0 = 1.0f / l;
        float ss = 0.f;
#pragma unroll
        for (int dt = 0; dt < 4; ++dt)
#pragma unroll
            for (int i = 0; i < 16; ++i) { const float v = o[dt][i] * i0 - xch[(dt * 16 + i) * 64]; o[dt][i] = v; ss += v * v; }
        ss += __shfl_xor(ss, 32);
        const float rs = 0.8f / sqrtf(ss * (1.0f / 128.0f) + RMS_EPS);
        bf16_t* orow = AD + (tok0 + qpos) * 1024 + h * 128;
#pragma unroll
        for (int dt = 0; dt < 4; ++dt)
#pragma unroll
            for (int g = 0; g < 4; ++g) { const int d = 32 * dt + 8 * g + 4 * hh;
                const f32x4 gg = *(const LAS f32x4*)(gtab + d);
                if constexpr (O78F8) { const float r8 = rs * F8_SAD;
                    *(unsigned*)((unsigned char*)AD + (tok0 + qpos) * 1024 + h * 128 + d) = epi::pack4_f8(o[dt][4 * g + 0] * r8 * gg[0], o[dt][4 * g + 1] * r8 * gg[1], o[dt][4 * g + 2] * r8 * gg[2], o[dt][4 * g + 3] * r8 * gg[3]); }
                else { u32x2 w; w.x = cvtpk(o[dt][4 * g + 0] * rs * gg[0], o[dt][4 * g + 1] * rs * gg[1]); w.y = cvtpk(o[dt][4 * g + 2] * rs * gg[2], o[dt][4 * g + 3] * rs * gg[3]);
                *(u32x2*)(orow + d) = w; } }
    }
}

__device__ __forceinline__ void moba_unit(LAS unsigned char* lds, int b, int h, int n, const int* list, int cnt, const bf16_t* QM, const bf16_t* KMT, const bf16_t* VMT, bf16_t* PARTS, float* ML, const float* rel_bias) {
    int tid_ = threadIdx.x; asm volatile("" : "+v"(tid_));
    const int tid = tid_, lane = tid & 63, r = lane & 31, hh = lane >> 5; const int wid = __builtin_amdgcn_readfirstlane(tid >> 6);
    const size_t tok0 = (size_t)b * SEQ;
    const LAS float* btab = (const LAS float*)(lds + OFF_TAB);
    const float sc = 0.08838834764831845f * LOG2E;
    const bool own = (list == nullptr);
    const int li = 32 * wid + r;
    const bool lane_valid = li < cnt;
    int qpos, slot;
    if (own) { qpos = 256 * n + li; slot = 3; }
    else { const int e = list[lane_valid ? li : 0]; qpos = e >> 2; slot = e & 3; }
    const bool wave_active = (32 * wid < cnt);
    bf16x8 qf[1][8];
#pragma unroll
    for (int ks = 0; ks < 8; ++ks) qf[0][ks] = *(const bf16x8*)(QM + (tok0 + qpos) * 1024 + h * 128 + 16 * ks + 8 * hh);
    f32x16 O[1][4];
#pragma unroll
    for (int dt = 0; dt < 4; ++dt)
#pragma unroll
        for (int i = 0; i < 16; ++i) O[0][dt][i] = 0.f;
    float mrun[1] = {-INFINITY}, lrun[1] = {0.f};
    const bf16_t* kbase = KMT + ((size_t)h * 256 + b * 128 + 4 * n) * 8192;
    const bf16_t* vbase = VMT + ((size_t)h * 256 + b * 128 + 4 * n) * 8192;
    const int qw0 = 256 * n + 32 * wid;
    TileRegs R;
    __syncthreads();
    fill_bias_tab((LAS float*)(lds + OFF_TAB), rel_bias, 8 + h);
    tile_load(R, kbase, vbase, tid);
    tile_store(R, lds + OFF_K, lds + OFF_V, tid);
    __syncthreads();
#pragma unroll 1
    for (int t = 0; t < 4; ++t) {
        const int cur = t & 1;
        if (t + 1 < 4) tile_load(R, kbase + (size_t)(t + 1) * 8192, vbase + (size_t)(t + 1) * 8192, tid);
        if (wave_active) {
#pragma unroll 1
            for (int kh = 0; kh < 2; ++kh) {
                const int kp = 256 * n + 64 * t + 32 * kh;
                bool run = true, need_mask = false, need_bias;
                if (own) { run = (kp <= qw0 + 31); need_mask = (kp + 31 > qw0); need_bias = true; }
                else { need_bias = __any(qpos - (kp + 31) < 113); }
                if (run) attn_half<1, 8>(lds + OFF_K + cur * KBUF, lds + OFF_V + cur * VBUF, kh, qf, O, mrun, lrun, qpos, kp, need_mask, need_bias, btab, sc, r, hh, 0);
            }
        }
        if (t + 1 < 4) tile_store(R, lds + OFF_K + (cur ^ 1) * KBUF, lds + OFF_V + (cur ^ 1) * VBUF, tid);
        __syncthreads();
    }
    const float l = lrun[0] + __shfl_xor(lrun[0], 32);
    const float il = 1.0f / l;
    if (lane_valid) {
        const size_t pidx = ((tok0 + qpos) * 8 + h) * 4 + slot;
        bf16_t* orow = PARTS + pidx * 128;
#pragma unroll
        for (int dt = 0; dt < 4; ++dt)
#pragma unroll
            for (int g = 0; g < 4; ++g) { const int d = 32 * dt + 8 * g + 4 * hh;
                u32x2 w; w.x = cvtpk(O[0][dt][4 * g + 0] * il, O[0][dt][4 * g + 1] * il); w.y = cvtpk(O[0][dt][4 * g + 2] * il, O[0][dt][4 * g + 3] * il);
                *(u32x2*)(orow + d) = w; }
        if (hh == 0) *(f32x2*)(ML + pidx * 2) = (f32x2){mrun[0], l};
    }
}
constexpr int MB_K = 0, MB_V = 4 * KBUF, MB_INC = MB_V + 4 * VBUF, MB_TAB = MB_INC + 2048, MB_END = MB_TAB + 512;
static_assert(MB_END <= MISC_OFF, "MoBA block LDS");
__device__ __forceinline__ void moba_block(LAS unsigned char* lds, int b, int h, int n, const int* list, int cntl, int c0, int c1, const bf16_t* QM, const bf16_t* KMT, const bf16_t* VMT, bf16_t* PARTS, float* ML, const float* rel_bias) {
    int tid_ = threadIdx.x; asm volatile("" : "+v"(tid_));
    const int tid = tid_, lane = tid & 63, r = lane & 31, hh = lane >> 5; const int wid = __builtin_amdgcn_readfirstlane(tid >> 6);
    const size_t tok0 = (size_t)b * SEQ;
    const LAS float* btab = (const LAS float*)(lds + MB_TAB);
    const float sc = 0.08838834764831845f * LOG2E;
    const bf16_t* kbase = KMT + ((size_t)h * 256 + b * 128 + 4 * n) * 8192;
    const bf16_t* vbase = VMT + ((size_t)h * 256 + b * 128 + 4 * n) * 8192;
    __syncthreads();
    fill_bias_tab((LAS float*)(lds + MB_TAB), rel_bias, 8 + h);
    const int li = 32 * wid + r;
    const int cA = c0, cB = c0 + 1;
    const bool ownA = (cA == 0);
    const int cntA = ownA ? 256 : ((cntl - 256 * (cA - 1)) < 256 ? (cntl - 256 * (cA - 1)) : 256);
    const int cntB = (cB < c1) ? ((cntl - 256 * (cB - 1)) < 256 ? (cntl - 256 * (cB - 1)) : 256) : 0;
    const bool hasA = (32 * wid < cntA), hasB = (32 * wid < cntB);
    const bool lvA = li < cntA, lvB = li < cntB;
    int eA = 0, eB = 0;
    if (hasA && !ownA) eA = list[256 * (cA - 1) + (lvA ? li : 0)];
    if (hasB) eB = list[256 * (cB - 1) + (lvB ? li : 0)];
    TileRegs R, R2;
    tile_load(R, kbase, vbase, tid); tile_load(R2, kbase + 8192, vbase + 8192, tid);
    tile_store(R, lds + MB_K, lds + MB_V, tid); tile_load(R, kbase + 2 * 8192, vbase + 2 * 8192, tid);
    const int qposA = ownA ? 256 * n + li : (eA >> 2), slotA = ownA ? 3 : (eA & 3);
    const int qposB = eB >> 2, slotB = eB & 3;
    bf16x8 qfA[1][8], qfB[1][8];
    if (hasA) {
#pragma unroll
        for (int ks = 0; ks < 8; ++ks) qfA[0][ks] = *(const bf16x8*)(QM + (tok0 + qposA) * 1024 + h * 128 + 16 * ks + 8 * hh);
    }
    if (hasB) {
#pragma unroll
        for (int ks = 0; ks < 8; ++ks) qfB[0][ks] = *(const bf16x8*)(QM + (tok0 + qposB) * 1024 + h * 128 + 16 * ks + 8 * hh);
    }
    tile_store(R2, lds + MB_K + KBUF, lds + MB_V + VBUF, tid); tile_load(R2, kbase + 3 * 8192, vbase + 3 * 8192, tid);
    tile_store(R, lds + MB_K + 2 * KBUF, lds + MB_V + 2 * VBUF, tid);
    tile_store(R2, lds + MB_K + 3 * KBUF, lds + MB_V + 3 * VBUF, tid);
    __syncthreads();
#define MB_CHUNK(HAS, OWN, QF, QPOS, SLOT, LV) do { if (HAS) { \
        f32x16 O[1][4]; \
        _Pragma("unroll") for (int dt = 0; dt < 4; ++dt) _Pragma("unroll") for (int i = 0; i < 16; ++i) O[0][dt][i] = 0.f; \
        float mrun[1] = {-INFINITY}, lrun[1] = {0.f}; \
        const int qw0 = 256 * n + 32 * wid; \
        _Pragma("unroll 1") for (int t8 = 0; t8 < 8; ++t8) { \
            const int t = t8 >> 1, kh = t8 & 1; const int kp = 256 * n + 32 * t8; \
            bool run = true, need_mask = false, need_bias; \
            if (OWN) { run = (kp <= qw0 + 31); need_mask = (kp + 31 > qw0); need_bias = true; } \
            else { need_bias = __any((QPOS) - (kp + 31) < 113); } \
            if (run) attn_half<1, 8>(lds + MB_K + t * KBUF, lds + MB_V + t * VBUF, kh, QF, O, mrun, lrun, QPOS, kp, need_mask, need_bias, btab, sc, r, hh, 0); \
        } \
        const float l = lrun[0] + __shfl_xor(lrun[0], 32); const float il = 1.0f / l; \
        if (LV) { const size_t pidx = ((tok0 + (QPOS)) * 8 + h) * 4 + (SLOT); bf16_t* orow = PARTS + pidx * 128; \
            _Pragma("unroll") for (int dt = 0; dt < 4; ++dt) _Pragma("unroll") for (int g = 0; g < 4; ++g) { const int d = 32 * dt + 8 * g + 4 * hh; \
                u32x2 w; w.x = cvtpk(O[0][dt][4 * g + 0] * il, O[0][dt][4 * g + 1] * il); w.y = cvtpk(O[0][dt][4 * g + 2] * il, O[0][dt][4 * g + 3] * il); \
                *(u32x2*)(orow + d) = w; } \
            if (hh == 0) *(f32x2*)(ML + pidx * 2) = (f32x2){mrun[0], l}; } } } while (0)
    MB_CHUNK(hasA, ownA, qfA, qposA, slotA, lvA);
    MB_CHUNK(hasB, false, qfB, qposB, slotB, lvB);
#undef MB_CHUNK
}
constexpr int MB8_TAB = 4 * TBUF8;
static_assert(MB8_TAB + 512 <= MB_INC, "fp8 MoBA block LDS");
__device__ __forceinline__ void moba_block8(LAS unsigned char* lds, int b, int h, int n, const int* list, int cntl, int c0, int c1, const unsigned char* QM8, const unsigned char* KMT8, const unsigned char* VMT8, bf16_t* PARTS, float* ML, const float* rel_bias) {
    int tid_ = threadIdx.x; asm volatile("" : "+v"(tid_));
    const int tid = tid_, lane = tid & 63, r = lane & 31, hh = lane >> 5; const int wid = __builtin_amdgcn_readfirstlane(tid >> 6);
    const size_t tok0 = (size_t)b * SEQ;
    const LAS float* btab = (const LAS float*)(lds + MB8_TAB);
    const unsigned char* kbase = KMT8 + ((size_t)h * 256 + b * 128 + 4 * n) * 8192;
    const unsigned char* vbase = VMT8 + ((size_t)h * 256 + b * 128 + 4 * n) * 8192;
    __syncthreads();
    if (tid < 128) { const int q = tid; ((LAS float*)(lds + MB8_TAB))[q] = (rel_bias[t5_bucket(q) * 16 + 8 + h] - rel_bias[31 * 16 + 8 + h]) * (LOG2E * 64.0f); }
    const int li = 32 * wid + r;
    const int cA = c0, cB = c0 + 1;
    const bool ownA = (cA == 0);
    const int cntA = ownA ? 256 : ((cntl - 256 * (cA - 1)) < 256 ? (cntl - 256 * (cA - 1)) : 256);
    const int cntB = (cB < c1) ? ((cntl - 256 * (cB - 1)) < 256 ? (cntl - 256 * (cB - 1)) : 256) : 0;
    const bool hasA = (32 * wid < cntA), hasB = (32 * wid < cntB);
    const bool lvA = li < cntA, lvB = li < cntB;
    int eA = 0, eB = 0;
    if (hasA && !ownA) eA = list[256 * (cA - 1) + (lvA ? li : 0)];
    if (hasB) eB = list[256 * (cB - 1) + (lvB ? li : 0)];
    TileRegs8 R0, R1, R2, R3;
    tile_load8(R0, kbase, vbase, tid); tile_load8(R1, kbase + 8192, vbase + 8192, tid); tile_load8(R2, kbase + 2 * 8192, vbase + 2 * 8192, tid); tile_load8(R3, kbase + 3 * 8192, vbase + 3 * 8192, tid);
    SBAR();
    tile_store8(R0, lds, lds + KBUF8, tid);
    const int qposA = ownA ? 256 * n + li : (eA >> 2), slotA = ownA ? 3 : (eA & 3);
    const int qposB = eB >> 2, slotB = eB & 3;
    i32x8 qf[2];
    if (hasA) { const unsigned char* qp = QM8 + (tok0 + qposA) * 1024 + h * 128 + 32 * hh; qf[0] = cat8(*(const i32x4*)qp, *(const i32x4*)(qp + 16)); qf[1] = cat8(*(const i32x4*)(qp + 64), *(const i32x4*)(qp + 80)); }
    tile_store8(R1, lds + TBUF8, lds + TBUF8 + KBUF8, tid);
    tile_store8(R2, lds + 2 * TBUF8, lds + 2 * TBUF8 + KBUF8, tid);
    tile_store8(R3, lds + 3 * TBUF8, lds + 3 * TBUF8 + KBUF8, tid);
    __syncthreads();
#define MB8_LOADQB() do { if (hasB) { const unsigned char* qp = QM8 + (tok0 + qposB) * 1024 + h * 128 + 32 * hh; qf[0] = cat8(*(const i32x4*)qp, *(const i32x4*)(qp + 16)); qf[1] = cat8(*(const i32x4*)(qp + 64), *(const i32x4*)(qp + 80)); } } while (0)
#define MB8_CHUNK(HAS, OWN, QPOS, SLOT, LV, NEXTQ) do { if (HAS) { \
        f32x16 o[4]; \
        _Pragma("unroll") for (int dt = 0; dt < 4; ++dt) _Pragma("unroll") for (int i = 0; i < 16; ++i) o[dt][i] = 0.f; \
        float mref = -INFINITY, lrun = 0.f; \
        const int qw0 = 256 * n + 32 * wid; \
        _Pragma("unroll 1") for (int t = 0; t < 4; ++t) { \
            const int kp = 256 * n + 64 * t; const LAS unsigned char* tb = lds + t * TBUF8; \
            bool run = true, need_mask = false, need_bias; \
            if (OWN) { run = (kp <= qw0 + 31); need_mask = (kp + 63 > qw0); need_bias = (qw0 - (kp + 63) < 113); } \
            else { need_bias = __any((QPOS) - (kp + 63) < 113); } \
            if (run) { \
                i32x8 ka[2], kc[2], vf[2]; \
                d8_load_kf(ka, tb, r, hh, 0); d8_load_kf(kc, tb, r, hh, 64); \
                f32x16 s0, s1; d8_scores(s0, s1, ka, qf[0]); \
                __builtin_amdgcn_s_setprio(1); \
                s0 = __builtin_amdgcn_mfma_scale_f32_32x32x64_f8f6f4(kc[0], qf[1], s0, 0, 0, 0, 0x7F7F7F7F, 0, 0x7F7F7F7F); \
                s1 = __builtin_amdgcn_mfma_scale_f32_32x32x64_f8f6f4(kc[1], qf[1], s1, 0, 0, 0, 0x7F7F7F7F, 0, 0x7F7F7F7F); \
                __builtin_amdgcn_s_setprio(0); \
                d8_load_vf2<0>(vf, tb + KBUF8, r, hh); SBAR(); \
                const i32x8 P = d8_softmax<true>(s0, s1, o, mref, lrun, QPOS, kp, need_mask, need_bias, false, btab, hh); \
                d8_pv(o, vf, P, tb + KBUF8, r, hh); \
            } \
        } \
        NEXTQ; \
        asm volatile("s_nop 15\n\ts_nop 15\n\ts_nop 15\n\ts_nop 15" ::: "memory");        \
        const float l = lrun + __shfl_xor(lrun, 32); const float il = 1.0f / (l * D8_VS); \
        { const float il8 = il * F8_SPART; const size_t pidx = ((tok0 + (QPOS)) * 8 + h) * 4 + (SLOT); unsigned char* orow = (unsigned char*)PARTS + pidx * 128; \
              \
            _Pragma("unroll") for (int dt = 0; dt < 4; ++dt) _Pragma("unroll") for (int g = 0; g < 4; g += 2) { \
                unsigned a_ = epi::pack4_f8(o[dt][4 * g + 0] * il8, o[dt][4 * g + 1] * il8, o[dt][4 * g + 2] * il8, o[dt][4 * g + 3] * il8); \
                unsigned b_ = epi::pack4_f8(o[dt][4 * g + 4] * il8, o[dt][4 * g + 5] * il8, o[dt][4 * g + 6] * il8, o[dt][4 * g + 7] * il8); \
                auto rr = __builtin_amdgcn_permlane32_swap(a_, b_, false, false); a_ = rr[0]; b_ = rr[1]; \
                if (LV) *(u32x2*)(orow + 32 * dt + 8 * g + 8 * hh) = (u32x2){a_, b_}; } } \
        if (LV) { const size_t pidx = ((tok0 + (QPOS)) * 8 + h) * 4 + (SLOT); \
            if (hh == 0) *(f32x2*)(ML + pidx * 2) = (f32x2){mref * D8_C - D8_SH, l}; } } else { NEXTQ; } } while (0)
    MB8_CHUNK(hasA, ownA, qposA, slotA, lvA, MB8_LOADQB());
    MB8_CHUNK(hasB, false, qposB, slotB, lvB, (void)0);
#undef MB8_CHUNK
#undef MB8_LOADQB
}
}

struct Ctx {
    LAS unsigned char* lds;
    unsigned char* ws; unsigned* ctl;
    const float* const* in; float* out;
    int tid, lane, wave, G, blk;
};
enum { I_X = 0, I_C, I_WADA, I_BADA, I_GMIX, I_GFFN, I_WIN, I_LAMBDA, I_SUBLN, I_RELB, I_WOD, I_WOM, I_WOUT, I_WROUTER, I_RBIAS, I_WEG, I_WEU, I_WED, I_WSG, I_WSU, I_WSD, I_GFINAL };

constexpr int TR_SCR = 64 * 65 * 4 + 128;
static_assert(8 * TR_SCR <= RING_BYTES + 16384, "transpose scratch");
template <bool NT>
__device__ __forceinline__ void transpose_item(const float* __restrict__ W, int K, int N, bf16_t* __restrict__ WT, int drow0, int k0, int n0, LAS float* scr, int lane) {
    const int nq = lane & 15, kr = lane >> 4;
    f32x4 v[16];
#pragma unroll
    for (int i = 0; i < 16; ++i) { const f32x4* p = (const f32x4*)(W + (size_t)(k0 + 4 * i + kr) * N + n0 + 4 * nq); v[i] = NT ? __builtin_nontemporal_load(p) : *p; }
#pragma unroll
    for (int i = 0; i < 16; ++i) { LAS float* d = scr + (4 * i + kr) * 65 + 4 * nq; d[0] = v[i][0]; d[1] = v[i][1]; d[2] = v[i][2]; d[3] = v[i][3]; }
    LDS_WAIT(); asm volatile("" ::: "memory");
    const int c = lane & 7;
#pragma unroll
    for (int j = 0; j < 8; ++j) { const int n = (lane >> 3) + 8 * j; const LAS float* s = scr + (8 * c) * 65 + n;
        u32x4 o; o.x = cvtpk(s[0 * 65], s[1 * 65]); o.y = cvtpk(s[2 * 65], s[3 * 65]); o.z = cvtpk(s[4 * 65], s[5 * 65]); o.w = cvtpk(s[6 * 65], s[7 * 65]);
        u32x4* q = (u32x4*)(WT + (size_t)(drow0 + n) * K + k0 + 8 * c); if (NT) __builtin_nontemporal_store(o, q); else *q = o; }
    LDS_WAIT(); asm volatile("" ::: "memory");
}
template <bool NT>
__device__ __forceinline__ void transpose_item_f8(const float* __restrict__ W, int K, int N, unsigned char* __restrict__ WT, int drow0, int k0, int n0, LAS float* scr, int lane, float scale) {
    const int nq = lane & 15, kr = lane >> 4;
    f32x4 v[16];
#pragma unroll
    for (int i = 0; i < 16; ++i) { const f32x4* p = (const f32x4*)(W + (size_t)(k0 + 4 * i + kr) * N + n0 + 4 * nq); v[i] = NT ? __builtin_nontemporal_load(p) : *p; }
#pragma unroll
    for (int i = 0; i < 16; ++i) { LAS float* d = scr + (4 * i + kr) * 65 + 4 * nq; d[0] = v[i][0] * scale; d[1] = v[i][1] * scale; d[2] = v[i][2] * scale; d[3] = v[i][3] * scale; }
    LDS_WAIT(); asm volatile("" ::: "memory");
    const int c = lane & 7;
#pragma unroll
    for (int j = 0; j < 8; ++j) { const int n = (lane >> 3) + 8 * j; const LAS float* s = scr + (8 * c) * 65 + n;
        const u32x2 o = {epi::pack4_f8(s[0 * 65], s[1 * 65], s[2 * 65], s[3 * 65]), epi::pack4_f8(s[4 * 65], s[5 * 65], s[6 * 65], s[7 * 65])};
        u32x2* q = (u32x2*)(WT + (size_t)(drow0 + n) * K + k0 + 8 * c); if (NT) __builtin_nontemporal_store(o, q); else *q = o; }
    LDS_WAIT(); asm volatile("" ::: "memory");
}
struct CvItemF8 { const float* W; unsigned char* WT; int K, N, drow0, k0, n0; float scale; };
__device__ __forceinline__ void transpose_pair_f8(const CvItemF8& A, const CvItemF8& B, LAS float* scr, int lane) {
    const int nq = lane & 15, kr = lane >> 4, c = lane & 7;
    f32x4 va[16], vb[16];
#pragma unroll
    for (int i = 0; i < 16; ++i) va[i] = __builtin_nontemporal_load((const f32x4*)(A.W + (size_t)(A.k0 + 4 * i + kr) * A.N + A.n0 + 4 * nq));
#pragma unroll
    for (int i = 0; i < 16; ++i) vb[i] = __builtin_nontemporal_load((const f32x4*)(B.W + (size_t)(B.k0 + 4 * i + kr) * B.N + B.n0 + 4 * nq));
    __builtin_amdgcn_sched_barrier(0);
#pragma unroll
    for (int i = 0; i < 16; ++i) { LAS float* d = scr + (4 * i + kr) * 65 + 4 * nq; d[0] = va[i][0] * A.scale; d[1] = va[i][1] * A.scale; d[2] = va[i][2] * A.scale; d[3] = va[i][3] * A.scale; }
    LDS_WAIT(); asm volatile("" ::: "memory");
#pragma unroll
    for (int j = 0; j < 8; ++j) { const int n = (lane >> 3) + 8 * j; const LAS float* s = scr + (8 * c) * 65 + n;
        const u32x2 o = {epi::pack4_f8(s[0 * 65], s[1 * 65], s[2 * 65], s[3 * 65]), epi::pack4_f8(s[4 * 65], s[5 * 65], s[6 * 65], s[7 * 65])};
        __builtin_nontemporal_store(o, (u32x2*)(A.WT + (size_t)(A.drow0 + n) * A.K + A.k0 + 8 * c)); }
    LDS_WAIT(); asm volatile("" ::: "memory");
#pragma unroll
    for (int i = 0; i < 16; ++i) { LAS float* d = scr + (4 * i + kr) * 65 + 4 * nq; d[0] = vb[i][0] * B.scale; d[1] = vb[i][1] * B.scale; d[2] = vb[i][2] * B.scale; d[3] = vb[i][3] * B.scale; }
    LDS_WAIT(); asm volatile("" ::: "memory");
#pragma unroll
    for (int j = 0; j < 8; ++j) { const int n = (lane >> 3) + 8 * j; const LAS float* s = scr + (8 * c) * 65 + n;
        const u32x2 o = {epi::pack4_f8(s[0 * 65], s[1 * 65], s[2 * 65], s[3 * 65]), epi::pack4_f8(s[4 * 65], s[5 * 65], s[6 * 65], s[7 * 65])};
        __builtin_nontemporal_store(o, (u32x2*)(B.WT + (size_t)(B.drow0 + n) * B.K + B.k0 + 8 * c)); }
    LDS_WAIT(); asm volatile("" ::: "memory");
}
__device__ __forceinline__ int gu_row(int n0, int up) { return 256 * (n0 >> 7) + 128 * up + (n0 & 127); }

__device__ __forceinline__ int win_row(int n) { return n < 2048 ? n : (n < 3072 ? 8192 + (n - 2048) : (n < 5120 ? 2048 + (n - 3072) : (n < 6144 ? 9216 + (n - 5120) : 4096 + (n - 6144)))); }
__device__ __forceinline__ void p0_prologue(Ctx& F) {
    const int gw = F.blk * 8 + F.wave, NGW = F.G * 8;
    unsigned char* ws = F.ws;
    {
        const float* wada = F.in[I_WADA]; const float* c = F.in[I_C]; float* modp = (float*)(ws + WS_MODP);
        for (int it = gw; it < 48 * 32; it += NGW) {
            const int cc = it % 48, ks = it / 48, col = 256 * cc + 4 * F.lane;
            f32x4 a0 = {0.f, 0.f, 0.f, 0.f}, a1 = {0.f, 0.f, 0.f, 0.f};
#pragma unroll 8
            for (int k = 64 * ks; k < 64 * ks + 64; ++k) {
                const f32x4 w = *(const f32x4*)(wada + (size_t)k * 12288 + col);
                const float c0 = c[k], c1 = c[2048 + k];
                a0 += w * siluf_(c0); a1 += w * siluf_(c1);
            }
            *(f32x4*)(modp + ((size_t)ks * 2 + 0) * 12288 + col) = a0;
            *(f32x4*)(modp + ((size_t)ks * 2 + 1) * 12288 + col) = a1;
        }
    }
    {
        LAS float* scr = (LAS float*)(F.lds + F.wave * TR_SCR);
        constexpr int I0 = 5120, I1 = I0 + 512, I2 = I1 + 512, I3 = I2 + 1024, I4 = I3 + 256, I5 = I4 + 256, I6 = I5 + 256;
        for (int it = gw; it < I6; it += NGW) {
            if (it < I0) { const int r = it, kb = r / 160, nb = r % 160; if constexpr (P2F8) transpose_item_f8<false>(F.in[I_WIN], 2048, 10240, ws + WS_W_IN_T, win_row(64 * nb), 64 * kb, 64 * nb, scr, F.lane, F8_SW); else transpose_item<false>(F.in[I_WIN], 2048, 10240, (bf16_t*)(ws + WS_W_IN_T), win_row(64 * nb), 64 * kb, 64 * nb, scr, F.lane); }
            else if (it < I1) { const int r = it - I0, kb = r / 32, nb = r % 32; if constexpr (O78F8) transpose_item_f8<false>(F.in[I_WOD], 1024, 2048, ws + WS_W_OD_T, 64 * nb, 64 * kb, 64 * nb, scr, F.lane, F8_SWO); else transpose_item<false>(F.in[I_WOD], 1024, 2048, (bf16_t*)(ws + WS_W_OD_T), 64 * nb, 64 * kb, 64 * nb, scr, F.lane); }
            else if (it < I2) { const int r = it - I1, kb = r / 32, nb = r % 32; if constexpr (O78F8) transpose_item_f8<false>(F.in[I_WOM], 1024, 2048, ws + WS_W_OM_T, 64 * nb, 64 * kb, 64 * nb, scr, F.lane, F8_SWO); else transpose_item<false>(F.in[I_WOM], 1024, 2048, (bf16_t*)(ws + WS_W_OM_T), 64 * nb, 64 * kb, 64 * nb, scr, F.lane); }
            else if (it < I3) { const int r = it - I2, kb = r / 32, nb = r % 32; if constexpr (O78F8) transpose_item_f8<false>(F.in[I_WOUT], 2048, 2048, ws + WS_W_OUT_T, 64 * nb, 64 * kb, 64 * nb, scr, F.lane, F8_SWOUT); else transpose_item<false>(F.in[I_WOUT], 2048, 2048, (bf16_t*)(ws + WS_W_OUT_T), 64 * nb, 64 * kb, 64 * nb, scr, F.lane); }
            else if (it < I4) { const int r = it - I3, kb = r / 8, nb = r % 8; transpose_item_f8<false>(F.in[I_WSG], 2048, 512, ws + WS_W_SHGU_T, gu_row(64 * nb, 0), 64 * kb, 64 * nb, scr, F.lane, F8_SW); }
            else if (it < I5) { const int r = it - I4, kb = r / 8, nb = r % 8; transpose_item_f8<false>(F.in[I_WSU], 2048, 512, ws + WS_W_SHGU_T, gu_row(64 * nb, 1), 64 * kb, 64 * nb, scr, F.lane, F8_SW); }
            else { const int r = it - I5, kb = r / 32, nb = r % 32; transpose_item_f8<false>(F.in[I_WSD], 512, 2048, ws + WS_W_SHD_T, 64 * nb, 64 * kb, 64 * nb, scr, F.lane, F8_SD); }
        }
    }
    {
        const float* wr = F.in[I_WROUTER]; bf16_t* hi = (bf16_t*)(ws + WS_WR); bf16_t* lo = hi + 64 * 2048;
        for (int idx = F.blk * 512 + F.tid; idx < 2048 * 64; idx += F.G * 512) {
            const int k = idx >> 6, e = idx & 63; const float w = wr[idx];
            const unsigned h16 = cvtpk(w, 0.f) & 0xffffu; const float res = w - __uint_as_float(h16 << 16);
            hi[e * 2048 + k] = (bf16_t)h16; lo[e * 2048 + k] = (bf16_t)(cvtpk(res, 0.f) & 0xffffu);
        }
    }
}

constexpr int CV_NCHUNK = 1536;
struct CvItem { const float* W; unsigned char* WT; int K, N, drow0, k0, n0; float scale; };
__device__ __forceinline__ CvItem cv_decode(Ctx& F, int it) {
    unsigned char* ws = F.ws; CvItem c;
    if (it < 16384) { const int r = it, e = r >> 8, r2 = r & 255, kb = r2 / 8, nb = r2 % 8;
        c.W = F.in[I_WEG] + (size_t)e * 2048 * 512; c.WT = ws + WS_W_EGU_T + (size_t)e * 1024 * 2048; c.scale = F8_SW; c.K = 2048; c.N = 512; c.drow0 = gu_row(64 * nb, 0); c.k0 = 64 * kb; c.n0 = 64 * nb; }
    else if (it < 32768) { const int r = it - 16384, e = r >> 8, r2 = r & 255, kb = r2 / 8, nb = r2 % 8;
        c.W = F.in[I_WEU] + (size_t)e * 2048 * 512; c.WT = ws + WS_W_EGU_T + (size_t)e * 1024 * 2048; c.scale = F8_SW; c.K = 2048; c.N = 512; c.drow0 = gu_row(64 * nb, 1); c.k0 = 64 * kb; c.n0 = 64 * nb; }
    else { const int r = it - 32768, e = r >> 8, r2 = r & 255, kb = r2 / 32, nb = r2 % 32;
        c.W = F.in[I_WED] + (size_t)e * 512 * 2048; c.WT = ws + WS_W_ED_T + (size_t)e * 2048 * 512; c.scale = F8_SD; c.K = 512; c.N = 2048; c.drow0 = 64 * nb; c.k0 = 64 * kb; c.n0 = 64 * nb; }
    return c;
}
__device__ __forceinline__ void convert_chunk(Ctx& F, int chunk) {
    LAS float* scr = (LAS float*)(F.lds + F.wave * TR_SCR);
    int lane = F.lane; asm volatile("" : "+v"(lane));
    const int it0 = chunk * 32 + F.wave * 4;
#pragma unroll 1
    for (int i = 0; i < 4; i += 2) { const CvItem a = cv_decode(F, it0 + i), b = cv_decode(F, it0 + i + 1);
        transpose_pair_f8(CvItemF8{a.W, a.WT, a.K, a.N, a.drow0, a.k0, a.n0, a.scale}, CvItemF8{b.W, b.WT, b.K, b.N, b.drow0, b.k0, b.n0, b.scale}, scr, lane); }
}
__device__ __forceinline__ int queue_take(Ctx& F, unsigned* head) {
    volatile LAS int* slot = (volatile LAS int*)(F.lds + MISC_OFF + 64);
    __syncthreads();
    if (F.tid == 0) *slot = (int)__hip_atomic_fetch_add(head, 1u, RLX_AGENT);
    __syncthreads();
    return *slot;
}

__device__ __forceinline__ void fill_mod_tables(Ctx& F, const float* gain, int shift_off, int scale_off, bool from_partials, int bsel = -1) {
    LAS float* A = (LAS float*)F.lds; LAS float* Bt = (LAS float*)(F.lds + 16384);
    const float* modp = (const float*)(F.ws + WS_MODP); const float* modf = (const float*)(F.ws + WS_MOD); const float* bada = F.in[I_BADA];
    const int lo = bsel < 0 ? 0 : bsel * 2048, hi = bsel < 0 ? 4096 : lo + 2048;
    for (int idx = lo + F.tid; idx < hi; idx += 512) {
        const int b = idx >> 11, c = idx & 2047;
        float sh, scl;
        if (from_partials) {
            sh = bada[shift_off + c]; scl = bada[scale_off + c];
#pragma unroll 16
            for (int ks = 0; ks < 32; ++ks) { sh += modp[((size_t)ks * 2 + b) * 12288 + shift_off + c]; scl += modp[((size_t)ks * 2 + b) * 12288 + scale_off + c]; }
        } else { sh = modf[b * 12288 + shift_off + c]; scl = modf[b * 12288 + scale_off + c]; }
        A[idx] = gain[c] * (1.0f + scl); Bt[idx] = sh;
    }
    __syncthreads();
}

__device__ __forceinline__ void p1_norm(Ctx& F) {
    { const float* modp = (const float*)(F.ws + WS_MODP); float* modf = (float*)(F.ws + WS_MOD); const float* bada = F.in[I_BADA];
      for (int idx = F.blk * 512 + F.tid; idx < 2 * 12288; idx += F.G * 512) { const int b = idx / 12288, j = idx % 12288; float s = bada[j];
#pragma unroll 8
          for (int ks = 0; ks < 32; ++ks) s += modp[((size_t)ks * 2 + b) * 12288 + j];
          modf[idx] = s; } }
    const int rpb = T / F.G;
    const bool one_batch = (F.G * rpb == T) && (SEQ % rpb == 0);
    const int row_lo = one_batch ? F.blk * rpb : 0, row_hi = one_batch ? row_lo + rpb : T, rstep = one_batch ? 8 : F.G * 8, r0 = one_batch ? row_lo + F.wave : F.blk * 8 + F.wave;
    fill_mod_tables(F, F.in[I_GMIX], 0, 2048, true, one_batch ? row_lo / SEQ : -1);
    const LAS float* A = (const LAS float*)F.lds; const LAS float* Bt = (const LAS float*)(F.lds + 16384);
    const float* x = F.in[I_X]; bf16_t* H = (bf16_t*)(F.ws + WS_H);
    for (int row = r0; row < row_hi; row += 2 * rstep) {
        const int row2 = row + rstep; const bool has2 = row2 < row_hi;
        const int b = row / SEQ, b2 = has2 ? row2 / SEQ : b;
        const f32x4* xr = (const f32x4*)(x + (size_t)row * 2048) + F.lane;
        const f32x4* xr2 = (const f32x4*)(x + (size_t)(has2 ? row2 : row) * 2048) + F.lane;
        f32x4 v[8], v2[8]; float ss = 0.f, ss2 = 0.f;
#pragma unroll
        for (int j = 0; j < 8; ++j) { v[j] = __builtin_nontemporal_load(xr + 64 * j); v2[j] = __builtin_nontemporal_load(xr2 + 64 * j); }
#pragma unroll
        for (int j = 0; j < 8; ++j) { ss += (v[j].x * v[j].x + v[j].y * v[j].y) + (v[j].z * v[j].z + v[j].w * v[j].w); ss2 += (v2[j].x * v2[j].x + v2[j].y * v2[j].y) + (v2[j].z * v2[j].z + v2[j].w * v2[j].w); }
        const float rstd = 1.0f / sqrtf(wave_sum(ss) * (1.0f / 2048.0f) + RMS_EPS), rstd2 = 1.0f / sqrtf(wave_sum(ss2) * (1.0f / 2048.0f) + RMS_EPS);
        unsigned long long* o8 = (unsigned long long*)(H + (size_t)row * 2048) + F.lane;
        unsigned long long* o82 = (unsigned long long*)(H + (size_t)row2 * 2048) + F.lane;
#pragma unroll
        for (int j = 0; j < 8; ++j) { const int c = 4 * F.lane + 256 * j;
            const f32x4 a = *(const LAS f32x4*)(A + b * 2048 + c), sft = *(const LAS f32x4*)(Bt + b * 2048 + c);
            const f32x4 y = v[j] * rstd * a + sft;
            if constexpr (P2F8) ((unsigned*)((unsigned char*)H + (size_t)row * 2048))[F.lane + 64 * j] = epi::pack4_f8(y.x * F8_SH, y.y * F8_SH, y.z * F8_SH, y.w * F8_SH);
            else o8[64 * j] = (unsigned long long)cvtpk(y.x, y.y) | ((unsigned long long)cvtpk(y.z, y.w) << 32);
            if (has2) { const f32x4 a2 = *(const LAS f32x4*)(A + b2 * 2048 + c), sft2 = *(const LAS f32x4*)(Bt + b2 * 2048 + c);
                const f32x4 y2 = v2[j] * rstd2 * a2 + sft2;
                if constexpr (P2F8) ((unsigned*)((unsigned char*)H + (size_t)row2 * 2048))[F.lane + 64 * j] = epi::pack4_f8(y2.x * F8_SH, y2.y * F8_SH, y2.z * F8_SH, y2.w * F8_SH);
                else o82[64 * j] = (unsigned long long)cvtpk(y2.x, y2.y) | ((unsigned long long)cvtpk(y2.z, y2.w) << 32); } }
    }
}

__device__ __forceinline__ void p3_kmean(Ctx& F) {
    const bf16_t* KMT = (const bf16_t*)(F.ws + WS_KMT); float* KM = (float*)(F.ws + WS_KMEAN);
    LAS float* red = (LAS float*)F.lds;
    for (int item = F.blk; item < 512; item += F.G) {
        const int b = item >> 8, h = (item >> 5) & 7, n = item & 31;
        const int cp = F.tid & 63, rg = F.tid >> 6;
        const bf16_t* base = KMT + (((size_t)h * 256 + b * 128 + 4 * n) * 64 + 32 * rg) * 128 + 2 * cp;
        float s0 = 0.f, s1 = 0.f;
#pragma unroll 8
        for (int rr = 0; rr < 32; ++rr) { const unsigned u = *(const unsigned*)(base + (size_t)rr * 128); s0 += bf_lo(u); s1 += bf_hi(u); }
        __syncthreads();
        red[rg * 128 + 2 * cp] = s0; red[rg * 128 + 2 * cp + 1] = s1;
        __syncthreads();
        if (F.tid < 128) { float s = 0.f;
#pragma unroll
            for (int g = 0; g < 8; ++g) s += red[g * 128 + F.tid];
            KM[(size_t)item * 128 + F.tid] = s * (1.0f / 256.0f); }
    }
    __syncthreads();
}

__device__ __forceinline__ void p4_gating(Ctx& F) {
    const bf16_t* QM = (const bf16_t*)(F.ws + WS_QM); const float* KM = (const float*)(F.ws + WS_KMEAN);
    float* ML = (float*)(F.ws + WS_ML); int* MLIST = (int*)(F.ws + WS_MLIST); unsigned* mcnt = F.ctl + CW_MCNT;
    for (int grp = F.blk; grp < T / 64; grp += F.G) {
        const int h = F.wave, tok = grp * 64 + F.lane, b = tok / SEQ, qs = tok % SEQ, cur = qs >> 8;
        const int curu = __builtin_amdgcn_readfirstlane(cur), bu = __builtin_amdgcn_readfirstlane(b);
        float q[128];
        const u32x4* qp = (const u32x4*)(QM + (size_t)tok * 1024 + h * 128);
#pragma unroll
        for (int i = 0; i < 16; ++i) { const u32x4 u = qp[i]; q[8 * i + 0] = bf_lo(u.x); q[8 * i + 1] = bf_hi(u.x); q[8 * i + 2] = bf_lo(u.y); q[8 * i + 3] = bf_hi(u.y);
            q[8 * i + 4] = bf_lo(u.z); q[8 * i + 5] = bf_hi(u.z); q[8 * i + 6] = bf_lo(u.w); q[8 * i + 7] = bf_hi(u.w); }
        float v0 = -INFINITY, v1 = -INFINITY, v2 = -INFINITY; int i0 = -1, i1 = -1, i2 = -1;
        const float* kmb = KM + (size_t)((bu * 8 + h) * 32) * 128;
        for (int n = 0; n < curu; ++n) {
            const float* km = kmb + n * 128;
            float a0 = 0.f, a1 = 0.f, a2 = 0.f, a3 = 0.f;
#pragma unroll
            for (int d = 0; d < 128; d += 4) { a0 += q[d] * km[d]; a1 += q[d + 1] * km[d + 1]; a2 += q[d + 2] * km[d + 2]; a3 += q[d + 3] * km[d + 3]; }
            const float s = (a0 + a1) + (a2 + a3);
            if (s > v0) { v2 = v1; i2 = i1; v1 = v0; i1 = i0; v0 = s; i0 = n; }
            else if (s > v1) { v2 = v1; i2 = i1; v1 = s; i1 = n; }
            else if (s > v2) { v2 = s; i2 = n; }
        }
        float* ml = ML + ((size_t)tok * 8 + h) * 8;
        if (i0 < 0) *(f32x2*)(ml + 0) = (f32x2){-INFINITY, 0.f};
        if (i1 < 0) *(f32x2*)(ml + 2) = (f32x2){-INFINITY, 0.f};
        if (i2 < 0) *(f32x2*)(ml + 4) = (f32x2){-INFINITY, 0.f};
        for (int n = 0; n < curu; ++n) {
            const bool hit = (i0 == n) || (i1 == n) || (i2 == n);
            const unsigned long long mask = __ballot(hit);
            if (mask) {
                const int cntw = __popcll(mask);
                unsigned base = 0;
                if (F.lane == 0) base = __hip_atomic_fetch_add(mcnt + ((bu * 8 + h) * 32 + n), (unsigned)cntw, RLX_AGENT);
                base = __builtin_amdgcn_readfirstlane(base);
                if (hit) { const int pos = base + __popcll(mask & ((1ull << F.lane) - 1ull)); const int slot = (i0 == n) ? 0 : ((i1 == n) ? 1 : 2);
                    MLIST[(size_t)((bu * 8 + h) * 32 + n) * 8192 + pos] = (qs << 2) | slot; }
            }
        }
    }
}

__device__ __forceinline__ void p6_merge(Ctx& F) {
    const bf16_t* PARTS = (const bf16_t*)(F.ws + WS_PARTS); const float* ML = (const float*)(F.ws + WS_ML); bf16_t* AM = (bf16_t*)(F.ws + WS_AM);
    const int gw = F.blk * 8 + F.wave, NGW = F.G * 8;
    for (int tok = gw; tok < T; tok += NGW) {
        f32x4 ml01[2], ml23[2]; u32x2 pu[2][4];
#pragma unroll
        for (int i = 0; i < 2; ++i) {
            const int item = F.lane + 64 * i, h = item >> 4, ch = item & 15;
            const float* ml = ML + ((size_t)tok * 8 + h) * 8;
            ml01[i] = *(const f32x4*)ml; ml23[i] = *(const f32x4*)(ml + 4);
            const unsigned char* pb = (const unsigned char*)PARTS + (((size_t)tok * 8 + h) * 4) * 128 + ch * 8;
#pragma unroll
            for (int s4 = 0; s4 < 4; ++s4) pu[i][s4] = __builtin_nontemporal_load((const u32x2*)(pb + s4 * 128));
        }
#pragma unroll
        for (int i = 0; i < 2; ++i) {
            const int item = F.lane + 64 * i, h = item >> 4, ch = item & 15;
            const float m0 = ml01[i][0], l0 = ml01[i][1], m1 = ml01[i][2], l1 = ml01[i][3], m2 = ml23[i][0], l2 = ml23[i][1], m3 = ml23[i][2], l3 = ml23[i][3];
            const float M = fmaxf(fmaxf(m0, m1), fmaxf(m2, m3));
            const float w0 = l0 * fast_exp2(m0 - M), w1 = l1 * fast_exp2(m1 - M), w2 = l2 * fast_exp2(m2 - M), w3 = l3 * fast_exp2(m3 - M);
            const float inv = 1.0f / (w0 + w1 + w2 + w3);
            float acc[8];
#pragma unroll
            for (int j = 0; j < 8; ++j) acc[j] = 0.f;
            const float ws4[4] = {w0, w1, w2, w3};
#pragma unroll
            for (int s4 = 0; s4 < 4; ++s4) {
                const float w = ws4[s4]; u32x2 u = pu[i][s4];
                if (!(w > 0.f)) u = (u32x2){0u, 0u};
                { const f32x2 a = __builtin_amdgcn_cvt_pk_f32_fp8((int)u.x, false), b = __builtin_amdgcn_cvt_pk_f32_fp8((int)u.x, true), c = __builtin_amdgcn_cvt_pk_f32_fp8((int)u.y, false), d = __builtin_amdgcn_cvt_pk_f32_fp8((int)u.y, true);
                  acc[0] += w * a[0]; acc[1] += w * a[1]; acc[2] += w * b[0]; acc[3] += w * b[1]; acc[4] += w * c[0]; acc[5] += w * c[1]; acc[6] += w * d[0]; acc[7] += w * d[1]; }
            }
            if constexpr (O78F8) { const float i8 = inv * (F8_SAM / F8_SPART);
                *(u32x2*)((unsigned char*)AM + (size_t)tok * 1024 + h * 128 + ch * 8) = (u32x2){epi::pack4_f8(acc[0] * i8, acc[1] * i8, acc[2] * i8, acc[3] * i8), epi::pack4_f8(acc[4] * i8, acc[5] * i8, acc[6] * i8, acc[7] * i8)}; }
            else { u32x4 o; o.x = cvtpk(acc[0] * inv, acc[1] * inv); o.y = cvtpk(acc[2] * inv, acc[3] * inv); o.z = cvtpk(acc[4] * inv, acc[5] * inv); o.w = cvtpk(acc[6] * inv, acc[7] * inv);
            *(u32x4*)(AM + (size_t)tok * 1024 + h * 128 + ch * 8) = o; }
        }
    }
}
constexpr int P9_RSTD = 32768, P9_LG = 33792, P9_LGROW = 68, P9_LCNT = P9_LG + 2 * 64 * P9_LGROW * 4, P9_LBASE = P9_LCNT + 256, P9_END = P9_LBASE + 256;
static_assert(P9_END <= RING_BYTES, "P9 LDS");
__device__ __forceinline__ void p9_route(Ctx& F) {
    fill_mod_tables(F, F.in[I_GFFN], 6144, 8192, false);
    const LAS float* A2 = (const LAS float*)F.lds; const LAS float* B2 = (const LAS float*)(F.lds + 16384);
    LAS float* rstd_l = (LAS float*)(F.lds + P9_RSTD); LAS float* LG = (LAS float*)(F.lds + P9_LG);
    LAS int* lcnt = (LAS int*)(F.lds + P9_LCNT); LAS int* lbase = (LAS int*)(F.lds + P9_LBASE);
    const bf16_t* x1 = (const bf16_t*)(F.ws + WS_X1); bf16_t* H2 = (bf16_t*)(F.ws + WS_H2); unsigned char* H2F8 = F.ws + WS_H2F8;
    const bf16_t* WRH = (const bf16_t*)(F.ws + WS_WR); const bf16_t* WRL = WRH + 64 * 2048;
    const float* rbias = F.in[I_RBIAS];
    int* ELIST = (int*)(F.ws + WS_ELIST); int* TOKE = (int*)(F.ws + WS_TOKE); float* TOKW = (float*)(F.ws + WS_TOKW);
    unsigned* ecnt = F.ctl + CW_ECNT;
    for (int grp = F.blk; grp < T / 64; grp += F.G) {
        const int tokb = grp * 64, b = tokb / SEQ;
        if (F.tid < 64) lcnt[F.tid] = 0;
        for (int i = 0; i < 8; i += 4) {
            const int tl = F.wave * 8 + i;
            u32x4 va[4][4];
#pragma unroll
            for (int q = 0; q < 4; ++q) { const u32x4* xr = (const u32x4*)(x1 + (size_t)(tokb + tl + q) * 2048) + F.lane;
#pragma unroll
                for (int j = 0; j < 4; ++j) va[q][j] = xr[64 * j]; }
#pragma unroll
            for (int q = 0; q < 4; ++q) { float ss = 0.f;
#pragma unroll
                for (int j = 0; j < 4; ++j) { const u32x4 u = va[q][j];
                    const float a0 = bf_lo(u.x), a1 = bf_hi(u.x), a2 = bf_lo(u.y), a3 = bf_hi(u.y), a4 = bf_lo(u.z), a5 = bf_hi(u.z), a6 = bf_lo(u.w), a7 = bf_hi(u.w);
                    ss += ((a0 * a0 + a1 * a1) + (a2 * a2 + a3 * a3)) + ((a4 * a4 + a5 * a5) + (a6 * a6 + a7 * a7)); }
                ss = wave_sum(ss);
                if (F.lane == 0) rstd_l[tl + q] = 1.0f / sqrtf(ss * (1.0f / 2048.0f) + RMS_EPS); }
        }
        __syncthreads();
        {
            const int tg = F.wave & 3, kh = F.wave >> 2, tc = F.lane & 15, kg = F.lane >> 4;
            const int tl = 16 * tg + tc; const float rs = rstd_l[tl];
            const bf16_t* xrow = x1 + (size_t)(tokb + tl) * 2048;
            bf16_t* hrow = H2 + (size_t)(tokb + tl) * 2048;
            f32x4 acc[4];
#pragma unroll
            for (int nt = 0; nt < 4; ++nt) acc[nt] = (f32x4){0.f, 0.f, 0.f, 0.f};
#pragma unroll 2
            for (int s = 32 * kh; s < 32 * kh + 32; ++s) {
                const int c0 = 32 * s + 8 * kg;
                const u32x4 xu = *(const u32x4*)(xrow + c0);
                const f32x4 xa = {bf_lo(xu.x), bf_hi(xu.x), bf_lo(xu.y), bf_hi(xu.y)}, xb = {bf_lo(xu.z), bf_hi(xu.z), bf_lo(xu.w), bf_hi(xu.w)};
                const f32x4 aa = *(const LAS f32x4*)(A2 + b * 2048 + c0), ab = *(const LAS f32x4*)(A2 + b * 2048 + c0 + 4);
                const f32x4 ba = *(const LAS f32x4*)(B2 + b * 2048 + c0), bb = *(const LAS f32x4*)(B2 + b * 2048 + c0 + 4);
                const f32x4 ya = xa * rs * aa + ba, yb = xb * rs * ab + bb;
                u32x4 hi; hi.x = cvtpk(ya[0], ya[1]); hi.y = cvtpk(ya[2], ya[3]); hi.z = cvtpk(yb[0], yb[1]); hi.w = cvtpk(yb[2], yb[3]);
                *(u32x2*)(H2F8 + (size_t)(tokb + tl) * 2048 + c0) = (u32x2){epi::pack4_f8(ya[0] * F8_SH, ya[1] * F8_SH, ya[2] * F8_SH, ya[3] * F8_SH), epi::pack4_f8(yb[0] * F8_SH, yb[1] * F8_SH, yb[2] * F8_SH, yb[3] * F8_SH)};
                u32x4 lo; lo.x = cvtpk(ya[0] - bf_lo(hi.x), ya[1] - bf_hi(hi.x)); lo.y = cvtpk(ya[2] - bf_lo(hi.y), ya[3] - bf_hi(hi.y));
                lo.z = cvtpk(yb[0] - bf_lo(hi.z), yb[1] - bf_hi(hi.z)); lo.w = cvtpk(yb[2] - bf_lo(hi.w), yb[3] - bf_hi(hi.w));
                const bf16x8 hf = __builtin_bit_cast(bf16x8, hi), lf = __builtin_bit_cast(bf16x8, lo);
#pragma unroll
                for (int nt = 0; nt < 4; ++nt) {
                    const bf16x8 wh = *(const bf16x8*)(WRH + (size_t)(16 * nt + tc) * 2048 + c0), wl = *(const bf16x8*)(WRL + (size_t)(16 * nt + tc) * 2048 + c0);
                    acc[nt] = __builtin_amdgcn_mfma_f32_16x16x32_bf16(wh, hf, acc[nt], 0, 0, 0);
                    acc[nt] = __builtin_amdgcn_mfma_f32_16x16x32_bf16(wh, lf, acc[nt], 0, 0, 0);
                    acc[nt] = __builtin_amdgcn_mfma_f32_16x16x32_bf16(wl, hf, acc[nt], 0, 0, 0);
                }
            }
#pragma unroll
            for (int nt = 0; nt < 4; ++nt) *(LAS f32x4*)(LG + (kh * 64 + tl) * P9_LGROW + 16 * nt + 4 * kg) = acc[nt];
        }
        __syncthreads();
        int se[8], sslot[8]; float sw[8];
        if (F.tid < 64) {
            LAS float* row0 = LG + F.tid * P9_LGROW; const LAS float* row1 = LG + (64 + F.tid) * P9_LGROW;
            float sl[64];
#pragma unroll
            for (int e = 0; e < 64; ++e) { const float s = sigmoidf_(row0[e] + row1[e]); row0[e] = s; sl[e] = s + rbias[e]; }
            float gs[8];
#pragma unroll
            for (int g = 0; g < 8; ++g) { float m1 = -INFINITY, m2 = -INFINITY;
#pragma unroll
                for (int j = 0; j < 8; ++j) { const float v = sl[8 * g + j]; if (v > m1) { m2 = m1; m1 = v; } else if (v > m2) m2 = v; }
                gs[g] = m1 + m2; }
            unsigned gmask = 0u;
#pragma unroll
            for (int it = 0; it < 4; ++it) { float best = -INFINITY; int bi = 0;
#pragma unroll
                for (int g = 0; g < 8; ++g) { const bool free_ = !((gmask >> g) & 1u); if (free_ && gs[g] > best) { best = gs[g]; bi = g; } }
                gmask |= 1u << bi; }
            unsigned long long picked = 0ull; float wsum = 0.f;
#pragma unroll
            for (int it = 0; it < 8; ++it) { float best = -INFINITY; int bi = 0;
#pragma unroll
                for (int e = 0; e < 64; ++e) { const bool ok = ((gmask >> (e >> 3)) & 1u) && !((picked >> e) & 1ull); if (ok && sl[e] > best) { best = sl[e]; bi = e; } }
                picked |= 1ull << bi; se[it] = bi; const float s = row0[bi]; sw[it] = s; wsum += s; }
            const float inv = 2.5f / wsum;
#pragma unroll
            for (int k = 0; k < 8; ++k) { sw[k] *= inv; sslot[k] = __hip_atomic_fetch_add(lcnt + se[k], 1, __ATOMIC_RELAXED, __HIP_MEMORY_SCOPE_WORKGROUP); }
        }
        __syncthreads();
        if (F.tid < 64) { const int c = lcnt[F.tid]; lbase[F.tid] = c > 0 ? (int)__hip_atomic_fetch_add(ecnt + F.tid, (unsigned)c, RLX_AGENT) : 0; }
        __syncthreads();
        if (F.tid < 64) { const int tok = tokb + F.tid;
#pragma unroll
            for (int k = 0; k < 8; ++k) { const int slot = lbase[se[k]] + sslot[k];
                ELIST[(size_t)se[k] * 16384 + slot] = tok; TOKE[tok * 8 + k] = (se[k] << 16) | slot; TOKW[tok * 8 + k] = sw[k]; } }
        __syncthreads();
    }
}

constexpr int MT_CNT = 0, MT_TST = 256, MT_COFF = 768, MT_GTAB = 2048;
__device__ __forceinline__ void moe_tables(Ctx& F) {
    LAS int* cnt = (LAS int*)(F.lds + LDSX_OFF + MT_CNT); LAS int* tst = (LAS int*)(F.lds + LDSX_OFF + MT_TST); LAS int* coff = (LAS int*)(F.lds + LDSX_OFF + MT_COFF);
    if (F.tid < 64) cnt[F.tid] = (int)__hip_atomic_load(F.ctl + CW_ECNT + F.tid, RLX_AGENT);
    __syncthreads();
    if (F.tid == 0) { int t = 0, c = 0; for (int e = 0; e < 64; ++e) { tst[e] = t; coff[e] = c; const int n = cnt[e]; t += (n + 255) >> 8; c += n; } tst[64] = t; coff[64] = c; }
    __syncthreads();
}
struct MoeSched {
    const LAS int* cnt; const LAS int* tst; const LAS int* coff; int G, c, npn_log2; const char* A; const char* B; size_t a_tile_bytes, b_exp_bytes, b_tile_bytes; bool compact;
    __device__ __forceinline__ bool next(int i, pg8::Unit& u) const {
        const int ntile = tst[64];
        const long L = (long)i * G + c; if (L >= ((long)ntile << npn_log2)) return false;
        const int rt = (int)(L >> npn_log2), pn = (int)(L & ((1 << npn_log2) - 1));
        int lo = 0, hi = 64;
#pragma unroll
        for (int s = 0; s < 6; ++s) { const int mid = (lo + hi) >> 1; if (tst[mid] <= rt) lo = mid; else hi = mid; }
        int e = lo;
        e = __builtin_amdgcn_readfirstlane(e);
        const int j = rt - __builtin_amdgcn_readfirstlane(tst[e]);
        const int n = __builtin_amdgcn_readfirstlane(cnt[e]);
        u.pm = rt; u.pn = pn; u.aux = e;
        u.valid = (n - 256 * j) < 256 ? (n - 256 * j) : 256;
        u.rowbase = compact ? (__builtin_amdgcn_readfirstlane(coff[e]) + 256 * j) : rt * 256;
        u.A = A + (size_t)rt * a_tile_bytes; u.B = B + (size_t)e * b_exp_bytes + (size_t)pn * b_tile_bytes;
        return true;
    }
};

__device__ __forceinline__ void p12_combine(Ctx& F) {
    moe_tables(F);
    const LAS int* coff = (const LAS int*)(F.lds + LDSX_OFF + MT_COFF);
    const unsigned char* Y = (const unsigned char*)(F.ws + WS_Y); const int* TOKE = (const int*)(F.ws + WS_TOKE); const float* TOKW = (const float*)(F.ws + WS_TOKW);
    const float* modf = (const float*)(F.ws + WS_MOD); const float* gfin = F.in[I_GFINAL]; const bf16_t* SHOUT = (const bf16_t*)(F.ws + WS_SHOUT);
    float* out = F.out;
    const int gw = F.blk * 8 + F.wave, NGW = F.G * 8;
    for (int tok = gw; tok < T; tok += NGW) {
        const int b = tok / SEQ;
        f32x4 acc[8];
        int es8[8]; float w8[8];
#pragma unroll
        for (int k = 0; k < 8; ++k) { es8[k] = TOKE[tok * 8 + k]; w8[k] = TOKW[tok * 8 + k]; }
        f32x4* xr = (f32x4*)(out + (size_t)tok * 2048) + F.lane;
        f32x4 v[8];
        { const unsigned long long* x1r = (const unsigned long long*)((const bf16_t*)(F.ws + WS_X1) + (size_t)tok * 2048) + F.lane;
#pragma unroll
          for (int j = 0; j < 8; ++j) { const unsigned long long u = __builtin_nontemporal_load(x1r + 64 * j); const unsigned lo = (unsigned)u, hi = (unsigned)(u >> 32);
              v[j] = (f32x4){bf_lo(lo), bf_hi(lo), bf_lo(hi), bf_hi(hi)}; } }
        { const unsigned* sr = (const unsigned*)((const unsigned char*)SHOUT + (size_t)tok * 2048) + F.lane;
#pragma unroll
          for (int j = 0; j < 8; ++j) { const int u = (int)__builtin_nontemporal_load(sr + 64 * j); const f32x2 lo = __builtin_amdgcn_cvt_pk_f32_fp8(u, false), hi = __builtin_amdgcn_cvt_pk_f32_fp8(u, true);
              acc[j].x = lo[0]; acc[j].y = lo[1]; acc[j].z = hi[0]; acc[j].w = hi[1]; } }
#pragma unroll
        for (int kk = 0; kk < 8; kk += 4) {
            unsigned yu[4][8];
#pragma unroll
            for (int k = 0; k < 4; ++k) { const int e = es8[kk + k] >> 16, slot = es8[kk + k] & 0xffff;
                const unsigned* yr = (const unsigned*)(Y + (size_t)(coff[e] + slot) * 2048) + F.lane;
#pragma unroll
                for (int j = 0; j < 8; ++j) yu[k][j] = __builtin_nontemporal_load(yr + 64 * j); }
#pragma unroll
            for (int k = 0; k < 4; ++k) { const float w = w8[kk + k];
#pragma unroll
                for (int j = 0; j < 8; ++j) { const int u = (int)yu[k][j]; const f32x2 lo = __builtin_amdgcn_cvt_pk_f32_fp8(u, false), hi = __builtin_amdgcn_cvt_pk_f32_fp8(u, true);
                    acc[j].x += w * lo[0]; acc[j].y += w * lo[1]; acc[j].z += w * hi[0]; acc[j].w += w * hi[1]; } }
        }
        float ss = 0.f;
#pragma unroll
        for (int j = 0; j < 8; ++j) { const int c = 4 * F.lane + 256 * j; const f32x4 g2 = *(const f32x4*)(modf + b * 12288 + 10240 + c);
            v[j] = v[j] + g2 * acc[j]; ss += (v[j].x * v[j].x + v[j].y * v[j].y) + (v[j].z * v[j].z + v[j].w * v[j].w); }
        const float rstd = 1.0f / sqrtf(wave_sum(ss) * (1.0f / 2048.0f) + RMS_EPS);
#pragma unroll
        for (int j = 0; j < 8; ++j) { const int c = 4 * F.lane + 256 * j; const f32x4 g = *(const f32x4*)(gfin + c); __builtin_nontemporal_store(v[j] * rstd * g, xr + 64 * j); }
    }
}
struct Args { const float* in[22]; float* out; unsigned char* ws; int ph_lo, ph_hi; };
static_assert(sizeof(Args) == 22 * 8 + 8 + 8 + 8, "Args has no padding");

__global__ void __launch_bounds__(512, 2) fwd_kernel(Args args) {
    extern __shared__ __attribute__((aligned(16))) unsigned char lds_raw[];
    Ctx F;
    F.lds = (LAS unsigned char*)lds_raw;
    F.tid = threadIdx.x; F.lane = F.tid & 63; F.wave = __builtin_amdgcn_readfirstlane(F.tid >> 6);
    F.G = gridDim.x; F.blk = blockIdx.x;
    F.ws = args.ws; F.ctl = (unsigned*)(args.ws + WS_CTL); F.out = args.out;
    F.in = args.in;
    volatile LAS unsigned* MISC = (volatile LAS unsigned*)(F.lds + MISC_OFF);
    if (F.tid < 32) MISC[F.tid] = 0u;
    __syncthreads();
    XcdBarrier bar; bar.bar = F.ctl + CW_BAR; bar.x = 0; bar.st = nullptr;
    if (MK_N_LAUNCHES == 1) bar = xcd_barrier_post(F.ctl + CW_BAR, MISC + 8);
    const int lo = args.ph_lo, hi = args.ph_hi;
    unsigned char* ws = args.ws;
#define IN(k) (lo <= (k) && (k) < hi && ((PHASE_MASK >> (k)) & 1u))
#define SEAM(k) do { if (MK_N_LAUNCHES == 1 && (k) + 1 < hi) xcd_barrier(bar); } while (0)
#define NREP(k) (((REP_MASK >> (k)) & 1u) ? 2 : 1)
    typedef pg8::StaticOrder SO;

    if (lo <= 0 && 0 < hi) { if (IN(0)) { for (int rep_ = 0; rep_ < NREP(0); ++rep_) { if (rep_) xcd_barrier(bar); p0_prologue(F); } } SEAM(0); }
    if (lo <= 1 && 1 < hi) { if (IN(1)) { for (int rep_ = 0; rep_ < NREP(1); ++rep_) { if (rep_) xcd_barrier(bar); p1_norm(F); } } SEAM(1); }
    if (lo <= 2 && 2 < hi) {
        if (IN(2)) {
#pragma unroll 1
        for (int rep_ = 0; rep_ < NREP(2); ++rep_) { if (rep_) xcd_barrier(bar);
            const char* H = (const char*)(ws + WS_H); const char* W = (const char*)(ws + WS_W_IN_T);
            constexpr int KP = P2F8 ? 1024 : 2048;
            { SO S; S.init(H, W, T, 8192, KP, F.G, F.blk);
              epi::ProjEpi E{epi::StoreQK8{ws + WS_QD, ws + WS_KDT, att::D8_QS, att::D8_KS}, epi::StoreQKboth{epi::StoreQK{(bf16_t*)(ws + WS_QM), (bf16_t*)(ws + WS_KMT), 1.0f}, ws + WS_QM8, ws + WS_KMT8}, epi::StoreBf16<1>{(bf16_t*)(ws + WS_GATES), 4096}};
              pg8::gemm_phase<epi::ProjEpi, SO, true, true, false, P2F8>(F.lds, KP, S, E, nullptr); }
            { SO S; S.init(W + (size_t)8192 * KP * 2, H, 2048, T, KP, F.G, F.blk); epi::ProjVT E{epi::StoreVT8{ws + WS_VDT, att::D8_VS}, epi::StoreVT8{ws + WS_VMT8, att::D8_VS}};
              pg8::gemm_phase<epi::ProjVT, SO, true, true, false, P2F8>(F.lds, KP, S, E, nullptr); }
        }
        }
        SEAM(2);
    }
    if (lo <= 3 && 3 < hi) {
        if (IN(3)) {
#pragma unroll 1
        for (int rep_ = 0; rep_ < NREP(3); ++rep_) { if (rep_) xcd_barrier(bar);
            const float* lv = F.in[I_LAMBDA];
            float d1 = 0.f, d2 = 0.f;
            for (int i = 0; i < 64; ++i) { d1 += lv[i] * lv[64 + i]; d2 += lv[128 + i] * lv[192 + i]; }
            if (F.tid == 0) *(LAS float*)(F.lds + MISC_OFF + 68) = expf(d1) - expf(d2) + 0.2f;
            {
                const int x = (int)(xb_xcc_id() & 7u);
                const bool converter = ((F.blk >> 3) & 3) == 3;
                if (converter) { for (int c = queue_take(F, F.ctl + CW_CQ); c < CV_NCHUNK; c = queue_take(F, F.ctl + CW_CQ)) { __syncthreads(); convert_chunk(F, c); } }
#pragma unroll 1
                for (int k = 0; k < 8; ++k) {
                    const int xq = (x + k) & 7;
#pragma unroll 1
                    for (int i = queue_take(F, F.ctl + CW_AQ + 64 * xq); i < 128; i = queue_take(F, F.ctl + CW_AQ + 64 * xq)) {
                        const int bh = 2 * xq + (i & 1), qt = 63 - (i >> 1);
                        att::diff_unit8(F.lds, bh >> 3, bh & 7, qt, ws + WS_QD, ws + WS_KDT, ws + WS_VDT, (bf16_t*)(ws + WS_AD), F.in[I_SUBLN], F.in[I_RELB]);
                    }
                }
                for (int c = queue_take(F, F.ctl + CW_CQ); c < CV_NCHUNK; c = queue_take(F, F.ctl + CW_CQ)) { __syncthreads(); convert_chunk(F, c); }
            }
            __syncthreads();
            p3_kmean(F);
        }
        }
        SEAM(3);
    }
    if (lo <= 4 && 4 < hi) { if (IN(4)) p4_gating(F); SEAM(4); }
    if (lo <= 5 && 5 < hi) {
        if (IN(5)) {
#pragma unroll 1
        for (int rep_ = 0; rep_ < NREP(5); ++rep_) { if (rep_) xcd_barrier(bar);
            constexpr int MB_CPU = 2;
            LAS int* pre = (LAS int*)(F.lds + LDSX_OFF);
            const unsigned* mcnt = F.ctl + CW_MCNT;
            const int mycnt = (int)__hip_atomic_load(mcnt + F.tid, RLX_AGENT);
            pre[F.tid] = (1 + ((mycnt + 255) >> 8) + MB_CPU - 1) / MB_CPU;
            __syncthreads();
            int src = 0;
            for (int off = 1; off < 512; off <<= 1) { const int v = pre[src * 512 + F.tid] + (F.tid >= off ? pre[src * 512 + F.tid - off] : 0); pre[(src ^ 1) * 512 + F.tid] = v; src ^= 1; __syncthreads(); }
            LAS int* inc = (LAS int*)(F.lds + att::MB_INC);
            inc[F.tid] = pre[src * 512 + F.tid];
            __syncthreads();
            const int total = inc[511];
            for (int u = F.blk; u < total; u += F.G) {
                int lo_ = -1, hi_ = 511;
#pragma unroll
                for (int st = 0; st < 9; ++st) { const int mid = (lo_ + hi_) >> 1; if (inc[mid] > u) hi_ = mid; else lo_ = mid; }
                const int l = __builtin_amdgcn_readfirstlane(hi_);
                const int before = l > 0 ? __builtin_amdgcn_readfirstlane(inc[l - 1]) : 0;
                const int j = u - before;
                const int cntl = (int)__builtin_amdgcn_readfirstlane(__hip_atomic_load(mcnt + l, RLX_AGENT));
                const int nch = 1 + ((cntl + 255) >> 8);
                const int c0 = j * MB_CPU, c1 = (c0 + MB_CPU) < nch ? (c0 + MB_CPU) : nch;
                att::moba_block8(F.lds, l >> 8, (l >> 5) & 7, l & 31, (const int*)(ws + WS_MLIST) + (size_t)l * 8192, cntl, c0, c1, ws + WS_QM8, ws + WS_KMT8, ws + WS_VMT8, (bf16_t*)(ws + WS_PARTS), (float*)(ws + WS_ML), F.in[I_RELB]);
            }
            __syncthreads();
        }
        }
        SEAM(5);
    }
    if (lo <= 6 && 6 < hi) { if (IN(6)) { for (int rep_ = 0; rep_ < NREP(6); ++rep_) { if (rep_) xcd_barrier(bar); p6_merge(F); } } SEAM(6); }
    if (lo <= 7 && 7 < hi) {
        if (IN(7)) {
#pragma unroll 1
        for (int rep_ = 0; rep_ < NREP(7); ++rep_) { if (rep_) xcd_barrier(bar);
            { pg8::PairOrder S; S.init(ws + WS_AD, ws + WS_W_OD_T, ws + WS_AM, ws + WS_W_OM_T, T, 2048, O78F8 ? 512 : 1024, F.G, F.blk);
              epi::GatePair E{epi::GateMul<0>{(const bf16_t*)(ws + WS_GATES), 0, nullptr, (bf16_t*)(ws + WS_T1)}, epi::GateMul<1>{(const bf16_t*)(ws + WS_GATES), 2048, (const bf16_t*)(ws + WS_T1), (bf16_t*)(ws + WS_G)}};
              pg8::gemm_phase<epi::GatePair, pg8::PairOrder, true, true, false, O78F8>(F.lds, O78F8 ? 512 : 1024, S, E, nullptr); }
        }
        }
        SEAM(7);
    }
    if (lo <= 8 && 8 < hi) {
        if (IN(8)) {
#pragma unroll 1
        for (int rep_ = 0; rep_ < NREP(8); ++rep_) { if (rep_) xcd_barrier(bar);
            SO S; S.init(ws + WS_G, ws + WS_W_OUT_T, T, 2048, O78F8 ? 1024 : 2048, F.G, F.blk); epi::ResidBf16 E{F.in[I_X], (bf16_t*)(ws + WS_X1), (const float*)(ws + WS_MOD), 4096};
            pg8::gemm_phase<epi::ResidBf16, SO, true, true, false, O78F8>(F.lds, O78F8 ? 1024 : 2048, S, E, nullptr);
        }
        }
        SEAM(8);
    }
    if (lo <= 9 && 9 < hi) { if (IN(9)) p9_route(F); SEAM(9); }
    if (lo <= 10 && 10 < hi) {
        if (IN(10)) {
#pragma unroll 1
        for (int rep_ = 0; rep_ < NREP(10); ++rep_) { if (rep_) xcd_barrier(bar);
            moe_tables(F);
            MoeSched S{(const LAS int*)(F.lds + LDSX_OFF + MT_CNT), (const LAS int*)(F.lds + LDSX_OFF + MT_TST), (const LAS int*)(F.lds + LDSX_OFF + MT_COFF), F.G, F.blk, 2,
                       (const char*)(ws + WS_H2F8), (const char*)(ws + WS_W_EGU_T), 0, (size_t)1024 * 2048, (size_t)256 * 2048, false};
            LAS unsigned short* gtab = (LAS unsigned short*)(F.lds + LDSX_OFF + MT_GTAB);
            { const int* ELIST = (const int*)(ws + WS_ELIST); pg8::Unit u;
              for (int i = 0; i < 24 && S.next(i, u); ++i) { if (F.tid < 256) { const int j = u.pm - S.tst[u.aux]; gtab[i * 256 + F.tid] = (unsigned short)(F.tid < u.valid ? ELIST[(size_t)u.aux * 16384 + 256 * j + F.tid] : 0); } } }
            __syncthreads();
            { epi::SwiGLU8 E{ws + WS_ACT}; pg8::gemm_phase<epi::SwiGLU8, MoeSched, true, true, true, true>(F.lds, 1024, S, E, gtab); }
            { SO S2; S2.init(ws + WS_H2F8, ws + WS_W_SHGU_T, T, 1024, 1024, F.G, F.blk); epi::SwiGLU8 E{ws + WS_SHACT};
              pg8::gemm_phase<epi::SwiGLU8, SO, true, true, false, true>(F.lds, 1024, S2, E, nullptr); }
        }
        }
        SEAM(10);
    }
    if (lo <= 11 && 11 < hi) {
        if (IN(11)) {
            moe_tables(F);
            MoeSched S{(const LAS int*)(F.lds + LDSX_OFF + MT_CNT), (const LAS int*)(F.lds + LDSX_OFF + MT_TST), (const LAS int*)(F.lds + LDSX_OFF + MT_COFF), F.G, F.blk, 3,
                       (const char*)(ws + WS_ACT), (const char*)(ws + WS_W_ED_T), (size_t)256 * 512, (size_t)2048 * 512, (size_t)256 * 512, true};
#pragma unroll 1
            for (int rep_ = 0; rep_ < NREP(11); ++rep_) { if (rep_) xcd_barrier(bar);
            { epi::DownY E{(unsigned char*)(ws + WS_Y)}; pg8::gemm_phase<epi::DownY, MoeSched, true, true, false, true>(F.lds, 256, S, E, nullptr); } }
            { SO S2; S2.init(ws + WS_SHACT, ws + WS_W_SHD_T, T, 2048, 256, F.G, F.blk); epi::DownShared8 E{ws + WS_SHOUT};
              pg8::gemm_phase<epi::DownShared8, SO, true, true, false, true>(F.lds, 256, S2, E, nullptr); }
        }
        SEAM(11);
    }
    if (lo <= 12 && 12 < hi) { if (IN(12)) p12_combine(F); }
#undef IN
#undef SEAM
}

extern "C" void kernel_launch(void* const* d_in, const int* in_sizes, int n_in, void* d_out, int out_size, void* d_ws, size_t ws_size, hipStream_t stream) {
    static int grid = 0;
    if (grid == 0) {
        if (n_in != 22 || in_sizes[0] != T * D || out_size != T * D || ws_size < WS_END) { fprintf(stderr, "kernel_launch: unexpected shapes (n_in %d, in0 %d, out %d, ws %zu < %zu); nothing launched\n", n_in, n_in > 0 ? in_sizes[0] : -1, out_size, ws_size, (size_t)WS_END); grid = -1; return; }
        int dev = 0, cus = 0, per_cu = 0;
        if (hipGetDevice(&dev) != hipSuccess || hipDeviceGetAttribute(&cus, hipDeviceAttributeMultiprocessorCount, dev) != hipSuccess) { grid = -1; return; }
        if (hipFuncSetAttribute((const void*)fwd_kernel, hipFuncAttributeMaxDynamicSharedMemorySize, LDS_BYTES) != hipSuccess) { fprintf(stderr, "kernel_launch: hipFuncSetAttribute failed\n"); grid = -1; return; }
        if (hipOccupancyMaxActiveBlocksPerMultiprocessor(&per_cu, (const void*)fwd_kernel, 512, LDS_BYTES) != hipSuccess || per_cu < 1) fprintf(stderr, "kernel_launch: occupancy query says %d\n", per_cu);
        (void)hipGetLastError();
        grid = cus;
    }
    if (grid < 0) return;
    if (hipMemsetAsync((char*)d_ws + WS_CTL, 0, CTL_ZERO_BYTES, stream) != hipSuccess) { fprintf(stderr, "kernel_launch: memset failed\n"); return; }
    Args a{};
    for (int i = 0; i < 22; ++i) a.in[i] = (const float*)d_in[i];
    a.out = (float*)d_out; a.ws = (unsigned char*)d_ws;
    for (int li = 0; li < MK_N_LAUNCHES; ++li) {
        a.ph_lo = (MK_N_LAUNCHES == 1) ? 0 : li; a.ph_hi = (MK_N_LAUNCHES == 1) ? NPHASE : li + 1;
        hipLaunchKernelGGL(fwd_kernel, dim3(grid), dim3(512), LDS_BYTES, stream, a);
        const hipError_t le = hipPeekAtLastError();
        if (le != hipSuccess) { fprintf(stderr, "kernel_launch: launch %d failed: %s\n", li, hipGetErrorName(le)); break; }
    }
}
```

```cpp
#include <hip/hip_runtime.h>
#include <cstdio>
#include <cstdint>

#define LAS __attribute__((address_space(3)))
#define GAS __attribute__((address_space(1)))
typedef unsigned short bf16_t;
typedef short bf16x8 __attribute__((ext_vector_type(8)));
typedef short s16x4 __attribute__((ext_vector_type(4)));
typedef int i32x4 __attribute__((ext_vector_type(4)));
typedef int i32x8 __attribute__((ext_vector_type(8)));
typedef float f32x4 __attribute__((ext_vector_type(4)));
typedef float f32x2 __attribute__((ext_vector_type(2)));
typedef float f32x16 __attribute__((ext_vector_type(16)));
typedef unsigned u32x4 __attribute__((ext_vector_type(4)));
typedef unsigned u32x2 __attribute__((ext_vector_type(2)));
typedef __bf16 bf16x2_t __attribute__((ext_vector_type(2)));

#ifndef MK_N_LAUNCHES
#define MK_N_LAUNCHES 1
#endif
#ifndef REP_MASK
#define REP_MASK 0u
#endif
#ifndef PHASE_MASK
#define PHASE_MASK 0xFFFFFFFFu
#endif

constexpr int NB = 2, SEQ = 8192, T = NB * SEQ, D = 2048, NH = 8, INC = 10240, NE = 64, EDIM = 512, TOPK = 8;
constexpr int NPHASE = 13;
constexpr float RMS_EPS = 1e-6f;
constexpr float LOG2E = 1.4426950408889634f;

constexpr size_t MiB = 1u << 20;
constexpr size_t WS_CTL = 0, CTL_ZERO_BYTES = 1 * MiB;
constexpr size_t WS_MODP = 1 * MiB;
constexpr size_t WS_MOD = 4 * MiB;
constexpr size_t WS_KMEAN = 4 * MiB + 256 * 1024;
constexpr size_t WS_WR = 4 * MiB + 512 * 1024;
constexpr size_t WS_TOKE = 5 * MiB;
constexpr size_t WS_TOKW = 5 * MiB + 512 * 1024;
constexpr size_t WS_W_IN_T = 8 * MiB;
constexpr size_t WS_W_OD_T = 48 * MiB;
constexpr size_t WS_W_OM_T = 52 * MiB;
constexpr size_t WS_W_OUT_T = 56 * MiB;
constexpr size_t WS_W_SHGU_T = 64 * MiB;
constexpr size_t WS_W_SHD_T = 68 * MiB;
constexpr size_t WS_ELIST = 70 * MiB;
constexpr size_t WS_W_ED_T = 76 * MiB;
constexpr size_t WS_W_EGU_T = 204 * MiB;
constexpr size_t WS_H = 460 * MiB;
constexpr size_t WS_QD = 524 * MiB;
constexpr size_t WS_KDT = 556 * MiB;
constexpr size_t WS_VDT = 588 * MiB;
constexpr size_t WS_QM = 620 * MiB;
constexpr size_t WS_KMT = 652 * MiB;
constexpr size_t WS_VMT = 684 * MiB;
constexpr size_t WS_GATES = 716 * MiB;
constexpr size_t WS_AD = 844 * MiB;
constexpr size_t WS_AM = 876 * MiB;
constexpr size_t WS_ML = 908 * MiB;
constexpr size_t WS_MLIST = 912 * MiB;
constexpr size_t WS_PARTS = 460 * MiB;
constexpr size_t WS_G = 460 * MiB;
constexpr size_t WS_T1 = 524 * MiB;
constexpr size_t WS_X1 = 524 * MiB;
constexpr size_t WS_H2 = 588 * MiB;
constexpr size_t WS_ACT = 716 * MiB;
constexpr size_t WS_H2F8 = 800 * MiB;
constexpr float F8_SH = 8.0f, F8_SW = 64.0f, F8_SA = 8.0f, F8_SD = 32.0f;
namespace att { constexpr float D8_QS = 0.125f * LOG2E * 16.0f, D8_KS = 4.0f, D8_VS = 8.0f; }
constexpr size_t WS_QM8 = 604 * MiB, WS_VMT8 = 684 * MiB, WS_KMT8 = 700 * MiB;
namespace att { constexpr float MB8_QS = 0.08838834764831845f * LOG2E * 16.0f; }
constexpr float F8_SPART = 16.0f;
constexpr float F8_SGATE = 256.0f;
constexpr bool O78F8 = true;
constexpr float F8_SAD = 16.0f, F8_SAM = 64.0f, F8_SWO = 32.0f, F8_SG = 16.0f, F8_SWOUT = 64.0f;
constexpr bool P2F8 = true;
constexpr float DS2 = 1.0f;
constexpr int P2_EXP = 9;
constexpr size_t WS_SHACT = 860 * MiB;
constexpr size_t WS_SHOUT = 588 * MiB;
constexpr size_t WS_Y = 204 * MiB;
constexpr size_t WS_END = 928 * MiB;
static_assert(WS_Y + (size_t)131072 * 2048 * 2 <= WS_ACT, "Y must not reach ACT");
static_assert(WS_ACT + (size_t)147456 * 512 * 2 <= WS_SHACT && WS_SHACT + (size_t)T * 512 * 2 <= WS_END, "act map");
static_assert(WS_PARTS + (size_t)T * 8 * 4 * 128 * 2 <= WS_VDT, "parts overlay");

constexpr int CW_BAR = 4096;
constexpr int CW_ECNT = 8192;
constexpr int CW_MCNT = 8448;
constexpr int CW_AQ = 9216;
constexpr int CW_CQ = 9216 + 64 * 8;

constexpr int RING_BYTES = 131072;
constexpr int LDSX_OFF = RING_BYTES;
constexpr int MISC_OFF = RING_BYTES + 16384;
constexpr int LDS_BYTES = MISC_OFF + 128;

#define LDS_WAIT() asm volatile("s_waitcnt lgkmcnt(0)" ::: "memory")
#define VM_WAIT() asm volatile("s_waitcnt vmcnt(0)" ::: "memory")
#define RLX_AGENT __ATOMIC_RELAXED, __HIP_MEMORY_SCOPE_AGENT

__device__ __forceinline__ unsigned cvtpk(float lo, float hi) { f32x2 v = {lo, hi}; bf16x2_t b = __builtin_convertvector(v, bf16x2_t); return __builtin_bit_cast(unsigned, b); }
__device__ __forceinline__ float bf_lo(unsigned u) { return __uint_as_float(u << 16); }
__device__ __forceinline__ float bf_hi(unsigned u) { return __uint_as_float(u & 0xffff0000u); }
__device__ __forceinline__ float wave_sum(float v) {
#pragma unroll
    for (int o = 1; o < 64; o <<= 1) v += __shfl_xor(v, o);
    return v;
}
__device__ __forceinline__ float fast_exp2(float x) { return __builtin_amdgcn_exp2f(x); }
__device__ __forceinline__ float fast_rcp(float x) { return __builtin_amdgcn_rcpf(x); }
__device__ __forceinline__ float sigmoidf_(float x) { return fast_rcp(1.0f + fast_exp2(-x * LOG2E)); }
__device__ __forceinline__ float siluf_(float x) { return x * sigmoidf_(x); }

#define XB_TMO      128
#define XB_XCNT(j)  (256  + 64 * (j))
#define XB_XSUB(j)  (1280 + 64 * (j))
#define XB_XGEN(j)  (2304 + 64 * (j))
#define XB_TOP      3328
#define XB_TOPGEN   3392
#define XCD_BAR_WORDS 3456
#define XB_SPIN_CAP (1u << 22)

__device__ __forceinline__ unsigned xb_ld(unsigned* p)              { return __hip_atomic_load(p, __ATOMIC_RELAXED, __HIP_MEMORY_SCOPE_AGENT); }
__device__ __forceinline__ unsigned xb_add(unsigned* p, unsigned v) { return __hip_atomic_fetch_add(p, v, __ATOMIC_RELAXED, __HIP_MEMORY_SCOPE_AGENT); }
__device__ __forceinline__ unsigned xb_xcc_id() { return (unsigned)__builtin_amdgcn_s_getreg((3 << 11) | 20) & 0xFu; }
#define XB_SPIN(cond, bar) do { unsigned _sp = 0; while (cond) { __builtin_amdgcn_s_sleep(1); \
    if ((++_sp & 255u) == 0u) { if (xb_ld(&(bar)[XB_TMO])) break; if (_sp > XB_SPIN_CAP) { atomicAdd(&(bar)[XB_TMO], 1u); break; } } } } while (0)

struct XcdBarrier { unsigned* bar; unsigned x; volatile LAS unsigned* st; };

__device__ __forceinline__ XcdBarrier xcd_barrier_post(unsigned* bar, volatile LAS unsigned* st) {
    XcdBarrier b; b.bar = bar; b.x = xb_xcc_id(); b.st = st;
    if (threadIdx.x == 0) (void)xb_add(&bar[XB_XCNT(b.x)], 1u);
    return b;
}
__device__ __forceinline__ void xcd_barrier_complete(unsigned* bar, unsigned x, unsigned& nloc, unsigned& nx) {
    const unsigned G = gridDim.x * gridDim.y * gridDim.z;
    unsigned sum, cnt, mine, sp = 0u;
    for (;;) {
        sum = 0u; cnt = 0u; mine = 0u;
#pragma unroll
        for (unsigned j = 0; j < 16; ++j) { const unsigned c = xb_ld(&bar[XB_XCNT(j)]); sum += c; cnt += (c > 0u) ? 1u : 0u; mine = (j == x) ? c : mine; }
        if (sum == G) break;
        __builtin_amdgcn_s_sleep(1);
        if ((++sp & 255u) == 0u) { if (xb_ld(&bar[XB_TMO])) break; if (sp > XB_SPIN_CAP) { atomicAdd(&bar[XB_TMO], 1u); break; } }
    }
    nloc = mine > 0u ? mine : 1u; nx = cnt > 0u ? cnt : 1u;
}
__device__ __forceinline__ void xcd_barrier(const XcdBarrier& b) {
    asm volatile("s_waitcnt vmcnt(0)" ::: "memory");
    __syncthreads();
    if (threadIdx.x == 0) {
        unsigned* bar = b.bar;
        __builtin_amdgcn_s_waitcnt(0);
        unsigned nloc = b.st[0], nx = b.st[1];
        if (nloc == 0u) { xcd_barrier_complete(bar, b.x, nloc, nx); b.st[0] = nloc; b.st[1] = nx; }
        const unsigned old = xb_add(&bar[XB_XSUB(b.x)], 1u);
        const unsigned gen = old / nloc;
        if (old + 1u == (gen + 1u) * nloc) {
            __builtin_amdgcn_fence(__ATOMIC_RELEASE, "agent");
            asm volatile("s_waitcnt vmcnt(0)" ::: "memory");
            const unsigned og = xb_add(&bar[XB_TOP], 1u);
            const unsigned tg = og / nx;
            if (og + 1u == (tg + 1u) * nx) xb_add(&bar[XB_TOPGEN], 1u);
            else XB_SPIN(xb_ld(&bar[XB_TOPGEN]) == tg, bar);
            __builtin_amdgcn_fence(__ATOMIC_ACQUIRE, "agent");
            xb_add(&bar[XB_XGEN(b.x)], 1u);
            asm volatile("s_waitcnt vmcnt(0)" ::: "memory");
        } else {
            XB_SPIN(xb_ld(&bar[XB_XGEN(b.x)]) == gen, bar);
            __builtin_amdgcn_fence(__ATOMIC_ACQUIRE, "agent");
            asm volatile("s_waitcnt vmcnt(0)" ::: "memory");
        }
    }
    __syncthreads();
}

namespace pg8 {
constexpr int BM = 256, BK = 64, HALF = 128, HTB = HALF * BK * 2, STAGE_BYTES = 8 * HTB, NXCD = 8, WGM = 8;
static_assert(STAGE_BYTES == RING_BYTES, "ring");
__host__ __device__ __forceinline__ int lds_byte(int r, int c) { const int st = (r >> 4) * 2 + (c >> 5), rr = r & 15, cc = c & 31, ob = rr * 64 + cc * 2; return st * 1024 + (ob ^ (((ob >> 9) & 1) << 5)); }
__host__ __device__ __forceinline__ void stage_rc(int b, int& R, int& C) { const int st = b / 1024, sb = b % 1024, swz = sb ^ (((sb >> 9) & 1) << 5); R = (st >> 1) * 16 + swz / 64; C = (st & 1) * 32 + (swz % 64) / 2; }
__host__ __device__ __forceinline__ int perm32(int rho) { const int n = rho >> 4, i = rho & 15; return 8 * (i >> 2) + 4 * n + (i & 3); }

struct Unit { int pm, pn; const char* A; const char* B; int rowbase, valid, aux; };

struct StaticOrder {
    int nM, nN, nwg, G, c; const char* A; const char* B; size_t tstep;
    __device__ void init(const void* A_, const void* B_, int M, int N, int K, int G_, int c_) { A = (const char*)A_; B = (const char*)B_; nM = M / BM; nN = N / BM; nwg = nM * nN; G = G_; c = c_; tstep = (size_t)BM * K * 2; }
    __device__ bool next(int i, Unit& u) const {
        const long L = (long)i * G + c; if (L >= nwg) return false;
        int wgid = (int)L; { const int q = nwg / NXCD, r = nwg % NXCD, xcd = wgid % NXCD, off = wgid / NXCD; wgid = (xcd < r ? xcd * (q + 1) : r * (q + 1) + (xcd - r) * q) + off; }
        const int nig = WGM * nN, gid = wgid / nig, fm = gid * WGM, gsz = (nM - fm) < WGM ? (nM - fm) : WGM;
        u.pm = fm + ((wgid % nig) % gsz); u.pn = (wgid % nig) / gsz;
        u.A = A + (size_t)u.pm * tstep; u.B = B + (size_t)u.pn * tstep; u.rowbase = u.pm * BM; u.valid = BM; u.aux = 0; return true;
    }
};

struct PairOrder {
    StaticOrder base; const char* A1; const char* B1;
    __device__ void init(const void* A0_, const void* B0_, const void* A1_, const void* B1_, int M, int N, int K, int G_, int c_) { base.init(A0_, B0_, M, N, K, G_, c_); A1 = (const char*)A1_; B1 = (const char*)B1_; }
    __device__ bool next(int i, Unit& u) const {
        if (!base.next(i >> 1, u)) return false;
        if (i & 1) { u.A = A1 + (size_t)u.pm * base.tstep; u.B = B1 + (size_t)u.pn * base.tstep; u.aux = 1; }
        return true;
    }
};

template <class Epi, class Sched, bool ALIGN_EPI, bool SP2, bool GATHER, bool F8 = false>
__device__ __forceinline__ void gemm_phase(LAS unsigned char* lds, const int K, const Sched& S, const Epi& E, const LAS unsigned short* gtab) {
    int tid_ = threadIdx.x; asm volatile("" : "+v"(tid_));
    const int tid = tid_, wid = __builtin_amdgcn_readfirstlane(tid >> 6), lane = tid & 63, wr = wid >> 2, wc = wid & 3, fr = lane & 15, fq = lane >> 4;
    const int nt = K / BK;
    unsigned voffA[2], voffB[2]; int RA[2], CA[2];
#pragma unroll
    for (int i = 0; i < 2; ++i) { int R, C; stage_rc(tid * 16 + i * 8192, R, C); const int Rb = (int)Epi::PERM == 2 ? (64 * (R >> 5) + 16 * ((R >> 2) & 3) + 4 * ((R >> 4) & 1) + (R & 3)) : (Epi::PERM ? ((R & ~31) + perm32(R & 31)) : R);
        RA[i] = R; CA[i] = C; voffA[i] = (unsigned)(R * K + C) * 2u; voffB[i] = (unsigned)(Rb * K + C) * 2u; }
    const size_t kstep = (size_t)(BK * 2);
    const size_t hstep = (size_t)HALF * K * 2;
    const size_t hstepB = (int)Epi::PERM == 2 ? (size_t)8 * K * 2 : hstep;
    const unsigned ldsw = (unsigned)wid * 1024u;
    const int aoff = lds_byte(wr * 64 + fr, fq * 8), boff = lds_byte(wc * 32 + fr, fq * 8);
    unsigned vA[2][2], nvA[2][2];
#define PG8_SA(b, h) (((b) * 2 + (h)) * HTB)
#define PG8_SB(b, h) ((4 + (b) * 2 + (h)) * HTB)
#define PG8_GL(gp, ldsoff) __builtin_amdgcn_global_load_lds((const unsigned*)(gp), (LAS unsigned*)(lds + (ldsoff)), 16, 0, 0)
#define PG8_STAGE(bufoff, gbase, voff) do { _Pragma("unroll") for (int _i = 0; _i < 2; ++_i) PG8_GL((const char*)(gbase) + (voff)[_i], (bufoff) + ldsw + _i * 8192); } while (0)
#define PG8_STA(bufoff, gbase, h, nx) do { if constexpr (GATHER) { \
        const unsigned _o0 = (nx) ? nvA[h][0] : vA[h][0], _o1 = (nx) ? nvA[h][1] : vA[h][1]; \
        PG8_GL((const char*)(gbase) + _o0, (bufoff) + ldsw); PG8_GL((const char*)(gbase) + _o1, (bufoff) + ldsw + 8192); \
    } else { PG8_STAGE(bufoff, (const char*)(gbase) + (h) * hstep, voffA); } } while (0)
#define PG8_GVA(dst, ul) do { _Pragma("unroll") for (int _h = 0; _h < 2; ++_h) _Pragma("unroll") for (int _i = 0; _i < 2; ++_i) \
        dst[_h][_i] = (unsigned)gtab[(ul) * 256 + _h * 128 + RA[_i]] * (unsigned)(K * 2) + (unsigned)(CA[_i] * 2); } while (0)
#define PG8_LDA(dst, b, h) do { _Pragma("unroll") for (int m = 0; m < 4; ++m) _Pragma("unroll") for (int k = 0; k < 2; ++k) dst[m][k] = *(const LAS bf16x8*)(lds + PG8_SA(b, h) + aoff + m * 2048 + k * 1024); } while (0)
#define PG8_LDB(dst, b, h) do { _Pragma("unroll") for (int n = 0; n < 2; ++n) _Pragma("unroll") for (int k = 0; k < 2; ++k) dst[n][k] = *(const LAS bf16x8*)(lds + PG8_SB(b, h) + boff + n * 2048 + k * 1024); } while (0)
#define PG8_MMA(ai, bj, At, Bt) do { __builtin_amdgcn_s_setprio(1); _Pragma("unroll") for (int m = 0; m < 4; ++m) _Pragma("unroll") for (int n = 0; n < 2; ++n) { \
        if constexpr (F8) { const i32x4 _b0 = __builtin_bit_cast(i32x4, Bt[n][0]), _b1 = __builtin_bit_cast(i32x4, Bt[n][1]), _a0 = __builtin_bit_cast(i32x4, At[m][0]), _a1 = __builtin_bit_cast(i32x4, At[m][1]); \
            const i32x8 _b8 = __builtin_shufflevector(_b0, _b1, 0, 1, 2, 3, 4, 5, 6, 7), _a8 = __builtin_shufflevector(_a0, _a1, 0, 1, 2, 3, 4, 5, 6, 7); \
            asm volatile("v_mfma_scale_f32_16x16x128_f8f6f4 %0, %1, %2, %0, %3, %4 op_sel_hi:[0,0,0]" : "+v"(acc[ai][bj][m][n]) : "v"(_b8), "v"(_a8), "v"(f8sc), "v"(f8one)); } \
        else { _Pragma("unroll") for (int k = 0; k < 2; ++k) acc[ai][bj][m][n] = __builtin_amdgcn_mfma_f32_16x16x32_bf16(Bt[n][k], At[m][k], acc[ai][bj][m][n], 0, 0, 0); } } __builtin_amdgcn_s_setprio(0); } while (0)
#define PG8_WAIT_V(n) asm volatile("s_waitcnt vmcnt(" #n ")" ::: "memory")
#define PG8_WAIT_L(n) asm volatile("s_waitcnt lgkmcnt(" #n ")" ::: "memory")
#define PG8_BAR __builtin_amdgcn_s_barrier()
#define PG8_SCHED __builtin_amdgcn_sched_barrier(0)
    Unit cur, nxt; int ui = 0;
    if (!S.next(0, cur)) return;
    if constexpr (GATHER) { PG8_GVA(vA, 0); }
    int f8sc = 0x7F7F7F7F;
    const int f8one = 0x7F7F7F7F;
    f32x4 acc[2][2][4][2];
#pragma unroll
    for (int a = 0; a < 2; ++a)
#pragma unroll
        for (int b = 0; b < 2; ++b)
#pragma unroll
            for (int m = 0; m < 4; ++m)
#pragma unroll
                for (int n = 0; n < 2; ++n) acc[a][b][m][n] = (f32x4){0.f, 0.f, 0.f, 0.f};
    bf16x8 At[4][2], B0[2][2], B1[2][2];
    const char* cA = cur.A; const char* cB = cur.B;
    if constexpr (SP2) {
        PG8_STAGE(PG8_SB(0, 0), cB, voffB); PG8_STAGE(PG8_SB(0, 1), cB + hstepB, voffB); PG8_STA(PG8_SA(0, 0), cA, 0, false); PG8_STA(PG8_SA(0, 1), cA, 1, false);
        if (wr == 1) PG8_BAR;
        PG8_WAIT_V(2); PG8_BAR;
        PG8_STAGE(PG8_SB(1, 0), cB + kstep, voffB); PG8_STA(PG8_SA(1, 0), cA + kstep, 0, false); PG8_STAGE(PG8_SB(1, 1), cB + hstepB + kstep, voffB);
        PG8_WAIT_V(6); PG8_BAR;
    } else {
        PG8_STAGE(PG8_SB(0, 0), cB, voffB); PG8_STA(PG8_SA(0, 0), cA, 0, false); PG8_STAGE(PG8_SB(0, 1), cB + hstepB, voffB); PG8_STA(PG8_SA(0, 1), cA, 1, false);
        if (wr == 1) PG8_BAR;
        PG8_WAIT_V(4); PG8_BAR;
        PG8_STAGE(PG8_SB(1, 0), cB + kstep, voffB); PG8_STA(PG8_SA(1, 0), cA + kstep, 0, false); PG8_STAGE(PG8_SB(1, 1), cB + hstepB + kstep, voffB);
        PG8_WAIT_V(6); PG8_BAR;
    }
    for (;;) {
        if constexpr (F8) f8sc = 0x01010101 * (127 - E.f8exp(cur));
        bool has_next = false; const char* nA = cA; const char* nB = cB;
#define PG8_NEXT_UNIT() do { has_next = S.next(ui + 1, nxt); nA = has_next ? nxt.A : cA; nB = has_next ? nxt.B : cB; \
        if constexpr (GATHER) { if (has_next) { PG8_GVA(nvA, ui + 1); } else { _Pragma("unroll") for (int _h = 0; _h < 2; ++_h) _Pragma("unroll") for (int _i = 0; _i < 2; ++_i) nvA[_h][_i] = vA[_h][_i]; } } } while (0)
        if (nt < 4 || !SP2) PG8_NEXT_UNIT();
        for (int t = 0; t < nt; t += 2) {
            const bool last = (t == nt - 2);
            const char* a1 = cA + (size_t)(t + 1) * kstep;
            const char* a2 = last ? nA : cA + (size_t)(t + 2) * kstep; const char* b2 = last ? nB : cB + (size_t)(t + 2) * kstep;
            const char* a3 = a2 + kstep; const char* b3 = b2 + kstep;
            if constexpr (SP2) {
            PG8_LDB(B0, 0, 0); PG8_LDB(B1, 0, 1); PG8_SCHED; PG8_LDA(At, 0, 0); PG8_STA(PG8_SA(1, 1), a1, 1, false);
            PG8_WAIT_V(8); PG8_WAIT_L(0); PG8_BAR; PG8_MMA(0, 0, At, B0); PG8_MMA(0, 1, At, B1); if (t == 0 && nt >= 4) { PG8_SCHED; PG8_NEXT_UNIT(); PG8_SCHED; } PG8_BAR; PG8_SCHED;
            PG8_LDA(At, 0, 1); PG8_STAGE(PG8_SB(0, 0), b2, voffB); PG8_STAGE(PG8_SB(0, 1), b2 + hstepB, voffB); PG8_STA(PG8_SA(0, 0), a2, 0, last);
            PG8_WAIT_V(8); PG8_WAIT_L(0); PG8_BAR; PG8_MMA(1, 0, At, B0); PG8_MMA(1, 1, At, B1); PG8_BAR; PG8_SCHED;
            PG8_LDB(B0, 1, 0); PG8_LDB(B1, 1, 1); PG8_SCHED; PG8_LDA(At, 1, 0); PG8_STA(PG8_SA(0, 1), a2, 1, last);
            PG8_WAIT_V(8); PG8_WAIT_L(0); PG8_BAR; PG8_MMA(0, 0, At, B0); PG8_MMA(0, 1, At, B1); PG8_BAR; PG8_SCHED;
            PG8_LDA(At, 1, 1); PG8_STAGE(PG8_SB(1, 0), b3, voffB); PG8_STAGE(PG8_SB(1, 1), b3 + hstepB, voffB); PG8_STA(PG8_SA(1, 0), a3, 0, last);
            PG8_WAIT_V(8); PG8_WAIT_L(0); PG8_BAR; PG8_MMA(1, 0, At, B0); PG8_MMA(1, 1, At, B1); PG8_BAR; PG8_SCHED;
            } else {
            PG8_LDB(B0, 0, 0); PG8_SCHED; PG8_LDA(At, 0, 0); PG8_STA(PG8_SA(1, 1), a1, 1, false);
            PG8_WAIT_L(8); PG8_BAR; PG8_WAIT_L(0); PG8_MMA(0, 0, At, B0); PG8_BAR; PG8_SCHED;
            PG8_LDB(B1, 0, 1); PG8_STAGE(PG8_SB(0, 0), b2, voffB);
            PG8_BAR; PG8_WAIT_L(0); PG8_MMA(0, 1, At, B1); PG8_BAR;
            PG8_LDA(At, 0, 1); PG8_STA(PG8_SA(0, 0), a2, 0, last);
            PG8_BAR; PG8_WAIT_L(0); PG8_MMA(1, 0, At, B0); PG8_BAR; PG8_SCHED;
            PG8_STAGE(PG8_SB(0, 1), b2 + hstepB, voffB);
            PG8_WAIT_V(6); PG8_BAR; PG8_MMA(1, 1, At, B1); PG8_BAR;
            PG8_LDB(B0, 1, 0); PG8_SCHED; PG8_LDA(At, 1, 0); PG8_STA(PG8_SA(0, 1), a2, 1, last);
            PG8_WAIT_L(8); PG8_BAR; PG8_WAIT_L(0); PG8_MMA(0, 0, At, B0); PG8_BAR; PG8_SCHED;
            PG8_LDB(B1, 1, 1); PG8_STAGE(PG8_SB(1, 0), b3, voffB);
            PG8_BAR; PG8_WAIT_L(0); PG8_MMA(0, 1, At, B1); PG8_BAR;
            PG8_LDA(At, 1, 1); PG8_STA(PG8_SA(1, 0), a3, 0, last);
            PG8_BAR; PG8_WAIT_L(0); PG8_MMA(1, 0, At, B0); PG8_BAR; PG8_SCHED;
            PG8_STAGE(PG8_SB(1, 1), b3 + hstepB, voffB);
            PG8_WAIT_V(6); PG8_BAR; PG8_MMA(1, 1, At, B1); PG8_BAR;
            }
        }
        if constexpr (F8) asm volatile("s_nop 15\n\ts_nop 15" ::: "memory");
        if constexpr (ALIGN_EPI) { if (wr == 0) PG8_BAR; }
        { int l2 = lane; asm volatile("" : "+v"(l2)); E(acc, cur, wr, wc, l2 & 15, l2 >> 4); }
        if (!has_next) break;
#pragma unroll
        for (int a = 0; a < 2; ++a)
#pragma unroll
            for (int b = 0; b < 2; ++b)
#pragma unroll
                for (int m = 0; m < 4; ++m)
#pragma unroll
                    for (int n = 0; n < 2; ++n) acc[a][b][m][n] = (f32x4){0.f, 0.f, 0.f, 0.f};
        cur = nxt; cA = nA; cB = nB; ++ui;
        if constexpr (GATHER) {
#pragma unroll
            for (int _h = 0; _h < 2; ++_h)
#pragma unroll
                for (int _i = 0; _i < 2; ++_i) vA[_h][_i] = nvA[_h][_i];
        }
        if constexpr (ALIGN_EPI) { if (wr == 1) PG8_BAR; }
    }
    PG8_WAIT_V(0);
    if constexpr (!ALIGN_EPI) { if (wr == 0) PG8_BAR; }
    PG8_BAR;
#undef PG8_SA
#undef PG8_SB
#undef PG8_GL
#undef PG8_STAGE
#undef PG8_STA
#undef PG8_GVA
#undef PG8_LDA
#undef PG8_LDB
#undef PG8_MMA
#undef PG8_WAIT_V
#undef PG8_WAIT_L
#undef PG8_BAR
#undef PG8_SCHED
}
}
namespace epi {
__device__ __forceinline__ float clamp_f8(float v) { return __builtin_fminf(__builtin_fmaxf(v, -448.0f), 448.0f); }
__device__ __forceinline__ unsigned pack4_f8(float a, float b, float c, float d) { int w = __builtin_amdgcn_cvt_pk_fp8_f32(clamp_f8(a), clamp_f8(b), 0, false); return (unsigned)__builtin_amdgcn_cvt_pk_fp8_f32(clamp_f8(c), clamp_f8(d), w, true); }
using pg8::Unit;
template <int ACT> struct StoreBf16 {
    static constexpr bool PERM = true;
    bf16_t* O; int ldc;
    __device__ __forceinline__ int f8exp(const Unit&) const { return 8; }
    __device__ __forceinline__ void operator()(const f32x4 (&acc)[2][2][4][2], const Unit& u, int wr, int wc, int fr, int fq) const {
        const int row0 = u.pm * 256 + wr * 64 + fr, col0 = u.pn * 256 + wc * 32 + 8 * fq;
#pragma unroll
        for (int ai = 0; ai < 2; ++ai)
#pragma unroll
            for (int m = 0; m < 4; ++m) { bf16_t* rowp = O + (size_t)(row0 + ai * 128 + m * 16) * ldc + col0;
#pragma unroll
                for (int bj = 0; bj < 2; ++bj) { f32x4 v0 = acc[ai][bj][m][0], v1 = acc[ai][bj][m][1];
                    if (ACT == 1) {
#pragma unroll
                        for (int j = 0; j < 4; ++j) { v0[j] = sigmoidf_(v0[j] * DS2); v1[j] = sigmoidf_(v1[j] * DS2); } }
                    if (ACT == 1) { *(u32x2*)((unsigned char*)O + (size_t)(row0 + ai * 128 + m * 16) * ldc + col0 + bj * 128) = (u32x2){pack4_f8(v0[0] * F8_SGATE, v0[1] * F8_SGATE, v0[2] * F8_SGATE, v0[3] * F8_SGATE), pack4_f8(v1[0] * F8_SGATE, v1[1] * F8_SGATE, v1[2] * F8_SGATE, v1[3] * F8_SGATE)}; }
                    else { u32x4 w; w.x = cvtpk(v0[0], v0[1]); w.y = cvtpk(v0[2], v0[3]); w.z = cvtpk(v1[0], v1[1]); w.w = cvtpk(v1[2], v1[3]);
                    *(u32x4*)(rowp + bj * 128) = w; } } }
    }
};
__device__ __forceinline__ f32x4 mul4_f8(f32x4 v, unsigned w) { const f32x2 lo = __builtin_amdgcn_cvt_pk_f32_fp8((int)w, false), hi = __builtin_amdgcn_cvt_pk_f32_fp8((int)w, true); v[0] *= lo[0]; v[1] *= lo[1]; v[2] *= hi[0]; v[3] *= hi[1]; return v; }
__device__ __forceinline__ f32x4 fma4_f8(unsigned w, float s, f32x4 v) { const f32x2 lo = __builtin_amdgcn_cvt_pk_f32_fp8((int)w, false), hi = __builtin_amdgcn_cvt_pk_f32_fp8((int)w, true);
    v[0] = __builtin_fmaf(lo[0], s, v[0]); v[1] = __builtin_fmaf(lo[1], s, v[1]); v[2] = __builtin_fmaf(hi[0], s, v[2]); v[3] = __builtin_fmaf(hi[1], s, v[3]); return v; }
template <int MODE> struct GateMul {
    static constexpr int PERM = 2;
    const bf16_t* gate; int goff; const bf16_t* prev; bf16_t* O;
    __device__ __forceinline__ void operator()(const f32x4 (&acc)[2][2][4][2], const Unit& u, int wr, int wc, int fr, int fq) const {
        const int row0 = u.pm * 256 + wr * 64 + fr, col = u.pn * 256 + wc * 64 + 16 * fq;
#pragma unroll
        for (int ai = 0; ai < 2; ++ai)
#pragma unroll
            for (int m = 0; m < 4; ++m) { const size_t row = (size_t)(row0 + ai * 128 + m * 16);
                const u32x4 g = *(const u32x4*)((const unsigned char*)gate + row * 4096 + goff + col);
                f32x4 v0 = mul4_f8(acc[ai][0][m][0], g.x), v1 = mul4_f8(acc[ai][0][m][1], g.y), v2 = mul4_f8(acc[ai][1][m][0], g.z), v3 = mul4_f8(acc[ai][1][m][1], g.w);
                if (MODE == 1) { const u32x4 p = *(const u32x4*)((const unsigned char*)prev + row * 2048 + col);
                    constexpr float ip = 1.0f / F8_SG;
                    v0 = fma4_f8(p.x, ip, v0); v1 = fma4_f8(p.y, ip, v1); v2 = fma4_f8(p.z, ip, v2); v3 = fma4_f8(p.w, ip, v3); }
                *(u32x4*)((unsigned char*)O + row * 2048 + col) = (u32x4){pack4_f8(v0[0] * F8_SG, v0[1] * F8_SG, v0[2] * F8_SG, v0[3] * F8_SG), pack4_f8(v1[0] * F8_SG, v1[1] * F8_SG, v1[2] * F8_SG, v1[3] * F8_SG),
                                                                           pack4_f8(v2[0] * F8_SG, v2[1] * F8_SG, v2[2] * F8_SG, v2[3] * F8_SG), pack4_f8(v3[0] * F8_SG, v3[1] * F8_SG, v3[2] * F8_SG, v3[3] * F8_SG)}; }
    }
};
struct Resid {
    static constexpr bool PERM = false;
    const float* base; float* out; const float* gate; int goff;
    __device__ __forceinline__ void operator()(const f32x4 (&acc)[2][2][4][2], const Unit& u, int wr, int wc, int fr, int fq) const {
        const int row0 = u.pm * 256 + wr * 64 + fr, col0 = u.pn * 256 + wc * 32 + 4 * fq;
        const int b = (u.pm * 256) / SEQ;
        f32x4 gv[2][2];
#pragma unroll
        for (int bj = 0; bj < 2; ++bj)
#pragma unroll
            for (int n = 0; n < 2; ++n) gv[bj][n] = *(const f32x4*)(gate + (size_t)b * 12288 + goff + col0 + bj * 128 + n * 16);
#pragma unroll
        for (int ai = 0; ai < 2; ++ai)
#pragma unroll
            for (int m = 0; m < 4; ++m) { const size_t off = (size_t)(row0 + ai * 128 + m * 16) * 2048 + col0;
#pragma unroll
                for (int bj = 0; bj < 2; ++bj)
#pragma unroll
                    for (int n = 0; n < 2; ++n) { const f32x4 bs = *(const f32x4*)(base + off + bj * 128 + n * 16);
                        *(f32x4*)(out + off + bj * 128 + n * 16) = bs + gv[bj][n] * acc[ai][bj][m][n]; } }
    }
};
struct SwiGLU {
    static constexpr bool PERM = true;
    bf16_t* O;
    __device__ __forceinline__ void operator()(const f32x4 (&acc)[2][2][4][2], const Unit& u, int wr, int wc, int fr, int fq) const {
        const int r0 = wr * 64 + fr, col0 = u.pn * 128 + wc * 32 + 8 * fq;
#pragma unroll
        for (int ai = 0; ai < 2; ++ai)
#pragma unroll
            for (int m = 0; m < 4; ++m) { const int r = r0 + ai * 128 + m * 16;
                f32x4 v0, v1;
#pragma unroll
                for (int j = 0; j < 4; ++j) { v0[j] = siluf_(acc[ai][0][m][0][j]) * acc[ai][1][m][0][j]; v1[j] = siluf_(acc[ai][0][m][1][j]) * acc[ai][1][m][1][j]; }
                u32x4 w; w.x = cvtpk(v0[0], v0[1]); w.y = cvtpk(v0[2], v0[3]); w.z = cvtpk(v1[0], v1[1]); w.w = cvtpk(v1[2], v1[3]);
                if (r < u.valid) *(u32x4*)(O + (size_t)(u.rowbase + r) * 512 + col0) = w; }
    }
};
struct SwiGLU8 {
    static constexpr bool PERM = true;
    unsigned char* O;
    __device__ __forceinline__ int f8exp(const Unit&) const { return 9; }
    __device__ __forceinline__ void operator()(const f32x4 (&acc)[2][2][4][2], const Unit& u, int wr, int wc, int fr, int fq) const {
        const int r0 = wr * 64 + fr, col0 = u.pn * 128 + wc * 32 + 8 * fq;
        constexpr float ds = 1.0f, us = F8_SA;
#pragma unroll
        for (int ai = 0; ai < 2; ++ai)
#pragma unroll
            for (int m = 0; m < 4; ++m) { const int r = r0 + ai * 128 + m * 16;
                f32x4 v0, v1;
#pragma unroll
                for (int j = 0; j < 4; ++j) { v0[j] = siluf_(acc[ai][0][m][0][j] * ds) * (acc[ai][1][m][0][j] * us); v1[j] = siluf_(acc[ai][0][m][1][j] * ds) * (acc[ai][1][m][1][j] * us); }
                if (r < u.valid) *(u32x2*)(O + (size_t)(u.rowbase + r) * 512 + col0) = (u32x2){pack4_f8(v0[0], v0[1], v0[2], v0[3]), pack4_f8(v1[0], v1[1], v1[2], v1[3])}; }
    }
};
struct DownY {
    static constexpr int PERM = 2;
    unsigned char* O;
    __device__ __forceinline__ int f8exp(const Unit&) const { return 8; }
    __device__ __forceinline__ void operator()(const f32x4 (&acc)[2][2][4][2], const Unit& u, int wr, int wc, int fr, int fq) const {
        const int r0 = wr * 64 + fr, col0 = u.pn * 256 + wc * 64 + 16 * fq;
#pragma unroll
        for (int ai = 0; ai < 2; ++ai)
#pragma unroll
            for (int m = 0; m < 4; ++m) { const int r = r0 + ai * 128 + m * 16;
                if (r < u.valid) {
                    const f32x4 v0 = acc[ai][0][m][0], v1 = acc[ai][0][m][1], v2 = acc[ai][1][m][0], v3 = acc[ai][1][m][1];
                    int w0 = __builtin_amdgcn_cvt_pk_fp8_f32(v0[0], v0[1], 0, false); w0 = __builtin_amdgcn_cvt_pk_fp8_f32(v0[2], v0[3], w0, true);
                    int w1 = __builtin_amdgcn_cvt_pk_fp8_f32(v1[0], v1[1], 0, false); w1 = __builtin_amdgcn_cvt_pk_fp8_f32(v1[2], v1[3], w1, true);
                    int w2 = __builtin_amdgcn_cvt_pk_fp8_f32(v2[0], v2[1], 0, false); w2 = __builtin_amdgcn_cvt_pk_fp8_f32(v2[2], v2[3], w2, true);
                    int w3 = __builtin_amdgcn_cvt_pk_fp8_f32(v3[0], v3[1], 0, false); w3 = __builtin_amdgcn_cvt_pk_fp8_f32(v3[2], v3[3], w3, true);
                    *(u32x4*)(O + (size_t)(u.rowbase + r) * 2048 + col0) = (u32x4){(unsigned)w0, (unsigned)w1, (unsigned)w2, (unsigned)w3}; } }
    }
};
struct DownShared8 {
    static constexpr int PERM = 2;
    unsigned char* O;
    __device__ __forceinline__ int f8exp(const Unit&) const { return 8; }
    __device__ __forceinline__ void operator()(const f32x4 (&acc)[2][2][4][2], const Unit& u, int wr, int wc, int fr, int fq) const {
        const int r0 = u.pm * 256 + wr * 64 + fr, col0 = u.pn * 256 + wc * 64 + 16 * fq;
#pragma unroll
        for (int ai = 0; ai < 2; ++ai)
#pragma unroll
            for (int m = 0; m < 4; ++m) { const int r = r0 + ai * 128 + m * 16;
                const f32x4 v0 = acc[ai][0][m][0], v1 = acc[ai][0][m][1], v2 = acc[ai][1][m][0], v3 = acc[ai][1][m][1];
                *(u32x4*)(O + (size_t)r * 2048 + col0) = (u32x4){pack4_f8(v0[0], v0[1], v0[2], v0[3]), pack4_f8(v1[0], v1[1], v1[2], v1[3]), pack4_f8(v2[0], v2[1], v2[2], v2[3]), pack4_f8(v3[0], v3[1], v3[2], v3[3])}; }
    }
};
struct StoreQK {
    static constexpr bool PERM = true;
    bf16_t* Q; bf16_t* KT; float qscale;
    __device__ __forceinline__ void operator()(const f32x4 (&acc)[2][2][4][2], const Unit& u, int wr, int wc, int fr, int fq) const {
        const int row0 = u.pm * 256 + wr * 64 + fr, col0 = u.pn * 256 + wc * 32 + 8 * fq;
        const bool isk = (u.pn >= 4);
#pragma unroll
        for (int ai = 0; ai < 2; ++ai)
#pragma unroll
            for (int m = 0; m < 4; ++m) { const int row = row0 + ai * 128 + m * 16;
#pragma unroll
                for (int bj = 0; bj < 2; ++bj) { const float sc = (isk ? 1.0f : qscale) * DS2; const f32x4 v0 = acc[ai][bj][m][0] * sc, v1 = acc[ai][bj][m][1] * sc; const int col = col0 + bj * 128;
                    u32x4 w; w.x = cvtpk(v0[0], v0[1]); w.y = cvtpk(v0[2], v0[3]); w.z = cvtpk(v1[0], v1[1]); w.w = cvtpk(v1[2], v1[3]);
                    bf16_t* p = isk ? KT + ((((size_t)((col - 1024) >> 7) * 256 + (row >> 6)) * 64 + (row & 63)) * 128 + (col & 127)) : Q + (size_t)row * 1024 + col;
                    *(u32x4*)p = w; } }
    }
};
struct StoreQK8 {
    static constexpr bool PERM = true;
    unsigned char* Q; unsigned char* KT; float qs, ks;
    __device__ __forceinline__ void operator()(const f32x4 (&acc)[2][2][4][2], const Unit& u, int wr, int wc, int fr, int fq) const {
        const int row0 = u.pm * 256 + wr * 64 + fr, col0 = u.pn * 256 + wc * 32 + 8 * fq;
        const bool isk = (u.pn >= 4);
#pragma unroll
        for (int ai = 0; ai < 2; ++ai)
#pragma unroll
            for (int m = 0; m < 4; ++m) { const int row = row0 + ai * 128 + m * 16;
#pragma unroll
                for (int bj = 0; bj < 2; ++bj) { const float sc = isk ? 1.0f : qs;        const f32x4 v0 = acc[ai][bj][m][0] * sc, v1 = acc[ai][bj][m][1] * sc; const int col = col0 + bj * 128;
                    unsigned char* p = isk ? KT + ((((size_t)((col - 1024) >> 7) * 256 + (row >> 6)) * 64 + (row & 63)) * 128 + (col & 127)) : Q + (size_t)row * 1024 + col;
                    *(u32x2*)p = (u32x2){pack4_f8(v0[0], v0[1], v0[2], v0[3]), pack4_f8(v1[0], v1[1], v1[2], v1[3])}; }
                __builtin_amdgcn_sched_barrier(0); }
    }
};
struct StoreQKboth {
    static constexpr bool PERM = true;
    StoreQK b16; unsigned char* Q8; unsigned char* KT8;
    __device__ __forceinline__ void operator()(const f32x4 (&acc)[2][2][4][2], const Unit& u, int wr, int wc, int fr, int fq) const {
        b16(acc, u, wr, wc, fr, fq);
        const int row0 = u.pm * 256 + wr * 64 + fr, col0 = u.pn * 256 + wc * 32 + 8 * fq;
        const bool isk = (u.pn >= 4);
        const float sc = isk ? att::D8_KS : att::MB8_QS;
#pragma unroll
        for (int ai = 0; ai < 2; ++ai)
#pragma unroll
            for (int m = 0; m < 4; ++m) { const int row = row0 + ai * 128 + m * 16;
#pragma unroll
                for (int bj = 0; bj < 2; ++bj) { const f32x4 v0 = acc[ai][bj][m][0] * sc, v1 = acc[ai][bj][m][1] * sc; const int col = col0 + bj * 128;
                    unsigned char* p = isk ? KT8 + ((((size_t)((col - 1024) >> 7) * 256 + (row >> 6)) * 64 + (row & 63)) * 128 + (col & 127)) : Q8 + (size_t)row * 1024 + col;
                    *(u32x2*)p = (u32x2){pack4_f8(v0[0], v0[1], v0[2], v0[3]), pack4_f8(v1[0], v1[1], v1[2], v1[3])}; }
                __builtin_amdgcn_sched_barrier(0); }
    }
};
struct StoreVT8 {
    static constexpr bool PERM = true;
    unsigned char* VT; float vs;
    __device__ __forceinline__ void operator()(const f32x4 (&acc)[2][2][4][2], const Unit& u, int wr, int wc, int fr, int fq) const {
        const int row0 = u.pm * 256 + wr * 64 + fr, col0 = u.pn * 256 + wc * 32 + 8 * fq;
#pragma unroll
        for (int ai = 0; ai < 2; ++ai)
#pragma unroll
            for (int m = 0; m < 4; ++m) { const int f = row0 + ai * 128 + m * 16;
#pragma unroll
                for (int bj = 0; bj < 2; ++bj) { const f32x4 v0 = acc[ai][bj][m][0], v1 = acc[ai][bj][m][1]; const int tok = col0 + bj * 128, k = tok & 63;
                    unsigned char* p = VT + ((((size_t)(f >> 7) * 256 + (tok >> 6)) * 128 + (f & 127)) * 64 + (k >> 5) * 16 + ((k & 31) >> 3) * 4);
                    *(unsigned*)p = pack4_f8(v0[0], v0[1], v0[2], v0[3]); *(unsigned*)(p + 32) = pack4_f8(v1[0], v1[1], v1[2], v1[3]); }
                __builtin_amdgcn_sched_barrier(0); }
    }
};
struct StoreVT {
    static constexpr bool PERM = true;
    bf16_t* VT;
    __device__ __forceinline__ void operator()(const f32x4 (&acc)[2][2][4][2], const Unit& u, int wr, int wc, int fr, int fq) const {
        const int row0 = u.pm * 256 + wr * 64 + fr, col0 = u.pn * 256 + wc * 32 + 8 * fq;
#pragma unroll
        for (int ai = 0; ai < 2; ++ai)
#pragma unroll
            for (int m = 0; m < 4; ++m) { const int f = row0 + ai * 128 + m * 16;
#pragma unroll
                for (int bj = 0; bj < 2; ++bj) { const f32x4 v0 = acc[ai][bj][m][0] * DS2, v1 = acc[ai][bj][m][1] * DS2; const int tok = col0 + bj * 128;
                    u32x4 w; w.x = cvtpk(v0[0], v0[1]); w.y = cvtpk(v0[2], v0[3]); w.z = cvtpk(v1[0], v1[1]); w.w = cvtpk(v1[2], v1[3]);
                    *(u32x4*)(VT + ((((size_t)(f >> 7) * 256 + (tok >> 6)) * 128 + (f & 127)) * 64 + (tok & 63))) = w; } }
    }
};
#define P2W_VALS(SC) const f32x4 v0 = acc[ai][0][m][0] * (SC), v1 = acc[ai][0][m][1] * (SC), v2 = acc[ai][1][m][0] * (SC), v3 = acc[ai][1][m][1] * (SC)
#define P2W_PACK8() ((u32x4){pack4_f8(v0[0], v0[1], v0[2], v0[3]), pack4_f8(v1[0], v1[1], v1[2], v1[3]), pack4_f8(v2[0], v2[1], v2[2], v2[3]), pack4_f8(v3[0], v3[1], v3[2], v3[3])})
struct StoreQK8w {
    unsigned char* Q; unsigned char* KT; float qs;
    __device__ __forceinline__ void operator()(const f32x4 (&acc)[2][2][4][2], const Unit& u, int wr, int wc, int fr, int fq) const {
        const int row0 = u.pm * 256 + wr * 64 + fr, col = u.pn * 256 + wc * 64 + 16 * fq; const bool isk = (u.pn >= 4); const float sc = isk ? 1.0f : qs;
#pragma unroll
        for (int ai = 0; ai < 2; ++ai)
#pragma unroll
            for (int m = 0; m < 4; ++m) { const int row = row0 + ai * 128 + m * 16; P2W_VALS(sc);
                unsigned char* p = isk ? KT + ((((size_t)((col - 1024) >> 7) * 256 + (row >> 6)) * 64 + (row & 63)) * 128 + (col & 127)) : Q + (size_t)row * 1024 + col;
                *(u32x4*)p = P2W_PACK8(); }
    }
};
struct StoreQKbothw {
    bf16_t* Q; bf16_t* KT; unsigned char* Q8; unsigned char* KT8;
    __device__ __forceinline__ void operator()(const f32x4 (&acc)[2][2][4][2], const Unit& u, int wr, int wc, int fr, int fq) const {
        const int row0 = u.pm * 256 + wr * 64 + fr, col = u.pn * 256 + wc * 64 + 16 * fq; const bool isk = (u.pn >= 4); const float sc = isk ? att::D8_KS : att::MB8_QS;
#pragma unroll
        for (int ai = 0; ai < 2; ++ai)
#pragma unroll
            for (int m = 0; m < 4; ++m) { const int row = row0 + ai * 128 + m * 16;
                const size_t koff = (((size_t)((col - 1024) >> 7) * 256 + (row >> 6)) * 64 + (row & 63)) * 128 + (col & 127), qoff = (size_t)row * 1024 + col;
                { P2W_VALS(1.0f); bf16_t* p = isk ? KT + koff : Q + qoff;
                  *(u32x4*)p = (u32x4){cvtpk(v0[0], v0[1]), cvtpk(v0[2], v0[3]), cvtpk(v1[0], v1[1]), cvtpk(v1[2], v1[3])};
                  *(u32x4*)(p + 8) = (u32x4){cvtpk(v2[0], v2[1]), cvtpk(v2[2], v2[3]), cvtpk(v3[0], v3[1]), cvtpk(v3[2], v3[3])}; }
                { P2W_VALS(sc); unsigned char* p = isk ? KT8 + koff : Q8 + qoff; *(u32x4*)p = P2W_PACK8(); }
                __builtin_amdgcn_sched_barrier(0); }
    }
};
struct GatesW {
    unsigned char* O;
    __device__ __forceinline__ void operator()(const f32x4 (&acc)[2][2][4][2], const Unit& u, int wr, int wc, int fr, int fq) const {
        const int row0 = u.pm * 256 + wr * 64 + fr, col = u.pn * 256 + wc * 64 + 16 * fq;
#pragma unroll
        for (int ai = 0; ai < 2; ++ai)
#pragma unroll
            for (int m = 0; m < 4; ++m) { const int row = row0 + ai * 128 + m * 16;
                f32x4 v0 = acc[ai][0][m][0], v1 = acc[ai][0][m][1], v2 = acc[ai][1][m][0], v3 = acc[ai][1][m][1];
#pragma unroll
                for (int j = 0; j < 4; ++j) { v0[j] = sigmoidf_(v0[j]) * F8_SGATE; v1[j] = sigmoidf_(v1[j]) * F8_SGATE; v2[j] = sigmoidf_(v2[j]) * F8_SGATE; v3[j] = sigmoidf_(v3[j]) * F8_SGATE; }
                *(u32x4*)(O + (size_t)row * 4096 + col) = P2W_PACK8(); }
    }
};
#undef P2W_VALS
struct ProjEpi {
    static constexpr int PERM = 2; static constexpr bool HAS_MID = false;
    StoreQK8w qkd; StoreQKbothw qkm; GatesW gates;
    __device__ __forceinline__ int f8exp(const Unit& u) const { return (u.pn >= 4 && u.pn < 8) ? P2_EXP - 2 : P2_EXP; }
    __device__ __forceinline__ void operator()(const f32x4 (&acc)[2][2][4][2], const Unit& u, int wr, int wc, int fr, int fq) const {
        Unit v = u;
        if (u.pn < 8) qkd(acc, v, wr, wc, fr, fq);
        else if (u.pn < 16) { v.pn = u.pn - 8; qkm(acc, v, wr, wc, fr, fq); }
        else { v.pn = u.pn - 16; gates(acc, v, wr, wc, fr, fq); }
    }
};
struct ProjVT {
    static constexpr bool PERM = true, HAS_MID = false;
    StoreVT8 vd; StoreVT8 vm;
    __device__ __forceinline__ int f8exp(const Unit& u) const { return P2_EXP - 3; }
    __device__ __forceinline__ void operator()(const f32x4 (&acc)[2][2][4][2], const Unit& u, int wr, int wc, int fr, int fq) const {
        Unit v = u;
        if (u.pm < 4) vd(acc, v, wr, wc, fr, fq); else { v.pm = u.pm - 4; vm(acc, v, wr, wc, fr, fq); }
    }
};
struct GatePair {
    static constexpr int PERM = 2; static constexpr bool HAS_MID = false;
    GateMul<0> e0; GateMul<1> e1;
    __device__ __forceinline__ int f8exp(const Unit& u) const { return u.aux == 0 ? 9 + 8 : 11 + 8; }
    __device__ __forceinline__ void operator()(const f32x4 (&acc)[2][2][4][2], const Unit& u, int wr, int wc, int fr, int fq) const {
        if (u.aux == 0) e0(acc, u, wr, wc, fr, fq); else e1(acc, u, wr, wc, fr, fq);
    }
};
struct ResidBf16 {
    static constexpr bool PERM = true, HAS_MID = false;
    const float* base; bf16_t* out; const float* gate; int goff;
    __device__ __forceinline__ int f8exp(const Unit&) const { return 10; }
    __device__ __forceinline__ void operator()(const f32x4 (&acc)[2][2][4][2], const Unit& u, int wr, int wc, int fr, int fq) const {
        const int row0 = u.pm * 256 + wr * 64 + fr, col0 = u.pn * 256 + wc * 32 + 8 * fq;
        const int b = (u.pm * 256) / SEQ;
        f32x4 gv[2][2];
#pragma unroll
        for (int bj = 0; bj < 2; ++bj)
#pragma unroll
            for (int n = 0; n < 2; ++n) gv[bj][n] = *(const f32x4*)(gate + (size_t)b * 12288 + goff + col0 + bj * 128 + n * 4);
#pragma unroll
        for (int ai = 0; ai < 2; ++ai)
#pragma unroll
            for (int m = 0; m < 4; ++m) { const size_t off = (size_t)(row0 + ai * 128 + m * 16) * 2048 + col0;
#pragma unroll
                for (int bj = 0; bj < 2; ++bj) {
                    const f32x4 b0 = *(const f32x4*)(base + off + bj * 128), b1 = *(const f32x4*)(base + off + bj * 128 + 4);
                    const f32x4 v0 = b0 + gv[bj][0] * acc[ai][bj][m][0], v1 = b1 + gv[bj][1] * acc[ai][bj][m][1];
                    u32x4 w; w.x = cvtpk(v0[0], v0[1]); w.y = cvtpk(v0[2], v0[3]); w.z = cvtpk(v1[0], v1[1]); w.w = cvtpk(v1[2], v1[3]);
                    *(u32x4*)(out + off + bj * 128) = w; } }
    }
};
}
namespace att {
constexpr int KROW = 272;
constexpr int VROW = 144;
constexpr int KBUF = 64 * KROW;
constexpr int VBUF = 128 * VROW;
constexpr int OFF_K = 0, OFF_V = 2 * KBUF, OFF_TAB = OFF_V + 2 * VBUF, OFF_G = OFF_TAB + 512, OFF_END = OFF_G + 512;
static_assert(OFF_END <= RING_BYTES, "attention LDS");
__device__ __forceinline__ int crow(int i, int hh) { return (i & 3) + 8 * (i >> 2) + 4 * hh; }

__device__ __forceinline__ int t5_bucket(int n) {
    if (n < 16) return n;
    int b = 16;
    b += (n >= 19); b += (n >= 21); b += (n >= 24); b += (n >= 27); b += (n >= 31); b += (n >= 35); b += (n >= 40); b += (n >= 46);
    b += (n >= 52); b += (n >= 59); b += (n >= 67); b += (n >= 77); b += (n >= 87); b += (n >= 99); b += (n >= 113);
    return b;
}
__device__ __forceinline__ void fill_bias_tab(LAS float* tab, const float* rel_bias, int col) {
    if (threadIdx.x < 128) { const int n = threadIdx.x; tab[n] = (rel_bias[t5_bucket(n) * 16 + col] - rel_bias[31 * 16 + col]) * LOG2E; }
}

struct TileRegs { u32x4 k[2]; u32x4 v[2]; };
__device__ __forceinline__ void tile_load(TileRegs& R, const bf16_t* kt, const bf16_t* vt, int tid) {
#pragma unroll
    for (int i = 0; i < 2; ++i) { const int c = tid + 512 * i; R.k[i] = *(const u32x4*)(kt + c * 8); }
#pragma unroll
    for (int i = 0; i < 2; ++i) { const int c = tid + 512 * i; R.v[i] = *(const u32x4*)(vt + c * 8); }
}
__device__ __forceinline__ void tile_store(const TileRegs& R, LAS unsigned char* kb, LAS unsigned char* vb, int tid) {
#pragma unroll
    for (int i = 0; i < 2; ++i) { const int c = tid + 512 * i; *(LAS u32x4*)(kb + (c >> 4) * KROW + (c & 15) * 16) = R.k[i]; }
#pragma unroll
    for (int i = 0; i < 2; ++i) { const int c = tid + 512 * i;
        LAS unsigned char* p = vb + (c >> 3) * VROW + ((c & 7) >> 1) * 32 + (c & 1) * 8;
        *(LAS u32x2*)p = (u32x2){R.v[i].x, R.v[i].y}; *(LAS u32x2*)(p + 16) = (u32x2){R.v[i].z, R.v[i].w}; }
}

template <int NMAP, int KS>
__device__ __forceinline__ void attn_half(const LAS unsigned char* kb, const LAS unsigned char* vb, int kh, const bf16x8 (&qf)[NMAP][KS], f32x16 (&O)[NMAP][4],
                                          float (&mrun)[NMAP], float (&lrun)[NMAP], int qpos, int kvpos0, bool need_mask, bool need_bias, const LAS float* btab, float sc, int r, int hh, int kcolbase) {
    bf16x8 P[NMAP][2];
#pragma unroll
    for (int m = 0; m < NMAP; ++m) {
        f32x16 s;
#pragma unroll
        for (int i = 0; i < 16; ++i) s[i] = 0.f;
#pragma unroll
        for (int ks = 0; ks < KS; ++ks) {
            const bf16x8 kf = *(const LAS bf16x8*)(kb + (32 * kh + r) * KROW + (kcolbase + m * 16 * KS + 16 * ks + 8 * hh) * 2);
            s = __builtin_amdgcn_mfma_f32_32x32x16_bf16(kf, qf[m][ks], s, 0, 0, 0);
        }
#pragma unroll
        for (int i = 0; i < 16; ++i) s[i] *= sc;
        if (need_bias) {
#pragma unroll
            for (int i = 0; i < 16; ++i) { int rel = qpos - (kvpos0 + crow(i, hh)); rel = rel < 0 ? 0 : (rel > 127 ? 127 : rel); s[i] += btab[rel]; }
        }
        if (need_mask) {
#pragma unroll
            for (int i = 0; i < 16; ++i) { if (kvpos0 + crow(i, hh) > qpos) s[i] = -INFINITY; }
        }
        float mx = s[0];
#pragma unroll
        for (int i = 1; i < 16; ++i) mx = fmaxf(mx, s[i]);
        mx = fmaxf(mx, __shfl_xor(mx, 32));
        const float mnew = fmaxf(mrun[m], mx);
        const float alpha = fast_exp2(mrun[m] - mnew);
        float sum = 0.f;
#pragma unroll
        for (int i = 0; i < 16; ++i) { const float p = fast_exp2(s[i] - mnew); sum += p; s[i] = p; }
        lrun[m] = lrun[m] * alpha + sum; mrun[m] = mnew;
#pragma unroll
        for (int dt = 0; dt < 4; ++dt)
#pragma unroll
            for (int i = 0; i < 16; ++i) O[m][dt][i] *= alpha;
#pragma unroll
        for (int st = 0; st < 2; ++st) { u32x4 w; w.x = cvtpk(s[8 * st + 0], s[8 * st + 1]); w.y = cvtpk(s[8 * st + 2], s[8 * st + 3]); w.z = cvtpk(s[8 * st + 4], s[8 * st + 5]); w.w = cvtpk(s[8 * st + 6], s[8 * st + 7]);
            P[m][st] = __builtin_bit_cast(bf16x8, w); }
    }
#pragma unroll
    for (int dt = 0; dt < 4; ++dt)
#pragma unroll
        for (int st = 0; st < 2; ++st) {
            const bf16x8 vf = *(const LAS bf16x8*)(vb + (32 * dt + r) * VROW + (2 * kh + st) * 32 + hh * 16);
#pragma unroll
            for (int m = 0; m < NMAP; ++m) O[m][dt] = __builtin_amdgcn_mfma_f32_32x32x16_bf16(vf, P[m][st], O[m][dt], 0, 0, 0);
        }
}

#define SBAR() __builtin_amdgcn_sched_barrier(0)
constexpr int TBUF = KBUF + VBUF;
constexpr int D_OFF_TAB = 3 * TBUF, D_OFF_G = D_OFF_TAB + 512;
static_assert(D_OFF_G + 512 <= RING_BYTES, "diff attention LDS");
constexpr float D_C = 0.125f * LOG2E;
__device__ __forceinline__ void d_load_kf(bf16x8 (&kf)[4], const LAS unsigned char* kb, int kh, int r, int hh, int kcol) {
#pragma unroll
    for (int ks = 0; ks < 4; ++ks) kf[ks] = *(const LAS bf16x8*)(kb + (32 * kh + r) * KROW + (kcol + 16 * ks + 8 * hh) * 2);
}
constexpr float D_THR = 8.0f;
__device__ __forceinline__ float max3_(float a, float b, float c) { float r; asm("v_max3_f32 %0, %1, %2, %3" : "=v"(r) : "v"(a), "v"(b), "v"(c)); return r; }
template <int MODE, bool LOADV, bool PREFK>
__device__ __forceinline__ void d_half_a(const bf16x8 (&kf)[4], bf16x8 (&kfn)[4], const LAS unsigned char* knext, int khn, const LAS unsigned char* vb, int kh,
                                         const bf16x8 (&qf)[4], f32x16 (&o)[4], float& mref, float& lrun, int qpos, int kvpos0, bool need_mask, bool need_bias, bool first,
                                         const LAS float* btab, int r, int hh, int kcol, bf16x8 (&vf)[4], bf16x8 (&P)[2]) {
    if (LOADV) {
#pragma unroll
        for (int dt = 0; dt < 2; ++dt)
#pragma unroll
            for (int st = 0; st < 2; ++st) vf[2 * dt + st] = *(const LAS bf16x8*)(vb + (32 * dt + r) * VROW + (2 * kh + st) * 32 + hh * 16);
    }
    SBAR();
    f32x16 s;
#pragma unroll
    for (int i = 0; i < 16; ++i) s[i] = 0.f;
    __builtin_amdgcn_s_setprio(1);
#pragma unroll
    for (int ks = 0; ks < 4; ++ks) { if (MODE != 3) s = __builtin_amdgcn_mfma_f32_32x32x16_bf16(kf[ks], qf[ks], s, 0, 0, 0); else { s[ks] += __builtin_bit_cast(float, (int)kf[ks][0]); s[4 + ks] += __builtin_bit_cast(float, (int)qf[ks][1]); } }
    __builtin_amdgcn_s_setprio(0);
    if (PREFK) d_load_kf(kfn, knext, khn, r, hh, kcol);
    SBAR();
    if (MODE == 4) { P[0] = qf[0]; P[1] = qf[1]; mref = fmaxf(mref, s[0]); } else {
    if (need_bias) {
#pragma unroll
        for (int i = 0; i < 16; ++i) { int rel = qpos - (kvpos0 + crow(i, hh)); rel = rel < 0 ? 0 : (rel > 127 ? 127 : rel); s[i] += btab[rel]; }
    }
    if (need_mask) {
#pragma unroll
        for (int i = 0; i < 16; ++i) { if (kvpos0 + crow(i, hh) > qpos) s[i] = -INFINITY; }
    }
    float mx = max3_(s[0], s[1], s[2]);
    mx = max3_(mx, s[3], s[4]); mx = max3_(mx, s[5], s[6]); mx = max3_(mx, s[7], s[8]); mx = max3_(mx, s[9], s[10]); mx = max3_(mx, s[11], s[12]); mx = max3_(mx, s[13], s[14]);
    { auto rr = __builtin_amdgcn_permlane32_swap(__float_as_uint(mx), __float_as_uint(mx), false, false); mx = max3_(s[15], __uint_as_float(rr[0]), __uint_as_float(rr[1])); }
    if (first || __any(mx - mref > D_THR)) {
        const float mn = first ? mx : fmaxf(mref, mx);
        const float alpha = first ? 0.f : fast_exp2(mref - mn);
        mref = mn; lrun *= alpha;
#pragma unroll
        for (int dt = 0; dt < 4; ++dt)
#pragma unroll
            for (int i = 0; i < 16; ++i) o[dt][i] *= alpha;
    }
    float sum = 0.f;
#pragma unroll
    for (int i = 0; i < 16; ++i) { const float p = fast_exp2(s[i] - mref); sum += p; s[i] = p; }
    lrun += sum;
#pragma unroll
    for (int st = 0; st < 2; ++st) { u32x4 w; w.x = cvtpk(s[8 * st + 0], s[8 * st + 1]); w.y = cvtpk(s[8 * st + 2], s[8 * st + 3]); w.z = cvtpk(s[8 * st + 4], s[8 * st + 5]); w.w = cvtpk(s[8 * st + 6], s[8 * st + 7]);
        P[st] = __builtin_bit_cast(bf16x8, w); }
    }
}
template <int MODE, bool LOADV>
__device__ __forceinline__ void d_half_b(f32x16 (&o)[4], bf16x8 (&vf)[4], const bf16x8 (&P)[2], const LAS unsigned char* vb, int kh, int r, int hh) {
    if (LOADV) {
#pragma unroll
        for (int dt = 0; dt < 2; ++dt)
#pragma unroll
            for (int st = 0; st < 2; ++st) vf[2 * dt + st] = *(const LAS bf16x8*)(vb + (32 * dt + r) * VROW + (2 * kh + st) * 32 + hh * 16);
    }
    bf16x8 vg[4];
#pragma unroll
    for (int dt = 2; dt < 4; ++dt)
#pragma unroll
        for (int st = 0; st < 2; ++st) vg[2 * (dt - 2) + st] = *(const LAS bf16x8*)(vb + (32 * dt + r) * VROW + (2 * kh + st) * 32 + hh * 16);
    asm volatile("s_waitcnt lgkmcnt(4)" ::: "memory"); SBAR();
    __builtin_amdgcn_s_setprio(1);
#pragma unroll
    for (int dt = 0; dt < 2; ++dt)
#pragma unroll
        for (int st = 0; st < 2; ++st) {
            if (MODE != 3) o[dt] = __builtin_amdgcn_mfma_f32_32x32x16_bf16(vf[2 * dt + st], P[st], o[dt], 0, 0, 0);
            else o[dt][st] += __builtin_bit_cast(float, (int)vf[2 * dt + st][0]) * __builtin_bit_cast(float, (int)P[st][0]);
        }
    asm volatile("s_waitcnt lgkmcnt(0)" ::: "memory"); SBAR();
#pragma unroll
    for (int dt = 2; dt < 4; ++dt)
#pragma unroll
        for (int st = 0; st < 2; ++st) {
            if (MODE != 3) o[dt] = __builtin_amdgcn_mfma_f32_32x32x16_bf16(vg[2 * (dt - 2) + st], P[st], o[dt], 0, 0, 0);
            else o[dt][st] += __builtin_bit_cast(float, (int)vg[2 * (dt - 2) + st][0]) * __builtin_bit_cast(float, (int)P[st][0]);
        }
    __builtin_amdgcn_s_setprio(0);
}
template <int MODE>
__device__ __forceinline__ void diff_unit(LAS unsigned char* lds, int b, int h, int qt, const bf16_t* QD, const bf16_t* KDT, const bf16_t* VDT, bf16_t* AD, const float* subln, const float* rel_bias) {
    int tid_ = threadIdx.x; asm volatile("" : "+v"(tid_));
    const int tid = tid_, lane = tid & 63, r = lane & 31, hh = lane >> 5; const int wid = __builtin_amdgcn_readfirstlane(tid >> 6);
    const int map = wid >> 2, qsub = wid & 3;
    const int q0 = qt * 128, qw0 = q0 + 32 * qsub, qpos = qw0 + r;
    const size_t tok0 = (size_t)b * SEQ;
    const LAS float* btab = (const LAS float*)(lds + D_OFF_TAB);
    const LAS float* gtab = (const LAS float*)(lds + D_OFF_G);
    const int kcol = map * 64;
    bf16x8 qf[4];
#pragma unroll
    for (int ks = 0; ks < 4; ++ks) qf[ks] = *(const bf16x8*)(QD + (tok0 + qpos) * 1024 + h * 128 + map * 64 + 16 * ks + 8 * hh);
    f32x16 o[4];
#pragma unroll
    for (int dt = 0; dt < 4; ++dt)
#pragma unroll
        for (int i = 0; i < 16; ++i) o[dt][i] = 0.f;
    float mrun = 0.f, lrun = 0.f;
    const bf16_t* kbase = KDT + ((size_t)h * 256 + b * 128) * 8192;
    const bf16_t* vbase = VDT + ((size_t)h * 256 + b * 128) * 8192;
    const int NT = 2 * (qt + 1);
    TileRegs R;
    bf16x8 kfa[4], kfb[4];
    __syncthreads();
    fill_bias_tab((LAS float*)(lds + D_OFF_TAB), rel_bias, h);
    if (tid < 128) ((LAS float*)(lds + D_OFF_G))[tid] = subln[tid];
    tile_load(R, kbase, vbase, tid);
    tile_store(R, lds, lds + KBUF, tid);
    tile_load(R, kbase + 8192, vbase + 8192, tid);
    __syncthreads();
    if (MODE != 2) d_load_kf(kfa, lds, 0, r, hh, kcol);
    int bc = 0;
    bf16x8 vf[4], P[2];
#define D_STAGE() do { if (t + 1 < NT) tile_store(R, lds + bn * TBUF, lds + bn * TBUF + KBUF, tid); \
        if (t + 2 < NT) tile_load(R, kbase + (size_t)(MODE == 1 ? 0 : t + 2) * 8192, vbase + (size_t)(MODE == 1 ? 0 : t + 2) * 8192, tid); \
        __syncthreads(); } while (0)
    if (wid < 4) {
#pragma unroll 1
        for (int t = 0; t < NT; ++t) {
            const int bn = (bc == 2) ? 0 : bc + 1;
            const LAS unsigned char* kb = lds + bc * TBUF; const LAS unsigned char* vb = kb + KBUF;
            const int k0 = 64 * t;
            { const bool nm = (k0 + 31 > qw0), nb = (qw0 - (k0 + 31) < 113);
              if (MODE != 2) { d_half_a<MODE, true, true>(kfa, kfb, kb, 1, vb, 0, qf, o, mrun, lrun, qpos, k0, nm, nb, t == 0, btab, r, hh, kcol, vf, P); d_half_b<MODE, false>(o, vf, P, vb, 0, r, hh); } }
            D_STAGE();
            { const bool nm = (k0 + 63 > qw0), nb = (qw0 - (k0 + 63) < 113);
              if (MODE != 2) { d_half_a<MODE, true, true>(kfb, kfa, lds + bn * TBUF, 0, vb, 1, qf, o, mrun, lrun, qpos, k0 + 32, nm, nb, false, btab, r, hh, kcol, vf, P); d_half_b<MODE, false>(o, vf, P, vb, 1, r, hh); } }
            bc = bn;
        }
    } else {
#pragma unroll 1
        for (int t = 0; t < NT; ++t) {
            const int bn = (bc == 2) ? 0 : bc + 1;
            const LAS unsigned char* kb = lds + bc * TBUF; const LAS unsigned char* vb = kb + KBUF;
            const int k0 = 64 * t;
            { const bool nm = (k0 + 31 > qw0), nb = (qw0 - (k0 + 31) < 113);
              if (MODE != 2) d_half_a<MODE, false, false>(kfa, kfb, kb, 1, vb, 0, qf, o, mrun, lrun, qpos, k0, nm, nb, t == 0, btab, r, hh, kcol, vf, P); }
            D_STAGE();
            if (MODE != 2) { d_half_b<MODE, true>(o, vf, P, vb, 0, r, hh); d_load_kf(kfb, kb, 1, r, hh, kcol); }
            { const bool nm = (k0 + 63 > qw0), nb = (qw0 - (k0 + 63) < 113);
              if (MODE != 2) { d_half_a<MODE, true, true>(kfb, kfa, lds + bn * TBUF, 0, vb, 1, qf, o, mrun, lrun, qpos, k0 + 32, nm, nb, false, btab, r, hh, kcol, vf, P); d_half_b<MODE, false>(o, vf, P, vb, 1, r, hh); } }
            bc = bn;
        }
    }
#undef D_STAGE
    __syncthreads();
    const float l = lrun + __shfl_xor(lrun, 32);
    LAS float* xch = (LAS float*)lds + qsub * 4096 + lane;
    if (map == 1) {
        const float lam = *(const LAS float*)(lds + MISC_OFF + 68);
        const float f = lam / l;
#pragma unroll
        for (int dt = 0; dt < 4; ++dt)
#pragma unroll
            for (int i = 0; i < 16; ++i) xch[(dt * 16 + i) * 64] = o[dt][i] * f;
    }
    __syncthreads();
    if (map == 0) {
        const float i0 = 1.0f / l;
        float ss = 0.f;
#pragma unroll
        for (int dt = 0; dt < 4; ++dt)
#pragma unroll
            for (int i = 0; i < 16; ++i) { const float v = o[dt][i] * i0 - xch[(dt * 16 + i) * 64]; o[dt][i] = v; ss += v * v; }
        ss += __shfl_xor(ss, 32);
        const float rs = 0.8f / sqrtf(ss * (1.0f / 128.0f) + RMS_EPS);
        bf16_t* orow = AD + (tok0 + qpos) * 1024 + h * 128;
#pragma unroll
        for (int dt = 0; dt < 4; ++dt)
#pragma unroll
            for (int g = 0; g < 4; ++g) { const int d = 32 * dt + 8 * g + 4 * hh;
                const f32x4 gg = *(const LAS f32x4*)(gtab + d);
                u32x2 w; w.x = cvtpk(o[dt][4 * g + 0] * rs * gg[0], o[dt][4 * g + 1] * rs * gg[1]); w.y = cvtpk(o[dt][4 * g + 2] * rs * gg[2], o[dt][4 * g + 3] * rs * gg[3]);
                *(u32x2*)(orow + d) = w; }
    }
}

constexpr int KROW8 = 144, VROW8 = 80, KBUF8 = 64 * KROW8, VBUF8 = 128 * VROW8, TBUF8 = KBUF8 + VBUF8;
static_assert(4 * TBUF8 <= D_OFF_TAB, "fp8 diff attention LDS");
constexpr float D8_C = 1.0f / 64.0f, D8_THR = 3.0f * 64.0f, D8_SH = 5.0f;
struct TileRegs8 { u32x4 k, v; };
__device__ __forceinline__ void tile_load8(TileRegs8& R, const unsigned char* kt, const unsigned char* vt, int tid) { R.k = *(const u32x4*)(kt + tid * 16); R.v = *(const u32x4*)(vt + tid * 16); }
__device__ __forceinline__ void tile_store8(const TileRegs8& R, LAS unsigned char* kb, LAS unsigned char* vb, int tid) {
    *(LAS u32x4*)(kb + (tid >> 3) * KROW8 + (tid & 7) * 16) = R.k; *(LAS u32x4*)(vb + (tid >> 2) * VROW8 + (tid & 3) * 16) = R.v; }
__device__ __forceinline__ i32x8 cat8(const i32x4 a, const i32x4 b) { return __builtin_shufflevector(a, b, 0, 1, 2, 3, 4, 5, 6, 7); }
__device__ __forceinline__ void d8_load_kf(i32x8 (&kf)[2], const LAS unsigned char* kb, int r, int hh, int kcolb) {
#pragma unroll
    for (int kh = 0; kh < 2; ++kh) { const LAS unsigned char* q = kb + (32 * kh + r) * KROW8 + kcolb + 32 * hh; kf[kh] = cat8(*(const LAS i32x4*)q, *(const LAS i32x4*)(q + 16)); }
}
template <int DT0>
__device__ __forceinline__ void d8_load_vf2(i32x8 (&vf)[2], const LAS unsigned char* vb, int r, int hh) {
#pragma unroll
    for (int dt = 0; dt < 2; ++dt) { const LAS unsigned char* q = vb + (32 * (DT0 + dt) + r) * VROW8 + 32 * hh; vf[dt] = cat8(*(const LAS i32x4*)q, *(const LAS i32x4*)(q + 16)); }
}
__device__ __forceinline__ void d8_scores(f32x16& s0, f32x16& s1, const i32x8 (&kf)[2], const i32x8& qf) {
    f32x16 z;
#pragma unroll
    for (int i = 0; i < 16; ++i) z[i] = 0.f;
    __builtin_amdgcn_s_setprio(1);
    s0 = __builtin_amdgcn_mfma_scale_f32_32x32x64_f8f6f4(kf[0], qf, z, 0, 0, 0, 0x7F7F7F7F, 0, 0x7F7F7F7F);
    s1 = __builtin_amdgcn_mfma_scale_f32_32x32x64_f8f6f4(kf[1], qf, z, 0, 0, 0, 0x7F7F7F7F, 0, 0x7F7F7F7F);
    __builtin_amdgcn_s_setprio(0);
}
template <bool ROW = false>
__device__ __forceinline__ i32x8 d8_softmax(f32x16& s0, f32x16& s1, f32x16 (&o)[4], float& mref, float& lrun, int qpos, int k0, bool need_mask, bool need_bias, bool first, const LAS float* btab, int hh) {
    if (need_bias) {
#pragma unroll
        for (int i = 0; i < 16; ++i) { int rel = qpos - (k0 + crow(i, hh)); rel = rel < 0 ? 0 : (rel > 127 ? 127 : rel); s0[i] += btab[rel]; }
        SBAR();
#pragma unroll
        for (int i = 0; i < 16; ++i) { int rel = qpos - (k0 + 32 + crow(i, hh)); rel = rel < 0 ? 0 : (rel > 127 ? 127 : rel); s1[i] += btab[rel]; }
        SBAR();
    }
    if (need_mask) {
#pragma unroll
        for (int i = 0; i < 16; ++i) { if (k0 + crow(i, hh) > qpos) s0[i] = -INFINITY; if (k0 + 32 + crow(i, hh) > qpos) s1[i] = -INFINITY; }
    }
    float mx = max3_(s0[0], s0[1], s0[2]);
#pragma unroll
    for (int i = 3; i < 15; i += 2) mx = max3_(mx, s0[i], s0[i + 1]);
    mx = max3_(mx, s0[15], s1[0]);
#pragma unroll
    for (int i = 1; i < 15; i += 2) mx = max3_(mx, s1[i], s1[i + 1]);
    { auto rr = __builtin_amdgcn_permlane32_swap(__float_as_uint(mx), __float_as_uint(mx), false, false); mx = max3_(s1[15], __uint_as_float(rr[0]), __uint_as_float(rr[1])); }
    if constexpr (ROW) {
        const bool up = (mx - mref > D8_THR);
        if (__any(up)) {
            const float alpha = up ? fast_exp2((mref - mx) * D8_C) : 1.0f;
            if (up) mref = mx;
            lrun *= alpha;
            asm volatile("s_nop 15\n\ts_nop 15" ::: "memory");
#pragma unroll
            for (int dt = 0; dt < 4; ++dt)
#pragma unroll
                for (int i = 0; i < 16; ++i) o[dt][i] *= alpha;
        }
    } else
    if (first || __any(mx - mref > D8_THR)) {
        const float mn = first ? mx : fmaxf(mref, mx);
        const float alpha = first ? 0.f : fast_exp2((mref - mn) * D8_C);
        mref = mn; lrun *= alpha;
        asm volatile("s_nop 15\n\ts_nop 15" ::: "memory");
#pragma unroll
        for (int dt = 0; dt < 4; ++dt)
#pragma unroll
            for (int i = 0; i < 16; ++i) o[dt][i] *= alpha;
    }
    const float off = D8_SH - mref * D8_C;
    float sum0 = 0.f, sum1 = 0.f;
    i32x8 P;
    const f32x2 c2 = {D8_C, D8_C}, off2 = {off, off};
    f32x2 sum2 = {0.f, 0.f};
#pragma unroll
    for (int g = 0; g < 4; ++g) {
        const f32x2 a0 = __builtin_elementwise_fma((f32x2){s0[4 * g], s0[4 * g + 1]}, c2, off2), a1 = __builtin_elementwise_fma((f32x2){s0[4 * g + 2], s0[4 * g + 3]}, c2, off2);
        const f32x2 b0 = __builtin_elementwise_fma((f32x2){s1[4 * g], s1[4 * g + 1]}, c2, off2), b1 = __builtin_elementwise_fma((f32x2){s1[4 * g + 2], s1[4 * g + 3]}, c2, off2);
        const f32x2 e0 = {fast_exp2(a0[0]), fast_exp2(a0[1])}, e1 = {fast_exp2(a1[0]), fast_exp2(a1[1])}, f0 = {fast_exp2(b0[0]), fast_exp2(b0[1])}, f1 = {fast_exp2(b1[0]), fast_exp2(b1[1])};
        sum2 += (e0 + e1) + (f0 + f1);
        int w0 = __builtin_amdgcn_cvt_pk_fp8_f32(e0[0], e0[1], 0, false); w0 = __builtin_amdgcn_cvt_pk_fp8_f32(e1[0], e1[1], w0, true);
        int w1 = __builtin_amdgcn_cvt_pk_fp8_f32(f0[0], f0[1], 0, false); w1 = __builtin_amdgcn_cvt_pk_fp8_f32(f1[0], f1[1], w1, true);
        P[g] = w0; P[4 + g] = w1; }
    sum0 = sum2[0]; sum1 = sum2[1];
    lrun += sum0 + sum1;
    return P;
}
__device__ __forceinline__ void d8_pv(f32x16 (&o)[4], const i32x8 (&va)[2], const i32x8& P, const LAS unsigned char* vb, int r, int hh) {
    i32x8 vg[2];
    d8_load_vf2<2>(vg, vb, r, hh);
    asm volatile("s_waitcnt lgkmcnt(4)" ::: "memory"); SBAR();
    __builtin_amdgcn_s_setprio(1);
#pragma unroll
    for (int dt = 0; dt < 2; ++dt) asm volatile("v_mfma_scale_f32_32x32x64_f8f6f4 %0, %1, %2, %0, %3, %3 op_sel_hi:[0,0,0]" : "+v"(o[dt]) : "v"(va[dt]), "v"(P), "v"(0x7F7F7F7F));
    asm volatile("s_waitcnt lgkmcnt(0)" ::: "memory"); SBAR();
#pragma unroll
    for (int dt = 0; dt < 2; ++dt) asm volatile("v_mfma_scale_f32_32x32x64_f8f6f4 %0, %1, %2, %0, %3, %3 op_sel_hi:[0,0,0]" : "+v"(o[2 + dt]) : "v"(vg[dt]), "v"(P), "v"(0x7F7F7F7F));
    __builtin_amdgcn_s_setprio(0);
}
__device__ __forceinline__ void diff_unit8(LAS unsigned char* lds, int b, int h, int qt, const unsigned char* QD, const unsigned char* KDT, const unsigned char* VDT, bf16_t* AD, const float* subln, const float* rel_bias) {
    int tid_ = threadIdx.x; asm volatile("" : "+v"(tid_));
    const int tid = tid_, lane = tid & 63, r = lane & 31, hh = lane >> 5; const int wid = __builtin_amdgcn_readfirstlane(tid >> 6);
    const int map = wid >> 2, qsub = wid & 3;
    const int q0 = qt * 128, qw0 = q0 + 32 * qsub, qpos = qw0 + r;
    const size_t tok0 = (size_t)b * SEQ;
    const LAS float* btab = (const LAS float*)(lds + D_OFF_TAB);
    const LAS float* gtab = (const LAS float*)(lds + D_OFF_G);
    const int kcolb = map * 64;
    i32x8 qf;
    { const unsigned char* qp = QD + (tok0 + qpos) * 1024 + h * 128 + map * 64 + 32 * hh; qf = cat8(*(const i32x4*)qp, *(const i32x4*)(qp + 16)); }
    f32x16 o[4];
#pragma unroll
    for (int dt = 0; dt < 4; ++dt)
#pragma unroll
        for (int i = 0; i < 16; ++i) o[dt][i] = 0.f;
    float mrun = 0.f, lrun = 0.f;
    const unsigned char* kbase = KDT + ((size_t)h * 256 + b * 128) * 8192;
    const unsigned char* vbase = VDT + ((size_t)h * 256 + b * 128) * 8192;
    const int NT = 2 * (qt + 1);
    TileRegs8 R;
    __syncthreads();
    if (tid < 128) { const int n = tid; ((LAS float*)(lds + D_OFF_TAB))[n] = (rel_bias[t5_bucket(n) * 16 + h] - rel_bias[31 * 16 + h]) * (LOG2E * 64.0f); ((LAS float*)(lds + D_OFF_G))[n] = subln[n]; }
    tile_load8(R, kbase, vbase, tid); tile_store8(R, lds, lds + KBUF8, tid);
    tile_load8(R, kbase + 8192, vbase + 8192, tid); tile_store8(R, lds + TBUF8, lds + TBUF8 + KBUF8, tid);
    if (NT > 2) tile_load8(R, kbase + 2 * 8192, vbase + 2 * 8192, tid);
    __syncthreads();
    i32x8 kf[2], vf[2];
    d8_load_kf(kf, lds, r, hh, kcolb);
#define D8_STAGE(t) do { if ((t) + 2 < NT) tile_store8(R, lds + (((t) + 2) & 3) * TBUF8, lds + (((t) + 2) & 3) * TBUF8 + KBUF8, tid); \
        if ((t) + 3 < NT) tile_load8(R, kbase + (size_t)((t) + 3) * 8192, vbase + (size_t)((t) + 3) * 8192, tid); \
        __syncthreads(); } while (0)
#pragma unroll 1
    for (int t = 0; t < NT; ++t) {
        const int k0 = 64 * t; const LAS unsigned char* tb = lds + (t & 3) * TBUF8;
        f32x16 s0, s1; d8_scores(s0, s1, kf, qf);
        d8_load_vf2<0>(vf, tb + KBUF8, r, hh); d8_load_kf(kf, lds + ((t + 1) & 3) * TBUF8, r, hh, kcolb); SBAR();
        const i32x8 P = d8_softmax(s0, s1, o, mrun, lrun, qpos, k0, (k0 + 63 > qw0), (qw0 - (k0 + 63) < 113), t == 0, btab, hh);
        if (wid >= 4) D8_STAGE(t);
        d8_pv(o, vf, P, tb + KBUF8, r, hh);
        if (wid < 4) D8_STAGE(t);
    }
#undef D8_STAGE
    __syncthreads();
    asm volatile("s_nop 15\n\ts_nop 15\n\ts_nop 15\n\ts_nop 15" ::: "memory");
    const float l = (lrun + __shfl_xor(lrun, 32)) * D8_VS;
    LAS float* xch = (LAS float*)lds + qsub * 4096 + lane;
    if (map == 1) {
        const float lam = *(const LAS float*)(lds + MISC_OFF + 68);
        const float f = lam / l;
#pragma unroll
        for (int dt = 0; dt < 4; ++dt)
#pragma unroll
            for (int i = 0; i < 16; ++i) xch[(dt * 16 + i) * 64] = o[dt][i] * f;
    }
    __syncthreads();
    if (map == 0) {
        const float i0 = 1.0f / l;
        float ss = 0.f;
#pragma unroll
        for (int dt = 0; dt < 4; ++dt)
#pragma unroll
            for (int i = 0; i < 16; ++i) { const float v = o[dt][i] * i0 - xch[(dt * 16 + i) * 64]; o[dt][i] = v; ss += v * v; }
        ss += __shfl_xor(ss, 32);
        const float rs = 0.8f / sqrtf(ss * (1.0f / 128.0f) + RMS_EPS);
        bf16_t* orow = AD + (tok0 + qpos) * 1024 + h * 128;
#pragma unroll
        for (int dt = 0; dt < 4; ++dt)
#pragma unroll
            for (int g = 0; g < 4; ++g) { const int d = 32 * dt + 8 * g + 4 * hh;
                const f32x4 gg = *(const LAS f32x4*)(gtab + d);
                if constexpr (O78F8) { const float r8 = rs * F8_SAD;
                    *(unsigned*)((unsigned char*)AD + (tok0 + qpos) * 1024 + h * 128 + d) = epi::pack4_f8(o[dt][4 * g + 0] * r8 * gg[0], o[dt][4 * g + 1] * r8 * gg[1], o[dt][4 * g + 2] * r8 * gg[2], o[dt][4 * g + 3] * r8 * gg[3]); }
                else { u32x2 w; w.x = cvtpk(o[dt][4 * g + 0] * rs * gg[0], o[dt][4 * g + 1] * rs * gg[1]); w.y = cvtpk(o[dt][4 * g + 2] * rs * gg[2], o[dt][4 * g + 3] * rs * gg[3]);
                *(u32x2*)(orow + d) = w; } }
    }
}

__device__ __forceinline__ void moba_unit(LAS unsigned char* lds, int b, int h, int n, const int* list, int cnt, const bf16_t* QM, const bf16_t* KMT, const bf16_t* VMT, bf16_t* PARTS, float* ML, const float* rel_bias) {
    int tid_ = threadIdx.x; asm volatile("" : "+v"(tid_));
    const int tid = tid_, lane = tid & 63, r = lane & 31, hh = lane >> 5; const int wid = __builtin_amdgcn_readfirstlane(tid >> 6);
    const size_t tok0 = (size_t)b * SEQ;
    const LAS float* btab = (const LAS float*)(lds + OFF_TAB);
    const float sc = 0.08838834764831845f * LOG2E;
    const bool own = (list == nullptr);
    const int li = 32 * wid + r;
    const bool lane_valid = li < cnt;
    int qpos, slot;
    if (own) { qpos = 256 * n + li; slot = 3; }
    else { const int e = list[lane_valid ? li : 0]; qpos = e >> 2; slot = e & 3; }
    const bool wave_active = (32 * wid < cnt);
    bf16x8 qf[1][8];
#pragma unroll
    for (int ks = 0; ks < 8; ++ks) qf[0][ks] = *(const bf16x8*)(QM + (tok0 + qpos) * 1024 + h * 128 + 16 * ks + 8 * hh);
    f32x16 O[1][4];
#pragma unroll
    for (int dt = 0; dt < 4; ++dt)
#pragma unroll
        for (int i = 0; i < 16; ++i) O[0][dt][i] = 0.f;
    float mrun[1] = {-INFINITY}, lrun[1] = {0.f};
    const bf16_t* kbase = KMT + ((size_t)h * 256 + b * 128 + 4 * n) * 8192;
    const bf16_t* vbase = VMT + ((size_t)h * 256 + b * 128 + 4 * n) * 8192;
    const int qw0 = 256 * n + 32 * wid;
    TileRegs R;
    __syncthreads();
    fill_bias_tab((LAS float*)(lds + OFF_TAB), rel_bias, 8 + h);
    tile_load(R, kbase, vbase, tid);
    tile_store(R, lds + OFF_K, lds + OFF_V, tid);
    __syncthreads();
#pragma unroll 1
    for (int t = 0; t < 4; ++t) {
        const int cur = t & 1;
        if (t + 1 < 4) tile_load(R, kbase + (size_t)(t + 1) * 8192, vbase + (size_t)(t + 1) * 8192, tid);
        if (wave_active) {
#pragma unroll 1
            for (int kh = 0; kh < 2; ++kh) {
                const int kp = 256 * n + 64 * t + 32 * kh;
                bool run = true, need_mask = false, need_bias;
                if (own) { run = (kp <= qw0 + 31); need_mask = (kp + 31 > qw0); need_bias = true; }
                else { need_bias = __any(qpos - (kp + 31) < 113); }
                if (run) attn_half<1, 8>(lds + OFF_K + cur * KBUF, lds + OFF_V + cur * VBUF, kh, qf, O, mrun, lrun, qpos, kp, need_mask, need_bias, btab, sc, r, hh, 0);
            }
        }
        if (t + 1 < 4) tile_store(R, lds + OFF_K + (cur ^ 1) * KBUF, lds + OFF_V + (cur ^ 1) * VBUF, tid);
        __syncthreads();
    }
    const float l = lrun[0] + __shfl_xor(lrun[0], 32);
    const float il = 1.0f / l;
    if (lane_valid) {
        const size_t pidx = ((tok0 + qpos) * 8 + h) * 4 + slot;
        bf16_t* orow = PARTS + pidx * 128;
#pragma unroll
        for (int dt = 0; dt < 4; ++dt)
#pragma unroll
            for (int g = 0; g < 4; ++g) { const int d = 32 * dt + 8 * g + 4 * hh;
                u32x2 w; w.x = cvtpk(O[0][dt][4 * g + 0] * il, O[0][dt][4 * g + 1] * il); w.y = cvtpk(O[0][dt][4 * g + 2] * il, O[0][dt][4 * g + 3] * il);
                *(u32x2*)(orow + d) = w; }
        if (hh == 0) *(f32x2*)(ML + pidx * 2) = (f32x2){mrun[0], l};
    }
}
constexpr int MB_K = 0, MB_V = 4 * KBUF, MB_INC = MB_V + 4 * VBUF, MB_TAB = MB_INC + 2048, MB_END = MB_TAB + 512;
static_assert(MB_END <= MISC_OFF, "MoBA block LDS");
__device__ __forceinline__ void moba_block(LAS unsigned char* lds, int b, int h, int n, const int* list, int cntl, int c0, int c1, const bf16_t* QM, const bf16_t* KMT, const bf16_t* VMT, bf16_t* PARTS, float* ML, const float* rel_bias) {
    int tid_ = threadIdx.x; asm volatile("" : "+v"(tid_));
    const int tid = tid_, lane = tid & 63, r = lane & 31, hh = lane >> 5; const int wid = __builtin_amdgcn_readfirstlane(tid >> 6);
    const size_t tok0 = (size_t)b * SEQ;
    const LAS float* btab = (const LAS float*)(lds + MB_TAB);
    const float sc = 0.08838834764831845f * LOG2E;
    const bf16_t* kbase = KMT + ((size_t)h * 256 + b * 128 + 4 * n) * 8192;
    const bf16_t* vbase = VMT + ((size_t)h * 256 + b * 128 + 4 * n) * 8192;
    __syncthreads();
    fill_bias_tab((LAS float*)(lds + MB_TAB), rel_bias, 8 + h);
    const int li = 32 * wid + r;
    const int cA = c0, cB = c0 + 1;
    const bool ownA = (cA == 0);
    const int cntA = ownA ? 256 : ((cntl - 256 * (cA - 1)) < 256 ? (cntl - 256 * (cA - 1)) : 256);
    const int cntB = (cB < c1) ? ((cntl - 256 * (cB - 1)) < 256 ? (cntl - 256 * (cB - 1)) : 256) : 0;
    const bool hasA = (32 * wid < cntA), hasB = (32 * wid < cntB);
    const bool lvA = li < cntA, lvB = li < cntB;
    int eA = 0, eB = 0;
    if (hasA && !ownA) eA = list[256 * (cA - 1) + (lvA ? li : 0)];
    if (hasB) eB = list[256 * (cB - 1) + (lvB ? li : 0)];
    TileRegs R, R2;
    tile_load(R, kbase, vbase, tid); tile_load(R2, kbase + 8192, vbase + 8192, tid);
    tile_store(R, lds + MB_K, lds + MB_V, tid); tile_load(R, kbase + 2 * 8192, vbase + 2 * 8192, tid);
    const int qposA = ownA ? 256 * n + li : (eA >> 2), slotA = ownA ? 3 : (eA & 3);
    const int qposB = eB >> 2, slotB = eB & 3;
    bf16x8 qfA[1][8], qfB[1][8];
    if (hasA) {
#pragma unroll
        for (int ks = 0; ks < 8; ++ks) qfA[0][ks] = *(const bf16x8*)(QM + (tok0 + qposA) * 1024 + h * 128 + 16 * ks + 8 * hh);
    }
    if (hasB) {
#pragma unroll
        for (int ks = 0; ks < 8; ++ks) qfB[0][ks] = *(const bf16x8*)(QM + (tok0 + qposB) * 1024 + h * 128 + 16 * ks + 8 * hh);
    }
    tile_store(R2, lds + MB_K + KBUF, lds + MB_V + VBUF, tid); tile_load(R2, kbase + 3 * 8192, vbase + 3 * 8192, tid);
    tile_store(R, lds + MB_K + 2 * KBUF, lds + MB_V + 2 * VBUF, tid);
    tile_store(R2, lds + MB_K + 3 * KBUF, lds + MB_V + 3 * VBUF, tid);
    __syncthreads();
#define MB_CHUNK(HAS, OWN, QF, QPOS, SLOT, LV) do { if (HAS) { \
        f32x16 O[1][4]; \
        _Pragma("unroll") for (int dt = 0; dt < 4; ++dt) _Pragma("unroll") for (int i = 0; i < 16; ++i) O[0][dt][i] = 0.f; \
        float mrun[1] = {-INFINITY}, lrun[1] = {0.f}; \
        const int qw0 = 256 * n + 32 * wid; \
        _Pragma("unroll 1") for (int t8 = 0; t8 < 8; ++t8) { \
            const int t = t8 >> 1, kh = t8 & 1; const int kp = 256 * n + 32 * t8; \
            bool run = true, need_mask = false, need_bias; \
            if (OWN) { run = (kp <= qw0 + 31); need_mask = (kp + 31 > qw0); need_bias = true; } \
            else { need_bias = __any((QPOS) - (kp + 31) < 113); } \
            if (run) attn_half<1, 8>(lds + MB_K + t * KBUF, lds + MB_V + t * VBUF, kh, QF, O, mrun, lrun, QPOS, kp, need_mask, need_bias, btab, sc, r, hh, 0); \
        } \
        const float l = lrun[0] + __shfl_xor(lrun[0], 32); const float il = 1.0f / l; \
        if (LV) { const size_t pidx = ((tok0 + (QPOS)) * 8 + h) * 4 + (SLOT); bf16_t* orow = PARTS + pidx * 128; \
            _Pragma("unroll") for (int dt = 0; dt < 4; ++dt) _Pragma("unroll") for (int g = 0; g < 4; ++g) { const int d = 32 * dt + 8 * g + 4 * hh; \
                u32x2 w; w.x = cvtpk(O[0][dt][4 * g + 0] * il, O[0][dt][4 * g + 1] * il); w.y = cvtpk(O[0][dt][4 * g + 2] * il, O[0][dt][4 * g + 3] * il); \
                *(u32x2*)(orow + d) = w; } \
            if (hh == 0) *(f32x2*)(ML + pidx * 2) = (f32x2){mrun[0], l}; } } } while (0)
    MB_CHUNK(hasA, ownA, qfA, qposA, slotA, lvA);
    MB_CHUNK(hasB, false, qfB, qposB, slotB, lvB);
#undef MB_CHUNK
}
constexpr int MB8_TAB = 4 * TBUF8;
static_assert(MB8_TAB + 512 <= MB_INC, "fp8 MoBA block LDS");
__device__ __forceinline__ void moba_block8(LAS unsigned char* lds, int b, int h, int n, const int* list, int cntl, int c0, int c1, const unsigned char* QM8, const unsigned char* KMT8, const unsigned char* VMT8, bf16_t* PARTS, float* ML, const float* rel_bias) {
    int tid_ = threadIdx.x; asm volatile("" : "+v"(tid_));
    const int tid = tid_, lane = tid & 63, r = lane & 31, hh = lane >> 5; const int wid = __builtin_amdgcn_readfirstlane(tid >> 6);
    const size_t tok0 = (size_t)b * SEQ;
    const LAS float* btab = (const LAS float*)(lds + MB8_TAB);
    const unsigned char* kbase = KMT8 + ((size_t)h * 256 + b * 128 + 4 * n) * 8192;
    const unsigned char* vbase = VMT8 + ((size_t)h * 256 + b * 128 + 4 * n) * 8192;
    __syncthreads();
    if (tid < 128) { const int q = tid; ((LAS float*)(lds + MB8_TAB))[q] = (rel_bias[t5_bucket(q) * 16 + 8 + h] - rel_bias[31 * 16 + 8 + h]) * (LOG2E * 64.0f); }
    const int li = 32 * wid + r;
    const int cA = c0, cB = c0 + 1;
    const bool ownA = (cA == 0);
    const int cntA = ownA ? 256 : ((cntl - 256 * (cA - 1)) < 256 ? (cntl - 256 * (cA - 1)) : 256);
    const int cntB = (cB < c1) ? ((cntl - 256 * (cB - 1)) < 256 ? (cntl - 256 * (cB - 1)) : 256) : 0;
    const bool hasA = (32 * wid < cntA), hasB = (32 * wid < cntB);
    const bool lvA = li < cntA, lvB = li < cntB;
    int eA = 0, eB = 0;
    if (hasA && !ownA) eA = list[256 * (cA - 1) + (lvA ? li : 0)];
    if (hasB) eB = list[256 * (cB - 1) + (lvB ? li : 0)];
    TileRegs8 R0, R1, R2, R3;
    tile_load8(R0, kbase, vbase, tid); tile_load8(R1, kbase + 8192, vbase + 8192, tid); tile_load8(R2, kbase + 2 * 8192, vbase + 2 * 8192, tid); tile_load8(R3, kbase + 3 * 8192, vbase + 3 * 8192, tid);
    SBAR();
    tile_store8(R0, lds, lds + KBUF8, tid);
    const int qposA = ownA ? 256 * n + li : (eA >> 2), slotA = ownA ? 3 : (eA & 3);
    const int qposB = eB >> 2, slotB = eB & 3;
    i32x8 qf[2];
    if (hasA) { const unsigned char* qp = QM8 + (tok0 + qposA) * 1024 + h * 128 + 32 * hh; qf[0] = cat8(*(const i32x4*)qp, *(const i32x4*)(qp + 16)); qf[1] = cat8(*(const i32x4*)(qp + 64), *(const i32x4*)(qp + 80)); }
    tile_store8(R1, lds + TBUF8, lds + TBUF8 + KBUF8, tid);
    tile_store8(R2, lds + 2 * TBUF8, lds + 2 * TBUF8 + KBUF8, tid);
    tile_store8(R3, lds + 3 * TBUF8, lds + 3 * TBUF8 + KBUF8, tid);
    __syncthreads();
#define MB8_LOADQB() do { if (hasB) { const unsigned char* qp = QM8 + (tok0 + qposB) * 1024 + h * 128 + 32 * hh; qf[0] = cat8(*(const i32x4*)qp, *(const i32x4*)(qp + 16)); qf[1] = cat8(*(const i32x4*)(qp + 64), *(const i32x4*)(qp + 80)); } } while (0)
#define MB8_CHUNK(HAS, OWN, QPOS, SLOT, LV, NEXTQ) do { if (HAS) { \
        f32x16 o[4]; \
        _Pragma("unroll") for (int dt = 0; dt < 4; ++dt) _Pragma("unroll") for (int i = 0; i < 16; ++i) o[dt][i] = 0.f; \
        float mref = -INFINITY, lrun = 0.f; \
        const int qw0 = 256 * n + 32 * wid; \
        _Pragma("unroll 1") for (int t = 0; t < 4; ++t) { \
            const int kp = 256 * n + 64 * t; const LAS unsigned char* tb = lds + t * TBUF8; \
            bool run = true, need_mask = false, need_bias; \
            if (OWN) { run = (kp <= qw0 + 31); need_mask = (kp + 63 > qw0); need_bias = (qw0 - (kp + 63) < 113); } \
            else { need_bias = __any((QPOS) - (kp + 63) < 113); } \
            if (run) { \
                i32x8 ka[2], kc[2], vf[2]; \
                d8_load_kf(ka, tb, r, hh, 0); d8_load_kf(kc, tb, r, hh, 64); \
                f32x16 s0, s1; d8_scores(s0, s1, ka, qf[0]); \
                __builtin_amdgcn_s_setprio(1); \
                s0 = __builtin_amdgcn_mfma_scale_f32_32x32x64_f8f6f4(kc[0], qf[1], s0, 0, 0, 0, 0x7F7F7F7F, 0, 0x7F7F7F7F); \
                s1 = __builtin_amdgcn_mfma_scale_f32_32x32x64_f8f6f4(kc[1], qf[1], s1, 0, 0, 0, 0x7F7F7F7F, 0, 0x7F7F7F7F); \
                __builtin_amdgcn_s_setprio(0); \
                d8_load_vf2<0>(vf, tb + KBUF8, r, hh); SBAR(); \
                const i32x8 P = d8_softmax<true>(s0, s1, o, mref, lrun, QPOS, kp, need_mask, need_bias, false, btab, hh); \
                d8_pv(o, vf, P, tb + KBUF8, r, hh); \
            } \
        } \
        NEXTQ; \
        asm volatile("s_nop 15\n\ts_nop 15\n\ts_nop 15\n\ts_nop 15" ::: "memory");        \
        const float l = lrun + __shfl_xor(lrun, 32); const float il = 1.0f / (l * D8_VS); \
        { const float il8 = il * F8_SPART; const size_t pidx = ((tok0 + (QPOS)) * 8 + h) * 4 + (SLOT); unsigned char* orow = (unsigned char*)PARTS + pidx * 128; \
              \
            _Pragma("unroll") for (int dt = 0; dt < 4; ++dt) _Pragma("unroll") for (int g = 0; g < 4; g += 2) { \
                unsigned a_ = epi::pack4_f8(o[dt][4 * g + 0] * il8, o[dt][4 * g + 1] * il8, o[dt][4 * g + 2] * il8, o[dt][4 * g + 3] * il8); \
                unsigned b_ = epi::pack4_f8(o[dt][4 * g + 4] * il8, o[dt][4 * g + 5] * il8, o[dt][4 * g + 6] * il8, o[dt][4 * g + 7] * il8); \
                auto rr = __builtin_amdgcn_permlane32_swap(a_, b_, false, false); a_ = rr[0]; b_ = rr[1]; \
                if (LV) *(u32x2*)(orow + 32 * dt + 8 * g + 8 * hh) = (u32x2){a_, b_}; } } \
        if (LV) { const size_t pidx = ((tok0 + (QPOS)) * 8 + h) * 4 + (SLOT); \
            if (hh == 0) *(f32x2*)(ML + pidx * 2) = (f32x2){mref * D8_C - D8_SH, l}; } } else { NEXTQ; } } while (0)
    MB8_CHUNK(hasA, ownA, qposA, slotA, lvA, MB8_LOADQB());
    MB8_CHUNK(hasB, false, qposB, slotB, lvB, (void)0);
#undef MB8_CHUNK
#undef MB8_LOADQB
}
}

struct Ctx {
    LAS unsigned char* lds;
    unsigned char* ws; unsigned* ctl;
    const float* const* in; float* out;
    int tid, lane, wave, G, blk;
};
enum { I_X = 0, I_C, I_WADA, I_BADA, I_GMIX, I_GFFN, I_WIN, I_LAMBDA, I_SUBLN, I_RELB, I_WOD, I_WOM, I_WOUT, I_WROUTER, I_RBIAS, I_WEG, I_WEU, I_WED, I_WSG, I_WSU, I_WSD, I_GFINAL };

constexpr int TR_SCR = 64 * 65 * 4 + 128;
static_assert(8 * TR_SCR <= RING_BYTES + 16384, "transpose scratch");
template <bool NT>
__device__ __forceinline__ void transpose_item(const float* __restrict__ W, int K, int N, bf16_t* __restrict__ WT, int drow0, int k0, int n0, LAS float* scr, int lane) {
    const int nq = lane & 15, kr = lane >> 4;
    f32x4 v[16];
#pragma unroll
    for (int i = 0; i < 16; ++i) { const f32x4* p = (const f32x4*)(W + (size_t)(k0 + 4 * i + kr) * N + n0 + 4 * nq); v[i] = NT ? __builtin_nontemporal_load(p) : *p; }
#pragma unroll
    for (int i = 0; i < 16; ++i) { LAS float* d = scr + (4 * i + kr) * 65 + 4 * nq; d[0] = v[i][0]; d[1] = v[i][1]; d[2] = v[i][2]; d[3] = v[i][3]; }
    LDS_WAIT(); asm volatile("" ::: "memory");
    const int c = lane & 7;
#pragma unroll
    for (int j = 0; j < 8; ++j) { const int n = (lane >> 3) + 8 * j; const LAS float* s = scr + (8 * c) * 65 + n;
        u32x4 o; o.x = cvtpk(s[0 * 65], s[1 * 65]); o.y = cvtpk(s[2 * 65], s[3 * 65]); o.z = cvtpk(s[4 * 65], s[5 * 65]); o.w = cvtpk(s[6 * 65], s[7 * 65]);
        u32x4* q = (u32x4*)(WT + (size_t)(drow0 + n) * K + k0 + 8 * c); if (NT) __builtin_nontemporal_store(o, q); else *q = o; }
    LDS_WAIT(); asm volatile("" ::: "memory");
}
template <bool NT>
__device__ __forceinline__ void transpose_item_f8(const float* __restrict__ W, int K, int N, unsigned char* __restrict__ WT, int drow0, int k0, int n0, LAS float* scr, int lane, float scale) {
    const int nq = lane & 15, kr = lane >> 4;
    f32x4 v[16];
#pragma unroll
    for (int i = 0; i < 16; ++i) { const f32x4* p = (const f32x4*)(W + (size_t)(k0 + 4 * i + kr) * N + n0 + 4 * nq); v[i] = NT ? __builtin_nontemporal_load(p) : *p; }
#pragma unroll
    for (int i = 0; i < 16; ++i) { LAS float* d = scr + (4 * i + kr) * 65 + 4 * nq; d[0] = v[i][0] * scale; d[1] = v[i][1] * scale; d[2] = v[i][2] * scale; d[3] = v[i][3] * scale; }
    LDS_WAIT(); asm volatile("" ::: "memory");
    const int c = lane & 7;
#pragma unroll
    for (int j = 0; j < 8; ++j) { const int n = (lane >> 3) + 8 * j; const LAS float* s = scr + (8 * c) * 65 + n;
        const u32x2 o = {epi::pack4_f8(s[0 * 65], s[1 * 65], s[2 * 65], s[3 * 65]), epi::pack4_f8(s[4 * 65], s[5 * 65], s[6 * 65], s[7 * 65])};
        u32x2* q = (u32x2*)(WT + (size_t)(drow0 + n) * K + k0 + 8 * c); if (NT) __builtin_nontemporal_store(o, q); else *q = o; }
    LDS_WAIT(); asm volatile("" ::: "memory");
}
struct CvItemF8 { const float* W; unsigned char* WT; int K, N, drow0, k0, n0; float scale; };
__device__ __forceinline__ void transpose_pair_f8(const CvItemF8& A, const CvItemF8& B, LAS float* scr, int lane) {
    const int nq = lane & 15, kr = lane >> 4, c = lane & 7;
    f32x4 va[16], vb[16];
#pragma unroll
    for (int i = 0; i < 16; ++i) va[i] = __builtin_nontemporal_load((const f32x4*)(A.W + (size_t)(A.k0 + 4 * i + kr) * A.N + A.n0 + 4 * nq));
#pragma unroll
    for (int i = 0; i < 16; ++i) vb[i] = __builtin_nontemporal_load((const f32x4*)(B.W + (size_t)(B.k0 + 4 * i + kr) * B.N + B.n0 + 4 * nq));
    __builtin_amdgcn_sched_barrier(0);
#pragma unroll
    for (int i = 0; i < 16; ++i) { LAS float* d = scr + (4 * i + kr) * 65 + 4 * nq; d[0] = va[i][0] * A.scale; d[1] = va[i][1] * A.scale; d[2] = va[i][2] * A.scale; d[3] = va[i][3] * A.scale; }
    LDS_WAIT(); asm volatile("" ::: "memory");
#pragma unroll
    for (int j = 0; j < 8; ++j) { const int n = (lane >> 3) + 8 * j; const LAS float* s = scr + (8 * c) * 65 + n;
        const u32x2 o = {epi::pack4_f8(s[0 * 65], s[1 * 65], s[2 * 65], s[3 * 65]), epi::pack4_f8(s[4 * 65], s[5 * 65], s[6 * 65], s[7 * 65])};
        __builtin_nontemporal_store(o, (u32x2*)(A.WT + (size_t)(A.drow0 + n) * A.K + A.k0 + 8 * c)); }
    LDS_WAIT(); asm volatile("" ::: "memory");
#pragma unroll
    for (int i = 0; i < 16; ++i) { LAS float* d = scr + (4 * i + kr) * 65 + 4 * nq; d[0] = vb[i][0] * B.scale; d[1] = vb[i][1] * B.scale; d[2] = vb[i][2] * B.scale; d[3] = vb[i][3] * B.scale; }
    LDS_WAIT(); asm volatile("" ::: "memory");
#pragma unroll
    for (int j = 0; j < 8; ++j) { const int n = (lane >> 3) + 8 * j; const LAS float* s = scr + (8 * c) * 65 + n;
        const u32x2 o = {epi::pack4_f8(s[0 * 65], s[1 * 65], s[2 * 65], s[3 * 65]), epi::pack4_f8(s[4 * 65], s[5 * 65], s[6 * 65], s[7 * 65])};
        __builtin_nontemporal_store(o, (u32x2*)(B.WT + (size_t)(B.drow0 + n) * B.K + B.k0 + 8 * c)); }
    LDS_WAIT(); asm volatile("" ::: "memory");
}
__device__ __forceinline__ int gu_row(int n0, int up) { return 256 * (n0 >> 7) + 128 * up + (n0 & 127); }

__device__ __forceinline__ int win_row(int n) { return n < 2048 ? n : (n < 3072 ? 8192 + (n - 2048) : (n < 5120 ? 2048 + (n - 3072) : (n < 6144 ? 9216 + (n - 5120) : 4096 + (n - 6144)))); }
__device__ __forceinline__ void p0_prologue(Ctx& F) {
    const int gw = F.blk * 8 + F.wave, NGW = F.G * 8;
    unsigned char* ws = F.ws;
    {
        const float* wada = F.in[I_WADA]; const float* c = F.in[I_C]; float* modp = (float*)(ws + WS_MODP);
        for (int it = gw; it < 48 * 32; it += NGW) {
            const int cc = it % 48, ks = it / 48, col = 256 * cc + 4 * F.lane;
            f32x4 a0 = {0.f, 0.f, 0.f, 0.f}, a1 = {0.f, 0.f, 0.f, 0.f};
#pragma unroll 8
            for (int k = 64 * ks; k < 64 * ks + 64; ++k) {
                const f32x4 w = *(const f32x4*)(wada + (size_t)k * 12288 + col);
                const float c0 = c[k], c1 = c[2048 + k];
                a0 += w * siluf_(c0); a1 += w * siluf_(c1);
            }
            *(f32x4*)(modp + ((size_t)ks * 2 + 0) * 12288 + col) = a0;
            *(f32x4*)(modp + ((size_t)ks * 2 + 1) * 12288 + col) = a1;
        }
    }
    {
        LAS float* scr = (LAS float*)(F.lds + F.wave * TR_SCR);
        constexpr int I0 = 5120, I1 = I0 + 512, I2 = I1 + 512, I3 = I2 + 1024, I4 = I3 + 256, I5 = I4 + 256, I6 = I5 + 256;
        for (int it = gw; it < I6; it += NGW) {
            if (it < I0) { const int r = it, kb = r / 160, nb = r % 160; if constexpr (P2F8) transpose_item_f8<false>(F.in[I_WIN], 2048, 10240, ws + WS_W_IN_T, win_row(64 * nb), 64 * kb, 64 * nb, scr, F.lane, F8_SW); else transpose_item<false>(F.in[I_WIN], 2048, 10240, (bf16_t*)(ws + WS_W_IN_T), win_row(64 * nb), 64 * kb, 64 * nb, scr, F.lane); }
            else if (it < I1) { const int r = it - I0, kb = r / 32, nb = r % 32; if constexpr (O78F8) transpose_item_f8<false>(F.in[I_WOD], 1024, 2048, ws + WS_W_OD_T, 64 * nb, 64 * kb, 64 * nb, scr, F.lane, F8_SWO); else transpose_item<false>(F.in[I_WOD], 1024, 2048, (bf16_t*)(ws + WS_W_OD_T), 64 * nb, 64 * kb, 64 * nb, scr, F.lane); }
            else if (it < I2) { const int r = it - I1, kb = r / 32, nb = r % 32; if constexpr (O78F8) transpose_item_f8<false>(F.in[I_WOM], 1024, 2048, ws + WS_W_OM_T, 64 * nb, 64 * kb, 64 * nb, scr, F.lane, F8_SWO); else transpose_item<false>(F.in[I_WOM], 1024, 2048, (bf16_t*)(ws + WS_W_OM_T), 64 * nb, 64 * kb, 64 * nb, scr, F.lane); }
            else if (it < I3) { const int r = it - I2, kb = r / 32, nb = r % 32; if constexpr (O78F8) transpose_item_f8<false>(F.in[I_WOUT], 2048, 2048, ws + WS_W_OUT_T, 64 * nb, 64 * kb, 64 * nb, scr, F.lane, F8_SWOUT); else transpose_item<false>(F.in[I_WOUT], 2048, 2048, (bf16_t*)(ws + WS_W_OUT_T), 64 * nb, 64 * kb, 64 * nb, scr, F.lane); }
            else if (it < I4) { const int r = it - I3, kb = r / 8, nb = r % 8; transpose_item_f8<false>(F.in[I_WSG], 2048, 512, ws + WS_W_SHGU_T, gu_row(64 * nb, 0), 64 * kb, 64 * nb, scr, F.lane, F8_SW); }
            else if (it < I5) { const int r = it - I4, kb = r / 8, nb = r % 8; transpose_item_f8<false>(F.in[I_WSU], 2048, 512, ws + WS_W_SHGU_T, gu_row(64 * nb, 1), 64 * kb, 64 * nb, scr, F.lane, F8_SW); }
            else { const int r = it - I5, kb = r / 32, nb = r % 32; transpose_item_f8<false>(F.in[I_WSD], 512, 2048, ws + WS_W_SHD_T, 64 * nb, 64 * kb, 64 * nb, scr, F.lane, F8_SD); }
        }
    }
    {
        const float* wr = F.in[I_WROUTER]; bf16_t* hi = (bf16_t*)(ws + WS_WR); bf16_t* lo = hi + 64 * 2048;
        for (int idx = F.blk * 512 + F.tid; idx < 2048 * 64; idx += F.G * 512) {
            const int k = idx >> 6, e = idx & 63; const float w = wr[idx];
            const unsigned h16 = cvtpk(w, 0.f) & 0xffffu; const float res = w - __uint_as_float(h16 << 16);
            hi[e * 2048 + k] = (bf16_t)h16; lo[e * 2048 + k] = (bf16_t)(cvtpk(res, 0.f) & 0xffffu);
        }
    }
}

constexpr int CV_NCHUNK = 1536;
struct CvItem { const float* W; unsigned char* WT; int K, N, drow0, k0, n0; float scale; };
__device__ __forceinline__ CvItem cv_decode(Ctx& F, int it) {
    unsigned char* ws = F.ws; CvItem c;
    if (it < 16384) { const int r = it, e = r >> 8, r2 = r & 255, kb = r2 / 8, nb = r2 % 8;
        c.W = F.in[I_WEG] + (size_t)e * 2048 * 512; c.WT = ws + WS_W_EGU_T + (size_t)e * 1024 * 2048; c.scale = F8_SW; c.K = 2048; c.N = 512; c.drow0 = gu_row(64 * nb, 0); c.k0 = 64 * kb; c.n0 = 64 * nb; }
    else if (it < 32768) { const int r = it - 16384, e = r >> 8, r2 = r & 255, kb = r2 / 8, nb = r2 % 8;
        c.W = F.in[I_WEU] + (size_t)e * 2048 * 512; c.WT = ws + WS_W_EGU_T + (size_t)e * 1024 * 2048; c.scale = F8_SW; c.K = 2048; c.N = 512; c.drow0 = gu_row(64 * nb, 1); c.k0 = 64 * kb; c.n0 = 64 * nb; }
    else { const int r = it - 32768, e = r >> 8, r2 = r & 255, kb = r2 / 32, nb = r2 % 32;
        c.W = F.in[I_WED] + (size_t)e * 512 * 2048; c.WT = ws + WS_W_ED_T + (size_t)e * 2048 * 512; c.scale = F8_SD; c.K = 512; c.N = 2048; c.drow0 = 64 * nb; c.k0 = 64 * kb; c.n0 = 64 * nb; }
    return c;
}
__device__ __forceinline__ void convert_chunk(Ctx& F, int chunk) {
    LAS float* scr = (LAS float*)(F.lds + F.wave * TR_SCR);
    int lane = F.lane; asm volatile("" : "+v"(lane));
    const int it0 = chunk * 32 + F.wave * 4;
#pragma unroll 1
    for (int i = 0; i < 4; i += 2) { const CvItem a = cv_decode(F, it0 + i), b = cv_decode(F, it0 + i + 1);
        transpose_pair_f8(CvItemF8{a.W, a.WT, a.K, a.N, a.drow0, a.k0, a.n0, a.scale}, CvItemF8{b.W, b.WT, b.K, b.N, b.drow0, b.k0, b.n0, b.scale}, scr, lane); }
}
__device__ __forceinline__ int queue_take(Ctx& F, unsigned* head) {
    volatile LAS int* slot = (volatile LAS int*)(F.lds + MISC_OFF + 64);
    __syncthreads();
    if (F.tid == 0) *slot = (int)__hip_atomic_fetch_add(head, 1u, RLX_AGENT);
    __syncthreads();
    return *slot;
}

__device__ __forceinline__ void fill_mod_tables(Ctx& F, const float* gain, int shift_off, int scale_off, bool from_partials, int bsel = -1) {
    LAS float* A = (LAS float*)F.lds; LAS float* Bt = (LAS float*)(F.lds + 16384);
    const float* modp = (const float*)(F.ws + WS_MODP); const float* modf = (const float*)(F.ws + WS_MOD); const float* bada = F.in[I_BADA];
    const int lo = bsel < 0 ? 0 : bsel * 2048, hi = bsel < 0 ? 4096 : lo + 2048;
    for (int idx = lo + F.tid; idx < hi; idx += 512) {
        const int b = idx >> 11, c = idx & 2047;
        float sh, scl;
        if (from_partials) {
            sh = bada[shift_off + c]; scl = bada[scale_off + c];
#pragma unroll 16
            for (int ks = 0; ks < 32; ++ks) { sh += modp[((size_t)ks * 2 + b) * 12288 + shift_off + c]; scl += modp[((size_t)ks * 2 + b) * 12288 + scale_off + c]; }
        } else { sh = modf[b * 12288 + shift_off + c]; scl = modf[b * 12288 + scale_off + c]; }
        A[idx] = gain[c] * (1.0f + scl); Bt[idx] = sh;
    }
    __syncthreads();
}

__device__ __forceinline__ void p1_norm(Ctx& F) {
    { const float* modp = (const float*)(F.ws + WS_MODP); float* modf = (float*)(F.ws + WS_MOD); const float* bada = F.in[I_BADA];
      for (int idx = F.blk * 512 + F.tid; idx < 2 * 12288; idx += F.G * 512) { const int b = idx / 12288, j = idx % 12288; float s = bada[j];
#pragma unroll 8
          for (int ks = 0; ks < 32; ++ks) s += modp[((size_t)ks * 2 + b) * 12288 + j];
          modf[idx] = s; } }
    const int rpb = T / F.G;
    const bool one_batch = (F.G * rpb == T) && (SEQ % rpb == 0);
    const int row_lo = one_batch ? F.blk * rpb : 0, row_hi = one_batch ? row_lo + rpb : T, rstep = one_batch ? 8 : F.G * 8, r0 = one_batch ? row_lo + F.wave : F.blk * 8 + F.wave;
    fill_mod_tables(F, F.in[I_GMIX], 0, 2048, true, one_batch ? row_lo / SEQ : -1);
    const LAS float* A = (const LAS float*)F.lds; const LAS float* Bt = (const LAS float*)(F.lds + 16384);
    const float* x = F.in[I_X]; bf16_t* H = (bf16_t*)(F.ws + WS_H);
    for (int row = r0; row < row_hi; row += 2 * rstep) {
        const int row2 = row + rstep; const bool has2 = row2 < row_hi;
        const int b = row / SEQ, b2 = has2 ? row2 / SEQ : b;
        const f32x4* xr = (const f32x4*)(x + (size_t)row * 2048) + F.lane;
        const f32x4* xr2 = (const f32x4*)(x + (size_t)(has2 ? row2 : row) * 2048) + F.lane;
        f32x4 v[8], v2[8]; float ss = 0.f, ss2 = 0.f;
#pragma unroll
        for (int j = 0; j < 8; ++j) { v[j] = __builtin_nontemporal_load(xr + 64 * j); v2[j] = __builtin_nontemporal_load(xr2 + 64 * j); }
#pragma unroll
        for (int j = 0; j < 8; ++j) { ss += (v[j].x * v[j].x + v[j].y * v[j].y) + (v[j].z * v[j].z + v[j].w * v[j].w); ss2 += (v2[j].x * v2[j].x + v2[j].y * v2[j].y) + (v2[j].z * v2[j].z + v2[j].w * v2[j].w); }
        const float rstd = 1.0f / sqrtf(wave_sum(ss) * (1.0f / 2048.0f) + RMS_EPS), rstd2 = 1.0f / sqrtf(wave_sum(ss2) * (1.0f / 2048.0f) + RMS_EPS);
        unsigned long long* o8 = (unsigned long long*)(H + (size_t)row * 2048) + F.lane;
        unsigned long long* o82 = (unsigned long long*)(H + (size_t)row2 * 2048) + F.lane;
#pragma unroll
        for (int j = 0; j < 8; ++j) { const int c = 4 * F.lane + 256 * j;
            const f32x4 a = *(const LAS f32x4*)(A + b * 2048 + c), sft = *(const LAS f32x4*)(Bt + b * 2048 + c);
            const f32x4 y = v[j] * rstd * a + sft;
            if constexpr (P2F8) ((unsigned*)((unsigned char*)H + (size_t)row * 2048))[F.lane + 64 * j] = epi::pack4_f8(y.x * F8_SH, y.y * F8_SH, y.z * F8_SH, y.w * F8_SH);
            else o8[64 * j] = (unsigned long long)cvtpk(y.x, y.y) | ((unsigned long long)cvtpk(y.z, y.w) << 32);
            if (has2) { const f32x4 a2 = *(const LAS f32x4*)(A + b2 * 2048 + c), sft2 = *(const LAS f32x4*)(Bt + b2 * 2048 + c);
                const f32x4 y2 = v2[j] * rstd2 * a2 + sft2;
                if constexpr (P2F8) ((unsigned*)((unsigned char*)H + (size_t)row2 * 2048))[F.lane + 64 * j] = epi::pack4_f8(y2.x * F8_SH, y2.y * F8_SH, y2.z * F8_SH, y2.w * F8_SH);
                else o82[64 * j] = (unsigned long long)cvtpk(y2.x, y2.y) | ((unsigned long long)cvtpk(y2.z, y2.w) << 32); } }
    }
}

__device__ __forceinline__ void p3_kmean(Ctx& F) {
    const bf16_t* KMT = (const bf16_t*)(F.ws + WS_KMT); float* KM = (float*)(F.ws + WS_KMEAN);
    LAS float* red = (LAS float*)F.lds;
    for (int item = F.blk; item < 512; item += F.G) {
        const int b = item >> 8, h = (item >> 5) & 7, n = item & 31;
        const int cp = F.tid & 63, rg = F.tid >> 6;
        const bf16_t* base = KMT + (((size_t)h * 256 + b * 128 + 4 * n) * 64 + 32 * rg) * 128 + 2 * cp;
        float s0 = 0.f, s1 = 0.f;
#pragma unroll 8
        for (int rr = 0; rr < 32; ++rr) { const unsigned u = *(const unsigned*)(base + (size_t)rr * 128); s0 += bf_lo(u); s1 += bf_hi(u); }
        __syncthreads();
        red[rg * 128 + 2 * cp] = s0; red[rg * 128 + 2 * cp + 1] = s1;
        __syncthreads();
        if (F.tid < 128) { float s = 0.f;
#pragma unroll
            for (int g = 0; g < 8; ++g) s += red[g * 128 + F.tid];
            KM[(size_t)item * 128 + F.tid] = s * (1.0f / 256.0f); }
    }
    __syncthreads();
}

__device__ __forceinline__ void p4_gating(Ctx& F) {
    const bf16_t* QM = (const bf16_t*)(F.ws + WS_QM); const float* KM = (const float*)(F.ws + WS_KMEAN);
    float* ML = (float*)(F.ws + WS_ML); int* MLIST = (int*)(F.ws + WS_MLIST); unsigned* mcnt = F.ctl + CW_MCNT;
    for (int grp = F.blk; grp < T / 64; grp += F.G) {
        const int h = F.wave, tok = grp * 64 + F.lane, b = tok / SEQ, qs = tok % SEQ, cur = qs >> 8;
        const int curu = __builtin_amdgcn_readfirstlane(cur), bu = __builtin_amdgcn_readfirstlane(b);
        float q[128];
        const u32x4* qp = (const u32x4*)(QM + (size_t)tok * 1024 + h * 128);
#pragma unroll
        for (int i = 0; i < 16; ++i) { const u32x4 u = qp[i]; q[8 * i + 0] = bf_lo(u.x); q[8 * i + 1] = bf_hi(u.x); q[8 * i + 2] = bf_lo(u.y); q[8 * i + 3] = bf_hi(u.y);
            q[8 * i + 4] = bf_lo(u.z); q[8 * i + 5] = bf_hi(u.z); q[8 * i + 6] = bf_lo(u.w); q[8 * i + 7] = bf_hi(u.w); }
        float v0 = -INFINITY, v1 = -INFINITY, v2 = -INFINITY; int i0 = -1, i1 = -1, i2 = -1;
        const float* kmb = KM + (size_t)((bu * 8 + h) * 32) * 128;
        for (int n = 0; n < curu; ++n) {
            const float* km = kmb + n * 128;
            float a0 = 0.f, a1 = 0.f, a2 = 0.f, a3 = 0.f;
#pragma unroll
            for (int d = 0; d < 128; d += 4) { a0 += q[d] * km[d]; a1 += q[d + 1] * km[d + 1]; a2 += q[d + 2] * km[d + 2]; a3 += q[d + 3] * km[d + 3]; }
            const float s = (a0 + a1) + (a2 + a3);
            if (s > v0) { v2 = v1; i2 = i1; v1 = v0; i1 = i0; v0 = s; i0 = n; }
            else if (s > v1) { v2 = v1; i2 = i1; v1 = s; i1 = n; }
            else if (s > v2) { v2 = s; i2 = n; }
        }
        float* ml = ML + ((size_t)tok * 8 + h) * 8;
        if (i0 < 0) *(f32x2*)(ml + 0) = (f32x2){-INFINITY, 0.f};
        if (i1 < 0) *(f32x2*)(ml + 2) = (f32x2){-INFINITY, 0.f};
        if (i2 < 0) *(f32x2*)(ml + 4) = (f32x2){-INFINITY, 0.f};
        for (int n = 0; n < curu; ++n) {
            const bool hit = (i0 == n) || (i1 == n) || (i2 == n);
            const unsigned long long mask = __ballot(hit);
            if (mask) {
                const int cntw = __popcll(mask);
                unsigned base = 0;
                if (F.lane == 0) base = __hip_atomic_fetch_add(mcnt + ((bu * 8 + h) * 32 + n), (unsigned)cntw, RLX_AGENT);
                base = __builtin_amdgcn_readfirstlane(base);
                if (hit) { const int pos = base + __popcll(mask & ((1ull << F.lane) - 1ull)); const int slot = (i0 == n) ? 0 : ((i1 == n) ? 1 : 2);
                    MLIST[(size_t)((bu * 8 + h) * 32 + n) * 8192 + pos] = (qs << 2) | slot; }
            }
        }
    }
}

__device__ __forceinline__ void p6_merge(Ctx& F) {
    const bf16_t* PARTS = (const bf16_t*)(F.ws + WS_PARTS); const float* ML = (const float*)(F.ws + WS_ML); bf16_t* AM = (bf16_t*)(F.ws + WS_AM);
    const int gw = F.blk * 8 + F.wave, NGW = F.G * 8;
    for (int tok = gw; tok < T; tok += NGW) {
        f32x4 ml01[2], ml23[2]; u32x2 pu[2][4];
#pragma unroll
        for (int i = 0; i < 2; ++i) {
            const int item = F.lane + 64 * i, h = item >> 4, ch = item & 15;
            const float* ml = ML + ((size_t)tok * 8 + h) * 8;
            ml01[i] = *(const f32x4*)ml; ml23[i] = *(const f32x4*)(ml + 4);
            const unsigned char* pb = (const unsigned char*)PARTS + (((size_t)tok * 8 + h) * 4) * 128 + ch * 8;
#pragma unroll
            for (int s4 = 0; s4 < 4; ++s4) pu[i][s4] = __builtin_nontemporal_load((const u32x2*)(pb + s4 * 128));
        }
#pragma unroll
        for (int i = 0; i < 2; ++i) {
            const int item = F.lane + 64 * i, h = item >> 4, ch = item & 15;
            const float m0 = ml01[i][0], l0 = ml01[i][1], m1 = ml01[i][2], l1 = ml01[i][3], m2 = ml23[i][0], l2 = ml23[i][1], m3 = ml23[i][2], l3 = ml23[i][3];
            const float M = fmaxf(fmaxf(m0, m1), fmaxf(m2, m3));
            const float w0 = l0 * fast_exp2(m0 - M), w1 = l1 * fast_exp2(m1 - M), w2 = l2 * fast_exp2(m2 - M), w3 = l3 * fast_exp2(m3 - M);
            const float inv = 1.0f / (w0 + w1 + w2 + w3);
            float acc[8];
#pragma unroll
            for (int j = 0; j < 8; ++j) acc[j] = 0.f;
            const float ws4[4] = {w0, w1, w2, w3};
#pragma unroll
            for (int s4 = 0; s4 < 4; ++s4) {
                const float w = ws4[s4]; u32x2 u = pu[i][s4];
                if (!(w > 0.f)) u = (u32x2){0u, 0u};
                { const f32x2 a = __builtin_amdgcn_cvt_pk_f32_fp8((int)u.x, false), b = __builtin_amdgcn_cvt_pk_f32_fp8((int)u.x, true), c = __builtin_amdgcn_cvt_pk_f32_fp8((int)u.y, false), d = __builtin_amdgcn_cvt_pk_f32_fp8((int)u.y, true);
                  acc[0] += w * a[0]; acc[1] += w * a[1]; acc[2] += w * b[0]; acc[3] += w * b[1]; acc[4] += w * c[0]; acc[5] += w * c[1]; acc[6] += w * d[0]; acc[7] += w * d[1]; }
            }
            if constexpr (O78F8) { const float i8 = inv * (F8_SAM / F8_SPART);
                *(u32x2*)((unsigned char*)AM + (size_t)tok * 1024 + h * 128 + ch * 8) = (u32x2){epi::pack4_f8(acc[0] * i8, acc[1] * i8, acc[2] * i8, acc[3] * i8), epi::pack4_f8(acc[4] * i8, acc[5] * i8, acc[6] * i8, acc[7] * i8)}; }
            else { u32x4 o; o.x = cvtpk(acc[0] * inv, acc[1] * inv); o.y = cvtpk(acc[2] * inv, acc[3] * inv); o.z = cvtpk(acc[4] * inv, acc[5] * inv); o.w = cvtpk(acc[6] * inv, acc[7] * inv);
            *(u32x4*)(AM + (size_t)tok * 1024 + h * 128 + ch * 8) = o; }
        }
    }
}
constexpr int P9_RSTD = 32768, P9_LG = 33792, P9_LGROW = 68, P9_LCNT = P9_LG + 2 * 64 * P9_LGROW * 4, P9_LBASE = P9_LCNT + 256, P9_END = P9_LBASE + 256;
static_assert(P9_END <= RING_BYTES, "P9 LDS");
__device__ __forceinline__ void p9_route(Ctx& F) {
    fill_mod_tables(F, F.in[I_GFFN], 6144, 8192, false);
    const LAS float* A2 = (const LAS float*)F.lds; const LAS float* B2 = (const LAS float*)(F.lds + 16384);
    LAS float* rstd_l = (LAS float*)(F.lds + P9_RSTD); LAS float* LG = (LAS float*)(F.lds + P9_LG);
    LAS int* lcnt = (LAS int*)(F.lds + P9_LCNT); LAS int* lbase = (LAS int*)(F.lds + P9_LBASE);
    const bf16_t* x1 = (const bf16_t*)(F.ws + WS_X1); bf16_t* H2 = (bf16_t*)(F.ws + WS_H2); unsigned char* H2F8 = F.ws + WS_H2F8;
    const bf16_t* WRH = (const bf16_t*)(F.ws + WS_WR); const bf16_t* WRL = WRH + 64 * 2048;
    const float* rbias = F.in[I_RBIAS];
    int* ELIST = (int*)(F.ws + WS_ELIST); int* TOKE = (int*)(F.ws + WS_TOKE); float* TOKW = (float*)(F.ws + WS_TOKW);
    unsigned* ecnt = F.ctl + CW_ECNT;
    for (int grp = F.blk; grp < T / 64; grp += F.G) {
        const int tokb = grp * 64, b = tokb / SEQ;
        if (F.tid < 64) lcnt[F.tid] = 0;
        for (int i = 0; i < 8; i += 4) {
            const int tl = F.wave * 8 + i;
            u32x4 va[4][4];
#pragma unroll
            for (int q = 0; q < 4; ++q) { const u32x4* xr = (const u32x4*)(x1 + (size_t)(tokb + tl + q) * 2048) + F.lane;
#pragma unroll
                for (int j = 0; j < 4; ++j) va[q][j] = xr[64 * j]; }
#pragma unroll
            for (int q = 0; q < 4; ++q) { float ss = 0.f;
#pragma unroll
                for (int j = 0; j < 4; ++j) { const u32x4 u = va[q][j];
                    const float a0 = bf_lo(u.x), a1 = bf_hi(u.x), a2 = bf_lo(u.y), a3 = bf_hi(u.y), a4 = bf_lo(u.z), a5 = bf_hi(u.z), a6 = bf_lo(u.w), a7 = bf_hi(u.w);
                    ss += ((a0 * a0 + a1 * a1) + (a2 * a2 + a3 * a3)) + ((a4 * a4 + a5 * a5) + (a6 * a6 + a7 * a7)); }
                ss = wave_sum(ss);
                if (F.lane == 0) rstd_l[tl + q] = 1.0f / sqrtf(ss * (1.0f / 2048.0f) + RMS_EPS); }
        }
        __syncthreads();
        {
            const int tg = F.wave & 3, kh = F.wave >> 2, tc = F.lane & 15, kg = F.lane >> 4;
            const int tl = 16 * tg + tc; const float rs = rstd_l[tl];
            const bf16_t* xrow = x1 + (size_t)(tokb + tl) * 2048;
            bf16_t* hrow = H2 + (size_t)(tokb + tl) * 2048;
            f32x4 acc[4];
#pragma unroll
            for (int nt = 0; nt < 4; ++nt) acc[nt] = (f32x4){0.f, 0.f, 0.f, 0.f};
#pragma unroll 2
            for (int s = 32 * kh; s < 32 * kh + 32; ++s) {
                const int c0 = 32 * s + 8 * kg;
                const u32x4 xu = *(const u32x4*)(xrow + c0);
                const f32x4 xa = {bf_lo(xu.x), bf_hi(xu.x), bf_lo(xu.y), bf_hi(xu.y)}, xb = {bf_lo(xu.z), bf_hi(xu.z), bf_lo(xu.w), bf_hi(xu.w)};
                const f32x4 aa = *(const LAS f32x4*)(A2 + b * 2048 + c0), ab = *(const LAS f32x4*)(A2 + b * 2048 + c0 + 4);
                const f32x4 ba = *(const LAS f32x4*)(B2 + b * 2048 + c0), bb = *(const LAS f32x4*)(B2 + b * 2048 + c0 + 4);
                const f32x4 ya = xa * rs * aa + ba, yb = xb * rs * ab + bb;
                u32x4 hi; hi.x = cvtpk(ya[0], ya[1]); hi.y = cvtpk(ya[2], ya[3]); hi.z = cvtpk(yb[0], yb[1]); hi.w = cvtpk(yb[2], yb[3]);
                *(u32x2*)(H2F8 + (size_t)(tokb + tl) * 2048 + c0) = (u32x2){epi::pack4_f8(ya[0] * F8_SH, ya[1] * F8_SH, ya[2] * F8_SH, ya[3] * F8_SH), epi::pack4_f8(yb[0] * F8_SH, yb[1] * F8_SH, yb[2] * F8_SH, yb[3] * F8_SH)};
                u32x4 lo; lo.x = cvtpk(ya[0] - bf_lo(hi.x), ya[1] - bf_hi(hi.x)); lo.y = cvtpk(ya[2] - bf_lo(hi.y), ya[3] - bf_hi(hi.y));
                lo.z = cvtpk(yb[0] - bf_lo(hi.z), yb[1] - bf_hi(hi.z)); lo.w = cvtpk(yb[2] - bf_lo(hi.w), yb[3] - bf_hi(hi.w));
                const bf16x8 hf = __builtin_bit_cast(bf16x8, hi), lf = __builtin_bit_cast(bf16x8, lo);
#pragma unroll
                for (int nt = 0; nt < 4; ++nt) {
                    const bf16x8 wh = *(const bf16x8*)(WRH + (size_t)(16 * nt + tc) * 2048 + c0), wl = *(const bf16x8*)(WRL + (size_t)(16 * nt + tc) * 2048 + c0);
                    acc[nt] = __builtin_amdgcn_mfma_f32_16x16x32_bf16(wh, hf, acc[nt], 0, 0, 0);
                    acc[nt] = __builtin_amdgcn_mfma_f32_16x16x32_bf16(wh, lf, acc[nt], 0, 0, 0);
                    acc[nt] = __builtin_amdgcn_mfma_f32_16x16x32_bf16(wl, hf, acc[nt], 0, 0, 0);
                }
            }
#pragma unroll
            for (int nt = 0; nt < 4; ++nt) *(LAS f32x4*)(LG + (kh * 64 + tl) * P9_LGROW + 16 * nt + 4 * kg) = acc[nt];
        }
        __syncthreads();
        int se[8], sslot[8]; float sw[8];
        if (F.tid < 64) {
            LAS float* row0 = LG + F.tid * P9_LGROW; const LAS float* row1 = LG + (64 + F.tid) * P9_LGROW;
            float sl[64];
#pragma unroll
            for (int e = 0; e < 64; ++e) { const float s = sigmoidf_(row0[e] + row1[e]); row0[e] = s; sl[e] = s + rbias[e]; }
            float gs[8];
#pragma unroll
            for (int g = 0; g < 8; ++g) { float m1 = -INFINITY, m2 = -INFINITY;
#pragma unroll
                for (int j = 0; j < 8; ++j) { const float v = sl[8 * g + j]; if (v > m1) { m2 = m1; m1 = v; } else if (v > m2) m2 = v; }
                gs[g] = m1 + m2; }
            unsigned gmask = 0u;
#pragma unroll
            for (int it = 0; it < 4; ++it) { float best = -INFINITY; int bi = 0;
#pragma unroll
                for (int g = 0; g < 8; ++g) { const bool free_ = !((gmask >> g) & 1u); if (free_ && gs[g] > best) { best = gs[g]; bi = g; } }
                gmask |= 1u << bi; }
            unsigned long long picked = 0ull; float wsum = 0.f;
#pragma unroll
            for (int it = 0; it < 8; ++it) { float best = -INFINITY; int bi = 0;
#pragma unroll
                for (int e = 0; e < 64; ++e) { const bool ok = ((gmask >> (e >> 3)) & 1u) && !((picked >> e) & 1ull); if (ok && sl[e] > best) { best = sl[e]; bi = e; } }
                picked |= 1ull << bi; se[it] = bi; const float s = row0[bi]; sw[it] = s; wsum += s; }
            const float inv = 2.5f / wsum;
#pragma unroll
            for (int k = 0; k < 8; ++k) { sw[k] *= inv; sslot[k] = __hip_atomic_fetch_add(lcnt + se[k], 1, __ATOMIC_RELAXED, __HIP_MEMORY_SCOPE_WORKGROUP); }
        }
        __syncthreads();
        if (F.tid < 64) { const int c = lcnt[F.tid]; lbase[F.tid] = c > 0 ? (int)__hip_atomic_fetch_add(ecnt + F.tid, (unsigned)c, RLX_AGENT) : 0; }
        __syncthreads();
        if (F.tid < 64) { const int tok = tokb + F.tid;
#pragma unroll
            for (int k = 0; k < 8; ++k) { const int slot = lbase[se[k]] + sslot[k];
                ELIST[(size_t)se[k] * 16384 + slot] = tok; TOKE[tok * 8 + k] = (se[k] << 16) | slot; TOKW[tok * 8 + k] = sw[k]; } }
        __syncthreads();
    }
}

constexpr int MT_CNT = 0, MT_TST = 256, MT_COFF = 768, MT_GTAB = 2048;
__device__ __forceinline__ void moe_tables(Ctx& F) {
    LAS int* cnt = (LAS int*)(F.lds + LDSX_OFF + MT_CNT); LAS int* tst = (LAS int*)(F.lds + LDSX_OFF + MT_TST); LAS int* coff = (LAS int*)(F.lds + LDSX_OFF + MT_COFF);
    if (F.tid < 64) cnt[F.tid] = (int)__hip_atomic_load(F.ctl + CW_ECNT + F.tid, RLX_AGENT);
    __syncthreads();
    if (F.tid == 0) { int t = 0, c = 0; for (int e = 0; e < 64; ++e) { tst[e] = t; coff[e] = c; const int n = cnt[e]; t += (n + 255) >> 8; c += n; } tst[64] = t; coff[64] = c; }
    __syncthreads();
}
struct MoeSched {
    const LAS int* cnt; const LAS int* tst; const LAS int* coff; int G, c, npn_log2; const char* A; const char* B; size_t a_tile_bytes, b_exp_bytes, b_tile_bytes; bool compact;
    __device__ __forceinline__ bool next(int i, pg8::Unit& u) const {
        const int ntile = tst[64];
        const long L = (long)i * G + c; if (L >= ((long)ntile << npn_log2)) return false;
        const int rt = (int)(L >> npn_log2), pn = (int)(L & ((1 << npn_log2) - 1));
        int lo = 0, hi = 64;
#pragma unroll
        for (int s = 0; s < 6; ++s) { const int mid = (lo + hi) >> 1; if (tst[mid] <= rt) lo = mid; else hi = mid; }
        int e = lo;
        e = __builtin_amdgcn_readfirstlane(e);
        const int j = rt - __builtin_amdgcn_readfirstlane(tst[e]);
        const int n = __builtin_amdgcn_readfirstlane(cnt[e]);
        u.pm = rt; u.pn = pn; u.aux = e;
        u.valid = (n - 256 * j) < 256 ? (n - 256 * j) : 256;
        u.rowbase = compact ? (__builtin_amdgcn_readfirstlane(coff[e]) + 256 * j) : rt * 256;
        u.A = A + (size_t)rt * a_tile_bytes; u.B = B + (size_t)e * b_exp_bytes + (size_t)pn * b_tile_bytes;
        return true;
    }
};

__device__ __forceinline__ void p12_combine(Ctx& F) {
    moe_tables(F);
    const LAS int* coff = (const LAS int*)(F.lds + LDSX_OFF + MT_COFF);
    const unsigned char* Y = (const unsigned char*)(F.ws + WS_Y); const int* TOKE = (const int*)(F.ws + WS_TOKE); const float* TOKW = (const float*)(F.ws + WS_TOKW);
    const float* modf = (const float*)(F.ws + WS_MOD); const float* gfin = F.in[I_GFINAL]; const bf16_t* SHOUT = (const bf16_t*)(F.ws + WS_SHOUT);
    float* out = F.out;
    const int gw = F.blk * 8 + F.wave, NGW = F.G * 8;
    for (int tok = gw; tok < T; tok += NGW) {
        const int b = tok / SEQ;
        f32x4 acc[8];
        int es8[8]; float w8[8];
#pragma unroll
        for (int k = 0; k < 8; ++k) { es8[k] = TOKE[tok * 8 + k]; w8[k] = TOKW[tok * 8 + k]; }
        f32x4* xr = (f32x4*)(out + (size_t)tok * 2048) + F.lane;
        f32x4 v[8];
        { const unsigned long long* x1r = (const unsigned long long*)((const bf16_t*)(F.ws + WS_X1) + (size_t)tok * 2048) + F.lane;
#pragma unroll
          for (int j = 0; j < 8; ++j) { const unsigned long long u = __builtin_nontemporal_load(x1r + 64 * j); const unsigned lo = (unsigned)u, hi = (unsigned)(u >> 32);
              v[j] = (f32x4){bf_lo(lo), bf_hi(lo), bf_lo(hi), bf_hi(hi)}; } }
        { const unsigned* sr = (const unsigned*)((const unsigned char*)SHOUT + (size_t)tok * 2048) + F.lane;
#pragma unroll
          for (int j = 0; j < 8; ++j) { const int u = (int)__builtin_nontemporal_load(sr + 64 * j); const f32x2 lo = __builtin_amdgcn_cvt_pk_f32_fp8(u, false), hi = __builtin_amdgcn_cvt_pk_f32_fp8(u, true);
              acc[j].x = lo[0]; acc[j].y = lo[1]; acc[j].z = hi[0]; acc[j].w = hi[1]; } }
#pragma unroll
        for (int kk = 0; kk < 8; kk += 4) {
            unsigned yu[4][8];
#pragma unroll
            for (int k = 0; k < 4; ++k) { const int e = es8[kk + k] >> 16, slot = es8[kk + k] & 0xffff;
                const unsigned* yr = (const unsigned*)(Y + (size_t)(coff[e] + slot) * 2048) + F.lane;
#pragma unroll
                for (int j = 0; j < 8; ++j) yu[k][j] = __builtin_nontemporal_load(yr + 64 * j); }
#pragma unroll
            for (int k = 0; k < 4; ++k) { const float w = w8[kk + k];
#pragma unroll
                for (int j = 0; j < 8; ++j) { const int u = (int)yu[k][j]; const f32x2 lo = __builtin_amdgcn_cvt_pk_f32_fp8(u, false), hi = __builtin_amdgcn_cvt_pk_f32_fp8(u, true);
                    acc[j].x += w * lo[0]; acc[j].y += w * lo[1]; acc[j].z += w * hi[0]; acc[j].w += w * hi[1]; } }
        }
        float ss = 0.f;
#pragma unroll
        for (int j = 0; j < 8; ++j) { const int c = 4 * F.lane + 256 * j; const f32x4 g2 = *(const f32x4*)(modf + b * 12288 + 10240 + c);
            v[j] = v[j] + g2 * acc[j]; ss += (v[j].x * v[j].x + v[j].y * v[j].y) + (v[j].z * v[j].z + v[j].w * v[j].w); }
        const float rstd = 1.0f / sqrtf(wave_sum(ss) * (1.0f / 2048.0f) + RMS_EPS);
#pragma unroll
        for (int j = 0; j < 8; ++j) { const int c = 4 * F.lane + 256 * j; const f32x4 g = *(const f32x4*)(gfin + c); __builtin_nontemporal_store(v[j] * rstd * g, xr + 64 * j); }
    }
}
struct Args { const float* in[22]; float* out; unsigned char* ws; int ph_lo, ph_hi; };
static_assert(sizeof(Args) == 22 * 8 + 8 + 8 + 8, "Args has no padding");

__global__ void __launch_bounds__(512, 2) fwd_kernel(Args args) {
    extern __shared__ __attribute__((aligned(16))) unsigned char lds_raw[];
    Ctx F;
    F.lds = (LAS unsigned char*)lds_raw;
    F.tid = threadIdx.x; F.lane = F.tid & 63; F.wave = __builtin_amdgcn_readfirstlane(F.tid >> 6);
    F.G = gridDim.x; F.blk = blockIdx.x;
    F.ws = args.ws; F.ctl = (unsigned*)(args.ws + WS_CTL); F.out = args.out;
    F.in = args.in;
    volatile LAS unsigned* MISC = (volatile LAS unsigned*)(F.lds + MISC_OFF);
    if (F.tid < 32) MISC[F.tid] = 0u;
    __syncthreads();
    XcdBarrier bar; bar.bar = F.ctl + CW_BAR; bar.x = 0; bar.st = nullptr;
    if (MK_N_LAUNCHES == 1) bar = xcd_barrier_post(F.ctl + CW_BAR, MISC + 8);
    const int lo = args.ph_lo, hi = args.ph_hi;
    unsigned char* ws = args.ws;
#define IN(k) (lo <= (k) && (k) < hi && ((PHASE_MASK >> (k)) & 1u))
#define SEAM(k) do { if (MK_N_LAUNCHES == 1 && (k) + 1 < hi) xcd_barrier(bar); } while (0)
#define NREP(k) (((REP_MASK >> (k)) & 1u) ? 2 : 1)
    typedef pg8::StaticOrder SO;

    if (lo <= 0 && 0 < hi) { if (IN(0)) { for (int rep_ = 0; rep_ < NREP(0); ++rep_) { if (rep_) xcd_barrier(bar); p0_prologue(F); } } SEAM(0); }
    if (lo <= 1 && 1 < hi) { if (IN(1)) { for (int rep_ = 0; rep_ < NREP(1); ++rep_) { if (rep_) xcd_barrier(bar); p1_norm(F); } } SEAM(1); }
    if (lo <= 2 && 2 < hi) {
        if (IN(2)) {
#pragma unroll 1
        for (int rep_ = 0; rep_ < NREP(2); ++rep_) { if (rep_) xcd_barrier(bar);
            const char* H = (const char*)(ws + WS_H); const char* W = (const char*)(ws + WS_W_IN_T);
            constexpr int KP = P2F8 ? 1024 : 2048;
            { SO S; S.init(H, W, T, 8192, KP, F.G, F.blk);
              epi::ProjEpi E{epi::StoreQK8w{ws + WS_QD, ws + WS_KDT, att::D8_QS}, epi::StoreQKbothw{(bf16_t*)(ws + WS_QM), (bf16_t*)(ws + WS_KMT), ws + WS_QM8, ws + WS_KMT8}, epi::GatesW{ws + WS_GATES}};
              pg8::gemm_phase<epi::ProjEpi, SO, true, true, false, P2F8>(F.lds, KP, S, E, nullptr); }
            { SO S; S.init(W + (size_t)8192 * KP * 2, H, 2048, T, KP, F.G, F.blk); epi::ProjVT E{epi::StoreVT8{ws + WS_VDT, att::D8_VS}, epi::StoreVT8{ws + WS_VMT8, att::D8_VS}};
              pg8::gemm_phase<epi::ProjVT, SO, true, true, false, P2F8>(F.lds, KP, S, E, nullptr); }
        }
        }
        SEAM(2);
    }
    if (lo <= 3 && 3 < hi) {
        if (IN(3)) {
#pragma unroll 1
        for (int rep_ = 0; rep_ < NREP(3); ++rep_) { if (rep_) xcd_barrier(bar);
            const float* lv = F.in[I_LAMBDA];
            float d1 = 0.f, d2 = 0.f;
            for (int i = 0; i < 64; ++i) { d1 += lv[i] * lv[64 + i]; d2 += lv[128 + i] * lv[192 + i]; }
            if (F.tid == 0) *(LAS float*)(F.lds + MISC_OFF + 68) = expf(d1) - expf(d2) + 0.2f;
            {
                const int x = (int)(xb_xcc_id() & 7u);
                const bool converter = ((F.blk >> 3) & 3) == 3;
                if (converter) { for (int c = queue_take(F, F.ctl + CW_CQ); c < CV_NCHUNK; c = queue_take(F, F.ctl + CW_CQ)) { __syncthreads(); convert_chunk(F, c); } }
#pragma unroll 1
                for (int k = 0; k < 8; ++k) {
                    const int xq = (x + k) & 7;
#pragma unroll 1
                    for (int i = queue_take(F, F.ctl + CW_AQ + 64 * xq); i < 128; i = queue_take(F, F.ctl + CW_AQ + 64 * xq)) {
                        const int bh = 2 * xq + (i & 1), qt = 63 - (i >> 1);
                        att::diff_unit8(F.lds, bh >> 3, bh & 7, qt, ws + WS_QD, ws + WS_KDT, ws + WS_VDT, (bf16_t*)(ws + WS_AD), F.in[I_SUBLN], F.in[I_RELB]);
                    }
                }
                for (int c = queue_take(F, F.ctl + CW_CQ); c < CV_NCHUNK; c = queue_take(F, F.ctl + CW_CQ)) { __syncthreads(); convert_chunk(F, c); }
            }
            __syncthreads();
            p3_kmean(F);
        }
        }
        SEAM(3);
    }
    if (lo <= 4 && 4 < hi) { if (IN(4)) p4_gating(F); SEAM(4); }
    if (lo <= 5 && 5 < hi) {
        if (IN(5)) {
#pragma unroll 1
        for (int rep_ = 0; rep_ < NREP(5); ++rep_) { if (rep_) xcd_barrier(bar);
            constexpr int MB_CPU = 2;
            LAS int* pre = (LAS int*)(F.lds + LDSX_OFF);
            const unsigned* mcnt = F.ctl + CW_MCNT;
            const int mycnt = (int)__hip_atomic_load(mcnt + F.tid, RLX_AGENT);
            pre[F.tid] = (1 + ((mycnt + 255) >> 8) + MB_CPU - 1) / MB_CPU;
            __syncthreads();
            int src = 0;
            for (int off = 1; off < 512; off <<= 1) { const int v = pre[src * 512 + F.tid] + (F.tid >= off ? pre[src * 512 + F.tid - off] : 0); pre[(src ^ 1) * 512 + F.tid] = v; src ^= 1; __syncthreads(); }
            LAS int* inc = (LAS int*)(F.lds + att::MB_INC);
            inc[F.tid] = pre[src * 512 + F.tid];
            __syncthreads();
            const int total = inc[511];
            for (int u = F.blk; u < total; u += F.G) {
                int lo_ = -1, hi_ = 511;
#pragma unroll
                for (int st = 0; st < 9; ++st) { const int mid = (lo_ + hi_) >> 1; if (inc[mid] > u) hi_ = mid; else lo_ = mid; }
                const int l = __builtin_amdgcn_readfirstlane(hi_);
                const int before = l > 0 ? __builtin_amdgcn_readfirstlane(inc[l - 1]) : 0;
                const int j = u - before;
                const int cntl = (int)__builtin_amdgcn_readfirstlane(__hip_atomic_load(mcnt + l, RLX_AGENT));
                const int nch = 1 + ((cntl + 255) >> 8);
                const int c0 = j * MB_CPU, c1 = (c0 + MB_CPU) < nch ? (c0 + MB_CPU) : nch;
                att::moba_block8(F.lds, l >> 8, (l >> 5) & 7, l & 31, (const int*)(ws + WS_MLIST) + (size_t)l * 8192, cntl, c0, c1, ws + WS_QM8, ws + WS_KMT8, ws + WS_VMT8, (bf16_t*)(ws + WS_PARTS), (float*)(ws + WS_ML), F.in[I_RELB]);
            }
            __syncthreads();
        }
        }
        SEAM(5);
    }
    if (lo <= 6 && 6 < hi) { if (IN(6)) { for (int rep_ = 0; rep_ < NREP(6); ++rep_) { if (rep_) xcd_barrier(bar); p6_merge(F); } } SEAM(6); }
    if (lo <= 7 && 7 < hi) {
        if (IN(7)) {
#pragma unroll 1
        for (int rep_ = 0; rep_ < NREP(7); ++rep_) { if (rep_) xcd_barrier(bar);
            { pg8::PairOrder S; S.init(ws + WS_AD, ws + WS_W_OD_T, ws + WS_AM, ws + WS_W_OM_T, T, 2048, O78F8 ? 512 : 1024, F.G, F.blk);
              epi::GatePair E{epi::GateMul<0>{(const bf16_t*)(ws + WS_GATES), 0, nullptr, (bf16_t*)(ws + WS_T1)}, epi::GateMul<1>{(const bf16_t*)(ws + WS_GATES), 2048, (const bf16_t*)(ws + WS_T1), (bf16_t*)(ws + WS_G)}};
              pg8::gemm_phase<epi::GatePair, pg8::PairOrder, true, true, false, O78F8>(F.lds, O78F8 ? 512 : 1024, S, E, nullptr); }
        }
        }
        SEAM(7);
    }
    if (lo <= 8 && 8 < hi) {
        if (IN(8)) {
#pragma unroll 1
        for (int rep_ = 0; rep_ < NREP(8); ++rep_) { if (rep_) xcd_barrier(bar);
            SO S; S.init(ws + WS_G, ws + WS_W_OUT_T, T, 2048, O78F8 ? 1024 : 2048, F.G, F.blk); epi::ResidBf16 E{F.in[I_X], (bf16_t*)(ws + WS_X1), (const float*)(ws + WS_MOD), 4096};
            pg8::gemm_phase<epi::ResidBf16, SO, true, true, false, O78F8>(F.lds, O78F8 ? 1024 : 2048, S, E, nullptr);
        }
        }
        SEAM(8);
    }
    if (lo <= 9 && 9 < hi) { if (IN(9)) p9_route(F); SEAM(9); }
    if (lo <= 10 && 10 < hi) {
        if (IN(10)) {
#pragma unroll 1
        for (int rep_ = 0; rep_ < NREP(10); ++rep_) { if (rep_) xcd_barrier(bar);
            moe_tables(F);
            MoeSched S{(const LAS int*)(F.lds + LDSX_OFF + MT_CNT), (const LAS int*)(F.lds + LDSX_OFF + MT_TST), (const LAS int*)(F.lds + LDSX_OFF + MT_COFF), F.G, F.blk, 2,
                       (const char*)(ws + WS_H2F8), (const char*)(ws + WS_W_EGU_T), 0, (size_t)1024 * 2048, (size_t)256 * 2048, false};
            LAS unsigned short* gtab = (LAS unsigned short*)(F.lds + LDSX_OFF + MT_GTAB);
            { const int* ELIST = (const int*)(ws + WS_ELIST); pg8::Unit u;
              for (int i = 0; i < 24 && S.next(i, u); ++i) { if (F.tid < 256) { const int j = u.pm - S.tst[u.aux]; gtab[i * 256 + F.tid] = (unsigned short)(F.tid < u.valid ? ELIST[(size_t)u.aux * 16384 + 256 * j + F.tid] : 0); } } }
            __syncthreads();
            { epi::SwiGLU8 E{ws + WS_ACT}; pg8::gemm_phase<epi::SwiGLU8, MoeSched, true, true, true, true>(F.lds, 1024, S, E, gtab); }
            { SO S2; S2.init(ws + WS_H2F8, ws + WS_W_SHGU_T, T, 1024, 1024, F.G, F.blk); epi::SwiGLU8 E{ws + WS_SHACT};
              pg8::gemm_phase<epi::SwiGLU8, SO, true, true, false, true>(F.lds, 1024, S2, E, nullptr); }
        }
        }
        SEAM(10);
    }
    if (lo <= 11 && 11 < hi) {
        if (IN(11)) {
            moe_tables(F);
            MoeSched S{(const LAS int*)(F.lds + LDSX_OFF + MT_CNT), (const LAS int*)(F.lds + LDSX_OFF + MT_TST), (const LAS int*)(F.lds + LDSX_OFF + MT_COFF), F.G, F.blk, 3,
                       (const char*)(ws + WS_ACT), (const char*)(ws + WS_W_ED_T), (size_t)256 * 512, (size_t)2048 * 512, (size_t)256 * 512, true};
#pragma unroll 1
            for (int rep_ = 0; rep_ < NREP(11); ++rep_) { if (rep_) xcd_barrier(bar);
            { epi::DownY E{(unsigned char*)(ws + WS_Y)}; pg8::gemm_phase<epi::DownY, MoeSched, true, true, false, true>(F.lds, 256, S, E, nullptr); } }
            { SO S2; S2.init(ws + WS_SHACT, ws + WS_W_SHD_T, T, 2048, 256, F.G, F.blk); epi::DownShared8 E{ws + WS_SHOUT};
              pg8::gemm_phase<epi::DownShared8, SO, true, true, false, true>(F.lds, 256, S2, E, nullptr); }
        }
        SEAM(11);
    }
    if (lo <= 12 && 12 < hi) { if (IN(12)) p12_combine(F); }
#undef IN
#undef SEAM
}

extern "C" void kernel_launch(void* const* d_in, const int* in_sizes, int n_in, void* d_out, int out_size, void* d_ws, size_t ws_size, hipStream_t stream) {
    static int grid = 0;
    if (grid == 0) {
        if (n_in != 22 || in_sizes[0] != T * D || out_size != T * D || ws_size < WS_END) { fprintf(stderr, "kernel_launch: unexpected shapes (n_in %d, in0 %d, out %d, ws %zu < %zu); nothing launched\n", n_in, n_in > 0 ? in_sizes[0] : -1, out_size, ws_size, (size_t)WS_END); grid = -1; return; }
        int dev = 0, cus = 0, per_cu = 0;
        if (hipGetDevice(&dev) != hipSuccess || hipDeviceGetAttribute(&cus, hipDeviceAttributeMultiprocessorCount, dev) != hipSuccess) { grid = -1; return; }
        if (hipFuncSetAttribute((const void*)fwd_kernel, hipFuncAttributeMaxDynamicSharedMemorySize, LDS_BYTES) != hipSuccess) { fprintf(stderr, "kernel_launch: hipFuncSetAttribute failed\n"); grid = -1; return; }
        if (hipOccupancyMaxActiveBlocksPerMultiprocessor(&per_cu, (const void*)fwd_kernel, 512, LDS_BYTES) != hipSuccess || per_cu < 1) fprintf(stderr, "kernel_launch: occupancy query says %d\n", per_cu);
        (void)hipGetLastError();
        grid = cus;
    }
    if (grid < 0) return;
    if (hipMemsetAsync((char*)d_ws + WS_CTL, 0, CTL_ZERO_BYTES, stream) != hipSuccess) { fprintf(stderr, "kernel_launch: memset failed\n"); return; }
    Args a{};
    for (int i = 0; i < 22; ++i) a.in[i] = (const float*)d_in[i];
    a.out = (float*)d_out; a.ws = (unsigned char*)d_ws;
    for (int li = 0; li < MK_N_LAUNCHES; ++li) {
        a.ph_lo = (MK_N_LAUNCHES == 1) ? 0 : li; a.ph_hi = (MK_N_LAUNCHES == 1) ? NPHASE : li + 1;
        hipLaunchKernelGGL(fwd_kernel, dim3(grid), dim3(512), LDS_BYTES, stream, a);
        const hipError_t le = hipPeekAtLastError();
        if (le != hipSuccess) { fprintf(stderr, "kernel_launch: launch %d failed: %s\n", li, hipGetErrorName(le)); break; }
    }
}
```

```cpp
#include <hip/hip_runtime.h>
#include <cstdio>
#include <cstdint>

#define LAS __attribute__((address_space(3)))
#define GAS __attribute__((address_space(1)))
typedef unsigned short bf16_t;
typedef short bf16x8 __attribute__((ext_vector_type(8)));
typedef short s16x4 __attribute__((ext_vector_type(4)));
typedef int i32x4 __attribute__((ext_vector_type(4)));
typedef int i32x8 __attribute__((ext_vector_type(8)));
typedef float f32x4 __attribute__((ext_vector_type(4)));
typedef float f32x2 __attribute__((ext_vector_type(2)));
typedef float f32x16 __attribute__((ext_vector_type(16)));
typedef unsigned u32x4 __attribute__((ext_vector_type(4)));
typedef unsigned u32x2 __attribute__((ext_vector_type(2)));
typedef __bf16 bf16x2_t __attribute__((ext_vector_type(2)));

#ifndef MK_N_LAUNCHES
#define MK_N_LAUNCHES 1
#endif
#ifndef REP_MASK
#define REP_MASK 0u
#endif
#ifndef PHASE_MASK
#define PHASE_MASK 0xFFFFFFFFu
#endif

constexpr int NB = 2, SEQ = 8192, T = NB * SEQ, D = 2048, NH = 8, INC = 10240, NE = 64, EDIM = 512, TOPK = 8;
constexpr int NPHASE = 13;
constexpr float RMS_EPS = 1e-6f;
constexpr float LOG2E = 1.4426950408889634f;

constexpr size_t MiB = 1u << 20;
constexpr size_t WS_CTL = 0, CTL_ZERO_BYTES = 1 * MiB;
constexpr size_t WS_MODP = 1 * MiB;
constexpr size_t WS_MOD = 4 * MiB;
constexpr size_t WS_KMEAN = 4 * MiB + 256 * 1024;
constexpr size_t WS_WR = 4 * MiB + 512 * 1024;
constexpr size_t WS_TOKE = 5 * MiB;
constexpr size_t WS_TOKW = 5 * MiB + 512 * 1024;
constexpr size_t WS_W_IN_T = 8 * MiB;
constexpr size_t WS_W_OD_T = 48 * MiB;
constexpr size_t WS_W_OM_T = 52 * MiB;
constexpr size_t WS_W_OUT_T = 56 * MiB;
constexpr size_t WS_W_SHGU_T = 64 * MiB;
constexpr size_t WS_W_SHD_T = 68 * MiB;
constexpr size_t WS_ELIST = 70 * MiB;
constexpr size_t WS_W_ED_T = 76 * MiB;
constexpr size_t WS_W_EGU_T = 204 * MiB;
constexpr size_t WS_H = 460 * MiB;
constexpr size_t WS_QD = 524 * MiB;
constexpr size_t WS_KDT = 556 * MiB;
constexpr size_t WS_VDT = 588 * MiB;
constexpr size_t WS_QM = 620 * MiB;
constexpr size_t WS_KMT = 652 * MiB;
constexpr size_t WS_VMT = 684 * MiB;
constexpr size_t WS_GATES = 716 * MiB;
constexpr size_t WS_AD = 844 * MiB;
constexpr size_t WS_AM = 876 * MiB;
constexpr size_t WS_ML = 908 * MiB;
constexpr size_t WS_MLIST = 912 * MiB;
constexpr size_t WS_PARTS = 460 * MiB;
constexpr size_t WS_G = 460 * MiB;
constexpr size_t WS_T1 = 524 * MiB;
constexpr size_t WS_X1 = 524 * MiB;
constexpr size_t WS_H2 = 588 * MiB;
constexpr size_t WS_ACT = 716 * MiB;
constexpr size_t WS_H2F8 = 800 * MiB;
constexpr float F8_SH = 8.0f, F8_SW = 64.0f, F8_SA = 8.0f, F8_SD = 32.0f;
namespace att { constexpr float D8_QS = 0.125f * LOG2E * 16.0f, D8_KS = 4.0f, D8_VS = 8.0f; }
constexpr size_t WS_QM8 = 604 * MiB, WS_VMT8 = 684 * MiB, WS_KMT8 = 700 * MiB;
namespace att { constexpr float MB8_QS = 0.08838834764831845f * LOG2E * 16.0f; }
constexpr float F8_SPART = 16.0f;
constexpr float F8_SGATE = 256.0f;
constexpr bool O78F8 = true;
constexpr float F8_SAD = 16.0f, F8_SAM = 64.0f, F8_SWO = 32.0f, F8_SG = 16.0f, F8_SWOUT = 64.0f;
constexpr bool P2F8 = true;
constexpr float DS2 = 1.0f;
constexpr int P2_EXP = 9;
constexpr size_t WS_SHACT = 860 * MiB;
constexpr size_t WS_SHOUT = 588 * MiB;
constexpr size_t WS_Y = 204 * MiB;
constexpr size_t WS_END = 928 * MiB;
static_assert(WS_Y + (size_t)131072 * 2048 * 2 <= WS_ACT, "Y must not reach ACT");
static_assert(WS_ACT + (size_t)147456 * 512 * 2 <= WS_SHACT && WS_SHACT + (size_t)T * 512 * 2 <= WS_END, "act map");
static_assert(WS_PARTS + (size_t)T * 8 * 4 * 128 * 2 <= WS_VDT, "parts overlay");

constexpr int CW_BAR = 4096;
constexpr int CW_ECNT = 8192;
constexpr int CW_MCNT = 8448;
constexpr int CW_AQ = 9216;
constexpr int CW_CQ = 9216 + 64 * 8;

constexpr int RING_BYTES = 131072;
constexpr int LDSX_OFF = RING_BYTES;
constexpr int MISC_OFF = RING_BYTES + 16384;
constexpr int LDS_BYTES = MISC_OFF + 128;

#define LDS_WAIT() asm volatile("s_waitcnt lgkmcnt(0)" ::: "memory")
#define VM_WAIT() asm volatile("s_waitcnt vmcnt(0)" ::: "memory")
#define RLX_AGENT __ATOMIC_RELAXED, __HIP_MEMORY_SCOPE_AGENT

__device__ __forceinline__ unsigned cvtpk(float lo, float hi) { f32x2 v = {lo, hi}; bf16x2_t b = __builtin_convertvector(v, bf16x2_t); return __builtin_bit_cast(unsigned, b); }
__device__ __forceinline__ float bf_lo(unsigned u) { return __uint_as_float(u << 16); }
__device__ __forceinline__ float bf_hi(unsigned u) { return __uint_as_float(u & 0xffff0000u); }
__device__ __forceinline__ float wave_sum(float v) {
#pragma unroll
    for (int o = 1; o < 64; o <<= 1) v += __shfl_xor(v, o);
    return v;
}
__device__ __forceinline__ float fast_exp2(float x) { return __builtin_amdgcn_exp2f(x); }
__device__ __forceinline__ float fast_rcp(float x) { return __builtin_amdgcn_rcpf(x); }
__device__ __forceinline__ float sigmoidf_(float x) { return fast_rcp(1.0f + fast_exp2(-x * LOG2E)); }
__device__ __forceinline__ float siluf_(float x) { return x * sigmoidf_(x); }

#define XB_TMO      128
#define XB_XCNT(j)  (256  + 64 * (j))
#define XB_XSUB(j)  (1280 + 64 * (j))
#define XB_XGEN(j)  (2304 + 64 * (j))
#define XB_TOP      3328
#define XB_TOPGEN   3392
#define XCD_BAR_WORDS 3456
#define XB_SPIN_CAP (1u << 22)

__device__ __forceinline__ unsigned xb_ld(unsigned* p)              { return __hip_atomic_load(p, __ATOMIC_RELAXED, __HIP_MEMORY_SCOPE_AGENT); }
__device__ __forceinline__ unsigned xb_add(unsigned* p, unsigned v) { return __hip_atomic_fetch_add(p, v, __ATOMIC_RELAXED, __HIP_MEMORY_SCOPE_AGENT); }
__device__ __forceinline__ unsigned xb_xcc_id() { return (unsigned)__builtin_amdgcn_s_getreg((3 << 11) | 20) & 0xFu; }
#define XB_SPIN(cond, bar) do { unsigned _sp = 0; while (cond) { __builtin_amdgcn_s_sleep(1); \
    if ((++_sp & 255u) == 0u) { if (xb_ld(&(bar)[XB_TMO])) break; if (_sp > XB_SPIN_CAP) { atomicAdd(&(bar)[XB_TMO], 1u); break; } } } } while (0)

struct XcdBarrier { unsigned* bar; unsigned x; volatile LAS unsigned* st; };

__device__ __forceinline__ XcdBarrier xcd_barrier_post(unsigned* bar, volatile LAS unsigned* st) {
    XcdBarrier b; b.bar = bar; b.x = xb_xcc_id(); b.st = st;
    if (threadIdx.x == 0) (void)xb_add(&bar[XB_XCNT(b.x)], 1u);
    return b;
}
__device__ __forceinline__ void xcd_barrier_complete(unsigned* bar, unsigned x, unsigned& nloc, unsigned& nx) {
    const unsigned G = gridDim.x * gridDim.y * gridDim.z;
    unsigned sum, cnt, mine, sp = 0u;
    for (;;) {
        sum = 0u; cnt = 0u; mine = 0u;
#pragma unroll
        for (unsigned j = 0; j < 16; ++j) { const unsigned c = xb_ld(&bar[XB_XCNT(j)]); sum += c; cnt += (c > 0u) ? 1u : 0u; mine = (j == x) ? c : mine; }
        if (sum == G) break;
        __builtin_amdgcn_s_sleep(1);
        if ((++sp & 255u) == 0u) { if (xb_ld(&bar[XB_TMO])) break; if (sp > XB_SPIN_CAP) { atomicAdd(&bar[XB_TMO], 1u); break; } }
    }
    nloc = mine > 0u ? mine : 1u; nx = cnt > 0u ? cnt : 1u;
}
__device__ __forceinline__ void xcd_barrier(const XcdBarrier& b) {
    asm volatile("s_waitcnt vmcnt(0)" ::: "memory");
    __syncthreads();
    if (threadIdx.x == 0) {
        unsigned* bar = b.bar;
        __builtin_amdgcn_s_waitcnt(0);
        unsigned nloc = b.st[0], nx = b.st[1];
        if (nloc == 0u) { xcd_barrier_complete(bar, b.x, nloc, nx); b.st[0] = nloc; b.st[1] = nx; }
        const unsigned old = xb_add(&bar[XB_XSUB(b.x)], 1u);
        const unsigned gen = old / nloc;
        if (old + 1u == (gen + 1u) * nloc) {
            __builtin_amdgcn_fence(__ATOMIC_RELEASE, "agent");
            asm volatile("s_waitcnt vmcnt(0)" ::: "memory");
            const unsigned og = xb_add(&bar[XB_TOP], 1u);
            const unsigned tg = og / nx;
            if (og + 1u == (tg + 1u) * nx) xb_add(&bar[XB_TOPGEN], 1u);
            else XB_SPIN(xb_ld(&bar[XB_TOPGEN]) == tg, bar);
            __builtin_amdgcn_fence(__ATOMIC_ACQUIRE, "agent");
            xb_add(&bar[XB_XGEN(b.x)], 1u);
            asm volatile("s_waitcnt vmcnt(0)" ::: "memory");
        } else {
            XB_SPIN(xb_ld(&bar[XB_XGEN(b.x)]) == gen, bar);
            __builtin_amdgcn_fence(__ATOMIC_ACQUIRE, "agent");
            asm volatile("s_waitcnt vmcnt(0)" ::: "memory");
        }
    }
    __syncthreads();
}

namespace pg8 {
constexpr int BM = 256, BK = 64, HALF = 128, HTB = HALF * BK * 2, STAGE_BYTES = 8 * HTB, NXCD = 8, WGM = 8;
static_assert(STAGE_BYTES == RING_BYTES, "ring");
__host__ __device__ __forceinline__ int lds_byte(int r, int c) { const int st = (r >> 4) * 2 + (c >> 5), rr = r & 15, cc = c & 31, ob = rr * 64 + cc * 2; return st * 1024 + (ob ^ (((ob >> 9) & 1) << 5)); }
__host__ __device__ __forceinline__ void stage_rc(int b, int& R, int& C) { const int st = b / 1024, sb = b % 1024, swz = sb ^ (((sb >> 9) & 1) << 5); R = (st >> 1) * 16 + swz / 64; C = (st & 1) * 32 + (swz % 64) / 2; }
__host__ __device__ __forceinline__ int perm32(int rho) { const int n = rho >> 4, i = rho & 15; return 8 * (i >> 2) + 4 * n + (i & 3); }

struct Unit { int pm, pn; const char* A; const char* B; int rowbase, valid, aux; };

struct StaticOrder {
    int nM, nN, nwg, G, c; const char* A; const char* B; size_t tstep;
    __device__ void init(const void* A_, const void* B_, int M, int N, int K, int G_, int c_) { A = (const char*)A_; B = (const char*)B_; nM = M / BM; nN = N / BM; nwg = nM * nN; G = G_; c = c_; tstep = (size_t)BM * K * 2; }
    __device__ bool next(int i, Unit& u) const {
        const long L = (long)i * G + c; if (L >= nwg) return false;
        int wgid = (int)L; { const int q = nwg / NXCD, r = nwg % NXCD, xcd = wgid % NXCD, off = wgid / NXCD; wgid = (xcd < r ? xcd * (q + 1) : r * (q + 1) + (xcd - r) * q) + off; }
        const int nig = WGM * nN, gid = wgid / nig, fm = gid * WGM, gsz = (nM - fm) < WGM ? (nM - fm) : WGM;
        u.pm = fm + ((wgid % nig) % gsz); u.pn = (wgid % nig) / gsz;
        u.A = A + (size_t)u.pm * tstep; u.B = B + (size_t)u.pn * tstep; u.rowbase = u.pm * BM; u.valid = BM; u.aux = 0; return true;
    }
};

struct PairOrder {
    StaticOrder base; const char* A1; const char* B1;
    __device__ void init(const void* A0_, const void* B0_, const void* A1_, const void* B1_, int M, int N, int K, int G_, int c_) { base.init(A0_, B0_, M, N, K, G_, c_); A1 = (const char*)A1_; B1 = (const char*)B1_; }
    __device__ bool next(int i, Unit& u) const {
        if (!base.next(i >> 1, u)) return false;
        if (i & 1) { u.A = A1 + (size_t)u.pm * base.tstep; u.B = B1 + (size_t)u.pn * base.tstep; u.aux = 1; }
        return true;
    }
};

template <class Epi, class Sched, bool ALIGN_EPI, bool SP2, bool GATHER, bool F8 = false>
__device__ __forceinline__ void gemm_phase(LAS unsigned char* lds, const int K, const Sched& S, const Epi& E, const LAS unsigned short* gtab) {
    int tid_ = threadIdx.x; asm volatile("" : "+v"(tid_));
    const int tid = tid_, wid = __builtin_amdgcn_readfirstlane(tid >> 6), lane = tid & 63, wr = wid >> 2, wc = wid & 3, fr = lane & 15, fq = lane >> 4;
    const int nt = K / BK;
    unsigned voffA[2], voffB[2]; int RA[2], CA[2];
#pragma unroll
    for (int i = 0; i < 2; ++i) { int R, C; stage_rc(tid * 16 + i * 8192, R, C); const int Rb = (int)Epi::PERM == 2 ? (64 * (R >> 5) + 16 * ((R >> 2) & 3) + 4 * ((R >> 4) & 1) + (R & 3)) : (Epi::PERM ? ((R & ~31) + perm32(R & 31)) : R);
        RA[i] = R; CA[i] = C; voffA[i] = (unsigned)(R * K + C) * 2u; voffB[i] = (unsigned)(Rb * K + C) * 2u; }
    const size_t kstep = (size_t)(BK * 2);
    const size_t hstep = (size_t)HALF * K * 2;
    const size_t hstepB = (int)Epi::PERM == 2 ? (size_t)8 * K * 2 : hstep;
    const unsigned ldsw = (unsigned)wid * 1024u;
    const int aoff = lds_byte(wr * 64 + fr, fq * 8), boff = lds_byte(wc * 32 + fr, fq * 8);
    unsigned vA[2][2], nvA[2][2];
#define PG8_SA(b, h) (((b) * 2 + (h)) * HTB)
#define PG8_SB(b, h) ((4 + (b) * 2 + (h)) * HTB)
#define PG8_GL(gp, ldsoff) __builtin_amdgcn_global_load_lds((const unsigned*)(gp), (LAS unsigned*)(lds + (ldsoff)), 16, 0, 0)
#define PG8_STAGE(bufoff, gbase, voff) do { _Pragma("unroll") for (int _i = 0; _i < 2; ++_i) PG8_GL((const char*)(gbase) + (voff)[_i], (bufoff) + ldsw + _i * 8192); } while (0)
#define PG8_STA(bufoff, gbase, h, nx) do { if constexpr (GATHER) { \
        const unsigned _o0 = (nx) ? nvA[h][0] : vA[h][0], _o1 = (nx) ? nvA[h][1] : vA[h][1]; \
        PG8_GL((const char*)(gbase) + _o0, (bufoff) + ldsw); PG8_GL((const char*)(gbase) + _o1, (bufoff) + ldsw + 8192); \
    } else { PG8_STAGE(bufoff, (const char*)(gbase) + (h) * hstep, voffA); } } while (0)
#define PG8_GVA(dst, ul) do { _Pragma("unroll") for (int _h = 0; _h < 2; ++_h) _Pragma("unroll") for (int _i = 0; _i < 2; ++_i) \
        dst[_h][_i] = (unsigned)gtab[(ul) * 256 + _h * 128 + RA[_i]] * (unsigned)(K * 2) + (unsigned)(CA[_i] * 2); } while (0)
#define PG8_LDA(dst, b, h) do { _Pragma("unroll") for (int m = 0; m < 4; ++m) _Pragma("unroll") for (int k = 0; k < 2; ++k) dst[m][k] = *(const LAS bf16x8*)(lds + PG8_SA(b, h) + aoff + m * 2048 + k * 1024); } while (0)
#define PG8_LDB(dst, b, h) do { _Pragma("unroll") for (int n = 0; n < 2; ++n) _Pragma("unroll") for (int k = 0; k < 2; ++k) dst[n][k] = *(const LAS bf16x8*)(lds + PG8_SB(b, h) + boff + n * 2048 + k * 1024); } while (0)
#define PG8_MMA(ai, bj, At, Bt) do { __builtin_amdgcn_s_setprio(1); _Pragma("unroll") for (int m = 0; m < 4; ++m) _Pragma("unroll") for (int n = 0; n < 2; ++n) { \
        if constexpr (F8) { const i32x4 _b0 = __builtin_bit_cast(i32x4, Bt[n][0]), _b1 = __builtin_bit_cast(i32x4, Bt[n][1]), _a0 = __builtin_bit_cast(i32x4, At[m][0]), _a1 = __builtin_bit_cast(i32x4, At[m][1]); \
            const i32x8 _b8 = __builtin_shufflevector(_b0, _b1, 0, 1, 2, 3, 4, 5, 6, 7), _a8 = __builtin_shufflevector(_a0, _a1, 0, 1, 2, 3, 4, 5, 6, 7); \
            asm volatile("v_mfma_scale_f32_16x16x128_f8f6f4 %0, %1, %2, %0, %3, %4 op_sel_hi:[0,0,0]" : "+v"(acc[ai][bj][m][n]) : "v"(_b8), "v"(_a8), "v"(f8sc), "v"(f8one)); } \
        else { _Pragma("unroll") for (int k = 0; k < 2; ++k) acc[ai][bj][m][n] = __builtin_amdgcn_mfma_f32_16x16x32_bf16(Bt[n][k], At[m][k], acc[ai][bj][m][n], 0, 0, 0); } } __builtin_amdgcn_s_setprio(0); } while (0)
#define PG8_WAIT_V(n) asm volatile("s_waitcnt vmcnt(" #n ")" ::: "memory")
#define PG8_WAIT_L(n) asm volatile("s_waitcnt lgkmcnt(" #n ")" ::: "memory")
#define PG8_BAR __builtin_amdgcn_s_barrier()
#define PG8_SCHED __builtin_amdgcn_sched_barrier(0)
    Unit cur, nxt; int ui = 0;
    if (!S.next(0, cur)) return;
    if constexpr (GATHER) { PG8_GVA(vA, 0); }
    int f8sc = 0x7F7F7F7F;
    const int f8one = 0x7F7F7F7F;
    f32x4 acc[2][2][4][2];
#pragma unroll
    for (int a = 0; a < 2; ++a)
#pragma unroll
        for (int b = 0; b < 2; ++b)
#pragma unroll
            for (int m = 0; m < 4; ++m)
#pragma unroll
                for (int n = 0; n < 2; ++n) acc[a][b][m][n] = (f32x4){0.f, 0.f, 0.f, 0.f};
    bf16x8 At[4][2], B0[2][2], B1[2][2];
    const char* cA = cur.A; const char* cB = cur.B;
    if constexpr (SP2) {
        PG8_STAGE(PG8_SB(0, 0), cB, voffB); PG8_STAGE(PG8_SB(0, 1), cB + hstepB, voffB); PG8_STA(PG8_SA(0, 0), cA, 0, false); PG8_STA(PG8_SA(0, 1), cA, 1, false);
        if (wr == 1) PG8_BAR;
        PG8_WAIT_V(2); PG8_BAR;
        PG8_STAGE(PG8_SB(1, 0), cB + kstep, voffB); PG8_STA(PG8_SA(1, 0), cA + kstep, 0, false); PG8_STAGE(PG8_SB(1, 1), cB + hstepB + kstep, voffB);
        PG8_WAIT_V(6); PG8_BAR;
    } else {
        PG8_STAGE(PG8_SB(0, 0), cB, voffB); PG8_STA(PG8_SA(0, 0), cA, 0, false); PG8_STAGE(PG8_SB(0, 1), cB + hstepB, voffB); PG8_STA(PG8_SA(0, 1), cA, 1, false);
        if (wr == 1) PG8_BAR;
        PG8_WAIT_V(4); PG8_BAR;
        PG8_STAGE(PG8_SB(1, 0), cB + kstep, voffB); PG8_STA(PG8_SA(1, 0), cA + kstep, 0, false); PG8_STAGE(PG8_SB(1, 1), cB + hstepB + kstep, voffB);
        PG8_WAIT_V(6); PG8_BAR;
    }
    for (;;) {
        if constexpr (F8) f8sc = 0x01010101 * (127 - E.f8exp(cur));
        bool has_next = false; const char* nA = cA; const char* nB = cB;
#define PG8_NEXT_UNIT() do { has_next = S.next(ui + 1, nxt); nA = has_next ? nxt.A : cA; nB = has_next ? nxt.B : cB; \
        if constexpr (GATHER) { if (has_next) { PG8_GVA(nvA, ui + 1); } else { _Pragma("unroll") for (int _h = 0; _h < 2; ++_h) _Pragma("unroll") for (int _i = 0; _i < 2; ++_i) nvA[_h][_i] = vA[_h][_i]; } } } while (0)
        if (nt < 4 || !SP2) PG8_NEXT_UNIT();
        for (int t = 0; t < nt; t += 2) {
            const bool last = (t == nt - 2);
            const char* a1 = cA + (size_t)(t + 1) * kstep;
            const char* a2 = last ? nA : cA + (size_t)(t + 2) * kstep; const char* b2 = last ? nB : cB + (size_t)(t + 2) * kstep;
            const char* a3 = a2 + kstep; const char* b3 = b2 + kstep;
            if constexpr (SP2) {
            PG8_LDB(B0, 0, 0); PG8_LDB(B1, 0, 1); PG8_SCHED; PG8_LDA(At, 0, 0); PG8_STA(PG8_SA(1, 1), a1, 1, false);
            PG8_WAIT_V(8); PG8_WAIT_L(0); PG8_BAR; PG8_MMA(0, 0, At, B0); PG8_MMA(0, 1, At, B1); if (t == 0 && nt >= 4) { PG8_SCHED; PG8_NEXT_UNIT(); PG8_SCHED; } PG8_BAR; PG8_SCHED;
            PG8_LDA(At, 0, 1); PG8_STAGE(PG8_SB(0, 0), b2, voffB); PG8_STAGE(PG8_SB(0, 1), b2 + hstepB, voffB); PG8_STA(PG8_SA(0, 0), a2, 0, last);
            PG8_WAIT_V(8); PG8_WAIT_L(0); PG8_BAR; PG8_MMA(1, 0, At, B0); PG8_MMA(1, 1, At, B1); PG8_BAR; PG8_SCHED;
            PG8_LDB(B0, 1, 0); PG8_LDB(B1, 1, 1); PG8_SCHED; PG8_LDA(At, 1, 0); PG8_STA(PG8_SA(0, 1), a2, 1, last);
            PG8_WAIT_V(8); PG8_WAIT_L(0); PG8_BAR; PG8_MMA(0, 0, At, B0); PG8_MMA(0, 1, At, B1); PG8_BAR; PG8_SCHED;
            PG8_LDA(At, 1, 1); PG8_STAGE(PG8_SB(1, 0), b3, voffB); PG8_STAGE(PG8_SB(1, 1), b3 + hstepB, voffB); PG8_STA(PG8_SA(1, 0), a3, 0, last);
            PG8_WAIT_V(8); PG8_WAIT_L(0); PG8_BAR; PG8_MMA(1, 0, At, B0); PG8_MMA(1, 1, At, B1); PG8_BAR; PG8_SCHED;
            } else {
            PG8_LDB(B0, 0, 0); PG8_SCHED; PG8_LDA(At, 0, 0); PG8_STA(PG8_SA(1, 1), a1, 1, false);
            PG8_WAIT_L(8); PG8_BAR; PG8_WAIT_L(0); PG8_MMA(0, 0, At, B0); PG8_BAR; PG8_SCHED;
            PG8_LDB(B1, 0, 1); PG8_STAGE(PG8_SB(0, 0), b2, voffB);
            PG8_BAR; PG8_WAIT_L(0); PG8_MMA(0, 1, At, B1); PG8_BAR;
            PG8_LDA(At, 0, 1); PG8_STA(PG8_SA(0, 0), a2, 0, last);
            PG8_BAR; PG8_WAIT_L(0); PG8_MMA(1, 0, At, B0); PG8_BAR; PG8_SCHED;
            PG8_STAGE(PG8_SB(0, 1), b2 + hstepB, voffB);
            PG8_WAIT_V(6); PG8_BAR; PG8_MMA(1, 1, At, B1); PG8_BAR;
            PG8_LDB(B0, 1, 0); PG8_SCHED; PG8_LDA(At, 1, 0); PG8_STA(PG8_SA(0, 1), a2, 1, last);
            PG8_WAIT_L(8); PG8_BAR; PG8_WAIT_L(0); PG8_MMA(0, 0, At, B0); PG8_BAR; PG8_SCHED;
            PG8_LDB(B1, 1, 1); PG8_STAGE(PG8_SB(1, 0), b3, voffB);
            PG8_BAR; PG8_WAIT_L(0); PG8_MMA(0, 1, At, B1); PG8_BAR;
            PG8_LDA(At, 1, 1); PG8_STA(PG8_SA(1, 0), a3, 0, last);
            PG8_BAR; PG8_WAIT_L(0); PG8_MMA(1, 0, At, B0); PG8_BAR; PG8_SCHED;
            PG8_STAGE(PG8_SB(1, 1), b3 + hstepB, voffB);
            PG8_WAIT_V(6); PG8_BAR; PG8_MMA(1, 1, At, B1); PG8_BAR;
            }
        }
        if constexpr (F8) asm volatile("s_nop 15\n\ts_nop 15" ::: "memory");
        if constexpr (ALIGN_EPI) { if (wr == 0) PG8_BAR; }
        { int l2 = lane; asm volatile("" : "+v"(l2)); E(acc, cur, wr, wc, l2 & 15, l2 >> 4); }
        if (!has_next) break;
#pragma unroll
        for (int a = 0; a < 2; ++a)
#pragma unroll
            for (int b = 0; b < 2; ++b)
#pragma unroll
                for (int m = 0; m < 4; ++m)
#pragma unroll
                    for (int n = 0; n < 2; ++n) acc[a][b][m][n] = (f32x4){0.f, 0.f, 0.f, 0.f};
        cur = nxt; cA = nA; cB = nB; ++ui;
        if constexpr (GATHER) {
#pragma unroll
            for (int _h = 0; _h < 2; ++_h)
#pragma unroll
                for (int _i = 0; _i < 2; ++_i) vA[_h][_i] = nvA[_h][_i];
        }
        if constexpr (ALIGN_EPI) { if (wr == 1) PG8_BAR; }
    }
    PG8_WAIT_V(0);
    if constexpr (!ALIGN_EPI) { if (wr == 0) PG8_BAR; }
    PG8_BAR;
#undef PG8_SA
#undef PG8_SB
#undef PG8_GL
#undef PG8_STAGE
#undef PG8_STA
#undef PG8_GVA
#undef PG8_LDA
#undef PG8_LDB
#undef PG8_MMA
#undef PG8_WAIT_V
#undef PG8_WAIT_L
#undef PG8_BAR
#undef PG8_SCHED
}
}
namespace epi {
__device__ __forceinline__ float clamp_f8(float v) { return __builtin_fminf(__builtin_fmaxf(v, -448.0f), 448.0f); }
__device__ __forceinline__ unsigned pack4_f8(float a, float b, float c, float d) { int w = __builtin_amdgcn_cvt_pk_fp8_f32(clamp_f8(a), clamp_f8(b), 0, false); return (unsigned)__builtin_amdgcn_cvt_pk_fp8_f32(clamp_f8(c), clamp_f8(d), w, true); }
using pg8::Unit;
template <int ACT> struct StoreBf16 {
    static constexpr bool PERM = true;
    bf16_t* O; int ldc;
    __device__ __forceinline__ int f8exp(const Unit&) const { return 8; }
    __device__ __forceinline__ void operator()(const f32x4 (&acc)[2][2][4][2], const Unit& u, int wr, int wc, int fr, int fq) const {
        const int row0 = u.pm * 256 + wr * 64 + fr, col0 = u.pn * 256 + wc * 32 + 8 * fq;
#pragma unroll
        for (int ai = 0; ai < 2; ++ai)
#pragma unroll
            for (int m = 0; m < 4; ++m) { bf16_t* rowp = O + (size_t)(row0 + ai * 128 + m * 16) * ldc + col0;
#pragma unroll
                for (int bj = 0; bj < 2; ++bj) { f32x4 v0 = acc[ai][bj][m][0], v1 = acc[ai][bj][m][1];
                    if (ACT == 1) {
#pragma unroll
                        for (int j = 0; j < 4; ++j) { v0[j] = sigmoidf_(v0[j] * DS2); v1[j] = sigmoidf_(v1[j] * DS2); } }
                    if (ACT == 1) { *(u32x2*)((unsigned char*)O + (size_t)(row0 + ai * 128 + m * 16) * ldc + col0 + bj * 128) = (u32x2){pack4_f8(v0[0] * F8_SGATE, v0[1] * F8_SGATE, v0[2] * F8_SGATE, v0[3] * F8_SGATE), pack4_f8(v1[0] * F8_SGATE, v1[1] * F8_SGATE, v1[2] * F8_SGATE, v1[3] * F8_SGATE)}; }
                    else { u32x4 w; w.x = cvtpk(v0[0], v0[1]); w.y = cvtpk(v0[2], v0[3]); w.z = cvtpk(v1[0], v1[1]); w.w = cvtpk(v1[2], v1[3]);
                    *(u32x4*)(rowp + bj * 128) = w; } } }
    }
};
__device__ __forceinline__ f32x4 mul4_f8(f32x4 v, unsigned w) { const f32x2 lo = __builtin_amdgcn_cvt_pk_f32_fp8((int)w, false), hi = __builtin_amdgcn_cvt_pk_f32_fp8((int)w, true); v[0] *= lo[0]; v[1] *= lo[1]; v[2] *= hi[0]; v[3] *= hi[1]; return v; }
__device__ __forceinline__ f32x4 fma4_f8(unsigned w, float s, f32x4 v) { const f32x2 lo = __builtin_amdgcn_cvt_pk_f32_fp8((int)w, false), hi = __builtin_amdgcn_cvt_pk_f32_fp8((int)w, true);
    v[0] = __builtin_fmaf(lo[0], s, v[0]); v[1] = __builtin_fmaf(lo[1], s, v[1]); v[2] = __builtin_fmaf(hi[0], s, v[2]); v[3] = __builtin_fmaf(hi[1], s, v[3]); return v; }
template <int MODE> struct GateMul {
    static constexpr int PERM = 2;
    const bf16_t* gate; int goff; const bf16_t* prev; bf16_t* O;
    __device__ __forceinline__ void operator()(const f32x4 (&acc)[2][2][4][2], const Unit& u, int wr, int wc, int fr, int fq) const {
        const int row0 = u.pm * 256 + wr * 64 + fr, col = u.pn * 256 + wc * 64 + 16 * fq;
#pragma unroll
        for (int ai = 0; ai < 2; ++ai)
#pragma unroll
            for (int m = 0; m < 4; ++m) { const size_t row = (size_t)(row0 + ai * 128 + m * 16);
                const u32x4 g = *(const u32x4*)((const unsigned char*)gate + row * 4096 + goff + col);
                f32x4 v0 = mul4_f8(acc[ai][0][m][0], g.x), v1 = mul4_f8(acc[ai][0][m][1], g.y), v2 = mul4_f8(acc[ai][1][m][0], g.z), v3 = mul4_f8(acc[ai][1][m][1], g.w);
                if (MODE == 1) { const u32x4 p = *(const u32x4*)((const unsigned char*)prev + row * 2048 + col);
                    constexpr float ip = 1.0f / F8_SG;
                    v0 = fma4_f8(p.x, ip, v0); v1 = fma4_f8(p.y, ip, v1); v2 = fma4_f8(p.z, ip, v2); v3 = fma4_f8(p.w, ip, v3); }
                *(u32x4*)((unsigned char*)O + row * 2048 + col) = (u32x4){pack4_f8(v0[0] * F8_SG, v0[1] * F8_SG, v0[2] * F8_SG, v0[3] * F8_SG), pack4_f8(v1[0] * F8_SG, v1[1] * F8_SG, v1[2] * F8_SG, v1[3] * F8_SG),
                                                                           pack4_f8(v2[0] * F8_SG, v2[1] * F8_SG, v2[2] * F8_SG, v2[3] * F8_SG), pack4_f8(v3[0] * F8_SG, v3[1] * F8_SG, v3[2] * F8_SG, v3[3] * F8_SG)}; }
    }
};
struct Resid {
    static constexpr bool PERM = false;
    const float* base; float* out; const float* gate; int goff;
    __device__ __forceinline__ void operator()(const f32x4 (&acc)[2][2][4][2], const Unit& u, int wr, int wc, int fr, int fq) const {
        const int row0 = u.pm * 256 + wr * 64 + fr, col0 = u.pn * 256 + wc * 32 + 4 * fq;
        const int b = (u.pm * 256) / SEQ;
        f32x4 gv[2][2];
#pragma unroll
        for (int bj = 0; bj < 2; ++bj)
#pragma unroll
            for (int n = 0; n < 2; ++n) gv[bj][n] = *(const f32x4*)(gate + (size_t)b * 12288 + goff + col0 + bj * 128 + n * 16);
#pragma unroll
        for (int ai = 0; ai < 2; ++ai)
#pragma unroll
            for (int m = 0; m < 4; ++m) { const size_t off = (size_t)(row0 + ai * 128 + m * 16) * 2048 + col0;
#pragma unroll
                for (int bj = 0; bj < 2; ++bj)
#pragma unroll
                    for (int n = 0; n < 2; ++n) { const f32x4 bs = *(const f32x4*)(base + off + bj * 128 + n * 16);
                        *(f32x4*)(out + off + bj * 128 + n * 16) = bs + gv[bj][n] * acc[ai][bj][m][n]; } }
    }
};
struct SwiGLU {
    static constexpr bool PERM = true;
    bf16_t* O;
    __device__ __forceinline__ void operator()(const f32x4 (&acc)[2][2][4][2], const Unit& u, int wr, int wc, int fr, int fq) const {
        const int r0 = wr * 64 + fr, col0 = u.pn * 128 + wc * 32 + 8 * fq;
#pragma unroll
        for (int ai = 0; ai < 2; ++ai)
#pragma unroll
            for (int m = 0; m < 4; ++m) { const int r = r0 + ai * 128 + m * 16;
                f32x4 v0, v1;
#pragma unroll
                for (int j = 0; j < 4; ++j) { v0[j] = siluf_(acc[ai][0][m][0][j]) * acc[ai][1][m][0][j]; v1[j] = siluf_(acc[ai][0][m][1][j]) * acc[ai][1][m][1][j]; }
                u32x4 w; w.x = cvtpk(v0[0], v0[1]); w.y = cvtpk(v0[2], v0[3]); w.z = cvtpk(v1[0], v1[1]); w.w = cvtpk(v1[2], v1[3]);
                if (r < u.valid) *(u32x4*)(O + (size_t)(u.rowbase + r) * 512 + col0) = w; }
    }
};
struct SwiGLU8 {
    static constexpr bool PERM = true;
    unsigned char* O;
    __device__ __forceinline__ int f8exp(const Unit&) const { return 9; }
    __device__ __forceinline__ void operator()(const f32x4 (&acc)[2][2][4][2], const Unit& u, int wr, int wc, int fr, int fq) const {
        const int r0 = wr * 64 + fr, col0 = u.pn * 128 + wc * 32 + 8 * fq;
        constexpr float ds = 1.0f, us = F8_SA;
#pragma unroll
        for (int ai = 0; ai < 2; ++ai)
#pragma unroll
            for (int m = 0; m < 4; ++m) { const int r = r0 + ai * 128 + m * 16;
                f32x4 v0, v1;
#pragma unroll
                for (int j = 0; j < 4; ++j) { v0[j] = siluf_(acc[ai][0][m][0][j] * ds) * (acc[ai][1][m][0][j] * us); v1[j] = siluf_(acc[ai][0][m][1][j] * ds) * (acc[ai][1][m][1][j] * us); }
                if (r < u.valid) *(u32x2*)(O + (size_t)(u.rowbase + r) * 512 + col0) = (u32x2){pack4_f8(v0[0], v0[1], v0[2], v0[3]), pack4_f8(v1[0], v1[1], v1[2], v1[3])}; }
    }
};
struct DownY {
    static constexpr int PERM = 2;
    unsigned char* O;
    __device__ __forceinline__ int f8exp(const Unit&) const { return 8; }
    __device__ __forceinline__ void operator()(const f32x4 (&acc)[2][2][4][2], const Unit& u, int wr, int wc, int fr, int fq) const {
        const int r0 = wr * 64 + fr, col0 = u.pn * 256 + wc * 64 + 16 * fq;
#pragma unroll
        for (int ai = 0; ai < 2; ++ai)
#pragma unroll
            for (int m = 0; m < 4; ++m) { const int r = r0 + ai * 128 + m * 16;
                if (r < u.valid) {
                    const f32x4 v0 = acc[ai][0][m][0], v1 = acc[ai][0][m][1], v2 = acc[ai][1][m][0], v3 = acc[ai][1][m][1];
                    int w0 = __builtin_amdgcn_cvt_pk_fp8_f32(v0[0], v0[1], 0, false); w0 = __builtin_amdgcn_cvt_pk_fp8_f32(v0[2], v0[3], w0, true);
                    int w1 = __builtin_amdgcn_cvt_pk_fp8_f32(v1[0], v1[1], 0, false); w1 = __builtin_amdgcn_cvt_pk_fp8_f32(v1[2], v1[3], w1, true);
                    int w2 = __builtin_amdgcn_cvt_pk_fp8_f32(v2[0], v2[1], 0, false); w2 = __builtin_amdgcn_cvt_pk_fp8_f32(v2[2], v2[3], w2, true);
                    int w3 = __builtin_amdgcn_cvt_pk_fp8_f32(v3[0], v3[1], 0, false); w3 = __builtin_amdgcn_cvt_pk_fp8_f32(v3[2], v3[3], w3, true);
                    *(u32x4*)(O + (size_t)(u.rowbase + r) * 2048 + col0) = (u32x4){(unsigned)w0, (unsigned)w1, (unsigned)w2, (unsigned)w3}; } }
    }
};
struct DownShared8 {
    static constexpr int PERM = 2;
    unsigned char* O;
    __device__ __forceinline__ int f8exp(const Unit&) const { return 8; }
    __device__ __forceinline__ void operator()(const f32x4 (&acc)[2][2][4][2], const Unit& u, int wr, int wc, int fr, int fq) const {
        const int r0 = u.pm * 256 + wr * 64 + fr, col0 = u.pn * 256 + wc * 64 + 16 * fq;
#pragma unroll
        for (int ai = 0; ai < 2; ++ai)
#pragma unroll
            for (int m = 0; m < 4; ++m) { const int r = r0 + ai * 128 + m * 16;
                const f32x4 v0 = acc[ai][0][m][0], v1 = acc[ai][0][m][1], v2 = acc[ai][1][m][0], v3 = acc[ai][1][m][1];
                *(u32x4*)(O + (size_t)r * 2048 + col0) = (u32x4){pack4_f8(v0[0], v0[1], v0[2], v0[3]), pack4_f8(v1[0], v1[1], v1[2], v1[3]), pack4_f8(v2[0], v2[1], v2[2], v2[3]), pack4_f8(v3[0], v3[1], v3[2], v3[3])}; }
    }
};
struct StoreQK {
    static constexpr bool PERM = true;
    bf16_t* Q; bf16_t* KT; float qscale;
    __device__ __forceinline__ void operator()(const f32x4 (&acc)[2][2][4][2], const Unit& u, int wr, int wc, int fr, int fq) const {
        const int row0 = u.pm * 256 + wr * 64 + fr, col0 = u.pn * 256 + wc * 32 + 8 * fq;
        const bool isk = (u.pn >= 4);
#pragma unroll
        for (int ai = 0; ai < 2; ++ai)
#pragma unroll
            for (int m = 0; m < 4; ++m) { const int row = row0 + ai * 128 + m * 16;
#pragma unroll
                for (int bj = 0; bj < 2; ++bj) { const float sc = (isk ? 1.0f : qscale) * DS2; const f32x4 v0 = acc[ai][bj][m][0] * sc, v1 = acc[ai][bj][m][1] * sc; const int col = col0 + bj * 128;
                    u32x4 w; w.x = cvtpk(v0[0], v0[1]); w.y = cvtpk(v0[2], v0[3]); w.z = cvtpk(v1[0], v1[1]); w.w = cvtpk(v1[2], v1[3]);
                    bf16_t* p = isk ? KT + ((((size_t)((col - 1024) >> 7) * 256 + (row >> 6)) * 64 + (row & 63)) * 128 + (col & 127)) : Q + (size_t)row * 1024 + col;
                    *(u32x4*)p = w; } }
    }
};
struct StoreQK8 {
    static constexpr bool PERM = true;
    unsigned char* Q; unsigned char* KT; float qs, ks;
    __device__ __forceinline__ void operator()(const f32x4 (&acc)[2][2][4][2], const Unit& u, int wr, int wc, int fr, int fq) const {
        const int row0 = u.pm * 256 + wr * 64 + fr, col0 = u.pn * 256 + wc * 32 + 8 * fq;
        const bool isk = (u.pn >= 4);
#pragma unroll
        for (int ai = 0; ai < 2; ++ai)
#pragma unroll
            for (int m = 0; m < 4; ++m) { const int row = row0 + ai * 128 + m * 16;
#pragma unroll
                for (int bj = 0; bj < 2; ++bj) { const float sc = isk ? 1.0f : qs;        const f32x4 v0 = acc[ai][bj][m][0] * sc, v1 = acc[ai][bj][m][1] * sc; const int col = col0 + bj * 128;
                    unsigned char* p = isk ? KT + ((((size_t)((col - 1024) >> 7) * 256 + (row >> 6)) * 64 + (row & 63)) * 128 + (col & 127)) : Q + (size_t)row * 1024 + col;
                    *(u32x2*)p = (u32x2){pack4_f8(v0[0], v0[1], v0[2], v0[3]), pack4_f8(v1[0], v1[1], v1[2], v1[3])}; }
                __builtin_amdgcn_sched_barrier(0); }
    }
};
struct StoreQKboth {
    static constexpr bool PERM = true;
    StoreQK b16; unsigned char* Q8; unsigned char* KT8;
    __device__ __forceinline__ void operator()(const f32x4 (&acc)[2][2][4][2], const Unit& u, int wr, int wc, int fr, int fq) const {
        b16(acc, u, wr, wc, fr, fq);
        const int row0 = u.pm * 256 + wr * 64 + fr, col0 = u.pn * 256 + wc * 32 + 8 * fq;
        const bool isk = (u.pn >= 4);
        const float sc = isk ? att::D8_KS : att::MB8_QS;
#pragma unroll
        for (int ai = 0; ai < 2; ++ai)
#pragma unroll
            for (int m = 0; m < 4; ++m) { const int row = row0 + ai * 128 + m * 16;
#pragma unroll
                for (int bj = 0; bj < 2; ++bj) { const f32x4 v0 = acc[ai][bj][m][0] * sc, v1 = acc[ai][bj][m][1] * sc; const int col = col0 + bj * 128;
                    unsigned char* p = isk ? KT8 + ((((size_t)((col - 1024) >> 7) * 256 + (row >> 6)) * 64 + (row & 63)) * 128 + (col & 127)) : Q8 + (size_t)row * 1024 + col;
                    *(u32x2*)p = (u32x2){pack4_f8(v0[0], v0[1], v0[2], v0[3]), pack4_f8(v1[0], v1[1], v1[2], v1[3])}; }
                __builtin_amdgcn_sched_barrier(0); }
    }
};
struct StoreVT8 {
    static constexpr int PERM = 2;
    unsigned char* VT; float vs;
    __device__ __forceinline__ void operator()(const f32x4 (&acc)[2][2][4][2], const Unit& u, int wr, int wc, int fr, int fq) const {
        const int row0 = u.pm * 256 + wr * 64 + fr, tok = u.pn * 256 + wc * 64 + 16 * fq, k = tok & 63;
#pragma unroll
        for (int ai = 0; ai < 2; ++ai)
#pragma unroll
            for (int m = 0; m < 4; ++m) { const int f = row0 + ai * 128 + m * 16;
                const f32x4 a0 = acc[ai][0][m][0], a1 = acc[ai][0][m][1], b0 = acc[ai][1][m][0], b1 = acc[ai][1][m][1];
                unsigned char* p = VT + ((((size_t)(f >> 7) * 256 + (tok >> 6)) * 128 + (f & 127)) * 64 + (k >> 5) * 16 + ((k & 31) >> 3) * 4);
                *(u32x2*)p = (u32x2){pack4_f8(a0[0], a0[1], a0[2], a0[3]), pack4_f8(b0[0], b0[1], b0[2], b0[3])};
                *(u32x2*)(p + 32) = (u32x2){pack4_f8(a1[0], a1[1], a1[2], a1[3]), pack4_f8(b1[0], b1[1], b1[2], b1[3])};
                __builtin_amdgcn_sched_barrier(0); }
    }
};
struct StoreVT {
    static constexpr bool PERM = true;
    bf16_t* VT;
    __device__ __forceinline__ void operator()(const f32x4 (&acc)[2][2][4][2], const Unit& u, int wr, int wc, int fr, int fq) const {
        const int row0 = u.pm * 256 + wr * 64 + fr, col0 = u.pn * 256 + wc * 32 + 8 * fq;
#pragma unroll
        for (int ai = 0; ai < 2; ++ai)
#pragma unroll
            for (int m = 0; m < 4; ++m) { const int f = row0 + ai * 128 + m * 16;
#pragma unroll
                for (int bj = 0; bj < 2; ++bj) { const f32x4 v0 = acc[ai][bj][m][0] * DS2, v1 = acc[ai][bj][m][1] * DS2; const int tok = col0 + bj * 128;
                    u32x4 w; w.x = cvtpk(v0[0], v0[1]); w.y = cvtpk(v0[2], v0[3]); w.z = cvtpk(v1[0], v1[1]); w.w = cvtpk(v1[2], v1[3]);
                    *(u32x4*)(VT + ((((size_t)(f >> 7) * 256 + (tok >> 6)) * 128 + (f & 127)) * 64 + (tok & 63))) = w; } }
    }
};
#define P2W_VALS(SC) const f32x4 v0 = acc[ai][0][m][0] * (SC), v1 = acc[ai][0][m][1] * (SC), v2 = acc[ai][1][m][0] * (SC), v3 = acc[ai][1][m][1] * (SC)
#define P2W_PACK8() ((u32x4){pack4_f8(v0[0], v0[1], v0[2], v0[3]), pack4_f8(v1[0], v1[1], v1[2], v1[3]), pack4_f8(v2[0], v2[1], v2[2], v2[3]), pack4_f8(v3[0], v3[1], v3[2], v3[3])})
struct StoreQK8w {
    unsigned char* Q; unsigned char* KT; float qs;
    __device__ __forceinline__ void operator()(const f32x4 (&acc)[2][2][4][2], const Unit& u, int wr, int wc, int fr, int fq) const {
        const int row0 = u.pm * 256 + wr * 64 + fr, col = u.pn * 256 + wc * 64 + 16 * fq; const bool isk = (u.pn >= 4); const float sc = isk ? 1.0f : qs;
#pragma unroll
        for (int ai = 0; ai < 2; ++ai)
#pragma unroll
            for (int m = 0; m < 4; ++m) { const int row = row0 + ai * 128 + m * 16; P2W_VALS(sc);
                unsigned char* p = isk ? KT + ((((size_t)((col - 1024) >> 7) * 256 + (row >> 6)) * 64 + (row & 63)) * 128 + (col & 127)) : Q + (size_t)row * 1024 + col;
                *(u32x4*)p = P2W_PACK8(); }
    }
};
struct StoreQKbothw {
    bf16_t* Q; bf16_t* KT; unsigned char* Q8; unsigned char* KT8;
    __device__ __forceinline__ void operator()(const f32x4 (&acc)[2][2][4][2], const Unit& u, int wr, int wc, int fr, int fq) const {
        const int row0 = u.pm * 256 + wr * 64 + fr, col = u.pn * 256 + wc * 64 + 16 * fq; const bool isk = (u.pn >= 4); const float sc = isk ? att::D8_KS : att::MB8_QS;
#pragma unroll
        for (int ai = 0; ai < 2; ++ai)
#pragma unroll
            for (int m = 0; m < 4; ++m) { const int row = row0 + ai * 128 + m * 16;
                const size_t koff = (((size_t)((col - 1024) >> 7) * 256 + (row >> 6)) * 64 + (row & 63)) * 128 + (col & 127), qoff = (size_t)row * 1024 + col;
                { P2W_VALS(1.0f); bf16_t* p = isk ? KT + koff : Q + qoff;
                  *(u32x4*)p = (u32x4){cvtpk(v0[0], v0[1]), cvtpk(v0[2], v0[3]), cvtpk(v1[0], v1[1]), cvtpk(v1[2], v1[3])};
                  *(u32x4*)(p + 8) = (u32x4){cvtpk(v2[0], v2[1]), cvtpk(v2[2], v2[3]), cvtpk(v3[0], v3[1]), cvtpk(v3[2], v3[3])}; }
                { P2W_VALS(sc); unsigned char* p = isk ? KT8 + koff : Q8 + qoff; *(u32x4*)p = P2W_PACK8(); }
                __builtin_amdgcn_sched_barrier(0); }
    }
};
struct GatesW {
    unsigned char* O;
    __device__ __forceinline__ void operator()(const f32x4 (&acc)[2][2][4][2], const Unit& u, int wr, int wc, int fr, int fq) const {
        const int row0 = u.pm * 256 + wr * 64 + fr, col = u.pn * 256 + wc * 64 + 16 * fq;
#pragma unroll
        for (int ai = 0; ai < 2; ++ai)
#pragma unroll
            for (int m = 0; m < 4; ++m) { const int row = row0 + ai * 128 + m * 16;
                f32x4 v0 = acc[ai][0][m][0], v1 = acc[ai][0][m][1], v2 = acc[ai][1][m][0], v3 = acc[ai][1][m][1];
#pragma unroll
                for (int j = 0; j < 4; ++j) { v0[j] = sigmoidf_(v0[j]) * F8_SGATE; v1[j] = sigmoidf_(v1[j]) * F8_SGATE; v2[j] = sigmoidf_(v2[j]) * F8_SGATE; v3[j] = sigmoidf_(v3[j]) * F8_SGATE; }
                *(u32x4*)(O + (size_t)row * 4096 + col) = P2W_PACK8(); }
    }
};
#undef P2W_VALS
struct ProjEpi {
    static constexpr int PERM = 2; static constexpr bool HAS_MID = false;
    StoreQK8w qkd; StoreQKbothw qkm; GatesW gates;
    __device__ __forceinline__ int f8exp(const Unit& u) const { return (u.pn >= 4 && u.pn < 8) ? P2_EXP - 2 : P2_EXP; }
    __device__ __forceinline__ void operator()(const f32x4 (&acc)[2][2][4][2], const Unit& u, int wr, int wc, int fr, int fq) const {
        Unit v = u;
        if (u.pn < 8) qkd(acc, v, wr, wc, fr, fq);
        else if (u.pn < 16) { v.pn = u.pn - 8; qkm(acc, v, wr, wc, fr, fq); }
        else { v.pn = u.pn - 16; gates(acc, v, wr, wc, fr, fq); }
    }
};
struct ProjVT {
    static constexpr int PERM = 2; static constexpr bool HAS_MID = false;
    StoreVT8 vd; StoreVT8 vm;
    __device__ __forceinline__ int f8exp(const Unit& u) const { return P2_EXP - 3; }
    __device__ __forceinline__ void operator()(const f32x4 (&acc)[2][2][4][2], const Unit& u, int wr, int wc, int fr, int fq) const {
        Unit v = u;
        if (u.pm < 4) vd(acc, v, wr, wc, fr, fq); else { v.pm = u.pm - 4; vm(acc, v, wr, wc, fr, fq); }
    }
};
struct GatePair {
    static constexpr int PERM = 2; static constexpr bool HAS_MID = false;
    GateMul<0> e0; GateMul<1> e1;
    __device__ __forceinline__ int f8exp(const Unit& u) const { return u.aux == 0 ? 9 + 8 : 11 + 8; }
    __device__ __forceinline__ void operator()(const f32x4 (&acc)[2][2][4][2], const Unit& u, int wr, int wc, int fr, int fq) const {
        if (u.aux == 0) e0(acc, u, wr, wc, fr, fq); else e1(acc, u, wr, wc, fr, fq);
    }
};
struct ResidBf16 {
    static constexpr int PERM = 2; static constexpr bool HAS_MID = false;
    const float* base; bf16_t* out; const float* gate; int goff;
    __device__ __forceinline__ int f8exp(const Unit&) const { return 10; }
    __device__ __forceinline__ void operator()(const f32x4 (&acc)[2][2][4][2], const Unit& u, int wr, int wc, int fr, int fq) const {
        const int row0 = u.pm * 256 + wr * 64 + fr, col = u.pn * 256 + wc * 64 + 16 * fq;
        const int b = (u.pm * 256) / SEQ;
        const float* gp = gate + (size_t)b * 12288 + goff + col;
        const f32x4 g0 = *(const f32x4*)gp, g1 = *(const f32x4*)(gp + 4), g2 = *(const f32x4*)(gp + 8), g3 = *(const f32x4*)(gp + 12);
#pragma unroll
        for (int ai = 0; ai < 2; ++ai)
#pragma unroll
            for (int m = 0; m < 4; ++m) { const size_t off = (size_t)(row0 + ai * 128 + m * 16) * 2048 + col;
                const f32x4 b0 = *(const f32x4*)(base + off), b1 = *(const f32x4*)(base + off + 4), b2 = *(const f32x4*)(base + off + 8), b3 = *(const f32x4*)(base + off + 12);
                const f32x4 v0 = b0 + g0 * acc[ai][0][m][0], v1 = b1 + g1 * acc[ai][0][m][1], v2 = b2 + g2 * acc[ai][1][m][0], v3 = b3 + g3 * acc[ai][1][m][1];
                *(u32x4*)(out + off) = (u32x4){cvtpk(v0[0], v0[1]), cvtpk(v0[2], v0[3]), cvtpk(v1[0], v1[1]), cvtpk(v1[2], v1[3])};
                *(u32x4*)(out + off + 8) = (u32x4){cvtpk(v2[0], v2[1]), cvtpk(v2[2], v2[3]), cvtpk(v3[0], v3[1]), cvtpk(v3[2], v3[3])}; }
    }
};
}
namespace att {
constexpr int KROW = 272;
constexpr int VROW = 144;
constexpr int KBUF = 64 * KROW;
constexpr int VBUF = 128 * VROW;
constexpr int OFF_K = 0, OFF_V = 2 * KBUF, OFF_TAB = OFF_V + 2 * VBUF, OFF_G = OFF_TAB + 512, OFF_END = OFF_G + 512;
static_assert(OFF_END <= RING_BYTES, "attention LDS");
__device__ __forceinline__ int crow(int i, int hh) { return (i & 3) + 8 * (i >> 2) + 4 * hh; }

__device__ __forceinline__ int t5_bucket(int n) {
    if (n < 16) return n;
    int b = 16;
    b += (n >= 19); b += (n >= 21); b += (n >= 24); b += (n >= 27); b += (n >= 31); b += (n >= 35); b += (n >= 40); b += (n >= 46);
    b += (n >= 52); b += (n >= 59); b += (n >= 67); b += (n >= 77); b += (n >= 87); b += (n >= 99); b += (n >= 113);
    return b;
}
__device__ __forceinline__ void fill_bias_tab(LAS float* tab, const float* rel_bias, int col) {
    if (threadIdx.x < 128) { const int n = threadIdx.x; tab[n] = (rel_bias[t5_bucket(n) * 16 + col] - rel_bias[31 * 16 + col]) * LOG2E; }
}

struct TileRegs { u32x4 k[2]; u32x4 v[2]; };
__device__ __forceinline__ void tile_load(TileRegs& R, const bf16_t* kt, const bf16_t* vt, int tid) {
#pragma unroll
    for (int i = 0; i < 2; ++i) { const int c = tid + 512 * i; R.k[i] = *(const u32x4*)(kt + c * 8); }
#pragma unroll
    for (int i = 0; i < 2; ++i) { const int c = tid + 512 * i; R.v[i] = *(const u32x4*)(vt + c * 8); }
}
__device__ __forceinline__ void tile_store(const TileRegs& R, LAS unsigned char* kb, LAS unsigned char* vb, int tid) {
#pragma unroll
    for (int i = 0; i < 2; ++i) { const int c = tid + 512 * i; *(LAS u32x4*)(kb + (c >> 4) * KROW + (c & 15) * 16) = R.k[i]; }
#pragma unroll
    for (int i = 0; i < 2; ++i) { const int c = tid + 512 * i;
        LAS unsigned char* p = vb + (c >> 3) * VROW + ((c & 7) >> 1) * 32 + (c & 1) * 8;
        *(LAS u32x2*)p = (u32x2){R.v[i].x, R.v[i].y}; *(LAS u32x2*)(p + 16) = (u32x2){R.v[i].z, R.v[i].w}; }
}

template <int NMAP, int KS>
__device__ __forceinline__ void attn_half(const LAS unsigned char* kb, const LAS unsigned char* vb, int kh, const bf16x8 (&qf)[NMAP][KS], f32x16 (&O)[NMAP][4],
                                          float (&mrun)[NMAP], float (&lrun)[NMAP], int qpos, int kvpos0, bool need_mask, bool need_bias, const LAS float* btab, float sc, int r, int hh, int kcolbase) {
    bf16x8 P[NMAP][2];
#pragma unroll
    for (int m = 0; m < NMAP; ++m) {
        f32x16 s;
#pragma unroll
        for (int i = 0; i < 16; ++i) s[i] = 0.f;
#pragma unroll
        for (int ks = 0; ks < KS; ++ks) {
            const bf16x8 kf = *(const LAS bf16x8*)(kb + (32 * kh + r) * KROW + (kcolbase + m * 16 * KS + 16 * ks + 8 * hh) * 2);
            s = __builtin_amdgcn_mfma_f32_32x32x16_bf16(kf, qf[m][ks], s, 0, 0, 0);
        }
#pragma unroll
        for (int i = 0; i < 16; ++i) s[i] *= sc;
        if (need_bias) {
#pragma unroll
            for (int i = 0; i < 16; ++i) { int rel = qpos - (kvpos0 + crow(i, hh)); rel = rel < 0 ? 0 : (rel > 127 ? 127 : rel); s[i] += btab[rel]; }
        }
        if (need_mask) {
#pragma unroll
            for (int i = 0; i < 16; ++i) { if (kvpos0 + crow(i, hh) > qpos) s[i] = -INFINITY; }
        }
        float mx = s[0];
#pragma unroll
        for (int i = 1; i < 16; ++i) mx = fmaxf(mx, s[i]);
        mx = fmaxf(mx, __shfl_xor(mx, 32));
        const float mnew = fmaxf(mrun[m], mx);
        const float alpha = fast_exp2(mrun[m] - mnew);
        float sum = 0.f;
#pragma unroll
        for (int i = 0; i < 16; ++i) { const float p = fast_exp2(s[i] - mnew); sum += p; s[i] = p; }
        lrun[m] = lrun[m] * alpha + sum; mrun[m] = mnew;
#pragma unroll
        for (int dt = 0; dt < 4; ++dt)
#pragma unroll
            for (int i = 0; i < 16; ++i) O[m][dt][i] *= alpha;
#pragma unroll
        for (int st = 0; st < 2; ++st) { u32x4 w; w.x = cvtpk(s[8 * st + 0], s[8 * st + 1]); w.y = cvtpk(s[8 * st + 2], s[8 * st + 3]); w.z = cvtpk(s[8 * st + 4], s[8 * st + 5]); w.w = cvtpk(s[8 * st + 6], s[8 * st + 7]);
            P[m][st] = __builtin_bit_cast(bf16x8, w); }
    }
#pragma unroll
    for (int dt = 0; dt < 4; ++dt)
#pragma unroll
        for (int st = 0; st < 2; ++st) {
            const bf16x8 vf = *(const LAS bf16x8*)(vb + (32 * dt + r) * VROW + (2 * kh + st) * 32 + hh * 16);
#pragma unroll
            for (int m = 0; m < NMAP; ++m) O[m][dt] = __builtin_amdgcn_mfma_f32_32x32x16_bf16(vf, P[m][st], O[m][dt], 0, 0, 0);
        }
}

#define SBAR() __builtin_amdgcn_sched_barrier(0)
constexpr int TBUF = KBUF + VBUF;
constexpr int D_OFF_TAB = 3 * TBUF, D_OFF_G = D_OFF_TAB + 512;
static_assert(D_OFF_G + 512 <= RING_BYTES, "diff attention LDS");
constexpr float D_C = 0.125f * LOG2E;
__device__ __forceinline__ void d_load_kf(bf16x8 (&kf)[4], const LAS unsigned char* kb, int kh, int r, int hh, int kcol) {
#pragma unroll
    for (int ks = 0; ks < 4; ++ks) kf[ks] = *(const LAS bf16x8*)(kb + (32 * kh + r) * KROW + (kcol + 16 * ks + 8 * hh) * 2);
}
constexpr float D_THR = 8.0f;
__device__ __forceinline__ float max3_(float a, float b, float c) { float r; asm("v_max3_f32 %0, %1, %2, %3" : "=v"(r) : "v"(a), "v"(b), "v"(c)); return r; }
template <int MODE, bool LOADV, bool PREFK>
__device__ __forceinline__ void d_half_a(const bf16x8 (&kf)[4], bf16x8 (&kfn)[4], const LAS unsigned char* knext, int khn, const LAS unsigned char* vb, int kh,
                                         const bf16x8 (&qf)[4], f32x16 (&o)[4], float& mref, float& lrun, int qpos, int kvpos0, bool need_mask, bool need_bias, bool first,
                                         const LAS float* btab, int r, int hh, int kcol, bf16x8 (&vf)[4], bf16x8 (&P)[2]) {
    if (LOADV) {
#pragma unroll
        for (int dt = 0; dt < 2; ++dt)
#pragma unroll
            for (int st = 0; st < 2; ++st) vf[2 * dt + st] = *(const LAS bf16x8*)(vb + (32 * dt + r) * VROW + (2 * kh + st) * 32 + hh * 16);
    }
    SBAR();
    f32x16 s;
#pragma unroll
    for (int i = 0; i < 16; ++i) s[i] = 0.f;
    __builtin_amdgcn_s_setprio(1);
#pragma unroll
    for (int ks = 0; ks < 4; ++ks) { if (MODE != 3) s = __builtin_amdgcn_mfma_f32_32x32x16_bf16(kf[ks], qf[ks], s, 0, 0, 0); else { s[ks] += __builtin_bit_cast(float, (int)kf[ks][0]); s[4 + ks] += __builtin_bit_cast(float, (int)qf[ks][1]); } }
    __builtin_amdgcn_s_setprio(0);
    if (PREFK) d_load_kf(kfn, knext, khn, r, hh, kcol);
    SBAR();
    if (MODE == 4) { P[0] = qf[0]; P[1] = qf[1]; mref = fmaxf(mref, s[0]); } else {
    if (need_bias) {
#pragma unroll
        for (int i = 0; i < 16; ++i) { int rel = qpos - (kvpos0 + crow(i, hh)); rel = rel < 0 ? 0 : (rel > 127 ? 127 : rel); s[i] += btab[rel]; }
    }
    if (need_mask) {
#pragma unroll
        for (int i = 0; i < 16; ++i) { if (kvpos0 + crow(i, hh) > qpos) s[i] = -INFINITY; }
    }
    float mx = max3_(s[0], s[1], s[2]);
    mx = max3_(mx, s[3], s[4]); mx = max3_(mx, s[5], s[6]); mx = max3_(mx, s[7], s[8]); mx = max3_(mx, s[9], s[10]); mx = max3_(mx, s[11], s[12]); mx = max3_(mx, s[13], s[14]);
    { auto rr = __builtin_amdgcn_permlane32_swap(__float_as_uint(mx), __float_as_uint(mx), false, false); mx = max3_(s[15], __uint_as_float(rr[0]), __uint_as_float(rr[1])); }
    if (first || __any(mx - mref > D_THR)) {
        const float mn = first ? mx : fmaxf(mref, mx);
        const float alpha = first ? 0.f : fast_exp2(mref - mn);
        mref = mn; lrun *= alpha;
#pragma unroll
        for (int dt = 0; dt < 4; ++dt)
#pragma unroll
            for (int i = 0; i < 16; ++i) o[dt][i] *= alpha;
    }
    float sum = 0.f;
#pragma unroll
    for (int i = 0; i < 16; ++i) { const float p = fast_exp2(s[i] - mref); sum += p; s[i] = p; }
    lrun += sum;
#pragma unroll
    for (int st = 0; st < 2; ++st) { u32x4 w; w.x = cvtpk(s[8 * st + 0], s[8 * st + 1]); w.y = cvtpk(s[8 * st + 2], s[8 * st + 3]); w.z = cvtpk(s[8 * st + 4], s[8 * st + 5]); w.w = cvtpk(s[8 * st + 6], s[8 * st + 7]);
        P[st] = __builtin_bit_cast(bf16x8, w); }
    }
}
template <int MODE, bool LOADV>
__device__ __forceinline__ void d_half_b(f32x16 (&o)[4], bf16x8 (&vf)[4], const bf16x8 (&P)[2], const LAS unsigned char* vb, int kh, int r, int hh) {
    if (LOADV) {
#pragma unroll
        for (int dt = 0; dt < 2; ++dt)
#pragma unroll
            for (int st = 0; st < 2; ++st) vf[2 * dt + st] = *(const LAS bf16x8*)(vb + (32 * dt + r) * VROW + (2 * kh + st) * 32 + hh * 16);
    }
    bf16x8 vg[4];
#pragma unroll
    for (int dt = 2; dt < 4; ++dt)
#pragma unroll
        for (int st = 0; st < 2; ++st) vg[2 * (dt - 2) + st] = *(const LAS bf16x8*)(vb + (32 * dt + r) * VROW + (2 * kh + st) * 32 + hh * 16);
    asm volatile("s_waitcnt lgkmcnt(4)" ::: "memory"); SBAR();
    __builtin_amdgcn_s_setprio(1);
#pragma unroll
    for (int dt = 0; dt < 2; ++dt)
#pragma unroll
        for (int st = 0; st < 2; ++st) {
            if (MODE != 3) o[dt] = __builtin_amdgcn_mfma_f32_32x32x16_bf16(vf[2 * dt + st], P[st], o[dt], 0, 0, 0);
            else o[dt][st] += __builtin_bit_cast(float, (int)vf[2 * dt + st][0]) * __builtin_bit_cast(float, (int)P[st][0]);
        }
    asm volatile("s_waitcnt lgkmcnt(0)" ::: "memory"); SBAR();
#pragma unroll
    for (int dt = 2; dt < 4; ++dt)
#pragma unroll
        for (int st = 0; st < 2; ++st) {
            if (MODE != 3) o[dt] = __builtin_amdgcn_mfma_f32_32x32x16_bf16(vg[2 * (dt - 2) + st], P[st], o[dt], 0, 0, 0);
            else o[dt][st] += __builtin_bit_cast(float, (int)vg[2 * (dt - 2) + st][0]) * __builtin_bit_cast(float, (int)P[st][0]);
        }
    __builtin_amdgcn_s_setprio(0);
}
template <int MODE>
__device__ __forceinline__ void diff_unit(LAS unsigned char* lds, int b, int h, int qt, const bf16_t* QD, const bf16_t* KDT, const bf16_t* VDT, bf16_t* AD, const float* subln, const float* rel_bias) {
    int tid_ = threadIdx.x; asm volatile("" : "+v"(tid_));
    const int tid = tid_, lane = tid & 63, r = lane & 31, hh = lane >> 5; const int wid = __builtin_amdgcn_readfirstlane(tid >> 6);
    const int map = wid >> 2, qsub = wid & 3;
    const int q0 = qt * 128, qw0 = q0 + 32 * qsub, qpos = qw0 + r;
    const size_t tok0 = (size_t)b * SEQ;
    const LAS float* btab = (const LAS float*)(lds + D_OFF_TAB);
    const LAS float* gtab = (const LAS float*)(lds + D_OFF_G);
    const int kcol = map * 64;
    bf16x8 qf[4];
#pragma unroll
    for (int ks = 0; ks < 4; ++ks) qf[ks] = *(const bf16x8*)(QD + (tok0 + qpos) * 1024 + h * 128 + map * 64 + 16 * ks + 8 * hh);
    f32x16 o[4];
#pragma unroll
    for (int dt = 0; dt < 4; ++dt)
#pragma unroll
        for (int i = 0; i < 16; ++i) o[dt][i] = 0.f;
    float mrun = 0.f, lrun = 0.f;
    const bf16_t* kbase = KDT + ((size_t)h * 256 + b * 128) * 8192;
    const bf16_t* vbase = VDT + ((size_t)h * 256 + b * 128) * 8192;
    const int NT = 2 * (qt + 1);
    TileRegs R;
    bf16x8 kfa[4], kfb[4];
    __syncthreads();
    fill_bias_tab((LAS float*)(lds + D_OFF_TAB), rel_bias, h);
    if (tid < 128) ((LAS float*)(lds + D_OFF_G))[tid] = subln[tid];
    tile_load(R, kbase, vbase, tid);
    tile_store(R, lds, lds + KBUF, tid);
    tile_load(R, kbase + 8192, vbase + 8192, tid);
    __syncthreads();
    if (MODE != 2) d_load_kf(kfa, lds, 0, r, hh, kcol);
    int bc = 0;
    bf16x8 vf[4], P[2];
#define D_STAGE() do { if (t + 1 < NT) tile_store(R, lds + bn * TBUF, lds + bn * TBUF + KBUF, tid); \
        if (t + 2 < NT) tile_load(R, kbase + (size_t)(MODE == 1 ? 0 : t + 2) * 8192, vbase + (size_t)(MODE == 1 ? 0 : t + 2) * 8192, tid); \
        __syncthreads(); } while (0)
    if (wid < 4) {
#pragma unroll 1
        for (int t = 0; t < NT; ++t) {
            const int bn = (bc == 2) ? 0 : bc + 1;
            const LAS unsigned char* kb = lds + bc * TBUF; const LAS unsigned char* vb = kb + KBUF;
            const int k0 = 64 * t;
            { const bool nm = (k0 + 31 > qw0), nb = (qw0 - (k0 + 31) < 113);
              if (MODE != 2) { d_half_a<MODE, true, true>(kfa, kfb, kb, 1, vb, 0, qf, o, mrun, lrun, qpos, k0, nm, nb, t == 0, btab, r, hh, kcol, vf, P); d_half_b<MODE, false>(o, vf, P, vb, 0, r, hh); } }
            D_STAGE();
            { const bool nm = (k0 + 63 > qw0), nb = (qw0 - (k0 + 63) < 113);
              if (MODE != 2) { d_half_a<MODE, true, true>(kfb, kfa, lds + bn * TBUF, 0, vb, 1, qf, o, mrun, lrun, qpos, k0 + 32, nm, nb, false, btab, r, hh, kcol, vf, P); d_half_b<MODE, false>(o, vf, P, vb, 1, r, hh); } }
            bc = bn;
        }
    } else {
#pragma unroll 1
        for (int t = 0; t < NT; ++t) {
            const int bn = (bc == 2) ? 0 : bc + 1;
            const LAS unsigned char* kb = lds + bc * TBUF; const LAS unsigned char* vb = kb + KBUF;
            const int k0 = 64 * t;
            { const bool nm = (k0 + 31 > qw0), nb = (qw0 - (k0 + 31) < 113);
              if (MODE != 2) d_half_a<MODE, false, false>(kfa, kfb, kb, 1, vb, 0, qf, o, mrun, lrun, qpos, k0, nm, nb, t == 0, btab, r, hh, kcol, vf, P); }
            D_STAGE();
            if (MODE != 2) { d_half_b<MODE, true>(o, vf, P, vb, 0, r, hh); d_load_kf(kfb, kb, 1, r, hh, kcol); }
            { const bool nm = (k0 + 63 > qw0), nb = (qw0 - (k0 + 63) < 113);
              if (MODE != 2) { d_half_a<MODE, true, true>(kfb, kfa, lds + bn * TBUF, 0, vb, 1, qf, o, mrun, lrun, qpos, k0 + 32, nm, nb, false, btab, r, hh, kcol, vf, P); d_half_b<MODE, false>(o, vf, P, vb, 1, r, hh); } }
            bc = bn;
        }
    }
#undef D_STAGE
    __syncthreads();
    const float l = lrun + __shfl_xor(lrun, 32);
    LAS float* xch = (LAS float*)lds + qsub * 4096 + lane;
    if (map == 1) {
        const float lam = *(const LAS float*)(lds + MISC_OFF + 68);
        const float f = lam / l;
#pragma unroll
        for (int dt = 0; dt < 4; ++dt)
#pragma unroll
            for (int i = 0; i < 16; ++i) xch[(dt * 16 + i) * 64] = o[dt][i] * f;
    }
    __syncthreads();
    if (map == 0) {
        const float i0 = 1.0f / l;
        float ss = 0.f;
#pragma unroll
        for (int dt = 0; dt < 4; ++dt)
#pragma unroll
            for (int i = 0; i < 16; ++i) { const float v = o[dt][i] * i0 - xch[(dt * 16 + i) * 64]; o[dt][i] = v; ss += v * v; }
        ss += __shfl_xor(ss, 32);
        const float rs = 0.8f / sqrtf(ss * (1.0f / 128.0f) + RMS_EPS);
        bf16_t* orow = AD + (tok0 + qpos) * 1024 + h * 128;
#pragma unroll
        for (int dt = 0; dt < 4; ++dt)
#pragma unroll
            for (int g = 0; g < 4; ++g) { const int d = 32 * dt + 8 * g + 4 * hh;
                const f32x4 gg = *(const LAS f32x4*)(gtab + d);
                u32x2 w; w.x = cvtpk(o[dt][4 * g + 0] * rs * gg[0], o[dt][4 * g + 1] * rs * gg[1]); w.y = cvtpk(o[dt][4 * g + 2] * rs * gg[2], o[dt][4 * g + 3] * rs * gg[3]);
                *(u32x2*)(orow + d) = w; }
    }
}

constexpr int KROW8 = 144, VROW8 = 80, KBUF8 = 64 * KROW8, VBUF8 = 128 * VROW8, TBUF8 = KBUF8 + VBUF8;
static_assert(4 * TBUF8 <= D_OFF_TAB, "fp8 diff attention LDS");
constexpr float D8_C = 1.0f / 64.0f, D8_THR = 3.0f * 64.0f, D8_SH = 5.0f;
struct TileRegs8 { u32x4 k, v; };
__device__ __forceinline__ void tile_load8(TileRegs8& R, const unsigned char* kt, const unsigned char* vt, int tid) { R.k = *(const u32x4*)(kt + tid * 16); R.v = *(const u32x4*)(vt + tid * 16); }
__device__ __forceinline__ void tile_store8(const TileRegs8& R, LAS unsigned char* kb, LAS unsigned char* vb, int tid) {
    *(LAS u32x4*)(kb + (tid >> 3) * KROW8 + (tid & 7) * 16) = R.k; *(LAS u32x4*)(vb + (tid >> 2) * VROW8 + (tid & 3) * 16) = R.v; }
__device__ __forceinline__ i32x8 cat8(const i32x4 a, const i32x4 b) { return __builtin_shufflevector(a, b, 0, 1, 2, 3, 4, 5, 6, 7); }
__device__ __forceinline__ void d8_load_kf(i32x8 (&kf)[2], const LAS unsigned char* kb, int r, int hh, int kcolb) {
#pragma unroll
    for (int kh = 0; kh < 2; ++kh) { const LAS unsigned char* q = kb + (32 * kh + r) * KROW8 + kcolb + 32 * hh; kf[kh] = cat8(*(const LAS i32x4*)q, *(const LAS i32x4*)(q + 16)); }
}
template <int DT0>
__device__ __forceinline__ void d8_load_vf2(i32x8 (&vf)[2], const LAS unsigned char* vb, int r, int hh) {
#pragma unroll
    for (int dt = 0; dt < 2; ++dt) { const LAS unsigned char* q = vb + (32 * (DT0 + dt) + r) * VROW8 + 32 * hh; vf[dt] = cat8(*(const LAS i32x4*)q, *(const LAS i32x4*)(q + 16)); }
}
__device__ __forceinline__ void d8_scores(f32x16& s0, f32x16& s1, const i32x8 (&kf)[2], const i32x8& qf) {
    f32x16 z;
#pragma unroll
    for (int i = 0; i < 16; ++i) z[i] = 0.f;
    __builtin_amdgcn_s_setprio(1);
    s0 = __builtin_amdgcn_mfma_scale_f32_32x32x64_f8f6f4(kf[0], qf, z, 0, 0, 0, 0x7F7F7F7F, 0, 0x7F7F7F7F);
    s1 = __builtin_amdgcn_mfma_scale_f32_32x32x64_f8f6f4(kf[1], qf, z, 0, 0, 0, 0x7F7F7F7F, 0, 0x7F7F7F7F);
    __builtin_amdgcn_s_setprio(0);
}
template <bool ROW = false>
__device__ __forceinline__ i32x8 d8_softmax(f32x16& s0, f32x16& s1, f32x16 (&o)[4], float& mref, float& lrun, int qpos, int k0, bool need_mask, bool need_bias, bool first, const LAS float* btab, int hh) {
    if (need_bias) {
#pragma unroll
        for (int i = 0; i < 16; ++i) { int rel = qpos - (k0 + crow(i, hh)); rel = rel < 0 ? 0 : (rel > 127 ? 127 : rel); s0[i] += btab[rel]; }
        SBAR();
#pragma unroll
        for (int i = 0; i < 16; ++i) { int rel = qpos - (k0 + 32 + crow(i, hh)); rel = rel < 0 ? 0 : (rel > 127 ? 127 : rel); s1[i] += btab[rel]; }
        SBAR();
    }
    if (need_mask) {
#pragma unroll
        for (int i = 0; i < 16; ++i) { if (k0 + crow(i, hh) > qpos) s0[i] = -INFINITY; if (k0 + 32 + crow(i, hh) > qpos) s1[i] = -INFINITY; }
    }
    float mx = max3_(s0[0], s0[1], s0[2]);
#pragma unroll
    for (int i = 3; i < 15; i += 2) mx = max3_(mx, s0[i], s0[i + 1]);
    mx = max3_(mx, s0[15], s1[0]);
#pragma unroll
    for (int i = 1; i < 15; i += 2) mx = max3_(mx, s1[i], s1[i + 1]);
    { auto rr = __builtin_amdgcn_permlane32_swap(__float_as_uint(mx), __float_as_uint(mx), false, false); mx = max3_(s1[15], __uint_as_float(rr[0]), __uint_as_float(rr[1])); }
    if constexpr (ROW) {
        const bool up = (mx - mref > D8_THR);
        if (__any(up)) {
            const float alpha = up ? fast_exp2((mref - mx) * D8_C) : 1.0f;
            if (up) mref = mx;
            lrun *= alpha;
            asm volatile("s_nop 15\n\ts_nop 15" ::: "memory");
#pragma unroll
            for (int dt = 0; dt < 4; ++dt)
#pragma unroll
                for (int i = 0; i < 16; ++i) o[dt][i] *= alpha;
        }
    } else
    if (first || __any(mx - mref > D8_THR)) {
        const float mn = first ? mx : fmaxf(mref, mx);
        const float alpha = first ? 0.f : fast_exp2((mref - mn) * D8_C);
        mref = mn; lrun *= alpha;
        asm volatile("s_nop 15\n\ts_nop 15" ::: "memory");
#pragma unroll
        for (int dt = 0; dt < 4; ++dt)
#pragma unroll
            for (int i = 0; i < 16; ++i) o[dt][i] *= alpha;
    }
    const float off = D8_SH - mref * D8_C;
    float sum0 = 0.f, sum1 = 0.f;
    i32x8 P;
    const f32x2 c2 = {D8_C, D8_C}, off2 = {off, off};
    f32x2 sum2 = {0.f, 0.f};
#pragma unroll
    for (int g = 0; g < 4; ++g) {
        const f32x2 a0 = __builtin_elementwise_fma((f32x2){s0[4 * g], s0[4 * g + 1]}, c2, off2), a1 = __builtin_elementwise_fma((f32x2){s0[4 * g + 2], s0[4 * g + 3]}, c2, off2);
        const f32x2 b0 = __builtin_elementwise_fma((f32x2){s1[4 * g], s1[4 * g + 1]}, c2, off2), b1 = __builtin_elementwise_fma((f32x2){s1[4 * g + 2], s1[4 * g + 3]}, c2, off2);
        const f32x2 e0 = {fast_exp2(a0[0]), fast_exp2(a0[1])}, e1 = {fast_exp2(a1[0]), fast_exp2(a1[1])}, f0 = {fast_exp2(b0[0]), fast_exp2(b0[1])}, f1 = {fast_exp2(b1[0]), fast_exp2(b1[1])};
        sum2 += (e0 + e1) + (f0 + f1);
        int w0 = __builtin_amdgcn_cvt_pk_fp8_f32(e0[0], e0[1], 0, false); w0 = __builtin_amdgcn_cvt_pk_fp8_f32(e1[0], e1[1], w0, true);
        int w1 = __builtin_amdgcn_cvt_pk_fp8_f32(f0[0], f0[1], 0, false); w1 = __builtin_amdgcn_cvt_pk_fp8_f32(f1[0], f1[1], w1, true);
        P[g] = w0; P[4 + g] = w1; }
    sum0 = sum2[0]; sum1 = sum2[1];
    lrun += sum0 + sum1;
    return P;
}
__device__ __forceinline__ void d8_pv(f32x16 (&o)[4], const i32x8 (&va)[2], const i32x8& P, const LAS unsigned char* vb, int r, int hh) {
    i32x8 vg[2];
    d8_load_vf2<2>(vg, vb, r, hh);
    asm volatile("s_waitcnt lgkmcnt(4)" ::: "memory"); SBAR();
    __builtin_amdgcn_s_setprio(1);
#pragma unroll
    for (int dt = 0; dt < 2; ++dt) asm volatile("v_mfma_scale_f32_32x32x64_f8f6f4 %0, %1, %2, %0, %3, %3 op_sel_hi:[0,0,0]" : "+v"(o[dt]) : "v"(va[dt]), "v"(P), "v"(0x7F7F7F7F));
    asm volatile("s_waitcnt lgkmcnt(0)" ::: "memory"); SBAR();
#pragma unroll
    for (int dt = 0; dt < 2; ++dt) asm volatile("v_mfma_scale_f32_32x32x64_f8f6f4 %0, %1, %2, %0, %3, %3 op_sel_hi:[0,0,0]" : "+v"(o[2 + dt]) : "v"(vg[dt]), "v"(P), "v"(0x7F7F7F7F));
    __builtin_amdgcn_s_setprio(0);
}
__device__ __forceinline__ void diff_unit8(LAS unsigned char* lds, int b, int h, int qt, const unsigned char* QD, const unsigned char* KDT, const unsigned char* VDT, bf16_t* AD, const float* subln, const float* rel_bias) {
    int tid_ = threadIdx.x; asm volatile("" : "+v"(tid_));
    const int tid = tid_, lane = tid & 63, r = lane & 31, hh = lane >> 5; const int wid = __builtin_amdgcn_readfirstlane(tid >> 6);
    const int map = wid >> 2, qsub = wid & 3;
    const int q0 = qt * 128, qw0 = q0 + 32 * qsub, qpos = qw0 + r;
    const size_t tok0 = (size_t)b * SEQ;
    const LAS float* btab = (const LAS float*)(lds + D_OFF_TAB);
    const LAS float* gtab = (const LAS float*)(lds + D_OFF_G);
    const int kcolb = map * 64;
    i32x8 qf;
    { const unsigned char* qp = QD + (tok0 + qpos) * 1024 + h * 128 + map * 64 + 32 * hh; qf = cat8(*(const i32x4*)qp, *(const i32x4*)(qp + 16)); }
    f32x16 o[4];
#pragma unroll
    for (int dt = 0; dt < 4; ++dt)
#pragma unroll
        for (int i = 0; i < 16; ++i) o[dt][i] = 0.f;
    float mrun = 0.f, lrun = 0.f;
    const unsigned char* kbase = KDT + ((size_t)h * 256 + b * 128) * 8192;
    const unsigned char* vbase = VDT + ((size_t)h * 256 + b * 128) * 8192;
    const int NT = 2 * (qt + 1);
    TileRegs8 R;
    __syncthreads();
    if (tid < 128) { const int n = tid; ((LAS float*)(lds + D_OFF_TAB))[n] = (rel_bias[t5_bucket(n) * 16 + h] - rel_bias[31 * 16 + h]) * (LOG2E * 64.0f); ((LAS float*)(lds + D_OFF_G))[n] = subln[n]; }
    tile_load8(R, kbase, vbase, tid); tile_store8(R, lds, lds + KBUF8, tid);
    tile_load8(R, kbase + 8192, vbase + 8192, tid); tile_store8(R, lds + TBUF8, lds + TBUF8 + KBUF8, tid);
    if (NT > 2) tile_load8(R, kbase + 2 * 8192, vbase + 2 * 8192, tid);
    __syncthreads();
    i32x8 kf[2], vf[2];
    d8_load_kf(kf, lds, r, hh, kcolb);
#define D8_STAGE(t) do { if ((t) + 2 < NT) tile_store8(R, lds + (((t) + 2) & 3) * TBUF8, lds + (((t) + 2) & 3) * TBUF8 + KBUF8, tid); \
        if ((t) + 3 < NT) tile_load8(R, kbase + (size_t)((t) + 3) * 8192, vbase + (size_t)((t) + 3) * 8192, tid); \
        __syncthreads(); } while (0)
#pragma unroll 1
    for (int t = 0; t < NT; ++t) {
        const int k0 = 64 * t; const LAS unsigned char* tb = lds + (t & 3) * TBUF8;
        f32x16 s0, s1; d8_scores(s0, s1, kf, qf);
        d8_load_vf2<0>(vf, tb + KBUF8, r, hh); d8_load_kf(kf, lds + ((t + 1) & 3) * TBUF8, r, hh, kcolb); SBAR();
        const i32x8 P = d8_softmax(s0, s1, o, mrun, lrun, qpos, k0, (k0 + 63 > qw0), (qw0 - (k0 + 63) < 113), t == 0, btab, hh);
        if (wid >= 4) D8_STAGE(t);
        d8_pv(o, vf, P, tb + KBUF8, r, hh);
        if (wid < 4) D8_STAGE(t);
    }
#undef D8_STAGE
    __syncthreads();
    asm volatile("s_nop 15\n\ts_nop 15\n\ts_nop 15\n\ts_nop 15" ::: "memory");
    const float l = (lrun + __shfl_xor(lrun, 32)) * D8_VS;
    LAS float* xch = (LAS float*)lds + qsub * 4096 + lane;
    if (map == 1) {
        const float lam = *(const LAS float*)(lds + MISC_OFF + 68);
        const float f = lam / l;
#pragma unroll
        for (int dt = 0; dt < 4; ++dt)
#pragma unroll
            for (int i = 0; i < 16; ++i) xch[(dt * 16 + i) * 64] = o[dt][i] * f;
    }
    __syncthreads();
    if (map == 0) {
        const float i0 = 1.0f / l;
        float ss = 0.f;
#pragma unroll
        for (int dt = 0; dt < 4; ++dt)
#pragma unroll
            for (int i = 0; i < 16; ++i) { const float v = o[dt][i] * i0 - xch[(dt * 16 + i) * 64]; o[dt][i] = v; ss += v * v; }
        ss += __shfl_xor(ss, 32);
        const float rs = 0.8f / sqrtf(ss * (1.0f / 128.0f) + RMS_EPS);
        bf16_t* orow = AD + (tok0 + qpos) * 1024 + h * 128;
#pragma unroll
        for (int dt = 0; dt < 4; ++dt)
#pragma unroll
            for (int g = 0; g < 4; ++g) { const int d = 32 * dt + 8 * g + 4 * hh;
                const f32x4 gg = *(const LAS f32x4*)(gtab + d);
                if constexpr (O78F8) { const float r8 = rs * F8_SAD;
                    *(unsigned*)((unsigned char*)AD + (tok0 + qpos) * 1024 + h * 128 + d) = epi::pack4_f8(o[dt][4 * g + 0] * r8 * gg[0], o[dt][4 * g + 1] * r8 * gg[1], o[dt][4 * g + 2] * r8 * gg[2], o[dt][4 * g + 3] * r8 * gg[3]); }
                else { u32x2 w; w.x = cvtpk(o[dt][4 * g + 0] * rs * gg[0], o[dt][4 * g + 1] * rs * gg[1]); w.y = cvtpk(o[dt][4 * g + 2] * rs * gg[2], o[dt][4 * g + 3] * rs * gg[3]);
                *(u32x2*)(orow + d) = w; } }
    }
}

__device__ __forceinline__ void moba_unit(LAS unsigned char* lds, int b, int h, int n, const int* list, int cnt, const bf16_t* QM, const bf16_t* KMT, const bf16_t* VMT, bf16_t* PARTS, float* ML, const float* rel_bias) {
    int tid_ = threadIdx.x; asm volatile("" : "+v"(tid_));
    const int tid = tid_, lane = tid & 63, r = lane & 31, hh = lane >> 5; const int wid = __builtin_amdgcn_readfirstlane(tid >> 6);
    const size_t tok0 = (size_t)b * SEQ;
    const LAS float* btab = (const LAS float*)(lds + OFF_TAB);
    const float sc = 0.08838834764831845f * LOG2E;
    const bool own = (list == nullptr);
    const int li = 32 * wid + r;
    const bool lane_valid = li < cnt;
    int qpos, slot;
    if (own) { qpos = 256 * n + li; slot = 3; }
    else { const int e = list[lane_valid ? li : 0]; qpos = e >> 2; slot = e & 3; }
    const bool wave_active = (32 * wid < cnt);
    bf16x8 qf[1][8];
#pragma unroll
    for (int ks = 0; ks < 8; ++ks) qf[0][ks] = *(const bf16x8*)(QM + (tok0 + qpos) * 1024 + h * 128 + 16 * ks + 8 * hh);
    f32x16 O[1][4];
#pragma unroll
    for (int dt = 0; dt < 4; ++dt)
#pragma unroll
        for (int i = 0; i < 16; ++i) O[0][dt][i] = 0.f;
    float mrun[1] = {-INFINITY}, lrun[1] = {0.f};
    const bf16_t* kbase = KMT + ((size_t)h * 256 + b * 128 + 4 * n) * 8192;
    const bf16_t* vbase = VMT + ((size_t)h * 256 + b * 128 + 4 * n) * 8192;
    const int qw0 = 256 * n + 32 * wid;
    TileRegs R;
    __syncthreads();
    fill_bias_tab((LAS float*)(lds + OFF_TAB), rel_bias, 8 + h);
    tile_load(R, kbase, vbase, tid);
    tile_store(R, lds + OFF_K, lds + OFF_V, tid);
    __syncthreads();
#pragma unroll 1
    for (int t = 0; t < 4; ++t) {
        const int cur = t & 1;
        if (t + 1 < 4) tile_load(R, kbase + (size_t)(t + 1) * 8192, vbase + (size_t)(t + 1) * 8192, tid);
        if (wave_active) {
#pragma unroll 1
            for (int kh = 0; kh < 2; ++kh) {
                const int kp = 256 * n + 64 * t + 32 * kh;
                bool run = true, need_mask = false, need_bias;
                if (own) { run = (kp <= qw0 + 31); need_mask = (kp + 31 > qw0); need_bias = true; }
                else { need_bias = __any(qpos - (kp + 31) < 113); }
                if (run) attn_half<1, 8>(lds + OFF_K + cur * KBUF, lds + OFF_V + cur * VBUF, kh, qf, O, mrun, lrun, qpos, kp, need_mask, need_bias, btab, sc, r, hh, 0);
            }
        }
        if (t + 1 < 4) tile_store(R, lds + OFF_K + (cur ^ 1) * KBUF, lds + OFF_V + (cur ^ 1) * VBUF, tid);
        __syncthreads();
    }
    const float l = lrun[0] + __shfl_xor(lrun[0], 32);
    const float il = 1.0f / l;
    if (lane_valid) {
        const size_t pidx = ((tok0 + qpos) * 8 + h) * 4 + slot;
        bf16_t* orow = PARTS + pidx * 128;
#pragma unroll
        for (int dt = 0; dt < 4; ++dt)
#pragma unroll
            for (int g = 0; g < 4; ++g) { const int d = 32 * dt + 8 * g + 4 * hh;
                u32x2 w; w.x = cvtpk(O[0][dt][4 * g + 0] * il, O[0][dt][4 * g + 1] * il); w.y = cvtpk(O[0][dt][4 * g + 2] * il, O[0][dt][4 * g + 3] * il);
                *(u32x2*)(orow + d) = w; }
        if (hh == 0) *(f32x2*)(ML + pidx * 2) = (f32x2){mrun[0], l};
    }
}
constexpr int MB_K = 0, MB_V = 4 * KBUF, MB_INC = MB_V + 4 * VBUF, MB_TAB = MB_INC + 2048, MB_END = MB_TAB + 512;
static_assert(MB_END <= MISC_OFF, "MoBA block LDS");
__device__ __forceinline__ void moba_block(LAS unsigned char* lds, int b, int h, int n, const int* list, int cntl, int c0, int c1, const bf16_t* QM, const bf16_t* KMT, const bf16_t* VMT, bf16_t* PARTS, float* ML, const float* rel_bias) {
    int tid_ = threadIdx.x; asm volatile("" : "+v"(tid_));
    const int tid = tid_, lane = tid & 63, r = lane & 31, hh = lane >> 5; const int wid = __builtin_amdgcn_readfirstlane(tid >> 6);
    const size_t tok0 = (size_t)b * SEQ;
    const LAS float* btab = (const LAS float*)(lds + MB_TAB);
    const float sc = 0.08838834764831845f * LOG2E;
    const bf16_t* kbase = KMT + ((size_t)h * 256 + b * 128 + 4 * n) * 8192;
    const bf16_t* vbase = VMT + ((size_t)h * 256 + b * 128 + 4 * n) * 8192;
    __syncthreads();
    fill_bias_tab((LAS float*)(lds + MB_TAB), rel_bias, 8 + h);
    const int li = 32 * wid + r;
    const int cA = c0, cB = c0 + 1;
    const bool ownA = (cA == 0);
    const int cntA = ownA ? 256 : ((cntl - 256 * (cA - 1)) < 256 ? (cntl - 256 * (cA - 1)) : 256);
    const int cntB = (cB < c1) ? ((cntl - 256 * (cB - 1)) < 256 ? (cntl - 256 * (cB - 1)) : 256) : 0;
    const bool hasA = (32 * wid < cntA), hasB = (32 * wid < cntB);
    const bool lvA = li < cntA, lvB = li < cntB;
    int eA = 0, eB = 0;
    if (hasA && !ownA) eA = list[256 * (cA - 1) + (lvA ? li : 0)];
    if (hasB) eB = list[256 * (cB - 1) + (lvB ? li : 0)];
    TileRegs R, R2;
    tile_load(R, kbase, vbase, tid); tile_load(R2, kbase + 8192, vbase + 8192, tid);
    tile_store(R, lds + MB_K, lds + MB_V, tid); tile_load(R, kbase + 2 * 8192, vbase + 2 * 8192, tid);
    const int qposA = ownA ? 256 * n + li : (eA >> 2), slotA = ownA ? 3 : (eA & 3);
    const int qposB = eB >> 2, slotB = eB & 3;
    bf16x8 qfA[1][8], qfB[1][8];
    if (hasA) {
#pragma unroll
        for (int ks = 0; ks < 8; ++ks) qfA[0][ks] = *(const bf16x8*)(QM + (tok0 + qposA) * 1024 + h * 128 + 16 * ks + 8 * hh);
    }
    if (hasB) {
#pragma unroll
        for (int ks = 0; ks < 8; ++ks) qfB[0][ks] = *(const bf16x8*)(QM + (tok0 + qposB) * 1024 + h * 128 + 16 * ks + 8 * hh);
    }
    tile_store(R2, lds + MB_K + KBUF, lds + MB_V + VBUF, tid); tile_load(R2, kbase + 3 * 8192, vbase + 3 * 8192, tid);
    tile_store(R, lds + MB_K + 2 * KBUF, lds + MB_V + 2 * VBUF, tid);
    tile_store(R2, lds + MB_K + 3 * KBUF, lds + MB_V + 3 * VBUF, tid);
    __syncthreads();
#define MB_CHUNK(HAS, OWN, QF, QPOS, SLOT, LV) do { if (HAS) { \
        f32x16 O[1][4]; \
        _Pragma("unroll") for (int dt = 0; dt < 4; ++dt) _Pragma("unroll") for (int i = 0; i < 16; ++i) O[0][dt][i] = 0.f; \
        float mrun[1] = {-INFINITY}, lrun[1] = {0.f}; \
        const int qw0 = 256 * n + 32 * wid; \
        _Pragma("unroll 1") for (int t8 = 0; t8 < 8; ++t8) { \
            const int t = t8 >> 1, kh = t8 & 1; const int kp = 256 * n + 32 * t8; \
            bool run = true, need_mask = false, need_bias; \
            if (OWN) { run = (kp <= qw0 + 31); need_mask = (kp + 31 > qw0); need_bias = true; } \
            else { need_bias = __any((QPOS) - (kp + 31) < 113); } \
            if (run) attn_half<1, 8>(lds + MB_K + t * KBUF, lds + MB_V + t * VBUF, kh, QF, O, mrun, lrun, QPOS, kp, need_mask, need_bias, btab, sc, r, hh, 0); \
        } \
        const float l = lrun[0] + __shfl_xor(lrun[0], 32); const float il = 1.0f / l; \
        if (LV) { const size_t pidx = ((tok0 + (QPOS)) * 8 + h) * 4 + (SLOT); bf16_t* orow = PARTS + pidx * 128; \
            _Pragma("unroll") for (int dt = 0; dt < 4; ++dt) _Pragma("unroll") for (int g = 0; g < 4; ++g) { const int d = 32 * dt + 8 * g + 4 * hh; \
                u32x2 w; w.x = cvtpk(O[0][dt][4 * g + 0] * il, O[0][dt][4 * g + 1] * il); w.y = cvtpk(O[0][dt][4 * g + 2] * il, O[0][dt][4 * g + 3] * il); \
                *(u32x2*)(orow + d) = w; } \
            if (hh == 0) *(f32x2*)(ML + pidx * 2) = (f32x2){mrun[0], l}; } } } while (0)
    MB_CHUNK(hasA, ownA, qfA, qposA, slotA, lvA);
    MB_CHUNK(hasB, false, qfB, qposB, slotB, lvB);
#undef MB_CHUNK
}
constexpr int MB8_TAB = 4 * TBUF8;
static_assert(MB8_TAB + 512 <= MB_INC, "fp8 MoBA block LDS");
__device__ __forceinline__ void moba_block8(LAS unsigned char* lds, int b, int h, int n, const int* list, int cntl, int c0, int c1, const unsigned char* QM8, const unsigned char* KMT8, const unsigned char* VMT8, bf16_t* PARTS, float* ML, const float* rel_bias) {
    int tid_ = threadIdx.x; asm volatile("" : "+v"(tid_));
    const int tid = tid_, lane = tid & 63, r = lane & 31, hh = lane >> 5; const int wid = __builtin_amdgcn_readfirstlane(tid >> 6);
    const size_t tok0 = (size_t)b * SEQ;
    const LAS float* btab = (const LAS float*)(lds + MB8_TAB);
    const unsigned char* kbase = KMT8 + ((size_t)h * 256 + b * 128 + 4 * n) * 8192;
    const unsigned char* vbase = VMT8 + ((size_t)h * 256 + b * 128 + 4 * n) * 8192;
    __syncthreads();
    if (tid < 128) { const int q = tid; ((LAS float*)(lds + MB8_TAB))[q] = (rel_bias[t5_bucket(q) * 16 + 8 + h] - rel_bias[31 * 16 + 8 + h]) * (LOG2E * 64.0f); }
    const int li = 32 * wid + r;
    const int cA = c0, cB = c0 + 1;
    const bool ownA = (cA == 0);
    const int cntA = ownA ? 256 : ((cntl - 256 * (cA - 1)) < 256 ? (cntl - 256 * (cA - 1)) : 256);
    const int cntB = (cB < c1) ? ((cntl - 256 * (cB - 1)) < 256 ? (cntl - 256 * (cB - 1)) : 256) : 0;
    const bool hasA = (32 * wid < cntA), hasB = (32 * wid < cntB);
    const bool lvA = li < cntA, lvB = li < cntB;
    int eA = 0, eB = 0;
    if (hasA && !ownA) eA = list[256 * (cA - 1) + (lvA ? li : 0)];
    if (hasB) eB = list[256 * (cB - 1) + (lvB ? li : 0)];
    TileRegs8 R0, R1, R2, R3;
    tile_load8(R0, kbase, vbase, tid); tile_load8(R1, kbase + 8192, vbase + 8192, tid); tile_load8(R2, kbase + 2 * 8192, vbase + 2 * 8192, tid); tile_load8(R3, kbase + 3 * 8192, vbase + 3 * 8192, tid);
    SBAR();
    tile_store8(R0, lds, lds + KBUF8, tid);
    const int qposA = ownA ? 256 * n + li : (eA >> 2), slotA = ownA ? 3 : (eA & 3);
    const int qposB = eB >> 2, slotB = eB & 3;
    i32x8 qf[2];
    if (hasA) { const unsigned char* qp = QM8 + (tok0 + qposA) * 1024 + h * 128 + 32 * hh; qf[0] = cat8(*(const i32x4*)qp, *(const i32x4*)(qp + 16)); qf[1] = cat8(*(const i32x4*)(qp + 64), *(const i32x4*)(qp + 80)); }
    tile_store8(R1, lds + TBUF8, lds + TBUF8 + KBUF8, tid);
    tile_store8(R2, lds + 2 * TBUF8, lds + 2 * TBUF8 + KBUF8, tid);
    tile_store8(R3, lds + 3 * TBUF8, lds + 3 * TBUF8 + KBUF8, tid);
    __syncthreads();
#define MB8_LOADQB() do { if (hasB) { const unsigned char* qp = QM8 + (tok0 + qposB) * 1024 + h * 128 + 32 * hh; qf[0] = cat8(*(const i32x4*)qp, *(const i32x4*)(qp + 16)); qf[1] = cat8(*(const i32x4*)(qp + 64), *(const i32x4*)(qp + 80)); } } while (0)
#define MB8_CHUNK(HAS, OWN, QPOS, SLOT, LV, NEXTQ) do { if (HAS) { \
        f32x16 o[4]; \
        _Pragma("unroll") for (int dt = 0; dt < 4; ++dt) _Pragma("unroll") for (int i = 0; i < 16; ++i) o[dt][i] = 0.f; \
        float mref = -INFINITY, lrun = 0.f; \
        const int qw0 = 256 * n + 32 * wid; \
        _Pragma("unroll 1") for (int t = 0; t < 4; ++t) { \
            const int kp = 256 * n + 64 * t; const LAS unsigned char* tb = lds + t * TBUF8; \
            bool run = true, need_mask = false, need_bias; \
            if (OWN) { run = (kp <= qw0 + 31); need_mask = (kp + 63 > qw0); need_bias = (qw0 - (kp + 63) < 113); } \
            else { need_bias = __any((QPOS) - (kp + 63) < 113); } \
            if (run) { \
                i32x8 ka[2], kc[2], vf[2]; \
                d8_load_kf(ka, tb, r, hh, 0); d8_load_kf(kc, tb, r, hh, 64); \
                f32x16 s0, s1; d8_scores(s0, s1, ka, qf[0]); \
                __builtin_amdgcn_s_setprio(1); \
                s0 = __builtin_amdgcn_mfma_scale_f32_32x32x64_f8f6f4(kc[0], qf[1], s0, 0, 0, 0, 0x7F7F7F7F, 0, 0x7F7F7F7F); \
                s1 = __builtin_amdgcn_mfma_scale_f32_32x32x64_f8f6f4(kc[1], qf[1], s1, 0, 0, 0, 0x7F7F7F7F, 0, 0x7F7F7F7F); \
                __builtin_amdgcn_s_setprio(0); \
                d8_load_vf2<0>(vf, tb + KBUF8, r, hh); SBAR(); \
                const i32x8 P = d8_softmax<true>(s0, s1, o, mref, lrun, QPOS, kp, need_mask, need_bias, false, btab, hh); \
                d8_pv(o, vf, P, tb + KBUF8, r, hh); \
            } \
        } \
        NEXTQ; \
        asm volatile("s_nop 15\n\ts_nop 15\n\ts_nop 15\n\ts_nop 15" ::: "memory");        \
        const float l = lrun + __shfl_xor(lrun, 32); const float il = 1.0f / (l * D8_VS); \
        { const float il8 = il * F8_SPART; const size_t pidx = ((tok0 + (QPOS)) * 8 + h) * 4 + (SLOT); unsigned char* orow = (unsigned char*)PARTS + pidx * 128; \
              \
            _Pragma("unroll") for (int dt = 0; dt < 4; ++dt) _Pragma("unroll") for (int g = 0; g < 4; g += 2) { \
                unsigned a_ = epi::pack4_f8(o[dt][4 * g + 0] * il8, o[dt][4 * g + 1] * il8, o[dt][4 * g + 2] * il8, o[dt][4 * g + 3] * il8); \
                unsigned b_ = epi::pack4_f8(o[dt][4 * g + 4] * il8, o[dt][4 * g + 5] * il8, o[dt][4 * g + 6] * il8, o[dt][4 * g + 7] * il8); \
                auto rr = __builtin_amdgcn_permlane32_swap(a_, b_, false, false); a_ = rr[0]; b_ = rr[1]; \
                if (LV) *(u32x2*)(orow + 32 * dt + 8 * g + 8 * hh) = (u32x2){a_, b_}; } } \
        if (LV) { const size_t pidx = ((tok0 + (QPOS)) * 8 + h) * 4 + (SLOT); \
            if (hh == 0) *(f32x2*)(ML + pidx * 2) = (f32x2){mref * D8_C - D8_SH, l}; } } else { NEXTQ; } } while (0)
    MB8_CHUNK(hasA, ownA, qposA, slotA, lvA, MB8_LOADQB());
    MB8_CHUNK(hasB, false, qposB, slotB, lvB, (void)0);
#undef MB8_CHUNK
#undef MB8_LOADQB
}
}

struct Ctx {
    LAS unsigned char* lds;
    unsigned char* ws; unsigned* ctl;
    const float* const* in; float* out;
    int tid, lane, wave, G, blk;
};
enum { I_X = 0, I_C, I_WADA, I_BADA, I_GMIX, I_GFFN, I_WIN, I_LAMBDA, I_SUBLN, I_RELB, I_WOD, I_WOM, I_WOUT, I_WROUTER, I_RBIAS, I_WEG, I_WEU, I_WED, I_WSG, I_WSU, I_WSD, I_GFINAL };

constexpr int TR_SCR = 64 * 65 * 4 + 128;
static_assert(8 * TR_SCR <= RING_BYTES + 16384, "transpose scratch");
template <bool NT>
__device__ __forceinline__ void transpose_item(const float* __restrict__ W, int K, int N, bf16_t* __restrict__ WT, int drow0, int k0, int n0, LAS float* scr, int lane) {
    const int nq = lane & 15, kr = lane >> 4;
    f32x4 v[16];
#pragma unroll
    for (int i = 0; i < 16; ++i) { const f32x4* p = (const f32x4*)(W + (size_t)(k0 + 4 * i + kr) * N + n0 + 4 * nq); v[i] = NT ? __builtin_nontemporal_load(p) : *p; }
#pragma unroll
    for (int i = 0; i < 16; ++i) { LAS float* d = scr + (4 * i + kr) * 65 + 4 * nq; d[0] = v[i][0]; d[1] = v[i][1]; d[2] = v[i][2]; d[3] = v[i][3]; }
    LDS_WAIT(); asm volatile("" ::: "memory");
    const int c = lane & 7;
#pragma unroll
    for (int j = 0; j < 8; ++j) { const int n = (lane >> 3) + 8 * j; const LAS float* s = scr + (8 * c) * 65 + n;
        u32x4 o; o.x = cvtpk(s[0 * 65], s[1 * 65]); o.y = cvtpk(s[2 * 65], s[3 * 65]); o.z = cvtpk(s[4 * 65], s[5 * 65]); o.w = cvtpk(s[6 * 65], s[7 * 65]);
        u32x4* q = (u32x4*)(WT + (size_t)(drow0 + n) * K + k0 + 8 * c); if (NT) __builtin_nontemporal_store(o, q); else *q = o; }
    LDS_WAIT(); asm volatile("" ::: "memory");
}
template <bool NT>
__device__ __forceinline__ void transpose_item_f8(const float* __restrict__ W, int K, int N, unsigned char* __restrict__ WT, int drow0, int k0, int n0, LAS float* scr, int lane, float scale) {
    const int nq = lane & 15, kr = lane >> 4;
    f32x4 v[16];
#pragma unroll
    for (int i = 0; i < 16; ++i) { const f32x4* p = (const f32x4*)(W + (size_t)(k0 + 4 * i + kr) * N + n0 + 4 * nq); v[i] = NT ? __builtin_nontemporal_load(p) : *p; }
#pragma unroll
    for (int i = 0; i < 16; ++i) { LAS float* d = scr + (4 * i + kr) * 65 + 4 * nq; d[0] = v[i][0] * scale; d[1] = v[i][1] * scale; d[2] = v[i][2] * scale; d[3] = v[i][3] * scale; }
    LDS_WAIT(); asm volatile("" ::: "memory");
    const int c = lane & 7;
#pragma unroll
    for (int j = 0; j < 8; ++j) { const int n = (lane >> 3) + 8 * j; const LAS float* s = scr + (8 * c) * 65 + n;
        const u32x2 o = {epi::pack4_f8(s[0 * 65], s[1 * 65], s[2 * 65], s[3 * 65]), epi::pack4_f8(s[4 * 65], s[5 * 65], s[6 * 65], s[7 * 65])};
        u32x2* q = (u32x2*)(WT + (size_t)(drow0 + n) * K + k0 + 8 * c); if (NT) __builtin_nontemporal_store(o, q); else *q = o; }
    LDS_WAIT(); asm volatile("" ::: "memory");
}
struct CvItemF8 { const float* W; unsigned char* WT; int K, N, drow0, k0, n0; float scale; };
__device__ __forceinline__ void transpose_pair_f8(const CvItemF8& A, const CvItemF8& B, LAS float* scr, int lane) {
    const int nq = lane & 15, kr = lane >> 4, c = lane & 7;
    f32x4 va[16], vb[16];
#pragma unroll
    for (int i = 0; i < 16; ++i) va[i] = __builtin_nontemporal_load((const f32x4*)(A.W + (size_t)(A.k0 + 4 * i + kr) * A.N + A.n0 + 4 * nq));
#pragma unroll
    for (int i = 0; i < 16; ++i) vb[i] = __builtin_nontemporal_load((const f32x4*)(B.W + (size_t)(B.k0 + 4 * i + kr) * B.N + B.n0 + 4 * nq));
    __builtin_amdgcn_sched_barrier(0);
#pragma unroll
    for (int i = 0; i < 16; ++i) { LAS float* d = scr + (4 * i + kr) * 65 + 4 * nq; d[0] = va[i][0] * A.scale; d[1] = va[i][1] * A.scale; d[2] = va[i][2] * A.scale; d[3] = va[i][3] * A.scale; }
    LDS_WAIT(); asm volatile("" ::: "memory");
#pragma unroll
    for (int j = 0; j < 8; ++j) { const int n = (lane >> 3) + 8 * j; const LAS float* s = scr + (8 * c) * 65 + n;
        const u32x2 o = {epi::pack4_f8(s[0 * 65], s[1 * 65], s[2 * 65], s[3 * 65]), epi::pack4_f8(s[4 * 65], s[5 * 65], s[6 * 65], s[7 * 65])};
        __builtin_nontemporal_store(o, (u32x2*)(A.WT + (size_t)(A.drow0 + n) * A.K + A.k0 + 8 * c)); }
    LDS_WAIT(); asm volatile("" ::: "memory");
#pragma unroll
    for (int i = 0; i < 16; ++i) { LAS float* d = scr + (4 * i + kr) * 65 + 4 * nq; d[0] = vb[i][0] * B.scale; d[1] = vb[i][1] * B.scale; d[2] = vb[i][2] * B.scale; d[3] = vb[i][3] * B.scale; }
    LDS_WAIT(); asm volatile("" ::: "memory");
#pragma unroll
    for (int j = 0; j < 8; ++j) { const int n = (lane >> 3) + 8 * j; const LAS float* s = scr + (8 * c) * 65 + n;
        const u32x2 o = {epi::pack4_f8(s[0 * 65], s[1 * 65], s[2 * 65], s[3 * 65]), epi::pack4_f8(s[4 * 65], s[5 * 65], s[6 * 65], s[7 * 65])};
        __builtin_nontemporal_store(o, (u32x2*)(B.WT + (size_t)(B.drow0 + n) * B.K + B.k0 + 8 * c)); }
    LDS_WAIT(); asm volatile("" ::: "memory");
}
__device__ __forceinline__ int gu_row(int n0, int up) { return 256 * (n0 >> 7) + 128 * up + (n0 & 127); }

__device__ __forceinline__ int win_row(int n) { return n < 2048 ? n : (n < 3072 ? 8192 + (n - 2048) : (n < 5120 ? 2048 + (n - 3072) : (n < 6144 ? 9216 + (n - 5120) : 4096 + (n - 6144)))); }
__device__ __forceinline__ void p0_prologue(Ctx& F) {
    const int gw = F.blk * 8 + F.wave, NGW = F.G * 8;
    unsigned char* ws = F.ws;
    {
        const float* wada = F.in[I_WADA]; const float* c = F.in[I_C]; float* modp = (float*)(ws + WS_MODP);
        for (int it = gw; it < 48 * 32; it += NGW) {
            const int cc = it % 48, ks = it / 48, col = 256 * cc + 4 * F.lane;
            f32x4 a0 = {0.f, 0.f, 0.f, 0.f}, a1 = {0.f, 0.f, 0.f, 0.f};
#pragma unroll 8
            for (int k = 64 * ks; k < 64 * ks + 64; ++k) {
                const f32x4 w = *(const f32x4*)(wada + (size_t)k * 12288 + col);
                const float c0 = c[k], c1 = c[2048 + k];
                a0 += w * siluf_(c0); a1 += w * siluf_(c1);
            }
            *(f32x4*)(modp + ((size_t)ks * 2 + 0) * 12288 + col) = a0;
            *(f32x4*)(modp + ((size_t)ks * 2 + 1) * 12288 + col) = a1;
        }
    }
    {
        LAS float* scr = (LAS float*)(F.lds + F.wave * TR_SCR);
        constexpr int I0 = 5120, I1 = I0 + 512, I2 = I1 + 512, I3 = I2 + 1024, I4 = I3 + 256, I5 = I4 + 256, I6 = I5 + 256;
        for (int it = gw; it < I6; it += NGW) {
            if (it < I0) { const int r = it, kb = r / 160, nb = r % 160; if constexpr (P2F8) transpose_item_f8<false>(F.in[I_WIN], 2048, 10240, ws + WS_W_IN_T, win_row(64 * nb), 64 * kb, 64 * nb, scr, F.lane, F8_SW); else transpose_item<false>(F.in[I_WIN], 2048, 10240, (bf16_t*)(ws + WS_W_IN_T), win_row(64 * nb), 64 * kb, 64 * nb, scr, F.lane); }
            else if (it < I1) { const int r = it - I0, kb = r / 32, nb = r % 32; if constexpr (O78F8) transpose_item_f8<false>(F.in[I_WOD], 1024, 2048, ws + WS_W_OD_T, 64 * nb, 64 * kb, 64 * nb, scr, F.lane, F8_SWO); else transpose_item<false>(F.in[I_WOD], 1024, 2048, (bf16_t*)(ws + WS_W_OD_T), 64 * nb, 64 * kb, 64 * nb, scr, F.lane); }
            else if (it < I2) { const int r = it - I1, kb = r / 32, nb = r % 32; if constexpr (O78F8) transpose_item_f8<false>(F.in[I_WOM], 1024, 2048, ws + WS_W_OM_T, 64 * nb, 64 * kb, 64 * nb, scr, F.lane, F8_SWO); else transpose_item<false>(F.in[I_WOM], 1024, 2048, (bf16_t*)(ws + WS_W_OM_T), 64 * nb, 64 * kb, 64 * nb, scr, F.lane); }
            else if (it < I3) { const int r = it - I2, kb = r / 32, nb = r % 32; if constexpr (O78F8) transpose_item_f8<false>(F.in[I_WOUT], 2048, 2048, ws + WS_W_OUT_T, 64 * nb, 64 * kb, 64 * nb, scr, F.lane, F8_SWOUT); else transpose_item<false>(F.in[I_WOUT], 2048, 2048, (bf16_t*)(ws + WS_W_OUT_T), 64 * nb, 64 * kb, 64 * nb, scr, F.lane); }
            else if (it < I4) { const int r = it - I3, kb = r / 8, nb = r % 8; transpose_item_f8<false>(F.in[I_WSG], 2048, 512, ws + WS_W_SHGU_T, gu_row(64 * nb, 0), 64 * kb, 64 * nb, scr, F.lane, F8_SW); }
            else if (it < I5) { const int r = it - I4, kb = r / 8, nb = r % 8; transpose_item_f8<false>(F.in[I_WSU], 2048, 512, ws + WS_W_SHGU_T, gu_row(64 * nb, 1), 64 * kb, 64 * nb, scr, F.lane, F8_SW); }
            else { const int r = it - I5, kb = r / 32, nb = r % 32; transpose_item_f8<false>(F.in[I_WSD], 512, 2048, ws + WS_W_SHD_T, 64 * nb, 64 * kb, 64 * nb, scr, F.lane, F8_SD); }
        }
    }
    {
        const float* wr = F.in[I_WROUTER]; bf16_t* hi = (bf16_t*)(ws + WS_WR); bf16_t* lo = hi + 64 * 2048;
        for (int idx = F.blk * 512 + F.tid; idx < 2048 * 64; idx += F.G * 512) {
            const int k = idx >> 6, e = idx & 63; const float w = wr[idx];
            const unsigned h16 = cvtpk(w, 0.f) & 0xffffu; const float res = w - __uint_as_float(h16 << 16);
            hi[e * 2048 + k] = (bf16_t)h16; lo[e * 2048 + k] = (bf16_t)(cvtpk(res, 0.f) & 0xffffu);
        }
    }
}

constexpr int CV_NCHUNK = 1536;
struct CvItem { const float* W; unsigned char* WT; int K, N, drow0, k0, n0; float scale; };
__device__ __forceinline__ CvItem cv_decode(Ctx& F, int it) {
    unsigned char* ws = F.ws; CvItem c;
    if (it < 16384) { const int r = it, e = r >> 8, r2 = r & 255, kb = r2 / 8, nb = r2 % 8;
        c.W = F.in[I_WEG] + (size_t)e * 2048 * 512; c.WT = ws + WS_W_EGU_T + (size_t)e * 1024 * 2048; c.scale = F8_SW; c.K = 2048; c.N = 512; c.drow0 = gu_row(64 * nb, 0); c.k0 = 64 * kb; c.n0 = 64 * nb; }
    else if (it < 32768) { const int r = it - 16384, e = r >> 8, r2 = r & 255, kb = r2 / 8, nb = r2 % 8;
        c.W = F.in[I_WEU] + (size_t)e * 2048 * 512; c.WT = ws + WS_W_EGU_T + (size_t)e * 1024 * 2048; c.scale = F8_SW; c.K = 2048; c.N = 512; c.drow0 = gu_row(64 * nb, 1); c.k0 = 64 * kb; c.n0 = 64 * nb; }
    else { const int r = it - 32768, e = r >> 8, r2 = r & 255, kb = r2 / 32, nb = r2 % 32;
        c.W = F.in[I_WED] + (size_t)e * 512 * 2048; c.WT = ws + WS_W_ED_T + (size_t)e * 2048 * 512; c.scale = F8_SD; c.K = 512; c.N = 2048; c.drow0 = 64 * nb; c.k0 = 64 * kb; c.n0 = 64 * nb; }
    return c;
}
__device__ __forceinline__ void convert_chunk(Ctx& F, int chunk) {
    LAS float* scr = (LAS float*)(F.lds + F.wave * TR_SCR);
    int lane = F.lane; asm volatile("" : "+v"(lane));
    const int it0 = chunk * 32 + F.wave * 4;
#pragma unroll 1
    for (int i = 0; i < 4; i += 2) { const CvItem a = cv_decode(F, it0 + i), b = cv_decode(F, it0 + i + 1);
        transpose_pair_f8(CvItemF8{a.W, a.WT, a.K, a.N, a.drow0, a.k0, a.n0, a.scale}, CvItemF8{b.W, b.WT, b.K, b.N, b.drow0, b.k0, b.n0, b.scale}, scr, lane); }
}
__device__ __forceinline__ int queue_take(Ctx& F, unsigned* head) {
    volatile LAS int* slot = (volatile LAS int*)(F.lds + MISC_OFF + 64);
    __syncthreads();
    if (F.tid == 0) *slot = (int)__hip_atomic_fetch_add(head, 1u, RLX_AGENT);
    __syncthreads();
    return *slot;
}

__device__ __forceinline__ void fill_mod_tables(Ctx& F, const float* gain, int shift_off, int scale_off, bool from_partials, int bsel = -1) {
    LAS float* A = (LAS float*)F.lds; LAS float* Bt = (LAS float*)(F.lds + 16384);
    const float* modp = (const float*)(F.ws + WS_MODP); const float* modf = (const float*)(F.ws + WS_MOD); const float* bada = F.in[I_BADA];
    const int lo = bsel < 0 ? 0 : bsel * 2048, hi = bsel < 0 ? 4096 : lo + 2048;
    for (int idx = lo + F.tid; idx < hi; idx += 512) {
        const int b = idx >> 11, c = idx & 2047;
        float sh, scl;
        if (from_partials) {
            sh = bada[shift_off + c]; scl = bada[scale_off + c];
#pragma unroll 16
            for (int ks = 0; ks < 32; ++ks) { sh += modp[((size_t)ks * 2 + b) * 12288 + shift_off + c]; scl += modp[((size_t)ks * 2 + b) * 12288 + scale_off + c]; }
        } else { sh = modf[b * 12288 + shift_off + c]; scl = modf[b * 12288 + scale_off + c]; }
        A[idx] = gain[c] * (1.0f + scl); Bt[idx] = sh;
    }
    __syncthreads();
}

__device__ __forceinline__ void p1_norm(Ctx& F) {
    { const float* modp = (const float*)(F.ws + WS_MODP); float* modf = (float*)(F.ws + WS_MOD); const float* bada = F.in[I_BADA];
      for (int idx = F.blk * 512 + F.tid; idx < 2 * 12288; idx += F.G * 512) { const int b = idx / 12288, j = idx % 12288; float s = bada[j];
#pragma unroll 8
          for (int ks = 0; ks < 32; ++ks) s += modp[((size_t)ks * 2 + b) * 12288 + j];
          modf[idx] = s; } }
    const int rpb = T / F.G;
    const bool one_batch = (F.G * rpb == T) && (SEQ % rpb == 0);
    const int row_lo = one_batch ? F.blk * rpb : 0, row_hi = one_batch ? row_lo + rpb : T, rstep = one_batch ? 8 : F.G * 8, r0 = one_batch ? row_lo + F.wave : F.blk * 8 + F.wave;
    fill_mod_tables(F, F.in[I_GMIX], 0, 2048, true, one_batch ? row_lo / SEQ : -1);
    const LAS float* A = (const LAS float*)F.lds; const LAS float* Bt = (const LAS float*)(F.lds + 16384);
    const float* x = F.in[I_X]; bf16_t* H = (bf16_t*)(F.ws + WS_H);
    for (int row = r0; row < row_hi; row += 2 * rstep) {
        const int row2 = row + rstep; const bool has2 = row2 < row_hi;
        const int b = row / SEQ, b2 = has2 ? row2 / SEQ : b;
        const f32x4* xr = (const f32x4*)(x + (size_t)row * 2048) + F.lane;
        const f32x4* xr2 = (const f32x4*)(x + (size_t)(has2 ? row2 : row) * 2048) + F.lane;
        f32x4 v[8], v2[8]; float ss = 0.f, ss2 = 0.f;
#pragma unroll
        for (int j = 0; j < 8; ++j) { v[j] = __builtin_nontemporal_load(xr + 64 * j); v2[j] = __builtin_nontemporal_load(xr2 + 64 * j); }
#pragma unroll
        for (int j = 0; j < 8; ++j) { ss += (v[j].x * v[j].x + v[j].y * v[j].y) + (v[j].z * v[j].z + v[j].w * v[j].w); ss2 += (v2[j].x * v2[j].x + v2[j].y * v2[j].y) + (v2[j].z * v2[j].z + v2[j].w * v2[j].w); }
        const float rstd = 1.0f / sqrtf(wave_sum(ss) * (1.0f / 2048.0f) + RMS_EPS), rstd2 = 1.0f / sqrtf(wave_sum(ss2) * (1.0f / 2048.0f) + RMS_EPS);
        unsigned long long* o8 = (unsigned long long*)(H + (size_t)row * 2048) + F.lane;
        unsigned long long* o82 = (unsigned long long*)(H + (size_t)row2 * 2048) + F.lane;
#pragma unroll
        for (int j = 0; j < 8; ++j) { const int c = 4 * F.lane + 256 * j;
            const f32x4 a = *(const LAS f32x4*)(A + b * 2048 + c), sft = *(const LAS f32x4*)(Bt + b * 2048 + c);
            const f32x4 y = v[j] * rstd * a + sft;
            if constexpr (P2F8) ((unsigned*)((unsigned char*)H + (size_t)row * 2048))[F.lane + 64 * j] = epi::pack4_f8(y.x * F8_SH, y.y * F8_SH, y.z * F8_SH, y.w * F8_SH);
            else o8[64 * j] = (unsigned long long)cvtpk(y.x, y.y) | ((unsigned long long)cvtpk(y.z, y.w) << 32);
            if (has2) { const f32x4 a2 = *(const LAS f32x4*)(A + b2 * 2048 + c), sft2 = *(const LAS f32x4*)(Bt + b2 * 2048 + c);
                const f32x4 y2 = v2[j] * rstd2 * a2 + sft2;
                if constexpr (P2F8) ((unsigned*)((unsigned char*)H + (size_t)row2 * 2048))[F.lane + 64 * j] = epi::pack4_f8(y2.x * F8_SH, y2.y * F8_SH, y2.z * F8_SH, y2.w * F8_SH);
                else o82[64 * j] = (unsigned long long)cvtpk(y2.x, y2.y) | ((unsigned long long)cvtpk(y2.z, y2.w) << 32); } }
    }
}

__device__ __forceinline__ void p3_kmean(Ctx& F) {
    const bf16_t* KMT = (const bf16_t*)(F.ws + WS_KMT); float* KM = (float*)(F.ws + WS_KMEAN);
    LAS float* red = (LAS float*)F.lds;
    for (int item = F.blk; item < 512; item += F.G) {
        const int b = item >> 8, h = (item >> 5) & 7, n = item & 31;
        const int cp = F.tid & 63, rg = F.tid >> 6;
        const bf16_t* base = KMT + (((size_t)h * 256 + b * 128 + 4 * n) * 64 + 32 * rg) * 128 + 2 * cp;
        float s0 = 0.f, s1 = 0.f;
#pragma unroll 8
        for (int rr = 0; rr < 32; ++rr) { const unsigned u = *(const unsigned*)(base + (size_t)rr * 128); s0 += bf_lo(u); s1 += bf_hi(u); }
        __syncthreads();
        red[rg * 128 + 2 * cp] = s0; red[rg * 128 + 2 * cp + 1] = s1;
        __syncthreads();
        if (F.tid < 128) { float s = 0.f;
#pragma unroll
            for (int g = 0; g < 8; ++g) s += red[g * 128 + F.tid];
            KM[(size_t)item * 128 + F.tid] = s * (1.0f / 256.0f); }
    }
    __syncthreads();
}

__device__ __forceinline__ void p4_gating(Ctx& F) {
    const bf16_t* QM = (const bf16_t*)(F.ws + WS_QM); const float* KM = (const float*)(F.ws + WS_KMEAN);
    float* ML = (float*)(F.ws + WS_ML); int* MLIST = (int*)(F.ws + WS_MLIST); unsigned* mcnt = F.ctl + CW_MCNT;
    for (int grp = F.blk; grp < T / 64; grp += F.G) {
        const int h = F.wave, tok = grp * 64 + F.lane, b = tok / SEQ, qs = tok % SEQ, cur = qs >> 8;
        const int curu = __builtin_amdgcn_readfirstlane(cur), bu = __builtin_amdgcn_readfirstlane(b);
        float q[128];
        const u32x4* qp = (const u32x4*)(QM + (size_t)tok * 1024 + h * 128);
#pragma unroll
        for (int i = 0; i < 16; ++i) { const u32x4 u = qp[i]; q[8 * i + 0] = bf_lo(u.x); q[8 * i + 1] = bf_hi(u.x); q[8 * i + 2] = bf_lo(u.y); q[8 * i + 3] = bf_hi(u.y);
            q[8 * i + 4] = bf_lo(u.z); q[8 * i + 5] = bf_hi(u.z); q[8 * i + 6] = bf_lo(u.w); q[8 * i + 7] = bf_hi(u.w); }
        float v0 = -INFINITY, v1 = -INFINITY, v2 = -INFINITY; int i0 = -1, i1 = -1, i2 = -1;
        const float* kmb = KM + (size_t)((bu * 8 + h) * 32) * 128;
        for (int n = 0; n < curu; ++n) {
            const float* km = kmb + n * 128;
            float a0 = 0.f, a1 = 0.f, a2 = 0.f, a3 = 0.f;
#pragma unroll
            for (int d = 0; d < 128; d += 4) { a0 += q[d] * km[d]; a1 += q[d + 1] * km[d + 1]; a2 += q[d + 2] * km[d + 2]; a3 += q[d + 3] * km[d + 3]; }
            const float s = (a0 + a1) + (a2 + a3);
            if (s > v0) { v2 = v1; i2 = i1; v1 = v0; i1 = i0; v0 = s; i0 = n; }
            else if (s > v1) { v2 = v1; i2 = i1; v1 = s; i1 = n; }
            else if (s > v2) { v2 = s; i2 = n; }
        }
        float* ml = ML + ((size_t)tok * 8 + h) * 8;
        if (i0 < 0) *(f32x2*)(ml + 0) = (f32x2){-INFINITY, 0.f};
        if (i1 < 0) *(f32x2*)(ml + 2) = (f32x2){-INFINITY, 0.f};
        if (i2 < 0) *(f32x2*)(ml + 4) = (f32x2){-INFINITY, 0.f};
        for (int n = 0; n < curu; ++n) {
            const bool hit = (i0 == n) || (i1 == n) || (i2 == n);
            const unsigned long long mask = __ballot(hit);
            if (mask) {
                const int cntw = __popcll(mask);
                unsigned base = 0;
                if (F.lane == 0) base = __hip_atomic_fetch_add(mcnt + ((bu * 8 + h) * 32 + n), (unsigned)cntw, RLX_AGENT);
                base = __builtin_amdgcn_readfirstlane(base);
                if (hit) { const int pos = base + __popcll(mask & ((1ull << F.lane) - 1ull)); const int slot = (i0 == n) ? 0 : ((i1 == n) ? 1 : 2);
                    MLIST[(size_t)((bu * 8 + h) * 32 + n) * 8192 + pos] = (qs << 2) | slot; }
            }
        }
    }
}

__device__ __forceinline__ void p6_merge(Ctx& F) {
    const bf16_t* PARTS = (const bf16_t*)(F.ws + WS_PARTS); const float* ML = (const float*)(F.ws + WS_ML); bf16_t* AM = (bf16_t*)(F.ws + WS_AM);
    const int gw = F.blk * 8 + F.wave, NGW = F.G * 8;
    for (int tok = gw; tok < T; tok += NGW) {
        f32x4 ml01[2], ml23[2]; u32x2 pu[2][4];
#pragma unroll
        for (int i = 0; i < 2; ++i) {
            const int item = F.lane + 64 * i, h = item >> 4, ch = item & 15;
            const float* ml = ML + ((size_t)tok * 8 + h) * 8;
            ml01[i] = *(const f32x4*)ml; ml23[i] = *(const f32x4*)(ml + 4);
            const unsigned char* pb = (const unsigned char*)PARTS + (((size_t)tok * 8 + h) * 4) * 128 + ch * 8;
#pragma unroll
            for (int s4 = 0; s4 < 4; ++s4) pu[i][s4] = __builtin_nontemporal_load((const u32x2*)(pb + s4 * 128));
        }
#pragma unroll
        for (int i = 0; i < 2; ++i) {
            const int item = F.lane + 64 * i, h = item >> 4, ch = item & 15;
            const float m0 = ml01[i][0], l0 = ml01[i][1], m1 = ml01[i][2], l1 = ml01[i][3], m2 = ml23[i][0], l2 = ml23[i][1], m3 = ml23[i][2], l3 = ml23[i][3];
            const float M = fmaxf(fmaxf(m0, m1), fmaxf(m2, m3));
            const float w0 = l0 * fast_exp2(m0 - M), w1 = l1 * fast_exp2(m1 - M), w2 = l2 * fast_exp2(m2 - M), w3 = l3 * fast_exp2(m3 - M);
            const float inv = 1.0f / (w0 + w1 + w2 + w3);
            float acc[8];
#pragma unroll
            for (int j = 0; j < 8; ++j) acc[j] = 0.f;
            const float ws4[4] = {w0, w1, w2, w3};
#pragma unroll
            for (int s4 = 0; s4 < 4; ++s4) {
                const float w = ws4[s4]; u32x2 u = pu[i][s4];
                if (!(w > 0.f)) u = (u32x2){0u, 0u};
                { const f32x2 a = __builtin_amdgcn_cvt_pk_f32_fp8((int)u.x, false), b = __builtin_amdgcn_cvt_pk_f32_fp8((int)u.x, true), c = __builtin_amdgcn_cvt_pk_f32_fp8((int)u.y, false), d = __builtin_amdgcn_cvt_pk_f32_fp8((int)u.y, true);
                  acc[0] += w * a[0]; acc[1] += w * a[1]; acc[2] += w * b[0]; acc[3] += w * b[1]; acc[4] += w * c[0]; acc[5] += w * c[1]; acc[6] += w * d[0]; acc[7] += w * d[1]; }
            }
            if constexpr (O78F8) { const float i8 = inv * (F8_SAM / F8_SPART);
                *(u32x2*)((unsigned char*)AM + (size_t)tok * 1024 + h * 128 + ch * 8) = (u32x2){epi::pack4_f8(acc[0] * i8, acc[1] * i8, acc[2] * i8, acc[3] * i8), epi::pack4_f8(acc[4] * i8, acc[5] * i8, acc[6] * i8, acc[7] * i8)}; }
            else { u32x4 o; o.x = cvtpk(acc[0] * inv, acc[1] * inv); o.y = cvtpk(acc[2] * inv, acc[3] * inv); o.z = cvtpk(acc[4] * inv, acc[5] * inv); o.w = cvtpk(acc[6] * inv, acc[7] * inv);
            *(u32x4*)(AM + (size_t)tok * 1024 + h * 128 + ch * 8) = o; }
        }
    }
}
constexpr int P9_RSTD = 32768, P9_LG = 33792, P9_LGROW = 68, P9_LCNT = P9_LG + 2 * 64 * P9_LGROW * 4, P9_LBASE = P9_LCNT + 256, P9_END = P9_LBASE + 256;
static_assert(P9_END <= RING_BYTES, "P9 LDS");
__device__ __forceinline__ void p9_route(Ctx& F) {
    fill_mod_tables(F, F.in[I_GFFN], 6144, 8192, false);
    const LAS float* A2 = (const LAS float*)F.lds; const LAS float* B2 = (const LAS float*)(F.lds + 16384);
    LAS float* rstd_l = (LAS float*)(F.lds + P9_RSTD); LAS float* LG = (LAS float*)(F.lds + P9_LG);
    LAS int* lcnt = (LAS int*)(F.lds + P9_LCNT); LAS int* lbase = (LAS int*)(F.lds + P9_LBASE);
    const bf16_t* x1 = (const bf16_t*)(F.ws + WS_X1); bf16_t* H2 = (bf16_t*)(F.ws + WS_H2); unsigned char* H2F8 = F.ws + WS_H2F8;
    const bf16_t* WRH = (const bf16_t*)(F.ws + WS_WR); const bf16_t* WRL = WRH + 64 * 2048;
    const float* rbias = F.in[I_RBIAS];
    int* ELIST = (int*)(F.ws + WS_ELIST); int* TOKE = (int*)(F.ws + WS_TOKE); float* TOKW = (float*)(F.ws + WS_TOKW);
    unsigned* ecnt = F.ctl + CW_ECNT;
    for (int grp = F.blk; grp < T / 64; grp += F.G) {
        const int tokb = grp * 64, b = tokb / SEQ;
        if (F.tid < 64) lcnt[F.tid] = 0;
        for (int i = 0; i < 8; i += 4) {
            const int tl = F.wave * 8 + i;
            u32x4 va[4][4];
#pragma unroll
            for (int q = 0; q < 4; ++q) { const u32x4* xr = (const u32x4*)(x1 + (size_t)(tokb + tl + q) * 2048) + F.lane;
#pragma unroll
                for (int j = 0; j < 4; ++j) va[q][j] = xr[64 * j]; }
#pragma unroll
            for (int q = 0; q < 4; ++q) { float ss = 0.f;
#pragma unroll
                for (int j = 0; j < 4; ++j) { const u32x4 u = va[q][j];
                    const float a0 = bf_lo(u.x), a1 = bf_hi(u.x), a2 = bf_lo(u.y), a3 = bf_hi(u.y), a4 = bf_lo(u.z), a5 = bf_hi(u.z), a6 = bf_lo(u.w), a7 = bf_hi(u.w);
                    ss += ((a0 * a0 + a1 * a1) + (a2 * a2 + a3 * a3)) + ((a4 * a4 + a5 * a5) + (a6 * a6 + a7 * a7)); }
                ss = wave_sum(ss);
                if (F.lane == 0) rstd_l[tl + q] = 1.0f / sqrtf(ss * (1.0f / 2048.0f) + RMS_EPS); }
        }
        __syncthreads();
        {
            const int tg = F.wave & 3, kh = F.wave >> 2, tc = F.lane & 15, kg = F.lane >> 4;
            const int tl = 16 * tg + tc; const float rs = rstd_l[tl];
            const bf16_t* xrow = x1 + (size_t)(tokb + tl) * 2048;
            bf16_t* hrow = H2 + (size_t)(tokb + tl) * 2048;
            f32x4 acc[4];
#pragma unroll
            for (int nt = 0; nt < 4; ++nt) acc[nt] = (f32x4){0.f, 0.f, 0.f, 0.f};
#pragma unroll 2
            for (int s = 32 * kh; s < 32 * kh + 32; ++s) {
                const int c0 = 32 * s + 8 * kg;
                const u32x4 xu = *(const u32x4*)(xrow + c0);
                const f32x4 xa = {bf_lo(xu.x), bf_hi(xu.x), bf_lo(xu.y), bf_hi(xu.y)}, xb = {bf_lo(xu.z), bf_hi(xu.z), bf_lo(xu.w), bf_hi(xu.w)};
                const f32x4 aa = *(const LAS f32x4*)(A2 + b * 2048 + c0), ab = *(const LAS f32x4*)(A2 + b * 2048 + c0 + 4);
                const f32x4 ba = *(const LAS f32x4*)(B2 + b * 2048 + c0), bb = *(const LAS f32x4*)(B2 + b * 2048 + c0 + 4);
                const f32x4 ya = xa * rs * aa + ba, yb = xb * rs * ab + bb;
                u32x4 hi; hi.x = cvtpk(ya[0], ya[1]); hi.y = cvtpk(ya[2], ya[3]); hi.z = cvtpk(yb[0], yb[1]); hi.w = cvtpk(yb[2], yb[3]);
                *(u32x2*)(H2F8 + (size_t)(tokb + tl) * 2048 + c0) = (u32x2){epi::pack4_f8(ya[0] * F8_SH, ya[1] * F8_SH, ya[2] * F8_SH, ya[3] * F8_SH), epi::pack4_f8(yb[0] * F8_SH, yb[1] * F8_SH, yb[2] * F8_SH, yb[3] * F8_SH)};
                u32x4 lo; lo.x = cvtpk(ya[0] - bf_lo(hi.x), ya[1] - bf_hi(hi.x)); lo.y = cvtpk(ya[2] - bf_lo(hi.y), ya[3] - bf_hi(hi.y));
                lo.z = cvtpk(yb[0] - bf_lo(hi.z), yb[1] - bf_hi(hi.z)); lo.w = cvtpk(yb[2] - bf_lo(hi.w), yb[3] - bf_hi(hi.w));
                const bf16x8 hf = __builtin_bit_cast(bf16x8, hi), lf = __builtin_bit_cast(bf16x8, lo);
#pragma unroll
                for (int nt = 0; nt < 4; ++nt) {
                    const bf16x8 wh = *(const bf16x8*)(WRH + (size_t)(16 * nt + tc) * 2048 + c0), wl = *(const bf16x8*)(WRL + (size_t)(16 * nt + tc) * 2048 + c0);
                    acc[nt] = __builtin_amdgcn_mfma_f32_16x16x32_bf16(wh, hf, acc[nt], 0, 0, 0);
                    acc[nt] = __builtin_amdgcn_mfma_f32_16x16x32_bf16(wh, lf, acc[nt], 0, 0, 0);
                    acc[nt] = __builtin_amdgcn_mfma_f32_16x16x32_bf16(wl, hf, acc[nt], 0, 0, 0);
                }
            }
#pragma unroll
            for (int nt = 0; nt < 4; ++nt) *(LAS f32x4*)(LG + (kh * 64 + tl) * P9_LGROW + 16 * nt + 4 * kg) = acc[nt];
        }
        __syncthreads();
        int se[8], sslot[8]; float sw[8];
        if (F.tid < 64) {
            LAS float* row0 = LG + F.tid * P9_LGROW; const LAS float* row1 = LG + (64 + F.tid) * P9_LGROW;
            float sl[64];
#pragma unroll
            for (int e = 0; e < 64; ++e) { const float s = sigmoidf_(row0[e] + row1[e]); row0[e] = s; sl[e] = s + rbias[e]; }
            float gs[8];
#pragma unroll
            for (int g = 0; g < 8; ++g) { float m1 = -INFINITY, m2 = -INFINITY;
#pragma unroll
                for (int j = 0; j < 8; ++j) { const float v = sl[8 * g + j]; if (v > m1) { m2 = m1; m1 = v; } else if (v > m2) m2 = v; }
                gs[g] = m1 + m2; }
            unsigned gmask = 0u;
#pragma unroll
            for (int it = 0; it < 4; ++it) { float best = -INFINITY; int bi = 0;
#pragma unroll
                for (int g = 0; g < 8; ++g) { const bool free_ = !((gmask >> g) & 1u); if (free_ && gs[g] > best) { best = gs[g]; bi = g; } }
                gmask |= 1u << bi; }
            unsigned long long picked = 0ull; float wsum = 0.f;
#pragma unroll
            for (int it = 0; it < 8; ++it) { float best = -INFINITY; int bi = 0;
#pragma unroll
                for (int e = 0; e < 64; ++e) { const bool ok = ((gmask >> (e >> 3)) & 1u) && !((picked >> e) & 1ull); if (ok && sl[e] > best) { best = sl[e]; bi = e; } }
                picked |= 1ull << bi; se[it] = bi; const float s = row0[bi]; sw[it] = s; wsum += s; }
            const float inv = 2.5f / wsum;
#pragma unroll
            for (int k = 0; k < 8; ++k) { sw[k] *= inv; sslot[k] = __hip_atomic_fetch_add(lcnt + se[k], 1, __ATOMIC_RELAXED, __HIP_MEMORY_SCOPE_WORKGROUP); }
        }
        __syncthreads();
        if (F.tid < 64) { const int c = lcnt[F.tid]; lbase[F.tid] = c > 0 ? (int)__hip_atomic_fetch_add(ecnt + F.tid, (unsigned)c, RLX_AGENT) : 0; }
        __syncthreads();
        if (F.tid < 64) { const int tok = tokb + F.tid;
#pragma unroll
            for (int k = 0; k < 8; ++k) { const int slot = lbase[se[k]] + sslot[k];
                ELIST[(size_t)se[k] * 16384 + slot] = tok; TOKE[tok * 8 + k] = (se[k] << 16) | slot; TOKW[tok * 8 + k] = sw[k]; } }
        __syncthreads();
    }
}

constexpr int MT_CNT = 0, MT_TST = 256, MT_COFF = 768, MT_GTAB = 2048;
__device__ __forceinline__ void moe_tables(Ctx& F) {
    LAS int* cnt = (LAS int*)(F.lds + LDSX_OFF + MT_CNT); LAS int* tst = (LAS int*)(F.lds + LDSX_OFF + MT_TST); LAS int* coff = (LAS int*)(F.lds + LDSX_OFF + MT_COFF);
    if (F.tid < 64) cnt[F.tid] = (int)__hip_atomic_load(F.ctl + CW_ECNT + F.tid, RLX_AGENT);
    __syncthreads();
    if (F.tid == 0) { int t = 0, c = 0; for (int e = 0; e < 64; ++e) { tst[e] = t; coff[e] = c; const int n = cnt[e]; t += (n + 255) >> 8; c += n; } tst[64] = t; coff[64] = c; }
    __syncthreads();
}
struct MoeSched {
    const LAS int* cnt; const LAS int* tst; const LAS int* coff; int G, c, npn_log2; const char* A; const char* B; size_t a_tile_bytes, b_exp_bytes, b_tile_bytes; bool compact;
    __device__ __forceinline__ bool next(int i, pg8::Unit& u) const {
        const int ntile = tst[64];
        const long L = (long)i * G + c; if (L >= ((long)ntile << npn_log2)) return false;
        const int rt = (int)(L >> npn_log2), pn = (int)(L & ((1 << npn_log2) - 1));
        int lo = 0, hi = 64;
#pragma unroll
        for (int s = 0; s < 6; ++s) { const int mid = (lo + hi) >> 1; if (tst[mid] <= rt) lo = mid; else hi = mid; }
        int e = lo;
        e = __builtin_amdgcn_readfirstlane(e);
        const int j = rt - __builtin_amdgcn_readfirstlane(tst[e]);
        const int n = __builtin_amdgcn_readfirstlane(cnt[e]);
        u.pm = rt; u.pn = pn; u.aux = e;
        u.valid = (n - 256 * j) < 256 ? (n - 256 * j) : 256;
        u.rowbase = compact ? (__builtin_amdgcn_readfirstlane(coff[e]) + 256 * j) : rt * 256;
        u.A = A + (size_t)rt * a_tile_bytes; u.B = B + (size_t)e * b_exp_bytes + (size_t)pn * b_tile_bytes;
        return true;
    }
};

__device__ __forceinline__ void p12_combine(Ctx& F) {
    moe_tables(F);
    const LAS int* coff = (const LAS int*)(F.lds + LDSX_OFF + MT_COFF);
    const unsigned char* Y = (const unsigned char*)(F.ws + WS_Y); const int* TOKE = (const int*)(F.ws + WS_TOKE); const float* TOKW = (const float*)(F.ws + WS_TOKW);
    const float* modf = (const float*)(F.ws + WS_MOD); const float* gfin = F.in[I_GFINAL]; const bf16_t* SHOUT = (const bf16_t*)(F.ws + WS_SHOUT);
    float* out = F.out;
    const int gw = F.blk * 8 + F.wave, NGW = F.G * 8;
    for (int tok = gw; tok < T; tok += NGW) {
        const int b = tok / SEQ;
        f32x4 acc[8];
        int es8[8]; float w8[8];
#pragma unroll
        for (int k = 0; k < 8; ++k) { es8[k] = TOKE[tok * 8 + k]; w8[k] = TOKW[tok * 8 + k]; }
        f32x4* xr = (f32x4*)(out + (size_t)tok * 2048) + F.lane;
        f32x4 v[8];
        { const unsigned long long* x1r = (const unsigned long long*)((const bf16_t*)(F.ws + WS_X1) + (size_t)tok * 2048) + F.lane;
#pragma unroll
          for (int j = 0; j < 8; ++j) { const unsigned long long u = __builtin_nontemporal_load(x1r + 64 * j); const unsigned lo = (unsigned)u, hi = (unsigned)(u >> 32);
              v[j] = (f32x4){bf_lo(lo), bf_hi(lo), bf_lo(hi), bf_hi(hi)}; } }
        { const unsigned* sr = (const unsigned*)((const unsigned char*)SHOUT + (size_t)tok * 2048) + F.lane;
#pragma unroll
          for (int j = 0; j < 8; ++j) { const int u = (int)__builtin_nontemporal_load(sr + 64 * j); const f32x2 lo = __builtin_amdgcn_cvt_pk_f32_fp8(u, false), hi = __builtin_amdgcn_cvt_pk_f32_fp8(u, true);
              acc[j].x = lo[0]; acc[j].y = lo[1]; acc[j].z = hi[0]; acc[j].w = hi[1]; } }
#pragma unroll
        for (int kk = 0; kk < 8; kk += 4) {
            unsigned yu[4][8];
#pragma unroll
            for (int k = 0; k < 4; ++k) { const int e = es8[kk + k] >> 16, slot = es8[kk + k] & 0xffff;
                const unsigned* yr = (const unsigned*)(Y + (size_t)(coff[e] + slot) * 2048) + F.lane;
#pragma unroll
                for (int j = 0; j < 8; ++j) yu[k][j] = __builtin_nontemporal_load(yr + 64 * j); }
#pragma unroll
            for (int k = 0; k < 4; ++k) { const float w = w8[kk + k];
#pragma unroll
                for (int j = 0; j < 8; ++j) { const int u = (int)yu[k][j]; const f32x2 lo = __builtin_amdgcn_cvt_pk_f32_fp8(u, false), hi = __builtin_amdgcn_cvt_pk_f32_fp8(u, true);
                    acc[j].x += w * lo[0]; acc[j].y += w * lo[1]; acc[j].z += w * hi[0]; acc[j].w += w * hi[1]; } }
        }
        float ss = 0.f;
#pragma unroll
        for (int j = 0; j < 8; ++j) { const int c = 4 * F.lane + 256 * j; const f32x4 g2 = *(const f32x4*)(modf + b * 12288 + 10240 + c);
            v[j] = v[j] + g2 * acc[j]; ss += (v[j].x * v[j].x + v[j].y * v[j].y) + (v[j].z * v[j].z + v[j].w * v[j].w); }
        const float rstd = 1.0f / sqrtf(wave_sum(ss) * (1.0f / 2048.0f) + RMS_EPS);
#pragma unroll
        for (int j = 0; j < 8; ++j) { const int c = 4 * F.lane + 256 * j; const f32x4 g = *(const f32x4*)(gfin + c); __builtin_nontemporal_store(v[j] * rstd * g, xr + 64 * j); }
    }
}
struct Args { const float* in[22]; float* out; unsigned char* ws; int ph_lo, ph_hi; };
static_assert(sizeof(Args) == 22 * 8 + 8 + 8 + 8, "Args has no padding");

__global__ void __launch_bounds__(512, 2) fwd_kernel(Args args) {
    extern __shared__ __attribute__((aligned(16))) unsigned char lds_raw[];
    Ctx F;
    F.lds = (LAS unsigned char*)lds_raw;
    F.tid = threadIdx.x; F.lane = F.tid & 63; F.wave = __builtin_amdgcn_readfirstlane(F.tid >> 6);
    F.G = gridDim.x; F.blk = blockIdx.x;
    F.ws = args.ws; F.ctl = (unsigned*)(args.ws + WS_CTL); F.out = args.out;
    F.in = args.in;
    volatile LAS unsigned* MISC = (volatile LAS unsigned*)(F.lds + MISC_OFF);
    if (F.tid < 32) MISC[F.tid] = 0u;
    __syncthreads();
    XcdBarrier bar; bar.bar = F.ctl + CW_BAR; bar.x = 0; bar.st = nullptr;
    if (MK_N_LAUNCHES == 1) bar = xcd_barrier_post(F.ctl + CW_BAR, MISC + 8);
    const int lo = args.ph_lo, hi = args.ph_hi;
    unsigned char* ws = args.ws;
#define IN(k) (lo <= (k) && (k) < hi && ((PHASE_MASK >> (k)) & 1u))
#define SEAM(k) do { if (MK_N_LAUNCHES == 1 && (k) + 1 < hi) xcd_barrier(bar); } while (0)
#define NREP(k) (((REP_MASK >> (k)) & 1u) ? 2 : 1)
    typedef pg8::StaticOrder SO;

    if (lo <= 0 && 0 < hi) { if (IN(0)) { for (int rep_ = 0; rep_ < NREP(0); ++rep_) { if (rep_) xcd_barrier(bar); p0_prologue(F); } } SEAM(0); }
    if (lo <= 1 && 1 < hi) { if (IN(1)) { for (int rep_ = 0; rep_ < NREP(1); ++rep_) { if (rep_) xcd_barrier(bar); p1_norm(F); } } SEAM(1); }
    if (lo <= 2 && 2 < hi) {
        if (IN(2)) {
#pragma unroll 1
        for (int rep_ = 0; rep_ < NREP(2); ++rep_) { if (rep_) xcd_barrier(bar);
            const char* H = (const char*)(ws + WS_H); const char* W = (const char*)(ws + WS_W_IN_T);
            constexpr int KP = P2F8 ? 1024 : 2048;
            { SO S; S.init(H, W, T, 8192, KP, F.G, F.blk);
              epi::ProjEpi E{epi::StoreQK8w{ws + WS_QD, ws + WS_KDT, att::D8_QS}, epi::StoreQKbothw{(bf16_t*)(ws + WS_QM), (bf16_t*)(ws + WS_KMT), ws + WS_QM8, ws + WS_KMT8}, epi::GatesW{ws + WS_GATES}};
              pg8::gemm_phase<epi::ProjEpi, SO, true, true, false, P2F8>(F.lds, KP, S, E, nullptr); }
            { SO S; S.init(W + (size_t)8192 * KP * 2, H, 2048, T, KP, F.G, F.blk); epi::ProjVT E{epi::StoreVT8{ws + WS_VDT, att::D8_VS}, epi::StoreVT8{ws + WS_VMT8, att::D8_VS}};
              pg8::gemm_phase<epi::ProjVT, SO, true, true, false, P2F8>(F.lds, KP, S, E, nullptr); }
        }
        }
        SEAM(2);
    }
    if (lo <= 3 && 3 < hi) {
        if (IN(3)) {
#pragma unroll 1
        for (int rep_ = 0; rep_ < NREP(3); ++rep_) { if (rep_) xcd_barrier(bar);
            const float* lv = F.in[I_LAMBDA];
            float d1 = 0.f, d2 = 0.f;
            for (int i = 0; i < 64; ++i) { d1 += lv[i] * lv[64 + i]; d2 += lv[128 + i] * lv[192 + i]; }
            if (F.tid == 0) *(LAS float*)(F.lds + MISC_OFF + 68) = expf(d1) - expf(d2) + 0.2f;
            {
                const int x = (int)(xb_xcc_id() & 7u);
                const bool converter = ((F.blk >> 3) & 3) == 3;
                if (converter) { for (int c = queue_take(F, F.ctl + CW_CQ); c < CV_NCHUNK; c = queue_take(F, F.ctl + CW_CQ)) { __syncthreads(); convert_chunk(F, c); } }
#pragma unroll 1
                for (int k = 0; k < 8; ++k) {
                    const int xq = (x + k) & 7;
#pragma unroll 1
                    for (int i = queue_take(F, F.ctl + CW_AQ + 64 * xq); i < 128; i = queue_take(F, F.ctl + CW_AQ + 64 * xq)) {
                        const int bh = 2 * xq + (i & 1), qt = 63 - (i >> 1);
                        att::diff_unit8(F.lds, bh >> 3, bh & 7, qt, ws + WS_QD, ws + WS_KDT, ws + WS_VDT, (bf16_t*)(ws + WS_AD), F.in[I_SUBLN], F.in[I_RELB]);
                    }
                }
                for (int c = queue_take(F, F.ctl + CW_CQ); c < CV_NCHUNK; c = queue_take(F, F.ctl + CW_CQ)) { __syncthreads(); convert_chunk(F, c); }
            }
            __syncthreads();
            p3_kmean(F);
        }
        }
        SEAM(3);
    }
    if (lo <= 4 && 4 < hi) { if (IN(4)) p4_gating(F); SEAM(4); }
    if (lo <= 5 && 5 < hi) {
        if (IN(5)) {
#pragma unroll 1
        for (int rep_ = 0; rep_ < NREP(5); ++rep_) { if (rep_) xcd_barrier(bar);
            constexpr int MB_CPU = 2;
            LAS int* pre = (LAS int*)(F.lds + LDSX_OFF);
            const unsigned* mcnt = F.ctl + CW_MCNT;
            const int mycnt = (int)__hip_atomic_load(mcnt + F.tid, RLX_AGENT);
            pre[F.tid] = (1 + ((mycnt + 255) >> 8) + MB_CPU - 1) / MB_CPU;
            __syncthreads();
            int src = 0;
            for (int off = 1; off < 512; off <<= 1) { const int v = pre[src * 512 + F.tid] + (F.tid >= off ? pre[src * 512 + F.tid - off] : 0); pre[(src ^ 1) * 512 + F.tid] = v; src ^= 1; __syncthreads(); }
            LAS int* inc = (LAS int*)(F.lds + att::MB_INC);
            inc[F.tid] = pre[src * 512 + F.tid];
            __syncthreads();
            const int total = inc[511];
            for (int u = F.blk; u < total; u += F.G) {
                int lo_ = -1, hi_ = 511;
#pragma unroll
                for (int st = 0; st < 9; ++st) { const int mid = (lo_ + hi_) >> 1; if (inc[mid] > u) hi_ = mid; else lo_ = mid; }
                const int l = __builtin_amdgcn_readfirstlane(hi_);
                const int before = l > 0 ? __builtin_amdgcn_readfirstlane(inc[l - 1]) : 0;
                const int j = u - before;
                const int cntl = (int)__builtin_amdgcn_readfirstlane(__hip_atomic_load(mcnt + l, RLX_AGENT));
                const int nch = 1 + ((cntl + 255) >> 8);
                const int c0 = j * MB_CPU, c1 = (c0 + MB_CPU) < nch ? (c0 + MB_CPU) : nch;
                att::moba_block8(F.lds, l >> 8, (l >> 5) & 7, l & 31, (const int*)(ws + WS_MLIST) + (size_t)l * 8192, cntl, c0, c1, ws + WS_QM8, ws + WS_KMT8, ws + WS_VMT8, (bf16_t*)(ws + WS_PARTS), (float*)(ws + WS_ML), F.in[I_RELB]);
            }
            __syncthreads();
        }
        }
        SEAM(5);
    }
    if (lo <= 6 && 6 < hi) { if (IN(6)) { for (int rep_ = 0; rep_ < NREP(6); ++rep_) { if (rep_) xcd_barrier(bar); p6_merge(F); } } SEAM(6); }
    if (lo <= 7 && 7 < hi) {
        if (IN(7)) {
#pragma unroll 1
        for (int rep_ = 0; rep_ < NREP(7); ++rep_) { if (rep_) xcd_barrier(bar);
            { pg8::PairOrder S; S.init(ws + WS_AD, ws + WS_W_OD_T, ws + WS_AM, ws + WS_W_OM_T, T, 2048, O78F8 ? 512 : 1024, F.G, F.blk);
              epi::GatePair E{epi::GateMul<0>{(const bf16_t*)(ws + WS_GATES), 0, nullptr, (bf16_t*)(ws + WS_T1)}, epi::GateMul<1>{(const bf16_t*)(ws + WS_GATES), 2048, (const bf16_t*)(ws + WS_T1), (bf16_t*)(ws + WS_G)}};
              pg8::gemm_phase<epi::GatePair, pg8::PairOrder, true, true, false, O78F8>(F.lds, O78F8 ? 512 : 1024, S, E, nullptr); }
        }
        }
        SEAM(7);
    }
    if (lo <= 8 && 8 < hi) {
        if (IN(8)) {
#pragma unroll 1
        for (int rep_ = 0; rep_ < NREP(8); ++rep_) { if (rep_) xcd_barrier(bar);
            SO S; S.init(ws + WS_G, ws + WS_W_OUT_T, T, 2048, O78F8 ? 1024 : 2048, F.G, F.blk); epi::ResidBf16 E{F.in[I_X], (bf16_t*)(ws + WS_X1), (const float*)(ws + WS_MOD), 4096};
            pg8::gemm_phase<epi::ResidBf16, SO, true, true, false, O78F8>(F.lds, O78F8 ? 1024 : 2048, S, E, nullptr);
        }
        }
        SEAM(8);
    }
    if (lo <= 9 && 9 < hi) { if (IN(9)) p9_route(F); SEAM(9); }
    if (lo <= 10 && 10 < hi) {
        if (IN(10)) {
#pragma unroll 1
        for (int rep_ = 0; rep_ < NREP(10); ++rep_) { if (rep_) xcd_barrier(bar);
            moe_tables(F);
            MoeSched S{(const LAS int*)(F.lds + LDSX_OFF + MT_CNT), (const LAS int*)(F.lds + LDSX_OFF + MT_TST), (const LAS int*)(F.lds + LDSX_OFF + MT_COFF), F.G, F.blk, 2,
                       (const char*)(ws + WS_H2F8), (const char*)(ws + WS_W_EGU_T), 0, (size_t)1024 * 2048, (size_t)256 * 2048, false};
            LAS unsigned short* gtab = (LAS unsigned short*)(F.lds + LDSX_OFF + MT_GTAB);
            { const int* ELIST = (const int*)(ws + WS_ELIST); pg8::Unit u;
              for (int i = 0; i < 24 && S.next(i, u); ++i) { if (F.tid < 256) { const int j = u.pm - S.tst[u.aux]; gtab[i * 256 + F.tid] = (unsigned short)(F.tid < u.valid ? ELIST[(size_t)u.aux * 16384 + 256 * j + F.tid] : 0); } } }
            __syncthreads();
            { epi::SwiGLU8 E{ws + WS_ACT}; pg8::gemm_phase<epi::SwiGLU8, MoeSched, true, true, true, true>(F.lds, 1024, S, E, gtab); }
            { SO S2; S2.init(ws + WS_H2F8, ws + WS_W_SHGU_T, T, 1024, 1024, F.G, F.blk); epi::SwiGLU8 E{ws + WS_SHACT};
              pg8::gemm_phase<epi::SwiGLU8, SO, true, true, false, true>(F.lds, 1024, S2, E, nullptr); }
        }
        }
        SEAM(10);
    }
    if (lo <= 11 && 11 < hi) {
        if (IN(11)) {
            moe_tables(F);
            MoeSched S{(const LAS int*)(F.lds + LDSX_OFF + MT_CNT), (const LAS int*)(F.lds + LDSX_OFF + MT_TST), (const LAS int*)(F.lds + LDSX_OFF + MT_COFF), F.G, F.blk, 3,
                       (const char*)(ws + WS_ACT), (const char*)(ws + WS_W_ED_T), (size_t)256 * 512, (size_t)2048 * 512, (size_t)256 * 512, true};
#pragma unroll 1
            for (int rep_ = 0; rep_ < NREP(11); ++rep_) { if (rep_) xcd_barrier(bar);
            { epi::DownY E{(unsigned char*)(ws + WS_Y)}; pg8::gemm_phase<epi::DownY, MoeSched, true, true, false, true>(F.lds, 256, S, E, nullptr); } }
            { SO S2; S2.init(ws + WS_SHACT, ws + WS_W_SHD_T, T, 2048, 256, F.G, F.blk); epi::DownShared8 E{ws + WS_SHOUT};
              pg8::gemm_phase<epi::DownShared8, SO, true, true, false, true>(F.lds, 256, S2, E, nullptr); }
        }
        SEAM(11);
    }
    if (lo <= 12 && 12 < hi) { if (IN(12)) p12_combine(F); }
#undef IN
#undef SEAM
}

extern "C" void kernel_launch(void* const* d_in, const int* in_sizes, int n_in, void* d_out, int out_size, void* d_ws, size_t ws_size, hipStream_t stream) {
    static int grid = 0;
    if (grid == 0) {
        if (n_in != 22 || in_sizes[0] != T * D || out_size != T * D || ws_size < WS_END) { fprintf(stderr, "kernel_launch: unexpected shapes (n_in %d, in0 %d, out %d, ws %zu < %zu); nothing launched\n", n_in, n_in > 0 ? in_sizes[0] : -1, out_size, ws_size, (size_t)WS_END); grid = -1; return; }
        int dev = 0, cus = 0, per_cu = 0;
        if (hipGetDevice(&dev) != hipSuccess || hipDeviceGetAttribute(&cus, hipDeviceAttributeMultiprocessorCount, dev) != hipSuccess) { grid = -1; return; }
        if (hipFuncSetAttribute((const void*)fwd_kernel, hipFuncAttributeMaxDynamicSharedMemorySize, LDS_BYTES) != hipSuccess) { fprintf(stderr, "kernel_launch: hipFuncSetAttribute failed\n"); grid = -1; return; }
        if (hipOccupancyMaxActiveBlocksPerMultiprocessor(&per_cu, (const void*)fwd_kernel, 512, LDS_BYTES) != hipSuccess || per_cu < 1) fprintf(stderr, "kernel_launch: occupancy query says %d\n", per_cu);
        (void)hipGetLastError();
        grid = cus;
    }
    if (grid < 0) return;
    if (hipMemsetAsync((char*)d_ws + WS_CTL, 0, CTL_ZERO_BYTES, stream) != hipSuccess) { fprintf(stderr, "kernel_launch: memset failed\n"); return; }
    Args a{};
    for (int i = 0; i < 22; ++i) a.in[i] = (const float*)d_in[i];
    a.out = (float*)d_out; a.ws = (unsigned char*)d_ws;
    for (int li = 0; li < MK_N_LAUNCHES; ++li) {
        a.ph_lo = (MK_N_LAUNCHES == 1) ? 0 : li; a.ph_hi = (MK_N_LAUNCHES == 1) ? NPHASE : li + 1;
        hipLaunchKernelGGL(fwd_kernel, dim3(grid), dim3(512), LDS_BYTES, stream, a);
        const hipError_t le = hipPeekAtLastError();
        if (le != hipSuccess) { fprintf(stderr, "kernel_launch: launch %d failed: %s\n", li, hipGetErrorName(le)); break; }
    }
}
```
